# Optimizing an MI355X kernel written in HIP

```python
import math
import jax, jax.numpy as jnp
from jax import lax
import numpy as np

D_MODEL = 1024
BATCH = 32
SEQ = 2048
DEPTH = 1

HEAD_DIM = 128
ATTN_SLOTS = 4
DIL_PATTERNS = ((128, 1), (512, 4), (2048, 16))
N_DIL = len(DIL_PATTERNS)
ATTN_QK = N_DIL * ATTN_SLOTS * HEAD_DIM
ATTN_OUT = ATTN_SLOTS * HEAD_DIM
BAND_BLOCK = 128
ROPE_THETA = 10000.0
CONV_CH = 512
CONV_WIDTH = 31
MEM_LEN = 256
MEM_HEADS = 4
MEM_HEAD_DIM = 128
MEM_W = MEM_HEADS * MEM_HEAD_DIM
N_BRANCH = 3
IN_COLS = 3 * ATTN_QK + 2 * CONV_CH + MEM_W + N_BRANCH * D_MODEL
N_GROUPS = 4
EXPERTS_PER_GROUP = 4
N_EXPERTS = N_GROUPS * EXPERTS_PER_GROUP
TOP_K = 2
EXPERT_FF = 512
LN_EPS = 1e-5
DN_ALPHA = (2.0 * DEPTH) ** 0.25
DN_BETA = (8.0 * DEPTH) ** -0.25

kernel_name = "hybrid_dilated_conformer_memory_hmoe_deepnorm"


def layer_norm(x, g, b):
    xf = x.astype(jnp.float32)
    mu = jnp.mean(xf, axis=-1, keepdims=True)
    var = jnp.mean(jnp.square(xf - mu), axis=-1, keepdims=True)
    y = (xf - mu) * lax.rsqrt(var + LN_EPS)
    return (y * g.astype(jnp.float32) + b.astype(jnp.float32)).astype(x.dtype)


def rope_tables(positions):
    half = HEAD_DIM // 2
    inv = ROPE_THETA ** (-jnp.arange(half, dtype=jnp.float32) / half)
    ang = positions.astype(jnp.float32)[..., None] * inv
    return jnp.cos(ang)[:, :, None, :], jnp.sin(ang)[:, :, None, :]


def apply_rope(t, cos, sin):
    half = HEAD_DIM // 2
    tf = t.astype(jnp.float32)
    t1, t2 = tf[..., :half], tf[..., half:]
    return jnp.concatenate([t1 * cos - t2 * sin, t2 * cos + t1 * sin], axis=-1).astype(t.dtype)


def dilated_group_attention(q, k, v, window, dilation):
    B, S, H, E = q.shape
    L = S // dilation
    nb = -(-L // BAND_BLOCK)
    Lp = nb * BAND_BLOCK
    reach = window // dilation

    def split(t):
        t = t.reshape(B, L, dilation, H, E).transpose(0, 2, 3, 1, 4)
        t = jnp.pad(t, ((0, 0), (0, 0), (0, 0), (0, Lp - L), (0, 0)))
        return t.reshape(B, dilation, H, nb, BAND_BLOCK, E)

    def with_prev(t):
        prev = jnp.pad(t, ((0, 0), (0, 0), (0, 0), (1, 0), (0, 0), (0, 0)))[:, :, :, :-1]
        return jnp.concatenate([prev, t], axis=4)

    qb = split(q)
    kk = with_prev(split(k))
    vv = with_prev(split(v))
    s = jnp.einsum('brhnqe,brhnke->brhnqk', qb, kk).astype(jnp.float32) * (E ** -0.5)
    qi = jnp.arange(BAND_BLOCK)[:, None]
    kj = jnp.arange(2 * BAND_BLOCK)[None, :]
    dist = BAND_BLOCK + qi - kj
    blk = jnp.arange(nb)[:, None, None]
    valid = (dist >= 0) & (dist <= reach) & (blk * BAND_BLOCK + kj - BAND_BLOCK >= 0)
    s = jnp.where(valid, s, -jnp.inf)
    m = jnp.max(s, axis=-1, keepdims=True)
    lse = m + jnp.log(jnp.sum(jnp.exp(s - m), axis=-1, keepdims=True))
    p = jnp.exp(s - lse)
    o = jnp.einsum('brhnqk,brhnke->brhnqe', p.astype(v.dtype), vv)
    o = o.reshape(B, dilation, H, Lp, E)[:, :, :, :L].transpose(0, 3, 1, 2, 4).reshape(B, S, H, E)
    lse = lse.reshape(B, dilation, H, Lp)[:, :, :, :L].transpose(0, 3, 1, 2).reshape(B, S, H)
    return o, lse


def hybrid_mixer(h, mem, cos, sin, w_in, b_in, conv_w, conv_b, conv_ln_g, conv_ln_b,
                 w_mem_kv, w_attn_o, w_conv_o, w_mem_o, w_out):
    B, S, D = h.shape
    u = h @ w_in + b_in
    cuts = [ATTN_QK, 2 * ATTN_QK, 3 * ATTN_QK, 3 * ATTN_QK + 2 * CONV_CH,
            3 * ATTN_QK + 2 * CONV_CH + MEM_W]
    q, k, v, glu_in, qm, gate_pre = jnp.split(u, cuts, axis=-1)

    nh = N_DIL * ATTN_SLOTS
    q = apply_rope(q.reshape(B, S, nh, HEAD_DIM), cos, sin).reshape(B, S, N_DIL, ATTN_SLOTS, HEAD_DIM)
    k = apply_rope(k.reshape(B, S, nh, HEAD_DIM), cos, sin).reshape(B, S, N_DIL, ATTN_SLOTS, HEAD_DIM)
    v = v.reshape(B, S, N_DIL, ATTN_SLOTS, HEAD_DIM)
    outs, lses = [], []
    for g, (window, dilation) in enumerate(DIL_PATTERNS):
        o_g, lse_g = dilated_group_attention(q[:, :, g], k[:, :, g], v[:, :, g], window, dilation)
        outs.append(o_g)
        lses.append(lse_g)
    wts = jax.nn.softmax(jnp.stack(lses, axis=0), axis=0)
    o_attn = jnp.sum(wts[..., None].astype(v.dtype) * jnp.stack(outs, axis=0), axis=0)
    y_attn = o_attn.reshape(B, S, ATTN_OUT) @ w_attn_o

    a, b = jnp.split(glu_in, 2, axis=-1)
    c = a * jax.nn.sigmoid(b)
    c = lax.conv_general_dilated(c, conv_w[:, None, :], window_strides=(1,),
                                 padding=[(CONV_WIDTH - 1, 0)],
                                 dimension_numbers=('NWC', 'WIO', 'NWC'),
                                 feature_group_count=CONV_CH) + conv_b
    c = jax.nn.silu(layer_norm(c, conv_ln_g, conv_ln_b))
    y_conv = c @ w_conv_o

    kv = mem @ w_mem_kv
    km, vm = jnp.split(kv, 2, axis=-1)
    Mlen = mem.shape[1]
    qm = qm.reshape(B, S, MEM_HEADS, MEM_HEAD_DIM)
    km = km.reshape(B, Mlen, MEM_HEADS, MEM_HEAD_DIM)
    vm = vm.reshape(B, Mlen, MEM_HEADS, MEM_HEAD_DIM)
    sm = jnp.einsum('bshe,bmhe->bhsm', qm, km).astype(jnp.float32) * (MEM_HEAD_DIM ** -0.5)
    pm = jax.nn.softmax(sm, axis=-1)
    om = jnp.einsum('bhsm,bmhe->bshe', pm.astype(vm.dtype), vm).reshape(B, S, MEM_W)
    y_mem = om @ w_mem_o

    gates = jax.nn.sigmoid(gate_pre).reshape(B, S, N_BRANCH, D)
    merged = gates[:, :, 0] * y_attn + gates[:, :, 1] * y_conv + gates[:, :, 2] * y_mem
    return merged @ w_out


def hierarchical_moe(h, w_gr, b_gr, w_er, b_er, w_g, w_u, w_d):
    B, S, D = h.shape
    t = h.reshape(B * S, D)
    gl = (t @ w_gr).astype(jnp.float32) + b_gr.astype(jnp.float32)
    gp = jax.nn.softmax(gl, axis=-1)
    g_sel = jnp.argmax(gl, axis=-1)
    g_prob = jnp.take_along_axis(gp, g_sel[:, None], axis=-1)[:, 0]
    el = jnp.einsum('td,gde->tge', t, w_er).astype(jnp.float32) + b_er.astype(jnp.float32)
    el_sel = jnp.take_along_axis(el, g_sel[:, None, None], axis=1)[:, 0]
    top_v, top_i = lax.top_k(el_sel, TOP_K)
    top_w = jax.nn.softmax(top_v, axis=-1) * g_prob[:, None]
    ew = jnp.sum(jax.nn.one_hot(top_i, EXPERTS_PER_GROUP, dtype=jnp.float32) * top_w[..., None], axis=1)
    full = (jax.nn.one_hot(g_sel, N_GROUPS, dtype=jnp.float32)[:, :, None] * ew[:, None, :])
    full = full.reshape(B * S, N_EXPERTS).astype(t.dtype)
    y = jnp.zeros_like(t)
    for e in range(N_EXPERTS):
        hid = jax.nn.silu(t @ w_g[e]) * (t @ w_u[e])
        y = y + full[:, e:e + 1] * (hid @ w_d[e])
    return y.reshape(B, S, D)


def setup_inputs(seed: int = 0) -> dict:
    key = jax.random.key(seed)
    ks = jax.random.split(key, 26)
    f32 = jnp.float32
    nrm = lambda k, shape, scale: jax.random.normal(k, shape, f32) * scale
    x = jax.random.normal(ks[0], (BATCH, SEQ, D_MODEL), f32)
    mem = jax.random.normal(ks[1], (BATCH, MEM_LEN, D_MODEL), f32)
    offset = jax.random.randint(ks[2], (BATCH, 1), 0, 1024, dtype=jnp.int32)
    positions = offset + jnp.arange(SEQ, dtype=jnp.int32)[None, :]
    w_in = nrm(ks[3], (DEPTH, D_MODEL, IN_COLS), D_MODEL ** -0.5)
    w_in = w_in.at[:, :, 2 * ATTN_QK:3 * ATTN_QK].multiply(DN_BETA)
    b_in = nrm(ks[4], (DEPTH, IN_COLS), 0.02)
    conv_w = nrm(ks[5], (DEPTH, CONV_WIDTH, CONV_CH), CONV_WIDTH ** -0.5)
    conv_b = nrm(ks[6], (DEPTH, CONV_CH), 0.02)
    conv_ln_g = 1.0 + nrm(ks[7], (DEPTH, CONV_CH), 0.02)
    conv_ln_b = nrm(ks[8], (DEPTH, CONV_CH), 0.02)
    w_mem_kv = nrm(ks[9], (DEPTH, D_MODEL, 2 * MEM_W), D_MODEL ** -0.5)
    w_attn_o = nrm(ks[10], (DEPTH, ATTN_OUT, D_MODEL), ATTN_OUT ** -0.5 * DN_BETA)
    w_conv_o = nrm(ks[11], (DEPTH, CONV_CH, D_MODEL), CONV_CH ** -0.5 * DN_BETA)
    w_mem_o = nrm(ks[12], (DEPTH, MEM_W, D_MODEL), MEM_W ** -0.5 * DN_BETA)
    w_out = nrm(ks[13], (DEPTH, D_MODEL, D_MODEL), D_MODEL ** -0.5 * DN_BETA)
    ln1_g = 1.0 + nrm(ks[14], (DEPTH, D_MODEL), 0.02)
    ln1_b = nrm(ks[15], (DEPTH, D_MODEL), 0.02)
    w_group_router = nrm(ks[16], (DEPTH, D_MODEL, N_GROUPS), D_MODEL ** -0.5)
    b_group_router = nrm(ks[17], (DEPTH, N_GROUPS), 0.01)
    w_expert_router = nrm(ks[18], (DEPTH, N_GROUPS, D_MODEL, EXPERTS_PER_GROUP), D_MODEL ** -0.5)
    b_expert_router = nrm(ks[19], (DEPTH, N_GROUPS, EXPERTS_PER_GROUP), 0.01)
    w_exp_gate = nrm(ks[20], (DEPTH, N_EXPERTS, D_MODEL, EXPERT_FF), D_MODEL ** -0.5)
    w_exp_up = nrm(ks[21], (DEPTH, N_EXPERTS, D_MODEL, EXPERT_FF), D_MODEL ** -0.5)
    w_exp_down = nrm(ks[22], (DEPTH, N_EXPERTS, EXPERT_FF, D_MODEL), EXPERT_FF ** -0.5 * DN_BETA)
    ln2_g = 1.0 + nrm(ks[23], (DEPTH, D_MODEL), 0.02)
    ln2_b = nrm(ks[24], (DEPTH, D_MODEL), 0.02)
    return {"x": x, "mem": mem, "positions": positions, "w_in": w_in, "b_in": b_in,
            "conv_w": conv_w, "conv_b": conv_b, "conv_ln_g": conv_ln_g, "conv_ln_b": conv_ln_b,
            "w_mem_kv": w_mem_kv, "w_attn_o": w_attn_o, "w_conv_o": w_conv_o, "w_mem_o": w_mem_o,
            "w_out": w_out, "ln1_g": ln1_g, "ln1_b": ln1_b,
            "w_group_router": w_group_router, "b_group_router": b_group_router,
            "w_expert_router": w_expert_router, "b_expert_router": b_expert_router,
            "w_exp_gate": w_exp_gate, "w_exp_up": w_exp_up, "w_exp_down": w_exp_down,
            "ln2_g": ln2_g, "ln2_b": ln2_b}


def reference(x, mem, positions, w_in, b_in, conv_w, conv_b, conv_ln_g, conv_ln_b,
              w_mem_kv, w_attn_o, w_conv_o, w_mem_o, w_out, ln1_g, ln1_b,
              w_group_router, b_group_router, w_expert_router, b_expert_router,
              w_exp_gate, w_exp_up, w_exp_down, ln2_g, ln2_b):
    cos, sin = rope_tables(positions)
    for l in range(DEPTH):
        mix = hybrid_mixer(x, mem, cos, sin, w_in[l], b_in[l], conv_w[l], conv_b[l],
                           conv_ln_g[l], conv_ln_b[l], w_mem_kv[l], w_attn_o[l], w_conv_o[l],
                           w_mem_o[l], w_out[l])
        x = layer_norm(DN_ALPHA * x + mix, ln1_g[l], ln1_b[l])
        ffn = hierarchical_moe(x, w_group_router[l], b_group_router[l], w_expert_router[l],
                               b_expert_router[l], w_exp_gate[l], w_exp_up[l], w_exp_down[l])
        x = layer_norm(DN_ALPHA * x + ffn, ln2_g[l], ln2_b[l])
    return x
```

```cpp
#include <hip/hip_runtime.h>
#include <cstdio>
#include <cstdint>

constexpr int D = 1024, NB = 32, S = 2048, T = NB * S;
constexpr int NCH = 2, BC = NB / NCH, TC = T / NCH;
constexpr int INC = 9216;
constexpr int MEML = 256;
constexpr int NCLS = 24;
constexpr int MPAD = T + NCLS * 256;
constexpr float LN_EPS = 1e-5f;
constexpr float DN_ALPHA = 1.189207115002721f;
constexpr float ATT_SCALE = 0.08838834764831845f;

constexpr int C_Q = 0, C_K = 1536, C_V = 3072, C_GLU = 4608, C_QM = 5632, C_GATE = 6144;

constexpr size_t MiB = 1ull << 20;
constexpr size_t WS_CTL = 0, CTL_BYTES = 1 * MiB;
constexpr size_t WS_WIN = 1 * MiB;
constexpr size_t WS_BIASP = 19 * MiB;
constexpr size_t WS_WRT = 19 * MiB + 64 * 1024;
constexpr size_t WS_WKV = 20 * MiB;
constexpr size_t WS_WA = 22 * MiB, WS_WC = 23 * MiB, WS_WM = 24 * MiB;
constexpr size_t WS_WOUT = 25 * MiB;
constexpr size_t WS_W1 = 27 * MiB;
constexpr size_t WS_W2 = 59 * MiB;
constexpr size_t WS_MEMB = 75 * MiB;
constexpr size_t WS_CH = 91 * MiB;
constexpr size_t SZ_XB = (size_t)TC * 1024 * 2, SZ_QKV1 = (size_t)TC * 1536 * 2, SZ_512 = (size_t)TC * 512 * 2;
constexpr size_t WS_XB = WS_CH;
constexpr size_t WS_QG = WS_XB + (size_t)T * 1024 * 2, WS_KG = WS_QG + SZ_QKV1, WS_VG = WS_KG + SZ_QKV1;
constexpr size_t WS_CGLU = WS_VG + SZ_QKV1, WS_QM = WS_CGLU + SZ_512, WS_OATT = WS_QM + SZ_512, WS_CCONV = WS_OATT + SZ_512, WS_OMT = WS_CCONV + SZ_512;
constexpr size_t WS_GATES = WS_OMT + SZ_512;
constexpr size_t SZ_KM = (size_t)NB * 4 * MEML * 128 * 2;
constexpr size_t WS_KM = WS_GATES + (size_t)TC * 3072 * 2, WS_VM = WS_KM + SZ_KM;
constexpr size_t WS_LSE = WS_VM + SZ_KM;
constexpr size_t WS_MERGED = WS_LSE + 2 * MiB;
constexpr size_t WS_CH_END = WS_MERGED + SZ_XB;
constexpr size_t WS_X1B = WS_CH;
constexpr size_t WS_H = WS_X1B + (size_t)T * 1024 * 2;
constexpr size_t WS_Y2 = WS_H + (size_t)MPAD * 1024 * 2;
constexpr size_t WS_LIST = WS_Y2 + (size_t)MPAD * 1024 * 2;
constexpr size_t WS_WTS = WS_LIST + (size_t)NCLS * T * 4;
constexpr size_t WS_X1B8 = WS_WTS + (size_t)T * 8;
constexpr size_t WS_MOE_END = WS_X1B8 + (size_t)T * 1024;
constexpr float W8_SCALE = 32.0f, H8_SCALE = 16.0f;
constexpr size_t WS_END = WS_CH_END > WS_MOE_END ? WS_CH_END : WS_MOE_END;
constexpr size_t WS_XB8 = 944 * MiB;
constexpr size_t WS_WG8 = 1008 * MiB;
constexpr float WG8_SCALE = 32.0f;
static_assert(WS_CH_END <= WS_XB8 && WS_WG8 + 9 * MiB <= 1024 * MiB, "fp8 operand buffers");
static_assert(WS_END <= 1024 * MiB, "workspace map exceeds 1 GiB");
constexpr int CW_CNT = 64;

typedef unsigned short bf16_t;
typedef float f32x4 __attribute__((ext_vector_type(4)));
typedef unsigned u32x4 __attribute__((ext_vector_type(4)));
typedef unsigned u32x2 __attribute__((ext_vector_type(2)));

__device__ __forceinline__ float bf2f(bf16_t b) { return __uint_as_float(((unsigned)b) << 16); }
__device__ __forceinline__ float bflo(unsigned w) { return __uint_as_float(w << 16); }
__device__ __forceinline__ float bfhi(unsigned w) { return __uint_as_float(w & 0xffff0000u); }
__device__ __forceinline__ unsigned f2bf(float f) { unsigned u = __float_as_uint(f); return (u + 0x7fffu + ((u >> 16) & 1u)) >> 16; }
typedef float f32x2_t __attribute__((ext_vector_type(2)));
typedef __bf16 bf16x2_t __attribute__((ext_vector_type(2)));
__device__ __forceinline__ unsigned pk2(float lo, float hi) { f32x2_t v = {lo, hi}; bf16x2_t b = __builtin_convertvector(v, bf16x2_t); return __builtin_bit_cast(unsigned, b); }
__device__ __forceinline__ float sigmoidf_(float x) { return __builtin_amdgcn_rcpf(1.0f + __builtin_amdgcn_exp2f(-1.4426950408889634f * x)); }
__device__ __forceinline__ float wave_sum(float v) {
#define DPP_F(x, ctrl) __int_as_float(__builtin_amdgcn_update_dpp(0, __float_as_int(x), ctrl, 0xf, 0xf, true))
    v += DPP_F(v, 0xB1);
    v += DPP_F(v, 0x4E);
    v += DPP_F(v, 0x141);
    v += DPP_F(v, 0x140);
#undef DPP_F
    const float r0 = __int_as_float(__builtin_amdgcn_readlane(__float_as_int(v), 0)), r1 = __int_as_float(__builtin_amdgcn_readlane(__float_as_int(v), 16));
    const float r2 = __int_as_float(__builtin_amdgcn_readlane(__float_as_int(v), 32)), r3 = __int_as_float(__builtin_amdgcn_readlane(__float_as_int(v), 48));
    return (r0 + r1) + (r2 + r3);
}
__device__ __forceinline__ float wave_max(float v) {
#pragma unroll
    for (int o = 1; o < 64; o <<= 1) v = fmaxf(v, __shfl_xor(v, o));
    return v;
}
__device__ __forceinline__ unsigned pk4_fp8(float a, float b, float c, float d) { unsigned w = 0; w = __builtin_amdgcn_cvt_pk_fp8_f32(a, b, w, false); w = __builtin_amdgcn_cvt_pk_fp8_f32(c, d, w, true); return w; }
__device__ __forceinline__ unsigned pk4_u8(float a, float b, float c, float d) {
    const unsigned ua = (unsigned)fmaxf(__builtin_rintf(a * 255.f), 1.f), ub = (unsigned)fmaxf(__builtin_rintf(b * 255.f), 1.f), uc = (unsigned)fmaxf(__builtin_rintf(c * 255.f), 1.f), ud = (unsigned)fmaxf(__builtin_rintf(d * 255.f), 1.f);
    return ua | (ub << 8) | (uc << 16) | (ud << 24); }
__device__ __forceinline__ f32x4 u8x4_raw(unsigned w) { return (f32x4){(float)(w & 255u), (float)((w >> 8) & 255u), (float)((w >> 16) & 255u), (float)(w >> 24)}; }
__device__ __forceinline__ f32x4 u8x4_to_f32(unsigned w) { return (f32x4){(float)(w & 255u), (float)((w >> 8) & 255u), (float)((w >> 16) & 255u), (float)(w >> 24)} * (1.0f / 255.0f); }
__device__ __forceinline__ int opaque_tid(int wave_s) { unsigned z = 0u; asm volatile("" : "+v"(z)); const int l = (int)__builtin_amdgcn_mbcnt_hi(~0u, __builtin_amdgcn_mbcnt_lo(~0u, z)); return (wave_s << 6) | l; }
__device__ __forceinline__ void rope_cs(float pos, int j, float& c, float& s) {
    const float invrev = __builtin_amdgcn_exp2f(-(float)j * (13.287712379549449f / 64.0f)) * 0.15915494309189535f;
    float rev = pos * invrev; rev = __builtin_amdgcn_fractf(rev);
    s = __builtin_amdgcn_sinf(rev); c = __builtin_amdgcn_cosf(rev);
}
__device__ __forceinline__ int rowperm(int g, int s) { return g == 0 ? s : (g == 1 ? ((s & 3) * 512 + (s >> 2)) : ((s & 15) * 128 + (s >> 4))); }
__host__ __device__ __forceinline__ int win_logical(int n) {
    if (n < C_V) { const int sec = n / 1536, r = n % 1536, gh = r / 128, p = r % 128, G = p >> 3, nn = (p >> 2) & 1, e = p & 3; return sec * 1536 + gh * 128 + 64 * nn + 4 * G + e; }
    if (n < C_GLU) return n;
    if (n < C_QM) { const int cc = n - C_GLU, G = cc >> 3, nn = (cc >> 2) & 1, e = cc & 3; return C_GLU + nn * 512 + 4 * G + e; }
    return n;
}

struct Params {
    const float *x, *mem; const int* pos;
    const float *w_in, *b_in, *conv_w, *conv_b, *conv_g, *conv_bb, *w_mem_kv, *w_attn_o, *w_conv_o, *w_mem_o, *w_out, *ln1_g, *ln1_b;
    const float *w_gr, *b_gr, *w_er, *b_er, *w_eg, *w_eu, *w_ed, *ln2_g, *ln2_b;
    float* out; unsigned char* ws;
};
#define WSP(T_, off) ((T_*)(p.ws + (off)))

__global__ void k_cvt_bf16(const float* __restrict__ src, bf16_t* __restrict__ dst, size_t n8) {
    for (size_t i = (size_t)blockIdx.x * blockDim.x + threadIdx.x; i < n8; i += (size_t)gridDim.x * blockDim.x) {
        const f32x4 a = *(const f32x4*)(src + i * 8), b = *(const f32x4*)(src + i * 8 + 4);
        u32x4 o; o.x = pk2(a.x, a.y); o.y = pk2(a.z, a.w); o.z = pk2(b.x, b.y); o.w = pk2(b.z, b.w);
        *(u32x4*)(dst + i * 8) = o;
    }
}
enum { TW_IN = 0, TW_KV, TW_A, TW_C, TW_M, TW_OUT, TW_W1, TW_W2 };
__device__ __forceinline__ void transpose_w_dev(const Params& p, int which, size_t gtid, size_t gstride) {
    int K, N, ldd; bf16_t* dst;
    switch (which) {
        case TW_IN: K = 1024; N = INC; ldd = 1024; dst = WSP(bf16_t, WS_WIN); break;
        case TW_KV: K = 1024; N = 1024; ldd = 1024; dst = WSP(bf16_t, WS_WKV); break;
        case TW_A: K = 512; N = 1024; ldd = 512; dst = WSP(bf16_t, WS_WA); break;
        case TW_C: K = 512; N = 1024; ldd = 512; dst = WSP(bf16_t, WS_WC); break;
        case TW_M: K = 512; N = 1024; ldd = 512; dst = WSP(bf16_t, WS_WM); break;
        case TW_OUT: K = 1024; N = 1024; ldd = 1024; dst = WSP(bf16_t, WS_WOUT); break;
        case TW_W1: K = 1024; N = 16 * 1024; ldd = 1024; dst = WSP(bf16_t, WS_W1); break;
        default: K = 512; N = 16 * 1024; ldd = 8192; dst = WSP(bf16_t, WS_W2); break;
    }
    const size_t total = (size_t)N * (K / 8);
    for (size_t i = gtid; i < total; i += gstride) {
        const int n = (int)(i % N), k0 = (int)(i / N) * 8;
        float v[8];
#pragma unroll
        for (int j = 0; j < 8; ++j) {
            const int k = k0 + j; float s;
            switch (which) {
                case TW_IN: s = p.w_in[(size_t)k * INC + win_logical(n)]; break;
                case TW_KV: s = p.w_mem_kv[(size_t)k * 1024 + n]; break;
                case TW_A: s = p.w_attn_o[(size_t)k * 1024 + n]; break;
                case TW_C: s = p.w_conv_o[(size_t)k * 1024 + n]; break;
                case TW_M: s = p.w_mem_o[(size_t)k * 1024 + n]; break;
                case TW_OUT: s = p.w_out[(size_t)k * 1024 + n]; break;
                case TW_W1: { const int e = n >> 10, c = n & 1023, G = c >> 3, nn = (c >> 2) & 1, ee = c & 3, jj = 4 * G + ee;
                              s = (nn ? p.w_eu : p.w_eg)[((size_t)e * 1024 + k) * 512 + jj]; } break;
                default: { const int e = n >> 10, c = n & 1023; s = p.w_ed[((size_t)e * 512 + k) * 1024 + c]; } break;
            }
            v[j] = s;
        }
        u32x4 o; o.x = pk2(v[0], v[1]); o.y = pk2(v[2], v[3]); o.z = pk2(v[4], v[5]); o.w = pk2(v[6], v[7]);
        size_t doff;
        if (which == TW_W2) { const int e = n >> 10, c = n & 1023; doff = (size_t)c * 8192 + e * 512 + k0; }
        else doff = (size_t)n * ldd + k0;
        *(u32x4*)(dst + doff) = o;
    }
}
__global__ void k_transpose_w(Params p, int which) { transpose_w_dev(p, which, (size_t)blockIdx.x * blockDim.x + threadIdx.x, (size_t)gridDim.x * blockDim.x); }
__device__ __forceinline__ void small_prep_dev(const Params& p, size_t gtid, size_t gstride) {
    for (size_t ii = gtid; ii < 20 * 1024; ii += gstride) { const int i = (int)ii;
        if (i < INC) WSP(float, WS_BIASP)[i] = p.b_in[win_logical(i)];
        const int e = i >> 10, k = i & 1023;
        WSP(float, WS_WRT)[i] = e < 4 ? p.w_gr[k * 4 + e] : p.w_er[((size_t)((e - 4) >> 2) * 1024 + k) * 4 + ((e - 4) & 3)]; }
}
__global__ void k_small_prep(Params p) { small_prep_dev(p, (size_t)blockIdx.x * blockDim.x + threadIdx.x, (size_t)gridDim.x * blockDim.x); }

struct EpiMain {
    const float* biasp; const int* pos; bf16_t *QG, *CGLU, *QM, *GATES; int tok0;
    static __device__ __forceinline__ void rope_freqs(int c0, float (&invrev)[4]) {
        const int j0 = ((c0 & 127) >> 3) * 4;
#pragma unroll
        for (int e = 0; e < 4; ++e) invrev[e] = __builtin_amdgcn_exp2f(-(float)(j0 + e) * (13.287712379549449f / 64.0f)) * 0.15915494309189535f;
    }
    __device__ __forceinline__ void finish(int rl, int c0, float (&v)[8], float fpos, const float (&invrev)[4]) const {
        const int bl = rl >> 11, s = rl & 2047;
        const int tcol = __builtin_amdgcn_readfirstlane(c0 & ~255);
        if (tcol < C_GLU) {
            const int sec = tcol / 1536, r = c0 - sec * 1536, gh = r >> 7, pcol = r & 127, g = gh >> 2;
            if (sec < 2) {
#pragma unroll
                for (int e = 0; e < 4; ++e) { const float rev = __builtin_amdgcn_fractf(fpos * invrev[e]); const float sn = __builtin_amdgcn_sinf(rev), c = __builtin_amdgcn_cosf(rev);
                    const float t1 = v[e], t2 = v[4 + e]; v[e] = t1 * c - t2 * sn; v[4 + e] = t2 * c + t1 * sn; }
            }
            bf16_t* base = QG + (size_t)sec * (SZ_QKV1 / 2);
            u32x4 o; o.x = pk2(v[0], v[1]); o.y = pk2(v[2], v[3]); o.z = pk2(v[4], v[5]); o.w = pk2(v[6], v[7]);
            *(u32x4*)(base + ((size_t)(bl * 12 + gh) * 2048 + rowperm(g, s)) * 128 + pcol) = o;
        } else if (tcol < C_QM) {
            const int j0 = (c0 - C_GLU) >> 1;
            u32x2 o; o.x = pk2(v[0] * sigmoidf_(v[4]), v[1] * sigmoidf_(v[5])); o.y = pk2(v[2] * sigmoidf_(v[6]), v[3] * sigmoidf_(v[7]));
            *(u32x2*)(CGLU + (size_t)rl * 512 + j0) = o;
        } else if (tcol < C_GATE) {
            const int cc = c0 - C_QM, h = cc >> 7, pcol = cc & 127;
            u32x4 o; o.x = pk2(v[0], v[1]); o.y = pk2(v[2], v[3]); o.z = pk2(v[4], v[5]); o.w = pk2(v[6], v[7]);
            *(u32x4*)(QM + ((size_t)(bl * 4 + h) * 2048 + s) * 128 + pcol) = o;
        } else {
            const int cc = c0 - C_GATE;
            u32x2 o; o.x = pk4_u8(sigmoidf_(v[0]), sigmoidf_(v[1]), sigmoidf_(v[2]), sigmoidf_(v[3])); o.y = pk4_u8(sigmoidf_(v[4]), sigmoidf_(v[5]), sigmoidf_(v[6]), sigmoidf_(v[7]));
            *(u32x2*)((unsigned char*)GATES + (size_t)rl * 3072 + cc) = o;
        }
    }
    __device__ __forceinline__ void operator()(int rl, int c0, float (&v)[8]) const {
        const f32x4 b0 = *(const f32x4*)(biasp + c0), b1 = *(const f32x4*)(biasp + c0 + 4);
        v[0] += b0.x; v[1] += b0.y; v[2] += b0.z; v[3] += b0.w; v[4] += b1.x; v[5] += b1.y; v[6] += b1.z; v[7] += b1.w;
        float invrev[4]; rope_freqs(c0, invrev);
        finish(rl, c0, v, c0 < C_V ? (float)pos[tok0 + rl] : 0.f, invrev);
    }
};
struct EpiKV {
    bf16_t *KM;
    __device__ __forceinline__ void operator()(int row, int c0, float (&v)[8]) const {
        const int bl = row >> 8, m = row & 255, isv = c0 >> 9, cc = c0 & 511, h = cc >> 7, pcol = cc & 127;
        u32x4 o; o.x = pk2(v[0], v[1]); o.y = pk2(v[2], v[3]); o.z = pk2(v[4], v[5]); o.w = pk2(v[6], v[7]);
        *(u32x4*)(KM + (size_t)isv * (SZ_KM / 2) + ((size_t)(bl * 4 + h) * 256 + m) * 128 + pcol) = o;
    }
};
struct EpiMerge {
    const bf16_t* GATES; bf16_t* MERGED; int br;
    __device__ __forceinline__ void operator()(int rl, int c0, float (&v)[8]) const {
        const u32x2 g = *(const u32x2*)((const unsigned char*)GATES + (size_t)rl * 3072 + br * 1024 + c0);
        const f32x4 g0 = u8x4_to_f32(g.x), g1 = u8x4_to_f32(g.y);
        float r[8] = {g0.x * v[0], g0.y * v[1], g0.z * v[2], g0.w * v[3], g1.x * v[4], g1.y * v[5], g1.z * v[6], g1.w * v[7]};
        bf16_t* mp = MERGED + (size_t)rl * 1024 + c0;
        if (br > 0) { const u32x4 m = *(const u32x4*)mp; r[0] += bflo(m.x); r[1] += bfhi(m.x); r[2] += bflo(m.y); r[3] += bfhi(m.y); r[4] += bflo(m.z); r[5] += bfhi(m.z); r[6] += bflo(m.w); r[7] += bfhi(m.w); }
        u32x4 o; o.x = pk2(r[0], r[1]); o.y = pk2(r[2], r[3]); o.z = pk2(r[4], r[5]); o.w = pk2(r[6], r[7]);
        *(u32x4*)mp = o;
    }
};
struct EpiMix {
    bf16_t* MIX; int tok0;
    __device__ __forceinline__ void operator()(int rl, int c0, float (&v)[8]) const {
        u32x4 o; o.x = pk2(v[0], v[1]); o.y = pk2(v[2], v[3]); o.z = pk2(v[4], v[5]); o.w = pk2(v[6], v[7]);
        *(u32x4*)(MIX + (size_t)(tok0 + rl) * 1024 + c0) = o;
    }
};
struct ClassTab { int cnt[NCLS], rowbase[NCLS + 1]; };
__device__ __forceinline__ void class_tab_fill(const unsigned* cntw, ClassTab* t) {
    int acc = 0;
    for (int c = 0; c < NCLS; ++c) { const int n = (int)cntw[c]; t->cnt[c] = n; t->rowbase[c] = acc; acc += ((n + 255) >> 8) << 8; }
    t->rowbase[NCLS] = acc;
}
__device__ __forceinline__ void class_experts(int cls, int& e_lo, int& e_hi) {
    const int g = cls / 6, pi = cls - g * 6;
    const int lo = pi < 3 ? 0 : (pi < 5 ? 1 : 2), hi = pi < 3 ? pi + 1 : (pi < 5 ? pi - 1 : 3);
    e_lo = g * 4 + lo; e_hi = g * 4 + hi;
}
struct EpiMoe1 {
    const int* list; const float* wts; bf16_t* H; int cls, cnt, rowbase;
    __device__ __forceinline__ void operator()(int prow, int c0, float (&v)[8]) const {
        int i = prow - rowbase; if (i >= cnt) i = cnt - 1;
        const int tok = list[i]; const int hi = c0 >> 10; const float w = wts[(size_t)tok * 2 + hi];
        const int j0 = hi * 512 + ((c0 & 1023) >> 1);
        float r[4];
#pragma unroll
        for (int e = 0; e < 4; ++e) { const float gt = v[e]; r[e] = gt * sigmoidf_(gt) * v[4 + e] * w; }
        u32x2 o; o.x = pk2(r[0], r[1]); o.y = pk2(r[2], r[3]);
        *(u32x2*)(H + (size_t)prow * 1024 + j0) = o;
    }
};
struct EpiMoe2 {
    bf16_t* Y2;
    __device__ __forceinline__ void operator()(int prow, int c0, float (&v)[8]) const {
        u32x4 o; o.x = pk2(v[0], v[1]); o.y = pk2(v[2], v[3]); o.z = pk2(v[4], v[5]); o.w = pk2(v[6], v[7]);
        *(u32x4*)(Y2 + (size_t)prow * 1024 + c0) = o;
    }
};

struct RowsPlain { const bf16_t* base; int ld; __device__ __forceinline__ const bf16_t* operator()(int r) const { return base + (size_t)r * ld; } };
template <class AF, class BF, class EF>
__device__ __forceinline__ void ngemm_tile(int row0, int col0, int K, const AF& af, const BF& bf, const EF& ef, int bkseg, long bjump) {
    __shared__ float As[64][33], Bs[64][33];
    const int tid = threadIdx.x, ty = tid >> 3, tx = tid & 7;
    float acc[2][8];
#pragma unroll
    for (int i = 0; i < 2; ++i)
#pragma unroll
        for (int j = 0; j < 8; ++j) acc[i][j] = 0.f;
    const int lr = tid >> 2, lk = (tid & 3) * 8;
    const bf16_t* ap = af(row0 + lr); const bf16_t* bp = bf(col0 + lr);
    for (int k0 = 0; k0 < K; k0 += 32) {
        const u32x4 a = *(const u32x4*)(ap + k0 + lk);
        const long bo = (long)k0 + lk + (long)(k0 / bkseg) * bjump;
        const u32x4 b = *(const u32x4*)(bp + bo);
        __syncthreads();
        As[lr][lk + 0] = bflo(a.x); As[lr][lk + 1] = bfhi(a.x); As[lr][lk + 2] = bflo(a.y); As[lr][lk + 3] = bfhi(a.y);
        As[lr][lk + 4] = bflo(a.z); As[lr][lk + 5] = bfhi(a.z); As[lr][lk + 6] = bflo(a.w); As[lr][lk + 7] = bfhi(a.w);
        Bs[lr][lk + 0] = bflo(b.x); Bs[lr][lk + 1] = bfhi(b.x); Bs[lr][lk + 2] = bflo(b.y); Bs[lr][lk + 3] = bfhi(b.y);
        Bs[lr][lk + 4] = bflo(b.z); Bs[lr][lk + 5] = bfhi(b.z); Bs[lr][lk + 6] = bflo(b.w); Bs[lr][lk + 7] = bfhi(b.w);
        __syncthreads();
#pragma unroll 8
        for (int kk = 0; kk < 32; ++kk) {
            const float a0 = As[2 * ty][kk], a1 = As[2 * ty + 1][kk];
#pragma unroll
            for (int j = 0; j < 8; ++j) { const float bv = Bs[8 * tx + j][kk]; acc[0][j] += a0 * bv; acc[1][j] += a1 * bv; }
        }
    }
    ef(row0 + 2 * ty, col0 + 8 * tx, acc[0]);
    ef(row0 + 2 * ty + 1, col0 + 8 * tx, acc[1]);
}
__global__ void __launch_bounds__(256) k_ngemm_main(Params p, int ch) {
    const int tok0 = ch * TC;
    EpiMain E{WSP(float, WS_BIASP), p.pos, WSP(bf16_t, WS_QG), WSP(bf16_t, WS_CGLU), WSP(bf16_t, WS_QM), WSP(bf16_t, WS_GATES), tok0};
    RowsPlain A{WSP(bf16_t, WS_XB) + (size_t)ch * TC * 1024, 1024}, Bm{WSP(bf16_t, WS_WIN), 1024};
    ngemm_tile(blockIdx.y * 64, blockIdx.x * 64, 1024, A, Bm, E, 1 << 30, 0);
}
__global__ void __launch_bounds__(256) k_ngemm_kv(Params p, int ch) {
    EpiKV E{WSP(bf16_t, WS_KM)};
    RowsPlain A{WSP(bf16_t, WS_MEMB), 1024}, Bm{WSP(bf16_t, WS_WKV), 1024};
    ngemm_tile(blockIdx.y * 64, blockIdx.x * 64, 1024, A, Bm, E, 1 << 30, 0);
}
__global__ void __launch_bounds__(256) k_ngemm_merge(Params p, int br) {
    EpiMerge E{WSP(bf16_t, WS_GATES), WSP(bf16_t, WS_MERGED), br};
    RowsPlain A{WSP(bf16_t, WS_OATT + (size_t)br * SZ_512), 512};
    RowsPlain Bm{WSP(bf16_t, WS_WA + (size_t)br * MiB), 512};
    ngemm_tile(blockIdx.y * 64, blockIdx.x * 64, 512, A, Bm, E, 1 << 30, 0);
}
__global__ void __launch_bounds__(256) k_ngemm_mix(Params p, int ch) {
    EpiMix E{(bf16_t*)p.out, ch * TC};
    RowsPlain A{WSP(bf16_t, WS_MERGED), 1024}, Bm{WSP(bf16_t, WS_WOUT), 1024};
    ngemm_tile(blockIdx.y * 64, blockIdx.x * 64, 1024, A, Bm, E, 1 << 30, 0);
}
struct RowsGather { const bf16_t* base; const int* list; int cnt, rowbase; __device__ __forceinline__ const bf16_t* operator()(int prow) const { int i = prow - rowbase; if (i >= cnt) i = cnt - 1; return base + (size_t)list[i] * 1024; } };
__device__ __forceinline__ int find_class(const ClassTab* t, int prow) { int c = 0;
    for (int i = 1; i < NCLS; ++i) if (prow >= t->rowbase[i]) c = i;
    return c; }
__global__ void __launch_bounds__(256) k_ngemm_moe1(Params p) {
    __shared__ ClassTab tabs; if (threadIdx.x == 0) class_tab_fill(WSP(unsigned, WS_CTL) + CW_CNT, &tabs); __syncthreads(); const ClassTab* tab = &tabs;
    const int row0 = blockIdx.y * 64; if (row0 >= tab->rowbase[NCLS]) return;
    const int cls = find_class(tab, row0); if (tab->cnt[cls] == 0) return;
    int e_lo, e_hi; class_experts(cls, e_lo, e_hi);
    const int col0 = blockIdx.x * 64, hi = col0 >> 10;
    const int* list = WSP(int, WS_LIST) + (size_t)cls * T;
    RowsGather A{WSP(bf16_t, WS_X1B), list, tab->cnt[cls], tab->rowbase[cls]};
    RowsPlain Bm{WSP(bf16_t, WS_W1) + ((size_t)(hi ? e_hi : e_lo) * 1024 - (size_t)hi * 1024) * 1024, 1024};
    EpiMoe1 E{list, WSP(float, WS_WTS), WSP(bf16_t, WS_H), cls, tab->cnt[cls], tab->rowbase[cls]};
    ngemm_tile(row0, col0, 1024, A, Bm, E, 1 << 30, 0);
}
__global__ void __launch_bounds__(256) k_ngemm_moe2(Params p) {
    __shared__ ClassTab tabs; if (threadIdx.x == 0) class_tab_fill(WSP(unsigned, WS_CTL) + CW_CNT, &tabs); __syncthreads(); const ClassTab* tab = &tabs;
    const int row0 = blockIdx.y * 64; if (row0 >= tab->rowbase[NCLS]) return;
    const int cls = find_class(tab, row0); if (tab->cnt[cls] == 0) return;
    int e_lo, e_hi; class_experts(cls, e_lo, e_hi);
    RowsPlain A{WSP(bf16_t, WS_H), 1024};
    RowsPlain Bm{WSP(bf16_t, WS_W2) + (size_t)e_lo * 512, 8192};
    EpiMoe2 E{WSP(bf16_t, WS_Y2)};
    ngemm_tile(row0, blockIdx.x * 64, 1024, A, Bm, E, 512, (long)(e_hi - e_lo - 1) * 512);
}

__device__ __forceinline__ void nattn_row(const bf16_t* qp, const bf16_t* kbase, const bf16_t* vbase, int nkeys, bf16_t* op, float* lsep, int lane) {
    const unsigned qw = *(const unsigned*)(qp + 2 * lane); const float q0 = bflo(qw), q1 = bfhi(qw);
    float sc[4] = {-INFINITY, -INFINITY, -INFINITY, -INFINITY};
#pragma unroll
    for (int kb = 0; kb < 4; ++kb) {
        for (int kk = 0; kk < 64; ++kk) { const int k = kb * 64 + kk; if (k >= nkeys) break;
            const unsigned kw = *(const unsigned*)(kbase + (size_t)k * 128 + 2 * lane);
            const float s = wave_sum(q0 * bflo(kw) + q1 * bfhi(kw)) * ATT_SCALE;
            if (lane == kk) sc[kb] = s; }
    }
    const float m = wave_max(fmaxf(fmaxf(sc[0], sc[1]), fmaxf(sc[2], sc[3])));
    float pr[4]; float ps = 0.f;
#pragma unroll
    for (int kb = 0; kb < 4; ++kb) { pr[kb] = __expf(sc[kb] - m); ps += pr[kb]; }
    const float l = wave_sum(ps);
    float a0 = 0.f, a1 = 0.f;
#pragma unroll
    for (int kb = 0; kb < 4; ++kb) {
        for (int kk = 0; kk < 64; ++kk) { const int k = kb * 64 + kk; if (k >= nkeys) break;
            const float pk = __shfl(pr[kb], kk);
            const unsigned vw = *(const unsigned*)(vbase + (size_t)k * 128 + 2 * lane);
            a0 += pk * bflo(vw); a1 += pk * bfhi(vw); }
    }
    const float inv = 1.0f / l;
    *(unsigned*)(op + 2 * lane) = pk2(a0 * inv, a1 * inv);
    if (lsep && lane == 0) *lsep = m + __logf(l);
}
__global__ void __launch_bounds__(256) k_nattn_dil(Params p) {
    const int lane = threadIdx.x & 63; const size_t w = (size_t)blockIdx.x * 4 + (threadIdx.x >> 6);
    if (w >= (size_t)BC * 12 * 2048) return;
    const int row = (int)(w & 2047); const int bgh = (int)(w >> 11); const int g = (bgh % 12) >> 2;
    const int seglen = 2048 >> (2 * g); const int pin = row & (seglen - 1); const int nk = pin + 1 < 129 ? pin + 1 : 129;
    bf16_t* Q = WSP(bf16_t, WS_QG) + ((size_t)bgh * 2048 + row) * 128;
    const bf16_t* K = WSP(bf16_t, WS_KG) + ((size_t)bgh * 2048 + row - nk + 1) * 128;
    const bf16_t* V = WSP(bf16_t, WS_VG) + ((size_t)bgh * 2048 + row - nk + 1) * 128;
    nattn_row(Q, K, V, nk, Q, WSP(float, WS_LSE) + (size_t)bgh * 2048 + row, lane);
}
__global__ void __launch_bounds__(256) k_nattn_mem(Params p, int ch) {
    const int lane = threadIdx.x & 63; const size_t w = (size_t)blockIdx.x * 4 + (threadIdx.x >> 6);
    if (w >= (size_t)BC * 4 * 2048) return;
    const int s = (int)(w & 2047); const int bh = (int)(w >> 11); const int bl = bh >> 2, h = bh & 3;
    const bf16_t* Q = WSP(bf16_t, WS_QM) + ((size_t)bh * 2048 + s) * 128;
    const bf16_t* K = WSP(bf16_t, WS_KM) + (size_t)(ch * BC * 4 + bh) * 256 * 128;
    const bf16_t* V = WSP(bf16_t, WS_VM) + (size_t)(ch * BC * 4 + bh) * 256 * 128;
    nattn_row(Q, K, V, 256, WSP(bf16_t, WS_OMT) + ((size_t)(bl * 2048 + s)) * 512 + h * 128, nullptr, lane);
}

__device__ __forceinline__ void combine_token(const Params& p, int rl, int lane) {
    const int bl = rl >> 11, s = rl & 2047, h = lane >> 4, d0 = (lane & 15) * 8;
    float ls[3]; u32x4 o[3];
#pragma unroll
    for (int g = 0; g < 3; ++g) { const size_t r = (size_t)(bl * 12 + g * 4 + h) * 2048 + rowperm(g, s);
        ls[g] = WSP(float, WS_LSE)[r]; o[g] = *(const u32x4*)(WSP(bf16_t, WS_QG) + r * 128 + d0); }
    const float m = fmaxf(ls[0], fmaxf(ls[1], ls[2]));
    float w0 = __expf(ls[0] - m), w1 = __expf(ls[1] - m), w2 = __expf(ls[2] - m); const float inv = 1.0f / (w0 + w1 + w2); w0 *= inv; w1 *= inv; w2 *= inv;
    u32x4 r;
    r.x = pk2(w0 * bflo(o[0].x) + w1 * bflo(o[1].x) + w2 * bflo(o[2].x), w0 * bfhi(o[0].x) + w1 * bfhi(o[1].x) + w2 * bfhi(o[2].x));
    r.y = pk2(w0 * bflo(o[0].y) + w1 * bflo(o[1].y) + w2 * bflo(o[2].y), w0 * bfhi(o[0].y) + w1 * bfhi(o[1].y) + w2 * bfhi(o[2].y));
    r.z = pk2(w0 * bflo(o[0].z) + w1 * bflo(o[1].z) + w2 * bflo(o[2].z), w0 * bfhi(o[0].z) + w1 * bfhi(o[1].z) + w2 * bfhi(o[2].z));
    r.w = pk2(w0 * bflo(o[0].w) + w1 * bflo(o[1].w) + w2 * bflo(o[2].w), w0 * bfhi(o[0].w) + w1 * bfhi(o[1].w) + w2 * bfhi(o[2].w));
    *(u32x4*)(WSP(bf16_t, WS_OATT) + (size_t)rl * 512 + h * 128 + d0) = r;
}
__global__ void __launch_bounds__(256) k_combine(Params p) {
    const int lane = threadIdx.x & 63; const int w = blockIdx.x * 4 + (threadIdx.x >> 6);
    if (w < TC) combine_token(p, w, lane);
}
constexpr int CONV_TILE = 62 * 1024, CONV_OUT = 32 * 1024, CONV_LDS = CONV_TILE + CONV_OUT + (8 * 32 + 64) * 4;
__device__ __forceinline__ void conv_unit(const Params& p, int u, unsigned char* lds, int tid_) {
    const int ch = tid_, lane = ch & 63, wv = ch >> 6;
    const int bl = u >> 6, s0 = (u & 63) * 32;
    bf16_t* tile = (bf16_t*)lds; bf16_t* otile = (bf16_t*)(lds + CONV_TILE); float* red = (float*)(lds + CONV_TILE + CONV_OUT);
    const bf16_t* cg = WSP(bf16_t, WS_CGLU) + (size_t)bl * 2048 * 512;
#pragma unroll
    for (int it = 0; it < 8; ++it) { const int c = it * 512 + ch; if (c < 62 * 64) { const int r = c >> 6, q = c & 63, s = s0 - 30 + r;
        u32x4 v = {0u, 0u, 0u, 0u}; if (s >= 0) v = *(const u32x4*)(cg + (size_t)s * 512 + q * 8);
        *(u32x4*)(tile + r * 512 + q * 8) = v; } }
    __syncthreads();
    float o[32]; const float cb = p.conv_b[ch];
#pragma unroll
    for (int i = 0; i < 32; ++i) o[i] = cb;
    {   float in[62];
#pragma unroll
        for (int i = 0; i < 62; ++i) in[i] = bf2f(tile[i * 512 + ch]);
#pragma unroll
        for (int j = 0; j < 31; ++j) { const float w = p.conv_w[j * 512 + ch];
#pragma unroll
            for (int i = 0; i < 32; ++i) o[i] += w * in[i + j]; } }
    float* mean = red + 256; float* rstd = red + 288;
#pragma unroll
    for (int i = 0; i < 32; ++i) { const float sr = wave_sum(o[i]); if (lane == 0) red[wv * 32 + i] = sr; }
    __syncthreads();
    if (ch < 32) { float sm = 0.f;
#pragma unroll
        for (int w = 0; w < 8; ++w) sm += red[w * 32 + ch];
        mean[ch] = sm * (1.0f / 512.0f); }
    __syncthreads();
#pragma unroll
    for (int i = 0; i < 32; ++i) { o[i] -= mean[i]; const float sr = wave_sum(o[i] * o[i]); if (lane == 0) red[wv * 32 + i] = sr; }
    __syncthreads();
    if (ch < 32) { float sm = 0.f;
#pragma unroll
        for (int w = 0; w < 8; ++w) sm += red[w * 32 + ch];
        rstd[ch] = 1.0f / sqrtf(sm * (1.0f / 512.0f) + LN_EPS); }
    __syncthreads();
    const float gg = p.conv_g[ch], bb = p.conv_bb[ch];
#pragma unroll
    for (int i = 0; i < 32; ++i) { const float y = o[i] * rstd[i] * gg + bb; otile[i * 512 + ch] = (bf16_t)f2bf(y * sigmoidf_(y)); }
    __syncthreads();
    bf16_t* outp = WSP(bf16_t, WS_CCONV) + ((size_t)bl * 2048 + s0) * 512;
#pragma unroll
    for (int it = 0; it < 4; ++it) { const int c = it * 512 + ch; *(u32x4*)(outp + (size_t)c * 8) = *(const u32x4*)(otile + c * 8); }
    __syncthreads();
}
__global__ void __launch_bounds__(512) k_conv(Params p) {
    __shared__ __attribute__((aligned(16))) unsigned char cl[CONV_LDS];
    conv_unit(p, blockIdx.x, cl, threadIdx.x);
}
__device__ __forceinline__ void ln1_unit(const Params& p, int u, const float* wr, int* cls_l, int* misc, int tid_, bool dummy = false) {
    const int tid = tid_, lane = tid & 63, wv = tid >> 6;
    float gam[16], bet[16];
#pragma unroll
    for (int j = 0; j < 4; ++j) { const f32x4 g4 = *(const f32x4*)(p.ln1_g + 4 * lane + 256 * j), b4 = *(const f32x4*)(p.ln1_b + 4 * lane + 256 * j);
        gam[4 * j] = g4.x; gam[4 * j + 1] = g4.y; gam[4 * j + 2] = g4.z; gam[4 * j + 3] = g4.w; bet[4 * j] = b4.x; bet[4 * j + 1] = b4.y; bet[4 * j + 2] = b4.z; bet[4 * j + 3] = b4.w; }
    const int tok0 = u * 64 + wv * 8;
    u32x2 xq[2][4]; u32x2 mq[2][4];
#define LN1_LOAD(slot, rr) do { const bf16_t* xr_ = WSP(bf16_t, WS_XB) + (size_t)(tok0 + (rr)) * 1024 + 4 * lane; const bf16_t* mr_ = (const bf16_t*)p.out + (size_t)(tok0 + (rr)) * 1024 + 4 * lane; \
        _Pragma("unroll") for (int j = 0; j < 4; ++j) { xq[slot][j] = *(const u32x2*)(xr_ + 256 * j); mq[slot][j] = *(const u32x2*)(mr_ + 256 * j); } } while (0)
    LN1_LOAD(0, 0);
#pragma unroll
    for (int rr = 0; rr < 8; ++rr) {
        const int lr = wv * 8 + rr; const int tok = tok0 + rr;
        if (rr + 1 < 8) { if (rr & 1) LN1_LOAD(0, rr + 1); else LN1_LOAD(1, rr + 1); }
        float v[16]; float sm = 0.f;
#pragma unroll
        for (int j = 0; j < 4; ++j) { const u32x2 t = xq[rr & 1][j]; const u32x2 mm = mq[rr & 1][j];
            v[4 * j] = DN_ALPHA * bflo(t.x) + bflo(mm.x); v[4 * j + 1] = DN_ALPHA * bfhi(t.x) + bfhi(mm.x); v[4 * j + 2] = DN_ALPHA * bflo(t.y) + bflo(mm.y); v[4 * j + 3] = DN_ALPHA * bfhi(t.y) + bfhi(mm.y);
            sm += (v[4 * j] + v[4 * j + 1]) + (v[4 * j + 2] + v[4 * j + 3]); }
        const float mean = wave_sum(sm) * (1.0f / 1024.0f); float sq = 0.f;
#pragma unroll
        for (int i = 0; i < 16; ++i) { v[i] -= mean; sq += v[i] * v[i]; }
        const float rstd = 1.0f / sqrtf(wave_sum(sq) * (1.0f / 1024.0f) + LN_EPS);
#pragma unroll
        for (int i = 0; i < 16; ++i) v[i] = v[i] * rstd * gam[i] + bet[i];
        bf16_t* xb = WSP(bf16_t, dummy ? WS_H : WS_X1B) + (size_t)tok * 1024;
#pragma unroll
        for (int j = 0; j < 4; ++j) { u32x2 o; o.x = pk2(v[4 * j], v[4 * j + 1]); o.y = pk2(v[4 * j + 2], v[4 * j + 3]); *(u32x2*)(xb + 4 * lane + 256 * j) = o; }
        if (!dummy) { unsigned char* x8 = p.ws + WS_X1B8 + (size_t)tok * 1024;
#pragma unroll
            for (int j = 0; j < 4; ++j) *(unsigned*)(x8 + 4 * lane + 256 * j) = pk4_fp8(v[4 * j], v[4 * j + 1], v[4 * j + 2], v[4 * j + 3]); }
        float gl[4];
#pragma unroll
        for (int e = 0; e < 4; ++e) { float a = 0.f;
#pragma unroll
            for (int j = 0; j < 4; ++j) { const f32x4 w4 = *(const f32x4*)(wr + e * 1024 + 4 * lane + 256 * j); a += v[4 * j] * w4.x + v[4 * j + 1] * w4.y + v[4 * j + 2] * w4.z + v[4 * j + 3] * w4.w; }
            gl[e] = wave_sum(a) + p.b_gr[e]; }
        int gs = 0; float gm = gl[0];
#pragma unroll
        for (int e = 1; e < 4; ++e) if (gl[e] > gm) { gm = gl[e]; gs = e; }
        float gsum = 0.f;
#pragma unroll
        for (int e = 0; e < 4; ++e) gsum += __expf(gl[e] - gm);
        const float gprob = 1.0f / gsum;
        gs = __builtin_amdgcn_readfirstlane(gs);
        float el[4];
#pragma unroll
        for (int e = 0; e < 4; ++e) { float a = 0.f; const float* wp = wr + (4 + gs * 4 + e) * 1024;
#pragma unroll
            for (int j = 0; j < 4; ++j) { const f32x4 w4 = *(const f32x4*)(wp + 4 * lane + 256 * j); a += v[4 * j] * w4.x + v[4 * j + 1] * w4.y + v[4 * j + 2] * w4.z + v[4 * j + 3] * w4.w; }
            el[e] = wave_sum(a) + p.b_er[gs * 4 + e]; }
        int i1 = 0; float v1 = el[0];
#pragma unroll
        for (int e = 1; e < 4; ++e) if (el[e] > v1) { v1 = el[e]; i1 = e; }
        int i2 = -1; float v2 = -INFINITY;
#pragma unroll
        for (int e = 0; e < 4; ++e) if (e != i1 && el[e] > v2) { v2 = el[e]; i2 = e; }
        const float t2 = __expf(v2 - v1); const float w1 = gprob / (1.0f + t2), w2 = gprob * t2 / (1.0f + t2);
        const int lo = i1 < i2 ? i1 : i2, hi = i1 < i2 ? i2 : i1;
        const int pi = lo == 0 ? hi - 1 : (lo == 1 ? hi + 1 : 5);
        if (lane == 0 && !dummy) { cls_l[lr] = gs * 6 + pi; float* wt = WSP(float, WS_WTS) + (size_t)tok * 2; wt[0] = (i1 == lo) ? w1 : w2; wt[1] = (i1 == lo) ? w2 : w1; }
    }
#undef LN1_LOAD
    __syncthreads();
    if (dummy) return;
    if (tid < NCLS) { int n = 0; for (int r = 0; r < 64; ++r) n += (cls_l[r] == tid); misc[tid] = n ? (int)atomicAdd(WSP(unsigned, WS_CTL) + CW_CNT + tid, (unsigned)n) : 0; }
    __syncthreads();
    if (tid < 64) { const int c = cls_l[tid]; int rank = 0; for (int r = 0; r < tid; ++r) rank += (cls_l[r] == c);
        WSP(int, WS_LIST)[(size_t)c * T + misc[c] + rank] = u * 64 + tid; }
    __syncthreads();
}
__global__ void __launch_bounds__(512) k_ln1(Params p) {
    extern __shared__ float dyn[];
    float* wr = dyn; int* cls_l = (int*)(dyn + 20 * 1024); int* misc = cls_l + 64;
    for (int i = threadIdx.x; i < 20 * 1024; i += 512) wr[i] = WSP(float, WS_WRT)[i];
    __syncthreads();
    for (int u = blockIdx.x; u < T / 64; u += gridDim.x) ln1_unit(p, u, wr, cls_l, misc, threadIdx.x);
}
template <int NR>
__device__ __forceinline__ void ln2_rows(const Params& p, const int (&tok)[NR], const int (&prow)[NR], int lane, float* dummy = nullptr) {
    u32x2 xa[NR][4], ya[NR][4];
#pragma unroll
    for (int r = 0; r < NR; ++r) if (tok[r] >= 0) { const bf16_t* xrow = WSP(bf16_t, WS_X1B) + (size_t)tok[r] * 1024 + 4 * lane; const bf16_t* yrow = WSP(bf16_t, WS_Y2) + (size_t)prow[r] * 1024 + 4 * lane;
#pragma unroll
        for (int j = 0; j < 4; ++j) { xa[r][j] = *(const u32x2*)(xrow + 256 * j); ya[r][j] = *(const u32x2*)(yrow + 256 * j); } }
    f32x4 g4[4], b4[4];
#pragma unroll
    for (int j = 0; j < 4; ++j) { g4[j] = *(const f32x4*)(p.ln2_g + 4 * lane + 256 * j); b4[j] = *(const f32x4*)(p.ln2_b + 4 * lane + 256 * j); }
#pragma unroll
    for (int r = 0; r < NR; ++r) if (tok[r] >= 0) {
        float v[16]; float sm = 0.f;
#pragma unroll
        for (int j = 0; j < 4; ++j) { const u32x2 t = xa[r][j], y = ya[r][j];
            v[4 * j] = DN_ALPHA * bflo(t.x) + bflo(y.x); v[4 * j + 1] = DN_ALPHA * bfhi(t.x) + bfhi(y.x); v[4 * j + 2] = DN_ALPHA * bflo(t.y) + bflo(y.y); v[4 * j + 3] = DN_ALPHA * bfhi(t.y) + bfhi(y.y);
            sm += (v[4 * j] + v[4 * j + 1]) + (v[4 * j + 2] + v[4 * j + 3]); }
        const float mean = wave_sum(sm) * (1.0f / 1024.0f); float sq = 0.f;
#pragma unroll
        for (int i2 = 0; i2 < 16; ++i2) { v[i2] -= mean; sq += v[i2] * v[i2]; }
        const float rstd = 1.0f / sqrtf(wave_sum(sq) * (1.0f / 1024.0f) + LN_EPS);
        float* orow = (dummy ? dummy : p.out) + (size_t)tok[r] * 1024 + 4 * lane;
#pragma unroll
        for (int j = 0; j < 4; ++j) *(f32x4*)(orow + 256 * j) = (f32x4){v[4 * j] * rstd * g4[j].x + b4[j].x, v[4 * j + 1] * rstd * g4[j].y + b4[j].y, v[4 * j + 2] * rstd * g4[j].z + b4[j].z, v[4 * j + 3] * rstd * g4[j].w + b4[j].w};
    }
}
__global__ void __launch_bounds__(256) k_ln2(Params p) {
    __shared__ ClassTab tabs; if (threadIdx.x == 0) class_tab_fill(WSP(unsigned, WS_CTL) + CW_CNT, &tabs); __syncthreads(); const ClassTab* tab = &tabs;
    const int lane = threadIdx.x & 63; const int prow = blockIdx.x * 4 + (threadIdx.x >> 6);
    if (prow >= tab->rowbase[NCLS]) return;
    const int cls = find_class(tab, prow); const int i = prow - tab->rowbase[cls]; if (i >= tab->cnt[cls]) return;
    const int tk[1] = {WSP(int, WS_LIST)[(size_t)cls * T + i]}, pr[1] = {prow};
    ln2_rows<1>(p, tk, pr, lane);
}


#define LAS __attribute__((address_space(3)))
#define GAS __attribute__((address_space(1)))
constexpr int RING_OFF = 0, RING_BYTES = 131072;
constexpr int LCTL_OFF = RING_BYTES;
constexpr int LTOK_OFF = LCTL_OFF + 4096, MAXU = 16;
constexpr int LDS_BYTES = LTOK_OFF + MAXU * 1024;
constexpr int NTHR = 512, NWAVES = 8;

namespace pg8 {
typedef short bf16x8 __attribute__((ext_vector_type(8)));
typedef int v4i_t __attribute__((ext_vector_type(4)));
typedef int v8i_t __attribute__((ext_vector_type(8)));
constexpr int BM = 256, BK = 64, HALF = 128, HTB = HALF * BK * 2, NXCD = 8, WGM = 8;
__host__ __device__ __forceinline__ int lds_byte(int r, int c) { const int st = (r >> 4) * 2 + (c >> 5), rr = r & 15, cc = c & 31, ob = rr * 64 + cc * 2; return st * 1024 + (ob ^ (((ob >> 9) & 1) << 5)); }
__host__ __device__ __forceinline__ void stage_rc(int b, int& R, int& C) { const int st = b / 1024, sb = b % 1024, swz = sb ^ (((sb >> 9) & 1) << 5); R = (st >> 1) * 16 + swz / 64; C = (st & 1) * 32 + (swz % 64) / 2; }
__host__ __device__ __forceinline__ int perm32(int rho) { const int n = rho >> 4, i = rho & 15; return 8 * (i >> 2) + 4 * n + (i & 3); }

struct Unit { const char* A; const char* B; int row0, col0, bjump, aux; };
struct TileOrder {
    int nM, nN, nwg, G, c;
    __device__ __forceinline__ void init(int nM_, int nN_, int G_, int c_) { nM = nM_; nN = nN_; nwg = nM * nN; G = G_; c = c_; }
    __device__ __forceinline__ bool tile(int i, int& pm, int& pn) const {
        const long L = (long)i * G + c; if (L >= nwg) return false;
        int wgid = (int)L; { const int q = nwg / NXCD, r = nwg % NXCD, xcd = wgid % NXCD, off = wgid / NXCD; wgid = (xcd < r ? xcd * (q + 1) : r * (q + 1) + (xcd - r) * q) + off; }
        const int nig = WGM * nN, gid = wgid / nig, fm = gid * WGM, gsz = (nM - fm) < WGM ? (nM - fm) : WGM;
        pm = fm + ((wgid % nig) % gsz); pn = (wgid % nig) / gsz; return true;
    }
};
__device__ __forceinline__ unsigned cvt_pk_bf16(float lo, float hi) { unsigned r; asm volatile("v_cvt_pk_bf16_f32 %0, %1, %2" : "=v"(r) : "v"(lo), "v"(hi)); return r; }

template <class EF> struct EpiRows {
    static constexpr bool PERM = true;
    EF ef;
    __device__ __forceinline__ bool keep_acc(const Unit&) const { return false; }
    __device__ __forceinline__ void operator()(f32x4 (&acc)[2][2][4][2], const Unit& u, int wr, int wc, int fr, int fq) const {
#pragma unroll
        for (int ai = 0; ai < 2; ++ai)
#pragma unroll
            for (int m = 0; m < 4; ++m) { const int row = u.row0 + ai * HALF + wr * 64 + m * 16 + fr;
#pragma unroll
                for (int bj = 0; bj < 2; ++bj) { const int c0 = u.col0 + bj * HALF + wc * 32 + 8 * fq;
                    float v[8] = {acc[ai][bj][m][0][0], acc[ai][bj][m][0][1], acc[ai][bj][m][0][2], acc[ai][bj][m][0][3], acc[ai][bj][m][1][0], acc[ai][bj][m][1][1], acc[ai][bj][m][1][2], acc[ai][bj][m][1][3]};
                    ef(u, row, c0, v); }
                asm volatile("" ::: "memory"); }
    }
};

template <class Epi, class Sched, bool ALIGN_EPI, bool GATHER, bool BJUMP, bool FP8 = false>
__device__ __forceinline__ void gemm_phase(LAS unsigned char* lds, const char* Abase, int lda, int ldb, int K, const Sched& S, const Epi& E, int wave_s) {
    const int tid = opaque_tid(wave_s), wid = __builtin_amdgcn_readfirstlane(tid >> 6), lane = tid & 63, wr = wid >> 2, wc = wid & 3, fr = lane & 15, fq = lane >> 4;
    const int nt = K / BK;
    unsigned voffA[2], voffB[2]; unsigned voffG[2][2], nvoffG[2][2];
#pragma unroll
    for (int i = 0; i < 2; ++i) { int R, C; stage_rc(tid * 16 + i * 8192, R, C); const int Rb = Epi::PERM ? ((R & ~31) + perm32(R & 31)) : R;
        voffA[i] = (unsigned)(R * lda + C) * 2u; voffB[i] = (unsigned)(Rb * ldb + C) * 2u; voffG[0][i] = voffG[1][i] = nvoffG[0][i] = nvoffG[1][i] = 0u; }
    const size_t kstep = (size_t)(BK * 2);
    const size_t hstepA = (size_t)HALF * lda * 2, hstepB = (size_t)HALF * ldb * 2;
    const unsigned ldsw = (unsigned)wid * 1024u;
    const int aoff = lds_byte(wr * 64 + fr, fq * 8), boff = lds_byte(wc * 32 + fr, fq * 8);
#define PG8_SA(b, h) (((b) * 2 + (h)) * HTB)
#define PG8_SB(b, h) ((4 + (b) * 2 + (h)) * HTB)
#define PG8_GLDS(gptr, ldsoff) __builtin_amdgcn_global_load_lds((const unsigned*)(gptr), (LAS unsigned*)(lds + (ldsoff)), 16, 0, 0)
#define PG8_STAGE_B(bufoff, gbase) do { _Pragma("unroll") for (int _i = 0; _i < 2; ++_i) PG8_GLDS((const char*)(gbase) + voffB[_i], (bufoff) + ldsw + _i * 8192); } while (0)
#define PG8_STAGE_A(bufoff, kptr, h, nx) do { if constexpr (GATHER) { _Pragma("unroll") for (int _i = 0; _i < 2; ++_i) PG8_GLDS((const char*)(kptr) + ((nx) ? nvoffG[h][_i] : voffG[h][_i]), (bufoff) + ldsw + _i * 8192); } \
        else { _Pragma("unroll") for (int _i = 0; _i < 2; ++_i) PG8_GLDS((const char*)(kptr) + (h) * hstepA + voffA[_i], (bufoff) + ldsw + _i * 8192); } } while (0)
#define PG8_GATHER_OFFS(dst, ord) do { LAS const int* _tk = S.toks(ord); _Pragma("unroll") for (int _h = 0; _h < 2; ++_h) _Pragma("unroll") for (int _i = 0; _i < 2; ++_i) { int _R, _C; stage_rc(tid * 16 + _i * 8192, _R, _C); \
        dst[_h][_i] = (unsigned)_tk[_h * HALF + _R] * (unsigned)(lda * 2) + (unsigned)(_C * 2); } } while (0)
#define PG8_LDA(dst, b, h) do { _Pragma("unroll") for (int m = 0; m < 4; ++m) _Pragma("unroll") for (int k = 0; k < 2; ++k) dst[m][k] = *(const LAS bf16x8*)(lds + PG8_SA(b, h) + aoff + m * 2048 + k * 1024); } while (0)
#define PG8_LDB(dst, b, h) do { _Pragma("unroll") for (int n = 0; n < 2; ++n) _Pragma("unroll") for (int k = 0; k < 2; ++k) dst[n][k] = *(const LAS bf16x8*)(lds + PG8_SB(b, h) + boff + n * 2048 + k * 1024); } while (0)
#define PG8_CAT8(lo, hi) __builtin_shufflevector(__builtin_bit_cast(v4i_t, lo), __builtin_bit_cast(v4i_t, hi), 0, 1, 2, 3, 4, 5, 6, 7)
#define PG8_MMA(ai, bj, At, Bt) do { __builtin_amdgcn_s_setprio(1); if constexpr (FP8) { _Pragma("unroll") for (int m = 0; m < 4; ++m) _Pragma("unroll") for (int n = 0; n < 2; ++n) \
        { const v8i_t b8_ = PG8_CAT8(Bt[n][0], Bt[n][1]), a8_ = PG8_CAT8(At[m][0], At[m][1]); asm volatile("v_mfma_f32_16x16x128_f8f6f4 %0, %1, %2, %0" : "+v"(acc[ai][bj][m][n]) : "v"(b8_), "v"(a8_)); } } \
        else { _Pragma("unroll") for (int m = 0; m < 4; ++m) _Pragma("unroll") for (int n = 0; n < 2; ++n) _Pragma("unroll") for (int k = 0; k < 2; ++k) \
        acc[ai][bj][m][n] = __builtin_amdgcn_mfma_f32_16x16x32_bf16(Bt[n][k], At[m][k], acc[ai][bj][m][n], 0, 0, 0); } __builtin_amdgcn_s_setprio(0); } while (0)
#define PG8_WAIT_V(n) asm volatile("s_waitcnt vmcnt(" #n ")" ::: "memory")
#define PG8_WAIT_L(n) asm volatile("s_waitcnt lgkmcnt(" #n ")" ::: "memory")
#define PG8_BAR __builtin_amdgcn_s_barrier()
#define PG8_SCHED __builtin_amdgcn_sched_barrier(0)
    Unit cur, nxt; int ui = 0;
    if (!S.next(0, cur)) return;
    f32x4 acc[2][2][4][2];
#pragma unroll
    for (int a = 0; a < 2; ++a)
#pragma unroll
        for (int b = 0; b < 2; ++b)
#pragma unroll
            for (int m = 0; m < 4; ++m)
#pragma unroll
                for (int n = 0; n < 2; ++n) acc[a][b][m][n] = (f32x4){0.f, 0.f, 0.f, 0.f};
    bf16x8 At[4][2], B0[2][2], B1[2][2];
    const char* cA = GATHER ? Abase : cur.A; const char* cB = cur.B;
    if constexpr (GATHER) PG8_GATHER_OFFS(voffG, 0);
    PG8_STAGE_B(PG8_SB(0, 0), cB); PG8_STAGE_B(PG8_SB(0, 1), cB + hstepB); PG8_STAGE_A(PG8_SA(0, 0), cA, 0, false); PG8_STAGE_A(PG8_SA(0, 1), cA, 1, false);
    if (wr == 1) PG8_BAR;
    PG8_WAIT_V(2); PG8_BAR;
    PG8_STAGE_B(PG8_SB(1, 0), cB + kstep); PG8_STAGE_A(PG8_SA(1, 0), cA + kstep, 0, false); PG8_STAGE_B(PG8_SB(1, 1), cB + hstepB + kstep);
    PG8_WAIT_V(6); PG8_BAR;
    for (;;) {
        const bool has_next = S.next(ui + 1, nxt);
        if constexpr (GATHER) { if (has_next) PG8_GATHER_OFFS(nvoffG, ui + 1); else {
#pragma unroll
            for (int h = 0; h < 2; ++h)
#pragma unroll
                for (int i = 0; i < 2; ++i) nvoffG[h][i] = voffG[h][i]; } }
        const char* nA = GATHER ? Abase : (has_next ? nxt.A : cA); const char* nB = has_next ? nxt.B : cB;
#pragma nounroll
        for (int t = 0; t < nt; t += 2) {
            const bool last = (t == nt - 2);
            const char* a1 = cA + (size_t)(t + 1) * kstep;
            const char* a2 = last ? nA : cA + (size_t)(t + 2) * kstep;
            const char* b2 = last ? nB : cB + (size_t)(t + 2) * kstep + ((BJUMP && (t + 2) >= (nt >> 1)) ? cur.bjump : 0);
            const char* a3 = a2 + kstep; const char* b3 = b2 + kstep;
            PG8_LDB(B0, 0, 0); PG8_LDB(B1, 0, 1); PG8_SCHED; PG8_LDA(At, 0, 0); PG8_STAGE_A(PG8_SA(1, 1), a1, 1, false);
            PG8_WAIT_V(8); PG8_WAIT_L(0); PG8_BAR; PG8_MMA(0, 0, At, B0); PG8_MMA(0, 1, At, B1); PG8_BAR; PG8_SCHED;
            PG8_LDA(At, 0, 1); PG8_STAGE_B(PG8_SB(0, 0), b2); PG8_STAGE_B(PG8_SB(0, 1), b2 + hstepB); PG8_STAGE_A(PG8_SA(0, 0), a2, 0, last);
            PG8_WAIT_V(8); PG8_WAIT_L(0); PG8_BAR; PG8_MMA(1, 0, At, B0); PG8_MMA(1, 1, At, B1); PG8_BAR; PG8_SCHED;
            PG8_LDB(B0, 1, 0); PG8_LDB(B1, 1, 1); PG8_SCHED; PG8_LDA(At, 1, 0); PG8_STAGE_A(PG8_SA(0, 1), a2, 1, last);
            PG8_WAIT_V(8); PG8_WAIT_L(0); PG8_BAR; PG8_MMA(0, 0, At, B0); PG8_MMA(0, 1, At, B1); PG8_BAR; PG8_SCHED;
            PG8_LDA(At, 1, 1); PG8_STAGE_B(PG8_SB(1, 0), b3); PG8_STAGE_B(PG8_SB(1, 1), b3 + hstepB); PG8_STAGE_A(PG8_SA(1, 0), a3, 0, last);
            PG8_WAIT_V(8); PG8_WAIT_L(0); PG8_BAR; PG8_MMA(1, 0, At, B0); PG8_MMA(1, 1, At, B1); PG8_BAR; PG8_SCHED;
        }
        if constexpr (ALIGN_EPI) { if (wr == 0) PG8_BAR; }
        if constexpr (FP8) { asm volatile("s_nop 15\n\ts_nop 15" ::: "memory"); PG8_SCHED; }
        E(acc, cur, wr, wc, fr, fq);
        if (!has_next) break;
        if (!E.keep_acc(cur)) {
#pragma unroll
        for (int a = 0; a < 2; ++a)
#pragma unroll
            for (int b = 0; b < 2; ++b)
#pragma unroll
                for (int m = 0; m < 4; ++m)
#pragma unroll
                    for (int n = 0; n < 2; ++n) acc[a][b][m][n] = (f32x4){0.f, 0.f, 0.f, 0.f}; }
        cur = nxt; cA = nA; cB = nB; ++ui;
        if constexpr (GATHER) {
#pragma unroll
            for (int h = 0; h < 2; ++h)
#pragma unroll
                for (int i = 0; i < 2; ++i) voffG[h][i] = nvoffG[h][i]; }
        if constexpr (ALIGN_EPI) { if (wr == 1) PG8_BAR; }
    }
    PG8_WAIT_V(0);
    if constexpr (!ALIGN_EPI) { if (wr == 0) PG8_BAR; }
    PG8_BAR;
#undef PG8_SA
#undef PG8_SB
#undef PG8_GLDS
#undef PG8_STAGE_A
#undef PG8_STAGE_B
#undef PG8_GATHER_OFFS
#undef PG8_LDA
#undef PG8_LDB
#undef PG8_MMA
#undef PG8_CAT8
#undef PG8_WAIT_V
#undef PG8_WAIT_L
#undef PG8_BAR
#undef PG8_SCHED
}
}

namespace swa {
typedef short bf16x8 __attribute__((ext_vector_type(8)));
typedef short s16x4 __attribute__((ext_vector_type(4)));
typedef float f32x16 __attribute__((ext_vector_type(16)));
constexpr int DH = 128, NW = 8, QBLK = 32, KVBLK = 64, QB = NW * QBLK;
constexpr int SHM_V = KVBLK * DH * 2, SHM_K = KVBLK * DH * 2;
constexpr int LDS_NEED = 2 * SHM_V + 2 * SHM_K + NW * 64 * 4;
constexpr float SCALE = 0.08838834764831845f, THR = 8.f;
#define KSWZ(row, colB) ((row) * 256 + ((colB) ^ (((row) & 7) << 4)))
#define SBAR() __builtin_amdgcn_sched_barrier(0)
__device__ __forceinline__ int v_st(int k, int c) { const int kk = (k & ~0xC) | ((k & 4) << 1) | ((k & 8) >> 1); return ((kk >> 3) * 4 + (c >> 5)) * 512 + ((kk & 7) * 32 + (c & 31)) * 2; }
__device__ __forceinline__ int v_rd_base(int lane) { return ((lane & 3) << 3) | (((lane >> 2) & 3) << 6) | (((lane >> 4) & 1) << 5) | (((lane >> 5) & 1) << 8); }
constexpr int v_rd_off(int d0, int ks, int half) { return d0 * 512 + ks * 4096 + half * 2048; }
__device__ __forceinline__ int crow(int r, int hi) { return (r & 3) + 8 * (r >> 2) + 4 * hi; }
__device__ __forceinline__ unsigned cvtpk(float lo, float hi) { unsigned r; asm volatile("v_cvt_pk_bf16_f32 %0, %1, %2" : "=v"(r) : "v"(lo), "v"(hi)); return r; }
__device__ __forceinline__ bf16x8 load8(const bf16_t* p) { return *reinterpret_cast<const bf16x8*>(p); }
__device__ __forceinline__ void mask_tile(f32x16& p0, f32x16& p1, int dq, unsigned W) {
    const float NEG = -__builtin_inff();
#pragma unroll
    for (int r = 0; r < 16; ++r) {
        const int c = (r & 3) + 8 * (r >> 2);
        if ((unsigned)(dq - c) >= W) p0[r] = NEG;
        if ((unsigned)(dq - c - 32) >= W) p1[r] = NEG;
    }
}
__device__ __forceinline__ void partialSM(f32x16& p0, f32x16& p1, float& m_reg, float& mn, float& alpha) {
    float pmax = p0[0]; for (int r = 1; r < 16; ++r) pmax = fmaxf(pmax, p0[r]); for (int r = 0; r < 16; ++r) pmax = fmaxf(pmax, p1[r]);
    { auto rr = __builtin_amdgcn_permlane32_swap(__float_as_uint(pmax), __float_as_uint(pmax), false, false);
      pmax = fmaxf(__uint_as_float(rr[0]), __uint_as_float(rr[1])); }
    constexpr float C2 = 1.4426950408889634f * SCALE;
    if (__builtin_expect(__all((pmax - m_reg) * SCALE <= THR), 1)) { mn = m_reg; alpha = 1.f; }
    else { mn = fmaxf(m_reg, pmax); alpha = __builtin_amdgcn_exp2f((m_reg - mn) * C2); m_reg = mn; }
    const float mnL = -mn * C2;
    for (int r = 0; r < 16; ++r) p0[r] = fmaf(p0[r], C2, mnL); for (int r = 0; r < 16; ++r) p1[r] = fmaf(p1[r], C2, mnL);
    for (int r = 0; r < 16; ++r) p0[r] = __builtin_amdgcn_exp2f(p0[r]);
}
__device__ __forceinline__ void finishSM(f32x16& p0, f32x16& p1, float alpha, float& l_reg, bf16x8& pa0, bf16x8& pa1, bf16x8& pa2, bf16x8& pa3) {
    for (int r = 0; r < 16; ++r) p1[r] = __builtin_amdgcn_exp2f(p1[r]);
    float ps = 0; for (int r = 0; r < 16; ++r) ps += p0[r]; for (int r = 0; r < 16; ++r) ps += p1[r];
    { auto rr = __builtin_amdgcn_permlane32_swap(__float_as_uint(ps), __float_as_uint(ps), false, false);
      ps = __uint_as_float(rr[0]) + __uint_as_float(rr[1]); }
    l_reg = l_reg * alpha + ps;
#define PK4(P, B_, OUT) do { unsigned a0 = cvtpk(P[B_+0], P[B_+1]), a1 = cvtpk(P[B_+2], P[B_+3]);                          \
        unsigned b0 = cvtpk(P[B_+4], P[B_+5]), b1 = cvtpk(P[B_+6], P[B_+7]);                                             \
        auto r0 = __builtin_amdgcn_permlane32_swap(a0, b0, false, false); auto r1 = __builtin_amdgcn_permlane32_swap(a1, b1, false, false); \
        u32x4 w = {r0[0], r1[0], r0[1], r1[1]}; OUT = *reinterpret_cast<bf16x8*>(&w); } while (0)
    PK4(p0, 0, pa0); PK4(p0, 8, pa1); PK4(p1, 0, pa2); PK4(p1, 8, pa3);
#undef PK4
}
template <int KB>
__device__ __forceinline__ void qkt(f32x16& p0, f32x16& p1, const char* K_lds, int r32, int hi, const bf16x8* qr, bool act) {
    if (!act) { const float NEG = -__builtin_inff();
#pragma unroll
        for (int r = 0; r < 16; ++r) { p0[r] = NEG; p1[r] = NEG; } return; }
    p0 = f32x16{}; p1 = f32x16{};
    const char* kb[4];
#pragma unroll
    for (int dd = 0; dd < 4; ++dd) kb[dd] = K_lds + KB * SHM_K + KSWZ(r32, (dd * 16 + hi * 8) * 2);
#pragma unroll
    for (int d0 = 0; d0 < 8; ++d0) { const char* a = kb[d0 & 3] + (d0 >> 2) * 128;
        bf16x8 b0 = *reinterpret_cast<const bf16x8*>(a);
        bf16x8 b1 = *reinterpret_cast<const bf16x8*>(a + 32 * 256);
        p0 = __builtin_amdgcn_mfma_f32_32x32x16_bf16(b0, qr[d0], p0, 0, 0, 0);
        p1 = __builtin_amdgcn_mfma_f32_32x32x16_bf16(b1, qr[d0], p1, 0, 0, 0); }
}
template <int VB>
__device__ __forceinline__ void pv_tile(f32x16* o, int vb0, bf16x8 pa0, bf16x8 pa1, bf16x8 pa2, bf16x8 pa3, bool act) {
    if (!act) return;
#define TRRD(dst, off) asm volatile("ds_read_b64_tr_b16 %0, %1 offset:%2" : "=&v"(dst) : "v"(vb0), "i"(off) : "memory")
#define PV_D0(d0) do { s16x4 l0, l1, l2, l3, h0, h1, h2, h3; constexpr int b_ = VB * SHM_V + v_rd_off(d0, 0, 0); \
        TRRD(l0, b_); TRRD(h0, b_ + 2048); TRRD(l1, b_ + 4096); TRRD(h1, b_ + 6144); TRRD(l2, b_ + 8192); TRRD(h2, b_ + 10240); TRRD(l3, b_ + 12288); TRRD(h3, b_ + 14336); \
        asm volatile("s_waitcnt lgkmcnt(0)" ::: "memory"); SBAR();   \
        o[d0] = __builtin_amdgcn_mfma_f32_32x32x16_bf16(pa0, (bf16x8){l0[0], l0[1], l0[2], l0[3], h0[0], h0[1], h0[2], h0[3]}, o[d0], 0, 0, 0);   \
        o[d0] = __builtin_amdgcn_mfma_f32_32x32x16_bf16(pa1, (bf16x8){l1[0], l1[1], l1[2], l1[3], h1[0], h1[1], h1[2], h1[3]}, o[d0], 0, 0, 0);   \
        o[d0] = __builtin_amdgcn_mfma_f32_32x32x16_bf16(pa2, (bf16x8){l2[0], l2[1], l2[2], l2[3], h2[0], h2[1], h2[2], h2[3]}, o[d0], 0, 0, 0);   \
        o[d0] = __builtin_amdgcn_mfma_f32_32x32x16_bf16(pa3, (bf16x8){l3[0], l3[1], l3[2], l3[3], h3[0], h3[1], h3[2], h3[3]}, o[d0], 0, 0, 0); } while (0)
    PV_D0(0); PV_D0(1); PV_D0(2); PV_D0(3);
#undef PV_D0
#undef TRRD
}
struct BlockRef { const bf16_t* Q; const bf16_t* K; const bf16_t* V; bf16_t* O; float* LSE; int P0, W, segmask, skv, ostride; };
struct Seam { bf16x8 qr[8]; bf16x8 st_v0, st_v1, st_k0, st_k1; };
__device__ __forceinline__ int imax(int a, int b) { return a > b ? a : b; }
__device__ __forceinline__ int blk_jlo(const BlockRef& b) { const int lowk = imax(b.P0 - b.W + 1, b.P0 & ~b.segmask); return lowk > 0 ? lowk / KVBLK : 0; }
#define ROW(p, k0, rr) ((p) + (size_t)((k0) + (rr)) * DH + sc)
#define VMW() asm volatile("s_waitcnt vmcnt(0)" ::: "memory")
#define VMWN(n) asm volatile("s_waitcnt vmcnt(%0)" :: "i"(n) : "memory")
#define SLOAD_H(Kp, Vp, k0) do { S.st_v0 = load8(ROW(Vp, k0, sr)); S.st_v1 = load8(ROW(Vp, k0, 32 + sr));              \
                         S.st_k0 = load8(ROW(Kp, k0, sr)); S.st_k1 = load8(ROW(Kp, k0, 32 + sr)); } while (0)
#define SWRITE_HK(bf) do { *(bf16x8*)(K_lds + (bf) * SHM_K + kws) = S.st_k0; *(bf16x8*)(K_lds + (bf) * SHM_K + kws + 32 * 256) = S.st_k1; } while (0)
#define SWRITE_HV(bf) do { *(bf16x8*)(V_lds + (bf) * SHM_V + vst0) = S.st_v0; *(bf16x8*)(V_lds + (bf) * SHM_V + vst1) = S.st_v1; } while (0)
#define SWRITE_H(bf) do { SWRITE_HV(bf); SWRITE_HK(bf); } while (0)
__device__ __forceinline__ void prime(const BlockRef& cur, char* lds, Seam& S, int wave_s) {
    const int tid = opaque_tid(wave_s), wid = __builtin_amdgcn_readfirstlane(tid >> 6), lane = tid & 63, r32 = lane & 31, hi = lane >> 5;
    const int sr = tid >> 4, sc = (tid & 15) * 8, kws = KSWZ(sr, sc * 2); char* K_lds = lds + 2 * SHM_V;
    const int kb0 = blk_jlo(cur) * KVBLK;
    for (int d0 = 0; d0 < 8; ++d0) S.qr[d0] = load8(cur.Q + (size_t)(wid * QBLK + r32) * DH + d0 * 16 + hi * 8);
    SLOAD_H(cur.K, cur.V, kb0); VMW(); SWRITE_HK(0);
    __syncthreads();
}
__device__ __forceinline__ void block(const BlockRef& cur, const BlockRef& nxt, char* lds, Seam& S, int wave_s) {
    const int tid = opaque_tid(wave_s), wid = __builtin_amdgcn_readfirstlane(tid >> 6), lane = tid & 63, r32 = lane & 31, hi = lane >> 5;
    const int W = cur.W;
    const int j_lo = blk_jlo(cur);
    int j_hi = (cur.P0 + QB - 1) / KVBLK + 1; if (j_hi > cur.skv / KVBLK) j_hi = cur.skv / KVBLK;
    const int NT = j_hi - j_lo;
    const int kbn = blk_jlo(nxt) * KVBLK;
    const int qlo = cur.P0 + wid * QBLK, qm = qlo + r32 - 4 * hi;
    const int segb = qlo & ~cur.segmask;
    const int lowk_w = imax(qlo - W + 1, segb);
    const int lowk_last = imax(qlo + QBLK - W, segb);
    const int wrow = ((qlo + r32) & cur.segmask) + 1;
    const unsigned Wl = (unsigned)(wrow < W ? wrow : W);
    char* V_lds = lds; char* K_lds = lds + 2 * SHM_V;
    float* ws = (float*)(lds + 2 * SHM_V + 2 * SHM_K) + wid * 64; float* li_l = ws, * al_l = ws + 32;
    float m_reg = -1e30f, l_reg = 0; f32x16 o[4] = {};
    const int sr = tid >> 4, sc = (tid & 15) * 8, vst0 = v_st(sr, sc), vst1 = v_st(32 + sr, sc), kws = KSWZ(sr, sc * 2);
    const int vb0 = (int)(uintptr_t)V_lds + v_rd_base(lane);
    const bf16_t* Kh = cur.K; const bf16_t* Vh = cur.V;
#define RESC(a) do { if (__any((a) < 1.f)) { if (hi == 0) al_l[r32] = (a); asm volatile("s_waitcnt lgkmcnt(0)" ::: "memory");              \
                     for (int d_ = 0; d_ < 4; ++d_) for (int r = 0; r < 16; ++r) o[d_][r] *= al_l[crow(r, hi)]; } } while (0)
#define KBASE(t) ((j_lo + (t)) * KVBLK)
#define ACT(t) (KBASE(t) <= qlo + QBLK - 1 && KBASE(t) + KVBLK - 1 >= lowk_w)
#define MASKT(P0_, P1_, t) do { const int kb_ = KBASE(t); if (ACT(t) && (kb_ + KVBLK - 1 > qlo || kb_ < lowk_last)) mask_tile(P0_, P1_, qm - kb_, Wl); } while (0)
    constexpr int NQL = 8;
#define SEAM_K0() do { VMWN(NQL); SWRITE_HK(0); SBAR(); } while (0)
    f32x16 pA0, pA1, pB0, pB1; float mnA, mnB, alA, alB; bf16x8 pa0, pa1, pa2, pa3;
    SWRITE_HV(0); SBAR();
    if (NT > 1) { SLOAD_H(Kh, Vh, KBASE(1)); }
    SBAR(); qkt<0>(pA0, pA1, K_lds, r32, hi, S.qr, ACT(0));
    MASKT(pA0, pA1, 0); partialSM(pA0, pA1, m_reg, mnA, alA);
    if (NT > 1) { VMW(); SWRITE_H(1); }
    __syncthreads();
#define HALF_STEP(PX0, PX1, mnX, alX, PY0, PY1, alY, t, KB, VB, SB) do {                                                      \
        SBAR(); if ((t) + 1 < NT) { SLOAD_H(Kh, Vh, KBASE((t) + 1)); SBAR(); }                                       \
        qkt<KB>(PX0, PX1, K_lds, r32, hi, S.qr, ACT(t));                                             \
        finishSM(PY0, PY1, alY, l_reg, pa0, pa1, pa2, pa3); SBAR();                                                           \
        pv_tile<VB>(o, vb0, pa0, pa1, pa2, pa3, ACT((t) - 1)); MASKT(PX0, PX1, (t)); partialSM(PX0, PX1, m_reg, mnX, alX);                                        \
        __syncthreads();                                                                                                      \
        if ((t) + 1 < NT) { VMW(); SWRITE_H(SB); }                                                                          \
        RESC(alX); __syncthreads(); } while (0)
    for (int t = 1; t + 1 < NT; t += 2) {
        HALF_STEP(pB0, pB1, mnB, alB, pA0, pA1, alA, t, 1, 0, 0);
        HALF_STEP(pA0, pA1, mnA, alA, pB0, pB1, alB, t + 1, 0, 1, 1);
    }
    const bool even = (NT & 1) == 0;
    if (even) { SBAR(); qkt<1>(pB0, pB1, K_lds, r32, hi, S.qr, ACT(NT - 1)); SBAR(); }
    SLOAD_H(nxt.K, nxt.V, kbn); SBAR();
#pragma unroll
    for (int d0 = 0; d0 < 8; ++d0) S.qr[d0] = load8(nxt.Q + (size_t)(wid * QBLK + r32) * DH + d0 * 16 + hi * 8);
    SBAR();
    finishSM(pA0, pA1, alA, l_reg, pa0, pa1, pa2, pa3); SBAR();
    pv_tile<0>(o, vb0, pa0, pa1, pa2, pa3, ACT(even ? NT - 2 : NT - 1));
    if (even) { MASKT(pB0, pB1, NT - 1); partialSM(pB0, pB1, m_reg, mnB, alB); __syncthreads(); RESC(alB);
        finishSM(pB0, pB1, alB, l_reg, pa0, pa1, pa2, pa3); SBAR(); pv_tile<1>(o, vb0, pa0, pa1, pa2, pa3, ACT(NT - 1)); }
    SBAR(); SEAM_K0();
    if (hi == 0) li_l[r32] = l_reg; asm volatile("s_waitcnt lgkmcnt(0)" ::: "memory");
    if (cur.LSE != nullptr && hi == 0) cur.LSE[wid * QBLK + r32] = m_reg * SCALE + __logf(l_reg);
    float rli[16];
#pragma unroll
    for (int r = 0; r < 16; ++r) rli[r] = __builtin_amdgcn_rcpf(li_l[crow(r, hi)]);
    bf16_t* Ow = cur.O + (size_t)(wid * QBLK) * cur.ostride;
#pragma unroll
    for (int r = 0; r < 16; ++r) { const int orow = crow(r, hi);
#pragma unroll
        for (int d0 = 0; d0 < 4; ++d0) { const float v = o[d0][r] * rli[r];
            const float vn = __shfl_xor(v, 1);
            if ((r32 & 1) == 0) *(unsigned*)(Ow + (size_t)orow * cur.ostride + d0 * 32 + r32) = cvtpk(v, vn); } }
    __syncthreads();
#undef RESC
#undef KBASE
#undef ACT
#undef MASKT
#undef SEAM_K0
#undef HALF_STEP
}

constexpr int RING_V = 4 * SHM_K;
__device__ __forceinline__ void qkt_rt(f32x16& p0, f32x16& p1, const LAS char* Kslot, int r32, int hi, const bf16x8* qr) {
    p0 = f32x16{}; p1 = f32x16{};
    const LAS char* kb[4];
#pragma unroll
    for (int dd = 0; dd < 4; ++dd) kb[dd] = Kslot + KSWZ(r32, (dd * 16 + hi * 8) * 2);
#pragma unroll
    for (int d0 = 0; d0 < 8; ++d0) { const LAS char* a = kb[d0 & 3] + (d0 >> 2) * 128;
        bf16x8 b0 = *(const LAS bf16x8*)(a);
        bf16x8 b1 = *(const LAS bf16x8*)(a + 32 * 256);
        p0 = __builtin_amdgcn_mfma_f32_32x32x16_bf16(b0, qr[d0], p0, 0, 0, 0);
        p1 = __builtin_amdgcn_mfma_f32_32x32x16_bf16(b1, qr[d0], p1, 0, 0, 0); }
}
__device__ __forceinline__ void pv_rt(f32x16* o, int vb, bf16x8 pa0, bf16x8 pa1, bf16x8 pa2, bf16x8 pa3) {
#define TRRD(dst, off) asm volatile("ds_read_b64_tr_b16 %0, %1 offset:%2" : "=&v"(dst) : "v"(vb), "i"(off) : "memory")
#define PV_D0(d0) do { s16x4 l0, l1, l2, l3, h0, h1, h2, h3; constexpr int b_ = v_rd_off(d0, 0, 0); \
        TRRD(l0, b_); TRRD(h0, b_ + 2048); TRRD(l1, b_ + 4096); TRRD(h1, b_ + 6144); TRRD(l2, b_ + 8192); TRRD(h2, b_ + 10240); TRRD(l3, b_ + 12288); TRRD(h3, b_ + 14336); \
        asm volatile("s_waitcnt lgkmcnt(0)" ::: "memory"); SBAR();   \
        o[d0] = __builtin_amdgcn_mfma_f32_32x32x16_bf16(pa0, (bf16x8){l0[0], l0[1], l0[2], l0[3], h0[0], h0[1], h0[2], h0[3]}, o[d0], 0, 0, 0);   \
        o[d0] = __builtin_amdgcn_mfma_f32_32x32x16_bf16(pa1, (bf16x8){l1[0], l1[1], l1[2], l1[3], h1[0], h1[1], h1[2], h1[3]}, o[d0], 0, 0, 0);   \
        o[d0] = __builtin_amdgcn_mfma_f32_32x32x16_bf16(pa2, (bf16x8){l2[0], l2[1], l2[2], l2[3], h2[0], h2[1], h2[2], h2[3]}, o[d0], 0, 0, 0);   \
        o[d0] = __builtin_amdgcn_mfma_f32_32x32x16_bf16(pa3, (bf16x8){l3[0], l3[1], l3[2], l3[3], h3[0], h3[1], h3[2], h3[3]}, o[d0], 0, 0, 0); } while (0)
    PV_D0(0); PV_D0(1); PV_D0(2); PV_D0(3);
#undef PV_D0
#undef TRRD
}
struct WaveState { float m, l; f32x16 o[4]; };
__device__ __forceinline__ void tile_step(WaveState& st, const bf16x8* qr, const LAS char* lds, int slot, int r32, int hi, int lane, LAS float* al_l, bool need_mask, int dq, unsigned Wl) {
    f32x16 p0, p1; float mn, alpha; bf16x8 pa0, pa1, pa2, pa3;
    qkt_rt(p0, p1, lds + slot * SHM_K, r32, hi, qr);
    if (need_mask) mask_tile(p0, p1, dq, Wl);
    partialSM(p0, p1, st.m, mn, alpha);
    if (__any(alpha < 1.f)) { if (hi == 0) al_l[r32] = alpha; asm volatile("s_waitcnt lgkmcnt(0)" ::: "memory");
        for (int d_ = 0; d_ < 4; ++d_) for (int r = 0; r < 16; ++r) st.o[d_][r] *= al_l[crow(r, hi)]; }
    finishSM(p0, p1, alpha, st.l, pa0, pa1, pa2, pa3); SBAR();
    pv_rt(st.o, (int)(unsigned)(uintptr_t)(lds + RING_V + slot * SHM_V) + v_rd_base(lane), pa0, pa1, pa2, pa3);
}
__device__ __forceinline__ void wave_store(const WaveState& st, bf16_t* Ow, int ostride, float* lse, int r32, int hi, LAS float* li_l) {
    if (hi == 0) li_l[r32] = st.l; asm volatile("s_waitcnt lgkmcnt(0)" ::: "memory");
    if (lse != nullptr && hi == 0) lse[r32] = st.m * SCALE + __logf(st.l);
    float rli[16];
#pragma unroll
    for (int r = 0; r < 16; ++r) rli[r] = __builtin_amdgcn_rcpf(li_l[crow(r, hi)]);
#pragma unroll
    for (int r = 0; r < 16; ++r) { const int orow = crow(r, hi);
#pragma unroll
        for (int d0 = 0; d0 < 4; ++d0) { const float v = st.o[d0][r] * rli[r];
            const float vn = __shfl_xor(v, 1);
            if ((r32 & 1) == 0) *(unsigned*)(Ow + (size_t)orow * ostride + d0 * 32 + r32) = cvtpk(v, vn); } }
}
__device__ __forceinline__ void wave_reset(WaveState& st) { st.m = -1e30f; st.l = 0.f;
#pragma unroll
    for (int d = 0; d < 4; ++d) st.o[d] = f32x16{}; }
#define HS_LOADQ(qr, Qrow0) do { _Pragma("unroll") for (int d0 = 0; d0 < 8; ++d0) qr[d0] = load8((Qrow0) + (size_t)(wid * QBLK + r32) * DH + d0 * 16 + hi * 8); } while (0)
#define HS_SLOAD(Kp, Vp, k0) do { st_v0 = load8(ROW(Vp, k0, sr)); st_v1 = load8(ROW(Vp, k0, 32 + sr)); st_k0 = load8(ROW(Kp, k0, sr)); st_k1 = load8(ROW(Kp, k0, 32 + sr)); } while (0)
#define HS_SWRITE(slot) do { *(LAS bf16x8*)(lds + (slot) * SHM_K + kws) = st_k0; *(LAS bf16x8*)(lds + (slot) * SHM_K + kws + 32 * 256) = st_k1; \
                             *(LAS bf16x8*)(lds + RING_V + (slot) * SHM_V + vst0) = st_v0; *(LAS bf16x8*)(lds + RING_V + (slot) * SHM_V + vst1) = st_v1; } while (0)
__device__ __forceinline__ void head_dilated(const bf16_t* Q, bf16_t* O, const bf16_t* K, const bf16_t* V, float* LSE, int segmask, LAS char* lds, LAS float* scr, int wave_s) {
    const int tid = opaque_tid(wave_s), wid = __builtin_amdgcn_readfirstlane(tid >> 6), lane = tid & 63, r32 = lane & 31, hi = lane >> 5, pair = wid >> 1;
    const int sr = tid >> 4, sc = (tid & 15) * 8, vst0 = v_st(sr, sc), vst1 = v_st(32 + sr, sc), kws = KSWZ(sr, sc * 2);
    LAS float* li_l = scr + wid * 64; LAS float* al_l = li_l + 32;
    constexpr int NT = 2048 / KVBLK, W = 129;
    bf16x8 st_v0, st_v1, st_k0, st_k1; bf16x8 qr[8]; WaveState st; wave_reset(st);
    HS_SLOAD(K, V, 0); HS_LOADQ(qr, Q); VMW(); HS_SWRITE(0); SBAR();
    HS_SLOAD(K, V, KVBLK); VMW(); HS_SWRITE(1);
    __syncthreads();
    for (int g = 1; g <= NT; ++g) {
        const bool ld = g + 1 < NT;
        if (ld) { HS_SLOAD(K, V, (g + 1) * KVBLK); SBAR(); }
        const int ph = (g - 1) & 3, qb = (g - 1) >> 2;
        if (ph != 3) {
            const int T = g - 3 + pair, qlo = qb * QB + wid * QBLK, segb = qlo & ~segmask;
            const int lowk_w = imax(qlo - W + 1, segb), lowk_last = imax(qlo + QBLK - W, segb), kb_ = T * KVBLK;
            if (T >= 0 && kb_ <= qlo + QBLK - 1 && kb_ + KVBLK - 1 >= lowk_w) {
                const int wrow = ((qlo + r32) & segmask) + 1;
                tile_step(st, qr, lds, T & 3, r32, hi, lane, al_l, (kb_ + KVBLK - 1 > qlo) || (kb_ < lowk_last), qlo + r32 - 4 * hi - kb_, (unsigned)(wrow < W ? wrow : W));
            }
        } else {
            wave_store(st, O + (size_t)(qb * QB + wid * QBLK) * DH, DH, LSE + qb * QB + wid * QBLK, r32, hi, li_l);
            wave_reset(st);
            if (qb + 1 < 2048 / QB) HS_LOADQ(qr, Q + (size_t)(qb + 1) * QB * DH);
        }
        __syncthreads();
        if (ld) { VMW(); HS_SWRITE((g + 1) & 3); }
        __syncthreads();
    }
}
__device__ __forceinline__ void head_mem(const bf16_t* Q, const bf16_t* K, const bf16_t* V, bf16_t* O, int ostride, LAS char* lds, LAS float* scr, int wave_s) {
    const int tid = opaque_tid(wave_s), wid = __builtin_amdgcn_readfirstlane(tid >> 6), lane = tid & 63, r32 = lane & 31, hi = lane >> 5, pair = wid >> 1;
    const int sr = tid >> 4, sc = (tid & 15) * 8, vst0 = v_st(sr, sc), vst1 = v_st(32 + sr, sc), kws = KSWZ(sr, sc * 2);
    LAS float* li_l = scr + wid * 64; LAS float* al_l = li_l + 32;
    bf16x8 st_v0, st_v1, st_k0, st_k1; bf16x8 qr[8]; WaveState st;
#pragma unroll
    for (int t = 0; t < 4; ++t) { HS_SLOAD(K, V, t * KVBLK); VMW(); HS_SWRITE(t); SBAR(); }
    __syncthreads();
    for (int qb = 0; qb < 2048 / QB; ++qb) {
        HS_LOADQ(qr, Q + (size_t)qb * QB * DH); wave_reset(st);
        for (int t = 0; t < 4; ++t) tile_step(st, qr, lds, (t + pair) & 3, r32, hi, lane, al_l, false, 0, 0u);
        wave_store(st, O + (size_t)(qb * QB + wid * QBLK) * ostride, ostride, nullptr, r32, hi, li_l);
    }
    __syncthreads();
}
#undef HS_LOADQ
#undef HS_SLOAD
#undef HS_SWRITE
#undef ROW
#undef VMW
#undef VMWN
#undef SLOAD_H
#undef SWRITE_HK
#undef SWRITE_HV
#undef SWRITE_H
#undef KSWZ
#undef SBAR
}

#define XB_TMO      128
#define XB_XCNT(j)  (256  + 64 * (j))
#define XB_XSUB(j)  (1280 + 64 * (j))
#define XB_XGEN(j)  (2304 + 64 * (j))
#define XB_TOP      3328
#define XB_TOPGEN   3392
#define XCD_BAR_WORDS 3456
#define XB_SPIN_CAP (1u << 18)
__device__ __forceinline__ unsigned xb_ld(unsigned* p)              { return __hip_atomic_load(p, __ATOMIC_RELAXED, __HIP_MEMORY_SCOPE_AGENT); }
__device__ __forceinline__ unsigned xb_add(unsigned* p, unsigned v) { return __hip_atomic_fetch_add(p, v, __ATOMIC_RELAXED, __HIP_MEMORY_SCOPE_AGENT); }
__device__ __forceinline__ unsigned xb_xcc_id() { return (unsigned)__builtin_amdgcn_s_getreg((3 << 11) | 20) & 0xFu; }
#define XB_SPIN(cond, bar) do { unsigned _sp = 0; while (cond) { __builtin_amdgcn_s_sleep(1); \
    if ((++_sp & 255u) == 0u) { if (xb_ld(&(bar)[XB_TMO])) break; if (_sp > XB_SPIN_CAP) { atomicAdd(&(bar)[XB_TMO], 1u); break; } } } } while (0)
struct XcdBarrier { unsigned* bar; unsigned x; volatile LAS unsigned* st; };
__device__ __forceinline__ XcdBarrier xcd_barrier_post(unsigned* bar, volatile LAS unsigned* st) {
    XcdBarrier b; b.bar = bar; b.x = xb_xcc_id(); b.st = st;
    if (threadIdx.x == 0) (void)xb_add(&bar[XB_XCNT(b.x)], 1u);
    return b;
}
__device__ __forceinline__ void xcd_barrier_complete(unsigned* bar, unsigned x, unsigned& nloc, unsigned& nx) {
    const unsigned G = gridDim.x * gridDim.y * gridDim.z;
    unsigned sum, cnt, mine, sp = 0u;
    for (;;) {
        sum = 0u; cnt = 0u; mine = 0u;
#pragma unroll
        for (unsigned j = 0; j < 16; ++j) { const unsigned c = xb_ld(&bar[XB_XCNT(j)]); sum += c; cnt += (c > 0u) ? 1u : 0u; mine = (j == x) ? c : mine; }
        if (sum == G) break;
        __builtin_amdgcn_s_sleep(1);
        if ((++sp & 255u) == 0u) { if (xb_ld(&bar[XB_TMO])) break; if (sp > XB_SPIN_CAP) { atomicAdd(&bar[XB_TMO], 1u); break; } }
    }
    nloc = mine > 0u ? mine : 1u; nx = cnt > 0u ? cnt : 1u;
}
__device__ __forceinline__ void xcd_barrier(const XcdBarrier& b) {
    asm volatile("s_waitcnt vmcnt(0)" ::: "memory");
    __syncthreads();
    if (threadIdx.x == 0) {
        unsigned* bar = b.bar; asm volatile("" : "+s"(bar)); bar = (unsigned*)(GAS unsigned*)bar;
        __builtin_amdgcn_s_waitcnt(0);
        unsigned nloc = b.st[0], nx = b.st[1];
        if (nloc == 0u) { xcd_barrier_complete(bar, b.x, nloc, nx); b.st[0] = nloc; b.st[1] = nx; }
        const unsigned old = xb_add(&bar[XB_XSUB(b.x)], 1u);
        const unsigned gen = old / nloc;
        if (old + 1u == (gen + 1u) * nloc) {
            __builtin_amdgcn_fence(__ATOMIC_RELEASE, "agent");
            asm volatile("s_waitcnt vmcnt(0)" ::: "memory");
            const unsigned og = xb_add(&bar[XB_TOP], 1u);
            const unsigned tg = og / nx;
            if (og + 1u == (tg + 1u) * nx) xb_add(&bar[XB_TOPGEN], 1u);
            else XB_SPIN(xb_ld(&bar[XB_TOPGEN]) == tg, bar);
            __builtin_amdgcn_fence(__ATOMIC_ACQUIRE, "agent");
            xb_add(&bar[XB_XGEN(b.x)], 1u);
            asm volatile("s_waitcnt vmcnt(0)" ::: "memory");
        } else {
            XB_SPIN(xb_ld(&bar[XB_XGEN(b.x)]) == gen, bar);
            __builtin_amdgcn_fence(__ATOMIC_ACQUIRE, "agent");
            asm volatile("s_waitcnt vmcnt(0)" ::: "memory");
        }
    }
    __syncthreads();
}
constexpr int CW_BAR = 4096, CW_CONVQ = 96;

#define ACC8(ai, bj, m) {acc[ai][bj][m][0][0], acc[ai][bj][m][0][1], acc[ai][bj][m][0][2], acc[ai][bj][m][0][3], acc[ai][bj][m][1][0], acc[ai][bj][m][1][1], acc[ai][bj][m][1][2], acc[ai][bj][m][1][3]}
struct FastEpiMain {
    static constexpr bool PERM = true; EpiMain mn; EpiKV kv; float ascale;
    __device__ __forceinline__ bool keep_acc(const pg8::Unit&) const { return false; }
    __device__ __forceinline__ void operator()(f32x4 (&acc)[2][2][4][2], const pg8::Unit& u, int wr, int wc, int fr, int fq) const {
        asm volatile("" : "+v"(fr), "+v"(fq));
        const int rowb = u.row0 + wr * 64 + fr, colb = u.col0 + wc * 32 + 8 * fq;
        if (u.aux != 0) {
#pragma unroll
            for (int ai = 0; ai < 2; ++ai)
#pragma unroll
                for (int m = 0; m < 4; ++m)
#pragma unroll
                    for (int bj = 0; bj < 2; ++bj) { float v[8] = ACC8(ai, bj, m); kv(rowb + ai * 128 + m * 16, colb + bj * 128, v); }
            return;
        }
        f32x4 bb[2][2];
#pragma unroll
        for (int bj = 0; bj < 2; ++bj) { bb[bj][0] = *(const f32x4*)(mn.biasp + colb + bj * 128); bb[bj][1] = *(const f32x4*)(mn.biasp + colb + bj * 128 + 4); }
        float fpos[2][4];
#pragma unroll
        for (int ai = 0; ai < 2; ++ai)
#pragma unroll
            for (int m = 0; m < 4; ++m) fpos[ai][m] = 0.f;
        if (u.col0 < C_V) {
#pragma unroll
            for (int ai = 0; ai < 2; ++ai)
#pragma unroll
                for (int m = 0; m < 4; ++m) fpos[ai][m] = (float)mn.pos[mn.tok0 + rowb + ai * 128 + m * 16];
        }
        float invrev[4]; EpiMain::rope_freqs(colb, invrev);
#pragma unroll
        for (int ai = 0; ai < 2; ++ai)
#pragma unroll
            for (int m = 0; m < 4; ++m)
#pragma unroll
                for (int bj = 0; bj < 2; ++bj) { float v[8] = ACC8(ai, bj, m);
#pragma unroll
                    for (int q = 0; q < 8; ++q) v[q] *= ascale;
                    v[0] += bb[bj][0].x; v[1] += bb[bj][0].y; v[2] += bb[bj][0].z; v[3] += bb[bj][0].w; v[4] += bb[bj][1].x; v[5] += bb[bj][1].y; v[6] += bb[bj][1].z; v[7] += bb[bj][1].w;
                    mn.finish(rowb + ai * 128 + m * 16, colb + bj * 128, v, fpos[ai][m], invrev); }
    }
};
struct FastEpiGates {
    static constexpr bool PERM = true; const float* biasp; bf16_t* GATES; float ascale;
    __device__ __forceinline__ bool keep_acc(const pg8::Unit&) const { return false; }
    __device__ __forceinline__ void operator()(f32x4 (&acc)[2][2][4][2], const pg8::Unit& u, int wr, int wc, int fr, int fq) const {
        asm volatile("" : "+v"(fr), "+v"(fq));
        const int rowb = u.row0 + wr * 64 + fr, colb = u.col0 + wc * 32 + 8 * fq;
        f32x4 bb[2][2];
#pragma unroll
        for (int bj = 0; bj < 2; ++bj) { bb[bj][0] = *(const f32x4*)(biasp + colb + bj * 128); bb[bj][1] = *(const f32x4*)(biasp + colb + bj * 128 + 4); }
#pragma unroll
        for (int ai = 0; ai < 2; ++ai)
#pragma unroll
            for (int m = 0; m < 4; ++m)
#pragma unroll
                for (int bj = 0; bj < 2; ++bj) { const f32x4 a = acc[ai][bj][m][0] * ascale + bb[bj][0], b = acc[ai][bj][m][1] * ascale + bb[bj][1];
                    u32x4 o; o.x = pk2(sigmoidf_(a.x), sigmoidf_(a.y)); o.y = pk2(sigmoidf_(a.z), sigmoidf_(a.w)); o.z = pk2(sigmoidf_(b.x), sigmoidf_(b.y)); o.w = pk2(sigmoidf_(b.z), sigmoidf_(b.w));
                    *(u32x4*)(GATES + (size_t)(rowb + ai * 128 + m * 16) * 3072 + (colb + bj * 128 - C_GATE)) = o; }
    }
};
struct FastEpiMerge {
    static constexpr bool PERM = true; const bf16_t* GATES; bf16_t* MERGED;
    __device__ __forceinline__ bool keep_acc(const pg8::Unit& u) const { return u.aux < 2; }
    __device__ __forceinline__ void operator()(f32x4 (&acc)[2][2][4][2], const pg8::Unit& u, int wr, int wc, int fr, int fq) const {
        asm volatile("" : "+v"(fr), "+v"(fq));
        const int rowb = u.row0 + wr * 64 + fr, colb = u.col0 + wc * 32 + 8 * fq, br = u.aux;
        const unsigned char* gp = (const unsigned char*)GATES + (size_t)rowb * 3072 + br * 1024 + colb;
        bf16_t* mp = MERGED + (size_t)rowb * 1024 + colb;
#pragma unroll
        for (int ai = 0; ai < 2; ++ai) {
            u32x2 tg[4][2], tn[4][2];
#pragma unroll
            for (int m = 0; m < 4; ++m)
#pragma unroll
                for (int bj = 0; bj < 2; ++bj) { tg[m][bj] = *(const u32x2*)(gp + (size_t)(ai * 128 + m * 16) * 3072 + bj * 128);
                    if (br < 2) tn[m][bj] = *(const u32x2*)(gp + 1024 + (size_t)(ai * 128 + m * 16) * 3072 + bj * 128); }
            if (br < 2) {
#pragma unroll
                for (int m = 0; m < 4; ++m)
#pragma unroll
                    for (int bj = 0; bj < 2; ++bj) { const u32x2 g = tg[m][bj], n = tn[m][bj]; const f32x4 n0 = u8x4_raw(n.x), n1 = u8x4_raw(n.y);
                        const f32x4 r0 = {__builtin_amdgcn_rcpf(n0.x), __builtin_amdgcn_rcpf(n0.y), __builtin_amdgcn_rcpf(n0.z), __builtin_amdgcn_rcpf(n0.w)}, r1 = {__builtin_amdgcn_rcpf(n1.x), __builtin_amdgcn_rcpf(n1.y), __builtin_amdgcn_rcpf(n1.z), __builtin_amdgcn_rcpf(n1.w)};
                        acc[ai][bj][m][0] = acc[ai][bj][m][0] * (u8x4_raw(g.x) * r0); acc[ai][bj][m][1] = acc[ai][bj][m][1] * (u8x4_raw(g.y) * r1); }
            } else {
#pragma unroll
                for (int m = 0; m < 4; ++m)
#pragma unroll
                    for (int bj = 0; bj < 2; ++bj) { const u32x2 g = tg[m][bj]; const f32x4 a = acc[ai][bj][m][0] * u8x4_to_f32(g.x), b = acc[ai][bj][m][1] * u8x4_to_f32(g.y);
                        u32x4 o; o.x = pk2(a.x, a.y); o.y = pk2(a.z, a.w); o.z = pk2(b.x, b.y); o.w = pk2(b.z, b.w);
                        *(u32x4*)(mp + (size_t)(ai * 128 + m * 16) * 1024 + bj * 128) = o; }
            }
            asm volatile("" ::: "memory");
        }
    }
};
struct FastEpiStore {
    static constexpr bool PERM = true; bf16_t* O; int ld; float scale;
    __device__ __forceinline__ bool keep_acc(const pg8::Unit&) const { return false; }
    __device__ __forceinline__ void operator()(f32x4 (&acc)[2][2][4][2], const pg8::Unit& u, int wr, int wc, int fr, int fq) const {
        asm volatile("" : "+v"(fr), "+v"(fq));
        const int rowb = u.row0 + wr * 64 + fr, colb = u.col0 + wc * 32 + 8 * fq;
#pragma unroll
        for (int ai = 0; ai < 2; ++ai)
#pragma unroll
            for (int m = 0; m < 4; ++m)
#pragma unroll
                for (int bj = 0; bj < 2; ++bj) { const f32x4 a = acc[ai][bj][m][0] * scale, b = acc[ai][bj][m][1] * scale;
                    u32x4 o; o.x = pk2(a.x, a.y); o.y = pk2(a.z, a.w); o.z = pk2(b.x, b.y); o.w = pk2(b.z, b.w);
                    *(u32x4*)(O + (size_t)(rowb + ai * 128 + m * 16) * ld + colb + bj * 128) = o; }
    }
};
struct FastEpiMoe1 {
    static constexpr bool PERM = true; LAS const int* toktab; const float* wts; unsigned char* H8;
    __device__ __forceinline__ bool keep_acc(const pg8::Unit&) const { return false; }
    __device__ __forceinline__ void operator()(f32x4 (&acc)[2][2][4][2], const pg8::Unit& u, int wr, int wc, int fr, int fq) const {
        asm volatile("" : "+v"(fr), "+v"(fq));
        const int rloc = wr * 64 + fr, colb = u.col0 + wc * 32 + 8 * fq, hi = u.col0 >> 10;
        float w[2][4];
#pragma unroll
        for (int ai = 0; ai < 2; ++ai)
#pragma unroll
            for (int m = 0; m < 4; ++m) { const int tok = toktab[u.aux * 256 + rloc + ai * 128 + m * 16]; w[ai][m] = wts[(size_t)tok * 2 + hi] * (H8_SCALE / W8_SCALE); }
        constexpr float inv = 1.0f / W8_SCALE;
#pragma unroll
        for (int ai = 0; ai < 2; ++ai)
#pragma unroll
            for (int m = 0; m < 4; ++m)
#pragma unroll
                for (int bj = 0; bj < 2; ++bj) { const f32x4 gt = acc[ai][bj][m][0] * inv, up = acc[ai][bj][m][1]; const float ww = w[ai][m];
                    const int j0 = hi * 512 + (((colb + bj * 128) & 1023) >> 1);
                    float h[4] = {gt.x * sigmoidf_(gt.x) * up.x * ww, gt.y * sigmoidf_(gt.y) * up.y * ww, gt.z * sigmoidf_(gt.z) * up.z * ww, gt.w * sigmoidf_(gt.w) * up.w * ww};
#pragma unroll
                    for (int q = 0; q < 4; ++q) h[q] = fminf(fmaxf(h[q], -448.f), 448.f);
                    *(unsigned*)(H8 + (size_t)(u.row0 + rloc + ai * 128 + m * 16) * 1024 + j0) = pk4_fp8(h[0], h[1], h[2], h[3]); }
    }
};
#undef ACC8

struct SchedMain {
    pg8::TileOrder to; int nkv, tile0, cut, skip; size_t astep, bstep; const char *XB, *WIN, *MEMB, *WKV;
    __device__ __forceinline__ bool next(int i, pg8::Unit& u) const {
        int pm, pn;
        if (to.tile(i, pm, pn)) { const int ct = tile0 + (pn < cut ? pn : pn + skip); u.A = XB + (size_t)pm * astep; u.B = WIN + (size_t)ct * bstep; u.row0 = pm * 256; u.col0 = ct * 256; u.bjump = 0; u.aux = 0; return true; }
        const long L = (long)i * to.G + to.c - to.nwg; if (L >= nkv) return false;
        pm = (int)(L >> 2); pn = (int)(L & 3);
        u.A = MEMB + (size_t)pm * 256 * 2048; u.B = WKV + (size_t)pn * 256 * 2048; u.row0 = pm * 256; u.col0 = pn * 256; u.bjump = 0; u.aux = 1; return true;
    }
};
struct SchedMerge {
    pg8::TileOrder to; const char *A0, *W;
    __device__ __forceinline__ bool next(int i, pg8::Unit& u) const {
        const int ti = i / 3, br = i - ti * 3; int pm, pn; if (!to.tile(ti, pm, pn)) return false;
        u.A = A0 + (size_t)br * SZ_512 + (size_t)pm * 256 * 1024; u.B = W + (size_t)br * MiB + (size_t)pn * 256 * 1024; u.row0 = pm * 256; u.col0 = pn * 256; u.bjump = 0; u.aux = br; return true;
    }
};
struct SchedPlain {
    pg8::TileOrder to; const char *A, *B; size_t astep, bstep;
    __device__ __forceinline__ bool next(int i, pg8::Unit& u) const {
        int pm, pn; if (!to.tile(i, pm, pn)) return false;
        u.A = A + (size_t)pm * astep; u.B = B + (size_t)pn * bstep; u.row0 = pm * 256; u.col0 = pn * 256; u.bjump = 0; u.aux = 0; return true;
    }
};
struct SchedMoe {
    pg8::TileOrder to; LAS const int* pan_cls; LAS const int* toktab; const char *H, *W1, *W2; int mode;
    __device__ __forceinline__ LAS const int* toks(int i) const { return toktab + i * 256; }
    __device__ __forceinline__ bool next(int i, pg8::Unit& u) const {
        int pm, pn; if (!to.tile(i, pm, pn)) return false;
        const int cls = pan_cls[pm]; int e_lo, e_hi; class_experts(cls, e_lo, e_hi);
        u.row0 = pm * 256; u.col0 = pn * 256; u.aux = i; u.bjump = 0;
        if (mode == 1) { u.A = nullptr; u.B = W1 + ((size_t)(pn < 4 ? e_lo : e_hi) * 1024 + (size_t)(pn & 3) * 256) * 1024; }
        else { u.A = H + (size_t)pm * 256 * 1024; u.B = W2 + (size_t)pn * 256 * 8192 + (size_t)e_lo * 512; u.bjump = (e_hi - e_lo - 1) * 512; }
        return true;
    }
};

template <int WHICH> __device__ __forceinline__ float tw_src(const Params& p, int k, int n) {
    if constexpr (WHICH == TW_IN) return p.w_in[(size_t)k * INC + win_logical(n)];
    else if constexpr (WHICH == TW_KV) return p.w_mem_kv[(size_t)k * 1024 + n];
    else if constexpr (WHICH == TW_A) return p.w_attn_o[(size_t)k * 1024 + n];
    else if constexpr (WHICH == TW_C) return p.w_conv_o[(size_t)k * 1024 + n];
    else if constexpr (WHICH == TW_M) return p.w_mem_o[(size_t)k * 1024 + n];
    else if constexpr (WHICH == TW_OUT) return p.w_out[(size_t)k * 1024 + n];
    else if constexpr (WHICH == TW_W1) { const int e = n >> 10, c = n & 1023, G = c >> 3, nn = (c >> 2) & 1, ee = c & 3, jj = 4 * G + ee; return (nn ? p.w_eu : p.w_eg)[((size_t)e * 1024 + k) * 512 + jj]; }
    else { const int e = n >> 10, c = n & 1023; return p.w_ed[((size_t)e * 512 + k) * 1024 + c]; }
}
template <int WHICH> __device__ __forceinline__ void tw_item(const Params& p, int item, float* scr, int lane) {
    constexpr int N = WHICH == TW_IN ? INC : (WHICH >= TW_W1 ? 16 * 1024 : 1024);
    constexpr int ldd = (WHICH == TW_A || WHICH == TW_C || WHICH == TW_M) ? 512 : (WHICH == TW_W2 ? 8192 : 1024);
    constexpr size_t dsto = WHICH == TW_IN ? WS_WIN : WHICH == TW_KV ? WS_WKV : WHICH == TW_A ? WS_WA : WHICH == TW_C ? WS_WC : WHICH == TW_M ? WS_WM : WHICH == TW_OUT ? WS_WOUT : WHICH == TW_W1 ? WS_W1 : WS_W2;
    bf16_t* dst = WSP(bf16_t, dsto);
    constexpr int nblk = N / 32; const int kb = item / nblk, nb = item - kb * nblk, k0 = 64 * kb, n0 = 32 * nb;
#pragma unroll 8
    for (int i = 0; i < 32; ++i) { const int kk = 2 * i + (lane >> 5); scr[kk * 33 + (lane & 31)] = tw_src<WHICH>(p, k0 + kk, n0 + (lane & 31)); }
    asm volatile("s_waitcnt lgkmcnt(0)" ::: "memory");
    const int c = lane & 7;
#pragma unroll
    for (int j = 0; j < 4; ++j) { const int n = (lane >> 3) + 8 * j; const float* sp = scr + (8 * c) * 33 + n;
        const int nn = n0 + n; size_t doff;
        if constexpr (WHICH == TW_W2) doff = (size_t)(nn & 1023) * 8192 + (size_t)(nn >> 10) * 512 + k0 + 8 * c; else doff = (size_t)nn * ldd + k0 + 8 * c;
        if constexpr (WHICH >= TW_W1) {
            u32x2 o; o.x = pk4_fp8(W8_SCALE * sp[0 * 33], W8_SCALE * sp[1 * 33], W8_SCALE * sp[2 * 33], W8_SCALE * sp[3 * 33]); o.y = pk4_fp8(W8_SCALE * sp[4 * 33], W8_SCALE * sp[5 * 33], W8_SCALE * sp[6 * 33], W8_SCALE * sp[7 * 33]);
            *(u32x2*)((unsigned char*)dst + doff) = o;
        } else {
            u32x4 o; o.x = pk2(sp[0 * 33], sp[1 * 33]); o.y = pk2(sp[2 * 33], sp[3 * 33]); o.z = pk2(sp[4 * 33], sp[5 * 33]); o.w = pk2(sp[6 * 33], sp[7 * 33]);
            *(u32x4*)(dst + doff) = o;
            if constexpr (WHICH == TW_IN) {
                u32x2 q; q.x = pk4_fp8(WG8_SCALE * sp[0 * 33], WG8_SCALE * sp[1 * 33], WG8_SCALE * sp[2 * 33], WG8_SCALE * sp[3 * 33]); q.y = pk4_fp8(WG8_SCALE * sp[4 * 33], WG8_SCALE * sp[5 * 33], WG8_SCALE * sp[6 * 33], WG8_SCALE * sp[7 * 33]);
                *(u32x2*)(p.ws + WS_WG8 + doff) = q; } } }
    asm volatile("s_waitcnt lgkmcnt(0)" ::: "memory");
}
__device__ __forceinline__ void transpose_all(const Params& p, float* scr, int gw, int ngw, int lane) {
    constexpr int I_IN = 16 * (INC / 32), I_KV = 16 * 32, I_B = 8 * 32, I_OUT = 16 * 32, I_W1 = 16 * 512, I_W2 = 8 * 512;
    constexpr int NITEMS = I_IN + I_KV + 3 * I_B + I_OUT + I_W1 + I_W2;
    for (int it = gw; it < NITEMS; it += ngw) {
        int r = it;
        if (r < I_W1) { tw_item<TW_W1>(p, r, scr, lane); continue; } r -= I_W1;
        if (r < I_IN) { tw_item<TW_IN>(p, r, scr, lane); continue; } r -= I_IN;
        if (r < I_W2) { tw_item<TW_W2>(p, r, scr, lane); continue; } r -= I_W2;
        if (r < I_KV) { tw_item<TW_KV>(p, r, scr, lane); continue; } r -= I_KV;
        if (r < I_OUT) { tw_item<TW_OUT>(p, r, scr, lane); continue; } r -= I_OUT;
        if (r < I_B) { tw_item<TW_A>(p, r, scr, lane); continue; } r -= I_B;
        if (r < I_B) { tw_item<TW_C>(p, r, scr, lane); continue; } r -= I_B;
        tw_item<TW_M>(p, r, scr, lane);
    }
}

__device__ __forceinline__ void cvt_bf16_dev(const float* __restrict__ src, bf16_t* __restrict__ dst, size_t n8, size_t gtid, size_t gstride) {
    for (size_t i = gtid; i < n8; i += gstride) {
        const f32x4 a = *(const f32x4*)(src + i * 8), b = *(const f32x4*)(src + i * 8 + 4);
        u32x4 o; o.x = pk2(a.x, a.y); o.y = pk2(a.z, a.w); o.z = pk2(b.x, b.y); o.w = pk2(b.z, b.w);
        *(u32x4*)(dst + i * 8) = o;
    }
}

__device__ __forceinline__ void cvt_x_dev(const float* __restrict__ src, bf16_t* __restrict__ dst, unsigned char* __restrict__ dst8, size_t n16, size_t gtid, size_t gstride) {
    for (size_t i = gtid; i < n16; i += 2 * gstride) {
        const size_t i2 = i + gstride; const bool has2 = i2 < n16; const size_t j2 = has2 ? i2 : i;
        f32x4 a[2][4];
#pragma unroll
        for (int q = 0; q < 4; ++q) { a[0][q] = *(const f32x4*)(src + i * 16 + 4 * q); a[1][q] = *(const f32x4*)(src + j2 * 16 + 4 * q); }
#pragma unroll
        for (int r = 0; r < 2; ++r) { if (r == 1 && !has2) break; const size_t ii = r ? i2 : i;
            u32x4 o0, o1; o0.x = pk2(a[r][0].x, a[r][0].y); o0.y = pk2(a[r][0].z, a[r][0].w); o0.z = pk2(a[r][1].x, a[r][1].y); o0.w = pk2(a[r][1].z, a[r][1].w);
            o1.x = pk2(a[r][2].x, a[r][2].y); o1.y = pk2(a[r][2].z, a[r][2].w); o1.z = pk2(a[r][3].x, a[r][3].y); o1.w = pk2(a[r][3].z, a[r][3].w);
            *(u32x4*)(dst + ii * 16) = o0; *(u32x4*)(dst + ii * 16 + 8) = o1;
            u32x4 q8; q8.x = pk4_fp8(a[r][0].x, a[r][0].y, a[r][0].z, a[r][0].w); q8.y = pk4_fp8(a[r][1].x, a[r][1].y, a[r][1].z, a[r][1].w); q8.z = pk4_fp8(a[r][2].x, a[r][2].y, a[r][2].z, a[r][2].w); q8.w = pk4_fp8(a[r][3].x, a[r][3].y, a[r][3].z, a[r][3].w);
            *(u32x4*)(dst8 + ii * 16) = q8; }
    }
}
__device__ __forceinline__ void wg8_dev(const Params& p, size_t gtid, size_t gstride) {
    for (size_t i = gtid; i < (size_t)INC * 64; i += gstride) { const int n = (int)(i % INC), k0 = (int)(i / INC) * 16, nl = win_logical(n); float v[16];
#pragma unroll
        for (int j = 0; j < 16; ++j) v[j] = WG8_SCALE * p.w_in[(size_t)(k0 + j) * INC + nl];
        u32x4 q; q.x = pk4_fp8(v[0], v[1], v[2], v[3]); q.y = pk4_fp8(v[4], v[5], v[6], v[7]); q.z = pk4_fp8(v[8], v[9], v[10], v[11]); q.w = pk4_fp8(v[12], v[13], v[14], v[15]);
        *(u32x4*)(p.ws + WS_WG8 + (size_t)n * 1024 + k0) = q; }
}

struct Args { Params p; int ph_lo, ph_hi; };
typedef const __attribute__((address_space(4))) unsigned long long* KArgPtr;
__device__ __forceinline__ Params load_params(KArgPtr q) {
    asm volatile("" : "+s"(q));
    Params p;
    p.x = (const float*)(const GAS float*)q[0]; p.mem = (const float*)(const GAS float*)q[1]; p.pos = (const int*)(const GAS int*)q[2]; p.w_in = (const float*)(const GAS float*)q[3]; p.b_in = (const float*)(const GAS float*)q[4]; p.conv_w = (const float*)(const GAS float*)q[5]; p.conv_b = (const float*)(const GAS float*)q[6];
    p.conv_g = (const float*)(const GAS float*)q[7]; p.conv_bb = (const float*)(const GAS float*)q[8]; p.w_mem_kv = (const float*)(const GAS float*)q[9]; p.w_attn_o = (const float*)(const GAS float*)q[10]; p.w_conv_o = (const float*)(const GAS float*)q[11]; p.w_mem_o = (const float*)(const GAS float*)q[12];
    p.w_out = (const float*)(const GAS float*)q[13]; p.ln1_g = (const float*)(const GAS float*)q[14]; p.ln1_b = (const float*)(const GAS float*)q[15]; p.w_gr = (const float*)(const GAS float*)q[16]; p.b_gr = (const float*)(const GAS float*)q[17]; p.w_er = (const float*)(const GAS float*)q[18]; p.b_er = (const float*)(const GAS float*)q[19];
    p.w_eg = (const float*)(const GAS float*)q[20]; p.w_eu = (const float*)(const GAS float*)q[21]; p.w_ed = (const float*)(const GAS float*)q[22]; p.ln2_g = (const float*)(const GAS float*)q[23]; p.ln2_b = (const float*)(const GAS float*)q[24]; p.out = (float*)(GAS float*)q[25]; p.ws = (unsigned char*)(GAS unsigned char*)q[26];
    return p;
}
static_assert(sizeof(Params) == 27 * 8, "Params is 27 pointers");
constexpr int PH_P0 = 0, PH_CH0 = 1, PH_PER_CH = 5, PH_LN1 = PH_CH0 + PH_PER_CH * NCH, PH_MOE1 = PH_LN1 + 1, PH_MOE2 = PH_LN1 + 2, PH_LN2 = PH_LN1 + 3, PH_END = PH_LN1 + 4;

__global__ void __launch_bounds__(NTHR, 2) mk_fwd(Args args) {
    extern __shared__ __attribute__((aligned(16))) unsigned char lds_raw[];
    LAS unsigned char* lds = (LAS unsigned char*)lds_raw;
    const KArgPtr kargs = (KArgPtr)__builtin_amdgcn_kernarg_segment_ptr();
    const int wave = __builtin_amdgcn_readfirstlane((int)threadIdx.x >> 6);
    const int G = gridDim.x; const int bx = blockIdx.x; const int vcu = (G % 8 == 0) ? (bx % 8) * (G / 8) + bx / 8 : bx;
    volatile LAS unsigned* MISC = (volatile LAS unsigned*)(lds + LCTL_OFF);
    ClassTab* tab = (ClassTab*)(lds_raw + LCTL_OFF + 256);
    int* pan_cls = (int*)(lds_raw + LCTL_OFF + 512);
    int* toktab = (int*)(lds_raw + LTOK_OFF);
    for (int u = threadIdx.x; u < (LDS_BYTES - LCTL_OFF) / 4; u += NTHR) ((LAS unsigned*)(lds + LCTL_OFF))[u] = 0u;
    __syncthreads();
    const int lo = args.ph_lo, hi = args.ph_hi;
    unsigned* ctl; { const Params p = load_params(kargs); ctl = WSP(unsigned, WS_CTL); }
    XcdBarrier bar; bar.bar = ctl + CW_BAR; bar.x = 0; bar.st = nullptr;
    if (hi - lo > 1) bar = xcd_barrier_post(ctl + CW_BAR, MISC);
#ifndef PHMASK
#define PHMASK 0x3ff
#endif
#ifndef P1_QK_FP8
#define P1_QK_FP8 3
#endif
#if P1_QK_FP8 == 3
constexpr int P1_BF16_TILES = 4, P1_BF16_T0 = 18, P1_BF16_CUT = 4, P1_BF16_SKIP = 0, P1_FP8_TILES = 32, P1_FP8_T0 = 0, P1_FP8_CUT = 18, P1_FP8_SKIP = 4;
#elif P1_QK_FP8 == 2
constexpr int P1_BF16_TILES = 0, P1_BF16_T0 = 0, P1_BF16_CUT = 0, P1_BF16_SKIP = 0, P1_FP8_TILES = 36, P1_FP8_T0 = 0, P1_FP8_CUT = 36, P1_FP8_SKIP = 0;
#elif P1_QK_FP8
constexpr int P1_BF16_TILES = 6, P1_BF16_T0 = 18, P1_BF16_CUT = 6, P1_BF16_SKIP = 0, P1_FP8_TILES = 30, P1_FP8_T0 = 0, P1_FP8_CUT = 18, P1_FP8_SKIP = 6;
#else
constexpr int P1_BF16_TILES = 18, P1_BF16_T0 = 0, P1_BF16_CUT = 12, P1_BF16_SKIP = 6, P1_FP8_TILES = 18, P1_FP8_T0 = 12, P1_FP8_CUT = 6, P1_FP8_SKIP = 6;
#endif
#ifndef ATTN_V2
#define ATTN_V2 1
#endif
#ifndef PROBE_DUP
#define PROBE_DUP (-1)
#endif
#define NREP(b) ((PROBE_DUP == (b)) ? 2 : 1)
#define IN(k) (lo <= (k) && (k) < hi)
#define HAS(b) ((PHMASK >> (b)) & 1)
#define SEAM(k) do { if (IN(k) && IN((k) + 1)) xcd_barrier(bar); } while (0)

    if (HAS(0) && IN(PH_P0)) {
        const Params p = load_params(kargs);
        const size_t gtid = (size_t)bx * NTHR + opaque_tid(wave), gstride = (size_t)G * NTHR;
        for (int rep = 0; rep < NREP(0); ++rep) {
        { const int ptid = opaque_tid(wave); transpose_all(p, (float*)(lds_raw + RING_OFF) + (ptid >> 6) * (64 * 33), bx * NWAVES + (ptid >> 6), G * NWAVES, ptid & 63); }
        small_prep_dev(p, gtid, gstride);
        cvt_bf16_dev(p.mem, WSP(bf16_t, WS_MEMB), (size_t)NB * MEML * 1024 / 8, gtid, gstride);
        cvt_x_dev(p.x, WSP(bf16_t, WS_XB), p.ws + WS_XB8, (size_t)T * 1024 / 16, gtid, gstride);
        }
    }
    SEAM(PH_P0);
    if (PROBE_DUP == 10 && hi - lo > 1) for (int r = 0; r < 16; ++r) xcd_barrier(bar);

    for (int ch = 0; ch < NCH; ++ch) {
        const int ph0 = PH_CH0 + PH_PER_CH * ch;
        if (HAS(1) && IN(ph0)) {
            const Params p = load_params(kargs);
            const EpiMain em{WSP(float, WS_BIASP), p.pos, WSP(bf16_t, WS_QG), WSP(bf16_t, WS_CGLU), WSP(bf16_t, WS_QM), WSP(bf16_t, WS_GATES), ch * TC};
            for (int rep = 0; rep < NREP(1); ++rep) {
            {
                SchedMain S; S.to.init(TC / 256, P1_BF16_TILES, G, bx); S.nkv = ch == 0 ? (NB * MEML / 256) * 4 : 0; S.tile0 = P1_BF16_T0; S.cut = P1_BF16_CUT; S.skip = P1_BF16_SKIP; S.astep = 256 * 2048; S.bstep = 256 * 2048;
                S.XB = (const char*)(WSP(bf16_t, WS_XB) + (size_t)ch * TC * 1024); S.WIN = (const char*)WSP(bf16_t, WS_WIN); S.MEMB = (const char*)WSP(bf16_t, WS_MEMB); S.WKV = (const char*)WSP(bf16_t, WS_WKV);
                FastEpiMain E{em, EpiKV{WSP(bf16_t, WS_KM)}, 1.0f};
#ifndef NO_P1A
                pg8::gemm_phase<FastEpiMain, SchedMain, true, false, false>(lds + RING_OFF, nullptr, 1024, 1024, 1024, S, E, wave);
#endif
                if (PROBE_DUP == 16) { FastEpiStore E2{WSP(bf16_t, WS_MERGED), 1024, 1.0f}; pg8::gemm_phase<FastEpiStore, SchedMain, true, false, false>(lds + RING_OFF, nullptr, 1024, 1024, 1024, S, E2, wave); }
            }
            {
                SchedMain S; S.to.init(TC / 256, P1_FP8_TILES, G, bx); S.nkv = 0; S.tile0 = P1_FP8_T0; S.cut = P1_FP8_CUT; S.skip = P1_FP8_SKIP; S.astep = 256 * 1024; S.bstep = 256 * 1024;
                S.XB = (const char*)(p.ws + WS_XB8 + (size_t)ch * TC * 1024); S.WIN = (const char*)(p.ws + WS_WG8); S.MEMB = nullptr; S.WKV = nullptr;
                FastEpiMain E{em, EpiKV{WSP(bf16_t, WS_KM)}, 1.0f / WG8_SCALE};
#ifndef NO_P1B
                pg8::gemm_phase<FastEpiMain, SchedMain, true, false, false, true>(lds + RING_OFF, nullptr, 512, 512, 512, S, E, wave);
#endif
                if (PROBE_DUP == 17) { FastEpiStore E2{WSP(bf16_t, WS_MERGED), 1024, 1.0f}; pg8::gemm_phase<FastEpiStore, SchedMain, true, false, false, true>(lds + RING_OFF, nullptr, 512, 512, 512, S, E2, wave); }
            }
            }
        }
        SEAM(ph0);
        if (HAS(2) && IN(ph0 + 1)) {
            const Params p = load_params(kargs);
            constexpr int NDIL = BC * 12 * 8, NMEMB = BC * 4 * 8, NBLK = NDIL + NMEMB;
#if ATTN_V2
            for (int rep = 0; rep < NREP(2); ++rep) {
            const bool dummy = (PROBE_DUP == 2) && rep == 0;
            LAS char* rlds = (LAS char*)(lds + RING_OFF); LAS float* scr = (LAS float*)(lds + LTOK_OFF);
            for (int hd = vcu; hd < BC * 16; hd += G) {
                if (hd < BC * 12) { const int g = (hd % 12) >> 2; const size_t base = (size_t)hd * 2048 * 128;
                    swa::head_dilated(WSP(bf16_t, WS_QG) + base, dummy ? WSP(bf16_t, WS_MERGED) + (size_t)(hd & 127) * 2048 * 128 : WSP(bf16_t, WS_QG) + base, WSP(bf16_t, WS_KG) + base, WSP(bf16_t, WS_VG) + base, WSP(float, WS_LSE) + (size_t)hd * 2048, (2048 >> (2 * g)) - 1, rlds, scr, wave);
                } else { const int bh = hd - BC * 12, bl = bh >> 2, h = bh & 3; const size_t kvb = (size_t)(ch * BC * 4 + bh) * 256 * 128;
                    swa::head_mem(WSP(bf16_t, WS_QM) + (size_t)bh * 2048 * 128, WSP(bf16_t, WS_KM) + kvb, WSP(bf16_t, WS_VM) + kvb, WSP(bf16_t, WS_OMT) + (size_t)bl * 2048 * 512 + h * 128, 512, rlds, scr, wave); }
            }
            __syncthreads();
            }
            {
                const Params pc = load_params(kargs); const int ptid = opaque_tid(wave); volatile LAS unsigned* qslot = MISC + 4;
                for (;;) {
                    if (ptid == 0) *qslot = atomicAdd(ctl + CW_CONVQ + ch, 1u);
                    __syncthreads();
                    const int u = (int)*qslot;
                    if (u >= BC * 64) break;
                    conv_unit(pc, u, lds_raw + RING_OFF, ptid);
                }
            }
        }
#else
            for (int rep = 0; rep < NREP(2); ++rep) {
            const bool dummy = (PROBE_DUP == 2) && rep == 0;
            auto make_ref = [&](int L) -> swa::BlockRef {
                swa::BlockRef r;
                if (L < NDIL) { const int bgh = L >> 3, qb = L & 7, g = (bgh % 12) >> 2; const size_t base = (size_t)bgh * 2048 * 128;
                    r.Q = WSP(bf16_t, WS_QG) + base + (size_t)qb * 256 * 128; r.K = WSP(bf16_t, WS_KG) + base; r.V = WSP(bf16_t, WS_VG) + base; r.O = dummy ? WSP(bf16_t, WS_MERGED) + (base % (SZ_XB / 2 - 65536)) : (bf16_t*)r.Q;
                    r.LSE = WSP(float, WS_LSE) + (size_t)bgh * 2048 + qb * 256; r.P0 = qb * 256; r.W = 129; r.segmask = (2048 >> (2 * g)) - 1; r.skv = 2048; r.ostride = 128; }
                else { const int idx = L - NDIL, bh = idx >> 3, qb = idx & 7, bl = bh >> 2, h = bh & 3; const size_t kvb = (size_t)(ch * BC * 4 + bh) * 256 * 128;
                    r.Q = WSP(bf16_t, WS_QM) + ((size_t)bh * 2048 + qb * 256) * 128; r.K = WSP(bf16_t, WS_KM) + kvb; r.V = WSP(bf16_t, WS_VM) + kvb;
                    r.O = WSP(bf16_t, WS_OMT) + ((size_t)bl * 2048 + qb * 256) * 512 + h * 128; r.LSE = nullptr; r.P0 = 256; r.W = 1 << 20; r.segmask = (1 << 20) - 1; r.skv = 256; r.ostride = 512; }
                return r; };
            int L = vcu;
            if (L < NBLK) {
                swa::BlockRef cur = make_ref(L); swa::Seam Sm;
                swa::prime(cur, (char*)lds_raw + RING_OFF, Sm, wave);
                for (;;) {
                    const bool more = L + G < NBLK; const int Ln = more ? L + G : L;
                    const swa::BlockRef nxt = more ? make_ref(Ln) : cur;
                    swa::block(cur, nxt, (char*)lds_raw + RING_OFF, Sm, wave);
                    if (!more) break;
                    cur = nxt; L = Ln;
                }
            }
            __syncthreads();
            { const Params pc = load_params(kargs); const int ptid = opaque_tid(wave); for (int u = bx; u < BC * 64; u += G) conv_unit(pc, u, lds_raw + RING_OFF, ptid); }
            if (PROBE_DUP == 13) { const int ptid = opaque_tid(wave); for (int u = bx; u < BC * 64; u += G) conv_unit(p, u, lds_raw + RING_OFF, ptid); }
            if (PROBE_DUP == 14) {
                int L = NDIL + vcu;
                if (L < NBLK) { swa::BlockRef cur = make_ref(L); swa::Seam Sm; swa::prime(cur, (char*)lds_raw + RING_OFF, Sm, wave);
                    for (;;) { const bool more = L + G < NBLK; const int Ln = more ? L + G : L; const swa::BlockRef nxt = more ? make_ref(Ln) : cur; swa::block(cur, nxt, (char*)lds_raw + RING_OFF, Sm, wave); if (!more) break; cur = nxt; L = Ln; } }
                __syncthreads();
            }
            }
        }
#endif
        SEAM(ph0 + 1);
        if (HAS(3) && IN(ph0 + 2)) { const Params p = load_params(kargs); const int ptid = opaque_tid(wave); for (int rep = 0; rep < NREP(3); ++rep) for (int w = bx * NWAVES + (ptid >> 6); w < TC; w += G * NWAVES) combine_token(p, w, ptid & 63); }
        SEAM(ph0 + 2);
        if (HAS(4) && IN(ph0 + 3)) {
            const Params p = load_params(kargs);
            SchedMerge S; S.to.init(TC / 256, 4, G, bx); S.A0 = (const char*)WSP(bf16_t, WS_OATT); S.W = (const char*)WSP(bf16_t, WS_WA);
            FastEpiMerge E{WSP(bf16_t, WS_GATES), WSP(bf16_t, WS_MERGED)};
            if (PROBE_DUP == 15) { FastEpiStore E2{WSP(bf16_t, WS_MERGED), 1024, 1.0f}; pg8::gemm_phase<FastEpiStore, SchedMerge, true, false, false>(lds + RING_OFF, nullptr, 512, 512, 512, S, E2, wave); }
            for (int rep = 0; rep < NREP(4); ++rep) pg8::gemm_phase<FastEpiMerge, SchedMerge, true, false, false>(lds + RING_OFF, nullptr, 512, 512, 512, S, E, wave);
        }
        SEAM(ph0 + 3);
        if (HAS(5) && IN(ph0 + 4)) {
            const Params p = load_params(kargs);
            SchedPlain S; S.to.init(TC / 256, 4, G, bx); S.A = (const char*)WSP(bf16_t, WS_MERGED); S.B = (const char*)WSP(bf16_t, WS_WOUT); S.astep = 256 * 2048; S.bstep = 256 * 2048;
            FastEpiStore E{(bf16_t*)p.out + (size_t)ch * TC * 1024, 1024, 1.0f};
            for (int rep = 0; rep < NREP(5); ++rep) pg8::gemm_phase<FastEpiStore, SchedPlain, true, false, false>(lds + RING_OFF, nullptr, 1024, 1024, 1024, S, E, wave);
        }
        SEAM(ph0 + 4);
    }

    if (HAS(6) && IN(PH_LN1)) {
        const Params p = load_params(kargs);
        float* wr = (float*)(lds_raw + RING_OFF); int* cls_l = (int*)(wr + 20 * 1024); int* misc = cls_l + 64;
        for (int i = opaque_tid(wave); i < 20 * 1024; i += NTHR) wr[i] = WSP(float, WS_WRT)[i];
        __syncthreads();
        { const int ptid = opaque_tid(wave); for (int rep = 0; rep < NREP(6); ++rep) for (int u = bx; u < T / 64; u += G) ln1_unit(p, u, wr, cls_l, misc, ptid, (PROBE_DUP == 6) && rep == 0); }
    }
    SEAM(PH_LN1);
    if (IN(PH_MOE1) || IN(PH_MOE2) || IN(PH_LN2)) {
        const int tid = opaque_tid(wave);
        if (tid == 0) class_tab_fill(ctl + CW_CNT, tab);
        __syncthreads();
        const int NP = tab->rowbase[NCLS] >> 8;
        for (int pm = tid; pm < NP; pm += NTHR) pan_cls[pm] = find_class(tab, pm * 256);
        __syncthreads();
    }
    if (HAS(7) && IN(PH_MOE1)) {
        const Params p = load_params(kargs);
        const int NP = tab->rowbase[NCLS] >> 8;
        SchedMoe S; S.to.init(NP, 8, G, bx); S.pan_cls = (LAS const int*)(lds + LCTL_OFF + 512); S.toktab = (LAS const int*)(lds + LTOK_OFF); S.H = nullptr; S.W1 = (const char*)WSP(bf16_t, WS_W1); S.W2 = nullptr; S.mode = 1;
        const int tid = opaque_tid(wave);
        for (int i = 0; i < MAXU; ++i) { int pm, pn; if (!S.to.tile(i, pm, pn)) break;
            if (tid < 256) { const int cls = pan_cls[pm]; int r = pm * 256 + tid - tab->rowbase[cls]; if (r >= tab->cnt[cls]) r = tab->cnt[cls] - 1; toktab[i * 256 + tid] = WSP(int, WS_LIST)[(size_t)cls * T + r]; } }
        __syncthreads();
        FastEpiMoe1 E{(LAS const int*)(lds + LTOK_OFF), WSP(float, WS_WTS), p.ws + WS_H};
        for (int rep = 0; rep < NREP(7); ++rep) pg8::gemm_phase<FastEpiMoe1, SchedMoe, true, true, false, true>(lds + RING_OFF, (const char*)(p.ws + WS_X1B8), 512, 512, 512, S, E, wave);
    }
    SEAM(PH_MOE1);
    if (HAS(8) && IN(PH_MOE2)) {
        const Params p = load_params(kargs);
        const int NP = tab->rowbase[NCLS] >> 8;
        SchedMoe S; S.to.init(NP, 4, G, bx); S.pan_cls = (LAS const int*)(lds + LCTL_OFF + 512); S.toktab = (LAS const int*)(lds + LTOK_OFF); S.H = (const char*)WSP(bf16_t, WS_H); S.W1 = nullptr; S.W2 = (const char*)WSP(bf16_t, WS_W2); S.mode = 2;
        FastEpiStore E{WSP(bf16_t, WS_Y2), 1024, 1.0f / (H8_SCALE * W8_SCALE)};
        for (int rep = 0; rep < NREP(8); ++rep) pg8::gemm_phase<FastEpiStore, SchedMoe, true, false, true, true>(lds + RING_OFF, nullptr, 512, 4096, 512, S, E, wave);
    }
    SEAM(PH_MOE2);
    if (HAS(9) && IN(PH_LN2)) {
        const Params p = load_params(kargs);
        const int tot = tab->rowbase[NCLS]; const int lane = opaque_tid(wave) & 63;
        for (int rep = 0; rep < NREP(9); ++rep)
        for (int prow = bx * NWAVES + wave; prow < tot; prow += 2 * G * NWAVES) {
            int tk[2], pr[2];
#pragma unroll
            for (int r = 0; r < 2; ++r) { pr[r] = prow + r * G * NWAVES; tk[r] = -1;
                if (pr[r] < tot) { const int cls = pan_cls[pr[r] >> 8]; const int i = pr[r] - tab->rowbase[cls]; if (i < tab->cnt[cls]) tk[r] = WSP(int, WS_LIST)[(size_t)cls * T + i]; } }
            ln2_rows<2>(p, tk, pr, lane, ((PROBE_DUP == 9) && rep == 0) ? (float*)(p.ws + 512 * MiB) : nullptr);
        }
    }
#undef IN
#undef HAS
#undef SEAM
}

#ifndef MK_MODE
#define MK_MODE 3
#endif
extern "C" void kernel_launch(void* const* d_in, const int* in_sizes, int n_in, void* d_out, int out_size, void* d_ws, size_t ws_size, hipStream_t stream) {
    if (n_in != 25 || ws_size < WS_END) { fprintf(stderr, "kernel_launch: unexpected n_in %d / ws_size %zu (need %zu)\n", n_in, ws_size, (size_t)WS_END); return; }
    static int grid = 0;
    if (grid == 0) {
        (void)hipFuncSetAttribute((const void*)k_ln1, hipFuncAttributeMaxDynamicSharedMemorySize, 20 * 1024 * 4 + 1024);
        if (hipFuncSetAttribute((const void*)mk_fwd, hipFuncAttributeMaxDynamicSharedMemorySize, LDS_BYTES) != hipSuccess) fprintf(stderr, "kernel_launch: hipFuncSetAttribute(mk_fwd, %d) failed\n", LDS_BYTES);
        int dev = 0, cus = 0; (void)hipGetDevice(&dev);
        if (hipDeviceGetAttribute(&cus, hipDeviceAttributeMultiprocessorCount, dev) != hipSuccess || cus <= 0) cus = 256;
        int per_cu = 0; (void)hipOccupancyMaxActiveBlocksPerMultiprocessor(&per_cu, (const void*)mk_fwd, NTHR, LDS_BYTES);
        if (per_cu < 1) fprintf(stderr, "kernel_launch: occupancy query reports %d blocks per CU for mk_fwd\n", per_cu);
        (void)hipGetLastError();
        grid = cus;
    }
    Params p{};
    p.x = (const float*)d_in[0]; p.mem = (const float*)d_in[1]; p.pos = (const int*)d_in[2];
    p.w_in = (const float*)d_in[3]; p.b_in = (const float*)d_in[4]; p.conv_w = (const float*)d_in[5]; p.conv_b = (const float*)d_in[6];
    p.conv_g = (const float*)d_in[7]; p.conv_bb = (const float*)d_in[8]; p.w_mem_kv = (const float*)d_in[9]; p.w_attn_o = (const float*)d_in[10];
    p.w_conv_o = (const float*)d_in[11]; p.w_mem_o = (const float*)d_in[12]; p.w_out = (const float*)d_in[13]; p.ln1_g = (const float*)d_in[14]; p.ln1_b = (const float*)d_in[15];
    p.w_gr = (const float*)d_in[16]; p.b_gr = (const float*)d_in[17]; p.w_er = (const float*)d_in[18]; p.b_er = (const float*)d_in[19];
    p.w_eg = (const float*)d_in[20]; p.w_eu = (const float*)d_in[21]; p.w_ed = (const float*)d_in[22]; p.ln2_g = (const float*)d_in[23]; p.ln2_b = (const float*)d_in[24];
    p.out = (float*)d_out; p.ws = (unsigned char*)d_ws;
    (void)hipMemsetAsync((char*)d_ws + WS_CTL, 0, CTL_BYTES, stream);
#if PROBE_DUP == 12
    (void)hipMemsetAsync((char*)d_ws + 944 * MiB, 0, 64 * MiB, stream);
#endif
    auto mk = [&](int lo, int hi) { Args a{}; a.p = p; a.ph_lo = lo; a.ph_hi = hi; hipLaunchKernelGGL(mk_fwd, dim3(grid), dim3(NTHR), LDS_BYTES, stream, a); };
#if MK_MODE == 3
    mk(0, PH_END);
#elif MK_MODE == 2
    for (int ph = 0; ph < PH_END; ++ph) mk(ph, ph + 1);
#elif MK_MODE == 1
    mk(PH_P0, PH_P0 + 1);
    for (int ch = 0; ch < NCH; ++ch) {
        const int ph0 = PH_CH0 + PH_PER_CH * ch;
        mk(ph0, ph0 + 1);
        k_nattn_dil<<<BC * 12 * 2048 / 4, 256, 0, stream>>>(p);
        k_nattn_mem<<<BC * 4 * 2048 / 4, 256, 0, stream>>>(p, ch);
        k_conv<<<BC * 64, 512, 0, stream>>>(p);
        mk(ph0 + 2, ph0 + 3); mk(ph0 + 3, ph0 + 4); mk(ph0 + 4, ph0 + 5);
    }
    mk(PH_LN1, PH_LN1 + 1); mk(PH_MOE1, PH_MOE1 + 1); mk(PH_MOE2, PH_MOE2 + 1); mk(PH_LN2, PH_LN2 + 1);
#else
    for (int w = 0; w < 8; ++w) k_transpose_w<<<2048, 256, 0, stream>>>(p, w);
    k_small_prep<<<(20 * 1024 + 255) / 256, 256, 0, stream>>>(p);
    k_cvt_bf16<<<2048, 256, 0, stream>>>(p.mem, (bf16_t*)((char*)d_ws + WS_MEMB), (size_t)NB * MEML * 1024 / 8);
    k_cvt_bf16<<<4096, 256, 0, stream>>>(p.x, (bf16_t*)((char*)d_ws + WS_XB), (size_t)T * 1024 / 8);
    k_ngemm_kv<<<dim3(1024 / 64, NB * MEML / 64), 256, 0, stream>>>(p, 0);
    for (int ch = 0; ch < NCH; ++ch) {
        k_ngemm_main<<<dim3(INC / 64, TC / 64), 256, 0, stream>>>(p, ch);
        k_nattn_dil<<<BC * 12 * 2048 / 4, 256, 0, stream>>>(p);
        k_nattn_mem<<<BC * 4 * 2048 / 4, 256, 0, stream>>>(p, ch);
        k_conv<<<BC * 64, 512, 0, stream>>>(p);
        k_combine<<<TC / 4, 256, 0, stream>>>(p);
        for (int br = 0; br < 3; ++br) k_ngemm_merge<<<dim3(1024 / 64, TC / 64), 256, 0, stream>>>(p, br);
        k_ngemm_mix<<<dim3(1024 / 64, TC / 64), 256, 0, stream>>>(p, ch);
    }
    k_ln1<<<256, 512, 20 * 1024 * 4 + 1024, stream>>>(p);
    k_ngemm_moe1<<<dim3(2048 / 64, MPAD / 64), 256, 0, stream>>>(p);
    k_ngemm_moe2<<<dim3(1024 / 64, MPAD / 64), 256, 0, stream>>>(p);
    k_ln2<<<MPAD / 4, 256, 0, stream>>>(p);
#endif
}
```

```cpp
#include <hip/hip_runtime.h>
#include <cstdio>
#include <cstdint>

constexpr int D = 1024, NB = 32, S = 2048, T = NB * S;
constexpr int NCH = 2, BC = NB / NCH, TC = T / NCH;
constexpr int INC = 9216;
constexpr int MEML = 256;
constexpr int NCLS = 24;
constexpr int MPAD = T + NCLS * 256;
constexpr float LN_EPS = 1e-5f;
constexpr float DN_ALPHA = 1.189207115002721f;
constexpr float ATT_SCALE = 0.08838834764831845f;

constexpr int C_Q = 0, C_K = 1536, C_V = 3072, C_GLU = 4608, C_QM = 5632, C_GATE = 6144;

constexpr size_t MiB = 1ull << 20;
constexpr size_t WS_CTL = 0, CTL_BYTES = 1 * MiB;
constexpr size_t WS_WIN = 1 * MiB;
constexpr size_t WS_BIASP = 19 * MiB;
constexpr size_t WS_WRT = 19 * MiB + 64 * 1024;
constexpr size_t WS_WKV = 20 * MiB;
constexpr size_t WS_WA = 22 * MiB, WS_WC = 23 * MiB, WS_WM = 24 * MiB;
constexpr size_t WS_WOUT = 25 * MiB;
constexpr size_t WS_W1 = 27 * MiB;
constexpr size_t WS_W2 = 59 * MiB;
constexpr size_t WS_MEMB = 75 * MiB;
constexpr size_t WS_CH = 91 * MiB;
constexpr size_t SZ_XB = (size_t)TC * 1024 * 2, SZ_QKV1 = (size_t)TC * 1536 * 2, SZ_512 = (size_t)TC * 512 * 2;
constexpr size_t WS_XB = WS_CH;
constexpr size_t WS_QG = WS_XB + (size_t)T * 1024 * 2, WS_KG = WS_QG + SZ_QKV1, WS_VG = WS_KG + SZ_QKV1;
constexpr size_t WS_CGLU = WS_VG + SZ_QKV1, WS_QM = WS_CGLU + SZ_512, WS_OATT = WS_QM + SZ_512, WS_CCONV = WS_OATT + SZ_512, WS_OMT = WS_CCONV + SZ_512;
constexpr size_t WS_GATES = WS_OMT + SZ_512;
constexpr size_t SZ_KM = (size_t)NB * 4 * MEML * 128 * 2;
constexpr size_t WS_KM = WS_GATES + (size_t)TC * 3072 * 2, WS_VM = WS_KM + SZ_KM;
constexpr size_t WS_LSE = WS_VM + SZ_KM;
constexpr size_t WS_MERGED = WS_LSE + 2 * MiB;
constexpr size_t WS_CH_END = WS_MERGED + SZ_XB;
constexpr size_t WS_X1B = WS_CH;
constexpr size_t WS_H = WS_X1B + (size_t)T * 1024 * 2;
constexpr size_t WS_Y2 = WS_H + (size_t)MPAD * 1024 * 2;
constexpr size_t WS_LIST = WS_Y2 + (size_t)MPAD * 1024 * 2;
constexpr size_t WS_WTS = WS_LIST + (size_t)NCLS * T * 4;
constexpr size_t WS_X1B8 = WS_WTS + (size_t)T * 8;
constexpr size_t WS_MOE_END = WS_X1B8 + (size_t)T * 1024;
constexpr float W8_SCALE = 32.0f, H8_SCALE = 16.0f;
constexpr size_t WS_END = WS_CH_END > WS_MOE_END ? WS_CH_END : WS_MOE_END;
constexpr size_t WS_XB8 = 944 * MiB;
constexpr size_t WS_WG8 = 1008 * MiB;
constexpr float WG8_SCALE = 32.0f;
static_assert(WS_CH_END <= WS_XB8 && WS_WG8 + 9 * MiB <= 1024 * MiB, "fp8 operand buffers");
static_assert(WS_END <= 1024 * MiB, "workspace map exceeds 1 GiB");
constexpr int CW_CNT = 64;

typedef unsigned short bf16_t;
typedef float f32x4 __attribute__((ext_vector_type(4)));
typedef unsigned u32x4 __attribute__((ext_vector_type(4)));
typedef unsigned u32x2 __attribute__((ext_vector_type(2)));

__device__ __forceinline__ float bf2f(bf16_t b) { return __uint_as_float(((unsigned)b) << 16); }
__device__ __forceinline__ float bflo(unsigned w) { return __uint_as_float(w << 16); }
__device__ __forceinline__ float bfhi(unsigned w) { return __uint_as_float(w & 0xffff0000u); }
__device__ __forceinline__ unsigned f2bf(float f) { unsigned u = __float_as_uint(f); return (u + 0x7fffu + ((u >> 16) & 1u)) >> 16; }
typedef float f32x2_t __attribute__((ext_vector_type(2)));
typedef __bf16 bf16x2_t __attribute__((ext_vector_type(2)));
__device__ __forceinline__ unsigned pk2(float lo, float hi) { f32x2_t v = {lo, hi}; bf16x2_t b = __builtin_convertvector(v, bf16x2_t); return __builtin_bit_cast(unsigned, b); }
__device__ __forceinline__ float sigmoidf_(float x) { return __builtin_amdgcn_rcpf(1.0f + __builtin_amdgcn_exp2f(-1.4426950408889634f * x)); }
__device__ __forceinline__ float wave_sum(float v) {
#define DPP_F(x, ctrl) __int_as_float(__builtin_amdgcn_update_dpp(0, __float_as_int(x), ctrl, 0xf, 0xf, true))
    v += DPP_F(v, 0xB1);
    v += DPP_F(v, 0x4E);
    v += DPP_F(v, 0x141);
    v += DPP_F(v, 0x140);
#undef DPP_F
    const float r0 = __int_as_float(__builtin_amdgcn_readlane(__float_as_int(v), 0)), r1 = __int_as_float(__builtin_amdgcn_readlane(__float_as_int(v), 16));
    const float r2 = __int_as_float(__builtin_amdgcn_readlane(__float_as_int(v), 32)), r3 = __int_as_float(__builtin_amdgcn_readlane(__float_as_int(v), 48));
    return (r0 + r1) + (r2 + r3);
}
__device__ __forceinline__ float wave_max(float v) {
#pragma unroll
    for (int o = 1; o < 64; o <<= 1) v = fmaxf(v, __shfl_xor(v, o));
    return v;
}
__device__ __forceinline__ unsigned pk4_fp8(float a, float b, float c, float d) { unsigned w = 0; w = __builtin_amdgcn_cvt_pk_fp8_f32(a, b, w, false); w = __builtin_amdgcn_cvt_pk_fp8_f32(c, d, w, true); return w; }
__device__ __forceinline__ unsigned pk4_u8(float a, float b, float c, float d) {
    const unsigned ua = (unsigned)fmaxf(__builtin_rintf(a * 255.f), 1.f), ub = (unsigned)fmaxf(__builtin_rintf(b * 255.f), 1.f), uc = (unsigned)fmaxf(__builtin_rintf(c * 255.f), 1.f), ud = (unsigned)fmaxf(__builtin_rintf(d * 255.f), 1.f);
    return ua | (ub << 8) | (uc << 16) | (ud << 24); }
__device__ __forceinline__ float sig255(float x) { const float e = __builtin_amdgcn_exp2f(-1.4426950408889634f * x); return fmaxf(__builtin_rintf(__builtin_amdgcn_rcpf(__builtin_fmaf(e, 1.0f / 255.0f, 1.0f / 255.0f))), 1.0f); }
__device__ __forceinline__ unsigned pk4_sig_u8(float a, float b, float c, float d) { unsigned w = 0u;
    w = __builtin_amdgcn_cvt_pk_u8_f32(sig255(a), 0, w); w = __builtin_amdgcn_cvt_pk_u8_f32(sig255(b), 1, w); w = __builtin_amdgcn_cvt_pk_u8_f32(sig255(c), 2, w); w = __builtin_amdgcn_cvt_pk_u8_f32(sig255(d), 3, w); return w; }
__device__ __forceinline__ f32x4 u8x4_raw(unsigned w) { return (f32x4){(float)(w & 255u), (float)((w >> 8) & 255u), (float)((w >> 16) & 255u), (float)(w >> 24)}; }
__device__ __forceinline__ f32x4 u8x4_to_f32(unsigned w) { return (f32x4){(float)(w & 255u), (float)((w >> 8) & 255u), (float)((w >> 16) & 255u), (float)(w >> 24)} * (1.0f / 255.0f); }
__device__ __forceinline__ int opaque_tid(int wave_s) { unsigned z = 0u; asm volatile("" : "+v"(z)); const int l = (int)__builtin_amdgcn_mbcnt_hi(~0u, __builtin_amdgcn_mbcnt_lo(~0u, z)); return (wave_s << 6) | l; }
__device__ __forceinline__ void rope_cs(float pos, int j, float& c, float& s) {
    const float invrev = __builtin_amdgcn_exp2f(-(float)j * (13.287712379549449f / 64.0f)) * 0.15915494309189535f;
    float rev = pos * invrev; rev = __builtin_amdgcn_fractf(rev);
    s = __builtin_amdgcn_sinf(rev); c = __builtin_amdgcn_cosf(rev);
}
__device__ __forceinline__ int rowperm(int g, int s) { return g == 0 ? s : (g == 1 ? ((s & 3) * 512 + (s >> 2)) : ((s & 15) * 128 + (s >> 4))); }
__host__ __device__ __forceinline__ int win_logical(int n) {
    if (n < C_V) { const int sec = n / 1536, r = n % 1536, gh = r / 128, p = r % 128, G = p >> 3, nn = (p >> 2) & 1, e = p & 3; return sec * 1536 + gh * 128 + 64 * nn + 4 * G + e; }
    if (n < C_GLU) return n;
    if (n < C_QM) { const int cc = n - C_GLU, G = cc >> 3, nn = (cc >> 2) & 1, e = cc & 3; return C_GLU + nn * 512 + 4 * G + e; }
    return n;
}

struct Params {
    const float *x, *mem; const int* pos;
    const float *w_in, *b_in, *conv_w, *conv_b, *conv_g, *conv_bb, *w_mem_kv, *w_attn_o, *w_conv_o, *w_mem_o, *w_out, *ln1_g, *ln1_b;
    const float *w_gr, *b_gr, *w_er, *b_er, *w_eg, *w_eu, *w_ed, *ln2_g, *ln2_b;
    float* out; unsigned char* ws;
};
#define WSP(T_, off) ((T_*)(p.ws + (off)))

__global__ void k_cvt_bf16(const float* __restrict__ src, bf16_t* __restrict__ dst, size_t n8) {
    for (size_t i = (size_t)blockIdx.x * blockDim.x + threadIdx.x; i < n8; i += (size_t)gridDim.x * blockDim.x) {
        const f32x4 a = *(const f32x4*)(src + i * 8), b = *(const f32x4*)(src + i * 8 + 4);
        u32x4 o; o.x = pk2(a.x, a.y); o.y = pk2(a.z, a.w); o.z = pk2(b.x, b.y); o.w = pk2(b.z, b.w);
        *(u32x4*)(dst + i * 8) = o;
    }
}
enum { TW_IN = 0, TW_KV, TW_A, TW_C, TW_M, TW_OUT, TW_W1, TW_W2 };
__device__ __forceinline__ void transpose_w_dev(const Params& p, int which, size_t gtid, size_t gstride) {
    int K, N, ldd; bf16_t* dst;
    switch (which) {
        case TW_IN: K = 1024; N = INC; ldd = 1024; dst = WSP(bf16_t, WS_WIN); break;
        case TW_KV: K = 1024; N = 1024; ldd = 1024; dst = WSP(bf16_t, WS_WKV); break;
        case TW_A: K = 512; N = 1024; ldd = 512; dst = WSP(bf16_t, WS_WA); break;
        case TW_C: K = 512; N = 1024; ldd = 512; dst = WSP(bf16_t, WS_WC); break;
        case TW_M: K = 512; N = 1024; ldd = 512; dst = WSP(bf16_t, WS_WM); break;
        case TW_OUT: K = 1024; N = 1024; ldd = 1024; dst = WSP(bf16_t, WS_WOUT); break;
        case TW_W1: K = 1024; N = 16 * 1024; ldd = 1024; dst = WSP(bf16_t, WS_W1); break;
        default: K = 512; N = 16 * 1024; ldd = 8192; dst = WSP(bf16_t, WS_W2); break;
    }
    const size_t total = (size_t)N * (K / 8);
    for (size_t i = gtid; i < total; i += gstride) {
        const int n = (int)(i % N), k0 = (int)(i / N) * 8;
        float v[8];
#pragma unroll
        for (int j = 0; j < 8; ++j) {
            const int k = k0 + j; float s;
            switch (which) {
                case TW_IN: s = p.w_in[(size_t)k * INC + win_logical(n)]; break;
                case TW_KV: s = p.w_mem_kv[(size_t)k * 1024 + n]; break;
                case TW_A: s = p.w_attn_o[(size_t)k * 1024 + n]; break;
                case TW_C: s = p.w_conv_o[(size_t)k * 1024 + n]; break;
                case TW_M: s = p.w_mem_o[(size_t)k * 1024 + n]; break;
                case TW_OUT: s = p.w_out[(size_t)k * 1024 + n]; break;
                case TW_W1: { const int e = n >> 10, c = n & 1023, G = c >> 3, nn = (c >> 2) & 1, ee = c & 3, jj = 4 * G + ee;
                              s = (nn ? p.w_eu : p.w_eg)[((size_t)e * 1024 + k) * 512 + jj]; } break;
                default: { const int e = n >> 10, c = n & 1023; s = p.w_ed[((size_t)e * 512 + k) * 1024 + c]; } break;
            }
            v[j] = s;
        }
        u32x4 o; o.x = pk2(v[0], v[1]); o.y = pk2(v[2], v[3]); o.z = pk2(v[4], v[5]); o.w = pk2(v[6], v[7]);
        size_t doff;
        if (which == TW_W2) { const int e = n >> 10, c = n & 1023; doff = (size_t)c * 8192 + e * 512 + k0; }
        else doff = (size_t)n * ldd + k0;
        *(u32x4*)(dst + doff) = o;
    }
}
__global__ void k_transpose_w(Params p, int which) { transpose_w_dev(p, which, (size_t)blockIdx.x * blockDim.x + threadIdx.x, (size_t)gridDim.x * blockDim.x); }
__device__ __forceinline__ void small_prep_dev(const Params& p, size_t gtid, size_t gstride) {
    for (size_t ii = gtid; ii < 20 * 1024; ii += gstride) { const int i = (int)ii;
        if (i < INC) WSP(float, WS_BIASP)[i] = p.b_in[win_logical(i)];
        const int e = i >> 10, k = i & 1023;
        WSP(float, WS_WRT)[i] = e < 4 ? p.w_gr[k * 4 + e] : p.w_er[((size_t)((e - 4) >> 2) * 1024 + k) * 4 + ((e - 4) & 3)]; }
}
__global__ void k_small_prep(Params p) { small_prep_dev(p, (size_t)blockIdx.x * blockDim.x + threadIdx.x, (size_t)gridDim.x * blockDim.x); }

struct EpiMain {
    const float* biasp; const int* pos; bf16_t *QG, *CGLU, *QM, *GATES; int tok0;
    static __device__ __forceinline__ void rope_freqs(int c0, float (&invrev)[4]) {
        const int j0 = ((c0 & 127) >> 3) * 4;
#pragma unroll
        for (int e = 0; e < 4; ++e) invrev[e] = __builtin_amdgcn_exp2f(-(float)(j0 + e) * (13.287712379549449f / 64.0f)) * 0.15915494309189535f;
    }
    __device__ __forceinline__ void finish(int rl, int c0, float (&v)[8], float fpos, const float (&invrev)[4]) const {
        const int bl = rl >> 11, s = rl & 2047;
        const int tcol = __builtin_amdgcn_readfirstlane(c0 & ~255);
        if (tcol < C_GLU) {
            const int sec = tcol / 1536, r = c0 - sec * 1536, gh = r >> 7, pcol = r & 127, g = gh >> 2;
            if (sec < 2) {
#pragma unroll
                for (int e = 0; e < 4; ++e) { const float rev = __builtin_amdgcn_fractf(fpos * invrev[e]); const float sn = __builtin_amdgcn_sinf(rev), c = __builtin_amdgcn_cosf(rev);
                    const float t1 = v[e], t2 = v[4 + e]; v[e] = t1 * c - t2 * sn; v[4 + e] = t2 * c + t1 * sn; }
            }
            bf16_t* base = QG + (size_t)sec * (SZ_QKV1 / 2);
            u32x4 o; o.x = pk2(v[0], v[1]); o.y = pk2(v[2], v[3]); o.z = pk2(v[4], v[5]); o.w = pk2(v[6], v[7]);
            *(u32x4*)(base + ((size_t)(bl * 12 + gh) * 2048 + rowperm(g, s)) * 128 + pcol) = o;
        } else if (tcol < C_QM) {
            const int j0 = (c0 - C_GLU) >> 1;
            u32x2 o; o.x = pk2(v[0] * sigmoidf_(v[4]), v[1] * sigmoidf_(v[5])); o.y = pk2(v[2] * sigmoidf_(v[6]), v[3] * sigmoidf_(v[7]));
            *(u32x2*)(CGLU + (size_t)rl * 512 + j0) = o;
        } else if (tcol < C_GATE) {
            const int cc = c0 - C_QM, h = cc >> 7, pcol = cc & 127;
            u32x4 o; o.x = pk2(v[0], v[1]); o.y = pk2(v[2], v[3]); o.z = pk2(v[4], v[5]); o.w = pk2(v[6], v[7]);
            *(u32x4*)(QM + ((size_t)(bl * 4 + h) * 2048 + s) * 128 + pcol) = o;
        } else {
            const int cc = c0 - C_GATE;
            u32x2 o; o.x = pk4_sig_u8(v[0], v[1], v[2], v[3]); o.y = pk4_sig_u8(v[4], v[5], v[6], v[7]);
            *(u32x2*)((unsigned char*)GATES + (size_t)rl * 3072 + cc) = o;
        }
    }
    __device__ __forceinline__ void operator()(int rl, int c0, float (&v)[8]) const {
        const f32x4 b0 = *(const f32x4*)(biasp + c0), b1 = *(const f32x4*)(biasp + c0 + 4);
        v[0] += b0.x; v[1] += b0.y; v[2] += b0.z; v[3] += b0.w; v[4] += b1.x; v[5] += b1.y; v[6] += b1.z; v[7] += b1.w;
        float invrev[4]; rope_freqs(c0, invrev);
        finish(rl, c0, v, c0 < C_V ? (float)pos[tok0 + rl] : 0.f, invrev);
    }
};
struct EpiKV {
    bf16_t *KM;
    __device__ __forceinline__ void operator()(int row, int c0, float (&v)[8]) const {
        const int bl = row >> 8, m = row & 255, isv = c0 >> 9, cc = c0 & 511, h = cc >> 7, pcol = cc & 127;
        u32x4 o; o.x = pk2(v[0], v[1]); o.y = pk2(v[2], v[3]); o.z = pk2(v[4], v[5]); o.w = pk2(v[6], v[7]);
        *(u32x4*)(KM + (size_t)isv * (SZ_KM / 2) + ((size_t)(bl * 4 + h) * 256 + m) * 128 + pcol) = o;
    }
};
struct EpiMerge {
    const bf16_t* GATES; bf16_t* MERGED; int br;
    __device__ __forceinline__ void operator()(int rl, int c0, float (&v)[8]) const {
        const u32x2 g = *(const u32x2*)((const unsigned char*)GATES + (size_t)rl * 3072 + br * 1024 + c0);
        const f32x4 g0 = u8x4_to_f32(g.x), g1 = u8x4_to_f32(g.y);
        float r[8] = {g0.x * v[0], g0.y * v[1], g0.z * v[2], g0.w * v[3], g1.x * v[4], g1.y * v[5], g1.z * v[6], g1.w * v[7]};
        bf16_t* mp = MERGED + (size_t)rl * 1024 + c0;
        if (br > 0) { const u32x4 m = *(const u32x4*)mp; r[0] += bflo(m.x); r[1] += bfhi(m.x); r[2] += bflo(m.y); r[3] += bfhi(m.y); r[4] += bflo(m.z); r[5] += bfhi(m.z); r[6] += bflo(m.w); r[7] += bfhi(m.w); }
        u32x4 o; o.x = pk2(r[0], r[1]); o.y = pk2(r[2], r[3]); o.z = pk2(r[4], r[5]); o.w = pk2(r[6], r[7]);
        *(u32x4*)mp = o;
    }
};
struct EpiMix {
    bf16_t* MIX; int tok0;
    __device__ __forceinline__ void operator()(int rl, int c0, float (&v)[8]) const {
        u32x4 o; o.x = pk2(v[0], v[1]); o.y = pk2(v[2], v[3]); o.z = pk2(v[4], v[5]); o.w = pk2(v[6], v[7]);
        *(u32x4*)(MIX + (size_t)(tok0 + rl) * 1024 + c0) = o;
    }
};
struct ClassTab { int cnt[NCLS], rowbase[NCLS + 1]; };
__device__ __forceinline__ void class_tab_fill(const unsigned* cntw, ClassTab* t) {
    int acc = 0;
    for (int c = 0; c < NCLS; ++c) { const int n = (int)cntw[c]; t->cnt[c] = n; t->rowbase[c] = acc; acc += ((n + 255) >> 8) << 8; }
    t->rowbase[NCLS] = acc;
}
__device__ __forceinline__ void class_experts(int cls, int& e_lo, int& e_hi) {
    const int g = cls / 6, pi = cls - g * 6;
    const int lo = pi < 3 ? 0 : (pi < 5 ? 1 : 2), hi = pi < 3 ? pi + 1 : (pi < 5 ? pi - 1 : 3);
    e_lo = g * 4 + lo; e_hi = g * 4 + hi;
}
struct EpiMoe1 {
    const int* list; const float* wts; bf16_t* H; int cls, cnt, rowbase;
    __device__ __forceinline__ void operator()(int prow, int c0, float (&v)[8]) const {
        int i = prow - rowbase; if (i >= cnt) i = cnt - 1;
        const int tok = list[i]; const int hi = c0 >> 10; const float w = wts[(size_t)tok * 2 + hi];
        const int j0 = hi * 512 + ((c0 & 1023) >> 1);
        float r[4];
#pragma unroll
        for (int e = 0; e < 4; ++e) { const float gt = v[e]; r[e] = gt * sigmoidf_(gt) * v[4 + e] * w; }
        u32x2 o; o.x = pk2(r[0], r[1]); o.y = pk2(r[2], r[3]);
        *(u32x2*)(H + (size_t)prow * 1024 + j0) = o;
    }
};
struct EpiMoe2 {
    bf16_t* Y2;
    __device__ __forceinline__ void operator()(int prow, int c0, float (&v)[8]) const {
        u32x4 o; o.x = pk2(v[0], v[1]); o.y = pk2(v[2], v[3]); o.z = pk2(v[4], v[5]); o.w = pk2(v[6], v[7]);
        *(u32x4*)(Y2 + (size_t)prow * 1024 + c0) = o;
    }
};

struct RowsPlain { const bf16_t* base; int ld; __device__ __forceinline__ const bf16_t* operator()(int r) const { return base + (size_t)r * ld; } };
template <class AF, class BF, class EF>
__device__ __forceinline__ void ngemm_tile(int row0, int col0, int K, const AF& af, const BF& bf, const EF& ef, int bkseg, long bjump) {
    __shared__ float As[64][33], Bs[64][33];
    const int tid = threadIdx.x, ty = tid >> 3, tx = tid & 7;
    float acc[2][8];
#pragma unroll
    for (int i = 0; i < 2; ++i)
#pragma unroll
        for (int j = 0; j < 8; ++j) acc[i][j] = 0.f;
    const int lr = tid >> 2, lk = (tid & 3) * 8;
    const bf16_t* ap = af(row0 + lr); const bf16_t* bp = bf(col0 + lr);
    for (int k0 = 0; k0 < K; k0 += 32) {
        const u32x4 a = *(const u32x4*)(ap + k0 + lk);
        const long bo = (long)k0 + lk + (long)(k0 / bkseg) * bjump;
        const u32x4 b = *(const u32x4*)(bp + bo);
        __syncthreads();
        As[lr][lk + 0] = bflo(a.x); As[lr][lk + 1] = bfhi(a.x); As[lr][lk + 2] = bflo(a.y); As[lr][lk + 3] = bfhi(a.y);
        As[lr][lk + 4] = bflo(a.z); As[lr][lk + 5] = bfhi(a.z); As[lr][lk + 6] = bflo(a.w); As[lr][lk + 7] = bfhi(a.w);
        Bs[lr][lk + 0] = bflo(b.x); Bs[lr][lk + 1] = bfhi(b.x); Bs[lr][lk + 2] = bflo(b.y); Bs[lr][lk + 3] = bfhi(b.y);
        Bs[lr][lk + 4] = bflo(b.z); Bs[lr][lk + 5] = bfhi(b.z); Bs[lr][lk + 6] = bflo(b.w); Bs[lr][lk + 7] = bfhi(b.w);
        __syncthreads();
#pragma unroll 8
        for (int kk = 0; kk < 32; ++kk) {
            const float a0 = As[2 * ty][kk], a1 = As[2 * ty + 1][kk];
#pragma unroll
            for (int j = 0; j < 8; ++j) { const float bv = Bs[8 * tx + j][kk]; acc[0][j] += a0 * bv; acc[1][j] += a1 * bv; }
        }
    }
    ef(row0 + 2 * ty, col0 + 8 * tx, acc[0]);
    ef(row0 + 2 * ty + 1, col0 + 8 * tx, acc[1]);
}
__global__ void __launch_bounds__(256) k_ngemm_main(Params p, int ch) {
    const int tok0 = ch * TC;
    EpiMain E{WSP(float, WS_BIASP), p.pos, WSP(bf16_t, WS_QG), WSP(bf16_t, WS_CGLU), WSP(bf16_t, WS_QM), WSP(bf16_t, WS_GATES), tok0};
    RowsPlain A{WSP(bf16_t, WS_XB) + (size_t)ch * TC * 1024, 1024}, Bm{WSP(bf16_t, WS_WIN), 1024};
    ngemm_tile(blockIdx.y * 64, blockIdx.x * 64, 1024, A, Bm, E, 1 << 30, 0);
}
__global__ void __launch_bounds__(256) k_ngemm_kv(Params p, int ch) {
    EpiKV E{WSP(bf16_t, WS_KM)};
    RowsPlain A{WSP(bf16_t, WS_MEMB), 1024}, Bm{WSP(bf16_t, WS_WKV), 1024};
    ngemm_tile(blockIdx.y * 64, blockIdx.x * 64, 1024, A, Bm, E, 1 << 30, 0);
}
__global__ void __launch_bounds__(256) k_ngemm_merge(Params p, int br) {
    EpiMerge E{WSP(bf16_t, WS_GATES), WSP(bf16_t, WS_MERGED), br};
    RowsPlain A{WSP(bf16_t, WS_OATT + (size_t)br * SZ_512), 512};
    RowsPlain Bm{WSP(bf16_t, WS_WA + (size_t)br * MiB), 512};
    ngemm_tile(blockIdx.y * 64, blockIdx.x * 64, 512, A, Bm, E, 1 << 30, 0);
}
__global__ void __launch_bounds__(256) k_ngemm_mix(Params p, int ch) {
    EpiMix E{(bf16_t*)p.out, ch * TC};
    RowsPlain A{WSP(bf16_t, WS_MERGED), 1024}, Bm{WSP(bf16_t, WS_WOUT), 1024};
    ngemm_tile(blockIdx.y * 64, blockIdx.x * 64, 1024, A, Bm, E, 1 << 30, 0);
}
struct RowsGather { const bf16_t* base; const int* list; int cnt, rowbase; __device__ __forceinline__ const bf16_t* operator()(int prow) const { int i = prow - rowbase; if (i >= cnt) i = cnt - 1; return base + (size_t)list[i] * 1024; } };
__device__ __forceinline__ int find_class(const ClassTab* t, int prow) { int c = 0;
    for (int i = 1; i < NCLS; ++i) if (prow >= t->rowbase[i]) c = i;
    return c; }
__global__ void __launch_bounds__(256) k_ngemm_moe1(Params p) {
    __shared__ ClassTab tabs; if (threadIdx.x == 0) class_tab_fill(WSP(unsigned, WS_CTL) + CW_CNT, &tabs); __syncthreads(); const ClassTab* tab = &tabs;
    const int row0 = blockIdx.y * 64; if (row0 >= tab->rowbase[NCLS]) return;
    const int cls = find_class(tab, row0); if (tab->cnt[cls] == 0) return;
    int e_lo, e_hi; class_experts(cls, e_lo, e_hi);
    const int col0 = blockIdx.x * 64, hi = col0 >> 10;
    const int* list = WSP(int, WS_LIST) + (size_t)cls * T;
    RowsGather A{WSP(bf16_t, WS_X1B), list, tab->cnt[cls], tab->rowbase[cls]};
    RowsPlain Bm{WSP(bf16_t, WS_W1) + ((size_t)(hi ? e_hi : e_lo) * 1024 - (size_t)hi * 1024) * 1024, 1024};
    EpiMoe1 E{list, WSP(float, WS_WTS), WSP(bf16_t, WS_H), cls, tab->cnt[cls], tab->rowbase[cls]};
    ngemm_tile(row0, col0, 1024, A, Bm, E, 1 << 30, 0);
}
__global__ void __launch_bounds__(256) k_ngemm_moe2(Params p) {
    __shared__ ClassTab tabs; if (threadIdx.x == 0) class_tab_fill(WSP(unsigned, WS_CTL) + CW_CNT, &tabs); __syncthreads(); const ClassTab* tab = &tabs;
    const int row0 = blockIdx.y * 64; if (row0 >= tab->rowbase[NCLS]) return;
    const int cls = find_class(tab, row0); if (tab->cnt[cls] == 0) return;
    int e_lo, e_hi; class_experts(cls, e_lo, e_hi);
    RowsPlain A{WSP(bf16_t, WS_H), 1024};
    RowsPlain Bm{WSP(bf16_t, WS_W2) + (size_t)e_lo * 512, 8192};
    EpiMoe2 E{WSP(bf16_t, WS_Y2)};
    ngemm_tile(row0, blockIdx.x * 64, 1024, A, Bm, E, 512, (long)(e_hi - e_lo - 1) * 512);
}

__device__ __forceinline__ void nattn_row(const bf16_t* qp, const bf16_t* kbase, const bf16_t* vbase, int nkeys, bf16_t* op, float* lsep, int lane) {
    const unsigned qw = *(const unsigned*)(qp + 2 * lane); const float q0 = bflo(qw), q1 = bfhi(qw);
    float sc[4] = {-INFINITY, -INFINITY, -INFINITY, -INFINITY};
#pragma unroll
    for (int kb = 0; kb < 4; ++kb) {
        for (int kk = 0; kk < 64; ++kk) { const int k = kb * 64 + kk; if (k >= nkeys) break;
            const unsigned kw = *(const unsigned*)(kbase + (size_t)k * 128 + 2 * lane);
            const float s = wave_sum(q0 * bflo(kw) + q1 * bfhi(kw)) * ATT_SCALE;
            if (lane == kk) sc[kb] = s; }
    }
    const float m = wave_max(fmaxf(fmaxf(sc[0], sc[1]), fmaxf(sc[2], sc[3])));
    float pr[4]; float ps = 0.f;
#pragma unroll
    for (int kb = 0; kb < 4; ++kb) { pr[kb] = __expf(sc[kb] - m); ps += pr[kb]; }
    const float l = wave_sum(ps);
    float a0 = 0.f, a1 = 0.f;
#pragma unroll
    for (int kb = 0; kb < 4; ++kb) {
        for (int kk = 0; kk < 64; ++kk) { const int k = kb * 64 + kk; if (k >= nkeys) break;
            const float pk = __shfl(pr[kb], kk);
            const unsigned vw = *(const unsigned*)(vbase + (size_t)k * 128 + 2 * lane);
            a0 += pk * bflo(vw); a1 += pk * bfhi(vw); }
    }
    const float inv = 1.0f / l;
    *(unsigned*)(op + 2 * lane) = pk2(a0 * inv, a1 * inv);
    if (lsep && lane == 0) *lsep = m + __logf(l);
}
__global__ void __launch_bounds__(256) k_nattn_dil(Params p) {
    const int lane = threadIdx.x & 63; const size_t w = (size_t)blockIdx.x * 4 + (threadIdx.x >> 6);
    if (w >= (size_t)BC * 12 * 2048) return;
    const int row = (int)(w & 2047); const int bgh = (int)(w >> 11); const int g = (bgh % 12) >> 2;
    const int seglen = 2048 >> (2 * g); const int pin = row & (seglen - 1); const int nk = pin + 1 < 129 ? pin + 1 : 129;
    bf16_t* Q = WSP(bf16_t, WS_QG) + ((size_t)bgh * 2048 + row) * 128;
    const bf16_t* K = WSP(bf16_t, WS_KG) + ((size_t)bgh * 2048 + row - nk + 1) * 128;
    const bf16_t* V = WSP(bf16_t, WS_VG) + ((size_t)bgh * 2048 + row - nk + 1) * 128;
    nattn_row(Q, K, V, nk, Q, WSP(float, WS_LSE) + (size_t)bgh * 2048 + row, lane);
}
__global__ void __launch_bounds__(256) k_nattn_mem(Params p, int ch) {
    const int lane = threadIdx.x & 63; const size_t w = (size_t)blockIdx.x * 4 + (threadIdx.x >> 6);
    if (w >= (size_t)BC * 4 * 2048) return;
    const int s = (int)(w & 2047); const int bh = (int)(w >> 11); const int bl = bh >> 2, h = bh & 3;
    const bf16_t* Q = WSP(bf16_t, WS_QM) + ((size_t)bh * 2048 + s) * 128;
    const bf16_t* K = WSP(bf16_t, WS_KM) + (size_t)(ch * BC * 4 + bh) * 256 * 128;
    const bf16_t* V = WSP(bf16_t, WS_VM) + (size_t)(ch * BC * 4 + bh) * 256 * 128;
    nattn_row(Q, K, V, 256, WSP(bf16_t, WS_OMT) + ((size_t)(bl * 2048 + s)) * 512 + h * 128, nullptr, lane);
}

__device__ __forceinline__ void combine_token(const Params& p, int rl, int lane) {
    const int bl = rl >> 11, s = rl & 2047, h = lane >> 4, d0 = (lane & 15) * 8;
    float ls[3]; u32x4 o[3];
#pragma unroll
    for (int g = 0; g < 3; ++g) { const size_t r = (size_t)(bl * 12 + g * 4 + h) * 2048 + rowperm(g, s);
        ls[g] = WSP(float, WS_LSE)[r]; o[g] = *(const u32x4*)(WSP(bf16_t, WS_QG) + r * 128 + d0); }
    const float m = fmaxf(ls[0], fmaxf(ls[1], ls[2]));
    float w0 = __expf(ls[0] - m), w1 = __expf(ls[1] - m), w2 = __expf(ls[2] - m); const float inv = 1.0f / (w0 + w1 + w2); w0 *= inv; w1 *= inv; w2 *= inv;
    u32x4 r;
    r.x = pk2(w0 * bflo(o[0].x) + w1 * bflo(o[1].x) + w2 * bflo(o[2].x), w0 * bfhi(o[0].x) + w1 * bfhi(o[1].x) + w2 * bfhi(o[2].x));
    r.y = pk2(w0 * bflo(o[0].y) + w1 * bflo(o[1].y) + w2 * bflo(o[2].y), w0 * bfhi(o[0].y) + w1 * bfhi(o[1].y) + w2 * bfhi(o[2].y));
    r.z = pk2(w0 * bflo(o[0].z) + w1 * bflo(o[1].z) + w2 * bflo(o[2].z), w0 * bfhi(o[0].z) + w1 * bfhi(o[1].z) + w2 * bfhi(o[2].z));
    r.w = pk2(w0 * bflo(o[0].w) + w1 * bflo(o[1].w) + w2 * bflo(o[2].w), w0 * bfhi(o[0].w) + w1 * bfhi(o[1].w) + w2 * bfhi(o[2].w));
    *(u32x4*)(WSP(bf16_t, WS_OATT) + (size_t)rl * 512 + h * 128 + d0) = r;
}
__global__ void __launch_bounds__(256) k_combine(Params p) {
    const int lane = threadIdx.x & 63; const int w = blockIdx.x * 4 + (threadIdx.x >> 6);
    if (w < TC) combine_token(p, w, lane);
}
constexpr int CONV_TILE = 62 * 1024, CONV_OUT = 32 * 1024, CONV_LDS = CONV_TILE + CONV_OUT + (8 * 32 + 64) * 4;
__device__ __forceinline__ void conv_unit(const Params& p, int u, unsigned char* lds, int tid_) {
    const int ch = tid_, lane = ch & 63, wv = ch >> 6;
    const int bl = u >> 6, s0 = (u & 63) * 32;
    bf16_t* tile = (bf16_t*)lds; bf16_t* otile = (bf16_t*)(lds + CONV_TILE); float* red = (float*)(lds + CONV_TILE + CONV_OUT);
    const bf16_t* cg = WSP(bf16_t, WS_CGLU) + (size_t)bl * 2048 * 512;
#pragma unroll
    for (int it = 0; it < 8; ++it) { const int c = it * 512 + ch; if (c < 62 * 64) { const int r = c >> 6, q = c & 63, s = s0 - 30 + r;
        u32x4 v = {0u, 0u, 0u, 0u}; if (s >= 0) v = *(const u32x4*)(cg + (size_t)s * 512 + q * 8);
        *(u32x4*)(tile + r * 512 + q * 8) = v; } }
    __syncthreads();
    float o[32]; const float cb = p.conv_b[ch];
#pragma unroll
    for (int i = 0; i < 32; ++i) o[i] = cb;
    {   float in[62];
#pragma unroll
        for (int i = 0; i < 62; ++i) in[i] = bf2f(tile[i * 512 + ch]);
#pragma unroll
        for (int j = 0; j < 31; ++j) { const float w = p.conv_w[j * 512 + ch];
#pragma unroll
            for (int i = 0; i < 32; ++i) o[i] += w * in[i + j]; } }
    float* mean = red + 256; float* rstd = red + 288;
#pragma unroll
    for (int i = 0; i < 32; ++i) { const float sr = wave_sum(o[i]); if (lane == 0) red[wv * 32 + i] = sr; }
    __syncthreads();
    if (ch < 32) { float sm = 0.f;
#pragma unroll
        for (int w = 0; w < 8; ++w) sm += red[w * 32 + ch];
        mean[ch] = sm * (1.0f / 512.0f); }
    __syncthreads();
#pragma unroll
    for (int i = 0; i < 32; ++i) { o[i] -= mean[i]; const float sr = wave_sum(o[i] * o[i]); if (lane == 0) red[wv * 32 + i] = sr; }
    __syncthreads();
    if (ch < 32) { float sm = 0.f;
#pragma unroll
        for (int w = 0; w < 8; ++w) sm += red[w * 32 + ch];
        rstd[ch] = 1.0f / sqrtf(sm * (1.0f / 512.0f) + LN_EPS); }
    __syncthreads();
    const float gg = p.conv_g[ch], bb = p.conv_bb[ch];
#pragma unroll
    for (int i = 0; i < 32; ++i) { const float y = o[i] * rstd[i] * gg + bb; otile[i * 512 + ch] = (bf16_t)f2bf(y * sigmoidf_(y)); }
    __syncthreads();
    bf16_t* outp = WSP(bf16_t, WS_CCONV) + ((size_t)bl * 2048 + s0) * 512;
#pragma unroll
    for (int it = 0; it < 4; ++it) { const int c = it * 512 + ch; *(u32x4*)(outp + (size_t)c * 8) = *(const u32x4*)(otile + c * 8); }
    __syncthreads();
}
__global__ void __launch_bounds__(512) k_conv(Params p) {
    __shared__ __attribute__((aligned(16))) unsigned char cl[CONV_LDS];
    conv_unit(p, blockIdx.x, cl, threadIdx.x);
}
__device__ __forceinline__ void ln1_unit(const Params& p, int u, const float* wr, int* cls_l, int* misc, int tid_, bool dummy = false) {
    const int tid = tid_, lane = tid & 63, wv = tid >> 6;
    float gam[16], bet[16];
#pragma unroll
    for (int j = 0; j < 4; ++j) { const f32x4 g4 = *(const f32x4*)(p.ln1_g + 4 * lane + 256 * j), b4 = *(const f32x4*)(p.ln1_b + 4 * lane + 256 * j);
        gam[4 * j] = g4.x; gam[4 * j + 1] = g4.y; gam[4 * j + 2] = g4.z; gam[4 * j + 3] = g4.w; bet[4 * j] = b4.x; bet[4 * j + 1] = b4.y; bet[4 * j + 2] = b4.z; bet[4 * j + 3] = b4.w; }
    const int tok0 = u * 64 + wv * 8;
    u32x2 xq[2][4]; u32x2 mq[2][4];
#define LN1_LOAD(slot, rr) do { const bf16_t* xr_ = WSP(bf16_t, WS_XB) + (size_t)(tok0 + (rr)) * 1024 + 4 * lane; const bf16_t* mr_ = (const bf16_t*)p.out + (size_t)(tok0 + (rr)) * 1024 + 4 * lane; \
        _Pragma("unroll") for (int j = 0; j < 4; ++j) { xq[slot][j] = *(const u32x2*)(xr_ + 256 * j); mq[slot][j] = *(const u32x2*)(mr_ + 256 * j); } } while (0)
    LN1_LOAD(0, 0);
#pragma unroll
    for (int rr = 0; rr < 8; ++rr) {
        const int lr = wv * 8 + rr; const int tok = tok0 + rr;
        if (rr + 1 < 8) { if (rr & 1) LN1_LOAD(0, rr + 1); else LN1_LOAD(1, rr + 1); }
        float v[16]; float sm = 0.f;
#pragma unroll
        for (int j = 0; j < 4; ++j) { const u32x2 t = xq[rr & 1][j]; const u32x2 mm = mq[rr & 1][j];
            v[4 * j] = DN_ALPHA * bflo(t.x) + bflo(mm.x); v[4 * j + 1] = DN_ALPHA * bfhi(t.x) + bfhi(mm.x); v[4 * j + 2] = DN_ALPHA * bflo(t.y) + bflo(mm.y); v[4 * j + 3] = DN_ALPHA * bfhi(t.y) + bfhi(mm.y);
            sm += (v[4 * j] + v[4 * j + 1]) + (v[4 * j + 2] + v[4 * j + 3]); }
        const float mean = wave_sum(sm) * (1.0f / 1024.0f); float sq = 0.f;
#pragma unroll
        for (int i = 0; i < 16; ++i) { v[i] -= mean; sq += v[i] * v[i]; }
        const float rstd = 1.0f / sqrtf(wave_sum(sq) * (1.0f / 1024.0f) + LN_EPS);
#pragma unroll
        for (int i = 0; i < 16; ++i) v[i] = v[i] * rstd * gam[i] + bet[i];
        bf16_t* xb = WSP(bf16_t, dummy ? WS_H : WS_X1B) + (size_t)tok * 1024;
#pragma unroll
        for (int j = 0; j < 4; ++j) { u32x2 o; o.x = pk2(v[4 * j], v[4 * j + 1]); o.y = pk2(v[4 * j + 2], v[4 * j + 3]); *(u32x2*)(xb + 4 * lane + 256 * j) = o; }
        if (!dummy) { unsigned char* x8 = p.ws + WS_X1B8 + (size_t)tok * 1024;
#pragma unroll
            for (int j = 0; j < 4; ++j) *(unsigned*)(x8 + 4 * lane + 256 * j) = pk4_fp8(v[4 * j], v[4 * j + 1], v[4 * j + 2], v[4 * j + 3]); }
        float gl[4];
#pragma unroll
        for (int e = 0; e < 4; ++e) { float a = 0.f;
#pragma unroll
            for (int j = 0; j < 4; ++j) { const f32x4 w4 = *(const f32x4*)(wr + e * 1024 + 4 * lane + 256 * j); a += v[4 * j] * w4.x + v[4 * j + 1] * w4.y + v[4 * j + 2] * w4.z + v[4 * j + 3] * w4.w; }
            gl[e] = wave_sum(a) + p.b_gr[e]; }
        int gs = 0; float gm = gl[0];
#pragma unroll
        for (int e = 1; e < 4; ++e) if (gl[e] > gm) { gm = gl[e]; gs = e; }
        float gsum = 0.f;
#pragma unroll
        for (int e = 0; e < 4; ++e) gsum += __expf(gl[e] - gm);
        const float gprob = 1.0f / gsum;
        gs = __builtin_amdgcn_readfirstlane(gs);
        float el[4];
#pragma unroll
        for (int e = 0; e < 4; ++e) { float a = 0.f; const float* wp = wr + (4 + gs * 4 + e) * 1024;
#pragma unroll
            for (int j = 0; j < 4; ++j) { const f32x4 w4 = *(const f32x4*)(wp + 4 * lane + 256 * j); a += v[4 * j] * w4.x + v[4 * j + 1] * w4.y + v[4 * j + 2] * w4.z + v[4 * j + 3] * w4.w; }
            el[e] = wave_sum(a) + p.b_er[gs * 4 + e]; }
        int i1 = 0; float v1 = el[0];
#pragma unroll
        for (int e = 1; e < 4; ++e) if (el[e] > v1) { v1 = el[e]; i1 = e; }
        int i2 = -1; float v2 = -INFINITY;
#pragma unroll
        for (int e = 0; e < 4; ++e) if (e != i1 && el[e] > v2) { v2 = el[e]; i2 = e; }
        const float t2 = __expf(v2 - v1); const float w1 = gprob / (1.0f + t2), w2 = gprob * t2 / (1.0f + t2);
        const int lo = i1 < i2 ? i1 : i2, hi = i1 < i2 ? i2 : i1;
        const int pi = lo == 0 ? hi - 1 : (lo == 1 ? hi + 1 : 5);
        if (lane == 0 && !dummy) { cls_l[lr] = gs * 6 + pi; float* wt = WSP(float, WS_WTS) + (size_t)tok * 2; wt[0] = (i1 == lo) ? w1 : w2; wt[1] = (i1 == lo) ? w2 : w1; }
    }
#undef LN1_LOAD
    __syncthreads();
    if (dummy) return;
    if (tid < NCLS) { int n = 0; for (int r = 0; r < 64; ++r) n += (cls_l[r] == tid); misc[tid] = n ? (int)atomicAdd(WSP(unsigned, WS_CTL) + CW_CNT + tid, (unsigned)n) : 0; }
    __syncthreads();
    if (tid < 64) { const int c = cls_l[tid]; int rank = 0; for (int r = 0; r < tid; ++r) rank += (cls_l[r] == c);
        WSP(int, WS_LIST)[(size_t)c * T + misc[c] + rank] = u * 64 + tid; }
    __syncthreads();
}
__global__ void __launch_bounds__(512) k_ln1(Params p) {
    extern __shared__ float dyn[];
    float* wr = dyn; int* cls_l = (int*)(dyn + 20 * 1024); int* misc = cls_l + 64;
    for (int i = threadIdx.x; i < 20 * 1024; i += 512) wr[i] = WSP(float, WS_WRT)[i];
    __syncthreads();
    for (int u = blockIdx.x; u < T / 64; u += gridDim.x) ln1_unit(p, u, wr, cls_l, misc, threadIdx.x);
}
template <int NR>
__device__ __forceinline__ void ln2_rows(const Params& p, const int (&tok)[NR], const int (&prow)[NR], int lane, float* dummy = nullptr) {
    u32x2 xa[NR][4], ya[NR][4];
#pragma unroll
    for (int r = 0; r < NR; ++r) if (tok[r] >= 0) { const bf16_t* xrow = WSP(bf16_t, WS_X1B) + (size_t)tok[r] * 1024 + 4 * lane; const bf16_t* yrow = WSP(bf16_t, WS_Y2) + (size_t)prow[r] * 1024 + 4 * lane;
#pragma unroll
        for (int j = 0; j < 4; ++j) { xa[r][j] = *(const u32x2*)(xrow + 256 * j); ya[r][j] = *(const u32x2*)(yrow + 256 * j); } }
    f32x4 g4[4], b4[4];
#pragma unroll
    for (int j = 0; j < 4; ++j) { g4[j] = *(const f32x4*)(p.ln2_g + 4 * lane + 256 * j); b4[j] = *(const f32x4*)(p.ln2_b + 4 * lane + 256 * j); }
#pragma unroll
    for (int r = 0; r < NR; ++r) if (tok[r] >= 0) {
        float v[16]; float sm = 0.f;
#pragma unroll
        for (int j = 0; j < 4; ++j) { const u32x2 t = xa[r][j], y = ya[r][j];
            v[4 * j] = DN_ALPHA * bflo(t.x) + bflo(y.x); v[4 * j + 1] = DN_ALPHA * bfhi(t.x) + bfhi(y.x); v[4 * j + 2] = DN_ALPHA * bflo(t.y) + bflo(y.y); v[4 * j + 3] = DN_ALPHA * bfhi(t.y) + bfhi(y.y);
            sm += (v[4 * j] + v[4 * j + 1]) + (v[4 * j + 2] + v[4 * j + 3]); }
        const float mean = wave_sum(sm) * (1.0f / 1024.0f); float sq = 0.f;
#pragma unroll
        for (int i2 = 0; i2 < 16; ++i2) { v[i2] -= mean; sq += v[i2] * v[i2]; }
        const float rstd = 1.0f / sqrtf(wave_sum(sq) * (1.0f / 1024.0f) + LN_EPS);
        float* orow = (dummy ? dummy : p.out) + (size_t)tok[r] * 1024 + 4 * lane;
#pragma unroll
        for (int j = 0; j < 4; ++j) *(f32x4*)(orow + 256 * j) = (f32x4){v[4 * j] * rstd * g4[j].x + b4[j].x, v[4 * j + 1] * rstd * g4[j].y + b4[j].y, v[4 * j + 2] * rstd * g4[j].z + b4[j].z, v[4 * j + 3] * rstd * g4[j].w + b4[j].w};
    }
}
__global__ void __launch_bounds__(256) k_ln2(Params p) {
    __shared__ ClassTab tabs; if (threadIdx.x == 0) class_tab_fill(WSP(unsigned, WS_CTL) + CW_CNT, &tabs); __syncthreads(); const ClassTab* tab = &tabs;
    const int lane = threadIdx.x & 63; const int prow = blockIdx.x * 4 + (threadIdx.x >> 6);
    if (prow >= tab->rowbase[NCLS]) return;
    const int cls = find_class(tab, prow); const int i = prow - tab->rowbase[cls]; if (i >= tab->cnt[cls]) return;
    const int tk[1] = {WSP(int, WS_LIST)[(size_t)cls * T + i]}, pr[1] = {prow};
    ln2_rows<1>(p, tk, pr, lane);
}


#define LAS __attribute__((address_space(3)))
#define GAS __attribute__((address_space(1)))
constexpr int RING_OFF = 0, RING_BYTES = 131072;
constexpr int LCTL_OFF = RING_BYTES;
constexpr int LTOK_OFF = LCTL_OFF + 4096, MAXU = 16;
constexpr int LDS_BYTES = LTOK_OFF + MAXU * 1024;
constexpr int NTHR = 512, NWAVES = 8;

namespace pg8 {
typedef short bf16x8 __attribute__((ext_vector_type(8)));
typedef int v4i_t __attribute__((ext_vector_type(4)));
typedef int v8i_t __attribute__((ext_vector_type(8)));
constexpr int BM = 256, BK = 64, HALF = 128, HTB = HALF * BK * 2, NXCD = 8, WGM = 8;
__host__ __device__ __forceinline__ int lds_byte(int r, int c) { const int st = (r >> 4) * 2 + (c >> 5), rr = r & 15, cc = c & 31, ob = rr * 64 + cc * 2; return st * 1024 + (ob ^ (((ob >> 9) & 1) << 5)); }
__host__ __device__ __forceinline__ void stage_rc(int b, int& R, int& C) { const int st = b / 1024, sb = b % 1024, swz = sb ^ (((sb >> 9) & 1) << 5); R = (st >> 1) * 16 + swz / 64; C = (st & 1) * 32 + (swz % 64) / 2; }
__host__ __device__ __forceinline__ int perm32(int rho) { const int n = rho >> 4, i = rho & 15; return 8 * (i >> 2) + 4 * n + (i & 3); }

struct Unit { const char* A; const char* B; int row0, col0, bjump, aux; };
struct TileOrder {
    int nM, nN, nwg, G, c;
    __device__ __forceinline__ void init(int nM_, int nN_, int G_, int c_) { nM = nM_; nN = nN_; nwg = nM * nN; G = G_; c = c_; }
    __device__ __forceinline__ bool tile(int i, int& pm, int& pn) const {
        const long L = (long)i * G + c; if (L >= nwg) return false;
        int wgid = (int)L; { const int q = nwg / NXCD, r = nwg % NXCD, xcd = wgid % NXCD, off = wgid / NXCD; wgid = (xcd < r ? xcd * (q + 1) : r * (q + 1) + (xcd - r) * q) + off; }
        const int nig = WGM * nN, gid = wgid / nig, fm = gid * WGM, gsz = (nM - fm) < WGM ? (nM - fm) : WGM;
        pm = fm + ((wgid % nig) % gsz); pn = (wgid % nig) / gsz; return true;
    }
};
__device__ __forceinline__ unsigned cvt_pk_bf16(float lo, float hi) { unsigned r; asm volatile("v_cvt_pk_bf16_f32 %0, %1, %2" : "=v"(r) : "v"(lo), "v"(hi)); return r; }

template <class EF> struct EpiRows {
    static constexpr bool PERM = true;
    EF ef;
    __device__ __forceinline__ bool keep_acc(const Unit&) const { return false; }
    __device__ __forceinline__ void operator()(f32x4 (&acc)[2][2][4][2], const Unit& u, int wr, int wc, int fr, int fq) const {
#pragma unroll
        for (int ai = 0; ai < 2; ++ai)
#pragma unroll
            for (int m = 0; m < 4; ++m) { const int row = u.row0 + ai * HALF + wr * 64 + m * 16 + fr;
#pragma unroll
                for (int bj = 0; bj < 2; ++bj) { const int c0 = u.col0 + bj * HALF + wc * 32 + 8 * fq;
                    float v[8] = {acc[ai][bj][m][0][0], acc[ai][bj][m][0][1], acc[ai][bj][m][0][2], acc[ai][bj][m][0][3], acc[ai][bj][m][1][0], acc[ai][bj][m][1][1], acc[ai][bj][m][1][2], acc[ai][bj][m][1][3]};
                    ef(u, row, c0, v); }
                asm volatile("" ::: "memory"); }
    }
};

template <class Epi, class Sched, bool ALIGN_EPI, bool GATHER, bool BJUMP, bool FP8 = false>
__device__ __forceinline__ void gemm_phase(LAS unsigned char* lds, const char* Abase, int lda, int ldb, int K, const Sched& S, const Epi& E, int wave_s) {
    const int tid = opaque_tid(wave_s), wid = __builtin_amdgcn_readfirstlane(tid >> 6), lane = tid & 63, wr = wid >> 2, wc = wid & 3, fr = lane & 15, fq = lane >> 4;
    const int nt = K / BK;
    unsigned voffA[2], voffB[2]; unsigned voffG[2][2], nvoffG[2][2];
#pragma unroll
    for (int i = 0; i < 2; ++i) { int R, C; stage_rc(tid * 16 + i * 8192, R, C); const int Rb = Epi::PERM ? ((R & ~31) + perm32(R & 31)) : R;
        voffA[i] = (unsigned)(R * lda + C) * 2u; voffB[i] = (unsigned)(Rb * ldb + C) * 2u; voffG[0][i] = voffG[1][i] = nvoffG[0][i] = nvoffG[1][i] = 0u; }
    const size_t kstep = (size_t)(BK * 2);
    const size_t hstepA = (size_t)HALF * lda * 2, hstepB = (size_t)HALF * ldb * 2;
    const unsigned ldsw = (unsigned)wid * 1024u;
    const int aoff = lds_byte(wr * 64 + fr, fq * 8), boff = lds_byte(wc * 32 + fr, fq * 8);
#define PG8_SA(b, h) (((b) * 2 + (h)) * HTB)
#define PG8_SB(b, h) ((4 + (b) * 2 + (h)) * HTB)
#define PG8_GLDS(gptr, ldsoff) __builtin_amdgcn_global_load_lds((const unsigned*)(gptr), (LAS unsigned*)(lds + (ldsoff)), 16, 0, 0)
#define PG8_STAGE_B(bufoff, gbase) do { _Pragma("unroll") for (int _i = 0; _i < 2; ++_i) PG8_GLDS((const char*)(gbase) + voffB[_i], (bufoff) + ldsw + _i * 8192); } while (0)
#define PG8_STAGE_A(bufoff, kptr, h, nx) do { if constexpr (GATHER) { _Pragma("unroll") for (int _i = 0; _i < 2; ++_i) PG8_GLDS((const char*)(kptr) + ((nx) ? nvoffG[h][_i] : voffG[h][_i]), (bufoff) + ldsw + _i * 8192); } \
        else { _Pragma("unroll") for (int _i = 0; _i < 2; ++_i) PG8_GLDS((const char*)(kptr) + (h) * hstepA + voffA[_i], (bufoff) + ldsw + _i * 8192); } } while (0)
#define PG8_GATHER_OFFS(dst, ord) do { LAS const int* _tk = S.toks(ord); _Pragma("unroll") for (int _h = 0; _h < 2; ++_h) _Pragma("unroll") for (int _i = 0; _i < 2; ++_i) { int _R, _C; stage_rc(tid * 16 + _i * 8192, _R, _C); \
        dst[_h][_i] = (unsigned)_tk[_h * HALF + _R] * (unsigned)(lda * 2) + (unsigned)(_C * 2); } } while (0)
#define PG8_LDA(dst, b, h) do { _Pragma("unroll") for (int m = 0; m < 4; ++m) _Pragma("unroll") for (int k = 0; k < 2; ++k) dst[m][k] = *(const LAS bf16x8*)(lds + PG8_SA(b, h) + aoff + m * 2048 + k * 1024); } while (0)
#define PG8_LDB(dst, b, h) do { _Pragma("unroll") for (int n = 0; n < 2; ++n) _Pragma("unroll") for (int k = 0; k < 2; ++k) dst[n][k] = *(const LAS bf16x8*)(lds + PG8_SB(b, h) + boff + n * 2048 + k * 1024); } while (0)
#define PG8_CAT8(lo, hi) __builtin_shufflevector(__builtin_bit_cast(v4i_t, lo), __builtin_bit_cast(v4i_t, hi), 0, 1, 2, 3, 4, 5, 6, 7)
#define PG8_MMA(ai, bj, At, Bt) do { __builtin_amdgcn_s_setprio(1); if constexpr (FP8) { _Pragma("unroll") for (int m = 0; m < 4; ++m) _Pragma("unroll") for (int n = 0; n < 2; ++n) \
        { const v8i_t b8_ = PG8_CAT8(Bt[n][0], Bt[n][1]), a8_ = PG8_CAT8(At[m][0], At[m][1]); asm volatile("v_mfma_f32_16x16x128_f8f6f4 %0, %1, %2, %0" : "+v"(acc[ai][bj][m][n]) : "v"(b8_), "v"(a8_)); } } \
        else { _Pragma("unroll") for (int m = 0; m < 4; ++m) _Pragma("unroll") for (int n = 0; n < 2; ++n) _Pragma("unroll") for (int k = 0; k < 2; ++k) \
        acc[ai][bj][m][n] = __builtin_amdgcn_mfma_f32_16x16x32_bf16(Bt[n][k], At[m][k], acc[ai][bj][m][n], 0, 0, 0); } __builtin_amdgcn_s_setprio(0); } while (0)
#define PG8_WAIT_V(n) asm volatile("s_waitcnt vmcnt(" #n ")" ::: "memory")
#define PG8_WAIT_L(n) asm volatile("s_waitcnt lgkmcnt(" #n ")" ::: "memory")
#define PG8_BAR __builtin_amdgcn_s_barrier()
#define PG8_SCHED __builtin_amdgcn_sched_barrier(0)
    Unit cur, nxt; int ui = 0;
    if (!S.next(0, cur)) return;
    f32x4 acc[2][2][4][2];
#pragma unroll
    for (int a = 0; a < 2; ++a)
#pragma unroll
        for (int b = 0; b < 2; ++b)
#pragma unroll
            for (int m = 0; m < 4; ++m)
#pragma unroll
                for (int n = 0; n < 2; ++n) acc[a][b][m][n] = (f32x4){0.f, 0.f, 0.f, 0.f};
    bf16x8 At[4][2], B0[2][2], B1[2][2];
    const char* cA = GATHER ? Abase : cur.A; const char* cB = cur.B;
    if constexpr (GATHER) PG8_GATHER_OFFS(voffG, 0);
    PG8_STAGE_B(PG8_SB(0, 0), cB); PG8_STAGE_B(PG8_SB(0, 1), cB + hstepB); PG8_STAGE_A(PG8_SA(0, 0), cA, 0, false); PG8_STAGE_A(PG8_SA(0, 1), cA, 1, false);
    if (wr == 1) PG8_BAR;
    PG8_WAIT_V(2); PG8_BAR;
    PG8_STAGE_B(PG8_SB(1, 0), cB + kstep); PG8_STAGE_A(PG8_SA(1, 0), cA + kstep, 0, false); PG8_STAGE_B(PG8_SB(1, 1), cB + hstepB + kstep);
    PG8_WAIT_V(6); PG8_BAR;
    for (;;) {
        const bool has_next = S.next(ui + 1, nxt);
        if constexpr (GATHER) { if (has_next) PG8_GATHER_OFFS(nvoffG, ui + 1); else {
#pragma unroll
            for (int h = 0; h < 2; ++h)
#pragma unroll
                for (int i = 0; i < 2; ++i) nvoffG[h][i] = voffG[h][i]; } }
        const char* nA = GATHER ? Abase : (has_next ? nxt.A : cA); const char* nB = has_next ? nxt.B : cB;
#pragma nounroll
        for (int t = 0; t < nt; t += 2) {
            const bool last = (t == nt - 2);
            const char* a1 = cA + (size_t)(t + 1) * kstep;
            const char* a2 = last ? nA : cA + (size_t)(t + 2) * kstep;
            const char* b2 = last ? nB : cB + (size_t)(t + 2) * kstep + ((BJUMP && (t + 2) >= (nt >> 1)) ? cur.bjump : 0);
            const char* a3 = a2 + kstep; const char* b3 = b2 + kstep;
            PG8_LDB(B0, 0, 0); PG8_LDB(B1, 0, 1); PG8_SCHED; PG8_LDA(At, 0, 0); PG8_STAGE_A(PG8_SA(1, 1), a1, 1, false);
            PG8_WAIT_V(8); PG8_WAIT_L(0); PG8_BAR; PG8_MMA(0, 0, At, B0); PG8_MMA(0, 1, At, B1); PG8_BAR; PG8_SCHED;
            PG8_LDA(At, 0, 1); PG8_STAGE_B(PG8_SB(0, 0), b2); PG8_STAGE_B(PG8_SB(0, 1), b2 + hstepB); PG8_STAGE_A(PG8_SA(0, 0), a2, 0, last);
            PG8_WAIT_V(8); PG8_WAIT_L(0); PG8_BAR; PG8_MMA(1, 0, At, B0); PG8_MMA(1, 1, At, B1); PG8_BAR; PG8_SCHED;
            PG8_LDB(B0, 1, 0); PG8_LDB(B1, 1, 1); PG8_SCHED; PG8_LDA(At, 1, 0); PG8_STAGE_A(PG8_SA(0, 1), a2, 1, last);
            PG8_WAIT_V(8); PG8_WAIT_L(0); PG8_BAR; PG8_MMA(0, 0, At, B0); PG8_MMA(0, 1, At, B1); PG8_BAR; PG8_SCHED;
            PG8_LDA(At, 1, 1); PG8_STAGE_B(PG8_SB(1, 0), b3); PG8_STAGE_B(PG8_SB(1, 1), b3 + hstepB); PG8_STAGE_A(PG8_SA(1, 0), a3, 0, last);
            PG8_WAIT_V(8); PG8_WAIT_L(0); PG8_BAR; PG8_MMA(1, 0, At, B0); PG8_MMA(1, 1, At, B1); PG8_BAR; PG8_SCHED;
        }
        if constexpr (ALIGN_EPI) { if (wr == 0) PG8_BAR; }
        if constexpr (FP8) { asm volatile("s_nop 15\n\ts_nop 15" ::: "memory"); PG8_SCHED; }
        E(acc, cur, wr, wc, fr, fq);
        if (!has_next) break;
        if (!E.keep_acc(cur)) {
#pragma unroll
        for (int a = 0; a < 2; ++a)
#pragma unroll
            for (int b = 0; b < 2; ++b)
#pragma unroll
                for (int m = 0; m < 4; ++m)
#pragma unroll
                    for (int n = 0; n < 2; ++n) acc[a][b][m][n] = (f32x4){0.f, 0.f, 0.f, 0.f}; }
        cur = nxt; cA = nA; cB = nB; ++ui;
        if constexpr (GATHER) {
#pragma unroll
            for (int h = 0; h < 2; ++h)
#pragma unroll
                for (int i = 0; i < 2; ++i) voffG[h][i] = nvoffG[h][i]; }
        if constexpr (ALIGN_EPI) { if (wr == 1) PG8_BAR; }
    }
    PG8_WAIT_V(0);
    if constexpr (!ALIGN_EPI) { if (wr == 0) PG8_BAR; }
    PG8_BAR;
#undef PG8_SA
#undef PG8_SB
#undef PG8_GLDS
#undef PG8_STAGE_A
#undef PG8_STAGE_B
#undef PG8_GATHER_OFFS
#undef PG8_LDA
#undef PG8_LDB
#undef PG8_MMA
#undef PG8_CAT8
#undef PG8_WAIT_V
#undef PG8_WAIT_L
#undef PG8_BAR
#undef PG8_SCHED
}
}

namespace swa {
typedef short bf16x8 __attribute__((ext_vector_type(8)));
typedef short s16x4 __attribute__((ext_vector_type(4)));
typedef float f32x16 __attribute__((ext_vector_type(16)));
constexpr int DH = 128, NW = 8, QBLK = 32, KVBLK = 64, QB = NW * QBLK;
constexpr int SHM_V = KVBLK * DH * 2, SHM_K = KVBLK * DH * 2;
constexpr int LDS_NEED = 2 * SHM_V + 2 * SHM_K + NW * 64 * 4;
constexpr float SCALE = 0.08838834764831845f, THR = 8.f;
#define KSWZ(row, colB) ((row) * 256 + ((colB) ^ (((row) & 7) << 4)))
#define SBAR() __builtin_amdgcn_sched_barrier(0)
__device__ __forceinline__ int v_st(int k, int c) { const int kk = (k & ~0xC) | ((k & 4) << 1) | ((k & 8) >> 1); return ((kk >> 3) * 4 + (c >> 5)) * 512 + ((kk & 7) * 32 + (c & 31)) * 2; }
__device__ __forceinline__ int v_rd_base(int lane) { return ((lane & 3) << 3) | (((lane >> 2) & 3) << 6) | (((lane >> 4) & 1) << 5) | (((lane >> 5) & 1) << 8); }
constexpr int v_rd_off(int d0, int ks, int half) { return d0 * 512 + ks * 4096 + half * 2048; }
__device__ __forceinline__ int crow(int r, int hi) { return (r & 3) + 8 * (r >> 2) + 4 * hi; }
__device__ __forceinline__ unsigned cvtpk(float lo, float hi) { unsigned r; asm volatile("v_cvt_pk_bf16_f32 %0, %1, %2" : "=v"(r) : "v"(lo), "v"(hi)); return r; }
__device__ __forceinline__ bf16x8 load8(const bf16_t* p) { return *reinterpret_cast<const bf16x8*>(p); }
__device__ __forceinline__ void mask_tile(f32x16& p0, f32x16& p1, int dq, unsigned W) {
    const float NEG = -__builtin_inff();
#pragma unroll
    for (int r = 0; r < 16; ++r) {
        const int c = (r & 3) + 8 * (r >> 2);
        if ((unsigned)(dq - c) >= W) p0[r] = NEG;
        if ((unsigned)(dq - c - 32) >= W) p1[r] = NEG;
    }
}
__device__ __forceinline__ void partialSM(f32x16& p0, f32x16& p1, float& m_reg, float& mn, float& alpha) {
    float pmax = p0[0]; for (int r = 1; r < 16; ++r) pmax = fmaxf(pmax, p0[r]); for (int r = 0; r < 16; ++r) pmax = fmaxf(pmax, p1[r]);
    { auto rr = __builtin_amdgcn_permlane32_swap(__float_as_uint(pmax), __float_as_uint(pmax), false, false);
      pmax = fmaxf(__uint_as_float(rr[0]), __uint_as_float(rr[1])); }
    constexpr float C2 = 1.4426950408889634f * SCALE;
    if (__builtin_expect(__all((pmax - m_reg) * SCALE <= THR), 1)) { mn = m_reg; alpha = 1.f; }
    else { mn = fmaxf(m_reg, pmax); alpha = __builtin_amdgcn_exp2f((m_reg - mn) * C2); m_reg = mn; }
    const float mnL = -mn * C2;
    for (int r = 0; r < 16; ++r) p0[r] = fmaf(p0[r], C2, mnL); for (int r = 0; r < 16; ++r) p1[r] = fmaf(p1[r], C2, mnL);
    for (int r = 0; r < 16; ++r) p0[r] = __builtin_amdgcn_exp2f(p0[r]);
}
__device__ __forceinline__ void finishSM(f32x16& p0, f32x16& p1, float alpha, float& l_reg, bf16x8& pa0, bf16x8& pa1, bf16x8& pa2, bf16x8& pa3) {
    for (int r = 0; r < 16; ++r) p1[r] = __builtin_amdgcn_exp2f(p1[r]);
    float ps = 0; for (int r = 0; r < 16; ++r) ps += p0[r]; for (int r = 0; r < 16; ++r) ps += p1[r];
    { auto rr = __builtin_amdgcn_permlane32_swap(__float_as_uint(ps), __float_as_uint(ps), false, false);
      ps = __uint_as_float(rr[0]) + __uint_as_float(rr[1]); }
    l_reg = l_reg * alpha + ps;
#define PK4(P, B_, OUT) do { unsigned a0 = cvtpk(P[B_+0], P[B_+1]), a1 = cvtpk(P[B_+2], P[B_+3]);                          \
        unsigned b0 = cvtpk(P[B_+4], P[B_+5]), b1 = cvtpk(P[B_+6], P[B_+7]);                                             \
        auto r0 = __builtin_amdgcn_permlane32_swap(a0, b0, false, false); auto r1 = __builtin_amdgcn_permlane32_swap(a1, b1, false, false); \
        u32x4 w = {r0[0], r1[0], r0[1], r1[1]}; OUT = *reinterpret_cast<bf16x8*>(&w); } while (0)
    PK4(p0, 0, pa0); PK4(p0, 8, pa1); PK4(p1, 0, pa2); PK4(p1, 8, pa3);
#undef PK4
}
template <int KB>
__device__ __forceinline__ void qkt(f32x16& p0, f32x16& p1, const char* K_lds, int r32, int hi, const bf16x8* qr, bool act) {
    if (!act) { const float NEG = -__builtin_inff();
#pragma unroll
        for (int r = 0; r < 16; ++r) { p0[r] = NEG; p1[r] = NEG; } return; }
    p0 = f32x16{}; p1 = f32x16{};
    const char* kb[4];
#pragma unroll
    for (int dd = 0; dd < 4; ++dd) kb[dd] = K_lds + KB * SHM_K + KSWZ(r32, (dd * 16 + hi * 8) * 2);
#pragma unroll
    for (int d0 = 0; d0 < 8; ++d0) { const char* a = kb[d0 & 3] + (d0 >> 2) * 128;
        bf16x8 b0 = *reinterpret_cast<const bf16x8*>(a);
        bf16x8 b1 = *reinterpret_cast<const bf16x8*>(a + 32 * 256);
        p0 = __builtin_amdgcn_mfma_f32_32x32x16_bf16(b0, qr[d0], p0, 0, 0, 0);
        p1 = __builtin_amdgcn_mfma_f32_32x32x16_bf16(b1, qr[d0], p1, 0, 0, 0); }
}
template <int VB>
__device__ __forceinline__ void pv_tile(f32x16* o, int vb0, bf16x8 pa0, bf16x8 pa1, bf16x8 pa2, bf16x8 pa3, bool act) {
    if (!act) return;
#define TRRD(dst, off) asm volatile("ds_read_b64_tr_b16 %0, %1 offset:%2" : "=&v"(dst) : "v"(vb0), "i"(off) : "memory")
#define PV_D0(d0) do { s16x4 l0, l1, l2, l3, h0, h1, h2, h3; constexpr int b_ = VB * SHM_V + v_rd_off(d0, 0, 0); \
        TRRD(l0, b_); TRRD(h0, b_ + 2048); TRRD(l1, b_ + 4096); TRRD(h1, b_ + 6144); TRRD(l2, b_ + 8192); TRRD(h2, b_ + 10240); TRRD(l3, b_ + 12288); TRRD(h3, b_ + 14336); \
        asm volatile("s_waitcnt lgkmcnt(0)" ::: "memory"); SBAR();   \
        o[d0] = __builtin_amdgcn_mfma_f32_32x32x16_bf16(pa0, (bf16x8){l0[0], l0[1], l0[2], l0[3], h0[0], h0[1], h0[2], h0[3]}, o[d0], 0, 0, 0);   \
        o[d0] = __builtin_amdgcn_mfma_f32_32x32x16_bf16(pa1, (bf16x8){l1[0], l1[1], l1[2], l1[3], h1[0], h1[1], h1[2], h1[3]}, o[d0], 0, 0, 0);   \
        o[d0] = __builtin_amdgcn_mfma_f32_32x32x16_bf16(pa2, (bf16x8){l2[0], l2[1], l2[2], l2[3], h2[0], h2[1], h2[2], h2[3]}, o[d0], 0, 0, 0);   \
        o[d0] = __builtin_amdgcn_mfma_f32_32x32x16_bf16(pa3, (bf16x8){l3[0], l3[1], l3[2], l3[3], h3[0], h3[1], h3[2], h3[3]}, o[d0], 0, 0, 0); } while (0)
    PV_D0(0); PV_D0(1); PV_D0(2); PV_D0(3);
#undef PV_D0
#undef TRRD
}
struct BlockRef { const bf16_t* Q; const bf16_t* K; const bf16_t* V; bf16_t* O; float* LSE; int P0, W, segmask, skv, ostride; };
struct Seam { bf16x8 qr[8]; bf16x8 st_v0, st_v1, st_k0, st_k1; };
__device__ __forceinline__ int imax(int a, int b) { return a > b ? a : b; }
__device__ __forceinline__ int blk_jlo(const BlockRef& b) { const int lowk = imax(b.P0 - b.W + 1, b.P0 & ~b.segmask); return lowk > 0 ? lowk / KVBLK : 0; }
#define ROW(p, k0, rr) ((p) + (size_t)((k0) + (rr)) * DH + sc)
#define VMW() asm volatile("s_waitcnt vmcnt(0)" ::: "memory")
#define VMWN(n) asm volatile("s_waitcnt vmcnt(%0)" :: "i"(n) : "memory")
#define SLOAD_H(Kp, Vp, k0) do { S.st_v0 = load8(ROW(Vp, k0, sr)); S.st_v1 = load8(ROW(Vp, k0, 32 + sr));              \
                         S.st_k0 = load8(ROW(Kp, k0, sr)); S.st_k1 = load8(ROW(Kp, k0, 32 + sr)); } while (0)
#define SWRITE_HK(bf) do { *(bf16x8*)(K_lds + (bf) * SHM_K + kws) = S.st_k0; *(bf16x8*)(K_lds + (bf) * SHM_K + kws + 32 * 256) = S.st_k1; } while (0)
#define SWRITE_HV(bf) do { *(bf16x8*)(V_lds + (bf) * SHM_V + vst0) = S.st_v0; *(bf16x8*)(V_lds + (bf) * SHM_V + vst1) = S.st_v1; } while (0)
#define SWRITE_H(bf) do { SWRITE_HV(bf); SWRITE_HK(bf); } while (0)
__device__ __forceinline__ void prime(const BlockRef& cur, char* lds, Seam& S, int wave_s) {
    const int tid = opaque_tid(wave_s), wid = __builtin_amdgcn_readfirstlane(tid >> 6), lane = tid & 63, r32 = lane & 31, hi = lane >> 5;
    const int sr = tid >> 4, sc = (tid & 15) * 8, kws = KSWZ(sr, sc * 2); char* K_lds = lds + 2 * SHM_V;
    const int kb0 = blk_jlo(cur) * KVBLK;
    for (int d0 = 0; d0 < 8; ++d0) S.qr[d0] = load8(cur.Q + (size_t)(wid * QBLK + r32) * DH + d0 * 16 + hi * 8);
    SLOAD_H(cur.K, cur.V, kb0); VMW(); SWRITE_HK(0);
    __syncthreads();
}
__device__ __forceinline__ void block(const BlockRef& cur, const BlockRef& nxt, char* lds, Seam& S, int wave_s) {
    const int tid = opaque_tid(wave_s), wid = __builtin_amdgcn_readfirstlane(tid >> 6), lane = tid & 63, r32 = lane & 31, hi = lane >> 5;
    const int W = cur.W;
    const int j_lo = blk_jlo(cur);
    int j_hi = (cur.P0 + QB - 1) / KVBLK + 1; if (j_hi > cur.skv / KVBLK) j_hi = cur.skv / KVBLK;
    const int NT = j_hi - j_lo;
    const int kbn = blk_jlo(nxt) * KVBLK;
    const int qlo = cur.P0 + wid * QBLK, qm = qlo + r32 - 4 * hi;
    const int segb = qlo & ~cur.segmask;
    const int lowk_w = imax(qlo - W + 1, segb);
    const int lowk_last = imax(qlo + QBLK - W, segb);
    const int wrow = ((qlo + r32) & cur.segmask) + 1;
    const unsigned Wl = (unsigned)(wrow < W ? wrow : W);
    char* V_lds = lds; char* K_lds = lds + 2 * SHM_V;
    float* ws = (float*)(lds + 2 * SHM_V + 2 * SHM_K) + wid * 64; float* li_l = ws, * al_l = ws + 32;
    float m_reg = -1e30f, l_reg = 0; f32x16 o[4] = {};
    const int sr = tid >> 4, sc = (tid & 15) * 8, vst0 = v_st(sr, sc), vst1 = v_st(32 + sr, sc), kws = KSWZ(sr, sc * 2);
    const int vb0 = (int)(uintptr_t)V_lds + v_rd_base(lane);
    const bf16_t* Kh = cur.K; const bf16_t* Vh = cur.V;
#define RESC(a) do { if (__any((a) < 1.f)) { if (hi == 0) al_l[r32] = (a); asm volatile("s_waitcnt lgkmcnt(0)" ::: "memory");              \
                     for (int d_ = 0; d_ < 4; ++d_) for (int r = 0; r < 16; ++r) o[d_][r] *= al_l[crow(r, hi)]; } } while (0)
#define KBASE(t) ((j_lo + (t)) * KVBLK)
#define ACT(t) (KBASE(t) <= qlo + QBLK - 1 && KBASE(t) + KVBLK - 1 >= lowk_w)
#define MASKT(P0_, P1_, t) do { const int kb_ = KBASE(t); if (ACT(t) && (kb_ + KVBLK - 1 > qlo || kb_ < lowk_last)) mask_tile(P0_, P1_, qm - kb_, Wl); } while (0)
    constexpr int NQL = 8;
#define SEAM_K0() do { VMWN(NQL); SWRITE_HK(0); SBAR(); } while (0)
    f32x16 pA0, pA1, pB0, pB1; float mnA, mnB, alA, alB; bf16x8 pa0, pa1, pa2, pa3;
    SWRITE_HV(0); SBAR();
    if (NT > 1) { SLOAD_H(Kh, Vh, KBASE(1)); }
    SBAR(); qkt<0>(pA0, pA1, K_lds, r32, hi, S.qr, ACT(0));
    MASKT(pA0, pA1, 0); partialSM(pA0, pA1, m_reg, mnA, alA);
    if (NT > 1) { VMW(); SWRITE_H(1); }
    __syncthreads();
#define HALF_STEP(PX0, PX1, mnX, alX, PY0, PY1, alY, t, KB, VB, SB) do {                                                      \
        SBAR(); if ((t) + 1 < NT) { SLOAD_H(Kh, Vh, KBASE((t) + 1)); SBAR(); }                                       \
        qkt<KB>(PX0, PX1, K_lds, r32, hi, S.qr, ACT(t));                                             \
        finishSM(PY0, PY1, alY, l_reg, pa0, pa1, pa2, pa3); SBAR();                                                           \
        pv_tile<VB>(o, vb0, pa0, pa1, pa2, pa3, ACT((t) - 1)); MASKT(PX0, PX1, (t)); partialSM(PX0, PX1, m_reg, mnX, alX);                                        \
        __syncthreads();                                                                                                      \
        if ((t) + 1 < NT) { VMW(); SWRITE_H(SB); }                                                                          \
        RESC(alX); __syncthreads(); } while (0)
    for (int t = 1; t + 1 < NT; t += 2) {
        HALF_STEP(pB0, pB1, mnB, alB, pA0, pA1, alA, t, 1, 0, 0);
        HALF_STEP(pA0, pA1, mnA, alA, pB0, pB1, alB, t + 1, 0, 1, 1);
    }
    const bool even = (NT & 1) == 0;
    if (even) { SBAR(); qkt<1>(pB0, pB1, K_lds, r32, hi, S.qr, ACT(NT - 1)); SBAR(); }
    SLOAD_H(nxt.K, nxt.V, kbn); SBAR();
#pragma unroll
    for (int d0 = 0; d0 < 8; ++d0) S.qr[d0] = load8(nxt.Q + (size_t)(wid * QBLK + r32) * DH + d0 * 16 + hi * 8);
    SBAR();
    finishSM(pA0, pA1, alA, l_reg, pa0, pa1, pa2, pa3); SBAR();
    pv_tile<0>(o, vb0, pa0, pa1, pa2, pa3, ACT(even ? NT - 2 : NT - 1));
    if (even) { MASKT(pB0, pB1, NT - 1); partialSM(pB0, pB1, m_reg, mnB, alB); __syncthreads(); RESC(alB);
        finishSM(pB0, pB1, alB, l_reg, pa0, pa1, pa2, pa3); SBAR(); pv_tile<1>(o, vb0, pa0, pa1, pa2, pa3, ACT(NT - 1)); }
    SBAR(); SEAM_K0();
    if (hi == 0) li_l[r32] = l_reg; asm volatile("s_waitcnt lgkmcnt(0)" ::: "memory");
    if (cur.LSE != nullptr && hi == 0) cur.LSE[wid * QBLK + r32] = m_reg * SCALE + __logf(l_reg);
    float rli[16];
#pragma unroll
    for (int r = 0; r < 16; ++r) rli[r] = __builtin_amdgcn_rcpf(li_l[crow(r, hi)]);
    bf16_t* Ow = cur.O + (size_t)(wid * QBLK) * cur.ostride;
#pragma unroll
    for (int r = 0; r < 16; ++r) { const int orow = crow(r, hi);
#pragma unroll
        for (int d0 = 0; d0 < 4; ++d0) { const float v = o[d0][r] * rli[r];
            const float vn = __shfl_xor(v, 1);
            if ((r32 & 1) == 0) *(unsigned*)(Ow + (size_t)orow * cur.ostride + d0 * 32 + r32) = cvtpk(v, vn); } }
    __syncthreads();
#undef RESC
#undef KBASE
#undef ACT
#undef MASKT
#undef SEAM_K0
#undef HALF_STEP
}

constexpr int RING_V = 4 * SHM_K;
__device__ __forceinline__ void qkt_rt(f32x16& p0, f32x16& p1, const LAS char* Kslot, int r32, int hi, const bf16x8* qr) {
    p0 = f32x16{}; p1 = f32x16{};
    const LAS char* kb[4];
#pragma unroll
    for (int dd = 0; dd < 4; ++dd) kb[dd] = Kslot + KSWZ(r32, (dd * 16 + hi * 8) * 2);
#pragma unroll
    for (int d0 = 0; d0 < 8; ++d0) { const LAS char* a = kb[d0 & 3] + (d0 >> 2) * 128;
        bf16x8 b0 = *(const LAS bf16x8*)(a);
        bf16x8 b1 = *(const LAS bf16x8*)(a + 32 * 256);
        p0 = __builtin_amdgcn_mfma_f32_32x32x16_bf16(b0, qr[d0], p0, 0, 0, 0);
        p1 = __builtin_amdgcn_mfma_f32_32x32x16_bf16(b1, qr[d0], p1, 0, 0, 0); }
}
__device__ __forceinline__ void pv_rt(f32x16* o, int vb, bf16x8 pa0, bf16x8 pa1, bf16x8 pa2, bf16x8 pa3) {
#define TRRD(dst, off) asm volatile("ds_read_b64_tr_b16 %0, %1 offset:%2" : "=&v"(dst) : "v"(vb), "i"(off) : "memory")
#define PV_D0(d0) do { s16x4 l0, l1, l2, l3, h0, h1, h2, h3; constexpr int b_ = v_rd_off(d0, 0, 0); \
        TRRD(l0, b_); TRRD(h0, b_ + 2048); TRRD(l1, b_ + 4096); TRRD(h1, b_ + 6144); TRRD(l2, b_ + 8192); TRRD(h2, b_ + 10240); TRRD(l3, b_ + 12288); TRRD(h3, b_ + 14336); \
        asm volatile("s_waitcnt lgkmcnt(0)" ::: "memory"); SBAR();   \
        o[d0] = __builtin_amdgcn_mfma_f32_32x32x16_bf16(pa0, (bf16x8){l0[0], l0[1], l0[2], l0[3], h0[0], h0[1], h0[2], h0[3]}, o[d0], 0, 0, 0);   \
        o[d0] = __builtin_amdgcn_mfma_f32_32x32x16_bf16(pa1, (bf16x8){l1[0], l1[1], l1[2], l1[3], h1[0], h1[1], h1[2], h1[3]}, o[d0], 0, 0, 0);   \
        o[d0] = __builtin_amdgcn_mfma_f32_32x32x16_bf16(pa2, (bf16x8){l2[0], l2[1], l2[2], l2[3], h2[0], h2[1], h2[2], h2[3]}, o[d0], 0, 0, 0);   \
        o[d0] = __builtin_amdgcn_mfma_f32_32x32x16_bf16(pa3, (bf16x8){l3[0], l3[1], l3[2], l3[3], h3[0], h3[1], h3[2], h3[3]}, o[d0], 0, 0, 0); } while (0)
    PV_D0(0); PV_D0(1); PV_D0(2); PV_D0(3);
#undef PV_D0
#undef TRRD
}
struct WaveState { float m, l; f32x16 o[4]; };
__device__ __forceinline__ void tile_step(WaveState& st, const bf16x8* qr, const LAS char* lds, int slot, int r32, int hi, int lane, LAS float* al_l, bool need_mask, int dq, unsigned Wl) {
    f32x16 p0, p1; float mn, alpha; bf16x8 pa0, pa1, pa2, pa3;
    qkt_rt(p0, p1, lds + slot * SHM_K, r32, hi, qr);
    if (need_mask) mask_tile(p0, p1, dq, Wl);
    partialSM(p0, p1, st.m, mn, alpha);
    if (__any(alpha < 1.f)) { if (hi == 0) al_l[r32] = alpha; asm volatile("s_waitcnt lgkmcnt(0)" ::: "memory");
        for (int d_ = 0; d_ < 4; ++d_) for (int r = 0; r < 16; ++r) st.o[d_][r] *= al_l[crow(r, hi)]; }
    finishSM(p0, p1, alpha, st.l, pa0, pa1, pa2, pa3); SBAR();
    pv_rt(st.o, (int)(unsigned)(uintptr_t)(lds + RING_V + slot * SHM_V) + v_rd_base(lane), pa0, pa1, pa2, pa3);
}
__device__ __forceinline__ void wave_store(const WaveState& st, bf16_t* Ow, int ostride, float* lse, int r32, int hi, LAS float* li_l) {
    if (hi == 0) li_l[r32] = st.l; asm volatile("s_waitcnt lgkmcnt(0)" ::: "memory");
    if (lse != nullptr && hi == 0) lse[r32] = st.m * SCALE + __logf(st.l);
    float rli[16];
#pragma unroll
    for (int r = 0; r < 16; ++r) rli[r] = __builtin_amdgcn_rcpf(li_l[crow(r, hi)]);
#pragma unroll
    for (int r = 0; r < 16; ++r) { const int orow = crow(r, hi);
#pragma unroll
        for (int d0 = 0; d0 < 4; ++d0) { const float v = st.o[d0][r] * rli[r];
            const float vn = __shfl_xor(v, 1);
            if ((r32 & 1) == 0) *(unsigned*)(Ow + (size_t)orow * ostride + d0 * 32 + r32) = cvtpk(v, vn); } }
}
__device__ __forceinline__ void wave_reset(WaveState& st) { st.m = -1e30f; st.l = 0.f;
#pragma unroll
    for (int d = 0; d < 4; ++d) st.o[d] = f32x16{}; }
#define HS_LOADQ(qr, Qrow0) do { _Pragma("unroll") for (int d0 = 0; d0 < 8; ++d0) qr[d0] = load8((Qrow0) + (size_t)(wid * QBLK + r32) * DH + d0 * 16 + hi * 8); } while (0)
#define HS_SLOAD(Kp, Vp, k0) do { st_v0 = load8(ROW(Vp, k0, sr)); st_v1 = load8(ROW(Vp, k0, 32 + sr)); st_k0 = load8(ROW(Kp, k0, sr)); st_k1 = load8(ROW(Kp, k0, 32 + sr)); } while (0)
#define HS_SWRITE(slot) do { *(LAS bf16x8*)(lds + (slot) * SHM_K + kws) = st_k0; *(LAS bf16x8*)(lds + (slot) * SHM_K + kws + 32 * 256) = st_k1; \
                             *(LAS bf16x8*)(lds + RING_V + (slot) * SHM_V + vst0) = st_v0; *(LAS bf16x8*)(lds + RING_V + (slot) * SHM_V + vst1) = st_v1; } while (0)
__device__ __forceinline__ void head_dilated(const bf16_t* Q, bf16_t* O, const bf16_t* K, const bf16_t* V, float* LSE, int segmask, LAS char* lds, LAS float* scr, int wave_s) {
    const int tid = opaque_tid(wave_s), wid = __builtin_amdgcn_readfirstlane(tid >> 6), lane = tid & 63, r32 = lane & 31, hi = lane >> 5, pair = wid >> 1;
    const int sr = tid >> 4, sc = (tid & 15) * 8, vst0 = v_st(sr, sc), vst1 = v_st(32 + sr, sc), kws = KSWZ(sr, sc * 2);
    LAS float* li_l = scr + wid * 64; LAS float* al_l = li_l + 32;
    constexpr int NT = 2048 / KVBLK, W = 129;
    bf16x8 st_v0, st_v1, st_k0, st_k1; bf16x8 qr[8]; WaveState st; wave_reset(st);
    HS_SLOAD(K, V, 0); HS_LOADQ(qr, Q); VMW(); HS_SWRITE(0); SBAR();
    HS_SLOAD(K, V, KVBLK); VMW(); HS_SWRITE(1);
    __syncthreads();
    for (int g = 1; g <= NT; ++g) {
        const bool ld = g + 1 < NT;
        if (ld) { HS_SLOAD(K, V, (g + 1) * KVBLK); SBAR(); }
        const int ph = (g - 1) & 3, qb = (g - 1) >> 2;
        if (ph != 3) {
            const int T = g - 3 + pair, qlo = qb * QB + wid * QBLK, segb = qlo & ~segmask;
            const int lowk_w = imax(qlo - W + 1, segb), lowk_last = imax(qlo + QBLK - W, segb), kb_ = T * KVBLK;
            if (T >= 0 && kb_ <= qlo + QBLK - 1 && kb_ + KVBLK - 1 >= lowk_w) {
                const int wrow = ((qlo + r32) & segmask) + 1;
                tile_step(st, qr, lds, T & 3, r32, hi, lane, al_l, (kb_ + KVBLK - 1 > qlo) || (kb_ < lowk_last), qlo + r32 - 4 * hi - kb_, (unsigned)(wrow < W ? wrow : W));
            }
        } else {
            wave_store(st, O + (size_t)(qb * QB + wid * QBLK) * DH, DH, LSE + qb * QB + wid * QBLK, r32, hi, li_l);
            wave_reset(st);
            if (qb + 1 < 2048 / QB) HS_LOADQ(qr, Q + (size_t)(qb + 1) * QB * DH);
        }
        __syncthreads();
        if (ld) { VMW(); HS_SWRITE((g + 1) & 3); }
        __syncthreads();
    }
}
__device__ __forceinline__ void head_mem(const bf16_t* Q, const bf16_t* K, const bf16_t* V, bf16_t* O, int ostride, LAS char* lds, LAS float* scr, int wave_s) {
    const int tid = opaque_tid(wave_s), wid = __builtin_amdgcn_readfirstlane(tid >> 6), lane = tid & 63, r32 = lane & 31, hi = lane >> 5, pair = wid >> 1;
    const int sr = tid >> 4, sc = (tid & 15) * 8, vst0 = v_st(sr, sc), vst1 = v_st(32 + sr, sc), kws = KSWZ(sr, sc * 2);
    LAS float* li_l = scr + wid * 64; LAS float* al_l = li_l + 32;
    bf16x8 st_v0, st_v1, st_k0, st_k1; bf16x8 qr[8]; WaveState st;
#pragma unroll
    for (int t = 0; t < 4; ++t) { HS_SLOAD(K, V, t * KVBLK); VMW(); HS_SWRITE(t); SBAR(); }
    __syncthreads();
    for (int qb = 0; qb < 2048 / QB; ++qb) {
        HS_LOADQ(qr, Q + (size_t)qb * QB * DH); wave_reset(st);
        for (int t = 0; t < 4; ++t) tile_step(st, qr, lds, (t + pair) & 3, r32, hi, lane, al_l, false, 0, 0u);
        wave_store(st, O + (size_t)(qb * QB + wid * QBLK) * ostride, ostride, nullptr, r32, hi, li_l);
    }
    __syncthreads();
}
#undef HS_LOADQ
#undef HS_SLOAD
#undef HS_SWRITE
#undef ROW
#undef VMW
#undef VMWN
#undef SLOAD_H
#undef SWRITE_HK
#undef SWRITE_HV
#undef SWRITE_H
#undef KSWZ
#undef SBAR
}

#define XB_TMO      128
#define XB_XCNT(j)  (256  + 64 * (j))
#define XB_XSUB(j)  (1280 + 64 * (j))
#define XB_XGEN(j)  (2304 + 64 * (j))
#define XB_TOP      3328
#define XB_TOPGEN   3392
#define XCD_BAR_WORDS 3456
#define XB_SPIN_CAP (1u << 18)
__device__ __forceinline__ unsigned xb_ld(unsigned* p)              { return __hip_atomic_load(p, __ATOMIC_RELAXED, __HIP_MEMORY_SCOPE_AGENT); }
__device__ __forceinline__ unsigned xb_add(unsigned* p, unsigned v) { return __hip_atomic_fetch_add(p, v, __ATOMIC_RELAXED, __HIP_MEMORY_SCOPE_AGENT); }
__device__ __forceinline__ unsigned xb_xcc_id() { return (unsigned)__builtin_amdgcn_s_getreg((3 << 11) | 20) & 0xFu; }
#define XB_SPIN(cond, bar) do { unsigned _sp = 0; while (cond) { __builtin_amdgcn_s_sleep(1); \
    if ((++_sp & 255u) == 0u) { if (xb_ld(&(bar)[XB_TMO])) break; if (_sp > XB_SPIN_CAP) { atomicAdd(&(bar)[XB_TMO], 1u); break; } } } } while (0)
struct XcdBarrier { unsigned* bar; unsigned x; volatile LAS unsigned* st; };
__device__ __forceinline__ XcdBarrier xcd_barrier_post(unsigned* bar, volatile LAS unsigned* st) {
    XcdBarrier b; b.bar = bar; b.x = xb_xcc_id(); b.st = st;
    if (threadIdx.x == 0) (void)xb_add(&bar[XB_XCNT(b.x)], 1u);
    return b;
}
__device__ __forceinline__ void xcd_barrier_complete(unsigned* bar, unsigned x, unsigned& nloc, unsigned& nx) {
    const unsigned G = gridDim.x * gridDim.y * gridDim.z;
    unsigned sum, cnt, mine, sp = 0u;
    for (;;) {
        sum = 0u; cnt = 0u; mine = 0u;
#pragma unroll
        for (unsigned j = 0; j < 16; ++j) { const unsigned c = xb_ld(&bar[XB_XCNT(j)]); sum += c; cnt += (c > 0u) ? 1u : 0u; mine = (j == x) ? c : mine; }
        if (sum == G) break;
        __builtin_amdgcn_s_sleep(1);
        if ((++sp & 255u) == 0u) { if (xb_ld(&bar[XB_TMO])) break; if (sp > XB_SPIN_CAP) { atomicAdd(&bar[XB_TMO], 1u); break; } }
    }
    nloc = mine > 0u ? mine : 1u; nx = cnt > 0u ? cnt : 1u;
}
__device__ __forceinline__ void xcd_barrier(const XcdBarrier& b) {
    asm volatile("s_waitcnt vmcnt(0)" ::: "memory");
    __syncthreads();
    if (threadIdx.x == 0) {
        unsigned* bar = b.bar; asm volatile("" : "+s"(bar)); bar = (unsigned*)(GAS unsigned*)bar;
        __builtin_amdgcn_s_waitcnt(0);
        unsigned nloc = b.st[0], nx = b.st[1];
        if (nloc == 0u) { xcd_barrier_complete(bar, b.x, nloc, nx); b.st[0] = nloc; b.st[1] = nx; }
        const unsigned old = xb_add(&bar[XB_XSUB(b.x)], 1u);
        const unsigned gen = old / nloc;
        if (old + 1u == (gen + 1u) * nloc) {
            __builtin_amdgcn_fence(__ATOMIC_RELEASE, "agent");
            asm volatile("s_waitcnt vmcnt(0)" ::: "memory");
            const unsigned og = xb_add(&bar[XB_TOP], 1u);
            const unsigned tg = og / nx;
            if (og + 1u == (tg + 1u) * nx) xb_add(&bar[XB_TOPGEN], 1u);
            else XB_SPIN(xb_ld(&bar[XB_TOPGEN]) == tg, bar);
            __builtin_amdgcn_fence(__ATOMIC_ACQUIRE, "agent");
            xb_add(&bar[XB_XGEN(b.x)], 1u);
            asm volatile("s_waitcnt vmcnt(0)" ::: "memory");
        } else {
            XB_SPIN(xb_ld(&bar[XB_XGEN(b.x)]) == gen, bar);
            __builtin_amdgcn_fence(__ATOMIC_ACQUIRE, "agent");
            asm volatile("s_waitcnt vmcnt(0)" ::: "memory");
        }
    }
    __syncthreads();
}
constexpr int CW_BAR = 4096, CW_CONVQ = 96;

#define ACC8(ai, bj, m) {acc[ai][bj][m][0][0], acc[ai][bj][m][0][1], acc[ai][bj][m][0][2], acc[ai][bj][m][0][3], acc[ai][bj][m][1][0], acc[ai][bj][m][1][1], acc[ai][bj][m][1][2], acc[ai][bj][m][1][3]}
struct FastEpiMain {
    static constexpr bool PERM = true; EpiMain mn; EpiKV kv; float ascale;
    __device__ __forceinline__ bool keep_acc(const pg8::Unit&) const { return false; }
    __device__ __forceinline__ void operator()(f32x4 (&acc)[2][2][4][2], const pg8::Unit& u, int wr, int wc, int fr, int fq) const {
        asm volatile("" : "+v"(fr), "+v"(fq));
        const int rowb = u.row0 + wr * 64 + fr, colb = u.col0 + wc * 32 + 8 * fq;
        if (u.aux != 0) {
#pragma unroll
            for (int ai = 0; ai < 2; ++ai)
#pragma unroll
                for (int m = 0; m < 4; ++m)
#pragma unroll
                    for (int bj = 0; bj < 2; ++bj) { float v[8] = ACC8(ai, bj, m); kv(rowb + ai * 128 + m * 16, colb + bj * 128, v); }
            return;
        }
        f32x4 bb[2][2];
#pragma unroll
        for (int bj = 0; bj < 2; ++bj) { bb[bj][0] = *(const f32x4*)(mn.biasp + colb + bj * 128); bb[bj][1] = *(const f32x4*)(mn.biasp + colb + bj * 128 + 4); }
        float fpos[2][4];
#pragma unroll
        for (int ai = 0; ai < 2; ++ai)
#pragma unroll
            for (int m = 0; m < 4; ++m) fpos[ai][m] = 0.f;
        if (u.col0 < C_V) {
#pragma unroll
            for (int ai = 0; ai < 2; ++ai)
#pragma unroll
                for (int m = 0; m < 4; ++m) fpos[ai][m] = (float)mn.pos[mn.tok0 + rowb + ai * 128 + m * 16];
        }
        float invrev[4]; EpiMain::rope_freqs(colb, invrev);
#pragma unroll
        for (int ai = 0; ai < 2; ++ai)
#pragma unroll
            for (int m = 0; m < 4; ++m)
#pragma unroll
                for (int bj = 0; bj < 2; ++bj) { float v[8] = ACC8(ai, bj, m);
#pragma unroll
                    for (int q = 0; q < 8; ++q) v[q] *= ascale;
                    v[0] += bb[bj][0].x; v[1] += bb[bj][0].y; v[2] += bb[bj][0].z; v[3] += bb[bj][0].w; v[4] += bb[bj][1].x; v[5] += bb[bj][1].y; v[6] += bb[bj][1].z; v[7] += bb[bj][1].w;
                    mn.finish(rowb + ai * 128 + m * 16, colb + bj * 128, v, fpos[ai][m], invrev); }
    }
};
struct FastEpiGates {
    static constexpr bool PERM = true; const float* biasp; bf16_t* GATES; float ascale;
    __device__ __forceinline__ bool keep_acc(const pg8::Unit&) const { return false; }
    __device__ __forceinline__ void operator()(f32x4 (&acc)[2][2][4][2], const pg8::Unit& u, int wr, int wc, int fr, int fq) const {
        asm volatile("" : "+v"(fr), "+v"(fq));
        const int rowb = u.row0 + wr * 64 + fr, colb = u.col0 + wc * 32 + 8 * fq;
        f32x4 bb[2][2];
#pragma unroll
        for (int bj = 0; bj < 2; ++bj) { bb[bj][0] = *(const f32x4*)(biasp + colb + bj * 128); bb[bj][1] = *(const f32x4*)(biasp + colb + bj * 128 + 4); }
#pragma unroll
        for (int ai = 0; ai < 2; ++ai)
#pragma unroll
            for (int m = 0; m < 4; ++m)
#pragma unroll
                for (int bj = 0; bj < 2; ++bj) { const f32x4 a = acc[ai][bj][m][0] * ascale + bb[bj][0], b = acc[ai][bj][m][1] * ascale + bb[bj][1];
                    u32x4 o; o.x = pk2(sigmoidf_(a.x), sigmoidf_(a.y)); o.y = pk2(sigmoidf_(a.z), sigmoidf_(a.w)); o.z = pk2(sigmoidf_(b.x), sigmoidf_(b.y)); o.w = pk2(sigmoidf_(b.z), sigmoidf_(b.w));
                    *(u32x4*)(GATES + (size_t)(rowb + ai * 128 + m * 16) * 3072 + (colb + bj * 128 - C_GATE)) = o; }
    }
};
struct FastEpiMerge {
    static constexpr bool PERM = true; const bf16_t* GATES; bf16_t* MERGED;
    __device__ __forceinline__ bool keep_acc(const pg8::Unit& u) const { return u.aux < 2; }
    __device__ __forceinline__ void operator()(f32x4 (&acc)[2][2][4][2], const pg8::Unit& u, int wr, int wc, int fr, int fq) const {
        asm volatile("" : "+v"(fr), "+v"(fq));
        const int rowb = u.row0 + wr * 64 + fr, colb = u.col0 + wc * 32 + 8 * fq, br = u.aux;
        const unsigned char* gp = (const unsigned char*)GATES + (size_t)rowb * 3072 + br * 1024 + colb;
        bf16_t* mp = MERGED + (size_t)rowb * 1024 + colb;
#pragma unroll
        for (int ai = 0; ai < 2; ++ai) {
            u32x2 tg[4][2], tn[4][2];
#pragma unroll
            for (int m = 0; m < 4; ++m)
#pragma unroll
                for (int bj = 0; bj < 2; ++bj) { tg[m][bj] = *(const u32x2*)(gp + (size_t)(ai * 128 + m * 16) * 3072 + bj * 128);
                    if (br < 2) tn[m][bj] = *(const u32x2*)(gp + 1024 + (size_t)(ai * 128 + m * 16) * 3072 + bj * 128); }
            if (br < 2) {
#pragma unroll
                for (int m = 0; m < 4; ++m)
#pragma unroll
                    for (int bj = 0; bj < 2; ++bj) { const u32x2 g = tg[m][bj], n = tn[m][bj]; const f32x4 n0 = u8x4_raw(n.x), n1 = u8x4_raw(n.y);
                        const f32x4 r0 = {__builtin_amdgcn_rcpf(n0.x), __builtin_amdgcn_rcpf(n0.y), __builtin_amdgcn_rcpf(n0.z), __builtin_amdgcn_rcpf(n0.w)}, r1 = {__builtin_amdgcn_rcpf(n1.x), __builtin_amdgcn_rcpf(n1.y), __builtin_amdgcn_rcpf(n1.z), __builtin_amdgcn_rcpf(n1.w)};
                        acc[ai][bj][m][0] = acc[ai][bj][m][0] * (u8x4_raw(g.x) * r0); acc[ai][bj][m][1] = acc[ai][bj][m][1] * (u8x4_raw(g.y) * r1); }
            } else {
#pragma unroll
                for (int m = 0; m < 4; ++m)
#pragma unroll
                    for (int bj = 0; bj < 2; ++bj) { const u32x2 g = tg[m][bj]; const f32x4 a = acc[ai][bj][m][0] * u8x4_to_f32(g.x), b = acc[ai][bj][m][1] * u8x4_to_f32(g.y);
                        u32x4 o; o.x = pk2(a.x, a.y); o.y = pk2(a.z, a.w); o.z = pk2(b.x, b.y); o.w = pk2(b.z, b.w);
                        *(u32x4*)(mp + (size_t)(ai * 128 + m * 16) * 1024 + bj * 128) = o; }
            }
            asm volatile("" ::: "memory");
        }
    }
};
struct FastEpiStore {
    static constexpr bool PERM = true; bf16_t* O; int ld; float scale;
    __device__ __forceinline__ bool keep_acc(const pg8::Unit&) const { return false; }
    __device__ __forceinline__ void operator()(f32x4 (&acc)[2][2][4][2], const pg8::Unit& u, int wr, int wc, int fr, int fq) const {
        asm volatile("" : "+v"(fr), "+v"(fq));
        const int rowb = u.row0 + wr * 64 + fr, colb = u.col0 + wc * 32 + 8 * fq;
#pragma unroll
        for (int ai = 0; ai < 2; ++ai)
#pragma unroll
            for (int m = 0; m < 4; ++m)
#pragma unroll
                for (int bj = 0; bj < 2; ++bj) { const f32x4 a = acc[ai][bj][m][0] * scale, b = acc[ai][bj][m][1] * scale;
                    u32x4 o; o.x = pk2(a.x, a.y); o.y = pk2(a.z, a.w); o.z = pk2(b.x, b.y); o.w = pk2(b.z, b.w);
                    *(u32x4*)(O + (size_t)(rowb + ai * 128 + m * 16) * ld + colb + bj * 128) = o; }
    }
};
struct FastEpiMoe1 {
    static constexpr bool PERM = true; LAS const int* toktab; const float* wts; unsigned char* H8;
    __device__ __forceinline__ bool keep_acc(const pg8::Unit&) const { return false; }
    __device__ __forceinline__ void operator()(f32x4 (&acc)[2][2][4][2], const pg8::Unit& u, int wr, int wc, int fr, int fq) const {
        asm volatile("" : "+v"(fr), "+v"(fq));
        const int rloc = wr * 64 + fr, colb = u.col0 + wc * 32 + 8 * fq, hi = u.col0 >> 10;
        float w[2][4];
#pragma unroll
        for (int ai = 0; ai < 2; ++ai)
#pragma unroll
            for (int m = 0; m < 4; ++m) { const int tok = toktab[u.aux * 256 + rloc + ai * 128 + m * 16]; w[ai][m] = wts[(size_t)tok * 2 + hi] * (H8_SCALE / W8_SCALE); }
        constexpr float inv = 1.0f / W8_SCALE;
#pragma unroll
        for (int ai = 0; ai < 2; ++ai)
#pragma unroll
            for (int m = 0; m < 4; ++m)
#pragma unroll
                for (int bj = 0; bj < 2; ++bj) { const f32x4 gt = acc[ai][bj][m][0] * inv, up = acc[ai][bj][m][1]; const float ww = w[ai][m];
                    const int j0 = hi * 512 + (((colb + bj * 128) & 1023) >> 1);
                    float h[4] = {gt.x * sigmoidf_(gt.x) * up.x * ww, gt.y * sigmoidf_(gt.y) * up.y * ww, gt.z * sigmoidf_(gt.z) * up.z * ww, gt.w * sigmoidf_(gt.w) * up.w * ww};
#pragma unroll
                    for (int q = 0; q < 4; ++q) h[q] = fminf(fmaxf(h[q], -448.f), 448.f);
                    *(unsigned*)(H8 + (size_t)(u.row0 + rloc + ai * 128 + m * 16) * 1024 + j0) = pk4_fp8(h[0], h[1], h[2], h[3]); }
    }
};
#undef ACC8

struct SchedMain {
    pg8::TileOrder to; int nkv, tile0, cut, skip; size_t astep, bstep; const char *XB, *WIN, *MEMB, *WKV;
    __device__ __forceinline__ bool next(int i, pg8::Unit& u) const {
        int pm, pn;
        if (to.tile(i, pm, pn)) { const int ct = tile0 + (pn < cut ? pn : pn + skip); u.A = XB + (size_t)pm * astep; u.B = WIN + (size_t)ct * bstep; u.row0 = pm * 256; u.col0 = ct * 256; u.bjump = 0; u.aux = 0; return true; }
        const long L = (long)i * to.G + to.c - to.nwg; if (L >= nkv) return false;
        pm = (int)(L >> 2); pn = (int)(L & 3);
        u.A = MEMB + (size_t)pm * 256 * 2048; u.B = WKV + (size_t)pn * 256 * 2048; u.row0 = pm * 256; u.col0 = pn * 256; u.bjump = 0; u.aux = 1; return true;
    }
};
struct SchedMerge {
    pg8::TileOrder to; const char *A0, *W;
    __device__ __forceinline__ bool next(int i, pg8::Unit& u) const {
        const int ti = i / 3, br = i - ti * 3; int pm, pn; if (!to.tile(ti, pm, pn)) return false;
        u.A = A0 + (size_t)br * SZ_512 + (size_t)pm * 256 * 1024; u.B = W + (size_t)br * MiB + (size_t)pn * 256 * 1024; u.row0 = pm * 256; u.col0 = pn * 256; u.bjump = 0; u.aux = br; return true;
    }
};
struct SchedPlain {
    pg8::TileOrder to; const char *A, *B; size_t astep, bstep;
    __device__ __forceinline__ bool next(int i, pg8::Unit& u) const {
        int pm, pn; if (!to.tile(i, pm, pn)) return false;
        u.A = A + (size_t)pm * astep; u.B = B + (size_t)pn * bstep; u.row0 = pm * 256; u.col0 = pn * 256; u.bjump = 0; u.aux = 0; return true;
    }
};
struct SchedMoe {
    pg8::TileOrder to; LAS const int* pan_cls; LAS const int* toktab; const char *H, *W1, *W2; int mode;
    __device__ __forceinline__ LAS const int* toks(int i) const { return toktab + i * 256; }
    __device__ __forceinline__ bool next(int i, pg8::Unit& u) const {
        int pm, pn; if (!to.tile(i, pm, pn)) return false;
        const int cls = pan_cls[pm]; int e_lo, e_hi; class_experts(cls, e_lo, e_hi);
        u.row0 = pm * 256; u.col0 = pn * 256; u.aux = i; u.bjump = 0;
        if (mode == 1) { u.A = nullptr; u.B = W1 + ((size_t)(pn < 4 ? e_lo : e_hi) * 1024 + (size_t)(pn & 3) * 256) * 1024; }
        else { u.A = H + (size_t)pm * 256 * 1024; u.B = W2 + (size_t)pn * 256 * 8192 + (size_t)e_lo * 512; u.bjump = (e_hi - e_lo - 1) * 512; }
        return true;
    }
};

template <int WHICH> __device__ __forceinline__ float tw_src(const Params& p, int k, int n) {
    if constexpr (WHICH == TW_IN) return p.w_in[(size_t)k * INC + win_logical(n)];
    else if constexpr (WHICH == TW_KV) return p.w_mem_kv[(size_t)k * 1024 + n];
    else if constexpr (WHICH == TW_A) return p.w_attn_o[(size_t)k * 1024 + n];
    else if constexpr (WHICH == TW_C) return p.w_conv_o[(size_t)k * 1024 + n];
    else if constexpr (WHICH == TW_M) return p.w_mem_o[(size_t)k * 1024 + n];
    else if constexpr (WHICH == TW_OUT) return p.w_out[(size_t)k * 1024 + n];
    else if constexpr (WHICH == TW_W1) { const int e = n >> 10, c = n & 1023, G = c >> 3, nn = (c >> 2) & 1, ee = c & 3, jj = 4 * G + ee; return (nn ? p.w_eu : p.w_eg)[((size_t)e * 1024 + k) * 512 + jj]; }
    else { const int e = n >> 10, c = n & 1023; return p.w_ed[((size_t)e * 512 + k) * 1024 + c]; }
}
template <int WHICH> __device__ __forceinline__ void tw_item(const Params& p, int item, float* scr, int lane) {
    constexpr int N = WHICH == TW_IN ? INC : (WHICH >= TW_W1 ? 16 * 1024 : 1024);
    constexpr int ldd = (WHICH == TW_A || WHICH == TW_C || WHICH == TW_M) ? 512 : (WHICH == TW_W2 ? 8192 : 1024);
    constexpr size_t dsto = WHICH == TW_IN ? WS_WIN : WHICH == TW_KV ? WS_WKV : WHICH == TW_A ? WS_WA : WHICH == TW_C ? WS_WC : WHICH == TW_M ? WS_WM : WHICH == TW_OUT ? WS_WOUT : WHICH == TW_W1 ? WS_W1 : WS_W2;
    bf16_t* dst = WSP(bf16_t, dsto);
    constexpr int nblk = N / 32; const int kb = item / nblk, nb = item - kb * nblk, k0 = 64 * kb, n0 = 32 * nb;
#pragma unroll 8
    for (int i = 0; i < 32; ++i) { const int kk = 2 * i + (lane >> 5); scr[kk * 33 + (lane & 31)] = tw_src<WHICH>(p, k0 + kk, n0 + (lane & 31)); }
    asm volatile("s_waitcnt lgkmcnt(0)" ::: "memory");
    const int c = lane & 7;
#pragma unroll
    for (int j = 0; j < 4; ++j) { const int n = (lane >> 3) + 8 * j; const float* sp = scr + (8 * c) * 33 + n;
        const int nn = n0 + n; size_t doff;
        if constexpr (WHICH == TW_W2) doff = (size_t)(nn & 1023) * 8192 + (size_t)(nn >> 10) * 512 + k0 + 8 * c; else doff = (size_t)nn * ldd + k0 + 8 * c;
        if constexpr (WHICH >= TW_W1) {
            u32x2 o; o.x = pk4_fp8(W8_SCALE * sp[0 * 33], W8_SCALE * sp[1 * 33], W8_SCALE * sp[2 * 33], W8_SCALE * sp[3 * 33]); o.y = pk4_fp8(W8_SCALE * sp[4 * 33], W8_SCALE * sp[5 * 33], W8_SCALE * sp[6 * 33], W8_SCALE * sp[7 * 33]);
            *(u32x2*)((unsigned char*)dst + doff) = o;
        } else {
            u32x4 o; o.x = pk2(sp[0 * 33], sp[1 * 33]); o.y = pk2(sp[2 * 33], sp[3 * 33]); o.z = pk2(sp[4 * 33], sp[5 * 33]); o.w = pk2(sp[6 * 33], sp[7 * 33]);
            *(u32x4*)(dst + doff) = o;
            if constexpr (WHICH == TW_IN) {
                u32x2 q; q.x = pk4_fp8(WG8_SCALE * sp[0 * 33], WG8_SCALE * sp[1 * 33], WG8_SCALE * sp[2 * 33], WG8_SCALE * sp[3 * 33]); q.y = pk4_fp8(WG8_SCALE * sp[4 * 33], WG8_SCALE * sp[5 * 33], WG8_SCALE * sp[6 * 33], WG8_SCALE * sp[7 * 33]);
                *(u32x2*)(p.ws + WS_WG8 + doff) = q; } } }
    asm volatile("s_waitcnt lgkmcnt(0)" ::: "memory");
}
__device__ __forceinline__ void transpose_all(const Params& p, float* scr, int gw, int ngw, int lane) {
    constexpr int I_IN = 16 * (INC / 32), I_KV = 16 * 32, I_B = 8 * 32, I_OUT = 16 * 32, I_W1 = 16 * 512, I_W2 = 8 * 512;
    constexpr int NITEMS = I_IN + I_KV + 3 * I_B + I_OUT + I_W1 + I_W2;
    for (int it = gw; it < NITEMS; it += ngw) {
        int r = it;
        if (r < I_W1) { tw_item<TW_W1>(p, r, scr, lane); continue; } r -= I_W1;
        if (r < I_IN) { tw_item<TW_IN>(p, r, scr, lane); continue; } r -= I_IN;
        if (r < I_W2) { tw_item<TW_W2>(p, r, scr, lane); continue; } r -= I_W2;
        if (r < I_KV) { tw_item<TW_KV>(p, r, scr, lane); continue; } r -= I_KV;
        if (r < I_OUT) { tw_item<TW_OUT>(p, r, scr, lane); continue; } r -= I_OUT;
        if (r < I_B) { tw_item<TW_A>(p, r, scr, lane); continue; } r -= I_B;
        if (r < I_B) { tw_item<TW_C>(p, r, scr, lane); continue; } r -= I_B;
        tw_item<TW_M>(p, r, scr, lane);
    }
}

__device__ __forceinline__ void cvt_bf16_dev(const float* __restrict__ src, bf16_t* __restrict__ dst, size_t n8, size_t gtid, size_t gstride) {
    for (size_t i = gtid; i < n8; i += gstride) {
        const f32x4 a = *(const f32x4*)(src + i * 8), b = *(const f32x4*)(src + i * 8 + 4);
        u32x4 o; o.x = pk2(a.x, a.y); o.y = pk2(a.z, a.w); o.z = pk2(b.x, b.y); o.w = pk2(b.z, b.w);
        *(u32x4*)(dst + i * 8) = o;
    }
}

__device__ __forceinline__ void cvt_x_dev(const float* __restrict__ src, bf16_t* __restrict__ dst, unsigned char* __restrict__ dst8, size_t n16, size_t gtid, size_t gstride) {
    for (size_t i = gtid; i < n16; i += 2 * gstride) {
        const size_t i2 = i + gstride; const bool has2 = i2 < n16; const size_t j2 = has2 ? i2 : i;
        f32x4 a[2][4];
#pragma unroll
        for (int q = 0; q < 4; ++q) { a[0][q] = *(const f32x4*)(src + i * 16 + 4 * q); a[1][q] = *(const f32x4*)(src + j2 * 16 + 4 * q); }
#pragma unroll
        for (int r = 0; r < 2; ++r) { if (r == 1 && !has2) break; const size_t ii = r ? i2 : i;
            u32x4 o0, o1; o0.x = pk2(a[r][0].x, a[r][0].y); o0.y = pk2(a[r][0].z, a[r][0].w); o0.z = pk2(a[r][1].x, a[r][1].y); o0.w = pk2(a[r][1].z, a[r][1].w);
            o1.x = pk2(a[r][2].x, a[r][2].y); o1.y = pk2(a[r][2].z, a[r][2].w); o1.z = pk2(a[r][3].x, a[r][3].y); o1.w = pk2(a[r][3].z, a[r][3].w);
            *(u32x4*)(dst + ii * 16) = o0; *(u32x4*)(dst + ii * 16 + 8) = o1;
            u32x4 q8; q8.x = pk4_fp8(a[r][0].x, a[r][0].y, a[r][0].z, a[r][0].w); q8.y = pk4_fp8(a[r][1].x, a[r][1].y, a[r][1].z, a[r][1].w); q8.z = pk4_fp8(a[r][2].x, a[r][2].y, a[r][2].z, a[r][2].w); q8.w = pk4_fp8(a[r][3].x, a[r][3].y, a[r][3].z, a[r][3].w);
            *(u32x4*)(dst8 + ii * 16) = q8; }
    }
}
__device__ __forceinline__ void wg8_dev(const Params& p, size_t gtid, size_t gstride) {
    for (size_t i = gtid; i < (size_t)INC * 64; i += gstride) { const int n = (int)(i % INC), k0 = (int)(i / INC) * 16, nl = win_logical(n); float v[16];
#pragma unroll
        for (int j = 0; j < 16; ++j) v[j] = WG8_SCALE * p.w_in[(size_t)(k0 + j) * INC + nl];
        u32x4 q; q.x = pk4_fp8(v[0], v[1], v[2], v[3]); q.y = pk4_fp8(v[4], v[5], v[6], v[7]); q.z = pk4_fp8(v[8], v[9], v[10], v[11]); q.w = pk4_fp8(v[12], v[13], v[14], v[15]);
        *(u32x4*)(p.ws + WS_WG8 + (size_t)n * 1024 + k0) = q; }
}

struct Args { Params p; int ph_lo, ph_hi; };
typedef const __attribute__((address_space(4))) unsigned long long* KArgPtr;
__device__ __forceinline__ Params load_params(KArgPtr q) {
    asm volatile("" : "+s"(q));
    Params p;
    p.x = (const float*)(const GAS float*)q[0]; p.mem = (const float*)(const GAS float*)q[1]; p.pos = (const int*)(const GAS int*)q[2]; p.w_in = (const float*)(const GAS float*)q[3]; p.b_in = (const float*)(const GAS float*)q[4]; p.conv_w = (const float*)(const GAS float*)q[5]; p.conv_b = (const float*)(const GAS float*)q[6];
    p.conv_g = (const float*)(const GAS float*)q[7]; p.conv_bb = (const float*)(const GAS float*)q[8]; p.w_mem_kv = (const float*)(const GAS float*)q[9]; p.w_attn_o = (const float*)(const GAS float*)q[10]; p.w_conv_o = (const float*)(const GAS float*)q[11]; p.w_mem_o = (const float*)(const GAS float*)q[12];
    p.w_out = (const float*)(const GAS float*)q[13]; p.ln1_g = (const float*)(const GAS float*)q[14]; p.ln1_b = (const float*)(const GAS float*)q[15]; p.w_gr = (const float*)(const GAS float*)q[16]; p.b_gr = (const float*)(const GAS float*)q[17]; p.w_er = (const float*)(const GAS float*)q[18]; p.b_er = (const float*)(const GAS float*)q[19];
    p.w_eg = (const float*)(const GAS float*)q[20]; p.w_eu = (const float*)(const GAS float*)q[21]; p.w_ed = (const float*)(const GAS float*)q[22]; p.ln2_g = (const float*)(const GAS float*)q[23]; p.ln2_b = (const float*)(const GAS float*)q[24]; p.out = (float*)(GAS float*)q[25]; p.ws = (unsigned char*)(GAS unsigned char*)q[26];
    return p;
}
static_assert(sizeof(Params) == 27 * 8, "Params is 27 pointers");
constexpr int PH_P0 = 0, PH_CH0 = 1, PH_PER_CH = 5, PH_LN1 = PH_CH0 + PH_PER_CH * NCH, PH_MOE1 = PH_LN1 + 1, PH_MOE2 = PH_LN1 + 2, PH_LN2 = PH_LN1 + 3, PH_END = PH_LN1 + 4;

__global__ void __launch_bounds__(NTHR, 2) mk_fwd(Args args) {
    extern __shared__ __attribute__((aligned(16))) unsigned char lds_raw[];
    LAS unsigned char* lds = (LAS unsigned char*)lds_raw;
    const KArgPtr kargs = (KArgPtr)__builtin_amdgcn_kernarg_segment_ptr();
    const int wave = __builtin_amdgcn_readfirstlane((int)threadIdx.x >> 6);
    const int G = gridDim.x; const int bx = blockIdx.x; const int vcu = (G % 8 == 0) ? (bx % 8) * (G / 8) + bx / 8 : bx;
    volatile LAS unsigned* MISC = (volatile LAS unsigned*)(lds + LCTL_OFF);
    ClassTab* tab = (ClassTab*)(lds_raw + LCTL_OFF + 256);
    int* pan_cls = (int*)(lds_raw + LCTL_OFF + 512);
    int* toktab = (int*)(lds_raw + LTOK_OFF);
    for (int u = threadIdx.x; u < (LDS_BYTES - LCTL_OFF) / 4; u += NTHR) ((LAS unsigned*)(lds + LCTL_OFF))[u] = 0u;
    __syncthreads();
    const int lo = args.ph_lo, hi = args.ph_hi;
    unsigned* ctl; { const Params p = load_params(kargs); ctl = WSP(unsigned, WS_CTL); }
    XcdBarrier bar; bar.bar = ctl + CW_BAR; bar.x = 0; bar.st = nullptr;
    if (hi - lo > 1) bar = xcd_barrier_post(ctl + CW_BAR, MISC);
#ifndef PHMASK
#define PHMASK 0x3ff
#endif
#ifndef P1_QK_FP8
#define P1_QK_FP8 3
#endif
#if P1_QK_FP8 == 3
constexpr int P1_BF16_TILES = 4, P1_BF16_T0 = 18, P1_BF16_CUT = 4, P1_BF16_SKIP = 0, P1_FP8_TILES = 32, P1_FP8_T0 = 0, P1_FP8_CUT = 18, P1_FP8_SKIP = 4;
#elif P1_QK_FP8 == 2
constexpr int P1_BF16_TILES = 0, P1_BF16_T0 = 0, P1_BF16_CUT = 0, P1_BF16_SKIP = 0, P1_FP8_TILES = 36, P1_FP8_T0 = 0, P1_FP8_CUT = 36, P1_FP8_SKIP = 0;
#elif P1_QK_FP8
constexpr int P1_BF16_TILES = 6, P1_BF16_T0 = 18, P1_BF16_CUT = 6, P1_BF16_SKIP = 0, P1_FP8_TILES = 30, P1_FP8_T0 = 0, P1_FP8_CUT = 18, P1_FP8_SKIP = 6;
#else
constexpr int P1_BF16_TILES = 18, P1_BF16_T0 = 0, P1_BF16_CUT = 12, P1_BF16_SKIP = 6, P1_FP8_TILES = 18, P1_FP8_T0 = 12, P1_FP8_CUT = 6, P1_FP8_SKIP = 6;
#endif
#ifndef ATTN_V2
#define ATTN_V2 1
#endif
#ifndef PROBE_DUP
#define PROBE_DUP (-1)
#endif
#define NREP(b) ((PROBE_DUP == (b)) ? 2 : 1)
#define IN(k) (lo <= (k) && (k) < hi)
#define HAS(b) ((PHMASK >> (b)) & 1)
#define SEAM(k) do { if (IN(k) && IN((k) + 1)) xcd_barrier(bar); } while (0)

    if (HAS(0) && IN(PH_P0)) {
        const Params p = load_params(kargs);
        const size_t gtid = (size_t)bx * NTHR + opaque_tid(wave), gstride = (size_t)G * NTHR;
        for (int rep = 0; rep < NREP(0); ++rep) {
        { const int ptid = opaque_tid(wave); transpose_all(p, (float*)(lds_raw + RING_OFF) + (ptid >> 6) * (64 * 33), bx * NWAVES + (ptid >> 6), G * NWAVES, ptid & 63); }
        small_prep_dev(p, gtid, gstride);
        cvt_bf16_dev(p.mem, WSP(bf16_t, WS_MEMB), (size_t)NB * MEML * 1024 / 8, gtid, gstride);
        cvt_x_dev(p.x, WSP(bf16_t, WS_XB), p.ws + WS_XB8, (size_t)T * 1024 / 16, gtid, gstride);
        }
    }
    SEAM(PH_P0);
    if (PROBE_DUP == 10 && hi - lo > 1) for (int r = 0; r < 16; ++r) xcd_barrier(bar);

    for (int ch = 0; ch < NCH; ++ch) {
        const int ph0 = PH_CH0 + PH_PER_CH * ch;
        if (HAS(1) && IN(ph0)) {
            const Params p = load_params(kargs);
            const EpiMain em{WSP(float, WS_BIASP), p.pos, WSP(bf16_t, WS_QG), WSP(bf16_t, WS_CGLU), WSP(bf16_t, WS_QM), WSP(bf16_t, WS_GATES), ch * TC};
            for (int rep = 0; rep < NREP(1); ++rep) {
            {
                SchedMain S; S.to.init(TC / 256, P1_BF16_TILES, G, bx); S.nkv = ch == 0 ? (NB * MEML / 256) * 4 : 0; S.tile0 = P1_BF16_T0; S.cut = P1_BF16_CUT; S.skip = P1_BF16_SKIP; S.astep = 256 * 2048; S.bstep = 256 * 2048;
                S.XB = (const char*)(WSP(bf16_t, WS_XB) + (size_t)ch * TC * 1024); S.WIN = (const char*)WSP(bf16_t, WS_WIN); S.MEMB = (const char*)WSP(bf16_t, WS_MEMB); S.WKV = (const char*)WSP(bf16_t, WS_WKV);
                FastEpiMain E{em, EpiKV{WSP(bf16_t, WS_KM)}, 1.0f};
#ifndef NO_P1A
                pg8::gemm_phase<FastEpiMain, SchedMain, true, false, false>(lds + RING_OFF, nullptr, 1024, 1024, 1024, S, E, wave);
#endif
                if (PROBE_DUP == 16) { FastEpiStore E2{WSP(bf16_t, WS_MERGED), 1024, 1.0f}; pg8::gemm_phase<FastEpiStore, SchedMain, true, false, false>(lds + RING_OFF, nullptr, 1024, 1024, 1024, S, E2, wave); }
            }
            {
                SchedMain S; S.to.init(TC / 256, P1_FP8_TILES, G, bx); S.nkv = 0; S.tile0 = P1_FP8_T0; S.cut = P1_FP8_CUT; S.skip = P1_FP8_SKIP; S.astep = 256 * 1024; S.bstep = 256 * 1024;
                S.XB = (const char*)(p.ws + WS_XB8 + (size_t)ch * TC * 1024); S.WIN = (const char*)(p.ws + WS_WG8); S.MEMB = nullptr; S.WKV = nullptr;
                FastEpiMain E{em, EpiKV{WSP(bf16_t, WS_KM)}, 1.0f / WG8_SCALE};
#ifndef NO_P1B
                pg8::gemm_phase<FastEpiMain, SchedMain, true, false, false, true>(lds + RING_OFF, nullptr, 512, 512, 512, S, E, wave);
#endif
                if (PROBE_DUP == 17) { FastEpiStore E2{WSP(bf16_t, WS_MERGED), 1024, 1.0f}; pg8::gemm_phase<FastEpiStore, SchedMain, true, false, false, true>(lds + RING_OFF, nullptr, 512, 512, 512, S, E2, wave); }
            }
            }
        }
        SEAM(ph0);
        if (HAS(2) && IN(ph0 + 1)) {
            const Params p = load_params(kargs);
            constexpr int NDIL = BC * 12 * 8, NMEMB = BC * 4 * 8, NBLK = NDIL + NMEMB;
#if ATTN_V2
            for (int rep = 0; rep < NREP(2); ++rep) {
            const bool dummy = (PROBE_DUP == 2) && rep == 0;
            LAS char* rlds = (LAS char*)(lds + RING_OFF); LAS float* scr = (LAS float*)(lds + LTOK_OFF);
            for (int hd = vcu; hd < BC * 16; hd += G) {
                if (hd < BC * 12) { const int g = (hd % 12) >> 2; const size_t base = (size_t)hd * 2048 * 128;
                    swa::head_dilated(WSP(bf16_t, WS_QG) + base, dummy ? WSP(bf16_t, WS_MERGED) + (size_t)(hd & 127) * 2048 * 128 : WSP(bf16_t, WS_QG) + base, WSP(bf16_t, WS_KG) + base, WSP(bf16_t, WS_VG) + base, WSP(float, WS_LSE) + (size_t)hd * 2048, (2048 >> (2 * g)) - 1, rlds, scr, wave);
                } else { const int bh = hd - BC * 12, bl = bh >> 2, h = bh & 3; const size_t kvb = (size_t)(ch * BC * 4 + bh) * 256 * 128;
                    swa::head_mem(WSP(bf16_t, WS_QM) + (size_t)bh * 2048 * 128, WSP(bf16_t, WS_KM) + kvb, WSP(bf16_t, WS_VM) + kvb, WSP(bf16_t, WS_OMT) + (size_t)bl * 2048 * 512 + h * 128, 512, rlds, scr, wave); }
            }
            __syncthreads();
            }
            {
                const Params pc = load_params(kargs); const int ptid = opaque_tid(wave); volatile LAS unsigned* qslot = MISC + 4;
                for (;;) {
                    if (ptid == 0) *qslot = atomicAdd(ctl + CW_CONVQ + ch, 1u);
                    __syncthreads();
                    const int u = (int)*qslot;
                    if (u >= BC * 64) break;
                    conv_unit(pc, u, lds_raw + RING_OFF, ptid);
                }
            }
        }
#else
            for (int rep = 0; rep < NREP(2); ++rep) {
            const bool dummy = (PROBE_DUP == 2) && rep == 0;
            auto make_ref = [&](int L) -> swa::BlockRef {
                swa::BlockRef r;
                if (L < NDIL) { const int bgh = L >> 3, qb = L & 7, g = (bgh % 12) >> 2; const size_t base = (size_t)bgh * 2048 * 128;
                    r.Q = WSP(bf16_t, WS_QG) + base + (size_t)qb * 256 * 128; r.K = WSP(bf16_t, WS_KG) + base; r.V = WSP(bf16_t, WS_VG) + base; r.O = dummy ? WSP(bf16_t, WS_MERGED) + (base % (SZ_XB / 2 - 65536)) : (bf16_t*)r.Q;
                    r.LSE = WSP(float, WS_LSE) + (size_t)bgh * 2048 + qb * 256; r.P0 = qb * 256; r.W = 129; r.segmask = (2048 >> (2 * g)) - 1; r.skv = 2048; r.ostride = 128; }
                else { const int idx = L - NDIL, bh = idx >> 3, qb = idx & 7, bl = bh >> 2, h = bh & 3; const size_t kvb = (size_t)(ch * BC * 4 + bh) * 256 * 128;
                    r.Q = WSP(bf16_t, WS_QM) + ((size_t)bh * 2048 + qb * 256) * 128; r.K = WSP(bf16_t, WS_KM) + kvb; r.V = WSP(bf16_t, WS_VM) + kvb;
                    r.O = WSP(bf16_t, WS_OMT) + ((size_t)bl * 2048 + qb * 256) * 512 + h * 128; r.LSE = nullptr; r.P0 = 256; r.W = 1 << 20; r.segmask = (1 << 20) - 1; r.skv = 256; r.ostride = 512; }
                return r; };
            int L = vcu;
            if (L < NBLK) {
                swa::BlockRef cur = make_ref(L); swa::Seam Sm;
                swa::prime(cur, (char*)lds_raw + RING_OFF, Sm, wave);
                for (;;) {
                    const bool more = L + G < NBLK; const int Ln = more ? L + G : L;
                    const swa::BlockRef nxt = more ? make_ref(Ln) : cur;
                    swa::block(cur, nxt, (char*)lds_raw + RING_OFF, Sm, wave);
                    if (!more) break;
                    cur = nxt; L = Ln;
                }
            }
            __syncthreads();
            { const Params pc = load_params(kargs); const int ptid = opaque_tid(wave); for (int u = bx; u < BC * 64; u += G) conv_unit(pc, u, lds_raw + RING_OFF, ptid); }
            if (PROBE_DUP == 13) { const int ptid = opaque_tid(wave); for (int u = bx; u < BC * 64; u += G) conv_unit(p, u, lds_raw + RING_OFF, ptid); }
            if (PROBE_DUP == 14) {
                int L = NDIL + vcu;
                if (L < NBLK) { swa::BlockRef cur = make_ref(L); swa::Seam Sm; swa::prime(cur, (char*)lds_raw + RING_OFF, Sm, wave);
                    for (;;) { const bool more = L + G < NBLK; const int Ln = more ? L + G : L; const swa::BlockRef nxt = more ? make_ref(Ln) : cur; swa::block(cur, nxt, (char*)lds_raw + RING_OFF, Sm, wave); if (!more) break; cur = nxt; L = Ln; } }
                __syncthreads();
            }
            }
        }
#endif
        SEAM(ph0 + 1);
        if (HAS(3) && IN(ph0 + 2)) { const Params p = load_params(kargs); const int ptid = opaque_tid(wave); for (int rep = 0; rep < NREP(3); ++rep) for (int w = bx * NWAVES + (ptid >> 6); w < TC; w += G * NWAVES) combine_token(p, w, ptid & 63); }
        SEAM(ph0 + 2);
        if (HAS(4) && IN(ph0 + 3)) {
            const Params p = load_params(kargs);
            SchedMerge S; S.to.init(TC / 256, 4, G, bx); S.A0 = (const char*)WSP(bf16_t, WS_OATT); S.W = (const char*)WSP(bf16_t, WS_WA);
            FastEpiMerge E{WSP(bf16_t, WS_GATES), WSP(bf16_t, WS_MERGED)};
            if (PROBE_DUP == 15) { FastEpiStore E2{WSP(bf16_t, WS_MERGED), 1024, 1.0f}; pg8::gemm_phase<FastEpiStore, SchedMerge, true, false, false>(lds + RING_OFF, nullptr, 512, 512, 512, S, E2, wave); }
            for (int rep = 0; rep < NREP(4); ++rep) pg8::gemm_phase<FastEpiMerge, SchedMerge, true, false, false>(lds + RING_OFF, nullptr, 512, 512, 512, S, E, wave);
        }
        SEAM(ph0 + 3);
        if (HAS(5) && IN(ph0 + 4)) {
            const Params p = load_params(kargs);
            SchedPlain S; S.to.init(TC / 256, 4, G, bx); S.A = (const char*)WSP(bf16_t, WS_MERGED); S.B = (const char*)WSP(bf16_t, WS_WOUT); S.astep = 256 * 2048; S.bstep = 256 * 2048;
            FastEpiStore E{(bf16_t*)p.out + (size_t)ch * TC * 1024, 1024, 1.0f};
            for (int rep = 0; rep < NREP(5); ++rep) pg8::gemm_phase<FastEpiStore, SchedPlain, true, false, false>(lds + RING_OFF, nullptr, 1024, 1024, 1024, S, E, wave);
        }
        SEAM(ph0 + 4);
    }

    if (HAS(6) && IN(PH_LN1)) {
        const Params p = load_params(kargs);
        float* wr = (float*)(lds_raw + RING_OFF); int* cls_l = (int*)(wr + 20 * 1024); int* misc = cls_l + 64;
        for (int i = opaque_tid(wave); i < 20 * 1024; i += NTHR) wr[i] = WSP(float, WS_WRT)[i];
        __syncthreads();
        { const int ptid = opaque_tid(wave); for (int rep = 0; rep < NREP(6); ++rep) for (int u = bx; u < T / 64; u += G) ln1_unit(p, u, wr, cls_l, misc, ptid, (PROBE_DUP == 6) && rep == 0); }
    }
    SEAM(PH_LN1);
    if (IN(PH_MOE1) || IN(PH_MOE2) || IN(PH_LN2)) {
        const int tid = opaque_tid(wave);
        if (tid == 0) class_tab_fill(ctl + CW_CNT, tab);
        __syncthreads();
        const int NP = tab->rowbase[NCLS] >> 8;
        for (int pm = tid; pm < NP; pm += NTHR) pan_cls[pm] = find_class(tab, pm * 256);
        __syncthreads();
    }
    if (HAS(7) && IN(PH_MOE1)) {
        const Params p = load_params(kargs);
        const int NP = tab->rowbase[NCLS] >> 8;
        SchedMoe S; S.to.init(NP, 8, G, bx); S.pan_cls = (LAS const int*)(lds + LCTL_OFF + 512); S.toktab = (LAS const int*)(lds + LTOK_OFF); S.H = nullptr; S.W1 = (const char*)WSP(bf16_t, WS_W1); S.W2 = nullptr; S.mode = 1;
        const int tid = opaque_tid(wave);
        for (int i = 0; i < MAXU; ++i) { int pm, pn; if (!S.to.tile(i, pm, pn)) break;
            if (tid < 256) { const int cls = pan_cls[pm]; int r = pm * 256 + tid - tab->rowbase[cls]; if (r >= tab->cnt[cls]) r = tab->cnt[cls] - 1; toktab[i * 256 + tid] = WSP(int, WS_LIST)[(size_t)cls * T + r]; } }
        __syncthreads();
        FastEpiMoe1 E{(LAS const int*)(lds + LTOK_OFF), WSP(float, WS_WTS), p.ws + WS_H};
        for (int rep = 0; rep < NREP(7); ++rep) pg8::gemm_phase<FastEpiMoe1, SchedMoe, true, true, false, true>(lds + RING_OFF, (const char*)(p.ws + WS_X1B8), 512, 512, 512, S, E, wave);
    }
    SEAM(PH_MOE1);
    if (HAS(8) && IN(PH_MOE2)) {
        const Params p = load_params(kargs);
        const int NP = tab->rowbase[NCLS] >> 8;
        SchedMoe S; S.to.init(NP, 4, G, bx); S.pan_cls = (LAS const int*)(lds + LCTL_OFF + 512); S.toktab = (LAS const int*)(lds + LTOK_OFF); S.H = (const char*)WSP(bf16_t, WS_H); S.W1 = nullptr; S.W2 = (const char*)WSP(bf16_t, WS_W2); S.mode = 2;
        FastEpiStore E{WSP(bf16_t, WS_Y2), 1024, 1.0f / (H8_SCALE * W8_SCALE)};
        for (int rep = 0; rep < NREP(8); ++rep) pg8::gemm_phase<FastEpiStore, SchedMoe, true, false, true, true>(lds + RING_OFF, nullptr, 512, 4096, 512, S, E, wave);
    }
    SEAM(PH_MOE2);
    if (HAS(9) && IN(PH_LN2)) {
        const Params p = load_params(kargs);
        const int tot = tab->rowbase[NCLS]; const int lane = opaque_tid(wave) & 63;
        for (int rep = 0; rep < NREP(9); ++rep)
        for (int prow = bx * NWAVES + wave; prow < tot; prow += 2 * G * NWAVES) {
            int tk[2], pr[2];
#pragma unroll
            for (int r = 0; r < 2; ++r) { pr[r] = prow + r * G * NWAVES; tk[r] = -1;
                if (pr[r] < tot) { const int cls = pan_cls[pr[r] >> 8]; const int i = pr[r] - tab->rowbase[cls]; if (i < tab->cnt[cls]) tk[r] = WSP(int, WS_LIST)[(size_t)cls * T + i]; } }
            ln2_rows<2>(p, tk, pr, lane, ((PROBE_DUP == 9) && rep == 0) ? (float*)(p.ws + 512 * MiB) : nullptr);
        }
    }
#undef IN
#undef HAS
#undef SEAM
}

#ifndef MK_MODE
#define MK_MODE 3
#endif
extern "C" void kernel_launch(void* const* d_in, const int* in_sizes, int n_in, void* d_out, int out_size, void* d_ws, size_t ws_size, hipStream_t stream) {
    if (n_in != 25 || ws_size < WS_END) { fprintf(stderr, "kernel_launch: unexpected n_in %d / ws_size %zu (need %zu)\n", n_in, ws_size, (size_t)WS_END); return; }
    static int grid = 0;
    if (grid == 0) {
        (void)hipFuncSetAttribute((const void*)k_ln1, hipFuncAttributeMaxDynamicSharedMemorySize, 20 * 1024 * 4 + 1024);
        if (hipFuncSetAttribute((const void*)mk_fwd, hipFuncAttributeMaxDynamicSharedMemorySize, LDS_BYTES) != hipSuccess) fprintf(stderr, "kernel_launch: hipFuncSetAttribute(mk_fwd, %d) failed\n", LDS_BYTES);
        int dev = 0, cus = 0; (void)hipGetDevice(&dev);
        if (hipDeviceGetAttribute(&cus, hipDeviceAttributeMultiprocessorCount, dev) != hipSuccess || cus <= 0) cus = 256;
        int per_cu = 0; (void)hipOccupancyMaxActiveBlocksPerMultiprocessor(&per_cu, (const void*)mk_fwd, NTHR, LDS_BYTES);
        if (per_cu < 1) fprintf(stderr, "kernel_launch: occupancy query reports %d blocks per CU for mk_fwd\n", per_cu);
        (void)hipGetLastError();
        grid = cus;
    }
    Params p{};
    p.x = (const float*)d_in[0]; p.mem = (const float*)d_in[1]; p.pos = (const int*)d_in[2];
    p.w_in = (const float*)d_in[3]; p.b_in = (const float*)d_in[4]; p.conv_w = (const float*)d_in[5]; p.conv_b = (const float*)d_in[6];
    p.conv_g = (const float*)d_in[7]; p.conv_bb = (const float*)d_in[8]; p.w_mem_kv = (const float*)d_in[9]; p.w_attn_o = (const float*)d_in[10];
    p.w_conv_o = (const float*)d_in[11]; p.w_mem_o = (const float*)d_in[12]; p.w_out = (const float*)d_in[13]; p.ln1_g = (const float*)d_in[14]; p.ln1_b = (const float*)d_in[15];
    p.w_gr = (const float*)d_in[16]; p.b_gr = (const float*)d_in[17]; p.w_er = (const float*)d_in[18]; p.b_er = (const float*)d_in[19];
    p.w_eg = (const float*)d_in[20]; p.w_eu = (const float*)d_in[21]; p.w_ed = (const float*)d_in[22]; p.ln2_g = (const float*)d_in[23]; p.ln2_b = (const float*)d_in[24];
    p.out = (float*)d_out; p.ws = (unsigned char*)d_ws;
    (void)hipMemsetAsync((char*)d_ws + WS_CTL, 0, CTL_BYTES, stream);
#if PROBE_DUP == 12
    (void)hipMemsetAsync((char*)d_ws + 944 * MiB, 0, 64 * MiB, stream);
#endif
    auto mk = [&](int lo, int hi) { Args a{}; a.p = p; a.ph_lo = lo; a.ph_hi = hi; hipLaunchKernelGGL(mk_fwd, dim3(grid), dim3(NTHR), LDS_BYTES, stream, a); };
#if MK_MODE == 3
    mk(0, PH_END);
#elif MK_MODE == 2
    for (int ph = 0; ph < PH_END; ++ph) mk(ph, ph + 1);
#elif MK_MODE == 1
    mk(PH_P0, PH_P0 + 1);
    for (int ch = 0; ch < NCH; ++ch) {
        const int ph0 = PH_CH0 + PH_PER_CH * ch;
        mk(ph0, ph0 + 1);
        k_nattn_dil<<<BC * 12 * 2048 / 4, 256, 0, stream>>>(p);
        k_nattn_mem<<<BC * 4 * 2048 / 4, 256, 0, stream>>>(p, ch);
        k_conv<<<BC * 64, 512, 0, stream>>>(p);
        mk(ph0 + 2, ph0 + 3); mk(ph0 + 3, ph0 + 4); mk(ph0 + 4, ph0 + 5);
    }
    mk(PH_LN1, PH_LN1 + 1); mk(PH_MOE1, PH_MOE1 + 1); mk(PH_MOE2, PH_MOE2 + 1); mk(PH_LN2, PH_LN2 + 1);
#else
    for (int w = 0; w < 8; ++w) k_transpose_w<<<2048, 256, 0, stream>>>(p, w);
    k_small_prep<<<(20 * 1024 + 255) / 256, 256, 0, stream>>>(p);
    k_cvt_bf16<<<2048, 256, 0, stream>>>(p.mem, (bf16_t*)((char*)d_ws + WS_MEMB), (size_t)NB * MEML * 1024 / 8);
    k_cvt_bf16<<<4096, 256, 0, stream>>>(p.x, (bf16_t*)((char*)d_ws + WS_XB), (size_t)T * 1024 / 8);
    k_ngemm_kv<<<dim3(1024 / 64, NB * MEML / 64), 256, 0, stream>>>(p, 0);
    for (int ch = 0; ch < NCH; ++ch) {
        k_ngemm_main<<<dim3(INC / 64, TC / 64), 256, 0, stream>>>(p, ch);
        k_nattn_dil<<<BC * 12 * 2048 / 4, 256, 0, stream>>>(p);
        k_nattn_mem<<<BC * 4 * 2048 / 4, 256, 0, stream>>>(p, ch);
        k_conv<<<BC * 64, 512, 0, stream>>>(p);
        k_combine<<<TC / 4, 256, 0, stream>>>(p);
        for (int br = 0; br < 3; ++br) k_ngemm_merge<<<dim3(1024 / 64, TC / 64), 256, 0, stream>>>(p, br);
        k_ngemm_mix<<<dim3(1024 / 64, TC / 64), 256, 0, stream>>>(p, ch);
    }
    k_ln1<<<256, 512, 20 * 1024 * 4 + 1024, stream>>>(p);
    k_ngemm_moe1<<<dim3(2048 / 64, MPAD / 64), 256, 0, stream>>>(p);
    k_ngemm_moe2<<<dim3(1024 / 64, MPAD / 64), 256, 0, stream>>>(p);
    k_ln2<<<MPAD / 4, 256, 0, stream>>>(p);
#endif
}
```

```cpp
#include <hip/hip_runtime.h>
#include <cstdio>
#include <cstdint>

constexpr int D = 1024, NB = 32, S = 2048, T = NB * S;
constexpr int NCH = 2, BC = NB / NCH, TC = T / NCH;
constexpr int INC = 9216;
constexpr int MEML = 256;
constexpr int NCLS = 24;
constexpr int MPAD = T + NCLS * 256;
constexpr float LN_EPS = 1e-5f;
constexpr float DN_ALPHA = 1.189207115002721f;
constexpr float ATT_SCALE = 0.08838834764831845f;

constexpr int C_Q = 0, C_K = 1536, C_V = 3072, C_GLU = 4608, C_QM = 5632, C_GATE = 6144;

constexpr size_t MiB = 1ull << 20;
constexpr size_t WS_CTL = 0, CTL_BYTES = 1 * MiB;
constexpr size_t WS_WIN = 1 * MiB;
constexpr size_t WS_BIASP = 19 * MiB;
constexpr size_t WS_WRT = 19 * MiB + 64 * 1024;
constexpr size_t WS_WKV = 20 * MiB;
constexpr size_t WS_WA = 22 * MiB, WS_WC = 23 * MiB, WS_WM = 24 * MiB;
constexpr size_t WS_WOUT = 25 * MiB;
constexpr size_t WS_W1 = 27 * MiB;
constexpr size_t WS_W2 = 59 * MiB;
constexpr size_t WS_MEMB = 75 * MiB;
constexpr size_t WS_CH = 91 * MiB;
constexpr size_t SZ_XB = (size_t)TC * 1024 * 2, SZ_QKV1 = (size_t)TC * 1536 * 2, SZ_512 = (size_t)TC * 512 * 2;
constexpr size_t WS_XB = WS_CH;
constexpr size_t WS_QG = WS_XB + (size_t)T * 1024 * 2, WS_KG = WS_QG + SZ_QKV1, WS_VG = WS_KG + SZ_QKV1;
constexpr size_t WS_CGLU = WS_VG + SZ_QKV1, WS_QM = WS_CGLU + SZ_512, WS_OATT = WS_QM + SZ_512, WS_CCONV = WS_OATT + SZ_512, WS_OMT = WS_CCONV + SZ_512;
constexpr size_t WS_GATES = WS_OMT + SZ_512;
constexpr size_t SZ_KM = (size_t)NB * 4 * MEML * 128 * 2;
constexpr size_t WS_KM = WS_GATES + (size_t)TC * 3072 * 2, WS_VM = WS_KM + SZ_KM;
constexpr size_t WS_LSE = WS_VM + SZ_KM;
constexpr size_t WS_MERGED = WS_LSE + 2 * MiB;
constexpr size_t WS_CH_END = WS_MERGED + SZ_XB;
constexpr size_t WS_X1B = WS_CH;
constexpr size_t WS_H = WS_X1B + (size_t)T * 1024 * 2;
constexpr size_t WS_Y2 = WS_H + (size_t)MPAD * 1024 * 2;
constexpr size_t WS_LIST = WS_Y2 + (size_t)MPAD * 1024 * 2;
constexpr size_t WS_WTS = WS_LIST + (size_t)NCLS * T * 4;
constexpr size_t WS_X1B8 = WS_WTS + (size_t)T * 8;
constexpr size_t WS_MOE_END = WS_X1B8 + (size_t)T * 1024;
constexpr float W8_SCALE = 32.0f, H8_SCALE = 16.0f;
constexpr size_t WS_END = WS_CH_END > WS_MOE_END ? WS_CH_END : WS_MOE_END;
constexpr size_t WS_XB8 = 944 * MiB;
constexpr size_t WS_WG8 = 1008 * MiB;
constexpr float WG8_SCALE = 32.0f;
static_assert(WS_CH_END <= WS_XB8 && WS_WG8 + 9 * MiB <= 1024 * MiB, "fp8 operand buffers");
static_assert(WS_END <= 1024 * MiB, "workspace map exceeds 1 GiB");
constexpr int CW_CNT = 64;

typedef unsigned short bf16_t;
typedef float f32x4 __attribute__((ext_vector_type(4)));
typedef unsigned u32x4 __attribute__((ext_vector_type(4)));
typedef unsigned u32x2 __attribute__((ext_vector_type(2)));

__device__ __forceinline__ float bf2f(bf16_t b) { return __uint_as_float(((unsigned)b) << 16); }
__device__ __forceinline__ float bflo(unsigned w) { return __uint_as_float(w << 16); }
__device__ __forceinline__ float bfhi(unsigned w) { return __uint_as_float(w & 0xffff0000u); }
__device__ __forceinline__ unsigned f2bf(float f) { unsigned u = __float_as_uint(f); return (u + 0x7fffu + ((u >> 16) & 1u)) >> 16; }
typedef float f32x2_t __attribute__((ext_vector_type(2)));
typedef __bf16 bf16x2_t __attribute__((ext_vector_type(2)));
__device__ __forceinline__ unsigned pk2(float lo, float hi) { f32x2_t v = {lo, hi}; bf16x2_t b = __builtin_convertvector(v, bf16x2_t); return __builtin_bit_cast(unsigned, b); }
__device__ __forceinline__ float sigmoidf_(float x) { return __builtin_amdgcn_rcpf(1.0f + __builtin_amdgcn_exp2f(-1.4426950408889634f * x)); }
__device__ __forceinline__ float wave_sum(float v) {
#define DPP_F(x, ctrl) __int_as_float(__builtin_amdgcn_update_dpp(0, __float_as_int(x), ctrl, 0xf, 0xf, true))
    v += DPP_F(v, 0xB1);
    v += DPP_F(v, 0x4E);
    v += DPP_F(v, 0x141);
    v += DPP_F(v, 0x140);
#undef DPP_F
    const float r0 = __int_as_float(__builtin_amdgcn_readlane(__float_as_int(v), 0)), r1 = __int_as_float(__builtin_amdgcn_readlane(__float_as_int(v), 16));
    const float r2 = __int_as_float(__builtin_amdgcn_readlane(__float_as_int(v), 32)), r3 = __int_as_float(__builtin_amdgcn_readlane(__float_as_int(v), 48));
    return (r0 + r1) + (r2 + r3);
}
__device__ __forceinline__ float wave_max(float v) {
#pragma unroll
    for (int o = 1; o < 64; o <<= 1) v = fmaxf(v, __shfl_xor(v, o));
    return v;
}
__device__ __forceinline__ unsigned pk4_fp8(float a, float b, float c, float d) { unsigned w = 0; w = __builtin_amdgcn_cvt_pk_fp8_f32(a, b, w, false); w = __builtin_amdgcn_cvt_pk_fp8_f32(c, d, w, true); return w; }
__device__ __forceinline__ unsigned pk4_u8(float a, float b, float c, float d) {
    const unsigned ua = (unsigned)fmaxf(__builtin_rintf(a * 255.f), 1.f), ub = (unsigned)fmaxf(__builtin_rintf(b * 255.f), 1.f), uc = (unsigned)fmaxf(__builtin_rintf(c * 255.f), 1.f), ud = (unsigned)fmaxf(__builtin_rintf(d * 255.f), 1.f);
    return ua | (ub << 8) | (uc << 16) | (ud << 24); }
__device__ __forceinline__ float sig255(float x) { const float e = __builtin_amdgcn_exp2f(-1.4426950408889634f * x); return fmaxf(__builtin_rintf(__builtin_amdgcn_rcpf(__builtin_fmaf(e, 1.0f / 255.0f, 1.0f / 255.0f))), 1.0f); }
__device__ __forceinline__ unsigned pk4_sig_u8(float a, float b, float c, float d) { unsigned w = 0u;
    w = __builtin_amdgcn_cvt_pk_u8_f32(sig255(a), 0, w); w = __builtin_amdgcn_cvt_pk_u8_f32(sig255(b), 1, w); w = __builtin_amdgcn_cvt_pk_u8_f32(sig255(c), 2, w); w = __builtin_amdgcn_cvt_pk_u8_f32(sig255(d), 3, w); return w; }
__device__ __forceinline__ f32x4 u8x4_raw(unsigned w) { return (f32x4){(float)(w & 255u), (float)((w >> 8) & 255u), (float)((w >> 16) & 255u), (float)(w >> 24)}; }
__device__ __forceinline__ f32x4 u8x4_to_f32(unsigned w) { return (f32x4){(float)(w & 255u), (float)((w >> 8) & 255u), (float)((w >> 16) & 255u), (float)(w >> 24)} * (1.0f / 255.0f); }
__device__ __forceinline__ int opaque_tid(int wave_s) { unsigned z = 0u; asm volatile("" : "+v"(z)); const int l = (int)__builtin_amdgcn_mbcnt_hi(~0u, __builtin_amdgcn_mbcnt_lo(~0u, z)); return (wave_s << 6) | l; }
__device__ __forceinline__ void rope_cs(float pos, int j, float& c, float& s) {
    const float invrev = __builtin_amdgcn_exp2f(-(float)j * (13.287712379549449f / 64.0f)) * 0.15915494309189535f;
    float rev = pos * invrev; rev = __builtin_amdgcn_fractf(rev);
    s = __builtin_amdgcn_sinf(rev); c = __builtin_amdgcn_cosf(rev);
}
__device__ __forceinline__ int rowperm(int g, int s) { return g == 0 ? s : (g == 1 ? ((s & 3) * 512 + (s >> 2)) : ((s & 15) * 128 + (s >> 4))); }
__host__ __device__ __forceinline__ int win_logical(int n) {
    if (n < C_V) { const int sec = n / 1536, r = n % 1536, gh = r / 128, p = r % 128, G = p >> 3, nn = (p >> 2) & 1, e = p & 3; return sec * 1536 + gh * 128 + 64 * nn + 4 * G + e; }
    if (n < C_GLU) return n;
    if (n < C_QM) { const int cc = n - C_GLU, G = cc >> 3, nn = (cc >> 2) & 1, e = cc & 3; return C_GLU + nn * 512 + 4 * G + e; }
    return n;
}

struct Params {
    const float *x, *mem; const int* pos;
    const float *w_in, *b_in, *conv_w, *conv_b, *conv_g, *conv_bb, *w_mem_kv, *w_attn_o, *w_conv_o, *w_mem_o, *w_out, *ln1_g, *ln1_b;
    const float *w_gr, *b_gr, *w_er, *b_er, *w_eg, *w_eu, *w_ed, *ln2_g, *ln2_b;
    float* out; unsigned char* ws;
};
#define WSP(T_, off) ((T_*)(p.ws + (off)))

__global__ void k_cvt_bf16(const float* __restrict__ src, bf16_t* __restrict__ dst, size_t n8) {
    for (size_t i = (size_t)blockIdx.x * blockDim.x + threadIdx.x; i < n8; i += (size_t)gridDim.x * blockDim.x) {
        const f32x4 a = *(const f32x4*)(src + i * 8), b = *(const f32x4*)(src + i * 8 + 4);
        u32x4 o; o.x = pk2(a.x, a.y); o.y = pk2(a.z, a.w); o.z = pk2(b.x, b.y); o.w = pk2(b.z, b.w);
        *(u32x4*)(dst + i * 8) = o;
    }
}
enum { TW_IN = 0, TW_KV, TW_A, TW_C, TW_M, TW_OUT, TW_W1, TW_W2 };
__device__ __forceinline__ void transpose_w_dev(const Params& p, int which, size_t gtid, size_t gstride) {
    int K, N, ldd; bf16_t* dst;
    switch (which) {
        case TW_IN: K = 1024; N = INC; ldd = 1024; dst = WSP(bf16_t, WS_WIN); break;
        case TW_KV: K = 1024; N = 1024; ldd = 1024; dst = WSP(bf16_t, WS_WKV); break;
        case TW_A: K = 512; N = 1024; ldd = 512; dst = WSP(bf16_t, WS_WA); break;
        case TW_C: K = 512; N = 1024; ldd = 512; dst = WSP(bf16_t, WS_WC); break;
        case TW_M: K = 512; N = 1024; ldd = 512; dst = WSP(bf16_t, WS_WM); break;
        case TW_OUT: K = 1024; N = 1024; ldd = 1024; dst = WSP(bf16_t, WS_WOUT); break;
        case TW_W1: K = 1024; N = 16 * 1024; ldd = 1024; dst = WSP(bf16_t, WS_W1); break;
        default: K = 512; N = 16 * 1024; ldd = 8192; dst = WSP(bf16_t, WS_W2); break;
    }
    const size_t total = (size_t)N * (K / 8);
    for (size_t i = gtid; i < total; i += gstride) {
        const int n = (int)(i % N), k0 = (int)(i / N) * 8;
        float v[8];
#pragma unroll
        for (int j = 0; j < 8; ++j) {
            const int k = k0 + j; float s;
            switch (which) {
                case TW_IN: s = p.w_in[(size_t)k * INC + win_logical(n)]; break;
                case TW_KV: s = p.w_mem_kv[(size_t)k * 1024 + n]; break;
                case TW_A: s = p.w_attn_o[(size_t)k * 1024 + n]; break;
                case TW_C: s = p.w_conv_o[(size_t)k * 1024 + n]; break;
                case TW_M: s = p.w_mem_o[(size_t)k * 1024 + n]; break;
                case TW_OUT: s = p.w_out[(size_t)k * 1024 + n]; break;
                case TW_W1: { const int e = n >> 10, c = n & 1023, G = c >> 3, nn = (c >> 2) & 1, ee = c & 3, jj = 4 * G + ee;
                              s = (nn ? p.w_eu : p.w_eg)[((size_t)e * 1024 + k) * 512 + jj]; } break;
                default: { const int e = n >> 10, c = n & 1023; s = p.w_ed[((size_t)e * 512 + k) * 1024 + c]; } break;
            }
            v[j] = s;
        }
        u32x4 o; o.x = pk2(v[0], v[1]); o.y = pk2(v[2], v[3]); o.z = pk2(v[4], v[5]); o.w = pk2(v[6], v[7]);
        size_t doff;
        if (which == TW_W2) { const int e = n >> 10, c = n & 1023; doff = (size_t)c * 8192 + e * 512 + k0; }
        else doff = (size_t)n * ldd + k0;
        *(u32x4*)(dst + doff) = o;
    }
}
__global__ void k_transpose_w(Params p, int which) { transpose_w_dev(p, which, (size_t)blockIdx.x * blockDim.x + threadIdx.x, (size_t)gridDim.x * blockDim.x); }
__device__ __forceinline__ void small_prep_dev(const Params& p, size_t gtid, size_t gstride) {
    for (size_t ii = gtid; ii < 20 * 1024; ii += gstride) { const int i = (int)ii;
        if (i < INC) WSP(float, WS_BIASP)[i] = p.b_in[win_logical(i)];
        const int e = i >> 10, k = i & 1023;
        WSP(float, WS_WRT)[i] = e < 4 ? p.w_gr[k * 4 + e] : p.w_er[((size_t)((e - 4) >> 2) * 1024 + k) * 4 + ((e - 4) & 3)]; }
}
__global__ void k_small_prep(Params p) { small_prep_dev(p, (size_t)blockIdx.x * blockDim.x + threadIdx.x, (size_t)gridDim.x * blockDim.x); }

struct EpiMain {
    const float* biasp; const int* pos; bf16_t *QG, *CGLU, *QM, *GATES; int tok0;
    static __device__ __forceinline__ void rope_freqs(int c0, float (&invrev)[4]) {
        const int j0 = ((c0 & 127) >> 3) * 4;
#pragma unroll
        for (int e = 0; e < 4; ++e) invrev[e] = __builtin_amdgcn_exp2f(-(float)(j0 + e) * (13.287712379549449f / 64.0f)) * 0.15915494309189535f;
    }
    __device__ __forceinline__ void finish(int rl, int c0, float (&v)[8], float fpos, const float (&invrev)[4]) const {
        const int bl = rl >> 11, s = rl & 2047;
        const int tcol = __builtin_amdgcn_readfirstlane(c0 & ~255);
        if (tcol < C_GLU) {
            const int sec = tcol / 1536, r = c0 - sec * 1536, gh = r >> 7, pcol = r & 127, g = gh >> 2;
            if (sec < 2) {
#pragma unroll
                for (int e = 0; e < 4; ++e) { const float rev = __builtin_amdgcn_fractf(fpos * invrev[e]); const float sn = __builtin_amdgcn_sinf(rev), c = __builtin_amdgcn_cosf(rev);
                    const float t1 = v[e], t2 = v[4 + e]; v[e] = t1 * c - t2 * sn; v[4 + e] = t2 * c + t1 * sn; }
            }
            bf16_t* base = QG + (size_t)sec * (SZ_QKV1 / 2);
            u32x4 o; o.x = pk2(v[0], v[1]); o.y = pk2(v[2], v[3]); o.z = pk2(v[4], v[5]); o.w = pk2(v[6], v[7]);
            *(u32x4*)(base + ((size_t)(bl * 12 + gh) * 2048 + rowperm(g, s)) * 128 + pcol) = o;
        } else if (tcol < C_QM) {
            const int j0 = (c0 - C_GLU) >> 1;
            u32x2 o; o.x = pk2(v[0] * sigmoidf_(v[4]), v[1] * sigmoidf_(v[5])); o.y = pk2(v[2] * sigmoidf_(v[6]), v[3] * sigmoidf_(v[7]));
            *(u32x2*)(CGLU + (size_t)rl * 512 + j0) = o;
        } else if (tcol < C_GATE) {
            const int cc = c0 - C_QM, h = cc >> 7, pcol = cc & 127;
            u32x4 o; o.x = pk2(v[0], v[1]); o.y = pk2(v[2], v[3]); o.z = pk2(v[4], v[5]); o.w = pk2(v[6], v[7]);
            *(u32x4*)(QM + ((size_t)(bl * 4 + h) * 2048 + s) * 128 + pcol) = o;
        } else {
            const int cc = c0 - C_GATE;
            u32x2 o; o.x = pk4_sig_u8(v[0], v[1], v[2], v[3]); o.y = pk4_sig_u8(v[4], v[5], v[6], v[7]);
            *(u32x2*)((unsigned char*)GATES + (size_t)rl * 3072 + cc) = o;
        }
    }
    __device__ __forceinline__ void operator()(int rl, int c0, float (&v)[8]) const {
        const f32x4 b0 = *(const f32x4*)(biasp + c0), b1 = *(const f32x4*)(biasp + c0 + 4);
        v[0] += b0.x; v[1] += b0.y; v[2] += b0.z; v[3] += b0.w; v[4] += b1.x; v[5] += b1.y; v[6] += b1.z; v[7] += b1.w;
        float invrev[4]; rope_freqs(c0, invrev);
        finish(rl, c0, v, c0 < C_V ? (float)pos[tok0 + rl] : 0.f, invrev);
    }
};
struct EpiKV {
    bf16_t *KM;
    __device__ __forceinline__ void operator()(int row, int c0, float (&v)[8]) const {
        const int bl = row >> 8, m = row & 255, isv = c0 >> 9, cc = c0 & 511, h = cc >> 7, pcol = cc & 127;
        u32x4 o; o.x = pk2(v[0], v[1]); o.y = pk2(v[2], v[3]); o.z = pk2(v[4], v[5]); o.w = pk2(v[6], v[7]);
        *(u32x4*)(KM + (size_t)isv * (SZ_KM / 2) + ((size_t)(bl * 4 + h) * 256 + m) * 128 + pcol) = o;
    }
};
struct EpiMerge {
    const bf16_t* GATES; bf16_t* MERGED; int br;
    __device__ __forceinline__ void operator()(int rl, int c0, float (&v)[8]) const {
        const u32x2 g = *(const u32x2*)((const unsigned char*)GATES + (size_t)rl * 3072 + br * 1024 + c0);
        const f32x4 g0 = u8x4_to_f32(g.x), g1 = u8x4_to_f32(g.y);
        float r[8] = {g0.x * v[0], g0.y * v[1], g0.z * v[2], g0.w * v[3], g1.x * v[4], g1.y * v[5], g1.z * v[6], g1.w * v[7]};
        bf16_t* mp = MERGED + (size_t)rl * 1024 + c0;
        if (br > 0) { const u32x4 m = *(const u32x4*)mp; r[0] += bflo(m.x); r[1] += bfhi(m.x); r[2] += bflo(m.y); r[3] += bfhi(m.y); r[4] += bflo(m.z); r[5] += bfhi(m.z); r[6] += bflo(m.w); r[7] += bfhi(m.w); }
        u32x4 o; o.x = pk2(r[0], r[1]); o.y = pk2(r[2], r[3]); o.z = pk2(r[4], r[5]); o.w = pk2(r[6], r[7]);
        *(u32x4*)mp = o;
    }
};
struct EpiMix {
    bf16_t* MIX; int tok0;
    __device__ __forceinline__ void operator()(int rl, int c0, float (&v)[8]) const {
        u32x4 o; o.x = pk2(v[0], v[1]); o.y = pk2(v[2], v[3]); o.z = pk2(v[4], v[5]); o.w = pk2(v[6], v[7]);
        *(u32x4*)(MIX + (size_t)(tok0 + rl) * 1024 + c0) = o;
    }
};
struct ClassTab { int cnt[NCLS], rowbase[NCLS + 1]; };
__device__ __forceinline__ void class_tab_fill(const unsigned* cntw, ClassTab* t) {
    int acc = 0;
    for (int c = 0; c < NCLS; ++c) { const int n = (int)cntw[c]; t->cnt[c] = n; t->rowbase[c] = acc; acc += ((n + 255) >> 8) << 8; }
    t->rowbase[NCLS] = acc;
}
__device__ __forceinline__ void class_experts(int cls, int& e_lo, int& e_hi) {
    const int g = cls / 6, pi = cls - g * 6;
    const int lo = pi < 3 ? 0 : (pi < 5 ? 1 : 2), hi = pi < 3 ? pi + 1 : (pi < 5 ? pi - 1 : 3);
    e_lo = g * 4 + lo; e_hi = g * 4 + hi;
}
struct EpiMoe1 {
    const int* list; const float* wts; bf16_t* H; int cls, cnt, rowbase;
    __device__ __forceinline__ void operator()(int prow, int c0, float (&v)[8]) const {
        int i = prow - rowbase; if (i >= cnt) i = cnt - 1;
        const int tok = list[i]; const int hi = c0 >> 10; const float w = wts[(size_t)tok * 2 + hi];
        const int j0 = hi * 512 + ((c0 & 1023) >> 1);
        float r[4];
#pragma unroll
        for (int e = 0; e < 4; ++e) { const float gt = v[e]; r[e] = gt * sigmoidf_(gt) * v[4 + e] * w; }
        u32x2 o; o.x = pk2(r[0], r[1]); o.y = pk2(r[2], r[3]);
        *(u32x2*)(H + (size_t)prow * 1024 + j0) = o;
    }
};
struct EpiMoe2 {
    bf16_t* Y2;
    __device__ __forceinline__ void operator()(int prow, int c0, float (&v)[8]) const {
        u32x4 o; o.x = pk2(v[0], v[1]); o.y = pk2(v[2], v[3]); o.z = pk2(v[4], v[5]); o.w = pk2(v[6], v[7]);
        *(u32x4*)(Y2 + (size_t)prow * 1024 + c0) = o;
    }
};

struct RowsPlain { const bf16_t* base; int ld; __device__ __forceinline__ const bf16_t* operator()(int r) const { return base + (size_t)r * ld; } };
template <class AF, class BF, class EF>
__device__ __forceinline__ void ngemm_tile(int row0, int col0, int K, const AF& af, const BF& bf, const EF& ef, int bkseg, long bjump) {
    __shared__ float As[64][33], Bs[64][33];
    const int tid = threadIdx.x, ty = tid >> 3, tx = tid & 7;
    float acc[2][8];
#pragma unroll
    for (int i = 0; i < 2; ++i)
#pragma unroll
        for (int j = 0; j < 8; ++j) acc[i][j] = 0.f;
    const int lr = tid >> 2, lk = (tid & 3) * 8;
    const bf16_t* ap = af(row0 + lr); const bf16_t* bp = bf(col0 + lr);
    for (int k0 = 0; k0 < K; k0 += 32) {
        const u32x4 a = *(const u32x4*)(ap + k0 + lk);
        const long bo = (long)k0 + lk + (long)(k0 / bkseg) * bjump;
        const u32x4 b = *(const u32x4*)(bp + bo);
        __syncthreads();
        As[lr][lk + 0] = bflo(a.x); As[lr][lk + 1] = bfhi(a.x); As[lr][lk + 2] = bflo(a.y); As[lr][lk + 3] = bfhi(a.y);
        As[lr][lk + 4] = bflo(a.z); As[lr][lk + 5] = bfhi(a.z); As[lr][lk + 6] = bflo(a.w); As[lr][lk + 7] = bfhi(a.w);
        Bs[lr][lk + 0] = bflo(b.x); Bs[lr][lk + 1] = bfhi(b.x); Bs[lr][lk + 2] = bflo(b.y); Bs[lr][lk + 3] = bfhi(b.y);
        Bs[lr][lk + 4] = bflo(b.z); Bs[lr][lk + 5] = bfhi(b.z); Bs[lr][lk + 6] = bflo(b.w); Bs[lr][lk + 7] = bfhi(b.w);
        __syncthreads();
#pragma unroll 8
        for (int kk = 0; kk < 32; ++kk) {
            const float a0 = As[2 * ty][kk], a1 = As[2 * ty + 1][kk];
#pragma unroll
            for (int j = 0; j < 8; ++j) { const float bv = Bs[8 * tx + j][kk]; acc[0][j] += a0 * bv; acc[1][j] += a1 * bv; }
        }
    }
    ef(row0 + 2 * ty, col0 + 8 * tx, acc[0]);
    ef(row0 + 2 * ty + 1, col0 + 8 * tx, acc[1]);
}
__global__ void __launch_bounds__(256) k_ngemm_main(Params p, int ch) {
    const int tok0 = ch * TC;
    EpiMain E{WSP(float, WS_BIASP), p.pos, WSP(bf16_t, WS_QG), WSP(bf16_t, WS_CGLU), WSP(bf16_t, WS_QM), WSP(bf16_t, WS_GATES), tok0};
    RowsPlain A{WSP(bf16_t, WS_XB) + (size_t)ch * TC * 1024, 1024}, Bm{WSP(bf16_t, WS_WIN), 1024};
    ngemm_tile(blockIdx.y * 64, blockIdx.x * 64, 1024, A, Bm, E, 1 << 30, 0);
}
__global__ void __launch_bounds__(256) k_ngemm_kv(Params p, int ch) {
    EpiKV E{WSP(bf16_t, WS_KM)};
    RowsPlain A{WSP(bf16_t, WS_MEMB), 1024}, Bm{WSP(bf16_t, WS_WKV), 1024};
    ngemm_tile(blockIdx.y * 64, blockIdx.x * 64, 1024, A, Bm, E, 1 << 30, 0);
}
__global__ void __launch_bounds__(256) k_ngemm_merge(Params p, int br) {
    EpiMerge E{WSP(bf16_t, WS_GATES), WSP(bf16_t, WS_MERGED), br};
    RowsPlain A{WSP(bf16_t, WS_OATT + (size_t)br * SZ_512), 512};
    RowsPlain Bm{WSP(bf16_t, WS_WA + (size_t)br * MiB), 512};
    ngemm_tile(blockIdx.y * 64, blockIdx.x * 64, 512, A, Bm, E, 1 << 30, 0);
}
__global__ void __launch_bounds__(256) k_ngemm_mix(Params p, int ch) {
    EpiMix E{(bf16_t*)p.out, ch * TC};
    RowsPlain A{WSP(bf16_t, WS_MERGED), 1024}, Bm{WSP(bf16_t, WS_WOUT), 1024};
    ngemm_tile(blockIdx.y * 64, blockIdx.x * 64, 1024, A, Bm, E, 1 << 30, 0);
}
struct RowsGather { const bf16_t* base; const int* list; int cnt, rowbase; __device__ __forceinline__ const bf16_t* operator()(int prow) const { int i = prow - rowbase; if (i >= cnt) i = cnt - 1; return base + (size_t)list[i] * 1024; } };
__device__ __forceinline__ int find_class(const ClassTab* t, int prow) { int c = 0;
    for (int i = 1; i < NCLS; ++i) if (prow >= t->rowbase[i]) c = i;
    return c; }
__global__ void __launch_bounds__(256) k_ngemm_moe1(Params p) {
    __shared__ ClassTab tabs; if (threadIdx.x == 0) class_tab_fill(WSP(unsigned, WS_CTL) + CW_CNT, &tabs); __syncthreads(); const ClassTab* tab = &tabs;
    const int row0 = blockIdx.y * 64; if (row0 >= tab->rowbase[NCLS]) return;
    const int cls = find_class(tab, row0); if (tab->cnt[cls] == 0) return;
    int e_lo, e_hi; class_experts(cls, e_lo, e_hi);
    const int col0 = blockIdx.x * 64, hi = col0 >> 10;
    const int* list = WSP(int, WS_LIST) + (size_t)cls * T;
    RowsGather A{WSP(bf16_t, WS_X1B), list, tab->cnt[cls], tab->rowbase[cls]};
    RowsPlain Bm{WSP(bf16_t, WS_W1) + ((size_t)(hi ? e_hi : e_lo) * 1024 - (size_t)hi * 1024) * 1024, 1024};
    EpiMoe1 E{list, WSP(float, WS_WTS), WSP(bf16_t, WS_H), cls, tab->cnt[cls], tab->rowbase[cls]};
    ngemm_tile(row0, col0, 1024, A, Bm, E, 1 << 30, 0);
}
__global__ void __launch_bounds__(256) k_ngemm_moe2(Params p) {
    __shared__ ClassTab tabs; if (threadIdx.x == 0) class_tab_fill(WSP(unsigned, WS_CTL) + CW_CNT, &tabs); __syncthreads(); const ClassTab* tab = &tabs;
    const int row0 = blockIdx.y * 64; if (row0 >= tab->rowbase[NCLS]) return;
    const int cls = find_class(tab, row0); if (tab->cnt[cls] == 0) return;
    int e_lo, e_hi; class_experts(cls, e_lo, e_hi);
    RowsPlain A{WSP(bf16_t, WS_H), 1024};
    RowsPlain Bm{WSP(bf16_t, WS_W2) + (size_t)e_lo * 512, 8192};
    EpiMoe2 E{WSP(bf16_t, WS_Y2)};
    ngemm_tile(row0, blockIdx.x * 64, 1024, A, Bm, E, 512, (long)(e_hi - e_lo - 1) * 512);
}

__device__ __forceinline__ void nattn_row(const bf16_t* qp, const bf16_t* kbase, const bf16_t* vbase, int nkeys, bf16_t* op, float* lsep, int lane) {
    const unsigned qw = *(const unsigned*)(qp + 2 * lane); const float q0 = bflo(qw), q1 = bfhi(qw);
    float sc[4] = {-INFINITY, -INFINITY, -INFINITY, -INFINITY};
#pragma unroll
    for (int kb = 0; kb < 4; ++kb) {
        for (int kk = 0; kk < 64; ++kk) { const int k = kb * 64 + kk; if (k >= nkeys) break;
            const unsigned kw = *(const unsigned*)(kbase + (size_t)k * 128 + 2 * lane);
            const float s = wave_sum(q0 * bflo(kw) + q1 * bfhi(kw)) * ATT_SCALE;
            if (lane == kk) sc[kb] = s; }
    }
    const float m = wave_max(fmaxf(fmaxf(sc[0], sc[1]), fmaxf(sc[2], sc[3])));
    float pr[4]; float ps = 0.f;
#pragma unroll
    for (int kb = 0; kb < 4; ++kb) { pr[kb] = __expf(sc[kb] - m); ps += pr[kb]; }
    const float l = wave_sum(ps);
    float a0 = 0.f, a1 = 0.f;
#pragma unroll
    for (int kb = 0; kb < 4; ++kb) {
        for (int kk = 0; kk < 64; ++kk) { const int k = kb * 64 + kk; if (k >= nkeys) break;
            const float pk = __shfl(pr[kb], kk);
            const unsigned vw = *(const unsigned*)(vbase + (size_t)k * 128 + 2 * lane);
            a0 += pk * bflo(vw); a1 += pk * bfhi(vw); }
    }
    const float inv = 1.0f / l;
    *(unsigned*)(op + 2 * lane) = pk2(a0 * inv, a1 * inv);
    if (lsep && lane == 0) *lsep = m + __logf(l);
}
__global__ void __launch_bounds__(256) k_nattn_dil(Params p) {
    const int lane = threadIdx.x & 63; const size_t w = (size_t)blockIdx.x * 4 + (threadIdx.x >> 6);
    if (w >= (size_t)BC * 12 * 2048) return;
    const int row = (int)(w & 2047); const int bgh = (int)(w >> 11); const int g = (bgh % 12) >> 2;
    const int seglen = 2048 >> (2 * g); const int pin = row & (seglen - 1); const int nk = pin + 1 < 129 ? pin + 1 : 129;
    bf16_t* Q = WSP(bf16_t, WS_QG) + ((size_t)bgh * 2048 + row) * 128;
    const bf16_t* K = WSP(bf16_t, WS_KG) + ((size_t)bgh * 2048 + row - nk + 1) * 128;
    const bf16_t* V = WSP(bf16_t, WS_VG) + ((size_t)bgh * 2048 + row - nk + 1) * 128;
    nattn_row(Q, K, V, nk, Q, WSP(float, WS_LSE) + (size_t)bgh * 2048 + row, lane);
}
__global__ void __launch_bounds__(256) k_nattn_mem(Params p, int ch) {
    const int lane = threadIdx.x & 63; const size_t w = (size_t)blockIdx.x * 4 + (threadIdx.x >> 6);
    if (w >= (size_t)BC * 4 * 2048) return;
    const int s = (int)(w & 2047); const int bh = (int)(w >> 11); const int bl = bh >> 2, h = bh & 3;
    const bf16_t* Q = WSP(bf16_t, WS_QM) + ((size_t)bh * 2048 + s) * 128;
    const bf16_t* K = WSP(bf16_t, WS_KM) + (size_t)(ch * BC * 4 + bh) * 256 * 128;
    const bf16_t* V = WSP(bf16_t, WS_VM) + (size_t)(ch * BC * 4 + bh) * 256 * 128;
    nattn_row(Q, K, V, 256, WSP(bf16_t, WS_OMT) + ((size_t)(bl * 2048 + s)) * 512 + h * 128, nullptr, lane);
}

__device__ __forceinline__ void combine_token(const Params& p, int rl, int lane) {
    const int bl = rl >> 11, s = rl & 2047, h = lane >> 4, d0 = (lane & 15) * 8;
    float ls[3]; u32x4 o[3];
#pragma unroll
    for (int g = 0; g < 3; ++g) { const size_t r = (size_t)(bl * 12 + g * 4 + h) * 2048 + rowperm(g, s);
        ls[g] = WSP(float, WS_LSE)[r]; o[g] = *(const u32x4*)(WSP(bf16_t, WS_QG) + r * 128 + d0); }
    const float m = fmaxf(ls[0], fmaxf(ls[1], ls[2]));
    float w0 = __expf(ls[0] - m), w1 = __expf(ls[1] - m), w2 = __expf(ls[2] - m); const float inv = 1.0f / (w0 + w1 + w2); w0 *= inv; w1 *= inv; w2 *= inv;
    u32x4 r;
    r.x = pk2(w0 * bflo(o[0].x) + w1 * bflo(o[1].x) + w2 * bflo(o[2].x), w0 * bfhi(o[0].x) + w1 * bfhi(o[1].x) + w2 * bfhi(o[2].x));
    r.y = pk2(w0 * bflo(o[0].y) + w1 * bflo(o[1].y) + w2 * bflo(o[2].y), w0 * bfhi(o[0].y) + w1 * bfhi(o[1].y) + w2 * bfhi(o[2].y));
    r.z = pk2(w0 * bflo(o[0].z) + w1 * bflo(o[1].z) + w2 * bflo(o[2].z), w0 * bfhi(o[0].z) + w1 * bfhi(o[1].z) + w2 * bfhi(o[2].z));
    r.w = pk2(w0 * bflo(o[0].w) + w1 * bflo(o[1].w) + w2 * bflo(o[2].w), w0 * bfhi(o[0].w) + w1 * bfhi(o[1].w) + w2 * bfhi(o[2].w));
    *(u32x4*)(WSP(bf16_t, WS_OATT) + (size_t)rl * 512 + h * 128 + d0) = r;
}
__global__ void __launch_bounds__(256) k_combine(Params p) {
    const int lane = threadIdx.x & 63; const int w = blockIdx.x * 4 + (threadIdx.x >> 6);
    if (w < TC) combine_token(p, w, lane);
}
constexpr int CONV_TILE = 62 * 1024, CONV_OUT = 32 * 1024, CONV_LDS = CONV_TILE + CONV_OUT + (8 * 32 + 64) * 4;
__device__ __forceinline__ void conv_unit(const Params& p, int u, unsigned char* lds, int tid_) {
    const int ch = tid_, lane = ch & 63, wv = ch >> 6;
    const int bl = u >> 6, s0 = (u & 63) * 32;
    bf16_t* tile = (bf16_t*)lds; bf16_t* otile = (bf16_t*)(lds + CONV_TILE); float* red = (float*)(lds + CONV_TILE + CONV_OUT);
    const bf16_t* cg = WSP(bf16_t, WS_CGLU) + (size_t)bl * 2048 * 512;
#pragma unroll
    for (int it = 0; it < 8; ++it) { const int c = it * 512 + ch; if (c < 62 * 64) { const int r = c >> 6, q = c & 63, s = s0 - 30 + r;
        u32x4 v = {0u, 0u, 0u, 0u}; if (s >= 0) v = *(const u32x4*)(cg + (size_t)s * 512 + q * 8);
        *(u32x4*)(tile + r * 512 + q * 8) = v; } }
    __syncthreads();
    float o[32]; const float cb = p.conv_b[ch];
#pragma unroll
    for (int i = 0; i < 32; ++i) o[i] = cb;
    {   float in[62];
#pragma unroll
        for (int i = 0; i < 62; ++i) in[i] = bf2f(tile[i * 512 + ch]);
#pragma unroll
        for (int j = 0; j < 31; ++j) { const float w = p.conv_w[j * 512 + ch];
#pragma unroll
            for (int i = 0; i < 32; ++i) o[i] += w * in[i + j]; } }
    float* mean = red + 256; float* rstd = red + 288;
#pragma unroll
    for (int i = 0; i < 32; ++i) { const float sr = wave_sum(o[i]); if (lane == 0) red[wv * 32 + i] = sr; }
    __syncthreads();
    if (ch < 32) { float sm = 0.f;
#pragma unroll
        for (int w = 0; w < 8; ++w) sm += red[w * 32 + ch];
        mean[ch] = sm * (1.0f / 512.0f); }
    __syncthreads();
#pragma unroll
    for (int i = 0; i < 32; ++i) { o[i] -= mean[i]; const float sr = wave_sum(o[i] * o[i]); if (lane == 0) red[wv * 32 + i] = sr; }
    __syncthreads();
    if (ch < 32) { float sm = 0.f;
#pragma unroll
        for (int w = 0; w < 8; ++w) sm += red[w * 32 + ch];
        rstd[ch] = 1.0f / sqrtf(sm * (1.0f / 512.0f) + LN_EPS); }
    __syncthreads();
    const float gg = p.conv_g[ch], bb = p.conv_bb[ch];
#pragma unroll
    for (int i = 0; i < 32; ++i) { const float y = o[i] * rstd[i] * gg + bb; otile[i * 512 + ch] = (bf16_t)f2bf(y * sigmoidf_(y)); }
    __syncthreads();
    bf16_t* outp = WSP(bf16_t, WS_CCONV) + ((size_t)bl * 2048 + s0) * 512;
#pragma unroll
    for (int it = 0; it < 4; ++it) { const int c = it * 512 + ch; *(u32x4*)(outp + (size_t)c * 8) = *(const u32x4*)(otile + c * 8); }
    __syncthreads();
}
__global__ void __launch_bounds__(512) k_conv(Params p) {
    __shared__ __attribute__((aligned(16))) unsigned char cl[CONV_LDS];
    conv_unit(p, blockIdx.x, cl, threadIdx.x);
}
__device__ __forceinline__ void ln1_unit(const Params& p, int u, const float* wr, int* cls_l, int* misc, int tid_, bool dummy = false) {
    const int tid = tid_, lane = tid & 63, wv = tid >> 6;
    float gam[16], bet[16];
#pragma unroll
    for (int j = 0; j < 4; ++j) { const f32x4 g4 = *(const f32x4*)(p.ln1_g + 4 * lane + 256 * j), b4 = *(const f32x4*)(p.ln1_b + 4 * lane + 256 * j);
        gam[4 * j] = g4.x; gam[4 * j + 1] = g4.y; gam[4 * j + 2] = g4.z; gam[4 * j + 3] = g4.w; bet[4 * j] = b4.x; bet[4 * j + 1] = b4.y; bet[4 * j + 2] = b4.z; bet[4 * j + 3] = b4.w; }
    const int tok0 = u * 64 + wv * 8;
    u32x2 xq[2][4]; u32x2 mq[2][4];
#define LN1_LOAD(slot, rr) do { const bf16_t* xr_ = WSP(bf16_t, WS_XB) + (size_t)(tok0 + (rr)) * 1024 + 4 * lane; const bf16_t* mr_ = (const bf16_t*)p.out + (size_t)(tok0 + (rr)) * 1024 + 4 * lane; \
        _Pragma("unroll") for (int j = 0; j < 4; ++j) { xq[slot][j] = *(const u32x2*)(xr_ + 256 * j); mq[slot][j] = *(const u32x2*)(mr_ + 256 * j); } } while (0)
    LN1_LOAD(0, 0);
#pragma unroll
    for (int rr = 0; rr < 8; ++rr) {
        const int lr = wv * 8 + rr; const int tok = tok0 + rr;
        if (rr + 1 < 8) { if (rr & 1) LN1_LOAD(0, rr + 1); else LN1_LOAD(1, rr + 1); }
        float v[16]; float sm = 0.f;
#pragma unroll
        for (int j = 0; j < 4; ++j) { const u32x2 t = xq[rr & 1][j]; const u32x2 mm = mq[rr & 1][j];
            v[4 * j] = DN_ALPHA * bflo(t.x) + bflo(mm.x); v[4 * j + 1] = DN_ALPHA * bfhi(t.x) + bfhi(mm.x); v[4 * j + 2] = DN_ALPHA * bflo(t.y) + bflo(mm.y); v[4 * j + 3] = DN_ALPHA * bfhi(t.y) + bfhi(mm.y);
            sm += (v[4 * j] + v[4 * j + 1]) + (v[4 * j + 2] + v[4 * j + 3]); }
        const float mean = wave_sum(sm) * (1.0f / 1024.0f); float sq = 0.f;
#pragma unroll
        for (int i = 0; i < 16; ++i) { v[i] -= mean; sq += v[i] * v[i]; }
        const float rstd = 1.0f / sqrtf(wave_sum(sq) * (1.0f / 1024.0f) + LN_EPS);
#pragma unroll
        for (int i = 0; i < 16; ++i) v[i] = v[i] * rstd * gam[i] + bet[i];
        bf16_t* xb = WSP(bf16_t, dummy ? WS_H : WS_X1B) + (size_t)tok * 1024;
#pragma unroll
        for (int j = 0; j < 4; ++j) { u32x2 o; o.x = pk2(v[4 * j], v[4 * j + 1]); o.y = pk2(v[4 * j + 2], v[4 * j + 3]); *(u32x2*)(xb + 4 * lane + 256 * j) = o; }
        if (!dummy) { unsigned char* x8 = p.ws + WS_X1B8 + (size_t)tok * 1024;
#pragma unroll
            for (int j = 0; j < 4; ++j) *(unsigned*)(x8 + 4 * lane + 256 * j) = pk4_fp8(v[4 * j], v[4 * j + 1], v[4 * j + 2], v[4 * j + 3]); }
        float gl[4];
#pragma unroll
        for (int e = 0; e < 4; ++e) { float a = 0.f;
#pragma unroll
            for (int j = 0; j < 4; ++j) { const f32x4 w4 = *(const f32x4*)(wr + e * 1024 + 4 * lane + 256 * j); a += v[4 * j] * w4.x + v[4 * j + 1] * w4.y + v[4 * j + 2] * w4.z + v[4 * j + 3] * w4.w; }
            gl[e] = wave_sum(a) + p.b_gr[e]; }
        int gs = 0; float gm = gl[0];
#pragma unroll
        for (int e = 1; e < 4; ++e) if (gl[e] > gm) { gm = gl[e]; gs = e; }
        float gsum = 0.f;
#pragma unroll
        for (int e = 0; e < 4; ++e) gsum += __expf(gl[e] - gm);
        const float gprob = 1.0f / gsum;
        gs = __builtin_amdgcn_readfirstlane(gs);
        float el[4];
#pragma unroll
        for (int e = 0; e < 4; ++e) { float a = 0.f; const float* wp = wr + (4 + gs * 4 + e) * 1024;
#pragma unroll
            for (int j = 0; j < 4; ++j) { const f32x4 w4 = *(const f32x4*)(wp + 4 * lane + 256 * j); a += v[4 * j] * w4.x + v[4 * j + 1] * w4.y + v[4 * j + 2] * w4.z + v[4 * j + 3] * w4.w; }
            el[e] = wave_sum(a) + p.b_er[gs * 4 + e]; }
        int i1 = 0; float v1 = el[0];
#pragma unroll
        for (int e = 1; e < 4; ++e) if (el[e] > v1) { v1 = el[e]; i1 = e; }
        int i2 = -1; float v2 = -INFINITY;
#pragma unroll
        for (int e = 0; e < 4; ++e) if (e != i1 && el[e] > v2) { v2 = el[e]; i2 = e; }
        const float t2 = __expf(v2 - v1); const float w1 = gprob / (1.0f + t2), w2 = gprob * t2 / (1.0f + t2);
        const int lo = i1 < i2 ? i1 : i2, hi = i1 < i2 ? i2 : i1;
        const int pi = lo == 0 ? hi - 1 : (lo == 1 ? hi + 1 : 5);
        if (lane == 0 && !dummy) { cls_l[lr] = gs * 6 + pi; float* wt = WSP(float, WS_WTS) + (size_t)tok * 2; wt[0] = (i1 == lo) ? w1 : w2; wt[1] = (i1 == lo) ? w2 : w1; }
    }
#undef LN1_LOAD
    __syncthreads();
    if (dummy) return;
    if (tid < NCLS) { int n = 0; for (int r = 0; r < 64; ++r) n += (cls_l[r] == tid); misc[tid] = n ? (int)atomicAdd(WSP(unsigned, WS_CTL) + CW_CNT + tid, (unsigned)n) : 0; }
    __syncthreads();
    if (tid < 64) { const int c = cls_l[tid]; int rank = 0; for (int r = 0; r < tid; ++r) rank += (cls_l[r] == c);
        WSP(int, WS_LIST)[(size_t)c * T + misc[c] + rank] = u * 64 + tid; }
    __syncthreads();
}
__global__ void __launch_bounds__(512) k_ln1(Params p) {
    extern __shared__ float dyn[];
    float* wr = dyn; int* cls_l = (int*)(dyn + 20 * 1024); int* misc = cls_l + 64;
    for (int i = threadIdx.x; i < 20 * 1024; i += 512) wr[i] = WSP(float, WS_WRT)[i];
    __syncthreads();
    for (int u = blockIdx.x; u < T / 64; u += gridDim.x) ln1_unit(p, u, wr, cls_l, misc, threadIdx.x);
}
template <int NR>
__device__ __forceinline__ void ln2_rows(const Params& p, const int (&tok)[NR], const int (&prow)[NR], int lane, float* dummy = nullptr) {
    u32x2 xa[NR][4], ya[NR][4];
#pragma unroll
    for (int r = 0; r < NR; ++r) if (tok[r] >= 0) { const bf16_t* xrow = WSP(bf16_t, WS_X1B) + (size_t)tok[r] * 1024 + 4 * lane; const bf16_t* yrow = WSP(bf16_t, WS_Y2) + (size_t)prow[r] * 1024 + 4 * lane;
#pragma unroll
        for (int j = 0; j < 4; ++j) { xa[r][j] = *(const u32x2*)(xrow + 256 * j); ya[r][j] = *(const u32x2*)(yrow + 256 * j); } }
    f32x4 g4[4], b4[4];
#pragma unroll
    for (int j = 0; j < 4; ++j) { g4[j] = *(const f32x4*)(p.ln2_g + 4 * lane + 256 * j); b4[j] = *(const f32x4*)(p.ln2_b + 4 * lane + 256 * j); }
#pragma unroll
    for (int r = 0; r < NR; ++r) if (tok[r] >= 0) {
        float v[16]; float sm = 0.f;
#pragma unroll
        for (int j = 0; j < 4; ++j) { const u32x2 t = xa[r][j], y = ya[r][j];
            v[4 * j] = DN_ALPHA * bflo(t.x) + bflo(y.x); v[4 * j + 1] = DN_ALPHA * bfhi(t.x) + bfhi(y.x); v[4 * j + 2] = DN_ALPHA * bflo(t.y) + bflo(y.y); v[4 * j + 3] = DN_ALPHA * bfhi(t.y) + bfhi(y.y);
            sm += (v[4 * j] + v[4 * j + 1]) + (v[4 * j + 2] + v[4 * j + 3]); }
        const float mean = wave_sum(sm) * (1.0f / 1024.0f); float sq = 0.f;
#pragma unroll
        for (int i2 = 0; i2 < 16; ++i2) { v[i2] -= mean; sq += v[i2] * v[i2]; }
        const float rstd = 1.0f / sqrtf(wave_sum(sq) * (1.0f / 1024.0f) + LN_EPS);
        float* orow = (dummy ? dummy : p.out) + (size_t)tok[r] * 1024 + 4 * lane;
#pragma unroll
        for (int j = 0; j < 4; ++j) *(f32x4*)(orow + 256 * j) = (f32x4){v[4 * j] * rstd * g4[j].x + b4[j].x, v[4 * j + 1] * rstd * g4[j].y + b4[j].y, v[4 * j + 2] * rstd * g4[j].z + b4[j].z, v[4 * j + 3] * rstd * g4[j].w + b4[j].w};
    }
}
__global__ void __launch_bounds__(256) k_ln2(Params p) {
    __shared__ ClassTab tabs; if (threadIdx.x == 0) class_tab_fill(WSP(unsigned, WS_CTL) + CW_CNT, &tabs); __syncthreads(); const ClassTab* tab = &tabs;
    const int lane = threadIdx.x & 63; const int prow = blockIdx.x * 4 + (threadIdx.x >> 6);
    if (prow >= tab->rowbase[NCLS]) return;
    const int cls = find_class(tab, prow); const int i = prow - tab->rowbase[cls]; if (i >= tab->cnt[cls]) return;
    const int tk[1] = {WSP(int, WS_LIST)[(size_t)cls * T + i]}, pr[1] = {prow};
    ln2_rows<1>(p, tk, pr, lane);
}


#define LAS __attribute__((address_space(3)))
#define GAS __attribute__((address_space(1)))
constexpr int RING_OFF = 0, RING_BYTES = 131072;
constexpr int LCTL_OFF = RING_BYTES;
constexpr int LTOK_OFF = LCTL_OFF + 4096, MAXU = 16;
constexpr int LDS_BYTES = LTOK_OFF + MAXU * 1024;
constexpr int NTHR = 512, NWAVES = 8;

namespace pg8 {
typedef short bf16x8 __attribute__((ext_vector_type(8)));
typedef int v4i_t __attribute__((ext_vector_type(4)));
typedef int v8i_t __attribute__((ext_vector_type(8)));
constexpr int BM = 256, BK = 64, HALF = 128, HTB = HALF * BK * 2, NXCD = 8, WGM = 8;
__host__ __device__ __forceinline__ int lds_byte(int r, int c) { const int st = (r >> 4) * 2 + (c >> 5), rr = r & 15, cc = c & 31, ob = rr * 64 + cc * 2; return st * 1024 + (ob ^ (((ob >> 9) & 1) << 5)); }
__host__ __device__ __forceinline__ void stage_rc(int b, int& R, int& C) { const int st = b / 1024, sb = b % 1024, swz = sb ^ (((sb >> 9) & 1) << 5); R = (st >> 1) * 16 + swz / 64; C = (st & 1) * 32 + (swz % 64) / 2; }
__host__ __device__ __forceinline__ int perm32(int rho) { const int n = rho >> 4, i = rho & 15; return 8 * (i >> 2) + 4 * n + (i & 3); }

struct Unit { const char* A; const char* B; int row0, col0, bjump, aux; };
struct TileOrder {
    int nM, nN, nwg, G, c;
    __device__ __forceinline__ void init(int nM_, int nN_, int G_, int c_) { nM = nM_; nN = nN_; nwg = nM * nN; G = G_; c = c_; }
    __device__ __forceinline__ bool tile(int i, int& pm, int& pn) const {
        const long L = (long)i * G + c; if (L >= nwg) return false;
        int wgid = (int)L; { const int q = nwg / NXCD, r = nwg % NXCD, xcd = wgid % NXCD, off = wgid / NXCD; wgid = (xcd < r ? xcd * (q + 1) : r * (q + 1) + (xcd - r) * q) + off; }
        const int nig = WGM * nN, gid = wgid / nig, fm = gid * WGM, gsz = (nM - fm) < WGM ? (nM - fm) : WGM;
        pm = fm + ((wgid % nig) % gsz); pn = (wgid % nig) / gsz; return true;
    }
};
__device__ __forceinline__ unsigned cvt_pk_bf16(float lo, float hi) { unsigned r; asm volatile("v_cvt_pk_bf16_f32 %0, %1, %2" : "=v"(r) : "v"(lo), "v"(hi)); return r; }

template <class EF> struct EpiRows {
    static constexpr bool PERM = true;
    EF ef;
    __device__ __forceinline__ bool keep_acc(const Unit&) const { return false; }
    __device__ __forceinline__ void operator()(f32x4 (&acc)[2][2][4][2], const Unit& u, int wr, int wc, int fr, int fq) const {
#pragma unroll
        for (int ai = 0; ai < 2; ++ai)
#pragma unroll
            for (int m = 0; m < 4; ++m) { const int row = u.row0 + ai * HALF + wr * 64 + m * 16 + fr;
#pragma unroll
                for (int bj = 0; bj < 2; ++bj) { const int c0 = u.col0 + bj * HALF + wc * 32 + 8 * fq;
                    float v[8] = {acc[ai][bj][m][0][0], acc[ai][bj][m][0][1], acc[ai][bj][m][0][2], acc[ai][bj][m][0][3], acc[ai][bj][m][1][0], acc[ai][bj][m][1][1], acc[ai][bj][m][1][2], acc[ai][bj][m][1][3]};
                    ef(u, row, c0, v); }
                asm volatile("" ::: "memory"); }
    }
};

template <class Epi, class Sched, bool ALIGN_EPI, bool GATHER, bool BJUMP, bool FP8 = false>
__device__ __forceinline__ void gemm_phase(LAS unsigned char* lds, const char* Abase, int lda, int ldb, int K, const Sched& S, const Epi& E, int wave_s) {
    const int tid = opaque_tid(wave_s), wid = __builtin_amdgcn_readfirstlane(tid >> 6), lane = tid & 63, wr = wid >> 2, wc = wid & 3, fr = lane & 15, fq = lane >> 4;
    const int nt = K / BK;
    unsigned voffA[2], voffB[2]; unsigned voffG[2][2], nvoffG[2][2];
#pragma unroll
    for (int i = 0; i < 2; ++i) { int R, C; stage_rc(tid * 16 + i * 8192, R, C); const int Rb = Epi::PERM ? ((R & ~31) + perm32(R & 31)) : R;
        voffA[i] = (unsigned)(R * lda + C) * 2u; voffB[i] = (unsigned)(Rb * ldb + C) * 2u; voffG[0][i] = voffG[1][i] = nvoffG[0][i] = nvoffG[1][i] = 0u; }
    const size_t kstep = (size_t)(BK * 2);
    const size_t hstepA = (size_t)HALF * lda * 2, hstepB = (size_t)HALF * ldb * 2;
    const unsigned ldsw = (unsigned)wid * 1024u;
    const int aoff = lds_byte(wr * 64 + fr, fq * 8), boff = lds_byte(wc * 32 + fr, fq * 8);
#define PG8_SA(b, h) (((b) * 2 + (h)) * HTB)
#define PG8_SB(b, h) ((4 + (b) * 2 + (h)) * HTB)
#define PG8_GLDS(gptr, ldsoff) __builtin_amdgcn_global_load_lds((const unsigned*)(gptr), (LAS unsigned*)(lds + (ldsoff)), 16, 0, 0)
#define PG8_STAGE_B(bufoff, gbase) do { _Pragma("unroll") for (int _i = 0; _i < 2; ++_i) PG8_GLDS((const char*)(gbase) + voffB[_i], (bufoff) + ldsw + _i * 8192); } while (0)
#define PG8_STAGE_A(bufoff, kptr, h, nx) do { if constexpr (GATHER) { _Pragma("unroll") for (int _i = 0; _i < 2; ++_i) PG8_GLDS((const char*)(kptr) + ((nx) ? nvoffG[h][_i] : voffG[h][_i]), (bufoff) + ldsw + _i * 8192); } \
        else { _Pragma("unroll") for (int _i = 0; _i < 2; ++_i) PG8_GLDS((const char*)(kptr) + (h) * hstepA + voffA[_i], (bufoff) + ldsw + _i * 8192); } } while (0)
#define PG8_GATHER_OFFS(dst, ord) do { LAS const int* _tk = S.toks(ord); _Pragma("unroll") for (int _h = 0; _h < 2; ++_h) _Pragma("unroll") for (int _i = 0; _i < 2; ++_i) { int _R, _C; stage_rc(tid * 16 + _i * 8192, _R, _C); \
        dst[_h][_i] = (unsigned)_tk[_h * HALF + _R] * (unsigned)(lda * 2) + (unsigned)(_C * 2); } } while (0)
#define PG8_LDA(dst, b, h) do { _Pragma("unroll") for (int m = 0; m < 4; ++m) _Pragma("unroll") for (int k = 0; k < 2; ++k) dst[m][k] = *(const LAS bf16x8*)(lds + PG8_SA(b, h) + aoff + m * 2048 + k * 1024); } while (0)
#define PG8_LDB(dst, b, h) do { _Pragma("unroll") for (int n = 0; n < 2; ++n) _Pragma("unroll") for (int k = 0; k < 2; ++k) dst[n][k] = *(const LAS bf16x8*)(lds + PG8_SB(b, h) + boff + n * 2048 + k * 1024); } while (0)
#define PG8_CAT8(lo, hi) __builtin_shufflevector(__builtin_bit_cast(v4i_t, lo), __builtin_bit_cast(v4i_t, hi), 0, 1, 2, 3, 4, 5, 6, 7)
#define PG8_MMA(ai, bj, At, Bt) do { __builtin_amdgcn_s_setprio(1); if constexpr (FP8) { _Pragma("unroll") for (int m = 0; m < 4; ++m) _Pragma("unroll") for (int n = 0; n < 2; ++n) \
        { const v8i_t b8_ = PG8_CAT8(Bt[n][0], Bt[n][1]), a8_ = PG8_CAT8(At[m][0], At[m][1]); asm volatile("v_mfma_f32_16x16x128_f8f6f4 %0, %1, %2, %0" : "+v"(acc[ai][bj][m][n]) : "v"(b8_), "v"(a8_)); } } \
        else { _Pragma("unroll") for (int m = 0; m < 4; ++m) _Pragma("unroll") for (int n = 0; n < 2; ++n) _Pragma("unroll") for (int k = 0; k < 2; ++k) \
        acc[ai][bj][m][n] = __builtin_amdgcn_mfma_f32_16x16x32_bf16(Bt[n][k], At[m][k], acc[ai][bj][m][n], 0, 0, 0); } __builtin_amdgcn_s_setprio(0); } while (0)
#define PG8_WAIT_V(n) asm volatile("s_waitcnt vmcnt(" #n ")" ::: "memory")
#define PG8_WAIT_L(n) asm volatile("s_waitcnt lgkmcnt(" #n ")" ::: "memory")
#define PG8_BAR __builtin_amdgcn_s_barrier()
#define PG8_SCHED __builtin_amdgcn_sched_barrier(0)
    Unit cur, nxt; int ui = 0;
    if (!S.next(0, cur)) return;
    f32x4 acc[2][2][4][2];
#pragma unroll
    for (int a = 0; a < 2; ++a)
#pragma unroll
        for (int b = 0; b < 2; ++b)
#pragma unroll
            for (int m = 0; m < 4; ++m)
#pragma unroll
                for (int n = 0; n < 2; ++n) acc[a][b][m][n] = (f32x4){0.f, 0.f, 0.f, 0.f};
    bf16x8 At[4][2], B0[2][2], B1[2][2];
    const char* cA = GATHER ? Abase : cur.A; const char* cB = cur.B;
    if constexpr (GATHER) PG8_GATHER_OFFS(voffG, 0);
    PG8_STAGE_B(PG8_SB(0, 0), cB); PG8_STAGE_B(PG8_SB(0, 1), cB + hstepB); PG8_STAGE_A(PG8_SA(0, 0), cA, 0, false); PG8_STAGE_A(PG8_SA(0, 1), cA, 1, false);
    if (wr == 1) PG8_BAR;
    PG8_WAIT_V(2); PG8_BAR;
    PG8_STAGE_B(PG8_SB(1, 0), cB + kstep); PG8_STAGE_A(PG8_SA(1, 0), cA + kstep, 0, false); PG8_STAGE_B(PG8_SB(1, 1), cB + hstepB + kstep);
    PG8_WAIT_V(6); PG8_BAR;
    for (;;) {
        const bool has_next = S.next(ui + 1, nxt);
        if constexpr (GATHER) { if (has_next) PG8_GATHER_OFFS(nvoffG, ui + 1); else {
#pragma unroll
            for (int h = 0; h < 2; ++h)
#pragma unroll
                for (int i = 0; i < 2; ++i) nvoffG[h][i] = voffG[h][i]; } }
        const char* nA = GATHER ? Abase : (has_next ? nxt.A : cA); const char* nB = has_next ? nxt.B : cB;
#pragma nounroll
        for (int t = 0; t < nt; t += 2) {
            const bool last = (t == nt - 2);
            const char* a1 = cA + (size_t)(t + 1) * kstep;
            const char* a2 = last ? nA : cA + (size_t)(t + 2) * kstep;
            const char* b2 = last ? nB : cB + (size_t)(t + 2) * kstep + ((BJUMP && (t + 2) >= (nt >> 1)) ? cur.bjump : 0);
            const char* a3 = a2 + kstep; const char* b3 = b2 + kstep;
            PG8_LDB(B0, 0, 0); PG8_LDB(B1, 0, 1); PG8_SCHED; PG8_LDA(At, 0, 0); PG8_STAGE_A(PG8_SA(1, 1), a1, 1, false);
            PG8_WAIT_V(8); PG8_WAIT_L(0); PG8_BAR; PG8_MMA(0, 0, At, B0); PG8_MMA(0, 1, At, B1); PG8_BAR; PG8_SCHED;
            PG8_LDA(At, 0, 1); PG8_STAGE_B(PG8_SB(0, 0), b2); PG8_STAGE_B(PG8_SB(0, 1), b2 + hstepB); PG8_STAGE_A(PG8_SA(0, 0), a2, 0, last);
            PG8_WAIT_V(8); PG8_WAIT_L(0); PG8_BAR; PG8_MMA(1, 0, At, B0); PG8_MMA(1, 1, At, B1); PG8_BAR; PG8_SCHED;
            PG8_LDB(B0, 1, 0); PG8_LDB(B1, 1, 1); PG8_SCHED; PG8_LDA(At, 1, 0); PG8_STAGE_A(PG8_SA(0, 1), a2, 1, last);
            PG8_WAIT_V(8); PG8_WAIT_L(0); PG8_BAR; PG8_MMA(0, 0, At, B0); PG8_MMA(0, 1, At, B1); PG8_BAR; PG8_SCHED;
            PG8_LDA(At, 1, 1); PG8_STAGE_B(PG8_SB(1, 0), b3); PG8_STAGE_B(PG8_SB(1, 1), b3 + hstepB); PG8_STAGE_A(PG8_SA(1, 0), a3, 0, last);
            PG8_WAIT_V(8); PG8_WAIT_L(0); PG8_BAR; PG8_MMA(1, 0, At, B0); PG8_MMA(1, 1, At, B1); PG8_BAR; PG8_SCHED;
        }
        if constexpr (ALIGN_EPI) { if (wr == 0) PG8_BAR; }
        if constexpr (FP8) { asm volatile("s_nop 15\n\ts_nop 15" ::: "memory"); PG8_SCHED; }
        E(acc, cur, wr, wc, fr, fq);
        if (!has_next) break;
        if (!E.keep_acc(cur)) {
#pragma unroll
        for (int a = 0; a < 2; ++a)
#pragma unroll
            for (int b = 0; b < 2; ++b)
#pragma unroll
                for (int m = 0; m < 4; ++m)
#pragma unroll
                    for (int n = 0; n < 2; ++n) acc[a][b][m][n] = (f32x4){0.f, 0.f, 0.f, 0.f}; }
        cur = nxt; cA = nA; cB = nB; ++ui;
        if constexpr (GATHER) {
#pragma unroll
            for (int h = 0; h < 2; ++h)
#pragma unroll
                for (int i = 0; i < 2; ++i) voffG[h][i] = nvoffG[h][i]; }
        if constexpr (ALIGN_EPI) { if (wr == 1) PG8_BAR; }
    }
    PG8_WAIT_V(0);
    if constexpr (!ALIGN_EPI) { if (wr == 0) PG8_BAR; }
    PG8_BAR;
#undef PG8_SA
#undef PG8_SB
#undef PG8_GLDS
#undef PG8_STAGE_A
#undef PG8_STAGE_B
#undef PG8_GATHER_OFFS
#undef PG8_LDA
#undef PG8_LDB
#undef PG8_MMA
#undef PG8_CAT8
#undef PG8_WAIT_V
#undef PG8_WAIT_L
#undef PG8_BAR
#undef PG8_SCHED
}
}

namespace swa {
typedef short bf16x8 __attribute__((ext_vector_type(8)));
typedef short s16x4 __attribute__((ext_vector_type(4)));
typedef float f32x16 __attribute__((ext_vector_type(16)));
constexpr int DH = 128, NW = 8, QBLK = 32, KVBLK = 64, QB = NW * QBLK;
constexpr int SHM_V = KVBLK * DH * 2, SHM_K = KVBLK * DH * 2;
constexpr int LDS_NEED = 2 * SHM_V + 2 * SHM_K + NW * 64 * 4;
constexpr float SCALE = 0.08838834764831845f, THR = 8.f;
#define KSWZ(row, colB) ((row) * 256 + ((colB) ^ (((row) & 7) << 4)))
#define SBAR() __builtin_amdgcn_sched_barrier(0)
__device__ __forceinline__ int v_st(int k, int c) { const int kk = (k & ~0xC) | ((k & 4) << 1) | ((k & 8) >> 1); return ((kk >> 3) * 4 + (c >> 5)) * 512 + ((kk & 7) * 32 + (c & 31)) * 2; }
__device__ __forceinline__ int v_rd_base(int lane) { return ((lane & 3) << 3) | (((lane >> 2) & 3) << 6) | (((lane >> 4) & 1) << 5) | (((lane >> 5) & 1) << 8); }
constexpr int v_rd_off(int d0, int ks, int half) { return d0 * 512 + ks * 4096 + half * 2048; }
__device__ __forceinline__ int crow(int r, int hi) { return (r & 3) + 8 * (r >> 2) + 4 * hi; }
__device__ __forceinline__ unsigned cvtpk(float lo, float hi) { unsigned r; asm volatile("v_cvt_pk_bf16_f32 %0, %1, %2" : "=v"(r) : "v"(lo), "v"(hi)); return r; }
__device__ __forceinline__ bf16x8 load8(const bf16_t* p) { return *reinterpret_cast<const bf16x8*>(p); }
__device__ __forceinline__ void mask_tile(f32x16& p0, f32x16& p1, int dq, unsigned W) {
    const float NEG = -__builtin_inff();
#pragma unroll
    for (int r = 0; r < 16; ++r) {
        const int c = (r & 3) + 8 * (r >> 2);
        if ((unsigned)(dq - c) >= W) p0[r] = NEG;
        if ((unsigned)(dq - c - 32) >= W) p1[r] = NEG;
    }
}
__device__ __forceinline__ void partialSM(f32x16& p0, f32x16& p1, float& m_reg, float& mn, float& alpha) {
    float pmax = p0[0]; for (int r = 1; r < 16; ++r) pmax = fmaxf(pmax, p0[r]); for (int r = 0; r < 16; ++r) pmax = fmaxf(pmax, p1[r]);
    { auto rr = __builtin_amdgcn_permlane32_swap(__float_as_uint(pmax), __float_as_uint(pmax), false, false);
      pmax = fmaxf(__uint_as_float(rr[0]), __uint_as_float(rr[1])); }
    constexpr float C2 = 1.4426950408889634f * SCALE;
    if (__builtin_expect(__all((pmax - m_reg) * SCALE <= THR), 1)) { mn = m_reg; alpha = 1.f; }
    else { mn = fmaxf(m_reg, pmax); alpha = __builtin_amdgcn_exp2f((m_reg - mn) * C2); m_reg = mn; }
    const float mnL = -mn * C2;
    for (int r = 0; r < 16; ++r) p0[r] = fmaf(p0[r], C2, mnL); for (int r = 0; r < 16; ++r) p1[r] = fmaf(p1[r], C2, mnL);
    for (int r = 0; r < 16; ++r) p0[r] = __builtin_amdgcn_exp2f(p0[r]);
}
__device__ __forceinline__ void finishSM(f32x16& p0, f32x16& p1, float alpha, float& l_reg, bf16x8& pa0, bf16x8& pa1, bf16x8& pa2, bf16x8& pa3) {
    for (int r = 0; r < 16; ++r) p1[r] = __builtin_amdgcn_exp2f(p1[r]);
    float ps = 0; for (int r = 0; r < 16; ++r) ps += p0[r]; for (int r = 0; r < 16; ++r) ps += p1[r];
    { auto rr = __builtin_amdgcn_permlane32_swap(__float_as_uint(ps), __float_as_uint(ps), false, false);
      ps = __uint_as_float(rr[0]) + __uint_as_float(rr[1]); }
    l_reg = l_reg * alpha + ps;
#define PK4(P, B_, OUT) do { unsigned a0 = cvtpk(P[B_+0], P[B_+1]), a1 = cvtpk(P[B_+2], P[B_+3]);                          \
        unsigned b0 = cvtpk(P[B_+4], P[B_+5]), b1 = cvtpk(P[B_+6], P[B_+7]);                                             \
        auto r0 = __builtin_amdgcn_permlane32_swap(a0, b0, false, false); auto r1 = __builtin_amdgcn_permlane32_swap(a1, b1, false, false); \
        u32x4 w = {r0[0], r1[0], r0[1], r1[1]}; OUT = *reinterpret_cast<bf16x8*>(&w); } while (0)
    PK4(p0, 0, pa0); PK4(p0, 8, pa1); PK4(p1, 0, pa2); PK4(p1, 8, pa3);
#undef PK4
}
template <int KB>
__device__ __forceinline__ void qkt(f32x16& p0, f32x16& p1, const char* K_lds, int r32, int hi, const bf16x8* qr, bool act) {
    if (!act) { const float NEG = -__builtin_inff();
#pragma unroll
        for (int r = 0; r < 16; ++r) { p0[r] = NEG; p1[r] = NEG; } return; }
    p0 = f32x16{}; p1 = f32x16{};
    const char* kb[4];
#pragma unroll
    for (int dd = 0; dd < 4; ++dd) kb[dd] = K_lds + KB * SHM_K + KSWZ(r32, (dd * 16 + hi * 8) * 2);
#pragma unroll
    for (int d0 = 0; d0 < 8; ++d0) { const char* a = kb[d0 & 3] + (d0 >> 2) * 128;
        bf16x8 b0 = *reinterpret_cast<const bf16x8*>(a);
        bf16x8 b1 = *reinterpret_cast<const bf16x8*>(a + 32 * 256);
        p0 = __builtin_amdgcn_mfma_f32_32x32x16_bf16(b0, qr[d0], p0, 0, 0, 0);
        p1 = __builtin_amdgcn_mfma_f32_32x32x16_bf16(b1, qr[d0], p1, 0, 0, 0); }
}
template <int VB>
__device__ __forceinline__ void pv_tile(f32x16* o, int vb0, bf16x8 pa0, bf16x8 pa1, bf16x8 pa2, bf16x8 pa3, bool act) {
    if (!act) return;
#define TRRD(dst, off) asm volatile("ds_read_b64_tr_b16 %0, %1 offset:%2" : "=&v"(dst) : "v"(vb0), "i"(off) : "memory")
#define PV_D0(d0) do { s16x4 l0, l1, l2, l3, h0, h1, h2, h3; constexpr int b_ = VB * SHM_V + v_rd_off(d0, 0, 0); \
        TRRD(l0, b_); TRRD(h0, b_ + 2048); TRRD(l1, b_ + 4096); TRRD(h1, b_ + 6144); TRRD(l2, b_ + 8192); TRRD(h2, b_ + 10240); TRRD(l3, b_ + 12288); TRRD(h3, b_ + 14336); \
        asm volatile("s_waitcnt lgkmcnt(0)" ::: "memory"); SBAR();   \
        o[d0] = __builtin_amdgcn_mfma_f32_32x32x16_bf16(pa0, (bf16x8){l0[0], l0[1], l0[2], l0[3], h0[0], h0[1], h0[2], h0[3]}, o[d0], 0, 0, 0);   \
        o[d0] = __builtin_amdgcn_mfma_f32_32x32x16_bf16(pa1, (bf16x8){l1[0], l1[1], l1[2], l1[3], h1[0], h1[1], h1[2], h1[3]}, o[d0], 0, 0, 0);   \
        o[d0] = __builtin_amdgcn_mfma_f32_32x32x16_bf16(pa2, (bf16x8){l2[0], l2[1], l2[2], l2[3], h2[0], h2[1], h2[2], h2[3]}, o[d0], 0, 0, 0);   \
        o[d0] = __builtin_amdgcn_mfma_f32_32x32x16_bf16(pa3, (bf16x8){l3[0], l3[1], l3[2], l3[3], h3[0], h3[1], h3[2], h3[3]}, o[d0], 0, 0, 0); } while (0)
    PV_D0(0); PV_D0(1); PV_D0(2); PV_D0(3);
#undef PV_D0
#undef TRRD
}
struct BlockRef { const bf16_t* Q; const bf16_t* K; const bf16_t* V; bf16_t* O; float* LSE; int P0, W, segmask, skv, ostride; };
struct Seam { bf16x8 qr[8]; bf16x8 st_v0, st_v1, st_k0, st_k1; };
__device__ __forceinline__ int imax(int a, int b) { return a > b ? a : b; }
__device__ __forceinline__ int blk_jlo(const BlockRef& b) { const int lowk = imax(b.P0 - b.W + 1, b.P0 & ~b.segmask); return lowk > 0 ? lowk / KVBLK : 0; }
#define ROW(p, k0, rr) ((p) + (size_t)((k0) + (rr)) * DH + sc)
#define VMW() asm volatile("s_waitcnt vmcnt(0)" ::: "memory")
#define VMWN(n) asm volatile("s_waitcnt vmcnt(%0)" :: "i"(n) : "memory")
#define SLOAD_H(Kp, Vp, k0) do { S.st_v0 = load8(ROW(Vp, k0, sr)); S.st_v1 = load8(ROW(Vp, k0, 32 + sr));              \
                         S.st_k0 = load8(ROW(Kp, k0, sr)); S.st_k1 = load8(ROW(Kp, k0, 32 + sr)); } while (0)
#define SWRITE_HK(bf) do { *(bf16x8*)(K_lds + (bf) * SHM_K + kws) = S.st_k0; *(bf16x8*)(K_lds + (bf) * SHM_K + kws + 32 * 256) = S.st_k1; } while (0)
#define SWRITE_HV(bf) do { *(bf16x8*)(V_lds + (bf) * SHM_V + vst0) = S.st_v0; *(bf16x8*)(V_lds + (bf) * SHM_V + vst1) = S.st_v1; } while (0)
#define SWRITE_H(bf) do { SWRITE_HV(bf); SWRITE_HK(bf); } while (0)
__device__ __forceinline__ void prime(const BlockRef& cur, char* lds, Seam& S, int wave_s) {
    const int tid = opaque_tid(wave_s), wid = __builtin_amdgcn_readfirstlane(tid >> 6), lane = tid & 63, r32 = lane & 31, hi = lane >> 5;
    const int sr = tid >> 4, sc = (tid & 15) * 8, kws = KSWZ(sr, sc * 2); char* K_lds = lds + 2 * SHM_V;
    const int kb0 = blk_jlo(cur) * KVBLK;
    for (int d0 = 0; d0 < 8; ++d0) S.qr[d0] = load8(cur.Q + (size_t)(wid * QBLK + r32) * DH + d0 * 16 + hi * 8);
    SLOAD_H(cur.K, cur.V, kb0); VMW(); SWRITE_HK(0);
    __syncthreads();
}
__device__ __forceinline__ void block(const BlockRef& cur, const BlockRef& nxt, char* lds, Seam& S, int wave_s) {
    const int tid = opaque_tid(wave_s), wid = __builtin_amdgcn_readfirstlane(tid >> 6), lane = tid & 63, r32 = lane & 31, hi = lane >> 5;
    const int W = cur.W;
    const int j_lo = blk_jlo(cur);
    int j_hi = (cur.P0 + QB - 1) / KVBLK + 1; if (j_hi > cur.skv / KVBLK) j_hi = cur.skv / KVBLK;
    const int NT = j_hi - j_lo;
    const int kbn = blk_jlo(nxt) * KVBLK;
    const int qlo = cur.P0 + wid * QBLK, qm = qlo + r32 - 4 * hi;
    const int segb = qlo & ~cur.segmask;
    const int lowk_w = imax(qlo - W + 1, segb);
    const int lowk_last = imax(qlo + QBLK - W, segb);
    const int wrow = ((qlo + r32) & cur.segmask) + 1;
    const unsigned Wl = (unsigned)(wrow < W ? wrow : W);
    char* V_lds = lds; char* K_lds = lds + 2 * SHM_V;
    float* ws = (float*)(lds + 2 * SHM_V + 2 * SHM_K) + wid * 64; float* li_l = ws, * al_l = ws + 32;
    float m_reg = -1e30f, l_reg = 0; f32x16 o[4] = {};
    const int sr = tid >> 4, sc = (tid & 15) * 8, vst0 = v_st(sr, sc), vst1 = v_st(32 + sr, sc), kws = KSWZ(sr, sc * 2);
    const int vb0 = (int)(uintptr_t)V_lds + v_rd_base(lane);
    const bf16_t* Kh = cur.K; const bf16_t* Vh = cur.V;
#define RESC(a) do { if (__any((a) < 1.f)) { if (hi == 0) al_l[r32] = (a); asm volatile("s_waitcnt lgkmcnt(0)" ::: "memory");              \
                     for (int d_ = 0; d_ < 4; ++d_) for (int r = 0; r < 16; ++r) o[d_][r] *= al_l[crow(r, hi)]; } } while (0)
#define KBASE(t) ((j_lo + (t)) * KVBLK)
#define ACT(t) (KBASE(t) <= qlo + QBLK - 1 && KBASE(t) + KVBLK - 1 >= lowk_w)
#define MASKT(P0_, P1_, t) do { const int kb_ = KBASE(t); if (ACT(t) && (kb_ + KVBLK - 1 > qlo || kb_ < lowk_last)) mask_tile(P0_, P1_, qm - kb_, Wl); } while (0)
    constexpr int NQL = 8;
#define SEAM_K0() do { VMWN(NQL); SWRITE_HK(0); SBAR(); } while (0)
    f32x16 pA0, pA1, pB0, pB1; float mnA, mnB, alA, alB; bf16x8 pa0, pa1, pa2, pa3;
    SWRITE_HV(0); SBAR();
    if (NT > 1) { SLOAD_H(Kh, Vh, KBASE(1)); }
    SBAR(); qkt<0>(pA0, pA1, K_lds, r32, hi, S.qr, ACT(0));
    MASKT(pA0, pA1, 0); partialSM(pA0, pA1, m_reg, mnA, alA);
    if (NT > 1) { VMW(); SWRITE_H(1); }
    __syncthreads();
#define HALF_STEP(PX0, PX1, mnX, alX, PY0, PY1, alY, t, KB, VB, SB) do {                                                      \
        SBAR(); if ((t) + 1 < NT) { SLOAD_H(Kh, Vh, KBASE((t) + 1)); SBAR(); }                                       \
        qkt<KB>(PX0, PX1, K_lds, r32, hi, S.qr, ACT(t));                                             \
        finishSM(PY0, PY1, alY, l_reg, pa0, pa1, pa2, pa3); SBAR();                                                           \
        pv_tile<VB>(o, vb0, pa0, pa1, pa2, pa3, ACT((t) - 1)); MASKT(PX0, PX1, (t)); partialSM(PX0, PX1, m_reg, mnX, alX);                                        \
        __syncthreads();                                                                                                      \
        if ((t) + 1 < NT) { VMW(); SWRITE_H(SB); }                                                                          \
        RESC(alX); __syncthreads(); } while (0)
    for (int t = 1; t + 1 < NT; t += 2) {
        HALF_STEP(pB0, pB1, mnB, alB, pA0, pA1, alA, t, 1, 0, 0);
        HALF_STEP(pA0, pA1, mnA, alA, pB0, pB1, alB, t + 1, 0, 1, 1);
    }
    const bool even = (NT & 1) == 0;
    if (even) { SBAR(); qkt<1>(pB0, pB1, K_lds, r32, hi, S.qr, ACT(NT - 1)); SBAR(); }
    SLOAD_H(nxt.K, nxt.V, kbn); SBAR();
#pragma unroll
    for (int d0 = 0; d0 < 8; ++d0) S.qr[d0] = load8(nxt.Q + (size_t)(wid * QBLK + r32) * DH + d0 * 16 + hi * 8);
    SBAR();
    finishSM(pA0, pA1, alA, l_reg, pa0, pa1, pa2, pa3); SBAR();
    pv_tile<0>(o, vb0, pa0, pa1, pa2, pa3, ACT(even ? NT - 2 : NT - 1));
    if (even) { MASKT(pB0, pB1, NT - 1); partialSM(pB0, pB1, m_reg, mnB, alB); __syncthreads(); RESC(alB);
        finishSM(pB0, pB1, alB, l_reg, pa0, pa1, pa2, pa3); SBAR(); pv_tile<1>(o, vb0, pa0, pa1, pa2, pa3, ACT(NT - 1)); }
    SBAR(); SEAM_K0();
    if (hi == 0) li_l[r32] = l_reg; asm volatile("s_waitcnt lgkmcnt(0)" ::: "memory");
    if (cur.LSE != nullptr && hi == 0) cur.LSE[wid * QBLK + r32] = m_reg * SCALE + __logf(l_reg);
    float rli[16];
#pragma unroll
    for (int r = 0; r < 16; ++r) rli[r] = __builtin_amdgcn_rcpf(li_l[crow(r, hi)]);
    bf16_t* Ow = cur.O + (size_t)(wid * QBLK) * cur.ostride;
#pragma unroll
    for (int r = 0; r < 16; ++r) { const int orow = crow(r, hi);
#pragma unroll
        for (int d0 = 0; d0 < 4; ++d0) { const float v = o[d0][r] * rli[r];
            const float vn = __shfl_xor(v, 1);
            if ((r32 & 1) == 0) *(unsigned*)(Ow + (size_t)orow * cur.ostride + d0 * 32 + r32) = cvtpk(v, vn); } }
    __syncthreads();
#undef RESC
#undef KBASE
#undef ACT
#undef MASKT
#undef SEAM_K0
#undef HALF_STEP
}

constexpr int RING_V = 4 * SHM_K;
__device__ __forceinline__ void qkt_rt(f32x16& p0, f32x16& p1, const LAS char* Kslot, int r32, int hi, const bf16x8* qr) {
    p0 = f32x16{}; p1 = f32x16{};
    const LAS char* kb[4];
#pragma unroll
    for (int dd = 0; dd < 4; ++dd) kb[dd] = Kslot + KSWZ(r32, (dd * 16 + hi * 8) * 2);
#pragma unroll
    for (int d0 = 0; d0 < 8; ++d0) { const LAS char* a = kb[d0 & 3] + (d0 >> 2) * 128;
        bf16x8 b0 = *(const LAS bf16x8*)(a);
        bf16x8 b1 = *(const LAS bf16x8*)(a + 32 * 256);
        p0 = __builtin_amdgcn_mfma_f32_32x32x16_bf16(b0, qr[d0], p0, 0, 0, 0);
        p1 = __builtin_amdgcn_mfma_f32_32x32x16_bf16(b1, qr[d0], p1, 0, 0, 0); }
}
__device__ __forceinline__ void pv_rt(f32x16* o, int vb, bf16x8 pa0, bf16x8 pa1, bf16x8 pa2, bf16x8 pa3) {
#define TRRD(dst, off) asm volatile("ds_read_b64_tr_b16 %0, %1 offset:%2" : "=&v"(dst) : "v"(vb), "i"(off) : "memory")
#define PV_D0(d0) do { s16x4 l0, l1, l2, l3, h0, h1, h2, h3; constexpr int b_ = v_rd_off(d0, 0, 0); \
        TRRD(l0, b_); TRRD(h0, b_ + 2048); TRRD(l1, b_ + 4096); TRRD(h1, b_ + 6144); TRRD(l2, b_ + 8192); TRRD(h2, b_ + 10240); TRRD(l3, b_ + 12288); TRRD(h3, b_ + 14336); \
        asm volatile("s_waitcnt lgkmcnt(0)" ::: "memory"); SBAR();   \
        o[d0] = __builtin_amdgcn_mfma_f32_32x32x16_bf16(pa0, (bf16x8){l0[0], l0[1], l0[2], l0[3], h0[0], h0[1], h0[2], h0[3]}, o[d0], 0, 0, 0);   \
        o[d0] = __builtin_amdgcn_mfma_f32_32x32x16_bf16(pa1, (bf16x8){l1[0], l1[1], l1[2], l1[3], h1[0], h1[1], h1[2], h1[3]}, o[d0], 0, 0, 0);   \
        o[d0] = __builtin_amdgcn_mfma_f32_32x32x16_bf16(pa2, (bf16x8){l2[0], l2[1], l2[2], l2[3], h2[0], h2[1], h2[2], h2[3]}, o[d0], 0, 0, 0);   \
        o[d0] = __builtin_amdgcn_mfma_f32_32x32x16_bf16(pa3, (bf16x8){l3[0], l3[1], l3[2], l3[3], h3[0], h3[1], h3[2], h3[3]}, o[d0], 0, 0, 0); } while (0)
    PV_D0(0); PV_D0(1); PV_D0(2); PV_D0(3);
#undef PV_D0
#undef TRRD
}
struct WaveState { float m, l; f32x16 o[4]; };
__device__ __forceinline__ void tile_step(WaveState& st, const bf16x8* qr, const LAS char* lds, int slot, int r32, int hi, int lane, LAS float* al_l, bool need_mask, int dq, unsigned Wl) {
    f32x16 p0, p1; float mn, alpha; bf16x8 pa0, pa1, pa2, pa3;
    qkt_rt(p0, p1, lds + slot * SHM_K, r32, hi, qr);
    if (need_mask) mask_tile(p0, p1, dq, Wl);
    partialSM(p0, p1, st.m, mn, alpha);
    if (__any(alpha < 1.f)) { if (hi == 0) al_l[r32] = alpha; asm volatile("s_waitcnt lgkmcnt(0)" ::: "memory");
        for (int d_ = 0; d_ < 4; ++d_) for (int r = 0; r < 16; ++r) st.o[d_][r] *= al_l[crow(r, hi)]; }
    finishSM(p0, p1, alpha, st.l, pa0, pa1, pa2, pa3); SBAR();
    pv_rt(st.o, (int)(unsigned)(uintptr_t)(lds + RING_V + slot * SHM_V) + v_rd_base(lane), pa0, pa1, pa2, pa3);
}
__device__ __forceinline__ void wave_store(const WaveState& st, bf16_t* Ow, int ostride, float* lse, int r32, int hi, LAS float* li_l) {
    if (hi == 0) li_l[r32] = st.l; asm volatile("s_waitcnt lgkmcnt(0)" ::: "memory");
    if (lse != nullptr && hi == 0) lse[r32] = st.m * SCALE + __logf(st.l);
    float rli[16];
#pragma unroll
    for (int r = 0; r < 16; ++r) rli[r] = __builtin_amdgcn_rcpf(li_l[crow(r, hi)]);
#pragma unroll
    for (int r = 0; r < 16; ++r) { const int orow = crow(r, hi);
#pragma unroll
        for (int d0 = 0; d0 < 4; ++d0) { const float v = st.o[d0][r] * rli[r];
            const float vn = __int_as_float(__builtin_amdgcn_update_dpp(0, __float_as_int(v), 0xB1, 0xf, 0xf, true));
            if ((r32 & 1) == 0) *(unsigned*)(Ow + (size_t)orow * ostride + d0 * 32 + r32) = cvtpk(v, vn); } }
}
__device__ __forceinline__ void wave_reset(WaveState& st) { st.m = -1e30f; st.l = 0.f;
#pragma unroll
    for (int d = 0; d < 4; ++d) st.o[d] = f32x16{}; }
#define HS_LOADQ(qr, Qrow0) do { _Pragma("unroll") for (int d0 = 0; d0 < 8; ++d0) qr[d0] = load8((Qrow0) + (size_t)(wid * QBLK + r32) * DH + d0 * 16 + hi * 8); } while (0)
#define HS_SLOAD(Kp, Vp, k0) do { st_v0 = load8(ROW(Vp, k0, sr)); st_v1 = load8(ROW(Vp, k0, 32 + sr)); st_k0 = load8(ROW(Kp, k0, sr)); st_k1 = load8(ROW(Kp, k0, 32 + sr)); } while (0)
#define HS_SWRITE(slot) do { *(LAS bf16x8*)(lds + (slot) * SHM_K + kws) = st_k0; *(LAS bf16x8*)(lds + (slot) * SHM_K + kws + 32 * 256) = st_k1; \
                             *(LAS bf16x8*)(lds + RING_V + (slot) * SHM_V + vst0) = st_v0; *(LAS bf16x8*)(lds + RING_V + (slot) * SHM_V + vst1) = st_v1; } while (0)
__device__ __forceinline__ void head_dilated(const bf16_t* Q, bf16_t* O, const bf16_t* K, const bf16_t* V, float* LSE, int segmask, LAS char* lds, LAS float* scr, int wave_s) {
    const int tid = opaque_tid(wave_s), wid = __builtin_amdgcn_readfirstlane(tid >> 6), lane = tid & 63, r32 = lane & 31, hi = lane >> 5, pair = wid >> 1;
    const int sr = tid >> 4, sc = (tid & 15) * 8, vst0 = v_st(sr, sc), vst1 = v_st(32 + sr, sc), kws = KSWZ(sr, sc * 2);
    LAS float* li_l = scr + wid * 64; LAS float* al_l = li_l + 32;
    constexpr int NT = 2048 / KVBLK, W = 129;
    bf16x8 st_v0, st_v1, st_k0, st_k1; bf16x8 qr[8]; WaveState st; wave_reset(st);
    HS_SLOAD(K, V, 0); HS_LOADQ(qr, Q); VMW(); HS_SWRITE(0); SBAR();
    HS_SLOAD(K, V, KVBLK); VMW(); HS_SWRITE(1);
    __syncthreads();
    for (int g = 1; g <= NT; ++g) {
        const bool ld = g + 1 < NT;
        if (ld) { HS_SLOAD(K, V, (g + 1) * KVBLK); SBAR(); }
        const int ph = (g - 1) & 3, qb = (g - 1) >> 2;
        if (ph != 3) {
            const int T = g - 3 + pair, qlo = qb * QB + wid * QBLK, segb = qlo & ~segmask;
            const int lowk_w = imax(qlo - W + 1, segb), lowk_last = imax(qlo + QBLK - W, segb), kb_ = T * KVBLK;
            if (T >= 0 && kb_ <= qlo + QBLK - 1 && kb_ + KVBLK - 1 >= lowk_w) {
                const int wrow = ((qlo + r32) & segmask) + 1;
                tile_step(st, qr, lds, T & 3, r32, hi, lane, al_l, (kb_ + KVBLK - 1 > qlo) || (kb_ < lowk_last), qlo + r32 - 4 * hi - kb_, (unsigned)(wrow < W ? wrow : W));
            }
            if (ph == 2 && qb + 1 < 2048 / QB) { SBAR(); HS_LOADQ(qr, Q + (size_t)(qb + 1) * QB * DH); }
        } else {
            wave_store(st, O + (size_t)(qb * QB + wid * QBLK) * DH, DH, LSE + qb * QB + wid * QBLK, r32, hi, li_l);
            wave_reset(st);
        }
        __syncthreads();
        if (ld) { HS_SWRITE((g + 1) & 3); }
        __syncthreads();
    }
}
__device__ __forceinline__ void head_mem(const bf16_t* Q, const bf16_t* K, const bf16_t* V, bf16_t* O, int ostride, LAS char* lds, LAS float* scr, int wave_s) {
    const int tid = opaque_tid(wave_s), wid = __builtin_amdgcn_readfirstlane(tid >> 6), lane = tid & 63, r32 = lane & 31, hi = lane >> 5, pair = wid >> 1;
    const int sr = tid >> 4, sc = (tid & 15) * 8, vst0 = v_st(sr, sc), vst1 = v_st(32 + sr, sc), kws = KSWZ(sr, sc * 2);
    LAS float* li_l = scr + wid * 64; LAS float* al_l = li_l + 32;
    bf16x8 st_v0, st_v1, st_k0, st_k1; bf16x8 qr[8]; WaveState st;
#pragma unroll
    for (int t = 0; t < 4; ++t) { HS_SLOAD(K, V, t * KVBLK); VMW(); HS_SWRITE(t); SBAR(); }
    __syncthreads();
    for (int qb = 0; qb < 2048 / QB; ++qb) {
        HS_LOADQ(qr, Q + (size_t)qb * QB * DH); wave_reset(st);
        for (int t = 0; t < 4; ++t) tile_step(st, qr, lds, (t + pair) & 3, r32, hi, lane, al_l, false, 0, 0u);
        wave_store(st, O + (size_t)(qb * QB + wid * QBLK) * ostride, ostride, nullptr, r32, hi, li_l);
    }
    __syncthreads();
}
#undef HS_LOADQ
#undef HS_SLOAD
#undef HS_SWRITE
#undef ROW
#undef VMW
#undef VMWN
#undef SLOAD_H
#undef SWRITE_HK
#undef SWRITE_HV
#undef SWRITE_H
#undef KSWZ
#undef SBAR
}

#define XB_TMO      128
#define XB_XCNT(j)  (256  + 64 * (j))
#define XB_XSUB(j)  (1280 + 64 * (j))
#define XB_XGEN(j)  (2304 + 64 * (j))
#define XB_TOP      3328
#define XB_TOPGEN   3392
#define XCD_BAR_WORDS 3456
#define XB_SPIN_CAP (1u << 18)
__device__ __forceinline__ unsigned xb_ld(unsigned* p)              { return __hip_atomic_load(p, __ATOMIC_RELAXED, __HIP_MEMORY_SCOPE_AGENT); }
__device__ __forceinline__ unsigned xb_add(unsigned* p, unsigned v) { return __hip_atomic_fetch_add(p, v, __ATOMIC_RELAXED, __HIP_MEMORY_SCOPE_AGENT); }
__device__ __forceinline__ unsigned xb_xcc_id() { return (unsigned)__builtin_amdgcn_s_getreg((3 << 11) | 20) & 0xFu; }
#define XB_SPIN(cond, bar) do { unsigned _sp = 0; while (cond) { __builtin_amdgcn_s_sleep(1); \
    if ((++_sp & 255u) == 0u) { if (xb_ld(&(bar)[XB_TMO])) break; if (_sp > XB_SPIN_CAP) { atomicAdd(&(bar)[XB_TMO], 1u); break; } } } } while (0)
struct XcdBarrier { unsigned* bar; unsigned x; volatile LAS unsigned* st; };
__device__ __forceinline__ XcdBarrier xcd_barrier_post(unsigned* bar, volatile LAS unsigned* st) {
    XcdBarrier b; b.bar = bar; b.x = xb_xcc_id(); b.st = st;
    if (threadIdx.x == 0) (void)xb_add(&bar[XB_XCNT(b.x)], 1u);
    return b;
}
__device__ __forceinline__ void xcd_barrier_complete(unsigned* bar, unsigned x, unsigned& nloc, unsigned& nx) {
    const unsigned G = gridDim.x * gridDim.y * gridDim.z;
    unsigned sum, cnt, mine, sp = 0u;
    for (;;) {
        sum = 0u; cnt = 0u; mine = 0u;
#pragma unroll
        for (unsigned j = 0; j < 16; ++j) { const unsigned c = xb_ld(&bar[XB_XCNT(j)]); sum += c; cnt += (c > 0u) ? 1u : 0u; mine = (j == x) ? c : mine; }
        if (sum == G) break;
        __builtin_amdgcn_s_sleep(1);
        if ((++sp & 255u) == 0u) { if (xb_ld(&bar[XB_TMO])) break; if (sp > XB_SPIN_CAP) { atomicAdd(&bar[XB_TMO], 1u); break; } }
    }
    nloc = mine > 0u ? mine : 1u; nx = cnt > 0u ? cnt : 1u;
}
__device__ __forceinline__ void xcd_barrier(const XcdBarrier& b) {
    asm volatile("s_waitcnt vmcnt(0)" ::: "memory");
    __syncthreads();
    if (threadIdx.x == 0) {
        unsigned* bar = b.bar; asm volatile("" : "+s"(bar)); bar = (unsigned*)(GAS unsigned*)bar;
        __builtin_amdgcn_s_waitcnt(0);
        unsigned nloc = b.st[0], nx = b.st[1];
        if (nloc == 0u) { xcd_barrier_complete(bar, b.x, nloc, nx); b.st[0] = nloc; b.st[1] = nx; }
        const unsigned old = xb_add(&bar[XB_XSUB(b.x)], 1u);
        const unsigned gen = old / nloc;
        if (old + 1u == (gen + 1u) * nloc) {
            __builtin_amdgcn_fence(__ATOMIC_RELEASE, "agent");
            asm volatile("s_waitcnt vmcnt(0)" ::: "memory");
            const unsigned og = xb_add(&bar[XB_TOP], 1u);
            const unsigned tg = og / nx;
            if (og + 1u == (tg + 1u) * nx) xb_add(&bar[XB_TOPGEN], 1u);
            else XB_SPIN(xb_ld(&bar[XB_TOPGEN]) == tg, bar);
            __builtin_amdgcn_fence(__ATOMIC_ACQUIRE, "agent");
            xb_add(&bar[XB_XGEN(b.x)], 1u);
            asm volatile("s_waitcnt vmcnt(0)" ::: "memory");
        } else {
            XB_SPIN(xb_ld(&bar[XB_XGEN(b.x)]) == gen, bar);
            __builtin_amdgcn_fence(__ATOMIC_ACQUIRE, "agent");
            asm volatile("s_waitcnt vmcnt(0)" ::: "memory");
        }
    }
    __syncthreads();
}
constexpr int CW_BAR = 4096, CW_CONVQ = 96;

#define ACC8(ai, bj, m) {acc[ai][bj][m][0][0], acc[ai][bj][m][0][1], acc[ai][bj][m][0][2], acc[ai][bj][m][0][3], acc[ai][bj][m][1][0], acc[ai][bj][m][1][1], acc[ai][bj][m][1][2], acc[ai][bj][m][1][3]}
struct FastEpiMain {
    static constexpr bool PERM = true; EpiMain mn; EpiKV kv; float ascale;
    __device__ __forceinline__ bool keep_acc(const pg8::Unit&) const { return false; }
    __device__ __forceinline__ void operator()(f32x4 (&acc)[2][2][4][2], const pg8::Unit& u, int wr, int wc, int fr, int fq) const {
        asm volatile("" : "+v"(fr), "+v"(fq));
        const int rowb = u.row0 + wr * 64 + fr, colb = u.col0 + wc * 32 + 8 * fq;
        if (u.aux != 0) {
#pragma unroll
            for (int ai = 0; ai < 2; ++ai)
#pragma unroll
                for (int m = 0; m < 4; ++m)
#pragma unroll
                    for (int bj = 0; bj < 2; ++bj) { float v[8] = ACC8(ai, bj, m); kv(rowb + ai * 128 + m * 16, colb + bj * 128, v); }
            return;
        }
        f32x4 bb[2][2];
#pragma unroll
        for (int bj = 0; bj < 2; ++bj) { bb[bj][0] = *(const f32x4*)(mn.biasp + colb + bj * 128); bb[bj][1] = *(const f32x4*)(mn.biasp + colb + bj * 128 + 4); }
        float fpos[2][4];
#pragma unroll
        for (int ai = 0; ai < 2; ++ai)
#pragma unroll
            for (int m = 0; m < 4; ++m) fpos[ai][m] = 0.f;
        if (u.col0 < C_V) {
#pragma unroll
            for (int ai = 0; ai < 2; ++ai)
#pragma unroll
                for (int m = 0; m < 4; ++m) fpos[ai][m] = (float)mn.pos[mn.tok0 + rowb + ai * 128 + m * 16];
        }
        float invrev[4]; EpiMain::rope_freqs(colb, invrev);
#pragma unroll
        for (int ai = 0; ai < 2; ++ai)
#pragma unroll
            for (int m = 0; m < 4; ++m)
#pragma unroll
                for (int bj = 0; bj < 2; ++bj) { float v[8] = ACC8(ai, bj, m);
#pragma unroll
                    for (int q = 0; q < 8; ++q) v[q] *= ascale;
                    v[0] += bb[bj][0].x; v[1] += bb[bj][0].y; v[2] += bb[bj][0].z; v[3] += bb[bj][0].w; v[4] += bb[bj][1].x; v[5] += bb[bj][1].y; v[6] += bb[bj][1].z; v[7] += bb[bj][1].w;
                    mn.finish(rowb + ai * 128 + m * 16, colb + bj * 128, v, fpos[ai][m], invrev); }
    }
};
struct FastEpiGates {
    static constexpr bool PERM = true; const float* biasp; bf16_t* GATES; float ascale;
    __device__ __forceinline__ bool keep_acc(const pg8::Unit&) const { return false; }
    __device__ __forceinline__ void operator()(f32x4 (&acc)[2][2][4][2], const pg8::Unit& u, int wr, int wc, int fr, int fq) const {
        asm volatile("" : "+v"(fr), "+v"(fq));
        const int rowb = u.row0 + wr * 64 + fr, colb = u.col0 + wc * 32 + 8 * fq;
        f32x4 bb[2][2];
#pragma unroll
        for (int bj = 0; bj < 2; ++bj) { bb[bj][0] = *(const f32x4*)(biasp + colb + bj * 128); bb[bj][1] = *(const f32x4*)(biasp + colb + bj * 128 + 4); }
#pragma unroll
        for (int ai = 0; ai < 2; ++ai)
#pragma unroll
            for (int m = 0; m < 4; ++m)
#pragma unroll
                for (int bj = 0; bj < 2; ++bj) { const f32x4 a = acc[ai][bj][m][0] * ascale + bb[bj][0], b = acc[ai][bj][m][1] * ascale + bb[bj][1];
                    u32x4 o; o.x = pk2(sigmoidf_(a.x), sigmoidf_(a.y)); o.y = pk2(sigmoidf_(a.z), sigmoidf_(a.w)); o.z = pk2(sigmoidf_(b.x), sigmoidf_(b.y)); o.w = pk2(sigmoidf_(b.z), sigmoidf_(b.w));
                    *(u32x4*)(GATES + (size_t)(rowb + ai * 128 + m * 16) * 3072 + (colb + bj * 128 - C_GATE)) = o; }
    }
};
struct FastEpiMerge {
    static constexpr bool PERM = true; const bf16_t* GATES; bf16_t* MERGED;
    __device__ __forceinline__ bool keep_acc(const pg8::Unit& u) const { return u.aux < 2; }
    __device__ __forceinline__ void operator()(f32x4 (&acc)[2][2][4][2], const pg8::Unit& u, int wr, int wc, int fr, int fq) const {
        asm volatile("" : "+v"(fr), "+v"(fq));
        const int rowb = u.row0 + wr * 64 + fr, colb = u.col0 + wc * 32 + 8 * fq, br = u.aux;
        const unsigned char* gp = (const unsigned char*)GATES + (size_t)rowb * 3072 + br * 1024 + colb;
        bf16_t* mp = MERGED + (size_t)rowb * 1024 + colb;
#pragma unroll
        for (int ai = 0; ai < 2; ++ai) {
            u32x2 tg[4][2], tn[4][2];
#pragma unroll
            for (int m = 0; m < 4; ++m)
#pragma unroll
                for (int bj = 0; bj < 2; ++bj) { tg[m][bj] = *(const u32x2*)(gp + (size_t)(ai * 128 + m * 16) * 3072 + bj * 128);
                    if (br < 2) tn[m][bj] = *(const u32x2*)(gp + 1024 + (size_t)(ai * 128 + m * 16) * 3072 + bj * 128); }
            if (br < 2) {
#pragma unroll
                for (int m = 0; m < 4; ++m)
#pragma unroll
                    for (int bj = 0; bj < 2; ++bj) { const u32x2 g = tg[m][bj], n = tn[m][bj]; const f32x4 n0 = u8x4_raw(n.x), n1 = u8x4_raw(n.y);
                        const f32x4 r0 = {__builtin_amdgcn_rcpf(n0.x), __builtin_amdgcn_rcpf(n0.y), __builtin_amdgcn_rcpf(n0.z), __builtin_amdgcn_rcpf(n0.w)}, r1 = {__builtin_amdgcn_rcpf(n1.x), __builtin_amdgcn_rcpf(n1.y), __builtin_amdgcn_rcpf(n1.z), __builtin_amdgcn_rcpf(n1.w)};
                        acc[ai][bj][m][0] = acc[ai][bj][m][0] * (u8x4_raw(g.x) * r0); acc[ai][bj][m][1] = acc[ai][bj][m][1] * (u8x4_raw(g.y) * r1); }
            } else {
#pragma unroll
                for (int m = 0; m < 4; ++m)
#pragma unroll
                    for (int bj = 0; bj < 2; ++bj) { const u32x2 g = tg[m][bj]; const f32x4 a = acc[ai][bj][m][0] * u8x4_to_f32(g.x), b = acc[ai][bj][m][1] * u8x4_to_f32(g.y);
                        u32x4 o; o.x = pk2(a.x, a.y); o.y = pk2(a.z, a.w); o.z = pk2(b.x, b.y); o.w = pk2(b.z, b.w);
                        *(u32x4*)(mp + (size_t)(ai * 128 + m * 16) * 1024 + bj * 128) = o; }
            }
            asm volatile("" ::: "memory");
        }
    }
};
struct FastEpiStore {
    static constexpr bool PERM = true; bf16_t* O; int ld; float scale;
    __device__ __forceinline__ bool keep_acc(const pg8::Unit&) const { return false; }
    __device__ __forceinline__ void operator()(f32x4 (&acc)[2][2][4][2], const pg8::Unit& u, int wr, int wc, int fr, int fq) const {
        asm volatile("" : "+v"(fr), "+v"(fq));
        const int rowb = u.row0 + wr * 64 + fr, colb = u.col0 + wc * 32 + 8 * fq;
#pragma unroll
        for (int ai = 0; ai < 2; ++ai)
#pragma unroll
            for (int m = 0; m < 4; ++m)
#pragma unroll
                for (int bj = 0; bj < 2; ++bj) { const f32x4 a = acc[ai][bj][m][0] * scale, b = acc[ai][bj][m][1] * scale;
                    u32x4 o; o.x = pk2(a.x, a.y); o.y = pk2(a.z, a.w); o.z = pk2(b.x, b.y); o.w = pk2(b.z, b.w);
                    *(u32x4*)(O + (size_t)(rowb + ai * 128 + m * 16) * ld + colb + bj * 128) = o; }
    }
};
struct FastEpiMoe1 {
    static constexpr bool PERM = true; LAS const int* toktab; const float* wts; unsigned char* H8;
    __device__ __forceinline__ bool keep_acc(const pg8::Unit&) const { return false; }
    __device__ __forceinline__ void operator()(f32x4 (&acc)[2][2][4][2], const pg8::Unit& u, int wr, int wc, int fr, int fq) const {
        asm volatile("" : "+v"(fr), "+v"(fq));
        const int rloc = wr * 64 + fr, colb = u.col0 + wc * 32 + 8 * fq, hi = u.col0 >> 10;
        float w[2][4];
#pragma unroll
        for (int ai = 0; ai < 2; ++ai)
#pragma unroll
            for (int m = 0; m < 4; ++m) { const int tok = toktab[u.aux * 256 + rloc + ai * 128 + m * 16]; w[ai][m] = wts[(size_t)tok * 2 + hi] * (H8_SCALE / W8_SCALE); }
        constexpr float inv = 1.0f / W8_SCALE;
#pragma unroll
        for (int ai = 0; ai < 2; ++ai)
#pragma unroll
            for (int m = 0; m < 4; ++m)
#pragma unroll
                for (int bj = 0; bj < 2; ++bj) { const f32x4 gt = acc[ai][bj][m][0] * inv, up = acc[ai][bj][m][1]; const float ww = w[ai][m];
                    const int j0 = hi * 512 + (((colb + bj * 128) & 1023) >> 1);
                    float h[4] = {gt.x * sigmoidf_(gt.x) * up.x * ww, gt.y * sigmoidf_(gt.y) * up.y * ww, gt.z * sigmoidf_(gt.z) * up.z * ww, gt.w * sigmoidf_(gt.w) * up.w * ww};
#pragma unroll
                    for (int q = 0; q < 4; ++q) h[q] = fminf(fmaxf(h[q], -448.f), 448.f);
                    *(unsigned*)(H8 + (size_t)(u.row0 + rloc + ai * 128 + m * 16) * 1024 + j0) = pk4_fp8(h[0], h[1], h[2], h[3]); }
    }
};
#undef ACC8

struct SchedMain {
    pg8::TileOrder to; int nkv, tile0, cut, skip; size_t astep, bstep; const char *XB, *WIN, *MEMB, *WKV;
    __device__ __forceinline__ bool next(int i, pg8::Unit& u) const {
        int pm, pn;
        if (to.tile(i, pm, pn)) { const int ct = tile0 + (pn < cut ? pn : pn + skip); u.A = XB + (size_t)pm * astep; u.B = WIN + (size_t)ct * bstep; u.row0 = pm * 256; u.col0 = ct * 256; u.bjump = 0; u.aux = 0; return true; }
        const long L = (long)i * to.G + to.c - to.nwg; if (L >= nkv) return false;
        pm = (int)(L >> 2); pn = (int)(L & 3);
        u.A = MEMB + (size_t)pm * 256 * 2048; u.B = WKV + (size_t)pn * 256 * 2048; u.row0 = pm * 256; u.col0 = pn * 256; u.bjump = 0; u.aux = 1; return true;
    }
};
struct SchedMerge {
    pg8::TileOrder to; const char *A0, *W;
    __device__ __forceinline__ bool next(int i, pg8::Unit& u) const {
        const int ti = i / 3, br = i - ti * 3; int pm, pn; if (!to.tile(ti, pm, pn)) return false;
        u.A = A0 + (size_t)br * SZ_512 + (size_t)pm * 256 * 1024; u.B = W + (size_t)br * MiB + (size_t)pn * 256 * 1024; u.row0 = pm * 256; u.col0 = pn * 256; u.bjump = 0; u.aux = br; return true;
    }
};
struct SchedPlain {
    pg8::TileOrder to; const char *A, *B; size_t astep, bstep;
    __device__ __forceinline__ bool next(int i, pg8::Unit& u) const {
        int pm, pn; if (!to.tile(i, pm, pn)) return false;
        u.A = A + (size_t)pm * astep; u.B = B + (size_t)pn * bstep; u.row0 = pm * 256; u.col0 = pn * 256; u.bjump = 0; u.aux = 0; return true;
    }
};
struct SchedMoe {
    pg8::TileOrder to; LAS const int* pan_cls; LAS const int* toktab; const char *H, *W1, *W2; int mode;
    __device__ __forceinline__ LAS const int* toks(int i) const { return toktab + i * 256; }
    __device__ __forceinline__ bool next(int i, pg8::Unit& u) const {
        int pm, pn; if (!to.tile(i, pm, pn)) return false;
        const int cls = pan_cls[pm]; int e_lo, e_hi; class_experts(cls, e_lo, e_hi);
        u.row0 = pm * 256; u.col0 = pn * 256; u.aux = i; u.bjump = 0;
        if (mode == 1) { u.A = nullptr; u.B = W1 + ((size_t)(pn < 4 ? e_lo : e_hi) * 1024 + (size_t)(pn & 3) * 256) * 1024; }
        else { u.A = H + (size_t)pm * 256 * 1024; u.B = W2 + (size_t)pn * 256 * 8192 + (size_t)e_lo * 512; u.bjump = (e_hi - e_lo - 1) * 512; }
        return true;
    }
};

template <int WHICH> __device__ __forceinline__ float tw_src(const Params& p, int k, int n) {
    if constexpr (WHICH == TW_IN) return p.w_in[(size_t)k * INC + win_logical(n)];
    else if constexpr (WHICH == TW_KV) return p.w_mem_kv[(size_t)k * 1024 + n];
    else if constexpr (WHICH == TW_A) return p.w_attn_o[(size_t)k * 1024 + n];
    else if constexpr (WHICH == TW_C) return p.w_conv_o[(size_t)k * 1024 + n];
    else if constexpr (WHICH == TW_M) return p.w_mem_o[(size_t)k * 1024 + n];
    else if constexpr (WHICH == TW_OUT) return p.w_out[(size_t)k * 1024 + n];
    else if constexpr (WHICH == TW_W1) { const int e = n >> 10, c = n & 1023, G = c >> 3, nn = (c >> 2) & 1, ee = c & 3, jj = 4 * G + ee; return (nn ? p.w_eu : p.w_eg)[((size_t)e * 1024 + k) * 512 + jj]; }
    else { const int e = n >> 10, c = n & 1023; return p.w_ed[((size_t)e * 512 + k) * 1024 + c]; }
}
template <int WHICH> __device__ __forceinline__ void tw_item(const Params& p, int item, float* scr, int lane) {
    constexpr int N = WHICH == TW_IN ? INC : (WHICH >= TW_W1 ? 16 * 1024 : 1024);
    constexpr int ldd = (WHICH == TW_A || WHICH == TW_C || WHICH == TW_M) ? 512 : (WHICH == TW_W2 ? 8192 : 1024);
    constexpr size_t dsto = WHICH == TW_IN ? WS_WIN : WHICH == TW_KV ? WS_WKV : WHICH == TW_A ? WS_WA : WHICH == TW_C ? WS_WC : WHICH == TW_M ? WS_WM : WHICH == TW_OUT ? WS_WOUT : WHICH == TW_W1 ? WS_W1 : WS_W2;
    bf16_t* dst = WSP(bf16_t, dsto);
    constexpr int nblk = N / 32; const int kb = item / nblk, nb = item - kb * nblk, k0 = 64 * kb, n0 = 32 * nb;
#pragma unroll 8
    for (int i = 0; i < 32; ++i) { const int kk = 2 * i + (lane >> 5); scr[kk * 33 + (lane & 31)] = tw_src<WHICH>(p, k0 + kk, n0 + (lane & 31)); }
    asm volatile("s_waitcnt lgkmcnt(0)" ::: "memory");
    const int c = lane & 7;
#pragma unroll
    for (int j = 0; j < 4; ++j) { const int n = (lane >> 3) + 8 * j; const float* sp = scr + (8 * c) * 33 + n;
        const int nn = n0 + n; size_t doff;
        if constexpr (WHICH == TW_W2) doff = (size_t)(nn & 1023) * 8192 + (size_t)(nn >> 10) * 512 + k0 + 8 * c; else doff = (size_t)nn * ldd + k0 + 8 * c;
        if constexpr (WHICH >= TW_W1) {
            u32x2 o; o.x = pk4_fp8(W8_SCALE * sp[0 * 33], W8_SCALE * sp[1 * 33], W8_SCALE * sp[2 * 33], W8_SCALE * sp[3 * 33]); o.y = pk4_fp8(W8_SCALE * sp[4 * 33], W8_SCALE * sp[5 * 33], W8_SCALE * sp[6 * 33], W8_SCALE * sp[7 * 33]);
            *(u32x2*)((unsigned char*)dst + doff) = o;
        } else {
            u32x4 o; o.x = pk2(sp[0 * 33], sp[1 * 33]); o.y = pk2(sp[2 * 33], sp[3 * 33]); o.z = pk2(sp[4 * 33], sp[5 * 33]); o.w = pk2(sp[6 * 33], sp[7 * 33]);
            *(u32x4*)(dst + doff) = o;
            if constexpr (WHICH == TW_IN) {
                u32x2 q; q.x = pk4_fp8(WG8_SCALE * sp[0 * 33], WG8_SCALE * sp[1 * 33], WG8_SCALE * sp[2 * 33], WG8_SCALE * sp[3 * 33]); q.y = pk4_fp8(WG8_SCALE * sp[4 * 33], WG8_SCALE * sp[5 * 33], WG8_SCALE * sp[6 * 33], WG8_SCALE * sp[7 * 33]);
                *(u32x2*)(p.ws + WS_WG8 + doff) = q; } } }
    asm volatile("s_waitcnt lgkmcnt(0)" ::: "memory");
}
__device__ __forceinline__ void transpose_all(const Params& p, float* scr, int gw, int ngw, int lane) {
    constexpr int I_IN = 16 * (INC / 32), I_KV = 16 * 32, I_B = 8 * 32, I_OUT = 16 * 32, I_W1 = 16 * 512, I_W2 = 8 * 512;
    constexpr int NITEMS = I_IN + I_KV + 3 * I_B + I_OUT + I_W1 + I_W2;
    for (int it = gw; it < NITEMS; it += ngw) {
        int r = it;
        if (r < I_W1) { tw_item<TW_W1>(p, r, scr, lane); continue; } r -= I_W1;
        if (r < I_IN) { tw_item<TW_IN>(p, r, scr, lane); continue; } r -= I_IN;
        if (r < I_W2) { tw_item<TW_W2>(p, r, scr, lane); continue; } r -= I_W2;
        if (r < I_KV) { tw_item<TW_KV>(p, r, scr, lane); continue; } r -= I_KV;
        if (r < I_OUT) { tw_item<TW_OUT>(p, r, scr, lane); continue; } r -= I_OUT;
        if (r < I_B) { tw_item<TW_A>(p, r, scr, lane); continue; } r -= I_B;
        if (r < I_B) { tw_item<TW_C>(p, r, scr, lane); continue; } r -= I_B;
        tw_item<TW_M>(p, r, scr, lane);
    }
}

__device__ __forceinline__ void cvt_bf16_dev(const float* __restrict__ src, bf16_t* __restrict__ dst, size_t n8, size_t gtid, size_t gstride) {
    for (size_t i = gtid; i < n8; i += gstride) {
        const f32x4 a = *(const f32x4*)(src + i * 8), b = *(const f32x4*)(src + i * 8 + 4);
        u32x4 o; o.x = pk2(a.x, a.y); o.y = pk2(a.z, a.w); o.z = pk2(b.x, b.y); o.w = pk2(b.z, b.w);
        *(u32x4*)(dst + i * 8) = o;
    }
}

__device__ __forceinline__ void cvt_x_dev(const float* __restrict__ src, bf16_t* __restrict__ dst, unsigned char* __restrict__ dst8, size_t n16, size_t gtid, size_t gstride) {
    for (size_t i = gtid; i < n16; i += 2 * gstride) {
        const size_t i2 = i + gstride; const bool has2 = i2 < n16; const size_t j2 = has2 ? i2 : i;
        f32x4 a[2][4];
#pragma unroll
        for (int q = 0; q < 4; ++q) { a[0][q] = *(const f32x4*)(src + i * 16 + 4 * q); a[1][q] = *(const f32x4*)(src + j2 * 16 + 4 * q); }
#pragma unroll
        for (int r = 0; r < 2; ++r) { if (r == 1 && !has2) break; const size_t ii = r ? i2 : i;
            u32x4 o0, o1; o0.x = pk2(a[r][0].x, a[r][0].y); o0.y = pk2(a[r][0].z, a[r][0].w); o0.z = pk2(a[r][1].x, a[r][1].y); o0.w = pk2(a[r][1].z, a[r][1].w);
            o1.x = pk2(a[r][2].x, a[r][2].y); o1.y = pk2(a[r][2].z, a[r][2].w); o1.z = pk2(a[r][3].x, a[r][3].y); o1.w = pk2(a[r][3].z, a[r][3].w);
            *(u32x4*)(dst + ii * 16) = o0; *(u32x4*)(dst + ii * 16 + 8) = o1;
            u32x4 q8; q8.x = pk4_fp8(a[r][0].x, a[r][0].y, a[r][0].z, a[r][0].w); q8.y = pk4_fp8(a[r][1].x, a[r][1].y, a[r][1].z, a[r][1].w); q8.z = pk4_fp8(a[r][2].x, a[r][2].y, a[r][2].z, a[r][2].w); q8.w = pk4_fp8(a[r][3].x, a[r][3].y, a[r][3].z, a[r][3].w);
            *(u32x4*)(dst8 + ii * 16) = q8; }
    }
}
__device__ __forceinline__ void wg8_dev(const Params& p, size_t gtid, size_t gstride) {
    for (size_t i = gtid; i < (size_t)INC * 64; i += gstride) { const int n = (int)(i % INC), k0 = (int)(i / INC) * 16, nl = win_logical(n); float v[16];
#pragma unroll
        for (int j = 0; j < 16; ++j) v[j] = WG8_SCALE * p.w_in[(size_t)(k0 + j) * INC + nl];
        u32x4 q; q.x = pk4_fp8(v[0], v[1], v[2], v[3]); q.y = pk4_fp8(v[4], v[5], v[6], v[7]); q.z = pk4_fp8(v[8], v[9], v[10], v[11]); q.w = pk4_fp8(v[12], v[13], v[14], v[15]);
        *(u32x4*)(p.ws + WS_WG8 + (size_t)n * 1024 + k0) = q; }
}

struct Args { Params p; int ph_lo, ph_hi; };
typedef const __attribute__((address_space(4))) unsigned long long* KArgPtr;
__device__ __forceinline__ Params load_params(KArgPtr q) {
    asm volatile("" : "+s"(q));
    Params p;
    p.x = (const float*)(const GAS float*)q[0]; p.mem = (const float*)(const GAS float*)q[1]; p.pos = (const int*)(const GAS int*)q[2]; p.w_in = (const float*)(const GAS float*)q[3]; p.b_in = (const float*)(const GAS float*)q[4]; p.conv_w = (const float*)(const GAS float*)q[5]; p.conv_b = (const float*)(const GAS float*)q[6];
    p.conv_g = (const float*)(const GAS float*)q[7]; p.conv_bb = (const float*)(const GAS float*)q[8]; p.w_mem_kv = (const float*)(const GAS float*)q[9]; p.w_attn_o = (const float*)(const GAS float*)q[10]; p.w_conv_o = (const float*)(const GAS float*)q[11]; p.w_mem_o = (const float*)(const GAS float*)q[12];
    p.w_out = (const float*)(const GAS float*)q[13]; p.ln1_g = (const float*)(const GAS float*)q[14]; p.ln1_b = (const float*)(const GAS float*)q[15]; p.w_gr = (const float*)(const GAS float*)q[16]; p.b_gr = (const float*)(const GAS float*)q[17]; p.w_er = (const float*)(const GAS float*)q[18]; p.b_er = (const float*)(const GAS float*)q[19];
    p.w_eg = (const float*)(const GAS float*)q[20]; p.w_eu = (const float*)(const GAS float*)q[21]; p.w_ed = (const float*)(const GAS float*)q[22]; p.ln2_g = (const float*)(const GAS float*)q[23]; p.ln2_b = (const float*)(const GAS float*)q[24]; p.out = (float*)(GAS float*)q[25]; p.ws = (unsigned char*)(GAS unsigned char*)q[26];
    return p;
}
static_assert(sizeof(Params) == 27 * 8, "Params is 27 pointers");
constexpr int PH_P0 = 0, PH_CH0 = 1, PH_PER_CH = 5, PH_LN1 = PH_CH0 + PH_PER_CH * NCH, PH_MOE1 = PH_LN1 + 1, PH_MOE2 = PH_LN1 + 2, PH_LN2 = PH_LN1 + 3, PH_END = PH_LN1 + 4;

__global__ void __launch_bounds__(NTHR, 2) mk_fwd(Args args) {
    extern __shared__ __attribute__((aligned(16))) unsigned char lds_raw[];
    LAS unsigned char* lds = (LAS unsigned char*)lds_raw;
    const KArgPtr kargs = (KArgPtr)__builtin_amdgcn_kernarg_segment_ptr();
    const int wave = __builtin_amdgcn_readfirstlane((int)threadIdx.x >> 6);
    const int G = gridDim.x; const int bx = blockIdx.x; const int vcu = (G % 8 == 0) ? (bx % 8) * (G / 8) + bx / 8 : bx;
    volatile LAS unsigned* MISC = (volatile LAS unsigned*)(lds + LCTL_OFF);
    ClassTab* tab = (ClassTab*)(lds_raw + LCTL_OFF + 256);
    int* pan_cls = (int*)(lds_raw + LCTL_OFF + 512);
    int* toktab = (int*)(lds_raw + LTOK_OFF);
    for (int u = threadIdx.x; u < (LDS_BYTES - LCTL_OFF) / 4; u += NTHR) ((LAS unsigned*)(lds + LCTL_OFF))[u] = 0u;
    __syncthreads();
    const int lo = args.ph_lo, hi = args.ph_hi;
    unsigned* ctl; { const Params p = load_params(kargs); ctl = WSP(unsigned, WS_CTL); }
    XcdBarrier bar; bar.bar = ctl + CW_BAR; bar.x = 0; bar.st = nullptr;
    if (hi - lo > 1) bar = xcd_barrier_post(ctl + CW_BAR, MISC);
#ifndef PHMASK
#define PHMASK 0x3ff
#endif
#ifndef P1_QK_FP8
#define P1_QK_FP8 3
#endif
#if P1_QK_FP8 == 3
constexpr int P1_BF16_TILES = 4, P1_BF16_T0 = 18, P1_BF16_CUT = 4, P1_BF16_SKIP = 0, P1_FP8_TILES = 32, P1_FP8_T0 = 0, P1_FP8_CUT = 18, P1_FP8_SKIP = 4;
#elif P1_QK_FP8 == 2
constexpr int P1_BF16_TILES = 0, P1_BF16_T0 = 0, P1_BF16_CUT = 0, P1_BF16_SKIP = 0, P1_FP8_TILES = 36, P1_FP8_T0 = 0, P1_FP8_CUT = 36, P1_FP8_SKIP = 0;
#elif P1_QK_FP8
constexpr int P1_BF16_TILES = 6, P1_BF16_T0 = 18, P1_BF16_CUT = 6, P1_BF16_SKIP = 0, P1_FP8_TILES = 30, P1_FP8_T0 = 0, P1_FP8_CUT = 18, P1_FP8_SKIP = 6;
#else
constexpr int P1_BF16_TILES = 18, P1_BF16_T0 = 0, P1_BF16_CUT = 12, P1_BF16_SKIP = 6, P1_FP8_TILES = 18, P1_FP8_T0 = 12, P1_FP8_CUT = 6, P1_FP8_SKIP = 6;
#endif
#ifndef ATTN_V2
#define ATTN_V2 1
#endif
#ifndef PROBE_DUP
#define PROBE_DUP (-1)
#endif
#define NREP(b) ((PROBE_DUP == (b)) ? 2 : 1)
#define IN(k) (lo <= (k) && (k) < hi)
#define HAS(b) ((PHMASK >> (b)) & 1)
#define SEAM(k) do { if (IN(k) && IN((k) + 1)) xcd_barrier(bar); } while (0)

    if (HAS(0) && IN(PH_P0)) {
        const Params p = load_params(kargs);
        const size_t gtid = (size_t)bx * NTHR + opaque_tid(wave), gstride = (size_t)G * NTHR;
        for (int rep = 0; rep < NREP(0); ++rep) {
        { const int ptid = opaque_tid(wave); transpose_all(p, (float*)(lds_raw + RING_OFF) + (ptid >> 6) * (64 * 33), bx * NWAVES + (ptid >> 6), G * NWAVES, ptid & 63); }
        small_prep_dev(p, gtid, gstride);
        cvt_bf16_dev(p.mem, WSP(bf16_t, WS_MEMB), (size_t)NB * MEML * 1024 / 8, gtid, gstride);
        cvt_x_dev(p.x, WSP(bf16_t, WS_XB), p.ws + WS_XB8, (size_t)T * 1024 / 16, gtid, gstride);
        }
    }
    SEAM(PH_P0);
    if (PROBE_DUP == 10 && hi - lo > 1) for (int r = 0; r < 16; ++r) xcd_barrier(bar);

    for (int ch = 0; ch < NCH; ++ch) {
        const int ph0 = PH_CH0 + PH_PER_CH * ch;
        if (HAS(1) && IN(ph0)) {
            const Params p = load_params(kargs);
            const EpiMain em{WSP(float, WS_BIASP), p.pos, WSP(bf16_t, WS_QG), WSP(bf16_t, WS_CGLU), WSP(bf16_t, WS_QM), WSP(bf16_t, WS_GATES), ch * TC};
            for (int rep = 0; rep < NREP(1); ++rep) {
            {
                SchedMain S; S.to.init(TC / 256, P1_BF16_TILES, G, bx); S.nkv = ch == 0 ? (NB * MEML / 256) * 4 : 0; S.tile0 = P1_BF16_T0; S.cut = P1_BF16_CUT; S.skip = P1_BF16_SKIP; S.astep = 256 * 2048; S.bstep = 256 * 2048;
                S.XB = (const char*)(WSP(bf16_t, WS_XB) + (size_t)ch * TC * 1024); S.WIN = (const char*)WSP(bf16_t, WS_WIN); S.MEMB = (const char*)WSP(bf16_t, WS_MEMB); S.WKV = (const char*)WSP(bf16_t, WS_WKV);
                FastEpiMain E{em, EpiKV{WSP(bf16_t, WS_KM)}, 1.0f};
#ifndef NO_P1A
                pg8::gemm_phase<FastEpiMain, SchedMain, true, false, false>(lds + RING_OFF, nullptr, 1024, 1024, 1024, S, E, wave);
#endif
                if (PROBE_DUP == 16) { FastEpiStore E2{WSP(bf16_t, WS_MERGED), 1024, 1.0f}; pg8::gemm_phase<FastEpiStore, SchedMain, true, false, false>(lds + RING_OFF, nullptr, 1024, 1024, 1024, S, E2, wave); }
            }
            {
                SchedMain S; S.to.init(TC / 256, P1_FP8_TILES, G, bx); S.nkv = 0; S.tile0 = P1_FP8_T0; S.cut = P1_FP8_CUT; S.skip = P1_FP8_SKIP; S.astep = 256 * 1024; S.bstep = 256 * 1024;
                S.XB = (const char*)(p.ws + WS_XB8 + (size_t)ch * TC * 1024); S.WIN = (const char*)(p.ws + WS_WG8); S.MEMB = nullptr; S.WKV = nullptr;
                FastEpiMain E{em, EpiKV{WSP(bf16_t, WS_KM)}, 1.0f / WG8_SCALE};
#ifndef NO_P1B
                pg8::gemm_phase<FastEpiMain, SchedMain, true, false, false, true>(lds + RING_OFF, nullptr, 512, 512, 512, S, E, wave);
#endif
                if (PROBE_DUP == 17) { FastEpiStore E2{WSP(bf16_t, WS_MERGED), 1024, 1.0f}; pg8::gemm_phase<FastEpiStore, SchedMain, true, false, false, true>(lds + RING_OFF, nullptr, 512, 512, 512, S, E2, wave); }
            }
            }
        }
        SEAM(ph0);
        if (HAS(2) && IN(ph0 + 1)) {
            const Params p = load_params(kargs);
            constexpr int NDIL = BC * 12 * 8, NMEMB = BC * 4 * 8, NBLK = NDIL + NMEMB;
#if ATTN_V2
            for (int rep = 0; rep < NREP(2); ++rep) {
            const bool dummy = (PROBE_DUP == 2) && rep == 0;
            LAS char* rlds = (LAS char*)(lds + RING_OFF); LAS float* scr = (LAS float*)(lds + LTOK_OFF);
            for (int hd = vcu; hd < BC * 16; hd += G) {
                if (hd < BC * 12) { const int g = (hd % 12) >> 2; const size_t base = (size_t)hd * 2048 * 128;
                    swa::head_dilated(WSP(bf16_t, WS_QG) + base, dummy ? WSP(bf16_t, WS_MERGED) + (size_t)(hd & 127) * 2048 * 128 : WSP(bf16_t, WS_QG) + base, WSP(bf16_t, WS_KG) + base, WSP(bf16_t, WS_VG) + base, WSP(float, WS_LSE) + (size_t)hd * 2048, (2048 >> (2 * g)) - 1, rlds, scr, wave);
                } else { const int bh = hd - BC * 12, bl = bh >> 2, h = bh & 3; const size_t kvb = (size_t)(ch * BC * 4 + bh) * 256 * 128;
                    swa::head_mem(WSP(bf16_t, WS_QM) + (size_t)bh * 2048 * 128, WSP(bf16_t, WS_KM) + kvb, WSP(bf16_t, WS_VM) + kvb, WSP(bf16_t, WS_OMT) + (size_t)bl * 2048 * 512 + h * 128, 512, rlds, scr, wave); }
            }
            __syncthreads();
            }
            {
                const Params pc = load_params(kargs); const int ptid = opaque_tid(wave); volatile LAS unsigned* qslot = MISC + 4;
                for (;;) {
                    if (ptid == 0) *qslot = atomicAdd(ctl + CW_CONVQ + ch, 1u);
                    __syncthreads();
                    const int u = (int)*qslot;
                    if (u >= BC * 64) break;
                    conv_unit(pc, u, lds_raw + RING_OFF, ptid);
                }
            }
        }
#else
            for (int rep = 0; rep < NREP(2); ++rep) {
            const bool dummy = (PROBE_DUP == 2) && rep == 0;
            auto make_ref = [&](int L) -> swa::BlockRef {
                swa::BlockRef r;
                if (L < NDIL) { const int bgh = L >> 3, qb = L & 7, g = (bgh % 12) >> 2; const size_t base = (size_t)bgh * 2048 * 128;
                    r.Q = WSP(bf16_t, WS_QG) + base + (size_t)qb * 256 * 128; r.K = WSP(bf16_t, WS_KG) + base; r.V = WSP(bf16_t, WS_VG) + base; r.O = dummy ? WSP(bf16_t, WS_MERGED) + (base % (SZ_XB / 2 - 65536)) : (bf16_t*)r.Q;
                    r.LSE = WSP(float, WS_LSE) + (size_t)bgh * 2048 + qb * 256; r.P0 = qb * 256; r.W = 129; r.segmask = (2048 >> (2 * g)) - 1; r.skv = 2048; r.ostride = 128; }
                else { const int idx = L - NDIL, bh = idx >> 3, qb = idx & 7, bl = bh >> 2, h = bh & 3; const size_t kvb = (size_t)(ch * BC * 4 + bh) * 256 * 128;
                    r.Q = WSP(bf16_t, WS_QM) + ((size_t)bh * 2048 + qb * 256) * 128; r.K = WSP(bf16_t, WS_KM) + kvb; r.V = WSP(bf16_t, WS_VM) + kvb;
                    r.O = WSP(bf16_t, WS_OMT) + ((size_t)bl * 2048 + qb * 256) * 512 + h * 128; r.LSE = nullptr; r.P0 = 256; r.W = 1 << 20; r.segmask = (1 << 20) - 1; r.skv = 256; r.ostride = 512; }
                return r; };
            int L = vcu;
            if (L < NBLK) {
                swa::BlockRef cur = make_ref(L); swa::Seam Sm;
                swa::prime(cur, (char*)lds_raw + RING_OFF, Sm, wave);
                for (;;) {
                    const bool more = L + G < NBLK; const int Ln = more ? L + G : L;
                    const swa::BlockRef nxt = more ? make_ref(Ln) : cur;
                    swa::block(cur, nxt, (char*)lds_raw + RING_OFF, Sm, wave);
                    if (!more) break;
                    cur = nxt; L = Ln;
                }
            }
            __syncthreads();
            { const Params pc = load_params(kargs); const int ptid = opaque_tid(wave); for (int u = bx; u < BC * 64; u += G) conv_unit(pc, u, lds_raw + RING_OFF, ptid); }
            if (PROBE_DUP == 13) { const int ptid = opaque_tid(wave); for (int u = bx; u < BC * 64; u += G) conv_unit(p, u, lds_raw + RING_OFF, ptid); }
            if (PROBE_DUP == 14) {
                int L = NDIL + vcu;
                if (L < NBLK) { swa::BlockRef cur = make_ref(L); swa::Seam Sm; swa::prime(cur, (char*)lds_raw + RING_OFF, Sm, wave);
                    for (;;) { const bool more = L + G < NBLK; const int Ln = more ? L + G : L; const swa::BlockRef nxt = more ? make_ref(Ln) : cur; swa::block(cur, nxt, (char*)lds_raw + RING_OFF, Sm, wave); if (!more) break; cur = nxt; L = Ln; } }
                __syncthreads();
            }
            }
        }
#endif
        SEAM(ph0 + 1);
        if (HAS(3) && IN(ph0 + 2)) { const Params p = load_params(kargs); const int ptid = opaque_tid(wave); for (int rep = 0; rep < NREP(3); ++rep) for (int w = bx * NWAVES + (ptid >> 6); w < TC; w += G * NWAVES) combine_token(p, w, ptid & 63); }
        SEAM(ph0 + 2);
        if (HAS(4) && IN(ph0 + 3)) {
            const Params p = load_params(kargs);
            SchedMerge S; S.to.init(TC / 256, 4, G, bx); S.A0 = (const char*)WSP(bf16_t, WS_OATT); S.W = (const char*)WSP(bf16_t, WS_WA);
            FastEpiMerge E{WSP(bf16_t, WS_GATES), WSP(bf16_t, WS_MERGED)};
            if (PROBE_DUP == 15) { FastEpiStore E2{WSP(bf16_t, WS_MERGED), 1024, 1.0f}; pg8::gemm_phase<FastEpiStore, SchedMerge, true, false, false>(lds + RING_OFF, nullptr, 512, 512, 512, S, E2, wave); }
            for (int rep = 0; rep < NREP(4); ++rep) pg8::gemm_phase<FastEpiMerge, SchedMerge, true, false, false>(lds + RING_OFF, nullptr, 512, 512, 512, S, E, wave);
        }
        SEAM(ph0 + 3);
        if (HAS(5) && IN(ph0 + 4)) {
            const Params p = load_params(kargs);
            SchedPlain S; S.to.init(TC / 256, 4, G, bx); S.A = (const char*)WSP(bf16_t, WS_MERGED); S.B = (const char*)WSP(bf16_t, WS_WOUT); S.astep = 256 * 2048; S.bstep = 256 * 2048;
            FastEpiStore E{(bf16_t*)p.out + (size_t)ch * TC * 1024, 1024, 1.0f};
            for (int rep = 0; rep < NREP(5); ++rep) pg8::gemm_phase<FastEpiStore, SchedPlain, true, false, false>(lds + RING_OFF, nullptr, 1024, 1024, 1024, S, E, wave);
        }
        SEAM(ph0 + 4);
    }

    if (HAS(6) && IN(PH_LN1)) {
        const Params p = load_params(kargs);
        float* wr = (float*)(lds_raw + RING_OFF); int* cls_l = (int*)(wr + 20 * 1024); int* misc = cls_l + 64;
        for (int i = opaque_tid(wave); i < 20 * 1024; i += NTHR) wr[i] = WSP(float, WS_WRT)[i];
        __syncthreads();
        { const int ptid = opaque_tid(wave); for (int rep = 0; rep < NREP(6); ++rep) for (int u = bx; u < T / 64; u += G) ln1_unit(p, u, wr, cls_l, misc, ptid, (PROBE_DUP == 6) && rep == 0); }
    }
    SEAM(PH_LN1);
    if (IN(PH_MOE1) || IN(PH_MOE2) || IN(PH_LN2)) {
        const int tid = opaque_tid(wave);
        if (tid == 0) class_tab_fill(ctl + CW_CNT, tab);
        __syncthreads();
        const int NP = tab->rowbase[NCLS] >> 8;
        for (int pm = tid; pm < NP; pm += NTHR) pan_cls[pm] = find_class(tab, pm * 256);
        __syncthreads();
    }
    if (HAS(7) && IN(PH_MOE1)) {
        const Params p = load_params(kargs);
        const int NP = tab->rowbase[NCLS] >> 8;
        SchedMoe S; S.to.init(NP, 8, G, bx); S.pan_cls = (LAS const int*)(lds + LCTL_OFF + 512); S.toktab = (LAS const int*)(lds + LTOK_OFF); S.H = nullptr; S.W1 = (const char*)WSP(bf16_t, WS_W1); S.W2 = nullptr; S.mode = 1;
        const int tid = opaque_tid(wave);
        for (int i = 0; i < MAXU; ++i) { int pm, pn; if (!S.to.tile(i, pm, pn)) break;
            if (tid < 256) { const int cls = pan_cls[pm]; int r = pm * 256 + tid - tab->rowbase[cls]; if (r >= tab->cnt[cls]) r = tab->cnt[cls] - 1; toktab[i * 256 + tid] = WSP(int, WS_LIST)[(size_t)cls * T + r]; } }
        __syncthreads();
        FastEpiMoe1 E{(LAS const int*)(lds + LTOK_OFF), WSP(float, WS_WTS), p.ws + WS_H};
        for (int rep = 0; rep < NREP(7); ++rep) pg8::gemm_phase<FastEpiMoe1, SchedMoe, true, true, false, true>(lds + RING_OFF, (const char*)(p.ws + WS_X1B8), 512, 512, 512, S, E, wave);
    }
    SEAM(PH_MOE1);
    if (HAS(8) && IN(PH_MOE2)) {
        const Params p = load_params(kargs);
        const int NP = tab->rowbase[NCLS] >> 8;
        SchedMoe S; S.to.init(NP, 4, G, bx); S.pan_cls = (LAS const int*)(lds + LCTL_OFF + 512); S.toktab = (LAS const int*)(lds + LTOK_OFF); S.H = (const char*)WSP(bf16_t, WS_H); S.W1 = nullptr; S.W2 = (const char*)WSP(bf16_t, WS_W2); S.mode = 2;
        FastEpiStore E{WSP(bf16_t, WS_Y2), 1024, 1.0f / (H8_SCALE * W8_SCALE)};
        for (int rep = 0; rep < NREP(8); ++rep) pg8::gemm_phase<FastEpiStore, SchedMoe, true, false, true, true>(lds + RING_OFF, nullptr, 512, 4096, 512, S, E, wave);
    }
    SEAM(PH_MOE2);
    if (HAS(9) && IN(PH_LN2)) {
        const Params p = load_params(kargs);
        const int tot = tab->rowbase[NCLS]; const int lane = opaque_tid(wave) & 63;
        for (int rep = 0; rep < NREP(9); ++rep)
        for (int prow = bx * NWAVES + wave; prow < tot; prow += 2 * G * NWAVES) {
            int tk[2], pr[2];
#pragma unroll
            for (int r = 0; r < 2; ++r) { pr[r] = prow + r * G * NWAVES; tk[r] = -1;
                if (pr[r] < tot) { const int cls = pan_cls[pr[r] >> 8]; const int i = pr[r] - tab->rowbase[cls]; if (i < tab->cnt[cls]) tk[r] = WSP(int, WS_LIST)[(size_t)cls * T + i]; } }
            ln2_rows<2>(p, tk, pr, lane, ((PROBE_DUP == 9) && rep == 0) ? (float*)(p.ws + 512 * MiB) : nullptr);
        }
    }
#undef IN
#undef HAS
#undef SEAM
}

#ifndef MK_MODE
#define MK_MODE 3
#endif
extern "C" void kernel_launch(void* const* d_in, const int* in_sizes, int n_in, void* d_out, int out_size, void* d_ws, size_t ws_size, hipStream_t stream) {
    if (n_in != 25 || ws_size < WS_END) { fprintf(stderr, "kernel_launch: unexpected n_in %d / ws_size %zu (need %zu)\n", n_in, ws_size, (size_t)WS_END); return; }
    static int grid = 0;
    if (grid == 0) {
        (void)hipFuncSetAttribute((const void*)k_ln1, hipFuncAttributeMaxDynamicSharedMemorySize, 20 * 1024 * 4 + 1024);
        if (hipFuncSetAttribute((const void*)mk_fwd, hipFuncAttributeMaxDynamicSharedMemorySize, LDS_BYTES) != hipSuccess) fprintf(stderr, "kernel_launch: hipFuncSetAttribute(mk_fwd, %d) failed\n", LDS_BYTES);
        int dev = 0, cus = 0; (void)hipGetDevice(&dev);
        if (hipDeviceGetAttribute(&cus, hipDeviceAttributeMultiprocessorCount, dev) != hipSuccess || cus <= 0) cus = 256;
        int per_cu = 0; (void)hipOccupancyMaxActiveBlocksPerMultiprocessor(&per_cu, (const void*)mk_fwd, NTHR, LDS_BYTES);
        if (per_cu < 1) fprintf(stderr, "kernel_launch: occupancy query reports %d blocks per CU for mk_fwd\n", per_cu);
        (void)hipGetLastError();
        grid = cus;
    }
    Params p{};
    p.x = (const float*)d_in[0]; p.mem = (const float*)d_in[1]; p.pos = (const int*)d_in[2];
    p.w_in = (const float*)d_in[3]; p.b_in = (const float*)d_in[4]; p.conv_w = (const float*)d_in[5]; p.conv_b = (const float*)d_in[6];
    p.conv_g = (const float*)d_in[7]; p.conv_bb = (const float*)d_in[8]; p.w_mem_kv = (const float*)d_in[9]; p.w_attn_o = (const float*)d_in[10];
    p.w_conv_o = (const float*)d_in[11]; p.w_mem_o = (const float*)d_in[12]; p.w_out = (const float*)d_in[13]; p.ln1_g = (const float*)d_in[14]; p.ln1_b = (const float*)d_in[15];
    p.w_gr = (const float*)d_in[16]; p.b_gr = (const float*)d_in[17]; p.w_er = (const float*)d_in[18]; p.b_er = (const float*)d_in[19];
    p.w_eg = (const float*)d_in[20]; p.w_eu = (const float*)d_in[21]; p.w_ed = (const float*)d_in[22]; p.ln2_g = (const float*)d_in[23]; p.ln2_b = (const float*)d_in[24];
    p.out = (float*)d_out; p.ws = (unsigned char*)d_ws;
    (void)hipMemsetAsync((char*)d_ws + WS_CTL, 0, CTL_BYTES, stream);
#if PROBE_DUP == 12
    (void)hipMemsetAsync((char*)d_ws + 944 * MiB, 0, 64 * MiB, stream);
#endif
    auto mk = [&](int lo, int hi) { Args a{}; a.p = p; a.ph_lo = lo; a.ph_hi = hi; hipLaunchKernelGGL(mk_fwd, dim3(grid), dim3(NTHR), LDS_BYTES, stream, a); };
#if MK_MODE == 3
    mk(0, PH_END);
#elif MK_MODE == 2
    for (int ph = 0; ph < PH_END; ++ph) mk(ph, ph + 1);
#elif MK_MODE == 1
    mk(PH_P0, PH_P0 + 1);
    for (int ch = 0; ch < NCH; ++ch) {
        const int ph0 = PH_CH0 + PH_PER_CH * ch;
        mk(ph0, ph0 + 1);
        k_nattn_dil<<<BC * 12 * 2048 / 4, 256, 0, stream>>>(p);
        k_nattn_mem<<<BC * 4 * 2048 / 4, 256, 0, stream>>>(p, ch);
        k_conv<<<BC * 64, 512, 0, stream>>>(p);
        mk(ph0 + 2, ph0 + 3); mk(ph0 + 3, ph0 + 4); mk(ph0 + 4, ph0 + 5);
    }
    mk(PH_LN1, PH_LN1 + 1); mk(PH_MOE1, PH_MOE1 + 1); mk(PH_MOE2, PH_MOE2 + 1); mk(PH_LN2, PH_LN2 + 1);
#else
    for (int w = 0; w < 8; ++w) k_transpose_w<<<2048, 256, 0, stream>>>(p, w);
    k_small_prep<<<(20 * 1024 + 255) / 256, 256, 0, stream>>>(p);
    k_cvt_bf16<<<2048, 256, 0, stream>>>(p.mem, (bf16_t*)((char*)d_ws + WS_MEMB), (size_t)NB * MEML * 1024 / 8);
    k_cvt_bf16<<<4096, 256, 0, stream>>>(p.x, (bf16_t*)((char*)d_ws + WS_XB), (size_t)T * 1024 / 8);
    k_ngemm_kv<<<dim3(1024 / 64, NB * MEML / 64), 256, 0, stream>>>(p, 0);
    for (int ch = 0; ch < NCH; ++ch) {
        k_ngemm_main<<<dim3(INC / 64, TC / 64), 256, 0, stream>>>(p, ch);
        k_nattn_dil<<<BC * 12 * 2048 / 4, 256, 0, stream>>>(p);
        k_nattn_mem<<<BC * 4 * 2048 / 4, 256, 0, stream>>>(p, ch);
        k_conv<<<BC * 64, 512, 0, stream>>>(p);
        k_combine<<<TC / 4, 256, 0, stream>>>(p);
        for (int br = 0; br < 3; ++br) k_ngemm_merge<<<dim3(1024 / 64, TC / 64), 256, 0, stream>>>(p, br);
        k_ngemm_mix<<<dim3(1024 / 64, TC / 64), 256, 0, stream>>>(p, ch);
    }
    k_ln1<<<256, 512, 20 * 1024 * 4 + 1024, stream>>>(p);
    k_ngemm_moe1<<<dim3(2048 / 64, MPAD / 64), 256, 0, stream>>>(p);
    k_ngemm_moe2<<<dim3(1024 / 64, MPAD / 64), 256, 0, stream>>>(p);
    k_ln2<<<MPAD / 4, 256, 0, stream>>>(p);
#endif
}
```

```cpp
#include <hip/hip_runtime.h>
#include <cstdio>
#include <cstdint>

constexpr int D = 1024, NB = 32, S = 2048, T = NB * S;
constexpr int NCH = 2, BC = NB / NCH, TC = T / NCH;
constexpr int INC = 9216;
constexpr int MEML = 256;
constexpr int NCLS = 24;
constexpr int MPAD = T + NCLS * 256;
constexpr float LN_EPS = 1e-5f;
constexpr float DN_ALPHA = 1.189207115002721f;
constexpr float ATT_SCALE = 0.08838834764831845f;

constexpr int C_Q = 0, C_K = 1536, C_V = 3072, C_GLU = 4608, C_QM = 5632, C_GATE = 6144;

constexpr size_t MiB = 1ull << 20;
constexpr size_t WS_CTL = 0, CTL_BYTES = 1 * MiB;
constexpr size_t WS_WIN = 1 * MiB;
constexpr size_t WS_BIASP = 19 * MiB;
constexpr size_t WS_WRT = 19 * MiB + 64 * 1024;
constexpr size_t WS_WKV = 20 * MiB;
constexpr size_t WS_WA = 22 * MiB, WS_WC = 23 * MiB, WS_WM = 24 * MiB;
constexpr size_t WS_WOUT = 25 * MiB;
constexpr size_t WS_W1 = 27 * MiB;
constexpr size_t WS_W2 = 59 * MiB;
constexpr size_t WS_MEMB = 75 * MiB;
constexpr size_t WS_CH = 91 * MiB;
constexpr size_t SZ_XB = (size_t)TC * 1024 * 2, SZ_QKV1 = (size_t)TC * 1536 * 2, SZ_512 = (size_t)TC * 512 * 2;
constexpr size_t WS_XB = WS_CH;
constexpr size_t WS_QG = WS_XB + (size_t)T * 1024 * 2, WS_KG = WS_QG + SZ_QKV1, WS_VG = WS_KG + SZ_QKV1;
constexpr size_t WS_CGLU = WS_VG + SZ_QKV1, WS_QM = WS_CGLU + SZ_512, WS_OATT = WS_QM + SZ_512, WS_CCONV = WS_OATT + SZ_512, WS_OMT = WS_CCONV + SZ_512;
constexpr size_t WS_GATES = WS_OMT + SZ_512;
constexpr size_t SZ_KM = (size_t)NB * 4 * MEML * 128 * 2;
constexpr size_t WS_KM = WS_GATES + (size_t)TC * 3072 * 2, WS_VM = WS_KM + SZ_KM;
constexpr size_t WS_LSE = WS_VM + SZ_KM;
constexpr size_t WS_MERGED = WS_LSE + 2 * MiB;
constexpr size_t WS_CH_END = WS_MERGED + SZ_XB;
constexpr size_t WS_X1B = WS_CH;
constexpr size_t WS_H = WS_X1B + (size_t)T * 1024 * 2;
constexpr size_t WS_Y2 = WS_H + (size_t)MPAD * 1024 * 2;
constexpr size_t WS_LIST = WS_Y2 + (size_t)MPAD * 1024 * 2;
constexpr size_t WS_WTS = WS_LIST + (size_t)NCLS * T * 4;
constexpr size_t WS_X1B8 = WS_WTS + (size_t)T * 8;
constexpr size_t WS_MOE_END = WS_X1B8 + (size_t)T * 1024;
constexpr float W8_SCALE = 32.0f, H8_SCALE = 16.0f;
constexpr size_t WS_END = WS_CH_END > WS_MOE_END ? WS_CH_END : WS_MOE_END;
constexpr size_t WS_XB8 = 944 * MiB;
constexpr size_t WS_WG8 = 1008 * MiB;
constexpr float WG8_SCALE = 32.0f;
static_assert(WS_CH_END <= WS_XB8 && WS_WG8 + 9 * MiB <= 1024 * MiB, "fp8 operand buffers");
static_assert(WS_END <= 1024 * MiB, "workspace map exceeds 1 GiB");
constexpr int CW_CNT = 64;

typedef unsigned short bf16_t;
typedef float f32x4 __attribute__((ext_vector_type(4)));
typedef unsigned u32x4 __attribute__((ext_vector_type(4)));
typedef unsigned u32x2 __attribute__((ext_vector_type(2)));

__device__ __forceinline__ float bf2f(bf16_t b) { return __uint_as_float(((unsigned)b) << 16); }
__device__ __forceinline__ float bflo(unsigned w) { return __uint_as_float(w << 16); }
__device__ __forceinline__ float bfhi(unsigned w) { return __uint_as_float(w & 0xffff0000u); }
__device__ __forceinline__ unsigned f2bf(float f) { unsigned u = __float_as_uint(f); return (u + 0x7fffu + ((u >> 16) & 1u)) >> 16; }
typedef float f32x2_t __attribute__((ext_vector_type(2)));
typedef __bf16 bf16x2_t __attribute__((ext_vector_type(2)));
__device__ __forceinline__ unsigned pk2(float lo, float hi) { f32x2_t v = {lo, hi}; bf16x2_t b = __builtin_convertvector(v, bf16x2_t); return __builtin_bit_cast(unsigned, b); }
__device__ __forceinline__ float sigmoidf_(float x) { return __builtin_amdgcn_rcpf(1.0f + __builtin_amdgcn_exp2f(-1.4426950408889634f * x)); }
__device__ __forceinline__ float wave_sum(float v) {
#define DPP_F(x, ctrl) __int_as_float(__builtin_amdgcn_update_dpp(0, __float_as_int(x), ctrl, 0xf, 0xf, true))
    v += DPP_F(v, 0xB1);
    v += DPP_F(v, 0x4E);
    v += DPP_F(v, 0x141);
    v += DPP_F(v, 0x140);
#undef DPP_F
    const float r0 = __int_as_float(__builtin_amdgcn_readlane(__float_as_int(v), 0)), r1 = __int_as_float(__builtin_amdgcn_readlane(__float_as_int(v), 16));
    const float r2 = __int_as_float(__builtin_amdgcn_readlane(__float_as_int(v), 32)), r3 = __int_as_float(__builtin_amdgcn_readlane(__float_as_int(v), 48));
    return (r0 + r1) + (r2 + r3);
}
__device__ __forceinline__ float wave_max(float v) {
#pragma unroll
    for (int o = 1; o < 64; o <<= 1) v = fmaxf(v, __shfl_xor(v, o));
    return v;
}
__device__ __forceinline__ unsigned pk4_fp8(float a, float b, float c, float d) { unsigned w = 0; w = __builtin_amdgcn_cvt_pk_fp8_f32(a, b, w, false); w = __builtin_amdgcn_cvt_pk_fp8_f32(c, d, w, true); return w; }
__device__ __forceinline__ unsigned pk4_u8(float a, float b, float c, float d) {
    const unsigned ua = (unsigned)fmaxf(__builtin_rintf(a * 255.f), 1.f), ub = (unsigned)fmaxf(__builtin_rintf(b * 255.f), 1.f), uc = (unsigned)fmaxf(__builtin_rintf(c * 255.f), 1.f), ud = (unsigned)fmaxf(__builtin_rintf(d * 255.f), 1.f);
    return ua | (ub << 8) | (uc << 16) | (ud << 24); }
__device__ __forceinline__ float sig255(float x) { const float e = __builtin_amdgcn_exp2f(-1.4426950408889634f * x); return fmaxf(__builtin_rintf(__builtin_amdgcn_rcpf(__builtin_fmaf(e, 1.0f / 255.0f, 1.0f / 255.0f))), 1.0f); }
__device__ __forceinline__ unsigned pk4_sig_u8(float a, float b, float c, float d) { unsigned w = 0u;
    w = __builtin_amdgcn_cvt_pk_u8_f32(sig255(a), 0, w); w = __builtin_amdgcn_cvt_pk_u8_f32(sig255(b), 1, w); w = __builtin_amdgcn_cvt_pk_u8_f32(sig255(c), 2, w); w = __builtin_amdgcn_cvt_pk_u8_f32(sig255(d), 3, w); return w; }
__device__ __forceinline__ f32x4 u8x4_raw(unsigned w) { return (f32x4){(float)(w & 255u), (float)((w >> 8) & 255u), (float)((w >> 16) & 255u), (float)(w >> 24)}; }
__device__ __forceinline__ f32x4 u8x4_to_f32(unsigned w) { return (f32x4){(float)(w & 255u), (float)((w >> 8) & 255u), (float)((w >> 16) & 255u), (float)(w >> 24)} * (1.0f / 255.0f); }
__device__ __forceinline__ int opaque_tid(int wave_s) { unsigned z = 0u; asm volatile("" : "+v"(z)); const int l = (int)__builtin_amdgcn_mbcnt_hi(~0u, __builtin_amdgcn_mbcnt_lo(~0u, z)); return (wave_s << 6) | l; }
__device__ __forceinline__ void rope_cs(float pos, int j, float& c, float& s) {
    const float invrev = __builtin_amdgcn_exp2f(-(float)j * (13.287712379549449f / 64.0f)) * 0.15915494309189535f;
    float rev = pos * invrev; rev = __builtin_amdgcn_fractf(rev);
    s = __builtin_amdgcn_sinf(rev); c = __builtin_amdgcn_cosf(rev);
}
__device__ __forceinline__ int rowperm(int g, int s) { return g == 0 ? s : (g == 1 ? ((s & 3) * 512 + (s >> 2)) : ((s & 15) * 128 + (s >> 4))); }
__host__ __device__ __forceinline__ int win_logical(int n) {
    if (n < C_V) { const int sec = n / 1536, r = n % 1536, gh = r / 128, p = r % 128, G = p >> 3, nn = (p >> 2) & 1, e = p & 3; return sec * 1536 + gh * 128 + 64 * nn + 4 * G + e; }
    if (n < C_GLU) return n;
    if (n < C_QM) { const int cc = n - C_GLU, G = cc >> 3, nn = (cc >> 2) & 1, e = cc & 3; return C_GLU + nn * 512 + 4 * G + e; }
    return n;
}

struct Params {
    const float *x, *mem; const int* pos;
    const float *w_in, *b_in, *conv_w, *conv_b, *conv_g, *conv_bb, *w_mem_kv, *w_attn_o, *w_conv_o, *w_mem_o, *w_out, *ln1_g, *ln1_b;
    const float *w_gr, *b_gr, *w_er, *b_er, *w_eg, *w_eu, *w_ed, *ln2_g, *ln2_b;
    float* out; unsigned char* ws;
};
#define WSP(T_, off) ((T_*)(p.ws + (off)))

__global__ void k_cvt_bf16(const float* __restrict__ src, bf16_t* __restrict__ dst, size_t n8) {
    for (size_t i = (size_t)blockIdx.x * blockDim.x + threadIdx.x; i < n8; i += (size_t)gridDim.x * blockDim.x) {
        const f32x4 a = *(const f32x4*)(src + i * 8), b = *(const f32x4*)(src + i * 8 + 4);
        u32x4 o; o.x = pk2(a.x, a.y); o.y = pk2(a.z, a.w); o.z = pk2(b.x, b.y); o.w = pk2(b.z, b.w);
        *(u32x4*)(dst + i * 8) = o;
    }
}
enum { TW_IN = 0, TW_KV, TW_A, TW_C, TW_M, TW_OUT, TW_W1, TW_W2 };
__device__ __forceinline__ void transpose_w_dev(const Params& p, int which, size_t gtid, size_t gstride) {
    int K, N, ldd; bf16_t* dst;
    switch (which) {
        case TW_IN: K = 1024; N = INC; ldd = 1024; dst = WSP(bf16_t, WS_WIN); break;
        case TW_KV: K = 1024; N = 1024; ldd = 1024; dst = WSP(bf16_t, WS_WKV); break;
        case TW_A: K = 512; N = 1024; ldd = 512; dst = WSP(bf16_t, WS_WA); break;
        case TW_C: K = 512; N = 1024; ldd = 512; dst = WSP(bf16_t, WS_WC); break;
        case TW_M: K = 512; N = 1024; ldd = 512; dst = WSP(bf16_t, WS_WM); break;
        case TW_OUT: K = 1024; N = 1024; ldd = 1024; dst = WSP(bf16_t, WS_WOUT); break;
        case TW_W1: K = 1024; N = 16 * 1024; ldd = 1024; dst = WSP(bf16_t, WS_W1); break;
        default: K = 512; N = 16 * 1024; ldd = 8192; dst = WSP(bf16_t, WS_W2); break;
    }
    const size_t total = (size_t)N * (K / 8);
    for (size_t i = gtid; i < total; i += gstride) {
        const int n = (int)(i % N), k0 = (int)(i / N) * 8;
        float v[8];
#pragma unroll
        for (int j = 0; j < 8; ++j) {
            const int k = k0 + j; float s;
            switch (which) {
                case TW_IN: s = p.w_in[(size_t)k * INC + win_logical(n)]; break;
                case TW_KV: s = p.w_mem_kv[(size_t)k * 1024 + n]; break;
                case TW_A: s = p.w_attn_o[(size_t)k * 1024 + n]; break;
                case TW_C: s = p.w_conv_o[(size_t)k * 1024 + n]; break;
                case TW_M: s = p.w_mem_o[(size_t)k * 1024 + n]; break;
                case TW_OUT: s = p.w_out[(size_t)k * 1024 + n]; break;
                case TW_W1: { const int e = n >> 10, c = n & 1023, G = c >> 3, nn = (c >> 2) & 1, ee = c & 3, jj = 4 * G + ee;
                              s = (nn ? p.w_eu : p.w_eg)[((size_t)e * 1024 + k) * 512 + jj]; } break;
                default: { const int e = n >> 10, c = n & 1023; s = p.w_ed[((size_t)e * 512 + k) * 1024 + c]; } break;
            }
            v[j] = s;
        }
        u32x4 o; o.x = pk2(v[0], v[1]); o.y = pk2(v[2], v[3]); o.z = pk2(v[4], v[5]); o.w = pk2(v[6], v[7]);
        size_t doff;
        if (which == TW_W2) { const int e = n >> 10, c = n & 1023; doff = (size_t)c * 8192 + e * 512 + k0; }
        else doff = (size_t)n * ldd + k0;
        *(u32x4*)(dst + doff) = o;
    }
}
__global__ void k_transpose_w(Params p, int which) { transpose_w_dev(p, which, (size_t)blockIdx.x * blockDim.x + threadIdx.x, (size_t)gridDim.x * blockDim.x); }
__device__ __forceinline__ void small_prep_dev(const Params& p, size_t gtid, size_t gstride) {
    for (size_t ii = gtid; ii < 20 * 1024; ii += gstride) { const int i = (int)ii;
        if (i < INC) WSP(float, WS_BIASP)[i] = p.b_in[win_logical(i)];
        const int e = i >> 10, k = i & 1023;
        WSP(float, WS_WRT)[i] = e < 4 ? p.w_gr[k * 4 + e] : p.w_er[((size_t)((e - 4) >> 2) * 1024 + k) * 4 + ((e - 4) & 3)]; }
}
__global__ void k_small_prep(Params p) { small_prep_dev(p, (size_t)blockIdx.x * blockDim.x + threadIdx.x, (size_t)gridDim.x * blockDim.x); }

struct EpiMain {
    const float* biasp; const int* pos; bf16_t *QG, *CGLU, *QM, *GATES; int tok0;
    static __device__ __forceinline__ void rope_freqs(int c0, float (&invrev)[4]) {
        const int j0 = ((c0 & 127) >> 3) * 4;
#pragma unroll
        for (int e = 0; e < 4; ++e) invrev[e] = __builtin_amdgcn_exp2f(-(float)(j0 + e) * (13.287712379549449f / 64.0f)) * 0.15915494309189535f;
    }
    __device__ __forceinline__ void finish(int rl, int c0, float (&v)[8], float fpos, const float (&invrev)[4]) const {
        const int bl = rl >> 11, s = rl & 2047;
        const int tcol = __builtin_amdgcn_readfirstlane(c0 & ~255);
        if (tcol < C_GLU) {
            const int sec = tcol / 1536, r = c0 - sec * 1536, gh = r >> 7, pcol = r & 127, g = gh >> 2;
            if (sec < 2) {
#pragma unroll
                for (int e = 0; e < 4; ++e) { const float rev = __builtin_amdgcn_fractf(fpos * invrev[e]); const float sn = __builtin_amdgcn_sinf(rev), c = __builtin_amdgcn_cosf(rev);
                    const float t1 = v[e], t2 = v[4 + e]; v[e] = t1 * c - t2 * sn; v[4 + e] = t2 * c + t1 * sn; }
            }
            bf16_t* base = QG + (size_t)sec * (SZ_QKV1 / 2);
            u32x4 o; o.x = pk2(v[0], v[1]); o.y = pk2(v[2], v[3]); o.z = pk2(v[4], v[5]); o.w = pk2(v[6], v[7]);
            *(u32x4*)(base + ((size_t)(bl * 12 + gh) * 2048 + rowperm(g, s)) * 128 + pcol) = o;
        } else if (tcol < C_QM) {
            const int j0 = (c0 - C_GLU) >> 1;
            u32x2 o; o.x = pk2(v[0] * sigmoidf_(v[4]), v[1] * sigmoidf_(v[5])); o.y = pk2(v[2] * sigmoidf_(v[6]), v[3] * sigmoidf_(v[7]));
            *(u32x2*)(CGLU + (size_t)rl * 512 + j0) = o;
        } else if (tcol < C_GATE) {
            const int cc = c0 - C_QM, h = cc >> 7, pcol = cc & 127;
            u32x4 o; o.x = pk2(v[0], v[1]); o.y = pk2(v[2], v[3]); o.z = pk2(v[4], v[5]); o.w = pk2(v[6], v[7]);
            *(u32x4*)(QM + ((size_t)(bl * 4 + h) * 2048 + s) * 128 + pcol) = o;
        } else {
            const int cc = c0 - C_GATE;
            u32x2 o; o.x = pk4_sig_u8(v[0], v[1], v[2], v[3]); o.y = pk4_sig_u8(v[4], v[5], v[6], v[7]);
            *(u32x2*)((unsigned char*)GATES + (size_t)rl * 3072 + cc) = o;
        }
    }
    __device__ __forceinline__ void operator()(int rl, int c0, float (&v)[8]) const {
        const f32x4 b0 = *(const f32x4*)(biasp + c0), b1 = *(const f32x4*)(biasp + c0 + 4);
        v[0] += b0.x; v[1] += b0.y; v[2] += b0.z; v[3] += b0.w; v[4] += b1.x; v[5] += b1.y; v[6] += b1.z; v[7] += b1.w;
        float invrev[4]; rope_freqs(c0, invrev);
        finish(rl, c0, v, c0 < C_V ? (float)pos[tok0 + rl] : 0.f, invrev);
    }
};
struct EpiKV {
    bf16_t *KM;
    __device__ __forceinline__ void operator()(int row, int c0, float (&v)[8]) const {
        const int bl = row >> 8, m = row & 255, isv = c0 >> 9, cc = c0 & 511, h = cc >> 7, pcol = cc & 127;
        u32x4 o; o.x = pk2(v[0], v[1]); o.y = pk2(v[2], v[3]); o.z = pk2(v[4], v[5]); o.w = pk2(v[6], v[7]);
        *(u32x4*)(KM + (size_t)isv * (SZ_KM / 2) + ((size_t)(bl * 4 + h) * 256 + m) * 128 + pcol) = o;
    }
};
struct EpiMerge {
    const bf16_t* GATES; bf16_t* MERGED; int br;
    __device__ __forceinline__ void operator()(int rl, int c0, float (&v)[8]) const {
        const u32x2 g = *(const u32x2*)((const unsigned char*)GATES + (size_t)rl * 3072 + br * 1024 + c0);
        const f32x4 g0 = u8x4_to_f32(g.x), g1 = u8x4_to_f32(g.y);
        float r[8] = {g0.x * v[0], g0.y * v[1], g0.z * v[2], g0.w * v[3], g1.x * v[4], g1.y * v[5], g1.z * v[6], g1.w * v[7]};
        bf16_t* mp = MERGED + (size_t)rl * 1024 + c0;
        if (br > 0) { const u32x4 m = *(const u32x4*)mp; r[0] += bflo(m.x); r[1] += bfhi(m.x); r[2] += bflo(m.y); r[3] += bfhi(m.y); r[4] += bflo(m.z); r[5] += bfhi(m.z); r[6] += bflo(m.w); r[7] += bfhi(m.w); }
        u32x4 o; o.x = pk2(r[0], r[1]); o.y = pk2(r[2], r[3]); o.z = pk2(r[4], r[5]); o.w = pk2(r[6], r[7]);
        *(u32x4*)mp = o;
    }
};
struct EpiMix {
    bf16_t* MIX; int tok0;
    __device__ __forceinline__ void operator()(int rl, int c0, float (&v)[8]) const {
        u32x4 o; o.x = pk2(v[0], v[1]); o.y = pk2(v[2], v[3]); o.z = pk2(v[4], v[5]); o.w = pk2(v[6], v[7]);
        *(u32x4*)(MIX + (size_t)(tok0 + rl) * 1024 + c0) = o;
    }
};
struct ClassTab { int cnt[NCLS], rowbase[NCLS + 1]; };
__device__ __forceinline__ void class_tab_fill(const unsigned* cntw, ClassTab* t) {
    int acc = 0;
    for (int c = 0; c < NCLS; ++c) { const int n = (int)cntw[c]; t->cnt[c] = n; t->rowbase[c] = acc; acc += ((n + 255) >> 8) << 8; }
    t->rowbase[NCLS] = acc;
}
__device__ __forceinline__ void class_experts(int cls, int& e_lo, int& e_hi) {
    const int g = cls / 6, pi = cls - g * 6;
    const int lo = pi < 3 ? 0 : (pi < 5 ? 1 : 2), hi = pi < 3 ? pi + 1 : (pi < 5 ? pi - 1 : 3);
    e_lo = g * 4 + lo; e_hi = g * 4 + hi;
}
struct EpiMoe1 {
    const int* list; const float* wts; bf16_t* H; int cls, cnt, rowbase;
    __device__ __forceinline__ void operator()(int prow, int c0, float (&v)[8]) const {
        int i = prow - rowbase; if (i >= cnt) i = cnt - 1;
        const int tok = list[i]; const int hi = c0 >> 10; const float w = wts[(size_t)tok * 2 + hi];
        const int j0 = hi * 512 + ((c0 & 1023) >> 1);
        float r[4];
#pragma unroll
        for (int e = 0; e < 4; ++e) { const float gt = v[e]; r[e] = gt * sigmoidf_(gt) * v[4 + e] * w; }
        u32x2 o; o.x = pk2(r[0], r[1]); o.y = pk2(r[2], r[3]);
        *(u32x2*)(H + (size_t)prow * 1024 + j0) = o;
    }
};
struct EpiMoe2 {
    bf16_t* Y2;
    __device__ __forceinline__ void operator()(int prow, int c0, float (&v)[8]) const {
        u32x4 o; o.x = pk2(v[0], v[1]); o.y = pk2(v[2], v[3]); o.z = pk2(v[4], v[5]); o.w = pk2(v[6], v[7]);
        *(u32x4*)(Y2 + (size_t)prow * 1024 + c0) = o;
    }
};

struct RowsPlain { const bf16_t* base; int ld; __device__ __forceinline__ const bf16_t* operator()(int r) const { return base + (size_t)r * ld; } };
template <class AF, class BF, class EF>
__device__ __forceinline__ void ngemm_tile(int row0, int col0, int K, const AF& af, const BF& bf, const EF& ef, int bkseg, long bjump) {
    __shared__ float As[64][33], Bs[64][33];
    const int tid = threadIdx.x, ty = tid >> 3, tx = tid & 7;
    float acc[2][8];
#pragma unroll
    for (int i = 0; i < 2; ++i)
#pragma unroll
        for (int j = 0; j < 8; ++j) acc[i][j] = 0.f;
    const int lr = tid >> 2, lk = (tid & 3) * 8;
    const bf16_t* ap = af(row0 + lr); const bf16_t* bp = bf(col0 + lr);
    for (int k0 = 0; k0 < K; k0 += 32) {
        const u32x4 a = *(const u32x4*)(ap + k0 + lk);
        const long bo = (long)k0 + lk + (long)(k0 / bkseg) * bjump;
        const u32x4 b = *(const u32x4*)(bp + bo);
        __syncthreads();
        As[lr][lk + 0] = bflo(a.x); As[lr][lk + 1] = bfhi(a.x); As[lr][lk + 2] = bflo(a.y); As[lr][lk + 3] = bfhi(a.y);
        As[lr][lk + 4] = bflo(a.z); As[lr][lk + 5] = bfhi(a.z); As[lr][lk + 6] = bflo(a.w); As[lr][lk + 7] = bfhi(a.w);
        Bs[lr][lk + 0] = bflo(b.x); Bs[lr][lk + 1] = bfhi(b.x); Bs[lr][lk + 2] = bflo(b.y); Bs[lr][lk + 3] = bfhi(b.y);
        Bs[lr][lk + 4] = bflo(b.z); Bs[lr][lk + 5] = bfhi(b.z); Bs[lr][lk + 6] = bflo(b.w); Bs[lr][lk + 7] = bfhi(b.w);
        __syncthreads();
#pragma unroll 8
        for (int kk = 0; kk < 32; ++kk) {
            const float a0 = As[2 * ty][kk], a1 = As[2 * ty + 1][kk];
#pragma unroll
            for (int j = 0; j < 8; ++j) { const float bv = Bs[8 * tx + j][kk]; acc[0][j] += a0 * bv; acc[1][j] += a1 * bv; }
        }
    }
    ef(row0 + 2 * ty, col0 + 8 * tx, acc[0]);
    ef(row0 + 2 * ty + 1, col0 + 8 * tx, acc[1]);
}
__global__ void __launch_bounds__(256) k_ngemm_main(Params p, int ch) {
    const int tok0 = ch * TC;
    EpiMain E{WSP(float, WS_BIASP), p.pos, WSP(bf16_t, WS_QG), WSP(bf16_t, WS_CGLU), WSP(bf16_t, WS_QM), WSP(bf16_t, WS_GATES), tok0};
    RowsPlain A{WSP(bf16_t, WS_XB) + (size_t)ch * TC * 1024, 1024}, Bm{WSP(bf16_t, WS_WIN), 1024};
    ngemm_tile(blockIdx.y * 64, blockIdx.x * 64, 1024, A, Bm, E, 1 << 30, 0);
}
__global__ void __launch_bounds__(256) k_ngemm_kv(Params p, int ch) {
    EpiKV E{WSP(bf16_t, WS_KM)};
    RowsPlain A{WSP(bf16_t, WS_MEMB), 1024}, Bm{WSP(bf16_t, WS_WKV), 1024};
    ngemm_tile(blockIdx.y * 64, blockIdx.x * 64, 1024, A, Bm, E, 1 << 30, 0);
}
__global__ void __launch_bounds__(256) k_ngemm_merge(Params p, int br) {
    EpiMerge E{WSP(bf16_t, WS_GATES), WSP(bf16_t, WS_MERGED), br};
    RowsPlain A{WSP(bf16_t, WS_OATT + (size_t)br * SZ_512), 512};
    RowsPlain Bm{WSP(bf16_t, WS_WA + (size_t)br * MiB), 512};
    ngemm_tile(blockIdx.y * 64, blockIdx.x * 64, 512, A, Bm, E, 1 << 30, 0);
}
__global__ void __launch_bounds__(256) k_ngemm_mix(Params p, int ch) {
    EpiMix E{(bf16_t*)p.out, ch * TC};
    RowsPlain A{WSP(bf16_t, WS_MERGED), 1024}, Bm{WSP(bf16_t, WS_WOUT), 1024};
    ngemm_tile(blockIdx.y * 64, blockIdx.x * 64, 1024, A, Bm, E, 1 << 30, 0);
}
struct RowsGather { const bf16_t* base; const int* list; int cnt, rowbase; __device__ __forceinline__ const bf16_t* operator()(int prow) const { int i = prow - rowbase; if (i >= cnt) i = cnt - 1; return base + (size_t)list[i] * 1024; } };
__device__ __forceinline__ int find_class(const ClassTab* t, int prow) { int c = 0;
    for (int i = 1; i < NCLS; ++i) if (prow >= t->rowbase[i]) c = i;
    return c; }
__global__ void __launch_bounds__(256) k_ngemm_moe1(Params p) {
    __shared__ ClassTab tabs; if (threadIdx.x == 0) class_tab_fill(WSP(unsigned, WS_CTL) + CW_CNT, &tabs); __syncthreads(); const ClassTab* tab = &tabs;
    const int row0 = blockIdx.y * 64; if (row0 >= tab->rowbase[NCLS]) return;
    const int cls = find_class(tab, row0); if (tab->cnt[cls] == 0) return;
    int e_lo, e_hi; class_experts(cls, e_lo, e_hi);
    const int col0 = blockIdx.x * 64, hi = col0 >> 10;
    const int* list = WSP(int, WS_LIST) + (size_t)cls * T;
    RowsGather A{WSP(bf16_t, WS_X1B), list, tab->cnt[cls], tab->rowbase[cls]};
    RowsPlain Bm{WSP(bf16_t, WS_W1) + ((size_t)(hi ? e_hi : e_lo) * 1024 - (size_t)hi * 1024) * 1024, 1024};
    EpiMoe1 E{list, WSP(float, WS_WTS), WSP(bf16_t, WS_H), cls, tab->cnt[cls], tab->rowbase[cls]};
    ngemm_tile(row0, col0, 1024, A, Bm, E, 1 << 30, 0);
}
__global__ void __launch_bounds__(256) k_ngemm_moe2(Params p) {
    __shared__ ClassTab tabs; if (threadIdx.x == 0) class_tab_fill(WSP(unsigned, WS_CTL) + CW_CNT, &tabs); __syncthreads(); const ClassTab* tab = &tabs;
    const int row0 = blockIdx.y * 64; if (row0 >= tab->rowbase[NCLS]) return;
    const int cls = find_class(tab, row0); if (tab->cnt[cls] == 0) return;
    int e_lo, e_hi; class_experts(cls, e_lo, e_hi);
    RowsPlain A{WSP(bf16_t, WS_H), 1024};
    RowsPlain Bm{WSP(bf16_t, WS_W2) + (size_t)e_lo * 512, 8192};
    EpiMoe2 E{WSP(bf16_t, WS_Y2)};
    ngemm_tile(row0, blockIdx.x * 64, 1024, A, Bm, E, 512, (long)(e_hi - e_lo - 1) * 512);
}

__device__ __forceinline__ void nattn_row(const bf16_t* qp, const bf16_t* kbase, const bf16_t* vbase, int nkeys, bf16_t* op, float* lsep, int lane) {
    const unsigned qw = *(const unsigned*)(qp + 2 * lane); const float q0 = bflo(qw), q1 = bfhi(qw);
    float sc[4] = {-INFINITY, -INFINITY, -INFINITY, -INFINITY};
#pragma unroll
    for (int kb = 0; kb < 4; ++kb) {
        for (int kk = 0; kk < 64; ++kk) { const int k = kb * 64 + kk; if (k >= nkeys) break;
            const unsigned kw = *(const unsigned*)(kbase + (size_t)k * 128 + 2 * lane);
            const float s = wave_sum(q0 * bflo(kw) + q1 * bfhi(kw)) * ATT_SCALE;
            if (lane == kk) sc[kb] = s; }
    }
    const float m = wave_max(fmaxf(fmaxf(sc[0], sc[1]), fmaxf(sc[2], sc[3])));
    float pr[4]; float ps = 0.f;
#pragma unroll
    for (int kb = 0; kb < 4; ++kb) { pr[kb] = __expf(sc[kb] - m); ps += pr[kb]; }
    const float l = wave_sum(ps);
    float a0 = 0.f, a1 = 0.f;
#pragma unroll
    for (int kb = 0; kb < 4; ++kb) {
        for (int kk = 0; kk < 64; ++kk) { const int k = kb * 64 + kk; if (k >= nkeys) break;
            const float pk = __shfl(pr[kb], kk);
            const unsigned vw = *(const unsigned*)(vbase + (size_t)k * 128 + 2 * lane);
            a0 += pk * bflo(vw); a1 += pk * bfhi(vw); }
    }
    const float inv = 1.0f / l;
    *(unsigned*)(op + 2 * lane) = pk2(a0 * inv, a1 * inv);
    if (lsep && lane == 0) *lsep = m + __logf(l);
}
__global__ void __launch_bounds__(256) k_nattn_dil(Params p) {
    const int lane = threadIdx.x & 63; const size_t w = (size_t)blockIdx.x * 4 + (threadIdx.x >> 6);
    if (w >= (size_t)BC * 12 * 2048) return;
    const int row = (int)(w & 2047); const int bgh = (int)(w >> 11); const int g = (bgh % 12) >> 2;
    const int seglen = 2048 >> (2 * g); const int pin = row & (seglen - 1); const int nk = pin + 1 < 129 ? pin + 1 : 129;
    bf16_t* Q = WSP(bf16_t, WS_QG) + ((size_t)bgh * 2048 + row) * 128;
    const bf16_t* K = WSP(bf16_t, WS_KG) + ((size_t)bgh * 2048 + row - nk + 1) * 128;
    const bf16_t* V = WSP(bf16_t, WS_VG) + ((size_t)bgh * 2048 + row - nk + 1) * 128;
    nattn_row(Q, K, V, nk, Q, WSP(float, WS_LSE) + (size_t)bgh * 2048 + row, lane);
}
__global__ void __launch_bounds__(256) k_nattn_mem(Params p, int ch) {
    const int lane = threadIdx.x & 63; const size_t w = (size_t)blockIdx.x * 4 + (threadIdx.x >> 6);
    if (w >= (size_t)BC * 4 * 2048) return;
    const int s = (int)(w & 2047); const int bh = (int)(w >> 11); const int bl = bh >> 2, h = bh & 3;
    const bf16_t* Q = WSP(bf16_t, WS_QM) + ((size_t)bh * 2048 + s) * 128;
    const bf16_t* K = WSP(bf16_t, WS_KM) + (size_t)(ch * BC * 4 + bh) * 256 * 128;
    const bf16_t* V = WSP(bf16_t, WS_VM) + (size_t)(ch * BC * 4 + bh) * 256 * 128;
    nattn_row(Q, K, V, 256, WSP(bf16_t, WS_OMT) + ((size_t)(bl * 2048 + s)) * 512 + h * 128, nullptr, lane);
}

__device__ __forceinline__ void combine_token(const Params& p, int rl, int lane) {
    const int bl = rl >> 11, s = rl & 2047, h = lane >> 4, d0 = (lane & 15) * 8;
    float ls[3]; u32x4 o[3];
#pragma unroll
    for (int g = 0; g < 3; ++g) { const size_t r = (size_t)(bl * 12 + g * 4 + h) * 2048 + rowperm(g, s);
        ls[g] = WSP(float, WS_LSE)[r]; o[g] = *(const u32x4*)(WSP(bf16_t, WS_QG) + r * 128 + d0); }
    const float m = fmaxf(ls[0], fmaxf(ls[1], ls[2]));
    float w0 = __expf(ls[0] - m), w1 = __expf(ls[1] - m), w2 = __expf(ls[2] - m); const float inv = 1.0f / (w0 + w1 + w2); w0 *= inv; w1 *= inv; w2 *= inv;
    u32x4 r;
    r.x = pk2(w0 * bflo(o[0].x) + w1 * bflo(o[1].x) + w2 * bflo(o[2].x), w0 * bfhi(o[0].x) + w1 * bfhi(o[1].x) + w2 * bfhi(o[2].x));
    r.y = pk2(w0 * bflo(o[0].y) + w1 * bflo(o[1].y) + w2 * bflo(o[2].y), w0 * bfhi(o[0].y) + w1 * bfhi(o[1].y) + w2 * bfhi(o[2].y));
    r.z = pk2(w0 * bflo(o[0].z) + w1 * bflo(o[1].z) + w2 * bflo(o[2].z), w0 * bfhi(o[0].z) + w1 * bfhi(o[1].z) + w2 * bfhi(o[2].z));
    r.w = pk2(w0 * bflo(o[0].w) + w1 * bflo(o[1].w) + w2 * bflo(o[2].w), w0 * bfhi(o[0].w) + w1 * bfhi(o[1].w) + w2 * bfhi(o[2].w));
    *(u32x4*)(WSP(bf16_t, WS_OATT) + (size_t)rl * 512 + h * 128 + d0) = r;
}
__global__ void __launch_bounds__(256) k_combine(Params p) {
    const int lane = threadIdx.x & 63; const int w = blockIdx.x * 4 + (threadIdx.x >> 6);
    if (w < TC) combine_token(p, w, lane);
}
constexpr int CONV_TILE = 62 * 1024, CONV_OUT = 32 * 1024, CONV_LDS = CONV_TILE + CONV_OUT + (8 * 32 + 64) * 4;
__device__ __forceinline__ void conv_unit(const Params& p, int u, unsigned char* lds, int tid_) {
    const int ch = tid_, lane = ch & 63, wv = ch >> 6;
    const int bl = u >> 6, s0 = (u & 63) * 32;
    bf16_t* tile = (bf16_t*)lds; bf16_t* otile = (bf16_t*)(lds + CONV_TILE); float* red = (float*)(lds + CONV_TILE + CONV_OUT);
    const bf16_t* cg = WSP(bf16_t, WS_CGLU) + (size_t)bl * 2048 * 512;
#pragma unroll
    for (int it = 0; it < 8; ++it) { const int c = it * 512 + ch; if (c < 62 * 64) { const int r = c >> 6, q = c & 63, s = s0 - 30 + r;
        u32x4 v = {0u, 0u, 0u, 0u}; if (s >= 0) v = *(const u32x4*)(cg + (size_t)s * 512 + q * 8);
        *(u32x4*)(tile + r * 512 + q * 8) = v; } }
    __syncthreads();
    float o[32]; const float cb = p.conv_b[ch];
#pragma unroll
    for (int i = 0; i < 32; ++i) o[i] = cb;
    {   float in[62];
#pragma unroll
        for (int i = 0; i < 62; ++i) in[i] = bf2f(tile[i * 512 + ch]);
#pragma unroll
        for (int j = 0; j < 31; ++j) { const float w = p.conv_w[j * 512 + ch];
#pragma unroll
            for (int i = 0; i < 32; ++i) o[i] += w * in[i + j]; } }
    float* mean = red + 256; float* rstd = red + 288;
#pragma unroll
    for (int i = 0; i < 32; ++i) { const float sr = wave_sum(o[i]); if (lane == 0) red[wv * 32 + i] = sr; }
    __syncthreads();
    if (ch < 32) { float sm = 0.f;
#pragma unroll
        for (int w = 0; w < 8; ++w) sm += red[w * 32 + ch];
        mean[ch] = sm * (1.0f / 512.0f); }
    __syncthreads();
#pragma unroll
    for (int i = 0; i < 32; ++i) { o[i] -= mean[i]; const float sr = wave_sum(o[i] * o[i]); if (lane == 0) red[wv * 32 + i] = sr; }
    __syncthreads();
    if (ch < 32) { float sm = 0.f;
#pragma unroll
        for (int w = 0; w < 8; ++w) sm += red[w * 32 + ch];
        rstd[ch] = 1.0f / sqrtf(sm * (1.0f / 512.0f) + LN_EPS); }
    __syncthreads();
    const float gg = p.conv_g[ch], bb = p.conv_bb[ch];
#pragma unroll
    for (int i = 0; i < 32; ++i) { const float y = o[i] * rstd[i] * gg + bb; otile[i * 512 + ch] = (bf16_t)f2bf(y * sigmoidf_(y)); }
    __syncthreads();
    bf16_t* outp = WSP(bf16_t, WS_CCONV) + ((size_t)bl * 2048 + s0) * 512;
#pragma unroll
    for (int it = 0; it < 4; ++it) { const int c = it * 512 + ch; *(u32x4*)(outp + (size_t)c * 8) = *(const u32x4*)(otile + c * 8); }
    __syncthreads();
}
__global__ void __launch_bounds__(512) k_conv(Params p) {
    __shared__ __attribute__((aligned(16))) unsigned char cl[CONV_LDS];
    conv_unit(p, blockIdx.x, cl, threadIdx.x);
}
__device__ __forceinline__ void ln1_unit(const Params& p, int u, const float* wr, int* cls_l, int* misc, int tid_, bool dummy = false) {
    const int tid = tid_, lane = tid & 63, wv = tid >> 6;
    float gam[16], bet[16];
#pragma unroll
    for (int j = 0; j < 4; ++j) { const f32x4 g4 = *(const f32x4*)(p.ln1_g + 4 * lane + 256 * j), b4 = *(const f32x4*)(p.ln1_b + 4 * lane + 256 * j);
        gam[4 * j] = g4.x; gam[4 * j + 1] = g4.y; gam[4 * j + 2] = g4.z; gam[4 * j + 3] = g4.w; bet[4 * j] = b4.x; bet[4 * j + 1] = b4.y; bet[4 * j + 2] = b4.z; bet[4 * j + 3] = b4.w; }
    const int tok0 = u * 64 + wv * 8;
    u32x2 xq[2][4]; u32x2 mq[2][4];
#define LN1_LOAD(slot, rr) do { const bf16_t* xr_ = WSP(bf16_t, WS_XB) + (size_t)(tok0 + (rr)) * 1024 + 4 * lane; const bf16_t* mr_ = (const bf16_t*)p.out + (size_t)(tok0 + (rr)) * 1024 + 4 * lane; \
        _Pragma("unroll") for (int j = 0; j < 4; ++j) { xq[slot][j] = *(const u32x2*)(xr_ + 256 * j); mq[slot][j] = *(const u32x2*)(mr_ + 256 * j); } } while (0)
    LN1_LOAD(0, 0);
#pragma unroll
    for (int rr = 0; rr < 8; ++rr) {
        const int lr = wv * 8 + rr; const int tok = tok0 + rr;
        if (rr + 1 < 8) { if (rr & 1) LN1_LOAD(0, rr + 1); else LN1_LOAD(1, rr + 1); }
        float v[16]; float sm = 0.f;
#pragma unroll
        for (int j = 0; j < 4; ++j) { const u32x2 t = xq[rr & 1][j]; const u32x2 mm = mq[rr & 1][j];
            v[4 * j] = DN_ALPHA * bflo(t.x) + bflo(mm.x); v[4 * j + 1] = DN_ALPHA * bfhi(t.x) + bfhi(mm.x); v[4 * j + 2] = DN_ALPHA * bflo(t.y) + bflo(mm.y); v[4 * j + 3] = DN_ALPHA * bfhi(t.y) + bfhi(mm.y);
            sm += (v[4 * j] + v[4 * j + 1]) + (v[4 * j + 2] + v[4 * j + 3]); }
        const float mean = wave_sum(sm) * (1.0f / 1024.0f); float sq = 0.f;
#pragma unroll
        for (int i = 0; i < 16; ++i) { v[i] -= mean; sq += v[i] * v[i]; }
        const float rstd = 1.0f / sqrtf(wave_sum(sq) * (1.0f / 1024.0f) + LN_EPS);
#pragma unroll
        for (int i = 0; i < 16; ++i) v[i] = v[i] * rstd * gam[i] + bet[i];
        bf16_t* xb = WSP(bf16_t, dummy ? WS_H : WS_X1B) + (size_t)tok * 1024;
#pragma unroll
        for (int j = 0; j < 4; ++j) { u32x2 o; o.x = pk2(v[4 * j], v[4 * j + 1]); o.y = pk2(v[4 * j + 2], v[4 * j + 3]); *(u32x2*)(xb + 4 * lane + 256 * j) = o; }
        if (!dummy) { unsigned char* x8 = p.ws + WS_X1B8 + (size_t)tok * 1024;
#pragma unroll
            for (int j = 0; j < 4; ++j) *(unsigned*)(x8 + 4 * lane + 256 * j) = pk4_fp8(v[4 * j], v[4 * j + 1], v[4 * j + 2], v[4 * j + 3]); }
        float gl[4];
#pragma unroll
        for (int e = 0; e < 4; ++e) { float a = 0.f;
#pragma unroll
            for (int j = 0; j < 4; ++j) { const f32x4 w4 = *(const f32x4*)(wr + e * 1024 + 4 * lane + 256 * j); a += v[4 * j] * w4.x + v[4 * j + 1] * w4.y + v[4 * j + 2] * w4.z + v[4 * j + 3] * w4.w; }
            gl[e] = wave_sum(a) + p.b_gr[e]; }
        int gs = 0; float gm = gl[0];
#pragma unroll
        for (int e = 1; e < 4; ++e) if (gl[e] > gm) { gm = gl[e]; gs = e; }
        float gsum = 0.f;
#pragma unroll
        for (int e = 0; e < 4; ++e) gsum += __expf(gl[e] - gm);
        const float gprob = 1.0f / gsum;
        gs = __builtin_amdgcn_readfirstlane(gs);
        float el[4];
#pragma unroll
        for (int e = 0; e < 4; ++e) { float a = 0.f; const float* wp = wr + (4 + gs * 4 + e) * 1024;
#pragma unroll
            for (int j = 0; j < 4; ++j) { const f32x4 w4 = *(const f32x4*)(wp + 4 * lane + 256 * j); a += v[4 * j] * w4.x + v[4 * j + 1] * w4.y + v[4 * j + 2] * w4.z + v[4 * j + 3] * w4.w; }
            el[e] = wave_sum(a) + p.b_er[gs * 4 + e]; }
        int i1 = 0; float v1 = el[0];
#pragma unroll
        for (int e = 1; e < 4; ++e) if (el[e] > v1) { v1 = el[e]; i1 = e; }
        int i2 = -1; float v2 = -INFINITY;
#pragma unroll
        for (int e = 0; e < 4; ++e) if (e != i1 && el[e] > v2) { v2 = el[e]; i2 = e; }
        const float t2 = __expf(v2 - v1); const float w1 = gprob / (1.0f + t2), w2 = gprob * t2 / (1.0f + t2);
        const int lo = i1 < i2 ? i1 : i2, hi = i1 < i2 ? i2 : i1;
        const int pi = lo == 0 ? hi - 1 : (lo == 1 ? hi + 1 : 5);
        if (lane == 0 && !dummy) { cls_l[lr] = gs * 6 + pi; float* wt = WSP(float, WS_WTS) + (size_t)tok * 2; wt[0] = (i1 == lo) ? w1 : w2; wt[1] = (i1 == lo) ? w2 : w1; }
    }
#undef LN1_LOAD
    __syncthreads();
    if (dummy) return;
    if (tid < NCLS) { int n = 0; for (int r = 0; r < 64; ++r) n += (cls_l[r] == tid); misc[tid] = n ? (int)atomicAdd(WSP(unsigned, WS_CTL) + CW_CNT + tid, (unsigned)n) : 0; }
    __syncthreads();
    if (tid < 64) { const int c = cls_l[tid]; int rank = 0; for (int r = 0; r < tid; ++r) rank += (cls_l[r] == c);
        WSP(int, WS_LIST)[(size_t)c * T + misc[c] + rank] = u * 64 + tid; }
    __syncthreads();
}
__global__ void __launch_bounds__(512) k_ln1(Params p) {
    extern __shared__ float dyn[];
    float* wr = dyn; int* cls_l = (int*)(dyn + 20 * 1024); int* misc = cls_l + 64;
    for (int i = threadIdx.x; i < 20 * 1024; i += 512) wr[i] = WSP(float, WS_WRT)[i];
    __syncthreads();
    for (int u = blockIdx.x; u < T / 64; u += gridDim.x) ln1_unit(p, u, wr, cls_l, misc, threadIdx.x);
}
template <int NR>
__device__ __forceinline__ void ln2_rows(const Params& p, const int (&tok)[NR], const int (&prow)[NR], int lane, float* dummy = nullptr) {
    u32x2 xa[NR][4], ya[NR][4];
#pragma unroll
    for (int r = 0; r < NR; ++r) if (tok[r] >= 0) { const bf16_t* xrow = WSP(bf16_t, WS_X1B) + (size_t)tok[r] * 1024 + 4 * lane; const bf16_t* yrow = WSP(bf16_t, WS_Y2) + (size_t)prow[r] * 1024 + 4 * lane;
#pragma unroll
        for (int j = 0; j < 4; ++j) { xa[r][j] = *(const u32x2*)(xrow + 256 * j); ya[r][j] = *(const u32x2*)(yrow + 256 * j); } }
    f32x4 g4[4], b4[4];
#pragma unroll
    for (int j = 0; j < 4; ++j) { g4[j] = *(const f32x4*)(p.ln2_g + 4 * lane + 256 * j); b4[j] = *(const f32x4*)(p.ln2_b + 4 * lane + 256 * j); }
#pragma unroll
    for (int r = 0; r < NR; ++r) if (tok[r] >= 0) {
        float v[16]; float sm = 0.f;
#pragma unroll
        for (int j = 0; j < 4; ++j) { const u32x2 t = xa[r][j], y = ya[r][j];
            v[4 * j] = DN_ALPHA * bflo(t.x) + bflo(y.x); v[4 * j + 1] = DN_ALPHA * bfhi(t.x) + bfhi(y.x); v[4 * j + 2] = DN_ALPHA * bflo(t.y) + bflo(y.y); v[4 * j + 3] = DN_ALPHA * bfhi(t.y) + bfhi(y.y);
            sm += (v[4 * j] + v[4 * j + 1]) + (v[4 * j + 2] + v[4 * j + 3]); }
        const float mean = wave_sum(sm) * (1.0f / 1024.0f); float sq = 0.f;
#pragma unroll
        for (int i2 = 0; i2 < 16; ++i2) { v[i2] -= mean; sq += v[i2] * v[i2]; }
        const float rstd = 1.0f / sqrtf(wave_sum(sq) * (1.0f / 1024.0f) + LN_EPS);
        float* orow = (dummy ? dummy : p.out) + (size_t)tok[r] * 1024 + 4 * lane;
#pragma unroll
        for (int j = 0; j < 4; ++j) *(f32x4*)(orow + 256 * j) = (f32x4){v[4 * j] * rstd * g4[j].x + b4[j].x, v[4 * j + 1] * rstd * g4[j].y + b4[j].y, v[4 * j + 2] * rstd * g4[j].z + b4[j].z, v[4 * j + 3] * rstd * g4[j].w + b4[j].w};
    }
}
__global__ void __launch_bounds__(256) k_ln2(Params p) {
    __shared__ ClassTab tabs; if (threadIdx.x == 0) class_tab_fill(WSP(unsigned, WS_CTL) + CW_CNT, &tabs); __syncthreads(); const ClassTab* tab = &tabs;
    const int lane = threadIdx.x & 63; const int prow = blockIdx.x * 4 + (threadIdx.x >> 6);
    if (prow >= tab->rowbase[NCLS]) return;
    const int cls = find_class(tab, prow); const int i = prow - tab->rowbase[cls]; if (i >= tab->cnt[cls]) return;
    const int tk[1] = {WSP(int, WS_LIST)[(size_t)cls * T + i]}, pr[1] = {prow};
    ln2_rows<1>(p, tk, pr, lane);
}


#define LAS __attribute__((address_space(3)))
#define GAS __attribute__((address_space(1)))
constexpr int RING_OFF = 0, RING_BYTES = 131072;
constexpr int LCTL_OFF = RING_BYTES;
constexpr int LTOK_OFF = LCTL_OFF + 4096, MAXU = 16;
constexpr int LDS_BYTES = LTOK_OFF + MAXU * 1024;
constexpr int NTHR = 512, NWAVES = 8;

namespace pg8 {
typedef short bf16x8 __attribute__((ext_vector_type(8)));
typedef int v4i_t __attribute__((ext_vector_type(4)));
typedef int v8i_t __attribute__((ext_vector_type(8)));
constexpr int BM = 256, BK = 64, HALF = 128, HTB = HALF * BK * 2, NXCD = 8, WGM = 8;
__host__ __device__ __forceinline__ int lds_byte(int r, int c) { const int st = (r >> 4) * 2 + (c >> 5), rr = r & 15, cc = c & 31, ob = rr * 64 + cc * 2; return st * 1024 + (ob ^ (((ob >> 9) & 1) << 5)); }
__host__ __device__ __forceinline__ void stage_rc(int b, int& R, int& C) { const int st = b / 1024, sb = b % 1024, swz = sb ^ (((sb >> 9) & 1) << 5); R = (st >> 1) * 16 + swz / 64; C = (st & 1) * 32 + (swz % 64) / 2; }
__host__ __device__ __forceinline__ int perm32(int rho) { const int n = rho >> 4, i = rho & 15; return 8 * (i >> 2) + 4 * n + (i & 3); }

struct Unit { const char* A; const char* B; int row0, col0, bjump, aux; };
struct TileOrder {
    int nM, nN, nwg, G, c;
    __device__ __forceinline__ void init(int nM_, int nN_, int G_, int c_) { nM = nM_; nN = nN_; nwg = nM * nN; G = G_; c = c_; }
    __device__ __forceinline__ bool tile(int i, int& pm, int& pn) const {
        const long L = (long)i * G + c; if (L >= nwg) return false;
        int wgid = (int)L; { const int q = nwg / NXCD, r = nwg % NXCD, xcd = wgid % NXCD, off = wgid / NXCD; wgid = (xcd < r ? xcd * (q + 1) : r * (q + 1) + (xcd - r) * q) + off; }
        const int nig = WGM * nN, gid = wgid / nig, fm = gid * WGM, gsz = (nM - fm) < WGM ? (nM - fm) : WGM;
        pm = fm + ((wgid % nig) % gsz); pn = (wgid % nig) / gsz; return true;
    }
};
__device__ __forceinline__ unsigned cvt_pk_bf16(float lo, float hi) { unsigned r; asm volatile("v_cvt_pk_bf16_f32 %0, %1, %2" : "=v"(r) : "v"(lo), "v"(hi)); return r; }

template <class EF> struct EpiRows {
    static constexpr bool PERM = true;
    EF ef;
    __device__ __forceinline__ bool keep_acc(const Unit&) const { return false; }
    __device__ __forceinline__ void operator()(f32x4 (&acc)[2][2][4][2], const Unit& u, int wr, int wc, int fr, int fq) const {
#pragma unroll
        for (int ai = 0; ai < 2; ++ai)
#pragma unroll
            for (int m = 0; m < 4; ++m) { const int row = u.row0 + ai * HALF + wr * 64 + m * 16 + fr;
#pragma unroll
                for (int bj = 0; bj < 2; ++bj) { const int c0 = u.col0 + bj * HALF + wc * 32 + 8 * fq;
                    float v[8] = {acc[ai][bj][m][0][0], acc[ai][bj][m][0][1], acc[ai][bj][m][0][2], acc[ai][bj][m][0][3], acc[ai][bj][m][1][0], acc[ai][bj][m][1][1], acc[ai][bj][m][1][2], acc[ai][bj][m][1][3]};
                    ef(u, row, c0, v); }
                asm volatile("" ::: "memory"); }
    }
};

template <class Epi, class Sched, bool ALIGN_EPI, bool GATHER, bool BJUMP, bool FP8 = false>
__device__ __forceinline__ void gemm_phase(LAS unsigned char* lds, const char* Abase, int lda, int ldb, int K, const Sched& S, const Epi& E, int wave_s) {
    const int tid = opaque_tid(wave_s), wid = __builtin_amdgcn_readfirstlane(tid >> 6), lane = tid & 63, wr = wid >> 2, wc = wid & 3, fr = lane & 15, fq = lane >> 4;
    const int nt = K / BK;
    unsigned voffA[2], voffB[2]; unsigned voffG[2][2], nvoffG[2][2];
#pragma unroll
    for (int i = 0; i < 2; ++i) { int R, C; stage_rc(tid * 16 + i * 8192, R, C); const int Rb = Epi::PERM ? ((R & ~31) + perm32(R & 31)) : R;
        voffA[i] = (unsigned)(R * lda + C) * 2u; voffB[i] = (unsigned)(Rb * ldb + C) * 2u; voffG[0][i] = voffG[1][i] = nvoffG[0][i] = nvoffG[1][i] = 0u; }
    const size_t kstep = (size_t)(BK * 2);
    const size_t hstepA = (size_t)HALF * lda * 2, hstepB = (size_t)HALF * ldb * 2;
    const unsigned ldsw = (unsigned)wid * 1024u;
    const int aoff = lds_byte(wr * 64 + fr, fq * 8), boff = lds_byte(wc * 32 + fr, fq * 8);
#define PG8_SA(b, h) (((b) * 2 + (h)) * HTB)
#define PG8_SB(b, h) ((4 + (b) * 2 + (h)) * HTB)
#define PG8_GLDS(gptr, ldsoff) __builtin_amdgcn_global_load_lds((const unsigned*)(gptr), (LAS unsigned*)(lds + (ldsoff)), 16, 0, 0)
#define PG8_STAGE_B(bufoff, gbase) do { _Pragma("unroll") for (int _i = 0; _i < 2; ++_i) PG8_GLDS((const char*)(gbase) + voffB[_i], (bufoff) + ldsw + _i * 8192); } while (0)
#define PG8_STAGE_A(bufoff, kptr, h, nx) do { if constexpr (GATHER) { _Pragma("unroll") for (int _i = 0; _i < 2; ++_i) PG8_GLDS((const char*)(kptr) + ((nx) ? nvoffG[h][_i] : voffG[h][_i]), (bufoff) + ldsw + _i * 8192); } \
        else { _Pragma("unroll") for (int _i = 0; _i < 2; ++_i) PG8_GLDS((const char*)(kptr) + (h) * hstepA + voffA[_i], (bufoff) + ldsw + _i * 8192); } } while (0)
#define PG8_GATHER_OFFS(dst, ord) do { LAS const int* _tk = S.toks(ord); _Pragma("unroll") for (int _h = 0; _h < 2; ++_h) _Pragma("unroll") for (int _i = 0; _i < 2; ++_i) { int _R, _C; stage_rc(tid * 16 + _i * 8192, _R, _C); \
        dst[_h][_i] = (unsigned)_tk[_h * HALF + _R] * (unsigned)(lda * 2) + (unsigned)(_C * 2); } } while (0)
#define PG8_LDA(dst, b, h) do { _Pragma("unroll") for (int m = 0; m < 4; ++m) _Pragma("unroll") for (int k = 0; k < 2; ++k) dst[m][k] = *(const LAS bf16x8*)(lds + PG8_SA(b, h) + aoff + m * 2048 + k * 1024); } while (0)
#define PG8_LDB(dst, b, h) do { _Pragma("unroll") for (int n = 0; n < 2; ++n) _Pragma("unroll") for (int k = 0; k < 2; ++k) dst[n][k] = *(const LAS bf16x8*)(lds + PG8_SB(b, h) + boff + n * 2048 + k * 1024); } while (0)
#define PG8_CAT8(lo, hi) __builtin_shufflevector(__builtin_bit_cast(v4i_t, lo), __builtin_bit_cast(v4i_t, hi), 0, 1, 2, 3, 4, 5, 6, 7)
#define PG8_MMA(ai, bj, At, Bt) do { __builtin_amdgcn_s_setprio(1); if constexpr (FP8) { _Pragma("unroll") for (int m = 0; m < 4; ++m) _Pragma("unroll") for (int n = 0; n < 2; ++n) \
        { const v8i_t b8_ = PG8_CAT8(Bt[n][0], Bt[n][1]), a8_ = PG8_CAT8(At[m][0], At[m][1]); asm volatile("v_mfma_f32_16x16x128_f8f6f4 %0, %1, %2, %0" : "+v"(acc[ai][bj][m][n]) : "v"(b8_), "v"(a8_)); } } \
        else { _Pragma("unroll") for (int m = 0; m < 4; ++m) _Pragma("unroll") for (int n = 0; n < 2; ++n) _Pragma("unroll") for (int k = 0; k < 2; ++k) \
        acc[ai][bj][m][n] = __builtin_amdgcn_mfma_f32_16x16x32_bf16(Bt[n][k], At[m][k], acc[ai][bj][m][n], 0, 0, 0); } __builtin_amdgcn_s_setprio(0); } while (0)
#define PG8_WAIT_V(n) asm volatile("s_waitcnt vmcnt(" #n ")" ::: "memory")
#define PG8_WAIT_L(n) asm volatile("s_waitcnt lgkmcnt(" #n ")" ::: "memory")
#define PG8_BAR __builtin_amdgcn_s_barrier()
#define PG8_SCHED __builtin_amdgcn_sched_barrier(0)
    Unit cur, nxt; int ui = 0;
    if (!S.next(0, cur)) return;
    f32x4 acc[2][2][4][2];
#pragma unroll
    for (int a = 0; a < 2; ++a)
#pragma unroll
        for (int b = 0; b < 2; ++b)
#pragma unroll
            for (int m = 0; m < 4; ++m)
#pragma unroll
                for (int n = 0; n < 2; ++n) acc[a][b][m][n] = (f32x4){0.f, 0.f, 0.f, 0.f};
    bf16x8 At[4][2], B0[2][2], B1[2][2];
    const char* cA = GATHER ? Abase : cur.A; const char* cB = cur.B;
    if constexpr (GATHER) PG8_GATHER_OFFS(voffG, 0);
    PG8_STAGE_B(PG8_SB(0, 0), cB); PG8_STAGE_B(PG8_SB(0, 1), cB + hstepB); PG8_STAGE_A(PG8_SA(0, 0), cA, 0, false); PG8_STAGE_A(PG8_SA(0, 1), cA, 1, false);
    if (wr == 1) PG8_BAR;
    PG8_WAIT_V(2); PG8_BAR;
    PG8_STAGE_B(PG8_SB(1, 0), cB + kstep); PG8_STAGE_A(PG8_SA(1, 0), cA + kstep, 0, false); PG8_STAGE_B(PG8_SB(1, 1), cB + hstepB + kstep);
    PG8_WAIT_V(6); PG8_BAR;
    for (;;) {
        const bool has_next = S.next(ui + 1, nxt);
        if constexpr (GATHER) { if (has_next) PG8_GATHER_OFFS(nvoffG, ui + 1); else {
#pragma unroll
            for (int h = 0; h < 2; ++h)
#pragma unroll
                for (int i = 0; i < 2; ++i) nvoffG[h][i] = voffG[h][i]; } }
        const char* nA = GATHER ? Abase : (has_next ? nxt.A : cA); const char* nB = has_next ? nxt.B : cB;
#pragma nounroll
        for (int t = 0; t < nt; t += 2) {
            const bool last = (t == nt - 2);
            const char* a1 = cA + (size_t)(t + 1) * kstep;
            const char* a2 = last ? nA : cA + (size_t)(t + 2) * kstep;
            const char* b2 = last ? nB : cB + (size_t)(t + 2) * kstep + ((BJUMP && (t + 2) >= (nt >> 1)) ? cur.bjump : 0);
            const char* a3 = a2 + kstep; const char* b3 = b2 + kstep;
            PG8_LDB(B0, 0, 0); PG8_LDB(B1, 0, 1); PG8_SCHED; PG8_LDA(At, 0, 0); PG8_STAGE_A(PG8_SA(1, 1), a1, 1, false);
            PG8_WAIT_V(8); PG8_WAIT_L(0); PG8_BAR; PG8_MMA(0, 0, At, B0); PG8_MMA(0, 1, At, B1); PG8_BAR; PG8_SCHED;
            PG8_LDA(At, 0, 1); PG8_STAGE_B(PG8_SB(0, 0), b2); PG8_STAGE_B(PG8_SB(0, 1), b2 + hstepB); PG8_STAGE_A(PG8_SA(0, 0), a2, 0, last);
            PG8_WAIT_V(8); PG8_WAIT_L(0); PG8_BAR; PG8_MMA(1, 0, At, B0); PG8_MMA(1, 1, At, B1); PG8_BAR; PG8_SCHED;
            PG8_LDB(B0, 1, 0); PG8_LDB(B1, 1, 1); PG8_SCHED; PG8_LDA(At, 1, 0); PG8_STAGE_A(PG8_SA(0, 1), a2, 1, last);
            PG8_WAIT_V(8); PG8_WAIT_L(0); PG8_BAR; PG8_MMA(0, 0, At, B0); PG8_MMA(0, 1, At, B1); PG8_BAR; PG8_SCHED;
            PG8_LDA(At, 1, 1); PG8_STAGE_B(PG8_SB(1, 0), b3); PG8_STAGE_B(PG8_SB(1, 1), b3 + hstepB); PG8_STAGE_A(PG8_SA(1, 0), a3, 0, last);
            PG8_WAIT_V(8); PG8_WAIT_L(0); PG8_BAR; PG8_MMA(1, 0, At, B0); PG8_MMA(1, 1, At, B1); PG8_BAR; PG8_SCHED;
        }
        if constexpr (ALIGN_EPI) { if (wr == 0) PG8_BAR; }
        if constexpr (FP8) { asm volatile("s_nop 15\n\ts_nop 15" ::: "memory"); PG8_SCHED; }
        E(acc, cur, wr, wc, fr, fq);
        if (!has_next) break;
        if (!E.keep_acc(cur)) {
#pragma unroll
        for (int a = 0; a < 2; ++a)
#pragma unroll
            for (int b = 0; b < 2; ++b)
#pragma unroll
                for (int m = 0; m < 4; ++m)
#pragma unroll
                    for (int n = 0; n < 2; ++n) acc[a][b][m][n] = (f32x4){0.f, 0.f, 0.f, 0.f}; }
        cur = nxt; cA = nA; cB = nB; ++ui;
        if constexpr (GATHER) {
#pragma unroll
            for (int h = 0; h < 2; ++h)
#pragma unroll
                for (int i = 0; i < 2; ++i) voffG[h][i] = nvoffG[h][i]; }
        if constexpr (ALIGN_EPI) { if (wr == 1) PG8_BAR; }
    }
    PG8_WAIT_V(0);
    if constexpr (!ALIGN_EPI) { if (wr == 0) PG8_BAR; }
    PG8_BAR;
#undef PG8_SA
#undef PG8_SB
#undef PG8_GLDS
#undef PG8_STAGE_A
#undef PG8_STAGE_B
#undef PG8_GATHER_OFFS
#undef PG8_LDA
#undef PG8_LDB
#undef PG8_MMA
#undef PG8_CAT8
#undef PG8_WAIT_V
#undef PG8_WAIT_L
#undef PG8_BAR
#undef PG8_SCHED
}
}

namespace swa {
typedef short bf16x8 __attribute__((ext_vector_type(8)));
typedef short s16x4 __attribute__((ext_vector_type(4)));
typedef float f32x16 __attribute__((ext_vector_type(16)));
constexpr int DH = 128, NW = 8, QBLK = 32, KVBLK = 64, QB = NW * QBLK;
constexpr int SHM_V = KVBLK * DH * 2, SHM_K = KVBLK * DH * 2;
constexpr int LDS_NEED = 2 * SHM_V + 2 * SHM_K + NW * 64 * 4;
constexpr float SCALE = 0.08838834764831845f, THR = 8.f;
#define KSWZ(row, colB) ((row) * 256 + ((colB) ^ (((row) & 7) << 4)))
#define SBAR() __builtin_amdgcn_sched_barrier(0)
__device__ __forceinline__ int v_st(int k, int c) { const int kk = (k & ~0xC) | ((k & 4) << 1) | ((k & 8) >> 1); return ((kk >> 3) * 4 + (c >> 5)) * 512 + ((kk & 7) * 32 + (c & 31)) * 2; }
__device__ __forceinline__ int v_rd_base(int lane) { return ((lane & 3) << 3) | (((lane >> 2) & 3) << 6) | (((lane >> 4) & 1) << 5) | (((lane >> 5) & 1) << 8); }
constexpr int v_rd_off(int d0, int ks, int half) { return d0 * 512 + ks * 4096 + half * 2048; }
__device__ __forceinline__ int crow(int r, int hi) { return (r & 3) + 8 * (r >> 2) + 4 * hi; }
__device__ __forceinline__ unsigned cvtpk(float lo, float hi) { unsigned r; asm volatile("v_cvt_pk_bf16_f32 %0, %1, %2" : "=v"(r) : "v"(lo), "v"(hi)); return r; }
__device__ __forceinline__ bf16x8 load8(const bf16_t* p) { return *reinterpret_cast<const bf16x8*>(p); }
__device__ __forceinline__ void mask_tile(f32x16& p0, f32x16& p1, int dq, unsigned W) {
    const float NEG = -__builtin_inff();
#pragma unroll
    for (int r = 0; r < 16; ++r) {
        const int c = (r & 3) + 8 * (r >> 2);
        if ((unsigned)(dq - c) >= W) p0[r] = NEG;
        if ((unsigned)(dq - c - 32) >= W) p1[r] = NEG;
    }
}
__device__ __forceinline__ void partialSM(f32x16& p0, f32x16& p1, float& m_reg, float& mn, float& alpha) {
    float pmax = p0[0]; for (int r = 1; r < 16; ++r) pmax = fmaxf(pmax, p0[r]); for (int r = 0; r < 16; ++r) pmax = fmaxf(pmax, p1[r]);
    { auto rr = __builtin_amdgcn_permlane32_swap(__float_as_uint(pmax), __float_as_uint(pmax), false, false);
      pmax = fmaxf(__uint_as_float(rr[0]), __uint_as_float(rr[1])); }
    constexpr float C2 = 1.4426950408889634f * SCALE;
    if (__builtin_expect(__all((pmax - m_reg) * SCALE <= THR), 1)) { mn = m_reg; alpha = 1.f; }
    else { mn = fmaxf(m_reg, pmax); alpha = __builtin_amdgcn_exp2f((m_reg - mn) * C2); m_reg = mn; }
    const float mnL = -mn * C2;
    for (int r = 0; r < 16; ++r) p0[r] = fmaf(p0[r], C2, mnL); for (int r = 0; r < 16; ++r) p1[r] = fmaf(p1[r], C2, mnL);
    for (int r = 0; r < 16; ++r) p0[r] = __builtin_amdgcn_exp2f(p0[r]);
}
__device__ __forceinline__ void finishSM(f32x16& p0, f32x16& p1, float alpha, float& l_reg, bf16x8& pa0, bf16x8& pa1, bf16x8& pa2, bf16x8& pa3) {
    for (int r = 0; r < 16; ++r) p1[r] = __builtin_amdgcn_exp2f(p1[r]);
    float ps = 0; for (int r = 0; r < 16; ++r) ps += p0[r]; for (int r = 0; r < 16; ++r) ps += p1[r];
    { auto rr = __builtin_amdgcn_permlane32_swap(__float_as_uint(ps), __float_as_uint(ps), false, false);
      ps = __uint_as_float(rr[0]) + __uint_as_float(rr[1]); }
    l_reg = l_reg * alpha + ps;
#define PK4(P, B_, OUT) do { unsigned a0 = cvtpk(P[B_+0], P[B_+1]), a1 = cvtpk(P[B_+2], P[B_+3]);                          \
        unsigned b0 = cvtpk(P[B_+4], P[B_+5]), b1 = cvtpk(P[B_+6], P[B_+7]);                                             \
        auto r0 = __builtin_amdgcn_permlane32_swap(a0, b0, false, false); auto r1 = __builtin_amdgcn_permlane32_swap(a1, b1, false, false); \
        u32x4 w = {r0[0], r1[0], r0[1], r1[1]}; OUT = *reinterpret_cast<bf16x8*>(&w); } while (0)
    PK4(p0, 0, pa0); PK4(p0, 8, pa1); PK4(p1, 0, pa2); PK4(p1, 8, pa3);
#undef PK4
}
template <int KB>
__device__ __forceinline__ void qkt(f32x16& p0, f32x16& p1, const char* K_lds, int r32, int hi, const bf16x8* qr, bool act) {
    if (!act) { const float NEG = -__builtin_inff();
#pragma unroll
        for (int r = 0; r < 16; ++r) { p0[r] = NEG; p1[r] = NEG; } return; }
    p0 = f32x16{}; p1 = f32x16{};
    const char* kb[4];
#pragma unroll
    for (int dd = 0; dd < 4; ++dd) kb[dd] = K_lds + KB * SHM_K + KSWZ(r32, (dd * 16 + hi * 8) * 2);
#pragma unroll
    for (int d0 = 0; d0 < 8; ++d0) { const char* a = kb[d0 & 3] + (d0 >> 2) * 128;
        bf16x8 b0 = *reinterpret_cast<const bf16x8*>(a);
        bf16x8 b1 = *reinterpret_cast<const bf16x8*>(a + 32 * 256);
        p0 = __builtin_amdgcn_mfma_f32_32x32x16_bf16(b0, qr[d0], p0, 0, 0, 0);
        p1 = __builtin_amdgcn_mfma_f32_32x32x16_bf16(b1, qr[d0], p1, 0, 0, 0); }
}
template <int VB>
__device__ __forceinline__ void pv_tile(f32x16* o, int vb0, bf16x8 pa0, bf16x8 pa1, bf16x8 pa2, bf16x8 pa3, bool act) {
    if (!act) return;
#define TRRD(dst, off) asm volatile("ds_read_b64_tr_b16 %0, %1 offset:%2" : "=&v"(dst) : "v"(vb0), "i"(off) : "memory")
#define PV_D0(d0) do { s16x4 l0, l1, l2, l3, h0, h1, h2, h3; constexpr int b_ = VB * SHM_V + v_rd_off(d0, 0, 0); \
        TRRD(l0, b_); TRRD(h0, b_ + 2048); TRRD(l1, b_ + 4096); TRRD(h1, b_ + 6144); TRRD(l2, b_ + 8192); TRRD(h2, b_ + 10240); TRRD(l3, b_ + 12288); TRRD(h3, b_ + 14336); \
        asm volatile("s_waitcnt lgkmcnt(0)" ::: "memory"); SBAR();   \
        o[d0] = __builtin_amdgcn_mfma_f32_32x32x16_bf16(pa0, (bf16x8){l0[0], l0[1], l0[2], l0[3], h0[0], h0[1], h0[2], h0[3]}, o[d0], 0, 0, 0);   \
        o[d0] = __builtin_amdgcn_mfma_f32_32x32x16_bf16(pa1, (bf16x8){l1[0], l1[1], l1[2], l1[3], h1[0], h1[1], h1[2], h1[3]}, o[d0], 0, 0, 0);   \
        o[d0] = __builtin_amdgcn_mfma_f32_32x32x16_bf16(pa2, (bf16x8){l2[0], l2[1], l2[2], l2[3], h2[0], h2[1], h2[2], h2[3]}, o[d0], 0, 0, 0);   \
        o[d0] = __builtin_amdgcn_mfma_f32_32x32x16_bf16(pa3, (bf16x8){l3[0], l3[1], l3[2], l3[3], h3[0], h3[1], h3[2], h3[3]}, o[d0], 0, 0, 0); } while (0)
    PV_D0(0); PV_D0(1); PV_D0(2); PV_D0(3);
#undef PV_D0
#undef TRRD
}
struct BlockRef { const bf16_t* Q; const bf16_t* K; const bf16_t* V; bf16_t* O; float* LSE; int P0, W, segmask, skv, ostride; };
struct Seam { bf16x8 qr[8]; bf16x8 st_v0, st_v1, st_k0, st_k1; };
__device__ __forceinline__ int imax(int a, int b) { return a > b ? a : b; }
__device__ __forceinline__ int blk_jlo(const BlockRef& b) { const int lowk = imax(b.P0 - b.W + 1, b.P0 & ~b.segmask); return lowk > 0 ? lowk / KVBLK : 0; }
#define ROW(p, k0, rr) ((p) + (size_t)((k0) + (rr)) * DH + sc)
#define VMW() asm volatile("s_waitcnt vmcnt(0)" ::: "memory")
#define VMWN(n) asm volatile("s_waitcnt vmcnt(%0)" :: "i"(n) : "memory")
#define SLOAD_H(Kp, Vp, k0) do { S.st_v0 = load8(ROW(Vp, k0, sr)); S.st_v1 = load8(ROW(Vp, k0, 32 + sr));              \
                         S.st_k0 = load8(ROW(Kp, k0, sr)); S.st_k1 = load8(ROW(Kp, k0, 32 + sr)); } while (0)
#define SWRITE_HK(bf) do { *(bf16x8*)(K_lds + (bf) * SHM_K + kws) = S.st_k0; *(bf16x8*)(K_lds + (bf) * SHM_K + kws + 32 * 256) = S.st_k1; } while (0)
#define SWRITE_HV(bf) do { *(bf16x8*)(V_lds + (bf) * SHM_V + vst0) = S.st_v0; *(bf16x8*)(V_lds + (bf) * SHM_V + vst1) = S.st_v1; } while (0)
#define SWRITE_H(bf) do { SWRITE_HV(bf); SWRITE_HK(bf); } while (0)
__device__ __forceinline__ void prime(const BlockRef& cur, char* lds, Seam& S, int wave_s) {
    const int tid = opaque_tid(wave_s), wid = __builtin_amdgcn_readfirstlane(tid >> 6), lane = tid & 63, r32 = lane & 31, hi = lane >> 5;
    const int sr = tid >> 4, sc = (tid & 15) * 8, kws = KSWZ(sr, sc * 2); char* K_lds = lds + 2 * SHM_V;
    const int kb0 = blk_jlo(cur) * KVBLK;
    for (int d0 = 0; d0 < 8; ++d0) S.qr[d0] = load8(cur.Q + (size_t)(wid * QBLK + r32) * DH + d0 * 16 + hi * 8);
    SLOAD_H(cur.K, cur.V, kb0); VMW(); SWRITE_HK(0);
    __syncthreads();
}
__device__ __forceinline__ void block(const BlockRef& cur, const BlockRef& nxt, char* lds, Seam& S, int wave_s) {
    const int tid = opaque_tid(wave_s), wid = __builtin_amdgcn_readfirstlane(tid >> 6), lane = tid & 63, r32 = lane & 31, hi = lane >> 5;
    const int W = cur.W;
    const int j_lo = blk_jlo(cur);
    int j_hi = (cur.P0 + QB - 1) / KVBLK + 1; if (j_hi > cur.skv / KVBLK) j_hi = cur.skv / KVBLK;
    const int NT = j_hi - j_lo;
    const int kbn = blk_jlo(nxt) * KVBLK;
    const int qlo = cur.P0 + wid * QBLK, qm = qlo + r32 - 4 * hi;
    const int segb = qlo & ~cur.segmask;
    const int lowk_w = imax(qlo - W + 1, segb);
    const int lowk_last = imax(qlo + QBLK - W, segb);
    const int wrow = ((qlo + r32) & cur.segmask) + 1;
    const unsigned Wl = (unsigned)(wrow < W ? wrow : W);
    char* V_lds = lds; char* K_lds = lds + 2 * SHM_V;
    float* ws = (float*)(lds + 2 * SHM_V + 2 * SHM_K) + wid * 64; float* li_l = ws, * al_l = ws + 32;
    float m_reg = -1e30f, l_reg = 0; f32x16 o[4] = {};
    const int sr = tid >> 4, sc = (tid & 15) * 8, vst0 = v_st(sr, sc), vst1 = v_st(32 + sr, sc), kws = KSWZ(sr, sc * 2);
    const int vb0 = (int)(uintptr_t)V_lds + v_rd_base(lane);
    const bf16_t* Kh = cur.K; const bf16_t* Vh = cur.V;
#define RESC(a) do { if (__any((a) < 1.f)) { if (hi == 0) al_l[r32] = (a); asm volatile("s_waitcnt lgkmcnt(0)" ::: "memory");              \
                     for (int d_ = 0; d_ < 4; ++d_) for (int r = 0; r < 16; ++r) o[d_][r] *= al_l[crow(r, hi)]; } } while (0)
#define KBASE(t) ((j_lo + (t)) * KVBLK)
#define ACT(t) (KBASE(t) <= qlo + QBLK - 1 && KBASE(t) + KVBLK - 1 >= lowk_w)
#define MASKT(P0_, P1_, t) do { const int kb_ = KBASE(t); if (ACT(t) && (kb_ + KVBLK - 1 > qlo || kb_ < lowk_last)) mask_tile(P0_, P1_, qm - kb_, Wl); } while (0)
    constexpr int NQL = 8;
#define SEAM_K0() do { VMWN(NQL); SWRITE_HK(0); SBAR(); } while (0)
    f32x16 pA0, pA1, pB0, pB1; float mnA, mnB, alA, alB; bf16x8 pa0, pa1, pa2, pa3;
    SWRITE_HV(0); SBAR();
    if (NT > 1) { SLOAD_H(Kh, Vh, KBASE(1)); }
    SBAR(); qkt<0>(pA0, pA1, K_lds, r32, hi, S.qr, ACT(0));
    MASKT(pA0, pA1, 0); partialSM(pA0, pA1, m_reg, mnA, alA);
    if (NT > 1) { VMW(); SWRITE_H(1); }
    __syncthreads();
#define HALF_STEP(PX0, PX1, mnX, alX, PY0, PY1, alY, t, KB, VB, SB) do {                                                      \
        SBAR(); if ((t) + 1 < NT) { SLOAD_H(Kh, Vh, KBASE((t) + 1)); SBAR(); }                                       \
        qkt<KB>(PX0, PX1, K_lds, r32, hi, S.qr, ACT(t));                                             \
        finishSM(PY0, PY1, alY, l_reg, pa0, pa1, pa2, pa3); SBAR();                                                           \
        pv_tile<VB>(o, vb0, pa0, pa1, pa2, pa3, ACT((t) - 1)); MASKT(PX0, PX1, (t)); partialSM(PX0, PX1, m_reg, mnX, alX);                                        \
        __syncthreads();                                                                                                      \
        if ((t) + 1 < NT) { VMW(); SWRITE_H(SB); }                                                                          \
        RESC(alX); __syncthreads(); } while (0)
    for (int t = 1; t + 1 < NT; t += 2) {
        HALF_STEP(pB0, pB1, mnB, alB, pA0, pA1, alA, t, 1, 0, 0);
        HALF_STEP(pA0, pA1, mnA, alA, pB0, pB1, alB, t + 1, 0, 1, 1);
    }
    const bool even = (NT & 1) == 0;
    if (even) { SBAR(); qkt<1>(pB0, pB1, K_lds, r32, hi, S.qr, ACT(NT - 1)); SBAR(); }
    SLOAD_H(nxt.K, nxt.V, kbn); SBAR();
#pragma unroll
    for (int d0 = 0; d0 < 8; ++d0) S.qr[d0] = load8(nxt.Q + (size_t)(wid * QBLK + r32) * DH + d0 * 16 + hi * 8);
    SBAR();
    finishSM(pA0, pA1, alA, l_reg, pa0, pa1, pa2, pa3); SBAR();
    pv_tile<0>(o, vb0, pa0, pa1, pa2, pa3, ACT(even ? NT - 2 : NT - 1));
    if (even) { MASKT(pB0, pB1, NT - 1); partialSM(pB0, pB1, m_reg, mnB, alB); __syncthreads(); RESC(alB);
        finishSM(pB0, pB1, alB, l_reg, pa0, pa1, pa2, pa3); SBAR(); pv_tile<1>(o, vb0, pa0, pa1, pa2, pa3, ACT(NT - 1)); }
    SBAR(); SEAM_K0();
    if (hi == 0) li_l[r32] = l_reg; asm volatile("s_waitcnt lgkmcnt(0)" ::: "memory");
    if (cur.LSE != nullptr && hi == 0) cur.LSE[wid * QBLK + r32] = m_reg * SCALE + __logf(l_reg);
    float rli[16];
#pragma unroll
    for (int r = 0; r < 16; ++r) rli[r] = __builtin_amdgcn_rcpf(li_l[crow(r, hi)]);
    bf16_t* Ow = cur.O + (size_t)(wid * QBLK) * cur.ostride;
#pragma unroll
    for (int r = 0; r < 16; ++r) { const int orow = crow(r, hi);
#pragma unroll
        for (int d0 = 0; d0 < 4; ++d0) { const float v = o[d0][r] * rli[r];
            const float vn = __shfl_xor(v, 1);
            if ((r32 & 1) == 0) *(unsigned*)(Ow + (size_t)orow * cur.ostride + d0 * 32 + r32) = cvtpk(v, vn); } }
    __syncthreads();
#undef RESC
#undef KBASE
#undef ACT
#undef MASKT
#undef SEAM_K0
#undef HALF_STEP
}

constexpr int RING_V = 4 * SHM_K;
__device__ __forceinline__ void qkt_rt(f32x16& p0, f32x16& p1, const LAS char* Kslot, int r32, int hi, const bf16x8* qr) {
    p0 = f32x16{}; p1 = f32x16{};
    const LAS char* kb[4];
#pragma unroll
    for (int dd = 0; dd < 4; ++dd) kb[dd] = Kslot + KSWZ(r32, (dd * 16 + hi * 8) * 2);
#pragma unroll
    for (int d0 = 0; d0 < 8; ++d0) { const LAS char* a = kb[d0 & 3] + (d0 >> 2) * 128;
        bf16x8 b0 = *(const LAS bf16x8*)(a);
        bf16x8 b1 = *(const LAS bf16x8*)(a + 32 * 256);
        p0 = __builtin_amdgcn_mfma_f32_32x32x16_bf16(b0, qr[d0], p0, 0, 0, 0);
        p1 = __builtin_amdgcn_mfma_f32_32x32x16_bf16(b1, qr[d0], p1, 0, 0, 0); }
}
__device__ __forceinline__ void pv_rt(f32x16* o, int vb, bf16x8 pa0, bf16x8 pa1, bf16x8 pa2, bf16x8 pa3) {
#define TRRD(dst, off) asm volatile("ds_read_b64_tr_b16 %0, %1 offset:%2" : "=&v"(dst) : "v"(vb), "i"(off) : "memory")
#define PV_D0(d0) do { s16x4 l0, l1, l2, l3, h0, h1, h2, h3; constexpr int b_ = v_rd_off(d0, 0, 0); \
        TRRD(l0, b_); TRRD(h0, b_ + 2048); TRRD(l1, b_ + 4096); TRRD(h1, b_ + 6144); TRRD(l2, b_ + 8192); TRRD(h2, b_ + 10240); TRRD(l3, b_ + 12288); TRRD(h3, b_ + 14336); \
        asm volatile("s_waitcnt lgkmcnt(0)" ::: "memory"); SBAR();   \
        o[d0] = __builtin_amdgcn_mfma_f32_32x32x16_bf16((bf16x8){l0[0], l0[1], l0[2], l0[3], h0[0], h0[1], h0[2], h0[3]}, pa0, o[d0], 0, 0, 0);   \
        o[d0] = __builtin_amdgcn_mfma_f32_32x32x16_bf16((bf16x8){l1[0], l1[1], l1[2], l1[3], h1[0], h1[1], h1[2], h1[3]}, pa1, o[d0], 0, 0, 0);   \
        o[d0] = __builtin_amdgcn_mfma_f32_32x32x16_bf16((bf16x8){l2[0], l2[1], l2[2], l2[3], h2[0], h2[1], h2[2], h2[3]}, pa2, o[d0], 0, 0, 0);   \
        o[d0] = __builtin_amdgcn_mfma_f32_32x32x16_bf16((bf16x8){l3[0], l3[1], l3[2], l3[3], h3[0], h3[1], h3[2], h3[3]}, pa3, o[d0], 0, 0, 0); } while (0)
    PV_D0(0); PV_D0(1); PV_D0(2); PV_D0(3);
#undef PV_D0
#undef TRRD
}
struct WaveState { float m, l; f32x16 o[4]; };
__device__ __forceinline__ void tile_step(WaveState& st, const bf16x8* qr, const LAS char* lds, int slot, int r32, int hi, int lane, bool need_mask, int dq, unsigned Wl) {
    f32x16 p0, p1; float mn, alpha; bf16x8 pa0, pa1, pa2, pa3;
    qkt_rt(p0, p1, lds + slot * SHM_K, r32, hi, qr);
    if (need_mask) mask_tile(p0, p1, dq, Wl);
    partialSM(p0, p1, st.m, mn, alpha);
    if (__any(alpha < 1.f)) {
#pragma unroll
        for (int d_ = 0; d_ < 4; ++d_)
#pragma unroll
            for (int r = 0; r < 16; ++r) st.o[d_][r] *= alpha; }
    finishSM(p0, p1, alpha, st.l, pa0, pa1, pa2, pa3); SBAR();
    pv_rt(st.o, (int)(unsigned)(uintptr_t)(lds + RING_V + slot * SHM_V) + v_rd_base(lane), pa0, pa1, pa2, pa3);
}
__device__ __forceinline__ void wave_store(const WaveState& st, bf16_t* Ow, int ostride, float* lse, int r32, int hi) {
    if (lse != nullptr && hi == 0) lse[r32] = st.m * SCALE + __logf(st.l);
    const float rl = __builtin_amdgcn_rcpf(st.l);
    bf16_t* rowp = Ow + (size_t)r32 * ostride + hi * 8;
#pragma unroll
    for (int d0 = 0; d0 < 4; ++d0)
#pragma unroll
        for (int k = 0; k < 4; k += 2) {
            unsigned ax = cvtpk(st.o[d0][4 * k] * rl, st.o[d0][4 * k + 1] * rl), ay = cvtpk(st.o[d0][4 * k + 2] * rl, st.o[d0][4 * k + 3] * rl);
            unsigned bx = cvtpk(st.o[d0][4 * k + 4] * rl, st.o[d0][4 * k + 5] * rl), by = cvtpk(st.o[d0][4 * k + 6] * rl, st.o[d0][4 * k + 7] * rl);
            { auto r = __builtin_amdgcn_permlane32_swap(ax, bx, false, false); ax = r[0]; bx = r[1]; }
            { auto r = __builtin_amdgcn_permlane32_swap(ay, by, false, false); ay = r[0]; by = r[1]; }
            *(u32x4*)(rowp + d0 * 32 + 8 * k) = (u32x4){ax, ay, bx, by};
        }
}
__device__ __forceinline__ void wave_reset(WaveState& st) { st.m = -1e30f; st.l = 0.f;
#pragma unroll
    for (int d = 0; d < 4; ++d) st.o[d] = f32x16{}; }
#define HS_LOADQ(qr, Qrow0) do { _Pragma("unroll") for (int d0 = 0; d0 < 8; ++d0) qr[d0] = load8((Qrow0) + (size_t)(wid * QBLK + r32) * DH + d0 * 16 + hi * 8); } while (0)
#define HS_SLOAD(Kp, Vp, k0) do { st_v0 = load8(ROW(Vp, k0, sr)); st_v1 = load8(ROW(Vp, k0, 32 + sr)); st_k0 = load8(ROW(Kp, k0, sr)); st_k1 = load8(ROW(Kp, k0, 32 + sr)); } while (0)
#define HS_SWRITE(slot) do { *(LAS bf16x8*)(lds + (slot) * SHM_K + kws) = st_k0; *(LAS bf16x8*)(lds + (slot) * SHM_K + kws + 32 * 256) = st_k1; \
                             *(LAS bf16x8*)(lds + RING_V + (slot) * SHM_V + vst0) = st_v0; *(LAS bf16x8*)(lds + RING_V + (slot) * SHM_V + vst1) = st_v1; } while (0)
__device__ __forceinline__ void head_dilated(const bf16_t* Q, bf16_t* O, const bf16_t* K, const bf16_t* V, float* LSE, int segmask, LAS char* lds, LAS float* scr, int wave_s) {
    const int tid = opaque_tid(wave_s), wid = __builtin_amdgcn_readfirstlane(tid >> 6), lane = tid & 63, r32 = lane & 31, hi = lane >> 5, pair = wid >> 1;
    const int sr = tid >> 4, sc = (tid & 15) * 8, vst0 = v_st(sr, sc), vst1 = v_st(32 + sr, sc), kws = KSWZ(sr, sc * 2);
    constexpr int NT = 2048 / KVBLK, W = 129;
    bf16x8 st_v0, st_v1, st_k0, st_k1; bf16x8 qr[8]; WaveState st; wave_reset(st);
    HS_SLOAD(K, V, 0); HS_LOADQ(qr, Q); VMW(); HS_SWRITE(0); SBAR();
    HS_SLOAD(K, V, KVBLK); VMW(); HS_SWRITE(1);
    __syncthreads();
    for (int g = 1; g <= NT; ++g) {
        const bool ld = g + 1 < NT;
        if (ld) { HS_SLOAD(K, V, (g + 1) * KVBLK); SBAR(); }
        const int ph = (g - 1) & 3, qb = (g - 1) >> 2;
        if (ph != 3) {
            const int T = g - 3 + pair, qlo = qb * QB + wid * QBLK, segb = qlo & ~segmask;
            const int lowk_w = imax(qlo - W + 1, segb), lowk_last = imax(qlo + QBLK - W, segb), kb_ = T * KVBLK;
            if (T >= 0 && kb_ <= qlo + QBLK - 1 && kb_ + KVBLK - 1 >= lowk_w) {
                const int wrow = ((qlo + r32) & segmask) + 1;
                tile_step(st, qr, lds, T & 3, r32, hi, lane, (kb_ + KVBLK - 1 > qlo) || (kb_ < lowk_last), qlo + r32 - 4 * hi - kb_, (unsigned)(wrow < W ? wrow : W));
            }
            if (ph == 2 && qb + 1 < 2048 / QB) { SBAR(); HS_LOADQ(qr, Q + (size_t)(qb + 1) * QB * DH); }
        } else {
            wave_store(st, O + (size_t)(qb * QB + wid * QBLK) * DH, DH, LSE + qb * QB + wid * QBLK, r32, hi);
            wave_reset(st);
        }
        __syncthreads();
        if (ld) { HS_SWRITE((g + 1) & 3); }
        __syncthreads();
    }
}
__device__ __forceinline__ void head_mem(const bf16_t* Q, const bf16_t* K, const bf16_t* V, bf16_t* O, int ostride, LAS char* lds, LAS float* scr, int wave_s) {
    const int tid = opaque_tid(wave_s), wid = __builtin_amdgcn_readfirstlane(tid >> 6), lane = tid & 63, r32 = lane & 31, hi = lane >> 5, pair = wid >> 1;
    const int sr = tid >> 4, sc = (tid & 15) * 8, vst0 = v_st(sr, sc), vst1 = v_st(32 + sr, sc), kws = KSWZ(sr, sc * 2);
    bf16x8 st_v0, st_v1, st_k0, st_k1; bf16x8 qr[8]; WaveState st;
#pragma unroll
    for (int t = 0; t < 4; ++t) { HS_SLOAD(K, V, t * KVBLK); VMW(); HS_SWRITE(t); SBAR(); }
    __syncthreads();
    for (int qb = 0; qb < 2048 / QB; ++qb) {
        HS_LOADQ(qr, Q + (size_t)qb * QB * DH); wave_reset(st);
        for (int t = 0; t < 4; ++t) tile_step(st, qr, lds, (t + pair) & 3, r32, hi, lane, false, 0, 0u);
        wave_store(st, O + (size_t)(qb * QB + wid * QBLK) * ostride, ostride, nullptr, r32, hi);
    }
    __syncthreads();
}
#undef HS_LOADQ
#undef HS_SLOAD
#undef HS_SWRITE
#undef ROW
#undef VMW
#undef VMWN
#undef SLOAD_H
#undef SWRITE_HK
#undef SWRITE_HV
#undef SWRITE_H
#undef KSWZ
#undef SBAR
}

#define XB_TMO      128
#define XB_XCNT(j)  (256  + 64 * (j))
#define XB_XSUB(j)  (1280 + 64 * (j))
#define XB_XGEN(j)  (2304 + 64 * (j))
#define XB_TOP      3328
#define XB_TOPGEN   3392
#define XCD_BAR_WORDS 3456
#define XB_SPIN_CAP (1u << 18)
__device__ __forceinline__ unsigned xb_ld(unsigned* p)              { return __hip_atomic_load(p, __ATOMIC_RELAXED, __HIP_MEMORY_SCOPE_AGENT); }
__device__ __forceinline__ unsigned xb_add(unsigned* p, unsigned v) { return __hip_atomic_fetch_add(p, v, __ATOMIC_RELAXED, __HIP_MEMORY_SCOPE_AGENT); }
__device__ __forceinline__ unsigned xb_xcc_id() { return (unsigned)__builtin_amdgcn_s_getreg((3 << 11) | 20) & 0xFu; }
#define XB_SPIN(cond, bar) do { unsigned _sp = 0; while (cond) { __builtin_amdgcn_s_sleep(1); \
    if ((++_sp & 255u) == 0u) { if (xb_ld(&(bar)[XB_TMO])) break; if (_sp > XB_SPIN_CAP) { atomicAdd(&(bar)[XB_TMO], 1u); break; } } } } while (0)
struct XcdBarrier { unsigned* bar; unsigned x; volatile LAS unsigned* st; };
__device__ __forceinline__ XcdBarrier xcd_barrier_post(unsigned* bar, volatile LAS unsigned* st) {
    XcdBarrier b; b.bar = bar; b.x = xb_xcc_id(); b.st = st;
    if (threadIdx.x == 0) (void)xb_add(&bar[XB_XCNT(b.x)], 1u);
    return b;
}
__device__ __forceinline__ void xcd_barrier_complete(unsigned* bar, unsigned x, unsigned& nloc, unsigned& nx) {
    const unsigned G = gridDim.x * gridDim.y * gridDim.z;
    unsigned sum, cnt, mine, sp = 0u;
    for (;;) {
        sum = 0u; cnt = 0u; mine = 0u;
#pragma unroll
        for (unsigned j = 0; j < 16; ++j) { const unsigned c = xb_ld(&bar[XB_XCNT(j)]); sum += c; cnt += (c > 0u) ? 1u : 0u; mine = (j == x) ? c : mine; }
        if (sum == G) break;
        __builtin_amdgcn_s_sleep(1);
        if ((++sp & 255u) == 0u) { if (xb_ld(&bar[XB_TMO])) break; if (sp > XB_SPIN_CAP) { atomicAdd(&bar[XB_TMO], 1u); break; } }
    }
    nloc = mine > 0u ? mine : 1u; nx = cnt > 0u ? cnt : 1u;
}
__device__ __forceinline__ void xcd_barrier(const XcdBarrier& b) {
    asm volatile("s_waitcnt vmcnt(0)" ::: "memory");
    __syncthreads();
    if (threadIdx.x == 0) {
        unsigned* bar = b.bar; asm volatile("" : "+s"(bar)); bar = (unsigned*)(GAS unsigned*)bar;
        __builtin_amdgcn_s_waitcnt(0);
        unsigned nloc = b.st[0], nx = b.st[1];
        if (nloc == 0u) { xcd_barrier_complete(bar, b.x, nloc, nx); b.st[0] = nloc; b.st[1] = nx; }
        const unsigned old = xb_add(&bar[XB_XSUB(b.x)], 1u);
        const unsigned gen = old / nloc;
        if (old + 1u == (gen + 1u) * nloc) {
            __builtin_amdgcn_fence(__ATOMIC_RELEASE, "agent");
            asm volatile("s_waitcnt vmcnt(0)" ::: "memory");
            const unsigned og = xb_add(&bar[XB_TOP], 1u);
            const unsigned tg = og / nx;
            if (og + 1u == (tg + 1u) * nx) xb_add(&bar[XB_TOPGEN], 1u);
            else XB_SPIN(xb_ld(&bar[XB_TOPGEN]) == tg, bar);
            __builtin_amdgcn_fence(__ATOMIC_ACQUIRE, "agent");
            xb_add(&bar[XB_XGEN(b.x)], 1u);
            asm volatile("s_waitcnt vmcnt(0)" ::: "memory");
        } else {
            XB_SPIN(xb_ld(&bar[XB_XGEN(b.x)]) == gen, bar);
            __builtin_amdgcn_fence(__ATOMIC_ACQUIRE, "agent");
            asm volatile("s_waitcnt vmcnt(0)" ::: "memory");
        }
    }
    __syncthreads();
}
constexpr int CW_BAR = 4096, CW_CONVQ = 96;

#define ACC8(ai, bj, m) {acc[ai][bj][m][0][0], acc[ai][bj][m][0][1], acc[ai][bj][m][0][2], acc[ai][bj][m][0][3], acc[ai][bj][m][1][0], acc[ai][bj][m][1][1], acc[ai][bj][m][1][2], acc[ai][bj][m][1][3]}
struct FastEpiMain {
    static constexpr bool PERM = true; EpiMain mn; EpiKV kv; float ascale;
    __device__ __forceinline__ bool keep_acc(const pg8::Unit&) const { return false; }
    __device__ __forceinline__ void operator()(f32x4 (&acc)[2][2][4][2], const pg8::Unit& u, int wr, int wc, int fr, int fq) const {
        asm volatile("" : "+v"(fr), "+v"(fq));
        const int rowb = u.row0 + wr * 64 + fr, colb = u.col0 + wc * 32 + 8 * fq;
        if (u.aux != 0) {
#pragma unroll
            for (int ai = 0; ai < 2; ++ai)
#pragma unroll
                for (int m = 0; m < 4; ++m)
#pragma unroll
                    for (int bj = 0; bj < 2; ++bj) { float v[8] = ACC8(ai, bj, m); kv(rowb + ai * 128 + m * 16, colb + bj * 128, v); }
            return;
        }
        f32x4 bb[2][2];
#pragma unroll
        for (int bj = 0; bj < 2; ++bj) { bb[bj][0] = *(const f32x4*)(mn.biasp + colb + bj * 128); bb[bj][1] = *(const f32x4*)(mn.biasp + colb + bj * 128 + 4); }
        float fpos[2][4];
#pragma unroll
        for (int ai = 0; ai < 2; ++ai)
#pragma unroll
            for (int m = 0; m < 4; ++m) fpos[ai][m] = 0.f;
        if (u.col0 < C_V) {
#pragma unroll
            for (int ai = 0; ai < 2; ++ai)
#pragma unroll
                for (int m = 0; m < 4; ++m) fpos[ai][m] = (float)mn.pos[mn.tok0 + rowb + ai * 128 + m * 16];
        }
        float invrev[4]; EpiMain::rope_freqs(colb, invrev);
#pragma unroll
        for (int ai = 0; ai < 2; ++ai)
#pragma unroll
            for (int m = 0; m < 4; ++m)
#pragma unroll
                for (int bj = 0; bj < 2; ++bj) { float v[8] = ACC8(ai, bj, m);
#pragma unroll
                    for (int q = 0; q < 8; ++q) v[q] *= ascale;
                    v[0] += bb[bj][0].x; v[1] += bb[bj][0].y; v[2] += bb[bj][0].z; v[3] += bb[bj][0].w; v[4] += bb[bj][1].x; v[5] += bb[bj][1].y; v[6] += bb[bj][1].z; v[7] += bb[bj][1].w;
                    mn.finish(rowb + ai * 128 + m * 16, colb + bj * 128, v, fpos[ai][m], invrev); }
    }
};
struct FastEpiGates {
    static constexpr bool PERM = true; const float* biasp; bf16_t* GATES; float ascale;
    __device__ __forceinline__ bool keep_acc(const pg8::Unit&) const { return false; }
    __device__ __forceinline__ void operator()(f32x4 (&acc)[2][2][4][2], const pg8::Unit& u, int wr, int wc, int fr, int fq) const {
        asm volatile("" : "+v"(fr), "+v"(fq));
        const int rowb = u.row0 + wr * 64 + fr, colb = u.col0 + wc * 32 + 8 * fq;
        f32x4 bb[2][2];
#pragma unroll
        for (int bj = 0; bj < 2; ++bj) { bb[bj][0] = *(const f32x4*)(biasp + colb + bj * 128); bb[bj][1] = *(const f32x4*)(biasp + colb + bj * 128 + 4); }
#pragma unroll
        for (int ai = 0; ai < 2; ++ai)
#pragma unroll
            for (int m = 0; m < 4; ++m)
#pragma unroll
                for (int bj = 0; bj < 2; ++bj) { const f32x4 a = acc[ai][bj][m][0] * ascale + bb[bj][0], b = acc[ai][bj][m][1] * ascale + bb[bj][1];
                    u32x4 o; o.x = pk2(sigmoidf_(a.x), sigmoidf_(a.y)); o.y = pk2(sigmoidf_(a.z), sigmoidf_(a.w)); o.z = pk2(sigmoidf_(b.x), sigmoidf_(b.y)); o.w = pk2(sigmoidf_(b.z), sigmoidf_(b.w));
                    *(u32x4*)(GATES + (size_t)(rowb + ai * 128 + m * 16) * 3072 + (colb + bj * 128 - C_GATE)) = o; }
    }
};
struct FastEpiMerge {
    static constexpr bool PERM = true; const bf16_t* GATES; bf16_t* MERGED;
    __device__ __forceinline__ bool keep_acc(const pg8::Unit& u) const { return u.aux < 2; }
    __device__ __forceinline__ void operator()(f32x4 (&acc)[2][2][4][2], const pg8::Unit& u, int wr, int wc, int fr, int fq) const {
        asm volatile("" : "+v"(fr), "+v"(fq));
        const int rowb = u.row0 + wr * 64 + fr, colb = u.col0 + wc * 32 + 8 * fq, br = u.aux;
        const unsigned char* gp = (const unsigned char*)GATES + (size_t)rowb * 3072 + br * 1024 + colb;
        bf16_t* mp = MERGED + (size_t)rowb * 1024 + colb;
#pragma unroll
        for (int ai = 0; ai < 2; ++ai) {
            u32x2 tg[4][2], tn[4][2];
#pragma unroll
            for (int m = 0; m < 4; ++m)
#pragma unroll
                for (int bj = 0; bj < 2; ++bj) { tg[m][bj] = *(const u32x2*)(gp + (size_t)(ai * 128 + m * 16) * 3072 + bj * 128);
                    if (br < 2) tn[m][bj] = *(const u32x2*)(gp + 1024 + (size_t)(ai * 128 + m * 16) * 3072 + bj * 128); }
            if (br < 2) {
#pragma unroll
                for (int m = 0; m < 4; ++m)
#pragma unroll
                    for (int bj = 0; bj < 2; ++bj) { const u32x2 g = tg[m][bj], n = tn[m][bj]; const f32x4 n0 = u8x4_raw(n.x), n1 = u8x4_raw(n.y);
                        const f32x4 r0 = {__builtin_amdgcn_rcpf(n0.x), __builtin_amdgcn_rcpf(n0.y), __builtin_amdgcn_rcpf(n0.z), __builtin_amdgcn_rcpf(n0.w)}, r1 = {__builtin_amdgcn_rcpf(n1.x), __builtin_amdgcn_rcpf(n1.y), __builtin_amdgcn_rcpf(n1.z), __builtin_amdgcn_rcpf(n1.w)};
                        acc[ai][bj][m][0] = acc[ai][bj][m][0] * (u8x4_raw(g.x) * r0); acc[ai][bj][m][1] = acc[ai][bj][m][1] * (u8x4_raw(g.y) * r1); }
            } else {
#pragma unroll
                for (int m = 0; m < 4; ++m)
#pragma unroll
                    for (int bj = 0; bj < 2; ++bj) { const u32x2 g = tg[m][bj]; const f32x4 a = acc[ai][bj][m][0] * u8x4_to_f32(g.x), b = acc[ai][bj][m][1] * u8x4_to_f32(g.y);
                        u32x4 o; o.x = pk2(a.x, a.y); o.y = pk2(a.z, a.w); o.z = pk2(b.x, b.y); o.w = pk2(b.z, b.w);
                        *(u32x4*)(mp + (size_t)(ai * 128 + m * 16) * 1024 + bj * 128) = o; }
            }
            asm volatile("" ::: "memory");
        }
    }
};
struct FastEpiStore {
    static constexpr bool PERM = true; bf16_t* O; int ld; float scale;
    __device__ __forceinline__ bool keep_acc(const pg8::Unit&) const { return false; }
    __device__ __forceinline__ void operator()(f32x4 (&acc)[2][2][4][2], const pg8::Unit& u, int wr, int wc, int fr, int fq) const {
        asm volatile("" : "+v"(fr), "+v"(fq));
        const int rowb = u.row0 + wr * 64 + fr, colb = u.col0 + wc * 32 + 8 * fq;
#pragma unroll
        for (int ai = 0; ai < 2; ++ai)
#pragma unroll
            for (int m = 0; m < 4; ++m)
#pragma unroll
                for (int bj = 0; bj < 2; ++bj) { const f32x4 a = acc[ai][bj][m][0] * scale, b = acc[ai][bj][m][1] * scale;
                    u32x4 o; o.x = pk2(a.x, a.y); o.y = pk2(a.z, a.w); o.z = pk2(b.x, b.y); o.w = pk2(b.z, b.w);
                    *(u32x4*)(O + (size_t)(rowb + ai * 128 + m * 16) * ld + colb + bj * 128) = o; }
    }
};
struct FastEpiMoe1 {
    static constexpr bool PERM = true; LAS const int* toktab; const float* wts; unsigned char* H8;
    __device__ __forceinline__ bool keep_acc(const pg8::Unit&) const { return false; }
    __device__ __forceinline__ void operator()(f32x4 (&acc)[2][2][4][2], const pg8::Unit& u, int wr, int wc, int fr, int fq) const {
        asm volatile("" : "+v"(fr), "+v"(fq));
        const int rloc = wr * 64 + fr, colb = u.col0 + wc * 32 + 8 * fq, hi = u.col0 >> 10;
        float w[2][4];
#pragma unroll
        for (int ai = 0; ai < 2; ++ai)
#pragma unroll
            for (int m = 0; m < 4; ++m) { const int tok = toktab[u.aux * 256 + rloc + ai * 128 + m * 16]; w[ai][m] = wts[(size_t)tok * 2 + hi] * (H8_SCALE / W8_SCALE); }
        constexpr float inv = 1.0f / W8_SCALE;
#pragma unroll
        for (int ai = 0; ai < 2; ++ai)
#pragma unroll
            for (int m = 0; m < 4; ++m)
#pragma unroll
                for (int bj = 0; bj < 2; ++bj) { const f32x4 gt = acc[ai][bj][m][0] * inv, up = acc[ai][bj][m][1]; const float ww = w[ai][m];
                    const int j0 = hi * 512 + (((colb + bj * 128) & 1023) >> 1);
                    float h[4] = {gt.x * sigmoidf_(gt.x) * up.x * ww, gt.y * sigmoidf_(gt.y) * up.y * ww, gt.z * sigmoidf_(gt.z) * up.z * ww, gt.w * sigmoidf_(gt.w) * up.w * ww};
#pragma unroll
                    for (int q = 0; q < 4; ++q) h[q] = fminf(fmaxf(h[q], -448.f), 448.f);
                    *(unsigned*)(H8 + (size_t)(u.row0 + rloc + ai * 128 + m * 16) * 1024 + j0) = pk4_fp8(h[0], h[1], h[2], h[3]); }
    }
};
#undef ACC8

struct SchedMain {
    pg8::TileOrder to; int nkv, tile0, cut, skip; size_t astep, bstep; const char *XB, *WIN, *MEMB, *WKV;
    __device__ __forceinline__ bool next(int i, pg8::Unit& u) const {
        int pm, pn;
        if (to.tile(i, pm, pn)) { const int ct = tile0 + (pn < cut ? pn : pn + skip); u.A = XB + (size_t)pm * astep; u.B = WIN + (size_t)ct * bstep; u.row0 = pm * 256; u.col0 = ct * 256; u.bjump = 0; u.aux = 0; return true; }
        const long L = (long)i * to.G + to.c - to.nwg; if (L >= nkv) return false;
        pm = (int)(L >> 2); pn = (int)(L & 3);
        u.A = MEMB + (size_t)pm * 256 * 2048; u.B = WKV + (size_t)pn * 256 * 2048; u.row0 = pm * 256; u.col0 = pn * 256; u.bjump = 0; u.aux = 1; return true;
    }
};
struct SchedMerge {
    pg8::TileOrder to; const char *A0, *W;
    __device__ __forceinline__ bool next(int i, pg8::Unit& u) const {
        const int ti = i / 3, br = i - ti * 3; int pm, pn; if (!to.tile(ti, pm, pn)) return false;
        u.A = A0 + (size_t)br * SZ_512 + (size_t)pm * 256 * 1024; u.B = W + (size_t)br * MiB + (size_t)pn * 256 * 1024; u.row0 = pm * 256; u.col0 = pn * 256; u.bjump = 0; u.aux = br; return true;
    }
};
struct SchedPlain {
    pg8::TileOrder to; const char *A, *B; size_t astep, bstep;
    __device__ __forceinline__ bool next(int i, pg8::Unit& u) const {
        int pm, pn; if (!to.tile(i, pm, pn)) return false;
        u.A = A + (size_t)pm * astep; u.B = B + (size_t)pn * bstep; u.row0 = pm * 256; u.col0 = pn * 256; u.bjump = 0; u.aux = 0; return true;
    }
};
struct SchedMoe {
    pg8::TileOrder to; LAS const int* pan_cls; LAS const int* toktab; const char *H, *W1, *W2; int mode;
    __device__ __forceinline__ LAS const int* toks(int i) const { return toktab + i * 256; }
    __device__ __forceinline__ bool next(int i, pg8::Unit& u) const {
        int pm, pn; if (!to.tile(i, pm, pn)) return false;
        const int cls = pan_cls[pm]; int e_lo, e_hi; class_experts(cls, e_lo, e_hi);
        u.row0 = pm * 256; u.col0 = pn * 256; u.aux = i; u.bjump = 0;
        if (mode == 1) { u.A = nullptr; u.B = W1 + ((size_t)(pn < 4 ? e_lo : e_hi) * 1024 + (size_t)(pn & 3) * 256) * 1024; }
        else { u.A = H + (size_t)pm * 256 * 1024; u.B = W2 + (size_t)pn * 256 * 8192 + (size_t)e_lo * 512; u.bjump = (e_hi - e_lo - 1) * 512; }
        return true;
    }
};

template <int WHICH> __device__ __forceinline__ float tw_src(const Params& p, int k, int n) {
    if constexpr (WHICH == TW_IN) return p.w_in[(size_t)k * INC + win_logical(n)];
    else if constexpr (WHICH == TW_KV) return p.w_mem_kv[(size_t)k * 1024 + n];
    else if constexpr (WHICH == TW_A) return p.w_attn_o[(size_t)k * 1024 + n];
    else if constexpr (WHICH == TW_C) return p.w_conv_o[(size_t)k * 1024 + n];
    else if constexpr (WHICH == TW_M) return p.w_mem_o[(size_t)k * 1024 + n];
    else if constexpr (WHICH == TW_OUT) return p.w_out[(size_t)k * 1024 + n];
    else if constexpr (WHICH == TW_W1) { const int e = n >> 10, c = n & 1023, G = c >> 3, nn = (c >> 2) & 1, ee = c & 3, jj = 4 * G + ee; return (nn ? p.w_eu : p.w_eg)[((size_t)e * 1024 + k) * 512 + jj]; }
    else { const int e = n >> 10, c = n & 1023; return p.w_ed[((size_t)e * 512 + k) * 1024 + c]; }
}
template <int WHICH> __device__ __forceinline__ void tw_item(const Params& p, int item, float* scr, int lane) {
    constexpr int N = WHICH == TW_IN ? INC : (WHICH >= TW_W1 ? 16 * 1024 : 1024);
    constexpr int ldd = (WHICH == TW_A || WHICH == TW_C || WHICH == TW_M) ? 512 : (WHICH == TW_W2 ? 8192 : 1024);
    constexpr size_t dsto = WHICH == TW_IN ? WS_WIN : WHICH == TW_KV ? WS_WKV : WHICH == TW_A ? WS_WA : WHICH == TW_C ? WS_WC : WHICH == TW_M ? WS_WM : WHICH == TW_OUT ? WS_WOUT : WHICH == TW_W1 ? WS_W1 : WS_W2;
    bf16_t* dst = WSP(bf16_t, dsto);
    constexpr int nblk = N / 32; const int kb = item / nblk, nb = item - kb * nblk, k0 = 64 * kb, n0 = 32 * nb;
#pragma unroll 8
    for (int i = 0; i < 32; ++i) { const int kk = 2 * i + (lane >> 5); scr[kk * 33 + (lane & 31)] = tw_src<WHICH>(p, k0 + kk, n0 + (lane & 31)); }
    asm volatile("s_waitcnt lgkmcnt(0)" ::: "memory");
    const int c = lane & 7;
#pragma unroll
    for (int j = 0; j < 4; ++j) { const int n = (lane >> 3) + 8 * j; const float* sp = scr + (8 * c) * 33 + n;
        const int nn = n0 + n; size_t doff;
        if constexpr (WHICH == TW_W2) doff = (size_t)(nn & 1023) * 8192 + (size_t)(nn >> 10) * 512 + k0 + 8 * c; else doff = (size_t)nn * ldd + k0 + 8 * c;
        if constexpr (WHICH >= TW_W1) {
            u32x2 o; o.x = pk4_fp8(W8_SCALE * sp[0 * 33], W8_SCALE * sp[1 * 33], W8_SCALE * sp[2 * 33], W8_SCALE * sp[3 * 33]); o.y = pk4_fp8(W8_SCALE * sp[4 * 33], W8_SCALE * sp[5 * 33], W8_SCALE * sp[6 * 33], W8_SCALE * sp[7 * 33]);
            *(u32x2*)((unsigned char*)dst + doff) = o;
        } else {
            u32x4 o; o.x = pk2(sp[0 * 33], sp[1 * 33]); o.y = pk2(sp[2 * 33], sp[3 * 33]); o.z = pk2(sp[4 * 33], sp[5 * 33]); o.w = pk2(sp[6 * 33], sp[7 * 33]);
            *(u32x4*)(dst + doff) = o;
            if constexpr (WHICH == TW_IN) {
                u32x2 q; q.x = pk4_fp8(WG8_SCALE * sp[0 * 33], WG8_SCALE * sp[1 * 33], WG8_SCALE * sp[2 * 33], WG8_SCALE * sp[3 * 33]); q.y = pk4_fp8(WG8_SCALE * sp[4 * 33], WG8_SCALE * sp[5 * 33], WG8_SCALE * sp[6 * 33], WG8_SCALE * sp[7 * 33]);
                *(u32x2*)(p.ws + WS_WG8 + doff) = q; } } }
    asm volatile("s_waitcnt lgkmcnt(0)" ::: "memory");
}
__device__ __forceinline__ void transpose_all(const Params& p, float* scr, int gw, int ngw, int lane) {
    constexpr int I_IN = 16 * (INC / 32), I_KV = 16 * 32, I_B = 8 * 32, I_OUT = 16 * 32, I_W1 = 16 * 512, I_W2 = 8 * 512;
    constexpr int NITEMS = I_IN + I_KV + 3 * I_B + I_OUT + I_W1 + I_W2;
    for (int it = gw; it < NITEMS; it += ngw) {
        int r = it;
        if (r < I_W1) { tw_item<TW_W1>(p, r, scr, lane); continue; } r -= I_W1;
        if (r < I_IN) { tw_item<TW_IN>(p, r, scr, lane); continue; } r -= I_IN;
        if (r < I_W2) { tw_item<TW_W2>(p, r, scr, lane); continue; } r -= I_W2;
        if (r < I_KV) { tw_item<TW_KV>(p, r, scr, lane); continue; } r -= I_KV;
        if (r < I_OUT) { tw_item<TW_OUT>(p, r, scr, lane); continue; } r -= I_OUT;
        if (r < I_B) { tw_item<TW_A>(p, r, scr, lane); continue; } r -= I_B;
        if (r < I_B) { tw_item<TW_C>(p, r, scr, lane); continue; } r -= I_B;
        tw_item<TW_M>(p, r, scr, lane);
    }
}

__device__ __forceinline__ void cvt_bf16_dev(const float* __restrict__ src, bf16_t* __restrict__ dst, size_t n8, size_t gtid, size_t gstride) {
    for (size_t i = gtid; i < n8; i += gstride) {
        const f32x4 a = *(const f32x4*)(src + i * 8), b = *(const f32x4*)(src + i * 8 + 4);
        u32x4 o; o.x = pk2(a.x, a.y); o.y = pk2(a.z, a.w); o.z = pk2(b.x, b.y); o.w = pk2(b.z, b.w);
        *(u32x4*)(dst + i * 8) = o;
    }
}

__device__ __forceinline__ void cvt_x_dev(const float* __restrict__ src, bf16_t* __restrict__ dst, unsigned char* __restrict__ dst8, size_t n16, size_t gtid, size_t gstride) {
    for (size_t i = gtid; i < n16; i += 2 * gstride) {
        const size_t i2 = i + gstride; const bool has2 = i2 < n16; const size_t j2 = has2 ? i2 : i;
        f32x4 a[2][4];
#pragma unroll
        for (int q = 0; q < 4; ++q) { a[0][q] = *(const f32x4*)(src + i * 16 + 4 * q); a[1][q] = *(const f32x4*)(src + j2 * 16 + 4 * q); }
#pragma unroll
        for (int r = 0; r < 2; ++r) { if (r == 1 && !has2) break; const size_t ii = r ? i2 : i;
            u32x4 o0, o1; o0.x = pk2(a[r][0].x, a[r][0].y); o0.y = pk2(a[r][0].z, a[r][0].w); o0.z = pk2(a[r][1].x, a[r][1].y); o0.w = pk2(a[r][1].z, a[r][1].w);
            o1.x = pk2(a[r][2].x, a[r][2].y); o1.y = pk2(a[r][2].z, a[r][2].w); o1.z = pk2(a[r][3].x, a[r][3].y); o1.w = pk2(a[r][3].z, a[r][3].w);
            *(u32x4*)(dst + ii * 16) = o0; *(u32x4*)(dst + ii * 16 + 8) = o1;
            u32x4 q8; q8.x = pk4_fp8(a[r][0].x, a[r][0].y, a[r][0].z, a[r][0].w); q8.y = pk4_fp8(a[r][1].x, a[r][1].y, a[r][1].z, a[r][1].w); q8.z = pk4_fp8(a[r][2].x, a[r][2].y, a[r][2].z, a[r][2].w); q8.w = pk4_fp8(a[r][3].x, a[r][3].y, a[r][3].z, a[r][3].w);
            *(u32x4*)(dst8 + ii * 16) = q8; }
    }
}
__device__ __forceinline__ void wg8_dev(const Params& p, size_t gtid, size_t gstride) {
    for (size_t i = gtid; i < (size_t)INC * 64; i += gstride) { const int n = (int)(i % INC), k0 = (int)(i / INC) * 16, nl = win_logical(n); float v[16];
#pragma unroll
        for (int j = 0; j < 16; ++j) v[j] = WG8_SCALE * p.w_in[(size_t)(k0 + j) * INC + nl];
        u32x4 q; q.x = pk4_fp8(v[0], v[1], v[2], v[3]); q.y = pk4_fp8(v[4], v[5], v[6], v[7]); q.z = pk4_fp8(v[8], v[9], v[10], v[11]); q.w = pk4_fp8(v[12], v[13], v[14], v[15]);
        *(u32x4*)(p.ws + WS_WG8 + (size_t)n * 1024 + k0) = q; }
}

struct Args { Params p; int ph_lo, ph_hi; };
typedef const __attribute__((address_space(4))) unsigned long long* KArgPtr;
__device__ __forceinline__ Params load_params(KArgPtr q) {
    asm volatile("" : "+s"(q));
    Params p;
    p.x = (const float*)(const GAS float*)q[0]; p.mem = (const float*)(const GAS float*)q[1]; p.pos = (const int*)(const GAS int*)q[2]; p.w_in = (const float*)(const GAS float*)q[3]; p.b_in = (const float*)(const GAS float*)q[4]; p.conv_w = (const float*)(const GAS float*)q[5]; p.conv_b = (const float*)(const GAS float*)q[6];
    p.conv_g = (const float*)(const GAS float*)q[7]; p.conv_bb = (const float*)(const GAS float*)q[8]; p.w_mem_kv = (const float*)(const GAS float*)q[9]; p.w_attn_o = (const float*)(const GAS float*)q[10]; p.w_conv_o = (const float*)(const GAS float*)q[11]; p.w_mem_o = (const float*)(const GAS float*)q[12];
    p.w_out = (const float*)(const GAS float*)q[13]; p.ln1_g = (const float*)(const GAS float*)q[14]; p.ln1_b = (const float*)(const GAS float*)q[15]; p.w_gr = (const float*)(const GAS float*)q[16]; p.b_gr = (const float*)(const GAS float*)q[17]; p.w_er = (const float*)(const GAS float*)q[18]; p.b_er = (const float*)(const GAS float*)q[19];
    p.w_eg = (const float*)(const GAS float*)q[20]; p.w_eu = (const float*)(const GAS float*)q[21]; p.w_ed = (const float*)(const GAS float*)q[22]; p.ln2_g = (const float*)(const GAS float*)q[23]; p.ln2_b = (const float*)(const GAS float*)q[24]; p.out = (float*)(GAS float*)q[25]; p.ws = (unsigned char*)(GAS unsigned char*)q[26];
    return p;
}
static_assert(sizeof(Params) == 27 * 8, "Params is 27 pointers");
constexpr int PH_P0 = 0, PH_CH0 = 1, PH_PER_CH = 5, PH_LN1 = PH_CH0 + PH_PER_CH * NCH, PH_MOE1 = PH_LN1 + 1, PH_MOE2 = PH_LN1 + 2, PH_LN2 = PH_LN1 + 3, PH_END = PH_LN1 + 4;

__global__ void __launch_bounds__(NTHR, 2) mk_fwd(Args args) {
    extern __shared__ __attribute__((aligned(16))) unsigned char lds_raw[];
    LAS unsigned char* lds = (LAS unsigned char*)lds_raw;
    const KArgPtr kargs = (KArgPtr)__builtin_amdgcn_kernarg_segment_ptr();
    const int wave = __builtin_amdgcn_readfirstlane((int)threadIdx.x >> 6);
    const int G = gridDim.x; const int bx = blockIdx.x; const int vcu = (G % 8 == 0) ? (bx % 8) * (G / 8) + bx / 8 : bx;
    volatile LAS unsigned* MISC = (volatile LAS unsigned*)(lds + LCTL_OFF);
    ClassTab* tab = (ClassTab*)(lds_raw + LCTL_OFF + 256);
    int* pan_cls = (int*)(lds_raw + LCTL_OFF + 512);
    int* toktab = (int*)(lds_raw + LTOK_OFF);
    for (int u = threadIdx.x; u < (LDS_BYTES - LCTL_OFF) / 4; u += NTHR) ((LAS unsigned*)(lds + LCTL_OFF))[u] = 0u;
    __syncthreads();
    const int lo = args.ph_lo, hi = args.ph_hi;
    unsigned* ctl; { const Params p = load_params(kargs); ctl = WSP(unsigned, WS_CTL); }
    XcdBarrier bar; bar.bar = ctl + CW_BAR; bar.x = 0; bar.st = nullptr;
    if (hi - lo > 1) bar = xcd_barrier_post(ctl + CW_BAR, MISC);
#ifndef PHMASK
#define PHMASK 0x3ff
#endif
#ifndef P1_QK_FP8
#define P1_QK_FP8 3
#endif
#if P1_QK_FP8 == 3
constexpr int P1_BF16_TILES = 4, P1_BF16_T0 = 18, P1_BF16_CUT = 4, P1_BF16_SKIP = 0, P1_FP8_TILES = 32, P1_FP8_T0 = 0, P1_FP8_CUT = 18, P1_FP8_SKIP = 4;
#elif P1_QK_FP8 == 2
constexpr int P1_BF16_TILES = 0, P1_BF16_T0 = 0, P1_BF16_CUT = 0, P1_BF16_SKIP = 0, P1_FP8_TILES = 36, P1_FP8_T0 = 0, P1_FP8_CUT = 36, P1_FP8_SKIP = 0;
#elif P1_QK_FP8
constexpr int P1_BF16_TILES = 6, P1_BF16_T0 = 18, P1_BF16_CUT = 6, P1_BF16_SKIP = 0, P1_FP8_TILES = 30, P1_FP8_T0 = 0, P1_FP8_CUT = 18, P1_FP8_SKIP = 6;
#else
constexpr int P1_BF16_TILES = 18, P1_BF16_T0 = 0, P1_BF16_CUT = 12, P1_BF16_SKIP = 6, P1_FP8_TILES = 18, P1_FP8_T0 = 12, P1_FP8_CUT = 6, P1_FP8_SKIP = 6;
#endif
#ifndef ATTN_V2
#define ATTN_V2 1
#endif
#ifndef PROBE_DUP
#define PROBE_DUP (-1)
#endif
#define NREP(b) ((PROBE_DUP == (b)) ? 2 : 1)
#define IN(k) (lo <= (k) && (k) < hi)
#define HAS(b) ((PHMASK >> (b)) & 1)
#define SEAM(k) do { if (IN(k) && IN((k) + 1)) xcd_barrier(bar); } while (0)

    if (HAS(0) && IN(PH_P0)) {
        const Params p = load_params(kargs);
        const size_t gtid = (size_t)bx * NTHR + opaque_tid(wave), gstride = (size_t)G * NTHR;
        for (int rep = 0; rep < NREP(0); ++rep) {
        { const int ptid = opaque_tid(wave); transpose_all(p, (float*)(lds_raw + RING_OFF) + (ptid >> 6) * (64 * 33), bx * NWAVES + (ptid >> 6), G * NWAVES, ptid & 63); }
        small_prep_dev(p, gtid, gstride);
        cvt_bf16_dev(p.mem, WSP(bf16_t, WS_MEMB), (size_t)NB * MEML * 1024 / 8, gtid, gstride);
        cvt_x_dev(p.x, WSP(bf16_t, WS_XB), p.ws + WS_XB8, (size_t)T * 1024 / 16, gtid, gstride);
        }
    }
    SEAM(PH_P0);
    if (PROBE_DUP == 10 && hi - lo > 1) for (int r = 0; r < 16; ++r) xcd_barrier(bar);

    for (int ch = 0; ch < NCH; ++ch) {
        const int ph0 = PH_CH0 + PH_PER_CH * ch;
        if (HAS(1) && IN(ph0)) {
            const Params p = load_params(kargs);
            const EpiMain em{WSP(float, WS_BIASP), p.pos, WSP(bf16_t, WS_QG), WSP(bf16_t, WS_CGLU), WSP(bf16_t, WS_QM), WSP(bf16_t, WS_GATES), ch * TC};
            for (int rep = 0; rep < NREP(1); ++rep) {
            {
                SchedMain S; S.to.init(TC / 256, P1_BF16_TILES, G, bx); S.nkv = ch == 0 ? (NB * MEML / 256) * 4 : 0; S.tile0 = P1_BF16_T0; S.cut = P1_BF16_CUT; S.skip = P1_BF16_SKIP; S.astep = 256 * 2048; S.bstep = 256 * 2048;
                S.XB = (const char*)(WSP(bf16_t, WS_XB) + (size_t)ch * TC * 1024); S.WIN = (const char*)WSP(bf16_t, WS_WIN); S.MEMB = (const char*)WSP(bf16_t, WS_MEMB); S.WKV = (const char*)WSP(bf16_t, WS_WKV);
                FastEpiMain E{em, EpiKV{WSP(bf16_t, WS_KM)}, 1.0f};
#ifndef NO_P1A
                pg8::gemm_phase<FastEpiMain, SchedMain, true, false, false>(lds + RING_OFF, nullptr, 1024, 1024, 1024, S, E, wave);
#endif
                if (PROBE_DUP == 16) { FastEpiStore E2{WSP(bf16_t, WS_MERGED), 1024, 1.0f}; pg8::gemm_phase<FastEpiStore, SchedMain, true, false, false>(lds + RING_OFF, nullptr, 1024, 1024, 1024, S, E2, wave); }
            }
            {
                SchedMain S; S.to.init(TC / 256, P1_FP8_TILES, G, bx); S.nkv = 0; S.tile0 = P1_FP8_T0; S.cut = P1_FP8_CUT; S.skip = P1_FP8_SKIP; S.astep = 256 * 1024; S.bstep = 256 * 1024;
                S.XB = (const char*)(p.ws + WS_XB8 + (size_t)ch * TC * 1024); S.WIN = (const char*)(p.ws + WS_WG8); S.MEMB = nullptr; S.WKV = nullptr;
                FastEpiMain E{em, EpiKV{WSP(bf16_t, WS_KM)}, 1.0f / WG8_SCALE};
#ifndef NO_P1B
                pg8::gemm_phase<FastEpiMain, SchedMain, true, false, false, true>(lds + RING_OFF, nullptr, 512, 512, 512, S, E, wave);
#endif
                if (PROBE_DUP == 17) { FastEpiStore E2{WSP(bf16_t, WS_MERGED), 1024, 1.0f}; pg8::gemm_phase<FastEpiStore, SchedMain, true, false, false, true>(lds + RING_OFF, nullptr, 512, 512, 512, S, E2, wave); }
            }
            }
        }
        SEAM(ph0);
        if (HAS(2) && IN(ph0 + 1)) {
            const Params p = load_params(kargs);
            constexpr int NDIL = BC * 12 * 8, NMEMB = BC * 4 * 8, NBLK = NDIL + NMEMB;
#if ATTN_V2
            for (int rep = 0; rep < NREP(2); ++rep) {
            const bool dummy = (PROBE_DUP == 2) && rep == 0;
            LAS char* rlds = (LAS char*)(lds + RING_OFF); LAS float* scr = (LAS float*)(lds + LTOK_OFF);
            if (wave >= 4) __builtin_amdgcn_s_setprio(1);
            for (int hd = vcu; hd < BC * 16; hd += G) {
                if (hd < BC * 12) { const int g = (hd % 12) >> 2; const size_t base = (size_t)hd * 2048 * 128;
                    swa::head_dilated(WSP(bf16_t, WS_QG) + base, dummy ? WSP(bf16_t, WS_MERGED) + (size_t)(hd & 127) * 2048 * 128 : WSP(bf16_t, WS_QG) + base, WSP(bf16_t, WS_KG) + base, WSP(bf16_t, WS_VG) + base, WSP(float, WS_LSE) + (size_t)hd * 2048, (2048 >> (2 * g)) - 1, rlds, scr, wave);
                } else { const int bh = hd - BC * 12, bl = bh >> 2, h = bh & 3; const size_t kvb = (size_t)(ch * BC * 4 + bh) * 256 * 128;
                    swa::head_mem(WSP(bf16_t, WS_QM) + (size_t)bh * 2048 * 128, WSP(bf16_t, WS_KM) + kvb, WSP(bf16_t, WS_VM) + kvb, WSP(bf16_t, WS_OMT) + (size_t)bl * 2048 * 512 + h * 128, 512, rlds, scr, wave); }
            }
            __builtin_amdgcn_s_setprio(0);
            __syncthreads();
            }
            {
                const Params pc = load_params(kargs); const int ptid = opaque_tid(wave); volatile LAS unsigned* qslot = MISC + 4;
                for (;;) {
                    if (ptid == 0) *qslot = atomicAdd(ctl + CW_CONVQ + ch, 1u);
                    __syncthreads();
                    const int u = (int)*qslot;
                    if (u >= BC * 64) break;
                    conv_unit(pc, u, lds_raw + RING_OFF, ptid);
                }
            }
        }
#else
            for (int rep = 0; rep < NREP(2); ++rep) {
            const bool dummy = (PROBE_DUP == 2) && rep == 0;
            auto make_ref = [&](int L) -> swa::BlockRef {
                swa::BlockRef r;
                if (L < NDIL) { const int bgh = L >> 3, qb = L & 7, g = (bgh % 12) >> 2; const size_t base = (size_t)bgh * 2048 * 128;
                    r.Q = WSP(bf16_t, WS_QG) + base + (size_t)qb * 256 * 128; r.K = WSP(bf16_t, WS_KG) + base; r.V = WSP(bf16_t, WS_VG) + base; r.O = dummy ? WSP(bf16_t, WS_MERGED) + (base % (SZ_XB / 2 - 65536)) : (bf16_t*)r.Q;
                    r.LSE = WSP(float, WS_LSE) + (size_t)bgh * 2048 + qb * 256; r.P0 = qb * 256; r.W = 129; r.segmask = (2048 >> (2 * g)) - 1; r.skv = 2048; r.ostride = 128; }
                else { const int idx = L - NDIL, bh = idx >> 3, qb = idx & 7, bl = bh >> 2, h = bh & 3; const size_t kvb = (size_t)(ch * BC * 4 + bh) * 256 * 128;
                    r.Q = WSP(bf16_t, WS_QM) + ((size_t)bh * 2048 + qb * 256) * 128; r.K = WSP(bf16_t, WS_KM) + kvb; r.V = WSP(bf16_t, WS_VM) + kvb;
                    r.O = WSP(bf16_t, WS_OMT) + ((size_t)bl * 2048 + qb * 256) * 512 + h * 128; r.LSE = nullptr; r.P0 = 256; r.W = 1 << 20; r.segmask = (1 << 20) - 1; r.skv = 256; r.ostride = 512; }
                return r; };
            int L = vcu;
            if (L < NBLK) {
                swa::BlockRef cur = make_ref(L); swa::Seam Sm;
                swa::prime(cur, (char*)lds_raw + RING_OFF, Sm, wave);
                for (;;) {
                    const bool more = L + G < NBLK; const int Ln = more ? L + G : L;
                    const swa::BlockRef nxt = more ? make_ref(Ln) : cur;
                    swa::block(cur, nxt, (char*)lds_raw + RING_OFF, Sm, wave);
                    if (!more) break;
                    cur = nxt; L = Ln;
                }
            }
            __syncthreads();
            { const Params pc = load_params(kargs); const int ptid = opaque_tid(wave); for (int u = bx; u < BC * 64; u += G) conv_unit(pc, u, lds_raw + RING_OFF, ptid); }
            if (PROBE_DUP == 13) { const int ptid = opaque_tid(wave); for (int u = bx; u < BC * 64; u += G) conv_unit(p, u, lds_raw + RING_OFF, ptid); }
            if (PROBE_DUP == 14) {
                int L = NDIL + vcu;
                if (L < NBLK) { swa::BlockRef cur = make_ref(L); swa::Seam Sm; swa::prime(cur, (char*)lds_raw + RING_OFF, Sm, wave);
                    for (;;) { const bool more = L + G < NBLK; const int Ln = more ? L + G : L; const swa::BlockRef nxt = more ? make_ref(Ln) : cur; swa::block(cur, nxt, (char*)lds_raw + RING_OFF, Sm, wave); if (!more) break; cur = nxt; L = Ln; } }
                __syncthreads();
            }
            }
        }
#endif
        SEAM(ph0 + 1);
        if (HAS(3) && IN(ph0 + 2)) { const Params p = load_params(kargs); const int ptid = opaque_tid(wave); for (int rep = 0; rep < NREP(3); ++rep) for (int w = bx * NWAVES + (ptid >> 6); w < TC; w += G * NWAVES) combine_token(p, w, ptid & 63); }
        SEAM(ph0 + 2);
        if (HAS(4) && IN(ph0 + 3)) {
            const Params p = load_params(kargs);
            SchedMerge S; S.to.init(TC / 256, 4, G, bx); S.A0 = (const char*)WSP(bf16_t, WS_OATT); S.W = (const char*)WSP(bf16_t, WS_WA);
            FastEpiMerge E{WSP(bf16_t, WS_GATES), WSP(bf16_t, WS_MERGED)};
            if (PROBE_DUP == 15) { FastEpiStore E2{WSP(bf16_t, WS_MERGED), 1024, 1.0f}; pg8::gemm_phase<FastEpiStore, SchedMerge, true, false, false>(lds + RING_OFF, nullptr, 512, 512, 512, S, E2, wave); }
            for (int rep = 0; rep < NREP(4); ++rep) pg8::gemm_phase<FastEpiMerge, SchedMerge, true, false, false>(lds + RING_OFF, nullptr, 512, 512, 512, S, E, wave);
        }
        SEAM(ph0 + 3);
        if (HAS(5) && IN(ph0 + 4)) {
            const Params p = load_params(kargs);
            SchedPlain S; S.to.init(TC / 256, 4, G, bx); S.A = (const char*)WSP(bf16_t, WS_MERGED); S.B = (const char*)WSP(bf16_t, WS_WOUT); S.astep = 256 * 2048; S.bstep = 256 * 2048;
            FastEpiStore E{(bf16_t*)p.out + (size_t)ch * TC * 1024, 1024, 1.0f};
            for (int rep = 0; rep < NREP(5); ++rep) pg8::gemm_phase<FastEpiStore, SchedPlain, true, false, false>(lds + RING_OFF, nullptr, 1024, 1024, 1024, S, E, wave);
        }
        SEAM(ph0 + 4);
    }

    if (HAS(6) && IN(PH_LN1)) {
        const Params p = load_params(kargs);
        float* wr = (float*)(lds_raw + RING_OFF); int* cls_l = (int*)(wr + 20 * 1024); int* misc = cls_l + 64;
        for (int i = opaque_tid(wave); i < 20 * 1024; i += NTHR) wr[i] = WSP(float, WS_WRT)[i];
        __syncthreads();
        { const int ptid = opaque_tid(wave); for (int rep = 0; rep < NREP(6); ++rep) for (int u = bx; u < T / 64; u += G) ln1_unit(p, u, wr, cls_l, misc, ptid, (PROBE_DUP == 6) && rep == 0); }
    }
    SEAM(PH_LN1);
    if (IN(PH_MOE1) || IN(PH_MOE2) || IN(PH_LN2)) {
        const int tid = opaque_tid(wave);
        if (tid == 0) class_tab_fill(ctl + CW_CNT, tab);
        __syncthreads();
        const int NP = tab->rowbase[NCLS] >> 8;
        for (int pm = tid; pm < NP; pm += NTHR) pan_cls[pm] = find_class(tab, pm * 256);
        __syncthreads();
    }
    if (HAS(7) && IN(PH_MOE1)) {
        const Params p = load_params(kargs);
        const int NP = tab->rowbase[NCLS] >> 8;
        SchedMoe S; S.to.init(NP, 8, G, bx); S.pan_cls = (LAS const int*)(lds + LCTL_OFF + 512); S.toktab = (LAS const int*)(lds + LTOK_OFF); S.H = nullptr; S.W1 = (const char*)WSP(bf16_t, WS_W1); S.W2 = nullptr; S.mode = 1;
        const int tid = opaque_tid(wave);
        for (int i = 0; i < MAXU; ++i) { int pm, pn; if (!S.to.tile(i, pm, pn)) break;
            if (tid < 256) { const int cls = pan_cls[pm]; int r = pm * 256 + tid - tab->rowbase[cls]; if (r >= tab->cnt[cls]) r = tab->cnt[cls] - 1; toktab[i * 256 + tid] = WSP(int, WS_LIST)[(size_t)cls * T + r]; } }
        __syncthreads();
        FastEpiMoe1 E{(LAS const int*)(lds + LTOK_OFF), WSP(float, WS_WTS), p.ws + WS_H};
        for (int rep = 0; rep < NREP(7); ++rep) pg8::gemm_phase<FastEpiMoe1, SchedMoe, true, true, false, true>(lds + RING_OFF, (const char*)(p.ws + WS_X1B8), 512, 512, 512, S, E, wave);
    }
    SEAM(PH_MOE1);
    if (HAS(8) && IN(PH_MOE2)) {
        const Params p = load_params(kargs);
        const int NP = tab->rowbase[NCLS] >> 8;
        SchedMoe S; S.to.init(NP, 4, G, bx); S.pan_cls = (LAS const int*)(lds + LCTL_OFF + 512); S.toktab = (LAS const int*)(lds + LTOK_OFF); S.H = (const char*)WSP(bf16_t, WS_H); S.W1 = nullptr; S.W2 = (const char*)WSP(bf16_t, WS_W2); S.mode = 2;
        FastEpiStore E{WSP(bf16_t, WS_Y2), 1024, 1.0f / (H8_SCALE * W8_SCALE)};
        for (int rep = 0; rep < NREP(8); ++rep) pg8::gemm_phase<FastEpiStore, SchedMoe, true, false, true, true>(lds + RING_OFF, nullptr, 512, 4096, 512, S, E, wave);
    }
    SEAM(PH_MOE2);
    if (HAS(9) && IN(PH_LN2)) {
        const Params p = load_params(kargs);
        const int tot = tab->rowbase[NCLS]; const int lane = opaque_tid(wave) & 63;
        for (int rep = 0; rep < NREP(9); ++rep)
        for (int prow = bx * NWAVES + wave; prow < tot; prow += 2 * G * NWAVES) {
            int tk[2], pr[2];
#pragma unroll
            for (int r = 0; r < 2; ++r) { pr[r] = prow + r * G * NWAVES; tk[r] = -1;
                if (pr[r] < tot) { const int cls = pan_cls[pr[r] >> 8]; const int i = pr[r] - tab->rowbase[cls]; if (i < tab->cnt[cls]) tk[r] = WSP(int, WS_LIST)[(size_t)cls * T + i]; } }
            ln2_rows<2>(p, tk, pr, lane, ((PROBE_DUP == 9) && rep == 0) ? (float*)(p.ws + 512 * MiB) : nullptr);
        }
    }
#undef IN
#undef HAS
#undef SEAM
}

#ifndef MK_MODE
#define MK_MODE 3
#endif
extern "C" void kernel_launch(void* const* d_in, const int* in_sizes, int n_in, void* d_out, int out_size, void* d_ws, size_t ws_size, hipStream_t stream) {
    if (n_in != 25 || ws_size < WS_END) { fprintf(stderr, "kernel_launch: unexpected n_in %d / ws_size %zu (need %zu)\n", n_in, ws_size, (size_t)WS_END); return; }
    static int grid = 0;
    if (grid == 0) {
        (void)hipFuncSetAttribute((const void*)k_ln1, hipFuncAttributeMaxDynamicSharedMemorySize, 20 * 1024 * 4 + 1024);
        if (hipFuncSetAttribute((const void*)mk_fwd, hipFuncAttributeMaxDynamicSharedMemorySize, LDS_BYTES) != hipSuccess) fprintf(stderr, "kernel_launch: hipFuncSetAttribute(mk_fwd, %d) failed\n", LDS_BYTES);
        int dev = 0, cus = 0; (void)hipGetDevice(&dev);
        if (hipDeviceGetAttribute(&cus, hipDeviceAttributeMultiprocessorCount, dev) != hipSuccess || cus <= 0) cus = 256;
        int per_cu = 0; (void)hipOccupancyMaxActiveBlocksPerMultiprocessor(&per_cu, (const void*)mk_fwd, NTHR, LDS_BYTES);
        if (per_cu < 1) fprintf(stderr, "kernel_launch: occupancy query reports %d blocks per CU for mk_fwd\n", per_cu);
        (void)hipGetLastError();
        grid = cus;
    }
    Params p{};
    p.x = (const float*)d_in[0]; p.mem = (const float*)d_in[1]; p.pos = (const int*)d_in[2];
    p.w_in = (const float*)d_in[3]; p.b_in = (const float*)d_in[4]; p.conv_w = (const float*)d_in[5]; p.conv_b = (const float*)d_in[6];
    p.conv_g = (const float*)d_in[7]; p.conv_bb = (const float*)d_in[8]; p.w_mem_kv = (const float*)d_in[9]; p.w_attn_o = (const float*)d_in[10];
    p.w_conv_o = (const float*)d_in[11]; p.w_mem_o = (const float*)d_in[12]; p.w_out = (const float*)d_in[13]; p.ln1_g = (const float*)d_in[14]; p.ln1_b = (const float*)d_in[15];
    p.w_gr = (const float*)d_in[16]; p.b_gr = (const float*)d_in[17]; p.w_er = (const float*)d_in[18]; p.b_er = (const float*)d_in[19];
    p.w_eg = (const float*)d_in[20]; p.w_eu = (const float*)d_in[21]; p.w_ed = (const float*)d_in[22]; p.ln2_g = (const float*)d_in[23]; p.ln2_b = (const float*)d_in[24];
    p.out = (float*)d_out; p.ws = (unsigned char*)d_ws;
    (void)hipMemsetAsync((char*)d_ws + WS_CTL, 0, CTL_BYTES, stream);
#if PROBE_DUP == 12
    (void)hipMemsetAsync((char*)d_ws + 944 * MiB, 0, 64 * MiB, stream);
#endif
    auto mk = [&](int lo, int hi) { Args a{}; a.p = p; a.ph_lo = lo; a.ph_hi = hi; hipLaunchKernelGGL(mk_fwd, dim3(grid), dim3(NTHR), LDS_BYTES, stream, a); };
#if MK_MODE == 3
    mk(0, PH_END);
#elif MK_MODE == 2
    for (int ph = 0; ph < PH_END; ++ph) mk(ph, ph + 1);
#elif MK_MODE == 1
    mk(PH_P0, PH_P0 + 1);
    for (int ch = 0; ch < NCH; ++ch) {
        const int ph0 = PH_CH0 + PH_PER_CH * ch;
        mk(ph0, ph0 + 1);
        k_nattn_dil<<<BC * 12 * 2048 / 4, 256, 0, stream>>>(p);
        k_nattn_mem<<<BC * 4 * 2048 / 4, 256, 0, stream>>>(p, ch);
        k_conv<<<BC * 64, 512, 0, stream>>>(p);
        mk(ph0 + 2, ph0 + 3); mk(ph0 + 3, ph0 + 4); mk(ph0 + 4, ph0 + 5);
    }
    mk(PH_LN1, PH_LN1 + 1); mk(PH_MOE1, PH_MOE1 + 1); mk(PH_MOE2, PH_MOE2 + 1); mk(PH_LN2, PH_LN2 + 1);
#else
    for (int w = 0; w < 8; ++w) k_transpose_w<<<2048, 256, 0, stream>>>(p, w);
    k_small_prep<<<(20 * 1024 + 255) / 256, 256, 0, stream>>>(p);
    k_cvt_bf16<<<2048, 256, 0, stream>>>(p.mem, (bf16_t*)((char*)d_ws + WS_MEMB), (size_t)NB * MEML * 1024 / 8);
    k_cvt_bf16<<<4096, 256, 0, stream>>>(p.x, (bf16_t*)((char*)d_ws + WS_XB), (size_t)T * 1024 / 8);
    k_ngemm_kv<<<dim3(1024 / 64, NB * MEML / 64), 256, 0, stream>>>(p, 0);
    for (int ch = 0; ch < NCH; ++ch) {
        k_ngemm_main<<<dim3(INC / 64, TC / 64), 256, 0, stream>>>(p, ch);
        k_nattn_dil<<<BC * 12 * 2048 / 4, 256, 0, stream>>>(p);
        k_nattn_mem<<<BC * 4 * 2048 / 4, 256, 0, stream>>>(p, ch);
        k_conv<<<BC * 64, 512, 0, stream>>>(p);
        k_combine<<<TC / 4, 256, 0, stream>>>(p);
        for (int br = 0; br < 3; ++br) k_ngemm_merge<<<dim3(1024 / 64, TC / 64), 256, 0, stream>>>(p, br);
        k_ngemm_mix<<<dim3(1024 / 64, TC / 64), 256, 0, stream>>>(p, ch);
    }
    k_ln1<<<256, 512, 20 * 1024 * 4 + 1024, stream>>>(p);
    k_ngemm_moe1<<<dim3(2048 / 64, MPAD / 64), 256, 0, stream>>>(p);
    k_ngemm_moe2<<<dim3(1024 / 64, MPAD / 64), 256, 0, stream>>>(p);
    k_ln2<<<MPAD / 4, 256, 0, stream>>>(p);
#endif
}
```

```cpp
#include <hip/hip_runtime.h>
#include <cstdio>
#include <cstdint>

constexpr int D = 1024, NB = 32, S = 2048, T = NB * S;
constexpr int NCH = 2, BC = NB / NCH, TC = T / NCH;
constexpr int INC = 9216;
constexpr int MEML = 256;
constexpr int NCLS = 24;
constexpr int MPAD = T + NCLS * 256;
constexpr float LN_EPS = 1e-5f;
constexpr float DN_ALPHA = 1.189207115002721f;
constexpr float ATT_SCALE = 0.08838834764831845f;

constexpr int C_Q = 0, C_K = 1536, C_V = 3072, C_GLU = 4608, C_QM = 5632, C_GATE = 6144;

constexpr size_t MiB = 1ull << 20;
constexpr size_t WS_CTL = 0, CTL_BYTES = 1 * MiB;
constexpr size_t WS_WIN = 1 * MiB;
constexpr size_t WS_BIASP = 19 * MiB;
constexpr size_t WS_WRT = 19 * MiB + 64 * 1024;
constexpr size_t WS_WKV = 20 * MiB;
constexpr size_t WS_WA = 22 * MiB, WS_WC = 23 * MiB, WS_WM = 24 * MiB;
constexpr size_t WS_WOUT = 25 * MiB;
constexpr size_t WS_W1 = 27 * MiB;
constexpr size_t WS_W2 = 59 * MiB;
constexpr size_t WS_MEMB = 75 * MiB;
constexpr size_t WS_CH = 91 * MiB;
constexpr size_t SZ_XB = (size_t)TC * 1024 * 2, SZ_QKV1 = (size_t)TC * 1536 * 2, SZ_512 = (size_t)TC * 512 * 2;
constexpr size_t WS_XB = WS_CH;
constexpr size_t WS_QG = WS_XB + (size_t)T * 1024 * 2, WS_KG = WS_QG + SZ_QKV1, WS_VG = WS_KG + SZ_QKV1;
constexpr size_t WS_CGLU = WS_VG + SZ_QKV1, WS_QM = WS_CGLU + SZ_512, WS_OATT = WS_QM + SZ_512, WS_CCONV = WS_OATT + SZ_512, WS_OMT = WS_CCONV + SZ_512;
constexpr size_t WS_GATES = WS_OMT + SZ_512;
constexpr size_t SZ_KM = (size_t)NB * 4 * MEML * 128 * 2;
constexpr size_t WS_KM = WS_GATES + (size_t)TC * 3072 * 2, WS_VM = WS_KM + SZ_KM;
constexpr size_t WS_LSE = WS_VM + SZ_KM;
constexpr size_t WS_MERGED = WS_LSE + 2 * MiB;
constexpr size_t WS_CH_END = WS_MERGED + SZ_XB;
constexpr size_t WS_X1B = WS_CH;
constexpr size_t WS_H = WS_X1B + (size_t)T * 1024 * 2;
constexpr size_t WS_Y2 = WS_H + (size_t)MPAD * 1024 * 2;
constexpr size_t WS_LIST = WS_Y2 + (size_t)MPAD * 1024 * 2;
constexpr size_t WS_WTS = WS_LIST + (size_t)NCLS * T * 4;
constexpr size_t WS_X1B8 = WS_WTS + (size_t)T * 8;
constexpr size_t WS_MOE_END = WS_X1B8 + (size_t)T * 1024;
#ifndef P5_FP8
#define P5_FP8 1
#endif
#ifndef Y2_FP8
#define Y2_FP8 1
#endif
constexpr float Y8_SCALE = 16.0f;
#ifndef P4_FP8
#define P4_FP8 1
#endif
constexpr float O8_SCALE = 16.0f;
constexpr float M8_SCALE = 16.0f;
constexpr float W8_SCALE = 32.0f, H8_SCALE = 16.0f;
constexpr size_t WS_END = WS_CH_END > WS_MOE_END ? WS_CH_END : WS_MOE_END;
constexpr size_t WS_XB8 = 944 * MiB;
constexpr size_t WS_WG8 = 1008 * MiB;
constexpr float WG8_SCALE = 32.0f;
static_assert(WS_CH_END <= WS_XB8 && WS_WG8 + 9 * MiB <= 1024 * MiB, "fp8 operand buffers");
static_assert(WS_END <= 1024 * MiB, "workspace map exceeds 1 GiB");
constexpr int CW_CNT = 64;

typedef unsigned short bf16_t;
typedef float f32x4 __attribute__((ext_vector_type(4)));
typedef unsigned u32x4 __attribute__((ext_vector_type(4)));
typedef unsigned u32x2 __attribute__((ext_vector_type(2)));

__device__ __forceinline__ float bf2f(bf16_t b) { return __uint_as_float(((unsigned)b) << 16); }
__device__ __forceinline__ float bflo(unsigned w) { return __uint_as_float(w << 16); }
__device__ __forceinline__ float bfhi(unsigned w) { return __uint_as_float(w & 0xffff0000u); }
__device__ __forceinline__ unsigned f2bf(float f) { unsigned u = __float_as_uint(f); return (u + 0x7fffu + ((u >> 16) & 1u)) >> 16; }
typedef float f32x2_t __attribute__((ext_vector_type(2)));
typedef __bf16 bf16x2_t __attribute__((ext_vector_type(2)));
__device__ __forceinline__ unsigned pk2(float lo, float hi) { f32x2_t v = {lo, hi}; bf16x2_t b = __builtin_convertvector(v, bf16x2_t); return __builtin_bit_cast(unsigned, b); }
__device__ __forceinline__ float sigmoidf_(float x) { return __builtin_amdgcn_rcpf(1.0f + __builtin_amdgcn_exp2f(-1.4426950408889634f * x)); }
__device__ __forceinline__ float wave_sum(float v) {
#define DPP_F(x, ctrl) __int_as_float(__builtin_amdgcn_update_dpp(0, __float_as_int(x), ctrl, 0xf, 0xf, true))
    v += DPP_F(v, 0xB1);
    v += DPP_F(v, 0x4E);
    v += DPP_F(v, 0x141);
    v += DPP_F(v, 0x140);
#undef DPP_F
    { const auto r = __builtin_amdgcn_permlane16_swap(__float_as_uint(v), __float_as_uint(v), false, false); v = __uint_as_float(r[0]) + __uint_as_float(r[1]); }
    { const auto r = __builtin_amdgcn_permlane32_swap(__float_as_uint(v), __float_as_uint(v), false, false); v = __uint_as_float(r[0]) + __uint_as_float(r[1]); }
    return v;
}
__device__ __forceinline__ float wave_max(float v) {
#pragma unroll
    for (int o = 1; o < 64; o <<= 1) v = fmaxf(v, __shfl_xor(v, o));
    return v;
}
__device__ __forceinline__ unsigned pk4_fp8(float a, float b, float c, float d) { unsigned w = 0; w = __builtin_amdgcn_cvt_pk_fp8_f32(a, b, w, false); w = __builtin_amdgcn_cvt_pk_fp8_f32(c, d, w, true); return w; }
__device__ __forceinline__ unsigned pk4_fp8s(float a, float b, float c, float d) { return pk4_fp8(__builtin_amdgcn_fmed3f(a, -448.f, 448.f), __builtin_amdgcn_fmed3f(b, -448.f, 448.f), __builtin_amdgcn_fmed3f(c, -448.f, 448.f), __builtin_amdgcn_fmed3f(d, -448.f, 448.f)); }
__device__ __forceinline__ unsigned pk4_u8(float a, float b, float c, float d) {
    const unsigned ua = (unsigned)fmaxf(__builtin_rintf(a * 255.f), 1.f), ub = (unsigned)fmaxf(__builtin_rintf(b * 255.f), 1.f), uc = (unsigned)fmaxf(__builtin_rintf(c * 255.f), 1.f), ud = (unsigned)fmaxf(__builtin_rintf(d * 255.f), 1.f);
    return ua | (ub << 8) | (uc << 16) | (ud << 24); }
__device__ __forceinline__ float sig255(float x) { const float e = __builtin_amdgcn_exp2f(-1.4426950408889634f * x); return fmaxf(__builtin_rintf(__builtin_amdgcn_rcpf(__builtin_fmaf(e, 1.0f / 255.0f, 1.0f / 255.0f))), 1.0f); }
__device__ __forceinline__ unsigned pk4_sig_u8(float a, float b, float c, float d) { unsigned w = 0u;
    w = __builtin_amdgcn_cvt_pk_u8_f32(sig255(a), 0, w); w = __builtin_amdgcn_cvt_pk_u8_f32(sig255(b), 1, w); w = __builtin_amdgcn_cvt_pk_u8_f32(sig255(c), 2, w); w = __builtin_amdgcn_cvt_pk_u8_f32(sig255(d), 3, w); return w; }
__device__ __forceinline__ f32x4 u8x4_raw(unsigned w) { return (f32x4){(float)(w & 255u), (float)((w >> 8) & 255u), (float)((w >> 16) & 255u), (float)(w >> 24)}; }
__device__ __forceinline__ f32x4 u8x4_to_f32(unsigned w) { return (f32x4){(float)(w & 255u), (float)((w >> 8) & 255u), (float)((w >> 16) & 255u), (float)(w >> 24)} * (1.0f / 255.0f); }
#ifndef P1_FP6
#define P1_FP6 0
#endif
typedef float v16f_t __attribute__((ext_vector_type(16)));
typedef unsigned v6u_t __attribute__((ext_vector_type(6)));
__device__ __forceinline__ v6u_t pack32_fp6(const float (&v)[32]) {
    v16f_t a, b;
#pragma unroll
    for (int i = 0; i < 16; ++i) { a[i] = fminf(fmaxf(v[i], -7.5f), 7.5f); b[i] = fminf(fmaxf(v[16 + i], -7.5f), 7.5f); }
    return __builtin_amdgcn_cvt_scalef32_2xpk16_fp6_f32(a, b, 1.0f);
}
__device__ __forceinline__ int opaque_tid(int wave_s) { unsigned z = 0u; asm volatile("" : "+v"(z)); const int l = (int)__builtin_amdgcn_mbcnt_hi(~0u, __builtin_amdgcn_mbcnt_lo(~0u, z)); return (wave_s << 6) | l; }
__device__ __forceinline__ void rope_cs(float pos, int j, float& c, float& s) {
    const float invrev = __builtin_amdgcn_exp2f(-(float)j * (13.287712379549449f / 64.0f)) * 0.15915494309189535f;
    float rev = pos * invrev; rev = __builtin_amdgcn_fractf(rev);
    s = __builtin_amdgcn_sinf(rev); c = __builtin_amdgcn_cosf(rev);
}
__device__ __forceinline__ int rowperm(int g, int s) { return g == 0 ? s : (g == 1 ? ((s & 3) * 512 + (s >> 2)) : ((s & 15) * 128 + (s >> 4))); }
__host__ __device__ __forceinline__ int win_logical(int n) {
    if (n < C_V) { const int sec = n / 1536, r = n % 1536, gh = r / 128, p = r % 128, G = p >> 3, nn = (p >> 2) & 1, e = p & 3; return sec * 1536 + gh * 128 + 64 * nn + 4 * G + e; }
    if (n < C_GLU) return n;
    if (n < C_QM) { const int cc = n - C_GLU, G = cc >> 3, nn = (cc >> 2) & 1, e = cc & 3; return C_GLU + nn * 512 + 4 * G + e; }
    return n;
}

struct Params {
    const float *x, *mem; const int* pos;
    const float *w_in, *b_in, *conv_w, *conv_b, *conv_g, *conv_bb, *w_mem_kv, *w_attn_o, *w_conv_o, *w_mem_o, *w_out, *ln1_g, *ln1_b;
    const float *w_gr, *b_gr, *w_er, *b_er, *w_eg, *w_eu, *w_ed, *ln2_g, *ln2_b;
    float* out; unsigned char* ws;
};
#define WSP(T_, off) ((T_*)(p.ws + (off)))

__global__ void k_cvt_bf16(const float* __restrict__ src, bf16_t* __restrict__ dst, size_t n8) {
    for (size_t i = (size_t)blockIdx.x * blockDim.x + threadIdx.x; i < n8; i += (size_t)gridDim.x * blockDim.x) {
        const f32x4 a = *(const f32x4*)(src + i * 8), b = *(const f32x4*)(src + i * 8 + 4);
        u32x4 o; o.x = pk2(a.x, a.y); o.y = pk2(a.z, a.w); o.z = pk2(b.x, b.y); o.w = pk2(b.z, b.w);
        *(u32x4*)(dst + i * 8) = o;
    }
}
enum { TW_IN = 0, TW_KV, TW_A, TW_C, TW_M, TW_OUT, TW_W1, TW_W2 };
__device__ __forceinline__ void transpose_w_dev(const Params& p, int which, size_t gtid, size_t gstride) {
    int K, N, ldd; bf16_t* dst;
    switch (which) {
        case TW_IN: K = 1024; N = INC; ldd = 1024; dst = WSP(bf16_t, WS_WIN); break;
        case TW_KV: K = 1024; N = 1024; ldd = 1024; dst = WSP(bf16_t, WS_WKV); break;
        case TW_A: K = 512; N = 1024; ldd = 512; dst = WSP(bf16_t, WS_WA); break;
        case TW_C: K = 512; N = 1024; ldd = 512; dst = WSP(bf16_t, WS_WC); break;
        case TW_M: K = 512; N = 1024; ldd = 512; dst = WSP(bf16_t, WS_WM); break;
        case TW_OUT: K = 1024; N = 1024; ldd = 1024; dst = WSP(bf16_t, WS_WOUT); break;
        case TW_W1: K = 1024; N = 16 * 1024; ldd = 1024; dst = WSP(bf16_t, WS_W1); break;
        default: K = 512; N = 16 * 1024; ldd = 8192; dst = WSP(bf16_t, WS_W2); break;
    }
    const size_t total = (size_t)N * (K / 8);
    for (size_t i = gtid; i < total; i += gstride) {
        const int n = (int)(i % N), k0 = (int)(i / N) * 8;
        float v[8];
#pragma unroll
        for (int j = 0; j < 8; ++j) {
            const int k = k0 + j; float s;
            switch (which) {
                case TW_IN: s = p.w_in[(size_t)k * INC + win_logical(n)]; break;
                case TW_KV: s = p.w_mem_kv[(size_t)k * 1024 + n]; break;
                case TW_A: s = p.w_attn_o[(size_t)k * 1024 + n]; break;
                case TW_C: s = p.w_conv_o[(size_t)k * 1024 + n]; break;
                case TW_M: s = p.w_mem_o[(size_t)k * 1024 + n]; break;
                case TW_OUT: s = p.w_out[(size_t)k * 1024 + n]; break;
                case TW_W1: { const int e = n >> 10, c = n & 1023, G = c >> 3, nn = (c >> 2) & 1, ee = c & 3, jj = 4 * G + ee;
                              s = (nn ? p.w_eu : p.w_eg)[((size_t)e * 1024 + k) * 512 + jj]; } break;
                default: { const int e = n >> 10, c = n & 1023; s = p.w_ed[((size_t)e * 512 + k) * 1024 + c]; } break;
            }
            v[j] = s;
        }
        u32x4 o; o.x = pk2(v[0], v[1]); o.y = pk2(v[2], v[3]); o.z = pk2(v[4], v[5]); o.w = pk2(v[6], v[7]);
        size_t doff;
        if (which == TW_W2) { const int e = n >> 10, c = n & 1023; doff = (size_t)c * 8192 + e * 512 + k0; }
        else doff = (size_t)n * ldd + k0;
        *(u32x4*)(dst + doff) = o;
    }
}
__global__ void k_transpose_w(Params p, int which) { transpose_w_dev(p, which, (size_t)blockIdx.x * blockDim.x + threadIdx.x, (size_t)gridDim.x * blockDim.x); }
__device__ __forceinline__ void small_prep_dev(const Params& p, size_t gtid, size_t gstride) {
    for (size_t ii = gtid; ii < 20 * 1024; ii += gstride) { const int i = (int)ii;
        if (i < INC) WSP(float, WS_BIASP)[i] = p.b_in[win_logical(i)];
        const int e = i >> 10, k = i & 1023;
        WSP(float, WS_WRT)[i] = e < 4 ? p.w_gr[k * 4 + e] : p.w_er[((size_t)((e - 4) >> 2) * 1024 + k) * 4 + ((e - 4) & 3)]; }
}
__global__ void k_small_prep(Params p) { small_prep_dev(p, (size_t)blockIdx.x * blockDim.x + threadIdx.x, (size_t)gridDim.x * blockDim.x); }

struct EpiMain {
    const float* biasp; const int* pos; bf16_t *QG, *CGLU, *QM, *GATES; int tok0;
    static __device__ __forceinline__ void rope_freqs(int c0, float (&invrev)[4]) {
        const int j0 = ((c0 & 127) >> 3) * 4;
#pragma unroll
        for (int e = 0; e < 4; ++e) invrev[e] = __builtin_amdgcn_exp2f(-(float)(j0 + e) * (13.287712379549449f / 64.0f)) * 0.15915494309189535f;
    }
    template <int S> __device__ __forceinline__ void finish_s(int rl, int c0, float (&v)[8], float fpos, const float (&invrev)[4]) const {
        const int bl = rl >> 11, s = rl & 2047;
        if constexpr (S <= 1) {
            const int tcol = __builtin_amdgcn_readfirstlane(c0 & ~255);
            const int sec = tcol / 1536, r = c0 - sec * 1536, gh = r >> 7, pcol = r & 127, g = gh >> 2;
            if constexpr (S == 0) {
#pragma unroll
                for (int e = 0; e < 4; ++e) { const float rev = __builtin_amdgcn_fractf(fpos * invrev[e]); const float sn = __builtin_amdgcn_sinf(rev), c = __builtin_amdgcn_cosf(rev);
                    const float t1 = v[e], t2 = v[4 + e]; v[e] = t1 * c - t2 * sn; v[4 + e] = t2 * c + t1 * sn; }
            }
            bf16_t* base = QG + (size_t)sec * (SZ_QKV1 / 2);
            u32x4 o; o.x = pk2(v[0], v[1]); o.y = pk2(v[2], v[3]); o.z = pk2(v[4], v[5]); o.w = pk2(v[6], v[7]);
            *(u32x4*)(base + ((size_t)(bl * 12 + gh) * 2048 + rowperm(g, s)) * 128 + pcol) = o;
        } else if constexpr (S == 2) {
            const int j0 = (c0 - C_GLU) >> 1;
            u32x2 o; o.x = pk2(v[0] * sigmoidf_(v[4]), v[1] * sigmoidf_(v[5])); o.y = pk2(v[2] * sigmoidf_(v[6]), v[3] * sigmoidf_(v[7]));
            *(u32x2*)(CGLU + (size_t)rl * 512 + j0) = o;
        } else {
            const int cc = c0 - C_QM, h = cc >> 7, pcol = cc & 127;
            u32x4 o; o.x = pk2(v[0], v[1]); o.y = pk2(v[2], v[3]); o.z = pk2(v[4], v[5]); o.w = pk2(v[6], v[7]);
            *(u32x4*)(QM + ((size_t)(bl * 4 + h) * 2048 + s) * 128 + pcol) = o;
        }
    }
    __device__ __forceinline__ void finish(int rl, int c0, float (&v)[8], float fpos, const float (&invrev)[4]) const {
        const int bl = rl >> 11, s = rl & 2047;
        const int tcol = __builtin_amdgcn_readfirstlane(c0 & ~255);
        if (tcol < C_GLU) {
            const int sec = tcol / 1536, r = c0 - sec * 1536, gh = r >> 7, pcol = r & 127, g = gh >> 2;
            if (sec < 2) {
#pragma unroll
                for (int e = 0; e < 4; ++e) { const float rev = __builtin_amdgcn_fractf(fpos * invrev[e]); const float sn = __builtin_amdgcn_sinf(rev), c = __builtin_amdgcn_cosf(rev);
                    const float t1 = v[e], t2 = v[4 + e]; v[e] = t1 * c - t2 * sn; v[4 + e] = t2 * c + t1 * sn; }
            }
            bf16_t* base = QG + (size_t)sec * (SZ_QKV1 / 2);
            u32x4 o; o.x = pk2(v[0], v[1]); o.y = pk2(v[2], v[3]); o.z = pk2(v[4], v[5]); o.w = pk2(v[6], v[7]);
            *(u32x4*)(base + ((size_t)(bl * 12 + gh) * 2048 + rowperm(g, s)) * 128 + pcol) = o;
        } else if (tcol < C_QM) {
            const int j0 = (c0 - C_GLU) >> 1;
            u32x2 o; o.x = pk2(v[0] * sigmoidf_(v[4]), v[1] * sigmoidf_(v[5])); o.y = pk2(v[2] * sigmoidf_(v[6]), v[3] * sigmoidf_(v[7]));
            *(u32x2*)(CGLU + (size_t)rl * 512 + j0) = o;
        } else if (tcol < C_GATE) {
            const int cc = c0 - C_QM, h = cc >> 7, pcol = cc & 127;
            u32x4 o; o.x = pk2(v[0], v[1]); o.y = pk2(v[2], v[3]); o.z = pk2(v[4], v[5]); o.w = pk2(v[6], v[7]);
            *(u32x4*)(QM + ((size_t)(bl * 4 + h) * 2048 + s) * 128 + pcol) = o;
        } else {
            const int cc = c0 - C_GATE;
            u32x2 o; o.x = pk4_sig_u8(v[0], v[1], v[2], v[3]); o.y = pk4_sig_u8(v[4], v[5], v[6], v[7]);
            *(u32x2*)((unsigned char*)GATES + (size_t)rl * 3072 + cc) = o;
        }
    }
    __device__ __forceinline__ void operator()(int rl, int c0, float (&v)[8]) const {
        const f32x4 b0 = *(const f32x4*)(biasp + c0), b1 = *(const f32x4*)(biasp + c0 + 4);
        v[0] += b0.x; v[1] += b0.y; v[2] += b0.z; v[3] += b0.w; v[4] += b1.x; v[5] += b1.y; v[6] += b1.z; v[7] += b1.w;
        float invrev[4]; rope_freqs(c0, invrev);
        finish(rl, c0, v, c0 < C_V ? (float)pos[tok0 + rl] : 0.f, invrev);
    }
};
struct EpiKV {
    bf16_t *KM;
    __device__ __forceinline__ void operator()(int row, int c0, float (&v)[8]) const {
        const int bl = row >> 8, m = row & 255, isv = c0 >> 9, cc = c0 & 511, h = cc >> 7, pcol = cc & 127;
        u32x4 o; o.x = pk2(v[0], v[1]); o.y = pk2(v[2], v[3]); o.z = pk2(v[4], v[5]); o.w = pk2(v[6], v[7]);
        *(u32x4*)(KM + (size_t)isv * (SZ_KM / 2) + ((size_t)(bl * 4 + h) * 256 + m) * 128 + pcol) = o;
    }
};
struct EpiMerge {
    const bf16_t* GATES; bf16_t* MERGED; int br;
    __device__ __forceinline__ void operator()(int rl, int c0, float (&v)[8]) const {
        const u32x2 g = *(const u32x2*)((const unsigned char*)GATES + (size_t)rl * 3072 + br * 1024 + c0);
        const f32x4 g0 = u8x4_to_f32(g.x), g1 = u8x4_to_f32(g.y);
        float r[8] = {g0.x * v[0], g0.y * v[1], g0.z * v[2], g0.w * v[3], g1.x * v[4], g1.y * v[5], g1.z * v[6], g1.w * v[7]};
        bf16_t* mp = MERGED + (size_t)rl * 1024 + c0;
        if (br > 0) { const u32x4 m = *(const u32x4*)mp; r[0] += bflo(m.x); r[1] += bfhi(m.x); r[2] += bflo(m.y); r[3] += bfhi(m.y); r[4] += bflo(m.z); r[5] += bfhi(m.z); r[6] += bflo(m.w); r[7] += bfhi(m.w); }
        u32x4 o; o.x = pk2(r[0], r[1]); o.y = pk2(r[2], r[3]); o.z = pk2(r[4], r[5]); o.w = pk2(r[6], r[7]);
        *(u32x4*)mp = o;
    }
};
struct EpiMix {
    bf16_t* MIX; int tok0;
    __device__ __forceinline__ void operator()(int rl, int c0, float (&v)[8]) const {
        u32x4 o; o.x = pk2(v[0], v[1]); o.y = pk2(v[2], v[3]); o.z = pk2(v[4], v[5]); o.w = pk2(v[6], v[7]);
        *(u32x4*)(MIX + (size_t)(tok0 + rl) * 1024 + c0) = o;
    }
};
struct ClassTab { int cnt[NCLS], rowbase[NCLS + 1]; };
__device__ __forceinline__ void class_tab_fill(const unsigned* cntw, ClassTab* t) {
    int acc = 0;
    for (int c = 0; c < NCLS; ++c) { const int n = (int)cntw[c]; t->cnt[c] = n; t->rowbase[c] = acc; acc += ((n + 255) >> 8) << 8; }
    t->rowbase[NCLS] = acc;
}
__device__ __forceinline__ void class_experts(int cls, int& e_lo, int& e_hi) {
    const int g = cls / 6, pi = cls - g * 6;
    const int lo = pi < 3 ? 0 : (pi < 5 ? 1 : 2), hi = pi < 3 ? pi + 1 : (pi < 5 ? pi - 1 : 3);
    e_lo = g * 4 + lo; e_hi = g * 4 + hi;
}
struct EpiMoe1 {
    const int* list; const float* wts; bf16_t* H; int cls, cnt, rowbase;
    __device__ __forceinline__ void operator()(int prow, int c0, float (&v)[8]) const {
        int i = prow - rowbase; if (i >= cnt) i = cnt - 1;
        const int tok = list[i]; const int hi = c0 >> 10; const float w = wts[(size_t)tok * 2 + hi];
        const int j0 = hi * 512 + ((c0 & 1023) >> 1);
        float r[4];
#pragma unroll
        for (int e = 0; e < 4; ++e) { const float gt = v[e]; r[e] = gt * sigmoidf_(gt) * v[4 + e] * w; }
        u32x2 o; o.x = pk2(r[0], r[1]); o.y = pk2(r[2], r[3]);
        *(u32x2*)(H + (size_t)prow * 1024 + j0) = o;
    }
};
struct EpiMoe2 {
    bf16_t* Y2;
    __device__ __forceinline__ void operator()(int prow, int c0, float (&v)[8]) const {
        u32x4 o; o.x = pk2(v[0], v[1]); o.y = pk2(v[2], v[3]); o.z = pk2(v[4], v[5]); o.w = pk2(v[6], v[7]);
        *(u32x4*)(Y2 + (size_t)prow * 1024 + c0) = o;
    }
};

struct RowsPlain { const bf16_t* base; int ld; __device__ __forceinline__ const bf16_t* operator()(int r) const { return base + (size_t)r * ld; } };
template <class AF, class BF, class EF>
__device__ __forceinline__ void ngemm_tile(int row0, int col0, int K, const AF& af, const BF& bf, const EF& ef, int bkseg, long bjump) {
    __shared__ float As[64][33], Bs[64][33];
    const int tid = threadIdx.x, ty = tid >> 3, tx = tid & 7;
    float acc[2][8];
#pragma unroll
    for (int i = 0; i < 2; ++i)
#pragma unroll
        for (int j = 0; j < 8; ++j) acc[i][j] = 0.f;
    const int lr = tid >> 2, lk = (tid & 3) * 8;
    const bf16_t* ap = af(row0 + lr); const bf16_t* bp = bf(col0 + lr);
    for (int k0 = 0; k0 < K; k0 += 32) {
        const u32x4 a = *(const u32x4*)(ap + k0 + lk);
        const long bo = (long)k0 + lk + (long)(k0 / bkseg) * bjump;
        const u32x4 b = *(const u32x4*)(bp + bo);
        __syncthreads();
        As[lr][lk + 0] = bflo(a.x); As[lr][lk + 1] = bfhi(a.x); As[lr][lk + 2] = bflo(a.y); As[lr][lk + 3] = bfhi(a.y);
        As[lr][lk + 4] = bflo(a.z); As[lr][lk + 5] = bfhi(a.z); As[lr][lk + 6] = bflo(a.w); As[lr][lk + 7] = bfhi(a.w);
        Bs[lr][lk + 0] = bflo(b.x); Bs[lr][lk + 1] = bfhi(b.x); Bs[lr][lk + 2] = bflo(b.y); Bs[lr][lk + 3] = bfhi(b.y);
        Bs[lr][lk + 4] = bflo(b.z); Bs[lr][lk + 5] = bfhi(b.z); Bs[lr][lk + 6] = bflo(b.w); Bs[lr][lk + 7] = bfhi(b.w);
        __syncthreads();
#pragma unroll 8
        for (int kk = 0; kk < 32; ++kk) {
            const float a0 = As[2 * ty][kk], a1 = As[2 * ty + 1][kk];
#pragma unroll
            for (int j = 0; j < 8; ++j) { const float bv = Bs[8 * tx + j][kk]; acc[0][j] += a0 * bv; acc[1][j] += a1 * bv; }
        }
    }
    ef(row0 + 2 * ty, col0 + 8 * tx, acc[0]);
    ef(row0 + 2 * ty + 1, col0 + 8 * tx, acc[1]);
}
__global__ void __launch_bounds__(256) k_ngemm_main(Params p, int ch) {
    const int tok0 = ch * TC;
    EpiMain E{WSP(float, WS_BIASP), p.pos, WSP(bf16_t, WS_QG), WSP(bf16_t, WS_CGLU), WSP(bf16_t, WS_QM), WSP(bf16_t, WS_GATES), tok0};
    RowsPlain A{WSP(bf16_t, WS_XB) + (size_t)ch * TC * 1024, 1024}, Bm{WSP(bf16_t, WS_WIN), 1024};
    ngemm_tile(blockIdx.y * 64, blockIdx.x * 64, 1024, A, Bm, E, 1 << 30, 0);
}
__global__ void __launch_bounds__(256) k_ngemm_kv(Params p, int ch) {
    EpiKV E{WSP(bf16_t, WS_KM)};
    RowsPlain A{WSP(bf16_t, WS_MEMB), 1024}, Bm{WSP(bf16_t, WS_WKV), 1024};
    ngemm_tile(blockIdx.y * 64, blockIdx.x * 64, 1024, A, Bm, E, 1 << 30, 0);
}
__global__ void __launch_bounds__(256) k_ngemm_merge(Params p, int br) {
    EpiMerge E{WSP(bf16_t, WS_GATES), WSP(bf16_t, WS_MERGED), br};
    RowsPlain A{WSP(bf16_t, WS_OATT + (size_t)br * SZ_512), 512};
    RowsPlain Bm{WSP(bf16_t, WS_WA + (size_t)br * MiB), 512};
    ngemm_tile(blockIdx.y * 64, blockIdx.x * 64, 512, A, Bm, E, 1 << 30, 0);
}
__global__ void __launch_bounds__(256) k_ngemm_mix(Params p, int ch) {
    EpiMix E{(bf16_t*)p.out, ch * TC};
    RowsPlain A{WSP(bf16_t, WS_MERGED), 1024}, Bm{WSP(bf16_t, WS_WOUT), 1024};
    ngemm_tile(blockIdx.y * 64, blockIdx.x * 64, 1024, A, Bm, E, 1 << 30, 0);
}
struct RowsGather { const bf16_t* base; const int* list; int cnt, rowbase; __device__ __forceinline__ const bf16_t* operator()(int prow) const { int i = prow - rowbase; if (i >= cnt) i = cnt - 1; return base + (size_t)list[i] * 1024; } };
__device__ __forceinline__ int find_class(const ClassTab* t, int prow) { int c = 0;
    for (int i = 1; i < NCLS; ++i) if (prow >= t->rowbase[i]) c = i;
    return c; }
__global__ void __launch_bounds__(256) k_ngemm_moe1(Params p) {
    __shared__ ClassTab tabs; if (threadIdx.x == 0) class_tab_fill(WSP(unsigned, WS_CTL) + CW_CNT, &tabs); __syncthreads(); const ClassTab* tab = &tabs;
    const int row0 = blockIdx.y * 64; if (row0 >= tab->rowbase[NCLS]) return;
    const int cls = find_class(tab, row0); if (tab->cnt[cls] == 0) return;
    int e_lo, e_hi; class_experts(cls, e_lo, e_hi);
    const int col0 = blockIdx.x * 64, hi = col0 >> 10;
    const int* list = WSP(int, WS_LIST) + (size_t)cls * T;
    RowsGather A{WSP(bf16_t, WS_X1B), list, tab->cnt[cls], tab->rowbase[cls]};
    RowsPlain Bm{WSP(bf16_t, WS_W1) + ((size_t)(hi ? e_hi : e_lo) * 1024 - (size_t)hi * 1024) * 1024, 1024};
    EpiMoe1 E{list, WSP(float, WS_WTS), WSP(bf16_t, WS_H), cls, tab->cnt[cls], tab->rowbase[cls]};
    ngemm_tile(row0, col0, 1024, A, Bm, E, 1 << 30, 0);
}
__global__ void __launch_bounds__(256) k_ngemm_moe2(Params p) {
    __shared__ ClassTab tabs; if (threadIdx.x == 0) class_tab_fill(WSP(unsigned, WS_CTL) + CW_CNT, &tabs); __syncthreads(); const ClassTab* tab = &tabs;
    const int row0 = blockIdx.y * 64; if (row0 >= tab->rowbase[NCLS]) return;
    const int cls = find_class(tab, row0); if (tab->cnt[cls] == 0) return;
    int e_lo, e_hi; class_experts(cls, e_lo, e_hi);
    RowsPlain A{WSP(bf16_t, WS_H), 1024};
    RowsPlain Bm{WSP(bf16_t, WS_W2) + (size_t)e_lo * 512, 8192};
    EpiMoe2 E{WSP(bf16_t, WS_Y2)};
    ngemm_tile(row0, blockIdx.x * 64, 1024, A, Bm, E, 512, (long)(e_hi - e_lo - 1) * 512);
}

__device__ __forceinline__ void nattn_row(const bf16_t* qp, const bf16_t* kbase, const bf16_t* vbase, int nkeys, bf16_t* op, float* lsep, int lane) {
    const unsigned qw = *(const unsigned*)(qp + 2 * lane); const float q0 = bflo(qw), q1 = bfhi(qw);
    float sc[4] = {-INFINITY, -INFINITY, -INFINITY, -INFINITY};
#pragma unroll
    for (int kb = 0; kb < 4; ++kb) {
        for (int kk = 0; kk < 64; ++kk) { const int k = kb * 64 + kk; if (k >= nkeys) break;
            const unsigned kw = *(const unsigned*)(kbase + (size_t)k * 128 + 2 * lane);
            const float s = wave_sum(q0 * bflo(kw) + q1 * bfhi(kw)) * ATT_SCALE;
            if (lane == kk) sc[kb] = s; }
    }
    const float m = wave_max(fmaxf(fmaxf(sc[0], sc[1]), fmaxf(sc[2], sc[3])));
    float pr[4]; float ps = 0.f;
#pragma unroll
    for (int kb = 0; kb < 4; ++kb) { pr[kb] = __expf(sc[kb] - m); ps += pr[kb]; }
    const float l = wave_sum(ps);
    float a0 = 0.f, a1 = 0.f;
#pragma unroll
    for (int kb = 0; kb < 4; ++kb) {
        for (int kk = 0; kk < 64; ++kk) { const int k = kb * 64 + kk; if (k >= nkeys) break;
            const float pk = __shfl(pr[kb], kk);
            const unsigned vw = *(const unsigned*)(vbase + (size_t)k * 128 + 2 * lane);
            a0 += pk * bflo(vw); a1 += pk * bfhi(vw); }
    }
    const float inv = 1.0f / l;
    *(unsigned*)(op + 2 * lane) = pk2(a0 * inv, a1 * inv);
    if (lsep && lane == 0) *lsep = m + __logf(l);
}
__global__ void __launch_bounds__(256) k_nattn_dil(Params p) {
    const int lane = threadIdx.x & 63; const size_t w = (size_t)blockIdx.x * 4 + (threadIdx.x >> 6);
    if (w >= (size_t)BC * 12 * 2048) return;
    const int row = (int)(w & 2047); const int bgh = (int)(w >> 11); const int g = (bgh % 12) >> 2;
    const int seglen = 2048 >> (2 * g); const int pin = row & (seglen - 1); const int nk = pin + 1 < 129 ? pin + 1 : 129;
    bf16_t* Q = WSP(bf16_t, WS_QG) + ((size_t)bgh * 2048 + row) * 128;
    const bf16_t* K = WSP(bf16_t, WS_KG) + ((size_t)bgh * 2048 + row - nk + 1) * 128;
    const bf16_t* V = WSP(bf16_t, WS_VG) + ((size_t)bgh * 2048 + row - nk + 1) * 128;
    nattn_row(Q, K, V, nk, Q, WSP(float, WS_LSE) + (size_t)bgh * 2048 + row, lane);
}
__global__ void __launch_bounds__(256) k_nattn_mem(Params p, int ch) {
    const int lane = threadIdx.x & 63; const size_t w = (size_t)blockIdx.x * 4 + (threadIdx.x >> 6);
    if (w >= (size_t)BC * 4 * 2048) return;
    const int s = (int)(w & 2047); const int bh = (int)(w >> 11); const int bl = bh >> 2, h = bh & 3;
    const bf16_t* Q = WSP(bf16_t, WS_QM) + ((size_t)bh * 2048 + s) * 128;
    const bf16_t* K = WSP(bf16_t, WS_KM) + (size_t)(ch * BC * 4 + bh) * 256 * 128;
    const bf16_t* V = WSP(bf16_t, WS_VM) + (size_t)(ch * BC * 4 + bh) * 256 * 128;
    nattn_row(Q, K, V, 256, WSP(bf16_t, WS_OMT) + ((size_t)(bl * 2048 + s)) * 512 + h * 128, nullptr, lane);
}

__device__ __forceinline__ void combine_token(const Params& p, int rl, int lane) {
    const int bl = rl >> 11, s = rl & 2047, h = lane >> 4, d0 = (lane & 15) * 8;
    float ls[3]; u32x4 o[3];
#pragma unroll
    for (int g = 0; g < 3; ++g) { const size_t r = (size_t)(bl * 12 + g * 4 + h) * 2048 + rowperm(g, s);
        ls[g] = WSP(float, WS_LSE)[r]; o[g] = *(const u32x4*)(WSP(bf16_t, WS_QG) + r * 128 + d0); }
    const float m = fmaxf(ls[0], fmaxf(ls[1], ls[2]));
    float w0 = __expf(ls[0] - m), w1 = __expf(ls[1] - m), w2 = __expf(ls[2] - m); const float inv = 1.0f / (w0 + w1 + w2); w0 *= inv; w1 *= inv; w2 *= inv;
    u32x4 r;
    r.x = pk2(w0 * bflo(o[0].x) + w1 * bflo(o[1].x) + w2 * bflo(o[2].x), w0 * bfhi(o[0].x) + w1 * bfhi(o[1].x) + w2 * bfhi(o[2].x));
    r.y = pk2(w0 * bflo(o[0].y) + w1 * bflo(o[1].y) + w2 * bflo(o[2].y), w0 * bfhi(o[0].y) + w1 * bfhi(o[1].y) + w2 * bfhi(o[2].y));
    r.z = pk2(w0 * bflo(o[0].z) + w1 * bflo(o[1].z) + w2 * bflo(o[2].z), w0 * bfhi(o[0].z) + w1 * bfhi(o[1].z) + w2 * bfhi(o[2].z));
    r.w = pk2(w0 * bflo(o[0].w) + w1 * bflo(o[1].w) + w2 * bflo(o[2].w), w0 * bfhi(o[0].w) + w1 * bfhi(o[1].w) + w2 * bfhi(o[2].w));
#if P4_FP8
    u32x2 r8; r8.x = pk4_fp8(O8_SCALE * bflo(r.x), O8_SCALE * bfhi(r.x), O8_SCALE * bflo(r.y), O8_SCALE * bfhi(r.y)); r8.y = pk4_fp8(O8_SCALE * bflo(r.z), O8_SCALE * bfhi(r.z), O8_SCALE * bflo(r.w), O8_SCALE * bfhi(r.w));
    *(u32x2*)(p.ws + WS_OATT + (size_t)rl * 512 + h * 128 + d0) = r8;
#else
    *(u32x4*)(WSP(bf16_t, WS_OATT) + (size_t)rl * 512 + h * 128 + d0) = r;
#endif
}
__device__ __forceinline__ void combine_token2(const Params& p, int rl0, int rl1, int lane) {
    const int h = lane >> 4, d0 = (lane & 15) * 8;
    float ls[2][3]; u32x4 o[2][3];
#pragma unroll
    for (int t = 0; t < 2; ++t) { const int rl = t ? rl1 : rl0; const int bl = rl >> 11, s = rl & 2047;
#pragma unroll
        for (int g = 0; g < 3; ++g) { const size_t r = (size_t)(bl * 12 + g * 4 + h) * 2048 + rowperm(g, s);
            ls[t][g] = WSP(float, WS_LSE)[r]; o[t][g] = *(const u32x4*)(WSP(bf16_t, WS_QG) + r * 128 + d0); } }
#pragma unroll
    for (int t = 0; t < 2; ++t) { const int rl = t ? rl1 : rl0;
        const float m = fmaxf(ls[t][0], fmaxf(ls[t][1], ls[t][2]));
        float w0 = __expf(ls[t][0] - m), w1 = __expf(ls[t][1] - m), w2 = __expf(ls[t][2] - m); const float inv = 1.0f / (w0 + w1 + w2); w0 *= inv; w1 *= inv; w2 *= inv;
#define CMB(c, f) (w0 * f(o[t][0].c) + w1 * f(o[t][1].c) + w2 * f(o[t][2].c))
#if P4_FP8
        u32x4 r; r.x = pk2(CMB(x, bflo), CMB(x, bfhi)); r.y = pk2(CMB(y, bflo), CMB(y, bfhi)); r.z = pk2(CMB(z, bflo), CMB(z, bfhi)); r.w = pk2(CMB(w, bflo), CMB(w, bfhi));
        u32x2 r8; r8.x = pk4_fp8(O8_SCALE * bflo(r.x), O8_SCALE * bfhi(r.x), O8_SCALE * bflo(r.y), O8_SCALE * bfhi(r.y)); r8.y = pk4_fp8(O8_SCALE * bflo(r.z), O8_SCALE * bfhi(r.z), O8_SCALE * bflo(r.w), O8_SCALE * bfhi(r.w));
        *(u32x2*)(p.ws + WS_OATT + (size_t)rl * 512 + h * 128 + d0) = r8;
#else
        u32x4 r; r.x = pk2(CMB(x, bflo), CMB(x, bfhi)); r.y = pk2(CMB(y, bflo), CMB(y, bfhi)); r.z = pk2(CMB(z, bflo), CMB(z, bfhi)); r.w = pk2(CMB(w, bflo), CMB(w, bfhi));
        *(u32x4*)(WSP(bf16_t, WS_OATT) + (size_t)rl * 512 + h * 128 + d0) = r;
#endif
#undef CMB
    }
}
__global__ void __launch_bounds__(256) k_combine(Params p) {
    const int lane = threadIdx.x & 63; const int w = blockIdx.x * 4 + (threadIdx.x >> 6);
    if (w < TC) combine_token(p, w, lane);
}
constexpr int CONV_TILE = 62 * 1024, CONV_OUT = 32 * 1024, CONV_LDS = CONV_TILE + CONV_OUT + (8 * 32 + 64) * 4;
__device__ __forceinline__ void conv_unit(const Params& p, int u, unsigned char* lds, int tid_) {
    const int ch = tid_, lane = ch & 63, wv = ch >> 6;
    const int bl = u >> 6, s0 = (u & 63) * 32;
    bf16_t* tile = (bf16_t*)lds; bf16_t* otile = (bf16_t*)(lds + CONV_TILE); float* red = (float*)(lds + CONV_TILE + CONV_OUT);
    const bf16_t* cg = WSP(bf16_t, WS_CGLU) + (size_t)bl * 2048 * 512;
#pragma unroll
    for (int it = 0; it < 8; ++it) { const int c = it * 512 + ch; if (c < 62 * 64) { const int r = c >> 6, q = c & 63, s = s0 - 30 + r;
        u32x4 v = {0u, 0u, 0u, 0u}; if (s >= 0) v = *(const u32x4*)(cg + (size_t)s * 512 + q * 8);
        *(u32x4*)(tile + r * 512 + q * 8) = v; } }
    __syncthreads();
    float o[32]; const float cb = p.conv_b[ch];
#pragma unroll
    for (int i = 0; i < 32; ++i) o[i] = cb;
    {   float in[62];
#pragma unroll
        for (int i = 0; i < 62; ++i) in[i] = bf2f(tile[i * 512 + ch]);
#pragma unroll
        for (int j = 0; j < 31; ++j) { const float w = p.conv_w[j * 512 + ch];
#pragma unroll
            for (int i = 0; i < 32; ++i) o[i] += w * in[i + j]; } }
    float* mean = red + 256; float* rstd = red + 288;
#pragma unroll
    for (int i = 0; i < 32; ++i) { const float sr = wave_sum(o[i]); if (lane == 0) red[wv * 32 + i] = sr; }
    __syncthreads();
    if (ch < 32) { float sm = 0.f;
#pragma unroll
        for (int w = 0; w < 8; ++w) sm += red[w * 32 + ch];
        mean[ch] = sm * (1.0f / 512.0f); }
    __syncthreads();
#pragma unroll
    for (int i = 0; i < 32; ++i) { o[i] -= mean[i]; const float sr = wave_sum(o[i] * o[i]); if (lane == 0) red[wv * 32 + i] = sr; }
    __syncthreads();
    if (ch < 32) { float sm = 0.f;
#pragma unroll
        for (int w = 0; w < 8; ++w) sm += red[w * 32 + ch];
        rstd[ch] = 1.0f / sqrtf(sm * (1.0f / 512.0f) + LN_EPS); }
    __syncthreads();
    const float gg = p.conv_g[ch], bb = p.conv_bb[ch];
#pragma unroll
#if P4_FP8
    for (int i = 0; i < 32; ++i) { const float y = o[i] * rstd[i] * gg + bb; const float z = O8_SCALE * (y * sigmoidf_(y)); ((unsigned char*)otile)[i * 512 + ch] = (unsigned char)(__builtin_amdgcn_cvt_pk_fp8_f32(z, z, 0, false) & 255); }
    __syncthreads();
    unsigned char* outp = p.ws + WS_CCONV + ((size_t)bl * 2048 + s0) * 512;
#pragma unroll
    for (int it = 0; it < 2; ++it) { const int c = it * 512 + ch; *(u32x4*)(outp + (size_t)c * 16) = *(const u32x4*)((const unsigned char*)otile + c * 16); }
#else
    for (int i = 0; i < 32; ++i) { const float y = o[i] * rstd[i] * gg + bb; otile[i * 512 + ch] = (bf16_t)f2bf(y * sigmoidf_(y)); }
    __syncthreads();
    bf16_t* outp = WSP(bf16_t, WS_CCONV) + ((size_t)bl * 2048 + s0) * 512;
#pragma unroll
    for (int it = 0; it < 4; ++it) { const int c = it * 512 + ch; *(u32x4*)(outp + (size_t)c * 8) = *(const u32x4*)(otile + c * 8); }
#endif
    __syncthreads();
}
__global__ void __launch_bounds__(512) k_conv(Params p) {
    __shared__ __attribute__((aligned(16))) unsigned char cl[CONV_LDS];
    conv_unit(p, blockIdx.x, cl, threadIdx.x);
}
__device__ __forceinline__ void ln1_unit(const Params& p, int u, const float* wr, int* cls_l, int* misc, int tid_, bool dummy = false) {
    const int tid = tid_, lane = tid & 63, wv = tid >> 6;
    float gam[16], bet[16];
#pragma unroll
    for (int j = 0; j < 4; ++j) { const f32x4 g4 = *(const f32x4*)(p.ln1_g + 4 * lane + 256 * j), b4 = *(const f32x4*)(p.ln1_b + 4 * lane + 256 * j);
        gam[4 * j] = g4.x; gam[4 * j + 1] = g4.y; gam[4 * j + 2] = g4.z; gam[4 * j + 3] = g4.w; bet[4 * j] = b4.x; bet[4 * j + 1] = b4.y; bet[4 * j + 2] = b4.z; bet[4 * j + 3] = b4.w; }
    const int tok0 = u * 64 + wv * 8;
    u32x2 xq[2][4]; u32x2 mq[2][4];
#define LN1_LOAD(slot, rr) do { const bf16_t* xr_ = WSP(bf16_t, WS_XB) + (size_t)(tok0 + (rr)) * 1024 + 4 * lane; const bf16_t* mr_ = (const bf16_t*)p.out + (size_t)(tok0 + (rr)) * 1024 + 4 * lane; \
        _Pragma("unroll") for (int j = 0; j < 4; ++j) { xq[slot][j] = *(const u32x2*)(xr_ + 256 * j); mq[slot][j] = *(const u32x2*)(mr_ + 256 * j); } } while (0)
    LN1_LOAD(0, 0);
#pragma unroll
    for (int rr = 0; rr < 8; ++rr) {
        const int lr = wv * 8 + rr; const int tok = tok0 + rr;
        if (rr + 1 < 8) { if (rr & 1) LN1_LOAD(0, rr + 1); else LN1_LOAD(1, rr + 1); }
        float v[16]; float sm = 0.f;
#pragma unroll
        for (int j = 0; j < 4; ++j) { const u32x2 t = xq[rr & 1][j]; const u32x2 mm = mq[rr & 1][j];
            v[4 * j] = DN_ALPHA * bflo(t.x) + bflo(mm.x); v[4 * j + 1] = DN_ALPHA * bfhi(t.x) + bfhi(mm.x); v[4 * j + 2] = DN_ALPHA * bflo(t.y) + bflo(mm.y); v[4 * j + 3] = DN_ALPHA * bfhi(t.y) + bfhi(mm.y);
            sm += (v[4 * j] + v[4 * j + 1]) + (v[4 * j + 2] + v[4 * j + 3]); }
        const float mean = wave_sum(sm) * (1.0f / 1024.0f); float sq = 0.f;
#pragma unroll
        for (int i = 0; i < 16; ++i) { v[i] -= mean; sq += v[i] * v[i]; }
        const float rstd = 1.0f / sqrtf(wave_sum(sq) * (1.0f / 1024.0f) + LN_EPS);
#pragma unroll
        for (int i = 0; i < 16; ++i) v[i] = v[i] * rstd * gam[i] + bet[i];
        bf16_t* xb = WSP(bf16_t, dummy ? WS_H : WS_X1B) + (size_t)tok * 1024;
#pragma unroll
        for (int j = 0; j < 4; ++j) { u32x2 o; o.x = pk2(v[4 * j], v[4 * j + 1]); o.y = pk2(v[4 * j + 2], v[4 * j + 3]); *(u32x2*)(xb + 4 * lane + 256 * j) = o; }
        if (!dummy) { unsigned char* x8 = p.ws + WS_X1B8 + (size_t)tok * 1024;
#pragma unroll
            for (int j = 0; j < 4; ++j) *(unsigned*)(x8 + 4 * lane + 256 * j) = pk4_fp8(v[4 * j], v[4 * j + 1], v[4 * j + 2], v[4 * j + 3]); }
        float gl[4];
#pragma unroll
        for (int e = 0; e < 4; ++e) { float a = 0.f;
#pragma unroll
            for (int j = 0; j < 4; ++j) { const f32x4 w4 = *(const f32x4*)(wr + e * 1024 + 4 * lane + 256 * j); a += v[4 * j] * w4.x + v[4 * j + 1] * w4.y + v[4 * j + 2] * w4.z + v[4 * j + 3] * w4.w; }
            gl[e] = wave_sum(a) + p.b_gr[e]; }
        int gs = 0; float gm = gl[0];
#pragma unroll
        for (int e = 1; e < 4; ++e) if (gl[e] > gm) { gm = gl[e]; gs = e; }
        float gsum = 0.f;
#pragma unroll
        for (int e = 0; e < 4; ++e) gsum += __expf(gl[e] - gm);
        const float gprob = 1.0f / gsum;
        gs = __builtin_amdgcn_readfirstlane(gs);
        float el[4];
#pragma unroll
        for (int e = 0; e < 4; ++e) { float a = 0.f; const float* wp = wr + (4 + gs * 4 + e) * 1024;
#pragma unroll
            for (int j = 0; j < 4; ++j) { const f32x4 w4 = *(const f32x4*)(wp + 4 * lane + 256 * j); a += v[4 * j] * w4.x + v[4 * j + 1] * w4.y + v[4 * j + 2] * w4.z + v[4 * j + 3] * w4.w; }
            el[e] = wave_sum(a) + p.b_er[gs * 4 + e]; }
        int i1 = 0; float v1 = el[0];
#pragma unroll
        for (int e = 1; e < 4; ++e) if (el[e] > v1) { v1 = el[e]; i1 = e; }
        int i2 = -1; float v2 = -INFINITY;
#pragma unroll
        for (int e = 0; e < 4; ++e) if (e != i1 && el[e] > v2) { v2 = el[e]; i2 = e; }
        const float t2 = __expf(v2 - v1); const float w1 = gprob / (1.0f + t2), w2 = gprob * t2 / (1.0f + t2);
        const int lo = i1 < i2 ? i1 : i2, hi = i1 < i2 ? i2 : i1;
        const int pi = lo == 0 ? hi - 1 : (lo == 1 ? hi + 1 : 5);
        if (lane == 0 && !dummy) { cls_l[lr] = gs * 6 + pi; float* wt = WSP(float, WS_WTS) + (size_t)tok * 2; wt[0] = (i1 == lo) ? w1 : w2; wt[1] = (i1 == lo) ? w2 : w1; }
    }
#undef LN1_LOAD
    __syncthreads();
    if (dummy) return;
    if (tid < NCLS) { int n = 0; for (int r = 0; r < 64; ++r) n += (cls_l[r] == tid); misc[tid] = n ? (int)atomicAdd(WSP(unsigned, WS_CTL) + CW_CNT + tid, (unsigned)n) : 0; }
    __syncthreads();
    if (tid < 64) { const int c = cls_l[tid]; int rank = 0; for (int r = 0; r < tid; ++r) rank += (cls_l[r] == c);
        WSP(int, WS_LIST)[(size_t)c * T + misc[c] + rank] = u * 64 + tid; }
    __syncthreads();
}
__device__ __forceinline__ float row16_sum(float v) {
#define DPP_F(x, ctrl) __int_as_float(__builtin_amdgcn_update_dpp(0, __float_as_int(x), ctrl, 0xf, 0xf, true))
    v += DPP_F(v, 0xB1); v += DPP_F(v, 0x4E); v += DPP_F(v, 0x141); v += DPP_F(v, 0x140);
#undef DPP_F
    return v;
}
__device__ __forceinline__ void ln1_unit16(const Params& p, int u, const float* wr, int* cls_l, int* misc, int tid_, bool dummy = false) {
    const int tid = tid_, lane = tid & 63, wv = tid >> 6;
#pragma unroll 1
    for (int pass = 0; pass < 2; ++pass) {
        int q = lane >> 4, l16 = lane & 15; asm volatile("" : "+v"(q), "+v"(l16));
        const int lr = wv * 8 + pass * 4 + q; const int tok = u * 64 + lr;
        const bf16_t* xr = WSP(bf16_t, WS_XB) + (size_t)tok * 1024 + 4 * l16; const bf16_t* mr = (const bf16_t*)p.out + (size_t)tok * 1024 + 4 * l16;
        u32x2 xq[16], mq[16]; f32x4 g4[16], b4[16];
#pragma unroll
        for (int c = 0; c < 16; ++c) { xq[c] = *(const u32x2*)(xr + 64 * c); mq[c] = *(const u32x2*)(mr + 64 * c); }
#pragma unroll
        for (int c = 0; c < 16; ++c) { g4[c] = *(const f32x4*)(p.ln1_g + 64 * c + 4 * l16); b4[c] = *(const f32x4*)(p.ln1_b + 64 * c + 4 * l16); }
        float v[64]; float sm = 0.f;
#pragma unroll
        for (int c = 0; c < 16; ++c) { const u32x2 t = xq[c], mm = mq[c];
            v[4 * c] = DN_ALPHA * bflo(t.x) + bflo(mm.x); v[4 * c + 1] = DN_ALPHA * bfhi(t.x) + bfhi(mm.x); v[4 * c + 2] = DN_ALPHA * bflo(t.y) + bflo(mm.y); v[4 * c + 3] = DN_ALPHA * bfhi(t.y) + bfhi(mm.y);
            sm += (v[4 * c] + v[4 * c + 1]) + (v[4 * c + 2] + v[4 * c + 3]); }
        const float mean = row16_sum(sm) * (1.0f / 1024.0f); float sq = 0.f;
#pragma unroll
        for (int i = 0; i < 64; ++i) { v[i] -= mean; sq += v[i] * v[i]; }
        const float rstd = 1.0f / sqrtf(row16_sum(sq) * (1.0f / 1024.0f) + LN_EPS);
        bf16_t* xb = WSP(bf16_t, dummy ? WS_H : WS_X1B) + (size_t)tok * 1024 + 4 * l16; unsigned char* x8 = p.ws + WS_X1B8 + (size_t)tok * 1024 + 4 * l16;
#pragma unroll
        for (int c = 0; c < 16; ++c) {
            v[4 * c] = v[4 * c] * rstd * g4[c].x + b4[c].x; v[4 * c + 1] = v[4 * c + 1] * rstd * g4[c].y + b4[c].y; v[4 * c + 2] = v[4 * c + 2] * rstd * g4[c].z + b4[c].z; v[4 * c + 3] = v[4 * c + 3] * rstd * g4[c].w + b4[c].w;
            u32x2 o; o.x = pk2(v[4 * c], v[4 * c + 1]); o.y = pk2(v[4 * c + 2], v[4 * c + 3]); *(u32x2*)(xb + 64 * c) = o;
            if (!dummy) *(unsigned*)(x8 + 64 * c) = pk4_fp8(v[4 * c], v[4 * c + 1], v[4 * c + 2], v[4 * c + 3]); }
        asm volatile("" ::: "memory");
        float gl[4];
#pragma unroll
        for (int e = 0; e < 4; ++e) { float a = 0.f;
#pragma unroll
            for (int c = 0; c < 16; ++c) { const f32x4 w4 = *(const f32x4*)(wr + e * 1024 + 64 * c + 4 * l16); a += v[4 * c] * w4.x + v[4 * c + 1] * w4.y + v[4 * c + 2] * w4.z + v[4 * c + 3] * w4.w; }
            gl[e] = a; asm volatile("" ::: "memory"); }
#pragma unroll
        for (int e = 0; e < 4; ++e) gl[e] = row16_sum(gl[e]) + p.b_gr[e];
        int gs = 0; float gm = gl[0];
#pragma unroll
        for (int e = 1; e < 4; ++e) if (gl[e] > gm) { gm = gl[e]; gs = e; }
        float gsum = 0.f;
#pragma unroll
        for (int e = 0; e < 4; ++e) gsum += __expf(gl[e] - gm);
        const float gprob = 1.0f / gsum;
        float el[4]; const float* wpb = wr + (4 + gs * 4) * 1024 + 4 * l16;
#pragma unroll
        for (int e = 0; e < 4; ++e) { float a = 0.f;
#pragma unroll
            for (int c = 0; c < 16; ++c) { const f32x4 w4 = *(const f32x4*)(wpb + e * 1024 + 64 * c); a += v[4 * c] * w4.x + v[4 * c + 1] * w4.y + v[4 * c + 2] * w4.z + v[4 * c + 3] * w4.w; }
            el[e] = a; asm volatile("" ::: "memory"); }
#pragma unroll
        for (int e = 0; e < 4; ++e) el[e] = row16_sum(el[e]) + p.b_er[gs * 4 + e];
        int i1 = 0; float v1 = el[0];
#pragma unroll
        for (int e = 1; e < 4; ++e) if (el[e] > v1) { v1 = el[e]; i1 = e; }
        int i2 = -1; float v2 = -INFINITY;
#pragma unroll
        for (int e = 0; e < 4; ++e) if (e != i1 && el[e] > v2) { v2 = el[e]; i2 = e; }
        const float t2 = __expf(v2 - v1); const float w1 = gprob / (1.0f + t2), w2 = gprob * t2 / (1.0f + t2);
        const int lo = i1 < i2 ? i1 : i2, hi = i1 < i2 ? i2 : i1;
        const int pi = lo == 0 ? hi - 1 : (lo == 1 ? hi + 1 : 5);
        if (l16 == 0 && !dummy) { cls_l[lr] = gs * 6 + pi; float* wt = WSP(float, WS_WTS) + (size_t)tok * 2; wt[0] = (i1 == lo) ? w1 : w2; wt[1] = (i1 == lo) ? w2 : w1; }
    }
    __syncthreads();
    if (dummy) return;
    if (tid < NCLS) { int n = 0; for (int r = 0; r < 64; ++r) n += (cls_l[r] == tid); misc[tid] = n ? (int)atomicAdd(WSP(unsigned, WS_CTL) + CW_CNT + tid, (unsigned)n) : 0; }
    __syncthreads();
    if (tid < 64) { const int c = cls_l[tid]; int rank = 0; for (int r = 0; r < tid; ++r) rank += (cls_l[r] == c);
        WSP(int, WS_LIST)[(size_t)c * T + misc[c] + rank] = u * 64 + tid; }
    __syncthreads();
}
__global__ void __launch_bounds__(512) k_ln1(Params p) {
    extern __shared__ float dyn[];
    float* wr = dyn; int* cls_l = (int*)(dyn + 20 * 1024); int* misc = cls_l + 64;
    for (int i = threadIdx.x; i < 20 * 1024; i += 512) wr[i] = WSP(float, WS_WRT)[i];
    __syncthreads();
    for (int u = blockIdx.x; u < T / 64; u += gridDim.x) ln1_unit(p, u, wr, cls_l, misc, threadIdx.x);
}
template <int NR>
__device__ __forceinline__ void ln2_rows(const Params& p, const int (&tok)[NR], const int (&prow)[NR], int lane, float* dummy = nullptr) {
    u32x2 xa[NR][4];
#if Y2_FP8
    unsigned ya[NR][4];
#pragma unroll
    for (int r = 0; r < NR; ++r) if (tok[r] >= 0) { const bf16_t* xrow = WSP(bf16_t, WS_X1B) + (size_t)tok[r] * 1024 + 4 * lane; const unsigned char* yrow = p.ws + WS_Y2 + (size_t)prow[r] * 1024 + 4 * lane;
#pragma unroll
        for (int j = 0; j < 4; ++j) { xa[r][j] = *(const u32x2*)(xrow + 256 * j); ya[r][j] = *(const unsigned*)(yrow + 256 * j); } }
#else
    u32x2 ya[NR][4];
#pragma unroll
    for (int r = 0; r < NR; ++r) if (tok[r] >= 0) { const bf16_t* xrow = WSP(bf16_t, WS_X1B) + (size_t)tok[r] * 1024 + 4 * lane; const bf16_t* yrow = WSP(bf16_t, WS_Y2) + (size_t)prow[r] * 1024 + 4 * lane;
#pragma unroll
        for (int j = 0; j < 4; ++j) { xa[r][j] = *(const u32x2*)(xrow + 256 * j); ya[r][j] = *(const u32x2*)(yrow + 256 * j); } }
#endif
    f32x4 g4[4], b4[4];
#pragma unroll
    for (int j = 0; j < 4; ++j) { g4[j] = *(const f32x4*)(p.ln2_g + 4 * lane + 256 * j); b4[j] = *(const f32x4*)(p.ln2_b + 4 * lane + 256 * j); }
#pragma unroll
    for (int r = 0; r < NR; ++r) if (tok[r] >= 0) {
        float v[16]; float sm = 0.f;
#pragma unroll
        for (int j = 0; j < 4; ++j) { const u32x2 t = xa[r][j];
#if Y2_FP8
            const auto ylo = __builtin_amdgcn_cvt_pk_f32_fp8(ya[r][j], false), yhi = __builtin_amdgcn_cvt_pk_f32_fp8(ya[r][j], true);
            v[4 * j] = DN_ALPHA * bflo(t.x) + ylo[0] * (1.0f / Y8_SCALE); v[4 * j + 1] = DN_ALPHA * bfhi(t.x) + ylo[1] * (1.0f / Y8_SCALE); v[4 * j + 2] = DN_ALPHA * bflo(t.y) + yhi[0] * (1.0f / Y8_SCALE); v[4 * j + 3] = DN_ALPHA * bfhi(t.y) + yhi[1] * (1.0f / Y8_SCALE);
#else
            const u32x2 y = ya[r][j];
            v[4 * j] = DN_ALPHA * bflo(t.x) + bflo(y.x); v[4 * j + 1] = DN_ALPHA * bfhi(t.x) + bfhi(y.x); v[4 * j + 2] = DN_ALPHA * bflo(t.y) + bflo(y.y); v[4 * j + 3] = DN_ALPHA * bfhi(t.y) + bfhi(y.y);
#endif
            sm += (v[4 * j] + v[4 * j + 1]) + (v[4 * j + 2] + v[4 * j + 3]); }
        const float mean = wave_sum(sm) * (1.0f / 1024.0f); float sq = 0.f;
#pragma unroll
        for (int i2 = 0; i2 < 16; ++i2) { v[i2] -= mean; sq += v[i2] * v[i2]; }
        const float rstd = 1.0f / sqrtf(wave_sum(sq) * (1.0f / 1024.0f) + LN_EPS);
        float* orow = (dummy ? dummy : p.out) + (size_t)tok[r] * 1024 + 4 * lane;
#pragma unroll
        for (int j = 0; j < 4; ++j) *(f32x4*)(orow + 256 * j) = (f32x4){v[4 * j] * rstd * g4[j].x + b4[j].x, v[4 * j + 1] * rstd * g4[j].y + b4[j].y, v[4 * j + 2] * rstd * g4[j].z + b4[j].z, v[4 * j + 3] * rstd * g4[j].w + b4[j].w};
    }
}
__global__ void __launch_bounds__(256) k_ln2(Params p) {
    __shared__ ClassTab tabs; if (threadIdx.x == 0) class_tab_fill(WSP(unsigned, WS_CTL) + CW_CNT, &tabs); __syncthreads(); const ClassTab* tab = &tabs;
    const int lane = threadIdx.x & 63; const int prow = blockIdx.x * 4 + (threadIdx.x >> 6);
    if (prow >= tab->rowbase[NCLS]) return;
    const int cls = find_class(tab, prow); const int i = prow - tab->rowbase[cls]; if (i >= tab->cnt[cls]) return;
    const int tk[1] = {WSP(int, WS_LIST)[(size_t)cls * T + i]}, pr[1] = {prow};
    ln2_rows<1>(p, tk, pr, lane);
}


#define LAS __attribute__((address_space(3)))
#define GAS __attribute__((address_space(1)))
constexpr int RING_OFF = 0, RING_BYTES = 131072;
constexpr int LCTL_OFF = RING_BYTES;
constexpr int LTOK_OFF = LCTL_OFF + 4096, MAXU = 16;
constexpr int LDS_BYTES = LTOK_OFF + MAXU * 1024;
constexpr int NTHR = 512, NWAVES = 8;

#ifndef FP6_DIAG
#define FP6_DIAG 1
#endif
#if FP6_DIAG & 1
#define FP6_PRE "s_nop 3\n\t"
#else
#define FP6_PRE
#endif
#define FP6_DIAG_V0 ((FP6_DIAG >> 1) & 1)
namespace pg8 {
typedef short bf16x8 __attribute__((ext_vector_type(8)));
typedef int v4i_t __attribute__((ext_vector_type(4)));
typedef int v8i_t __attribute__((ext_vector_type(8)));
typedef int v6i_t __attribute__((ext_vector_type(6)));
typedef int v2i_t __attribute__((ext_vector_type(2)));
constexpr int BM = 256, BK = 64, HALF = 128, HTB = HALF * BK * 2, NXCD = 8, WGM = 8;
__host__ __device__ __forceinline__ int lds_byte(int r, int c) { const int st = (r >> 4) * 2 + (c >> 5), rr = r & 15, cc = c & 31, ob = rr * 64 + cc * 2; return st * 1024 + (ob ^ (((ob >> 9) & 1) << 5)); }
__host__ __device__ __forceinline__ void stage_rc(int b, int& R, int& C) { const int st = b / 1024, sb = b % 1024, swz = sb ^ (((sb >> 9) & 1) << 5); R = (st >> 1) * 16 + swz / 64; C = (st & 1) * 32 + (swz % 64) / 2; }
__host__ __device__ __forceinline__ int perm32(int rho) { const int n = rho >> 4, i = rho & 15; return 8 * (i >> 2) + 4 * n + (i & 3); }

struct Unit { const char* A; const char* B; int row0, col0, bjump, aux; };
struct TileOrder {
    int nM, nN, nwg, G, c;
    __device__ __forceinline__ void init(int nM_, int nN_, int G_, int c_) { nM = nM_; nN = nN_; nwg = nM * nN; G = G_; c = c_; }
    __device__ __forceinline__ bool tile(int i, int& pm, int& pn) const {
        const long L = (long)i * G + c; if (L >= nwg) return false;
        int wgid = (int)L; { const int q = nwg / NXCD, r = nwg % NXCD, xcd = wgid % NXCD, off = wgid / NXCD; wgid = (xcd < r ? xcd * (q + 1) : r * (q + 1) + (xcd - r) * q) + off; }
        const int nig = WGM * nN, gid = wgid / nig, fm = gid * WGM, gsz = (nM - fm) < WGM ? (nM - fm) : WGM;
        pm = fm + ((wgid % nig) % gsz); pn = (wgid % nig) / gsz; return true;
    }
};
__device__ __forceinline__ unsigned cvt_pk_bf16(float lo, float hi) { unsigned r; asm volatile("v_cvt_pk_bf16_f32 %0, %1, %2" : "=v"(r) : "v"(lo), "v"(hi)); return r; }

template <class EF> struct EpiRows {
    static constexpr bool PERM = true, KEEPS = false;
    EF ef;
    __device__ __forceinline__ bool keep_acc(const Unit&) const { return false; }
    __device__ __forceinline__ void operator()(f32x4 (&acc)[2][2][4][2], const Unit& u, int wr, int wc, int fr, int fq) const {
#pragma unroll
        for (int ai = 0; ai < 2; ++ai)
#pragma unroll
            for (int m = 0; m < 4; ++m) { const int row = u.row0 + ai * HALF + wr * 64 + m * 16 + fr;
#pragma unroll
                for (int bj = 0; bj < 2; ++bj) { const int c0 = u.col0 + bj * HALF + wc * 32 + 8 * fq;
                    float v[8] = {acc[ai][bj][m][0][0], acc[ai][bj][m][0][1], acc[ai][bj][m][0][2], acc[ai][bj][m][0][3], acc[ai][bj][m][1][0], acc[ai][bj][m][1][1], acc[ai][bj][m][1][2], acc[ai][bj][m][1][3]};
                    ef(u, row, c0, v); }
                asm volatile("" ::: "memory"); }
    }
};

template <class Epi, class Sched, bool ALIGN_EPI, bool GATHER, bool BJUMP, int LOWP = 0>
__device__ __forceinline__ void gemm_phase(LAS unsigned char* lds, const char* Abase, int lda, int ldb, int K, const Sched& S, const Epi& E, int wave_s) {
    const int tid = opaque_tid(wave_s), wid = __builtin_amdgcn_readfirstlane(tid >> 6), lane = tid & 63, wr = wid >> 2, wc = wid & 3, fr = lane & 15, fq = lane >> 4;
    const int nt = K / BK;
    unsigned voffA[2], voffB[2]; unsigned voffG[2][2], nvoffG[2][2];
#pragma unroll
    for (int i = 0; i < 2; ++i) { int R, C; stage_rc(tid * 16 + i * 8192, R, C); const int Rb = Epi::PERM ? ((R & ~31) + perm32(R & 31)) : R;
        voffA[i] = (unsigned)(R * lda + C) * 2u; voffB[i] = (unsigned)(Rb * ldb + C) * 2u; voffG[0][i] = voffG[1][i] = nvoffG[0][i] = nvoffG[1][i] = 0u; }
    const size_t kstep = (size_t)(BK * 2);
    const size_t hstepA = (size_t)HALF * lda * 2, hstepB = (size_t)HALF * ldb * 2;
    const unsigned ldsw = (unsigned)wid * 1024u;
    const int aoff = lds_byte(wr * 64 + fr, fq * 8), boff = lds_byte(wc * 32 + fr, fq * 8);
#define PG8_SA(b, h) (((b) * 2 + (h)) * HTB)
#define PG8_SB(b, h) ((4 + (b) * 2 + (h)) * HTB)
#define PG8_GLDS(gptr, ldsoff) __builtin_amdgcn_global_load_lds((const unsigned*)(gptr), (LAS unsigned*)(lds + (ldsoff)), 16, 0, 0)
#define PG8_STAGE_B(bufoff, gbase) do { _Pragma("unroll") for (int _i = 0; _i < 2; ++_i) PG8_GLDS((const char*)(gbase) + voffB[_i], (bufoff) + ldsw + _i * 8192); } while (0)
#define PG8_STAGE_A(bufoff, kptr, h, nx) do { if constexpr (GATHER) { _Pragma("unroll") for (int _i = 0; _i < 2; ++_i) PG8_GLDS((const char*)(kptr) + ((nx) ? nvoffG[h][_i] : voffG[h][_i]), (bufoff) + ldsw + _i * 8192); } \
        else { _Pragma("unroll") for (int _i = 0; _i < 2; ++_i) PG8_GLDS((const char*)(kptr) + (h) * hstepA + voffA[_i], (bufoff) + ldsw + _i * 8192); } } while (0)
#define PG8_GATHER_OFFS(dst, ord) do { LAS const int* _tk = S.toks(ord); _Pragma("unroll") for (int _h = 0; _h < 2; ++_h) _Pragma("unroll") for (int _i = 0; _i < 2; ++_i) { int _R, _C; stage_rc(tid * 16 + _i * 8192, _R, _C); \
        dst[_h][_i] = (unsigned)_tk[_h * HALF + _R] * (unsigned)(lda * 2) + (unsigned)(_C * 2); } } while (0)
#define PG8_LD16(addr) (*(const LAS bf16x8*)(addr))
#define PG8_LD8(addr) __builtin_bit_cast(bf16x8, __builtin_shufflevector(*(const LAS v2i_t*)(addr), *(const LAS v2i_t*)(addr), 0, 1, -1, -1))
#define PG8_LDA(dst, b, h) do { _Pragma("unroll") for (int m = 0; m < 4; ++m) { dst[m][0] = PG8_LD16(lds + PG8_SA(b, h) + aoff + m * 2048); \
        if constexpr (LOWP == 2) dst[m][1] = PG8_LD8(lds + PG8_SA(b, h) + aoff + m * 2048 + 1024); else dst[m][1] = PG8_LD16(lds + PG8_SA(b, h) + aoff + m * 2048 + 1024); } } while (0)
#define PG8_LDB(dst, b, h) do { _Pragma("unroll") for (int n = 0; n < 2; ++n) { dst[n][0] = PG8_LD16(lds + PG8_SB(b, h) + boff + n * 2048); \
        if constexpr (LOWP == 2) dst[n][1] = PG8_LD8(lds + PG8_SB(b, h) + boff + n * 2048 + 1024); else dst[n][1] = PG8_LD16(lds + PG8_SB(b, h) + boff + n * 2048 + 1024); } } while (0)
#define PG8_CAT8(lo, hi) __builtin_shufflevector(__builtin_bit_cast(v4i_t, lo), __builtin_bit_cast(v4i_t, hi), 0, 1, 2, 3, 4, 5, 6, 7)
#define PG8_CAT6(lo, hi) __builtin_shufflevector(__builtin_bit_cast(v4i_t, lo), __builtin_bit_cast(v4i_t, hi), 0, 1, 2, 3, 4, 5)
#define PG8_MMA(ai, bj, At, Bt, Z) do { __builtin_amdgcn_s_setprio(1); if constexpr (LOWP == 1) { _Pragma("unroll") for (int m = 0; m < 4; ++m) _Pragma("unroll") for (int n = 0; n < 2; ++n) \
        { const v8i_t b8_ = PG8_CAT8(Bt[n][0], Bt[n][1]), a8_ = PG8_CAT8(At[m][0], At[m][1]); \
          if (Z) asm volatile("v_mfma_f32_16x16x128_f8f6f4 %0, %1, %2, 0" : "=v"(acc[ai][bj][m][n]) : "v"(b8_), "v"(a8_)); \
          else asm volatile("v_mfma_f32_16x16x128_f8f6f4 %0, %1, %2, %0" : "+v"(acc[ai][bj][m][n]) : "v"(b8_), "v"(a8_)); } } \
        else if constexpr (LOWP == 2) { _Pragma("unroll") for (int m = 0; m < 4; ++m) _Pragma("unroll") for (int n = 0; n < 2; ++n) \
        { const v6i_t b6_ = PG8_CAT6(Bt[n][0], Bt[n][1]), a6_ = PG8_CAT6(At[m][0], At[m][1]); if (Z) acc[ai][bj][m][n] = (f32x4){0.f, 0.f, 0.f, 0.f}; asm volatile(FP6_PRE "v_mfma_f32_16x16x128_f8f6f4 %0, %1, %2, %0 cbsz:2 blgp:2" : "+v"(acc[ai][bj][m][n]) : "v"(b6_), "v"(a6_)); } } \
        else { _Pragma("unroll") for (int m = 0; m < 4; ++m) _Pragma("unroll") for (int n = 0; n < 2; ++n) { \
        acc[ai][bj][m][n] = __builtin_amdgcn_mfma_f32_16x16x32_bf16(Bt[n][0], At[m][0], (Z) ? (f32x4){0.f, 0.f, 0.f, 0.f} : acc[ai][bj][m][n], 0, 0, 0); \
        acc[ai][bj][m][n] = __builtin_amdgcn_mfma_f32_16x16x32_bf16(Bt[n][1], At[m][1], acc[ai][bj][m][n], 0, 0, 0); } } __builtin_amdgcn_s_setprio(0); } while (0)
#define PG8_WAIT_V(n) do { if (LOWP == 2 && FP6_DIAG_V0) asm volatile("s_waitcnt vmcnt(0)" ::: "memory"); else asm volatile("s_waitcnt vmcnt(" #n ")" ::: "memory"); } while (0)
#define PG8_WAIT_L(n) asm volatile("s_waitcnt lgkmcnt(" #n ")" ::: "memory")
#define PG8_BAR __builtin_amdgcn_s_barrier()
#define PG8_SCHED __builtin_amdgcn_sched_barrier(0)
    Unit cur, nxt; int ui = 0;
    if (!S.next(0, cur)) return;
    constexpr bool ZRESET = Epi::KEEPS || LOWP != 1;
    f32x4 acc[2][2][4][2];
    if constexpr (ZRESET) {
#pragma unroll
        for (int a = 0; a < 2; ++a)
#pragma unroll
            for (int b = 0; b < 2; ++b)
#pragma unroll
                for (int m = 0; m < 4; ++m)
#pragma unroll
                    for (int n = 0; n < 2; ++n) acc[a][b][m][n] = (f32x4){0.f, 0.f, 0.f, 0.f}; }
    bf16x8 At[4][2], B0[2][2], B1[2][2];
    const char* cA = GATHER ? Abase : cur.A; const char* cB = cur.B;
    if constexpr (GATHER) PG8_GATHER_OFFS(voffG, 0);
    PG8_STAGE_B(PG8_SB(0, 0), cB); PG8_STAGE_B(PG8_SB(0, 1), cB + hstepB); PG8_STAGE_A(PG8_SA(0, 0), cA, 0, false); PG8_STAGE_A(PG8_SA(0, 1), cA, 1, false);
    if (wr == 1) PG8_BAR;
    PG8_WAIT_V(2); PG8_BAR;
    PG8_STAGE_B(PG8_SB(1, 0), cB + kstep); PG8_STAGE_A(PG8_SA(1, 0), cA + kstep, 0, false); PG8_STAGE_B(PG8_SB(1, 1), cB + hstepB + kstep);
    PG8_WAIT_V(6); PG8_BAR;
    for (;;) {
        const bool has_next = S.next(ui + 1, nxt);
        if constexpr (GATHER) { if (has_next) PG8_GATHER_OFFS(nvoffG, ui + 1); else {
#pragma unroll
            for (int h = 0; h < 2; ++h)
#pragma unroll
                for (int i = 0; i < 2; ++i) nvoffG[h][i] = voffG[h][i]; } }
        const char* nA = GATHER ? Abase : (has_next ? nxt.A : cA); const char* nB = has_next ? nxt.B : cB;
#define PG8_ITER(t, ZF) do { \
            const bool last = ((t) == nt - 2); \
            const char* a1 = cA + (size_t)((t) + 1) * kstep; \
            const char* a2 = last ? nA : cA + (size_t)((t) + 2) * kstep; \
            const char* b2 = last ? nB : cB + (size_t)((t) + 2) * kstep + ((BJUMP && ((t) + 2) >= (nt >> 1)) ? cur.bjump : 0); \
            const char* a3 = a2 + kstep; const char* b3 = b2 + kstep; \
              \
            PG8_LDB(B0, 0, 0); PG8_LDB(B1, 0, 1); PG8_SCHED; PG8_LDA(At, 0, 0); PG8_STAGE_A(PG8_SA(1, 1), a1, 1, false); \
            PG8_WAIT_V(8); PG8_WAIT_L(0); PG8_BAR; PG8_MMA(0, 0, At, B0, ZF); PG8_MMA(0, 1, At, B1, ZF); PG8_BAR; PG8_SCHED; \
              \
            PG8_LDA(At, 0, 1); PG8_STAGE_B(PG8_SB(0, 0), b2); PG8_STAGE_B(PG8_SB(0, 1), b2 + hstepB); PG8_STAGE_A(PG8_SA(0, 0), a2, 0, last); \
            PG8_WAIT_V(8); PG8_WAIT_L(0); PG8_BAR; PG8_MMA(1, 0, At, B0, ZF); PG8_MMA(1, 1, At, B1, ZF); PG8_BAR; PG8_SCHED; \
              \
            PG8_LDB(B0, 1, 0); PG8_LDB(B1, 1, 1); PG8_SCHED; PG8_LDA(At, 1, 0); PG8_STAGE_A(PG8_SA(0, 1), a2, 1, last); \
            PG8_WAIT_V(8); PG8_WAIT_L(0); PG8_BAR; PG8_MMA(0, 0, At, B0, false); PG8_MMA(0, 1, At, B1, false); PG8_BAR; PG8_SCHED; \
              \
            PG8_LDA(At, 1, 1); PG8_STAGE_B(PG8_SB(1, 0), b3); PG8_STAGE_B(PG8_SB(1, 1), b3 + hstepB); PG8_STAGE_A(PG8_SA(1, 0), a3, 0, last); \
            PG8_WAIT_V(8); PG8_WAIT_L(0); PG8_BAR; PG8_MMA(1, 0, At, B0, false); PG8_MMA(1, 1, At, B1, false); PG8_BAR; PG8_SCHED; \
        } while (0)
        if constexpr (ZRESET) {
#pragma nounroll
            for (int t = 0; t < nt; t += 2) PG8_ITER(t, false);
        } else {
            PG8_ITER(0, true);
#pragma nounroll
            for (int t = 2; t < nt; t += 2) PG8_ITER(t, false);
        }
#undef PG8_ITER
        if constexpr (ALIGN_EPI) { if (wr == 0) PG8_BAR; }
        if constexpr (LOWP != 0) { asm volatile("s_nop 15\n\ts_nop 15" ::: "memory"); PG8_SCHED; }
        E(acc, cur, wr, wc, fr, fq);
        if (!has_next) break;
        if constexpr (ZRESET) { if (!E.keep_acc(cur)) {
#pragma unroll
            for (int a = 0; a < 2; ++a)
#pragma unroll
                for (int b = 0; b < 2; ++b)
#pragma unroll
                    for (int m = 0; m < 4; ++m)
#pragma unroll
                        for (int n = 0; n < 2; ++n) acc[a][b][m][n] = (f32x4){0.f, 0.f, 0.f, 0.f}; } }
        cur = nxt; cA = nA; cB = nB; ++ui;
        if constexpr (GATHER) {
#pragma unroll
            for (int h = 0; h < 2; ++h)
#pragma unroll
                for (int i = 0; i < 2; ++i) voffG[h][i] = nvoffG[h][i]; }
        if constexpr (ALIGN_EPI) { if (wr == 1) PG8_BAR; }
    }
    PG8_WAIT_V(0);
    if constexpr (!ALIGN_EPI) { if (wr == 0) PG8_BAR; }
    PG8_BAR;
#undef PG8_SA
#undef PG8_SB
#undef PG8_GLDS
#undef PG8_STAGE_A
#undef PG8_STAGE_B
#undef PG8_GATHER_OFFS
#undef PG8_LDA
#undef PG8_LDB
#undef PG8_MMA
#undef PG8_CAT8
#undef PG8_CAT6
#undef PG8_LD16
#undef PG8_LD8
#undef PG8_WAIT_V
#undef PG8_WAIT_L
#undef PG8_BAR
#undef PG8_SCHED
}
}

namespace swa {
typedef short bf16x8 __attribute__((ext_vector_type(8)));
typedef short s16x4 __attribute__((ext_vector_type(4)));
typedef float f32x16 __attribute__((ext_vector_type(16)));
constexpr int DH = 128, NW = 8, QBLK = 32, KVBLK = 64, QB = NW * QBLK;
constexpr int SHM_V = KVBLK * DH * 2, SHM_K = KVBLK * DH * 2;
constexpr int LDS_NEED = 2 * SHM_V + 2 * SHM_K + NW * 64 * 4;
constexpr float SCALE = 0.08838834764831845f, THR = 8.f;
#define KSWZ(row, colB) ((row) * 256 + ((colB) ^ (((row) & 7) << 4)))
#define SBAR() __builtin_amdgcn_sched_barrier(0)
__device__ __forceinline__ int v_st(int k, int c) { const int kk = (k & ~0xC) | ((k & 4) << 1) | ((k & 8) >> 1); return ((kk >> 3) * 4 + (c >> 5)) * 512 + ((kk & 7) * 32 + (c & 31)) * 2; }
__device__ __forceinline__ int v_rd_base(int lane) { return ((lane & 3) << 3) | (((lane >> 2) & 3) << 6) | (((lane >> 4) & 1) << 5) | (((lane >> 5) & 1) << 8); }
constexpr int v_rd_off(int d0, int ks, int half) { return d0 * 512 + ks * 4096 + half * 2048; }
__device__ __forceinline__ int crow(int r, int hi) { return (r & 3) + 8 * (r >> 2) + 4 * hi; }
__device__ __forceinline__ unsigned cvtpk(float lo, float hi) { unsigned r; asm volatile("v_cvt_pk_bf16_f32 %0, %1, %2" : "=v"(r) : "v"(lo), "v"(hi)); return r; }
__device__ __forceinline__ bf16x8 load8(const bf16_t* p) { return *reinterpret_cast<const bf16x8*>(p); }
__device__ __forceinline__ void mask_tile(f32x16& p0, f32x16& p1, int dq, unsigned W) {
    const float NEG = -__builtin_inff();
#pragma unroll
    for (int r = 0; r < 16; ++r) {
        const int c = (r & 3) + 8 * (r >> 2);
        if ((unsigned)(dq - c) >= W) p0[r] = NEG;
        if ((unsigned)(dq - c - 32) >= W) p1[r] = NEG;
    }
}
__device__ __forceinline__ void partialSM(f32x16& p0, f32x16& p1, float& m_reg, float& mn, float& alpha) {
    float pmax = p0[0]; for (int r = 1; r < 16; ++r) pmax = fmaxf(pmax, p0[r]); for (int r = 0; r < 16; ++r) pmax = fmaxf(pmax, p1[r]);
    { auto rr = __builtin_amdgcn_permlane32_swap(__float_as_uint(pmax), __float_as_uint(pmax), false, false);
      pmax = fmaxf(__uint_as_float(rr[0]), __uint_as_float(rr[1])); }
    constexpr float C2 = 1.4426950408889634f * SCALE;
    if (__builtin_expect(__all((pmax - m_reg) * SCALE <= THR), 1)) { mn = m_reg; alpha = 1.f; }
    else { mn = fmaxf(m_reg, pmax); alpha = __builtin_amdgcn_exp2f((m_reg - mn) * C2); m_reg = mn; }
    const float mnL = -mn * C2;
    for (int r = 0; r < 16; ++r) p0[r] = fmaf(p0[r], C2, mnL); for (int r = 0; r < 16; ++r) p1[r] = fmaf(p1[r], C2, mnL);
    for (int r = 0; r < 16; ++r) p0[r] = __builtin_amdgcn_exp2f(p0[r]);
}
__device__ __forceinline__ void finishSM(f32x16& p0, f32x16& p1, float alpha, float& l_reg, bf16x8& pa0, bf16x8& pa1, bf16x8& pa2, bf16x8& pa3) {
    for (int r = 0; r < 16; ++r) p1[r] = __builtin_amdgcn_exp2f(p1[r]);
    float ps = 0; for (int r = 0; r < 16; ++r) ps += p0[r]; for (int r = 0; r < 16; ++r) ps += p1[r];
    { auto rr = __builtin_amdgcn_permlane32_swap(__float_as_uint(ps), __float_as_uint(ps), false, false);
      ps = __uint_as_float(rr[0]) + __uint_as_float(rr[1]); }
    l_reg = l_reg * alpha + ps;
#define PK4(P, B_, OUT) do { unsigned a0 = cvtpk(P[B_+0], P[B_+1]), a1 = cvtpk(P[B_+2], P[B_+3]);                          \
        unsigned b0 = cvtpk(P[B_+4], P[B_+5]), b1 = cvtpk(P[B_+6], P[B_+7]);                                             \
        auto r0 = __builtin_amdgcn_permlane32_swap(a0, b0, false, false); auto r1 = __builtin_amdgcn_permlane32_swap(a1, b1, false, false); \
        u32x4 w = {r0[0], r1[0], r0[1], r1[1]}; OUT = *reinterpret_cast<bf16x8*>(&w); } while (0)
    PK4(p0, 0, pa0); PK4(p0, 8, pa1); PK4(p1, 0, pa2); PK4(p1, 8, pa3);
#undef PK4
}
template <int KB>
__device__ __forceinline__ void qkt(f32x16& p0, f32x16& p1, const char* K_lds, int r32, int hi, const bf16x8* qr, bool act) {
    if (!act) { const float NEG = -__builtin_inff();
#pragma unroll
        for (int r = 0; r < 16; ++r) { p0[r] = NEG; p1[r] = NEG; } return; }
    p0 = f32x16{}; p1 = f32x16{};
    const char* kb[4];
#pragma unroll
    for (int dd = 0; dd < 4; ++dd) kb[dd] = K_lds + KB * SHM_K + KSWZ(r32, (dd * 16 + hi * 8) * 2);
#pragma unroll
    for (int d0 = 0; d0 < 8; ++d0) { const char* a = kb[d0 & 3] + (d0 >> 2) * 128;
        bf16x8 b0 = *reinterpret_cast<const bf16x8*>(a);
        bf16x8 b1 = *reinterpret_cast<const bf16x8*>(a + 32 * 256);
        p0 = __builtin_amdgcn_mfma_f32_32x32x16_bf16(b0, qr[d0], p0, 0, 0, 0);
        p1 = __builtin_amdgcn_mfma_f32_32x32x16_bf16(b1, qr[d0], p1, 0, 0, 0); }
}
template <int VB>
__device__ __forceinline__ void pv_tile(f32x16* o, int vb0, bf16x8 pa0, bf16x8 pa1, bf16x8 pa2, bf16x8 pa3, bool act) {
    if (!act) return;
#define TRRD(dst, off) asm volatile("ds_read_b64_tr_b16 %0, %1 offset:%2" : "=&v"(dst) : "v"(vb0), "i"(off) : "memory")
#define PV_D0(d0) do { s16x4 l0, l1, l2, l3, h0, h1, h2, h3; constexpr int b_ = VB * SHM_V + v_rd_off(d0, 0, 0); \
        TRRD(l0, b_); TRRD(h0, b_ + 2048); TRRD(l1, b_ + 4096); TRRD(h1, b_ + 6144); TRRD(l2, b_ + 8192); TRRD(h2, b_ + 10240); TRRD(l3, b_ + 12288); TRRD(h3, b_ + 14336); \
        asm volatile("s_waitcnt lgkmcnt(0)" ::: "memory"); SBAR();   \
        o[d0] = __builtin_amdgcn_mfma_f32_32x32x16_bf16(pa0, (bf16x8){l0[0], l0[1], l0[2], l0[3], h0[0], h0[1], h0[2], h0[3]}, o[d0], 0, 0, 0);   \
        o[d0] = __builtin_amdgcn_mfma_f32_32x32x16_bf16(pa1, (bf16x8){l1[0], l1[1], l1[2], l1[3], h1[0], h1[1], h1[2], h1[3]}, o[d0], 0, 0, 0);   \
        o[d0] = __builtin_amdgcn_mfma_f32_32x32x16_bf16(pa2, (bf16x8){l2[0], l2[1], l2[2], l2[3], h2[0], h2[1], h2[2], h2[3]}, o[d0], 0, 0, 0);   \
        o[d0] = __builtin_amdgcn_mfma_f32_32x32x16_bf16(pa3, (bf16x8){l3[0], l3[1], l3[2], l3[3], h3[0], h3[1], h3[2], h3[3]}, o[d0], 0, 0, 0); } while (0)
    PV_D0(0); PV_D0(1); PV_D0(2); PV_D0(3);
#undef PV_D0
#undef TRRD
}
struct BlockRef { const bf16_t* Q; const bf16_t* K; const bf16_t* V; bf16_t* O; float* LSE; int P0, W, segmask, skv, ostride; };
struct Seam { bf16x8 qr[8]; bf16x8 st_v0, st_v1, st_k0, st_k1; };
__device__ __forceinline__ int imax(int a, int b) { return a > b ? a : b; }
__device__ __forceinline__ int blk_jlo(const BlockRef& b) { const int lowk = imax(b.P0 - b.W + 1, b.P0 & ~b.segmask); return lowk > 0 ? lowk / KVBLK : 0; }
#define ROW(p, k0, rr) ((p) + (size_t)((k0) + (rr)) * DH + sc)
#define VMW() asm volatile("s_waitcnt vmcnt(0)" ::: "memory")
#define VMWN(n) asm volatile("s_waitcnt vmcnt(%0)" :: "i"(n) : "memory")
#define SLOAD_H(Kp, Vp, k0) do { S.st_v0 = load8(ROW(Vp, k0, sr)); S.st_v1 = load8(ROW(Vp, k0, 32 + sr));              \
                         S.st_k0 = load8(ROW(Kp, k0, sr)); S.st_k1 = load8(ROW(Kp, k0, 32 + sr)); } while (0)
#define SWRITE_HK(bf) do { *(bf16x8*)(K_lds + (bf) * SHM_K + kws) = S.st_k0; *(bf16x8*)(K_lds + (bf) * SHM_K + kws + 32 * 256) = S.st_k1; } while (0)
#define SWRITE_HV(bf) do { *(bf16x8*)(V_lds + (bf) * SHM_V + vst0) = S.st_v0; *(bf16x8*)(V_lds + (bf) * SHM_V + vst1) = S.st_v1; } while (0)
#define SWRITE_H(bf) do { SWRITE_HV(bf); SWRITE_HK(bf); } while (0)
__device__ __forceinline__ void prime(const BlockRef& cur, char* lds, Seam& S, int wave_s) {
    const int tid = opaque_tid(wave_s), wid = __builtin_amdgcn_readfirstlane(tid >> 6), lane = tid & 63, r32 = lane & 31, hi = lane >> 5;
    const int sr = tid >> 4, sc = (tid & 15) * 8, kws = KSWZ(sr, sc * 2); char* K_lds = lds + 2 * SHM_V;
    const int kb0 = blk_jlo(cur) * KVBLK;
    for (int d0 = 0; d0 < 8; ++d0) S.qr[d0] = load8(cur.Q + (size_t)(wid * QBLK + r32) * DH + d0 * 16 + hi * 8);
    SLOAD_H(cur.K, cur.V, kb0); VMW(); SWRITE_HK(0);
    __syncthreads();
}
__device__ __forceinline__ void block(const BlockRef& cur, const BlockRef& nxt, char* lds, Seam& S, int wave_s) {
    const int tid = opaque_tid(wave_s), wid = __builtin_amdgcn_readfirstlane(tid >> 6), lane = tid & 63, r32 = lane & 31, hi = lane >> 5;
    const int W = cur.W;
    const int j_lo = blk_jlo(cur);
    int j_hi = (cur.P0 + QB - 1) / KVBLK + 1; if (j_hi > cur.skv / KVBLK) j_hi = cur.skv / KVBLK;
    const int NT = j_hi - j_lo;
    const int kbn = blk_jlo(nxt) * KVBLK;
    const int qlo = cur.P0 + wid * QBLK, qm = qlo + r32 - 4 * hi;
    const int segb = qlo & ~cur.segmask;
    const int lowk_w = imax(qlo - W + 1, segb);
    const int lowk_last = imax(qlo + QBLK - W, segb);
    const int wrow = ((qlo + r32) & cur.segmask) + 1;
    const unsigned Wl = (unsigned)(wrow < W ? wrow : W);
    char* V_lds = lds; char* K_lds = lds + 2 * SHM_V;
    float* ws = (float*)(lds + 2 * SHM_V + 2 * SHM_K) + wid * 64; float* li_l = ws, * al_l = ws + 32;
    float m_reg = -1e30f, l_reg = 0; f32x16 o[4] = {};
    const int sr = tid >> 4, sc = (tid & 15) * 8, vst0 = v_st(sr, sc), vst1 = v_st(32 + sr, sc), kws = KSWZ(sr, sc * 2);
    const int vb0 = (int)(uintptr_t)V_lds + v_rd_base(lane);
    const bf16_t* Kh = cur.K; const bf16_t* Vh = cur.V;
#define RESC(a) do { if (__any((a) < 1.f)) { if (hi == 0) al_l[r32] = (a); asm volatile("s_waitcnt lgkmcnt(0)" ::: "memory");              \
                     for (int d_ = 0; d_ < 4; ++d_) for (int r = 0; r < 16; ++r) o[d_][r] *= al_l[crow(r, hi)]; } } while (0)
#define KBASE(t) ((j_lo + (t)) * KVBLK)
#define ACT(t) (KBASE(t) <= qlo + QBLK - 1 && KBASE(t) + KVBLK - 1 >= lowk_w)
#define MASKT(P0_, P1_, t) do { const int kb_ = KBASE(t); if (ACT(t) && (kb_ + KVBLK - 1 > qlo || kb_ < lowk_last)) mask_tile(P0_, P1_, qm - kb_, Wl); } while (0)
    constexpr int NQL = 8;
#define SEAM_K0() do { VMWN(NQL); SWRITE_HK(0); SBAR(); } while (0)
    f32x16 pA0, pA1, pB0, pB1; float mnA, mnB, alA, alB; bf16x8 pa0, pa1, pa2, pa3;
    SWRITE_HV(0); SBAR();
    if (NT > 1) { SLOAD_H(Kh, Vh, KBASE(1)); }
    SBAR(); qkt<0>(pA0, pA1, K_lds, r32, hi, S.qr, ACT(0));
    MASKT(pA0, pA1, 0); partialSM(pA0, pA1, m_reg, mnA, alA);
    if (NT > 1) { VMW(); SWRITE_H(1); }
    __syncthreads();
#define HALF_STEP(PX0, PX1, mnX, alX, PY0, PY1, alY, t, KB, VB, SB) do {                                                      \
        SBAR(); if ((t) + 1 < NT) { SLOAD_H(Kh, Vh, KBASE((t) + 1)); SBAR(); }                                       \
        qkt<KB>(PX0, PX1, K_lds, r32, hi, S.qr, ACT(t));                                             \
        finishSM(PY0, PY1, alY, l_reg, pa0, pa1, pa2, pa3); SBAR();                                                           \
        pv_tile<VB>(o, vb0, pa0, pa1, pa2, pa3, ACT((t) - 1)); MASKT(PX0, PX1, (t)); partialSM(PX0, PX1, m_reg, mnX, alX);                                        \
        __syncthreads();                                                                                                      \
        if ((t) + 1 < NT) { VMW(); SWRITE_H(SB); }                                                                          \
        RESC(alX); __syncthreads(); } while (0)
    for (int t = 1; t + 1 < NT; t += 2) {
        HALF_STEP(pB0, pB1, mnB, alB, pA0, pA1, alA, t, 1, 0, 0);
        HALF_STEP(pA0, pA1, mnA, alA, pB0, pB1, alB, t + 1, 0, 1, 1);
    }
    const bool even = (NT & 1) == 0;
    if (even) { SBAR(); qkt<1>(pB0, pB1, K_lds, r32, hi, S.qr, ACT(NT - 1)); SBAR(); }
    SLOAD_H(nxt.K, nxt.V, kbn); SBAR();
#pragma unroll
    for (int d0 = 0; d0 < 8; ++d0) S.qr[d0] = load8(nxt.Q + (size_t)(wid * QBLK + r32) * DH + d0 * 16 + hi * 8);
    SBAR();
    finishSM(pA0, pA1, alA, l_reg, pa0, pa1, pa2, pa3); SBAR();
    pv_tile<0>(o, vb0, pa0, pa1, pa2, pa3, ACT(even ? NT - 2 : NT - 1));
    if (even) { MASKT(pB0, pB1, NT - 1); partialSM(pB0, pB1, m_reg, mnB, alB); __syncthreads(); RESC(alB);
        finishSM(pB0, pB1, alB, l_reg, pa0, pa1, pa2, pa3); SBAR(); pv_tile<1>(o, vb0, pa0, pa1, pa2, pa3, ACT(NT - 1)); }
    SBAR(); SEAM_K0();
    if (hi == 0) li_l[r32] = l_reg; asm volatile("s_waitcnt lgkmcnt(0)" ::: "memory");
    if (cur.LSE != nullptr && hi == 0) cur.LSE[wid * QBLK + r32] = m_reg * SCALE + __logf(l_reg);
    float rli[16];
#pragma unroll
    for (int r = 0; r < 16; ++r) rli[r] = __builtin_amdgcn_rcpf(li_l[crow(r, hi)]);
    bf16_t* Ow = cur.O + (size_t)(wid * QBLK) * cur.ostride;
#pragma unroll
    for (int r = 0; r < 16; ++r) { const int orow = crow(r, hi);
#pragma unroll
        for (int d0 = 0; d0 < 4; ++d0) { const float v = o[d0][r] * rli[r];
            const float vn = __shfl_xor(v, 1);
            if ((r32 & 1) == 0) *(unsigned*)(Ow + (size_t)orow * cur.ostride + d0 * 32 + r32) = cvtpk(v, vn); } }
    __syncthreads();
#undef RESC
#undef KBASE
#undef ACT
#undef MASKT
#undef SEAM_K0
#undef HALF_STEP
}

constexpr int RING_V = 4 * SHM_K;
__device__ __forceinline__ void qkt_rt(f32x16& p0, f32x16& p1, const LAS char* Kslot, int r32, int hi, const bf16x8* qr) {
    p0 = f32x16{}; p1 = f32x16{};
    const LAS char* kb[4];
#pragma unroll
    for (int dd = 0; dd < 4; ++dd) kb[dd] = Kslot + KSWZ(r32, (dd * 16 + hi * 8) * 2);
#pragma unroll
    for (int d0 = 0; d0 < 8; ++d0) { const LAS char* a = kb[d0 & 3] + (d0 >> 2) * 128;
        bf16x8 b0 = *(const LAS bf16x8*)(a);
        bf16x8 b1 = *(const LAS bf16x8*)(a + 32 * 256);
        p0 = __builtin_amdgcn_mfma_f32_32x32x16_bf16(b0, qr[d0], p0, 0, 0, 0);
        p1 = __builtin_amdgcn_mfma_f32_32x32x16_bf16(b1, qr[d0], p1, 0, 0, 0); }
}
__device__ __forceinline__ void pv_rt(f32x16* o, int vb, bf16x8 pa0, bf16x8 pa1, bf16x8 pa2, bf16x8 pa3) {
#define TRRD(dst, off) asm volatile("ds_read_b64_tr_b16 %0, %1 offset:%2" : "=&v"(dst) : "v"(vb), "i"(off) : "memory")
#define PV_D0(d0) do { s16x4 l0, l1, l2, l3, h0, h1, h2, h3; constexpr int b_ = v_rd_off(d0, 0, 0); \
        TRRD(l0, b_); TRRD(h0, b_ + 2048); TRRD(l1, b_ + 4096); TRRD(h1, b_ + 6144); TRRD(l2, b_ + 8192); TRRD(h2, b_ + 10240); TRRD(l3, b_ + 12288); TRRD(h3, b_ + 14336); \
        asm volatile("s_waitcnt lgkmcnt(0)" ::: "memory"); SBAR();   \
        o[d0] = __builtin_amdgcn_mfma_f32_32x32x16_bf16((bf16x8){l0[0], l0[1], l0[2], l0[3], h0[0], h0[1], h0[2], h0[3]}, pa0, o[d0], 0, 0, 0);   \
        o[d0] = __builtin_amdgcn_mfma_f32_32x32x16_bf16((bf16x8){l1[0], l1[1], l1[2], l1[3], h1[0], h1[1], h1[2], h1[3]}, pa1, o[d0], 0, 0, 0);   \
        o[d0] = __builtin_amdgcn_mfma_f32_32x32x16_bf16((bf16x8){l2[0], l2[1], l2[2], l2[3], h2[0], h2[1], h2[2], h2[3]}, pa2, o[d0], 0, 0, 0);   \
        o[d0] = __builtin_amdgcn_mfma_f32_32x32x16_bf16((bf16x8){l3[0], l3[1], l3[2], l3[3], h3[0], h3[1], h3[2], h3[3]}, pa3, o[d0], 0, 0, 0); } while (0)
    PV_D0(0); PV_D0(1); PV_D0(2); PV_D0(3);
#undef PV_D0
#undef TRRD
}
struct WaveState { float m, l; f32x16 o[4]; };
__device__ __forceinline__ void tile_step(WaveState& st, const bf16x8* qr, const LAS char* lds, int slot, int r32, int hi, int lane, bool need_mask, int dq, unsigned Wl) {
    f32x16 p0, p1; float mn, alpha; bf16x8 pa0, pa1, pa2, pa3;
    qkt_rt(p0, p1, lds + slot * SHM_K, r32, hi, qr);
    if (need_mask) mask_tile(p0, p1, dq, Wl);
    partialSM(p0, p1, st.m, mn, alpha);
    if (__any(alpha < 1.f)) {
#pragma unroll
        for (int d_ = 0; d_ < 4; ++d_)
#pragma unroll
            for (int r = 0; r < 16; ++r) st.o[d_][r] *= alpha; }
    finishSM(p0, p1, alpha, st.l, pa0, pa1, pa2, pa3); SBAR();
    pv_rt(st.o, (int)(unsigned)(uintptr_t)(lds + RING_V + slot * SHM_V) + v_rd_base(lane), pa0, pa1, pa2, pa3);
}
__device__ __forceinline__ void wave_store(const WaveState& st, bf16_t* Ow, int ostride, float* lse, int r32, int hi) {
    if (lse != nullptr && hi == 0) lse[r32] = st.m * SCALE + __logf(st.l);
    const float rl = __builtin_amdgcn_rcpf(st.l);
    bf16_t* rowp = Ow + (size_t)r32 * ostride + hi * 8;
#pragma unroll
    for (int d0 = 0; d0 < 4; ++d0)
#pragma unroll
        for (int k = 0; k < 4; k += 2) {
            unsigned ax = cvtpk(st.o[d0][4 * k] * rl, st.o[d0][4 * k + 1] * rl), ay = cvtpk(st.o[d0][4 * k + 2] * rl, st.o[d0][4 * k + 3] * rl);
            unsigned bx = cvtpk(st.o[d0][4 * k + 4] * rl, st.o[d0][4 * k + 5] * rl), by = cvtpk(st.o[d0][4 * k + 6] * rl, st.o[d0][4 * k + 7] * rl);
            { auto r = __builtin_amdgcn_permlane32_swap(ax, bx, false, false); ax = r[0]; bx = r[1]; }
            { auto r = __builtin_amdgcn_permlane32_swap(ay, by, false, false); ay = r[0]; by = r[1]; }
            *(u32x4*)(rowp + d0 * 32 + 8 * k) = (u32x4){ax, ay, bx, by};
        }
}
__device__ __forceinline__ void wave_store8(const WaveState& st, unsigned char* Ow, int ostride, int r32, int hi) {
    const float rl = O8_SCALE * __builtin_amdgcn_rcpf(st.l);
    unsigned char* rowp = Ow + (size_t)r32 * ostride + hi * 8;
#pragma unroll
    for (int d0 = 0; d0 < 4; ++d0)
#pragma unroll
        for (int k = 0; k < 4; k += 2) {
            unsigned a = pk4_fp8(st.o[d0][4 * k] * rl, st.o[d0][4 * k + 1] * rl, st.o[d0][4 * k + 2] * rl, st.o[d0][4 * k + 3] * rl);
            unsigned b = pk4_fp8(st.o[d0][4 * k + 4] * rl, st.o[d0][4 * k + 5] * rl, st.o[d0][4 * k + 6] * rl, st.o[d0][4 * k + 7] * rl);
            { auto r = __builtin_amdgcn_permlane32_swap(a, b, false, false); a = r[0]; b = r[1]; }
            *(u32x2*)(rowp + d0 * 32 + 8 * k) = (u32x2){a, b};
        }
}
__device__ __forceinline__ void wave_reset(WaveState& st) { st.m = -1e30f; st.l = 0.f;
#pragma unroll
    for (int d = 0; d < 4; ++d) st.o[d] = f32x16{}; }
#define HS_LOADQ(qr, Qrow0) do { _Pragma("unroll") for (int d0 = 0; d0 < 8; ++d0) qr[d0] = load8((Qrow0) + (size_t)(wid * QBLK + r32) * DH + d0 * 16 + hi * 8); } while (0)
#define HS_SLOAD(Kp, Vp, k0) do { st_v0 = load8(ROW(Vp, k0, sr)); st_v1 = load8(ROW(Vp, k0, 32 + sr)); st_k0 = load8(ROW(Kp, k0, sr)); st_k1 = load8(ROW(Kp, k0, 32 + sr)); } while (0)
#define HS_SWRITE(slot) do { *(LAS bf16x8*)(lds + (slot) * SHM_K + kws) = st_k0; *(LAS bf16x8*)(lds + (slot) * SHM_K + kws + 32 * 256) = st_k1; \
                             *(LAS bf16x8*)(lds + RING_V + (slot) * SHM_V + vst0) = st_v0; *(LAS bf16x8*)(lds + RING_V + (slot) * SHM_V + vst1) = st_v1; } while (0)
__device__ __forceinline__ void head_dilated(const bf16_t* Q, bf16_t* O, const bf16_t* K, const bf16_t* V, float* LSE, int segmask, LAS char* lds, LAS float* scr, int wave_s) {
    const int tid = opaque_tid(wave_s), wid = __builtin_amdgcn_readfirstlane(tid >> 6), lane = tid & 63, r32 = lane & 31, hi = lane >> 5, pair = wid >> 1;
    const int sr = tid >> 4, sc = (tid & 15) * 8, vst0 = v_st(sr, sc), vst1 = v_st(32 + sr, sc), kws = KSWZ(sr, sc * 2);
    constexpr int NT = 2048 / KVBLK, W = 129;
    bf16x8 st_v0, st_v1, st_k0, st_k1; bf16x8 qr[8]; WaveState st; wave_reset(st);
    HS_SLOAD(K, V, 0); HS_LOADQ(qr, Q); VMW(); HS_SWRITE(0); SBAR();
    HS_SLOAD(K, V, KVBLK); VMW(); HS_SWRITE(1);
    __syncthreads();
    for (int g = 1; g <= NT; ++g) {
        const bool ld = g + 1 < NT;
        if (ld) { HS_SLOAD(K, V, (g + 1) * KVBLK); SBAR(); }
        const int ph = (g - 1) & 3, qb = (g - 1) >> 2;
        if (ph != 3) {
            const int T = g - 3 + pair, qlo = qb * QB + wid * QBLK, segb = qlo & ~segmask;
            const int lowk_w = imax(qlo - W + 1, segb), lowk_last = imax(qlo + QBLK - W, segb), kb_ = T * KVBLK;
            if (T >= 0 && kb_ <= qlo + QBLK - 1 && kb_ + KVBLK - 1 >= lowk_w) {
                const int wrow = ((qlo + r32) & segmask) + 1;
                tile_step(st, qr, lds, T & 3, r32, hi, lane, (kb_ + KVBLK - 1 > qlo) || (kb_ < lowk_last), qlo + r32 - 4 * hi - kb_, (unsigned)(wrow < W ? wrow : W));
            }
            if (ph == 2 && qb + 1 < 2048 / QB) { SBAR(); HS_LOADQ(qr, Q + (size_t)(qb + 1) * QB * DH); }
        } else {
            wave_store(st, O + (size_t)(qb * QB + wid * QBLK) * DH, DH, LSE + qb * QB + wid * QBLK, r32, hi);
            wave_reset(st);
        }
        __syncthreads();
        if (ld) { HS_SWRITE((g + 1) & 3); }
        __syncthreads();
    }
}
__device__ __forceinline__ void head_mem(const bf16_t* Q, const bf16_t* K, const bf16_t* V, bf16_t* O, int ostride, LAS char* lds, LAS float* scr, int wave_s) {
    const int tid = opaque_tid(wave_s), wid = __builtin_amdgcn_readfirstlane(tid >> 6), lane = tid & 63, r32 = lane & 31, hi = lane >> 5, pair = wid >> 1;
    const int sr = tid >> 4, sc = (tid & 15) * 8, vst0 = v_st(sr, sc), vst1 = v_st(32 + sr, sc), kws = KSWZ(sr, sc * 2);
    bf16x8 st_v0, st_v1, st_k0, st_k1; bf16x8 qr[8]; WaveState st;
#pragma unroll
    for (int t = 0; t < 4; ++t) { HS_SLOAD(K, V, t * KVBLK); VMW(); HS_SWRITE(t); SBAR(); }
    __syncthreads();
    for (int qb = 0; qb < 2048 / QB; ++qb) {
        HS_LOADQ(qr, Q + (size_t)qb * QB * DH); wave_reset(st);
        for (int t = 0; t < 4; ++t) tile_step(st, qr, lds, (t + pair) & 3, r32, hi, lane, false, 0, 0u);
#if P4_FP8
        wave_store8(st, (unsigned char*)O + (size_t)(qb * QB + wid * QBLK) * ostride, ostride, r32, hi);
#else
        wave_store(st, O + (size_t)(qb * QB + wid * QBLK) * ostride, ostride, nullptr, r32, hi);
#endif
    }
    __syncthreads();
}
#undef HS_LOADQ
#undef HS_SLOAD
#undef HS_SWRITE
#undef ROW
#undef VMW
#undef VMWN
#undef SLOAD_H
#undef SWRITE_HK
#undef SWRITE_HV
#undef SWRITE_H
#undef KSWZ
#undef SBAR
}

#define XB_TMO      128
#define XB_XCNT(j)  (256  + 64 * (j))
#define XB_XSUB(j)  (1280 + 64 * (j))
#define XB_XGEN(j)  (2304 + 64 * (j))
#define XB_TOP      3328
#define XB_TOPGEN   3392
#define XCD_BAR_WORDS 3456
#define XB_SPIN_CAP (1u << 18)
__device__ __forceinline__ unsigned xb_ld(unsigned* p)              { return __hip_atomic_load(p, __ATOMIC_RELAXED, __HIP_MEMORY_SCOPE_AGENT); }
__device__ __forceinline__ unsigned xb_add(unsigned* p, unsigned v) { return __hip_atomic_fetch_add(p, v, __ATOMIC_RELAXED, __HIP_MEMORY_SCOPE_AGENT); }
__device__ __forceinline__ unsigned xb_xcc_id() { return (unsigned)__builtin_amdgcn_s_getreg((3 << 11) | 20) & 0xFu; }
#define XB_SPIN(cond, bar) do { unsigned _sp = 0; while (cond) { __builtin_amdgcn_s_sleep(1); \
    if ((++_sp & 255u) == 0u) { if (xb_ld(&(bar)[XB_TMO])) break; if (_sp > XB_SPIN_CAP) { atomicAdd(&(bar)[XB_TMO], 1u); break; } } } } while (0)
struct XcdBarrier { unsigned* bar; unsigned x; volatile LAS unsigned* st; };
__device__ __forceinline__ XcdBarrier xcd_barrier_post(unsigned* bar, volatile LAS unsigned* st) {
    XcdBarrier b; b.bar = bar; b.x = xb_xcc_id(); b.st = st;
    if (threadIdx.x == 0) (void)xb_add(&bar[XB_XCNT(b.x)], 1u);
    return b;
}
__device__ __forceinline__ void xcd_barrier_complete(unsigned* bar, unsigned x, unsigned& nloc, unsigned& nx) {
    const unsigned G = gridDim.x * gridDim.y * gridDim.z;
    unsigned sum, cnt, mine, sp = 0u;
    for (;;) {
        sum = 0u; cnt = 0u; mine = 0u;
#pragma unroll
        for (unsigned j = 0; j < 16; ++j) { const unsigned c = xb_ld(&bar[XB_XCNT(j)]); sum += c; cnt += (c > 0u) ? 1u : 0u; mine = (j == x) ? c : mine; }
        if (sum == G) break;
        __builtin_amdgcn_s_sleep(1);
        if ((++sp & 255u) == 0u) { if (xb_ld(&bar[XB_TMO])) break; if (sp > XB_SPIN_CAP) { atomicAdd(&bar[XB_TMO], 1u); break; } }
    }
    nloc = mine > 0u ? mine : 1u; nx = cnt > 0u ? cnt : 1u;
}
__device__ __forceinline__ void xcd_barrier(const XcdBarrier& b) {
    asm volatile("s_waitcnt vmcnt(0)" ::: "memory");
    __syncthreads();
    if (threadIdx.x == 0) {
        unsigned* bar = b.bar; asm volatile("" : "+s"(bar)); bar = (unsigned*)(GAS unsigned*)bar;
        __builtin_amdgcn_s_waitcnt(0);
        unsigned nloc = b.st[0], nx = b.st[1];
        if (nloc == 0u) { xcd_barrier_complete(bar, b.x, nloc, nx); b.st[0] = nloc; b.st[1] = nx; }
        const unsigned old = xb_add(&bar[XB_XSUB(b.x)], 1u);
        const unsigned gen = old / nloc;
        if (old + 1u == (gen + 1u) * nloc) {
            __builtin_amdgcn_fence(__ATOMIC_RELEASE, "agent");
            asm volatile("s_waitcnt vmcnt(0)" ::: "memory");
            const unsigned og = xb_add(&bar[XB_TOP], 1u);
            const unsigned tg = og / nx;
            if (og + 1u == (tg + 1u) * nx) xb_add(&bar[XB_TOPGEN], 1u);
            else XB_SPIN(xb_ld(&bar[XB_TOPGEN]) == tg, bar);
            __builtin_amdgcn_fence(__ATOMIC_ACQUIRE, "agent");
            xb_add(&bar[XB_XGEN(b.x)], 1u);
            asm volatile("s_waitcnt vmcnt(0)" ::: "memory");
        } else {
            XB_SPIN(xb_ld(&bar[XB_XGEN(b.x)]) == gen, bar);
            __builtin_amdgcn_fence(__ATOMIC_ACQUIRE, "agent");
            asm volatile("s_waitcnt vmcnt(0)" ::: "memory");
        }
    }
    __syncthreads();
}
constexpr int CW_BAR = 4096, CW_CONVQ = 96;

#define ACC8(ai, bj, m) {acc[ai][bj][m][0][0], acc[ai][bj][m][0][1], acc[ai][bj][m][0][2], acc[ai][bj][m][0][3], acc[ai][bj][m][1][0], acc[ai][bj][m][1][1], acc[ai][bj][m][1][2], acc[ai][bj][m][1][3]}
struct FastEpiMain {
    static constexpr bool PERM = true, KEEPS = false; EpiMain mn; EpiKV kv; float ascale;
    __device__ __forceinline__ bool keep_acc(const pg8::Unit&) const { return false; }
    __device__ __forceinline__ void operator()(f32x4 (&acc)[2][2][4][2], const pg8::Unit& u, int wr, int wc, int fr, int fq) const {
        asm volatile("" : "+v"(fr), "+v"(fq));
        const int rowb = u.row0 + wr * 64 + fr, colb = u.col0 + wc * 32 + 8 * fq;
        if (u.aux != 0) {
#pragma unroll
            for (int ai = 0; ai < 2; ++ai)
#pragma unroll
                for (int m = 0; m < 4; ++m)
#pragma unroll
                    for (int bj = 0; bj < 2; ++bj) { float v[8] = ACC8(ai, bj, m); kv(rowb + ai * 128 + m * 16, colb + bj * 128, v); }
            return;
        }
        f32x4 bb[2][2];
#pragma unroll
        for (int bj = 0; bj < 2; ++bj) { bb[bj][0] = *(const f32x4*)(mn.biasp + colb + bj * 128); bb[bj][1] = *(const f32x4*)(mn.biasp + colb + bj * 128 + 4); }
        float fpos[2][4];
#pragma unroll
        for (int ai = 0; ai < 2; ++ai)
#pragma unroll
            for (int m = 0; m < 4; ++m) fpos[ai][m] = 0.f;
        if (u.col0 < C_V) {
#pragma unroll
            for (int ai = 0; ai < 2; ++ai)
#pragma unroll
                for (int m = 0; m < 4; ++m) fpos[ai][m] = (float)mn.pos[mn.tok0 + rowb + ai * 128 + m * 16];
        }
        if (u.col0 >= C_GATE) {
            typedef float v2f_t __attribute__((ext_vector_type(2)));
            const float s2 = -1.4426950408889634f * ascale; v2f_t bp[2][4];
#pragma unroll
            for (int bj = 0; bj < 2; ++bj) { bp[bj][0] = (v2f_t){bb[bj][0].x, bb[bj][0].y} * -1.4426950408889634f; bp[bj][1] = (v2f_t){bb[bj][0].z, bb[bj][0].w} * -1.4426950408889634f;
                bp[bj][2] = (v2f_t){bb[bj][1].x, bb[bj][1].y} * -1.4426950408889634f; bp[bj][3] = (v2f_t){bb[bj][1].z, bb[bj][1].w} * -1.4426950408889634f; }
            unsigned char* gp = (unsigned char*)mn.GATES + (size_t)rowb * 3072 + (colb - C_GATE);
#pragma unroll
            for (int ai = 0; ai < 2; ++ai)
#pragma unroll
                for (int m = 0; m < 4; ++m)
#pragma unroll
                    for (int bj = 0; bj < 2; ++bj) { const f32x4 a0 = acc[ai][bj][m][0], a1 = acc[ai][bj][m][1];
                        const v2f_t t[4] = {__builtin_elementwise_fma((v2f_t){a0.x, a0.y}, (v2f_t){s2, s2}, bp[bj][0]), __builtin_elementwise_fma((v2f_t){a0.z, a0.w}, (v2f_t){s2, s2}, bp[bj][1]),
                                            __builtin_elementwise_fma((v2f_t){a1.x, a1.y}, (v2f_t){s2, s2}, bp[bj][2]), __builtin_elementwise_fma((v2f_t){a1.z, a1.w}, (v2f_t){s2, s2}, bp[bj][3])};
                        unsigned w[2] = {0u, 0u};
#pragma unroll
                        for (int q = 0; q < 4; ++q) { v2f_t r;
#pragma unroll
                            for (int e = 0; e < 2; ++e) r[e] = __builtin_amdgcn_rcpf(__builtin_amdgcn_fmed3f(__builtin_fmaf(__builtin_amdgcn_exp2f(t[q][e]), 1.0f / 255.0f, 1.0f / 255.0f), 0.0f, 1.0f));
                            r = r + (v2f_t){0.5f, 0.5f};
                            w[q >> 1] = __builtin_amdgcn_cvt_pk_u8_f32(r[0], 2 * (q & 1), w[q >> 1]); w[q >> 1] = __builtin_amdgcn_cvt_pk_u8_f32(r[1], 2 * (q & 1) + 1, w[q >> 1]); }
                        *(u32x2*)(gp + (size_t)(ai * 128 + m * 16) * 3072 + bj * 128) = (u32x2){w[0], w[1]}; }
            return;
        }
        float invrev[4]; EpiMain::rope_freqs(colb, invrev);
#define FEM_LOOP(S_) do { _Pragma("unroll") for (int ai = 0; ai < 2; ++ai) _Pragma("unroll") for (int m = 0; m < 4; ++m) _Pragma("unroll") for (int bj = 0; bj < 2; ++bj) { float v[8] = ACC8(ai, bj, m); \
            _Pragma("unroll") for (int q = 0; q < 8; ++q) v[q] *= ascale; \
            v[0] += bb[bj][0].x; v[1] += bb[bj][0].y; v[2] += bb[bj][0].z; v[3] += bb[bj][0].w; v[4] += bb[bj][1].x; v[5] += bb[bj][1].y; v[6] += bb[bj][1].z; v[7] += bb[bj][1].w; \
            mn.template finish_s<S_>(rowb + ai * 128 + m * 16, colb + bj * 128, v, fpos[ai][m], invrev); } } while (0)
        if (u.col0 < C_GLU) {
            typedef float v2f_t __attribute__((ext_vector_type(2)));
            const int sec = u.col0 / 1536, r0 = colb - sec * 1536, gh0 = (u.col0 - sec * 1536) >> 7, pcol = r0 & 127, g = gh0 >> 2, sh = 2 * g;
            const int bl = rowb >> 11, s0 = rowb & 2047;
            bf16_t* p0 = mn.QG + (size_t)sec * (SZ_QKV1 / 2) + ((size_t)(bl * 12 + gh0) * 2048 + rowperm(g, s0)) * 128 + pcol;
            asm volatile("" : "+v"(invrev[0]), "+v"(invrev[1]), "+v"(invrev[2]), "+v"(invrev[3]));
#define FEM_QKV(ROT) do { _Pragma("unroll") for (int ai = 0; ai < 2; ++ai) _Pragma("unroll") for (int m = 0; m < 4; ++m) { \
                v2f_t C_[2], S_[2]; \
                if (ROT) { float c4[4], s4[4]; _Pragma("unroll") for (int e = 0; e < 4; ++e) { const float rev = __builtin_amdgcn_fractf(fpos[ai][m] * invrev[e]); s4[e] = __builtin_amdgcn_sinf(rev); c4[e] = __builtin_amdgcn_cosf(rev); } \
                    C_[0] = (v2f_t){c4[0], c4[1]}; C_[1] = (v2f_t){c4[2], c4[3]}; S_[0] = (v2f_t){s4[0], s4[1]}; S_[1] = (v2f_t){s4[2], s4[3]}; } \
                bf16_t* pr = p0 + (size_t)((16 * m + 128 * ai) >> sh) * 128; \
                _Pragma("unroll") for (int bj = 0; bj < 2; ++bj) { const f32x4 a0 = acc[ai][bj][m][0], a1 = acc[ai][bj][m][1]; const v2f_t as2 = {ascale, ascale}; \
                    v2f_t X[2] = {__builtin_elementwise_fma((v2f_t){a0.x, a0.y}, as2, (v2f_t){bb[bj][0].x, bb[bj][0].y}), __builtin_elementwise_fma((v2f_t){a0.z, a0.w}, as2, (v2f_t){bb[bj][0].z, bb[bj][0].w})}; \
                    v2f_t Y[2] = {__builtin_elementwise_fma((v2f_t){a1.x, a1.y}, as2, (v2f_t){bb[bj][1].x, bb[bj][1].y}), __builtin_elementwise_fma((v2f_t){a1.z, a1.w}, as2, (v2f_t){bb[bj][1].z, bb[bj][1].w})}; \
                    if (ROT) { _Pragma("unroll") for (int h = 0; h < 2; ++h) { const v2f_t x_ = X[h], y_ = Y[h]; X[h] = __builtin_elementwise_fma(-y_, S_[h], x_ * C_[h]); Y[h] = __builtin_elementwise_fma(x_, S_[h], y_ * C_[h]); } } \
                    u32x4 o; o.x = pk2(X[0].x, X[0].y); o.y = pk2(X[1].x, X[1].y); o.z = pk2(Y[0].x, Y[0].y); o.w = pk2(Y[1].x, Y[1].y); \
                    *(u32x4*)(pr + (size_t)bj * (2048 * 128)) = o; } } } while (0)
            if (u.col0 < C_V) FEM_QKV(true); else FEM_QKV(false);
#undef FEM_QKV
            return;
        }
        if (u.col0 < C_QM) FEM_LOOP(2); else FEM_LOOP(3);
#undef FEM_LOOP
    }
};
struct FastEpiGates {
    static constexpr bool PERM = true, KEEPS = false; const float* biasp; bf16_t* GATES; float ascale;
    __device__ __forceinline__ bool keep_acc(const pg8::Unit&) const { return false; }
    __device__ __forceinline__ void operator()(f32x4 (&acc)[2][2][4][2], const pg8::Unit& u, int wr, int wc, int fr, int fq) const {
        asm volatile("" : "+v"(fr), "+v"(fq));
        const int rowb = u.row0 + wr * 64 + fr, colb = u.col0 + wc * 32 + 8 * fq;
        f32x4 bb[2][2];
#pragma unroll
        for (int bj = 0; bj < 2; ++bj) { bb[bj][0] = *(const f32x4*)(biasp + colb + bj * 128); bb[bj][1] = *(const f32x4*)(biasp + colb + bj * 128 + 4); }
#pragma unroll
        for (int ai = 0; ai < 2; ++ai)
#pragma unroll
            for (int m = 0; m < 4; ++m)
#pragma unroll
                for (int bj = 0; bj < 2; ++bj) { const f32x4 a = acc[ai][bj][m][0] * ascale + bb[bj][0], b = acc[ai][bj][m][1] * ascale + bb[bj][1];
                    u32x4 o; o.x = pk2(sigmoidf_(a.x), sigmoidf_(a.y)); o.y = pk2(sigmoidf_(a.z), sigmoidf_(a.w)); o.z = pk2(sigmoidf_(b.x), sigmoidf_(b.y)); o.w = pk2(sigmoidf_(b.z), sigmoidf_(b.w));
                    *(u32x4*)(GATES + (size_t)(rowb + ai * 128 + m * 16) * 3072 + (colb + bj * 128 - C_GATE)) = o; }
    }
};
constexpr float P4_ASCALE = P4_FP8 ? 1.0f / (O8_SCALE * W8_SCALE) : 1.0f;
struct FastEpiMerge {
    static constexpr bool PERM = true, KEEPS = true; const bf16_t* GATES; bf16_t* MERGED;
    __device__ __forceinline__ bool keep_acc(const pg8::Unit& u) const { return u.aux < 2; }
    __device__ __forceinline__ void operator()(f32x4 (&acc)[2][2][4][2], const pg8::Unit& u, int wr, int wc, int fr, int fq) const {
        asm volatile("" : "+v"(fr), "+v"(fq));
        const int rowb = u.row0 + wr * 64 + fr, colb = u.col0 + wc * 32 + 8 * fq, br = u.aux;
        const unsigned char* gp = (const unsigned char*)GATES + (size_t)rowb * 3072 + br * 1024 + colb;
        bf16_t* mp = MERGED + (size_t)rowb * 1024 + colb;
#pragma unroll
        for (int ai = 0; ai < 2; ++ai) {
            u32x2 tg[4][2], tn[4][2];
#pragma unroll
            for (int m = 0; m < 4; ++m)
#pragma unroll
                for (int bj = 0; bj < 2; ++bj) { tg[m][bj] = *(const u32x2*)(gp + (size_t)(ai * 128 + m * 16) * 3072 + bj * 128);
                    if (br < 2) tn[m][bj] = *(const u32x2*)(gp + 1024 + (size_t)(ai * 128 + m * 16) * 3072 + bj * 128); }
            if (br < 2) {
#pragma unroll
                for (int m = 0; m < 4; ++m)
#pragma unroll
                    for (int bj = 0; bj < 2; ++bj) { const u32x2 g = tg[m][bj], n = tn[m][bj]; const f32x4 n0 = u8x4_raw(n.x), n1 = u8x4_raw(n.y);
                        const f32x4 r0 = {__builtin_amdgcn_rcpf(n0.x), __builtin_amdgcn_rcpf(n0.y), __builtin_amdgcn_rcpf(n0.z), __builtin_amdgcn_rcpf(n0.w)}, r1 = {__builtin_amdgcn_rcpf(n1.x), __builtin_amdgcn_rcpf(n1.y), __builtin_amdgcn_rcpf(n1.z), __builtin_amdgcn_rcpf(n1.w)};
                        acc[ai][bj][m][0] = acc[ai][bj][m][0] * (u8x4_raw(g.x) * r0); acc[ai][bj][m][1] = acc[ai][bj][m][1] * (u8x4_raw(g.y) * r1); }
            } else {
#pragma unroll
                for (int m = 0; m < 4; ++m)
#pragma unroll
                    for (int bj = 0; bj < 2; ++bj) { const u32x2 g = tg[m][bj];
#if P5_FP8
                        const f32x4 a = acc[ai][bj][m][0] * (u8x4_raw(g.x) * (P4_ASCALE * M8_SCALE / 255.0f)), b = acc[ai][bj][m][1] * (u8x4_raw(g.y) * (P4_ASCALE * M8_SCALE / 255.0f));
                        u32x2 o; o.x = pk4_fp8(a.x, a.y, a.z, a.w); o.y = pk4_fp8(b.x, b.y, b.z, b.w);
                        *(u32x2*)((unsigned char*)MERGED + (size_t)(rowb + ai * 128 + m * 16) * 1024 + colb + bj * 128) = o;
#else
                        const f32x4 a = acc[ai][bj][m][0] * (u8x4_raw(g.x) * (P4_ASCALE / 255.0f)), b = acc[ai][bj][m][1] * (u8x4_raw(g.y) * (P4_ASCALE / 255.0f));
                        u32x4 o; o.x = pk2(a.x, a.y); o.y = pk2(a.z, a.w); o.z = pk2(b.x, b.y); o.w = pk2(b.z, b.w);
                        *(u32x4*)(mp + (size_t)(ai * 128 + m * 16) * 1024 + bj * 128) = o;
#endif
                    }
            }
            asm volatile("" ::: "memory");
        }
    }
};
struct FastEpiStore8 {
    static constexpr bool PERM = true, KEEPS = false; unsigned char* O; int ld; float scale;
    __device__ __forceinline__ bool keep_acc(const pg8::Unit&) const { return false; }
    __device__ __forceinline__ void operator()(f32x4 (&acc)[2][2][4][2], const pg8::Unit& u, int wr, int wc, int fr, int fq) const {
        asm volatile("" : "+v"(fr), "+v"(fq));
        const int rowb = u.row0 + wr * 64 + fr, colb = u.col0 + wc * 32 + 8 * fq;
#pragma unroll
        for (int ai = 0; ai < 2; ++ai)
#pragma unroll
            for (int m = 0; m < 4; ++m)
#pragma unroll
                for (int bj = 0; bj < 2; ++bj) { const f32x4 a = acc[ai][bj][m][0] * scale, b = acc[ai][bj][m][1] * scale;
                    u32x2 o; o.x = pk4_fp8s(a.x, a.y, a.z, a.w); o.y = pk4_fp8s(b.x, b.y, b.z, b.w);
                    *(u32x2*)(O + (size_t)(rowb + ai * 128 + m * 16) * ld + colb + bj * 128) = o; }
    }
};
struct FastEpiStore {
    static constexpr bool PERM = true, KEEPS = false; bf16_t* O; int ld; float scale;
    __device__ __forceinline__ bool keep_acc(const pg8::Unit&) const { return false; }
    __device__ __forceinline__ void operator()(f32x4 (&acc)[2][2][4][2], const pg8::Unit& u, int wr, int wc, int fr, int fq) const {
        asm volatile("" : "+v"(fr), "+v"(fq));
        const int rowb = u.row0 + wr * 64 + fr, colb = u.col0 + wc * 32 + 8 * fq;
#pragma unroll
        for (int ai = 0; ai < 2; ++ai)
#pragma unroll
            for (int m = 0; m < 4; ++m)
#pragma unroll
                for (int bj = 0; bj < 2; ++bj) { const f32x4 a = acc[ai][bj][m][0] * scale, b = acc[ai][bj][m][1] * scale;
                    u32x4 o; o.x = pk2(a.x, a.y); o.y = pk2(a.z, a.w); o.z = pk2(b.x, b.y); o.w = pk2(b.z, b.w);
                    *(u32x4*)(O + (size_t)(rowb + ai * 128 + m * 16) * ld + colb + bj * 128) = o; }
    }
};
struct FastEpiNull {
    static constexpr bool PERM = true, KEEPS = false; bf16_t* O;
    __device__ __forceinline__ bool keep_acc(const pg8::Unit&) const { return false; }
    __device__ __forceinline__ void operator()(f32x4 (&acc)[2][2][4][2], const pg8::Unit& u, int wr, int wc, int fr, int fq) const {
        float s = 0.f;
#pragma unroll
        for (int ai = 0; ai < 2; ++ai)
#pragma unroll
            for (int m = 0; m < 4; ++m)
#pragma unroll
                for (int bj = 0; bj < 2; ++bj) { const f32x4 a = acc[ai][bj][m][0], b = acc[ai][bj][m][1]; s += a.x + a.y + a.z + a.w + b.x + b.y + b.z + b.w; }
        if (s == 1.2345e38f) O[u.row0 + fr] = (bf16_t)1;
    }
};
struct FastEpiMoe1 {
    static constexpr bool PERM = true, KEEPS = false; LAS const int* toktab; const float* wts; unsigned char* H8;
    __device__ __forceinline__ bool keep_acc(const pg8::Unit&) const { return false; }
    __device__ __forceinline__ void operator()(f32x4 (&acc)[2][2][4][2], const pg8::Unit& u, int wr, int wc, int fr, int fq) const {
        asm volatile("" : "+v"(fr), "+v"(fq));
        const int rloc = wr * 64 + fr, colb = u.col0 + wc * 32 + 8 * fq, hi = u.col0 >> 10;
        float w[2][4];
#pragma unroll
        for (int ai = 0; ai < 2; ++ai)
#pragma unroll
            for (int m = 0; m < 4; ++m) { const int tok = toktab[u.aux * 256 + rloc + ai * 128 + m * 16]; w[ai][m] = wts[(size_t)tok * 2 + hi] * (H8_SCALE / W8_SCALE); }
        constexpr float inv = 1.0f / W8_SCALE;
#pragma unroll
        for (int ai = 0; ai < 2; ++ai)
#pragma unroll
            for (int m = 0; m < 4; ++m)
#pragma unroll
                for (int bj = 0; bj < 2; ++bj) { const f32x4 gt = acc[ai][bj][m][0] * inv, up = acc[ai][bj][m][1]; const float ww = w[ai][m];
                    const int j0 = hi * 512 + (((colb + bj * 128) & 1023) >> 1);
                    float h[4] = {gt.x * sigmoidf_(gt.x) * up.x * ww, gt.y * sigmoidf_(gt.y) * up.y * ww, gt.z * sigmoidf_(gt.z) * up.z * ww, gt.w * sigmoidf_(gt.w) * up.w * ww};
#pragma unroll
                    for (int q = 0; q < 4; ++q) h[q] = fminf(fmaxf(h[q], -448.f), 448.f);
                    *(unsigned*)(H8 + (size_t)(u.row0 + rloc + ai * 128 + m * 16) * 1024 + j0) = pk4_fp8(h[0], h[1], h[2], h[3]); }
    }
};
#undef ACC8

struct SchedMain {
    pg8::TileOrder to; int nkv, tile0, cut, skip; size_t astep, bstep; const char *XB, *WIN, *MEMB, *WKV;
    __device__ __forceinline__ bool next(int i, pg8::Unit& u) const {
        int pm, pn;
        if (to.tile(i, pm, pn)) { const int ct = tile0 + (pn < cut ? pn : pn + skip); u.A = XB + (size_t)pm * astep; u.B = WIN + (size_t)ct * bstep; u.row0 = pm * 256; u.col0 = ct * 256; u.bjump = 0; u.aux = 0; return true; }
        const long L = (long)i * to.G + to.c - to.nwg; if (L >= nkv) return false;
        pm = (int)(L >> 2); pn = (int)(L & 3);
        u.A = MEMB + (size_t)pm * 256 * 2048; u.B = WKV + (size_t)pn * 256 * 2048; u.row0 = pm * 256; u.col0 = pn * 256; u.bjump = 0; u.aux = 1; return true;
    }
};
struct SchedMerge {
    pg8::TileOrder to; const char *A0, *W;
    __device__ __forceinline__ bool next(int i, pg8::Unit& u) const {
        const int ti = i / 3, br = i - ti * 3; int pm, pn; if (!to.tile(ti, pm, pn)) return false;
        u.A = A0 + (size_t)br * SZ_512 + (size_t)pm * 256 * (P4_FP8 ? 512 : 1024); u.B = W + (size_t)br * MiB + (size_t)pn * 256 * (P4_FP8 ? 512 : 1024); u.row0 = pm * 256; u.col0 = pn * 256; u.bjump = 0; u.aux = br; return true;
    }
};
struct SchedPlain {
    pg8::TileOrder to; const char *A, *B; size_t astep, bstep;
    __device__ __forceinline__ bool next(int i, pg8::Unit& u) const {
        int pm, pn; if (!to.tile(i, pm, pn)) return false;
        u.A = A + (size_t)pm * astep; u.B = B + (size_t)pn * bstep; u.row0 = pm * 256; u.col0 = pn * 256; u.bjump = 0; u.aux = 0; return true;
    }
};
struct SchedMoe {
    pg8::TileOrder to; LAS const int* pan_cls; LAS const int* toktab; const char *H, *W1, *W2; int mode;
    __device__ __forceinline__ LAS const int* toks(int i) const { return toktab + i * 256; }
    __device__ __forceinline__ bool next(int i, pg8::Unit& u) const {
        int pm, pn; if (!to.tile(i, pm, pn)) return false;
        const int cls = pan_cls[pm]; int e_lo, e_hi; class_experts(cls, e_lo, e_hi);
        u.row0 = pm * 256; u.col0 = pn * 256; u.aux = i; u.bjump = 0;
        if (mode == 1) { u.A = nullptr; u.B = W1 + ((size_t)(pn < 4 ? e_lo : e_hi) * 1024 + (size_t)(pn & 3) * 256) * 1024; }
        else { u.A = H + (size_t)pm * 256 * 1024; u.B = W2 + (size_t)pn * 256 * 8192 + (size_t)e_lo * 512; u.bjump = (e_hi - e_lo - 1) * 512; }
        return true;
    }
};

template <int WHICH> __device__ __forceinline__ float tw_src(const Params& p, int k, int n) {
    if constexpr (WHICH == TW_IN) return p.w_in[(size_t)k * INC + win_logical(n)];
    else if constexpr (WHICH == TW_KV) return p.w_mem_kv[(size_t)k * 1024 + n];
    else if constexpr (WHICH == TW_A) return p.w_attn_o[(size_t)k * 1024 + n];
    else if constexpr (WHICH == TW_C) return p.w_conv_o[(size_t)k * 1024 + n];
    else if constexpr (WHICH == TW_M) return p.w_mem_o[(size_t)k * 1024 + n];
    else if constexpr (WHICH == TW_OUT) return p.w_out[(size_t)k * 1024 + n];
    else if constexpr (WHICH == TW_W1) { const int e = n >> 10, c = n & 1023, G = c >> 3, nn = (c >> 2) & 1, ee = c & 3, jj = 4 * G + ee; return (nn ? p.w_eu : p.w_eg)[((size_t)e * 1024 + k) * 512 + jj]; }
    else { const int e = n >> 10, c = n & 1023; return p.w_ed[((size_t)e * 512 + k) * 1024 + c]; }
}
template <int WHICH> __device__ __forceinline__ void tw_item(const Params& p, int item, float* scr, int lane) {
    constexpr int N = WHICH == TW_IN ? INC : (WHICH >= TW_W1 ? 16 * 1024 : 1024);
    constexpr int ldd = (WHICH == TW_A || WHICH == TW_C || WHICH == TW_M) ? 512 : (WHICH == TW_W2 ? 8192 : 1024);
    constexpr size_t dsto = WHICH == TW_IN ? WS_WIN : WHICH == TW_KV ? WS_WKV : WHICH == TW_A ? WS_WA : WHICH == TW_C ? WS_WC : WHICH == TW_M ? WS_WM : WHICH == TW_OUT ? WS_WOUT : WHICH == TW_W1 ? WS_W1 : WS_W2;
    bf16_t* dst = WSP(bf16_t, dsto);
    constexpr int nblk = N / 32; const int kb = item / nblk, nb = item - kb * nblk, k0 = 64 * kb, n0 = 32 * nb;
#pragma unroll 8
    for (int i = 0; i < 32; ++i) { const int kk = 2 * i + (lane >> 5); scr[kk * 33 + (lane & 31)] = tw_src<WHICH>(p, k0 + kk, n0 + (lane & 31)); }
    asm volatile("s_waitcnt lgkmcnt(0)" ::: "memory");
    const int c = lane & 7;
#pragma unroll
    for (int j = 0; j < 4; ++j) { const int n = (lane >> 3) + 8 * j; const float* sp = scr + (8 * c) * 33 + n;
        const int nn = n0 + n; size_t doff;
        if constexpr (WHICH == TW_W2) doff = (size_t)(nn & 1023) * 8192 + (size_t)(nn >> 10) * 512 + k0 + 8 * c; else doff = (size_t)nn * ldd + k0 + 8 * c;
        if constexpr (WHICH >= TW_W1 || (P5_FP8 && WHICH == TW_OUT) || (P4_FP8 && (WHICH == TW_A || WHICH == TW_C || WHICH == TW_M))) {
            u32x2 o; o.x = pk4_fp8(W8_SCALE * sp[0 * 33], W8_SCALE * sp[1 * 33], W8_SCALE * sp[2 * 33], W8_SCALE * sp[3 * 33]); o.y = pk4_fp8(W8_SCALE * sp[4 * 33], W8_SCALE * sp[5 * 33], W8_SCALE * sp[6 * 33], W8_SCALE * sp[7 * 33]);
            *(u32x2*)((unsigned char*)dst + doff) = o;
        } else {
            u32x4 o; o.x = pk2(sp[0 * 33], sp[1 * 33]); o.y = pk2(sp[2 * 33], sp[3 * 33]); o.z = pk2(sp[4 * 33], sp[5 * 33]); o.w = pk2(sp[6 * 33], sp[7 * 33]);
            *(u32x4*)(dst + doff) = o;
            if constexpr (WHICH == TW_IN && !P1_FP6) {
                u32x2 q; q.x = pk4_fp8(WG8_SCALE * sp[0 * 33], WG8_SCALE * sp[1 * 33], WG8_SCALE * sp[2 * 33], WG8_SCALE * sp[3 * 33]); q.y = pk4_fp8(WG8_SCALE * sp[4 * 33], WG8_SCALE * sp[5 * 33], WG8_SCALE * sp[6 * 33], WG8_SCALE * sp[7 * 33]);
                *(u32x2*)(p.ws + WS_WG8 + doff) = q; } } }
    if constexpr (WHICH == TW_IN && P1_FP6) {
        const int n = lane & 31, b = lane >> 5, blk = (k0 >> 5) + b, tt = blk >> 2, fq = blk & 3; float v[32];
#pragma unroll
        for (int j = 0; j < 32; ++j) v[j] = WG8_SCALE * scr[(32 * b + j) * 33 + n];
        const v6u_t q = pack32_fp6(v);
        unsigned char* wp = p.ws + WS_WG8 + (size_t)(n0 + n) * 1024 + tt * 128 + 16 * fq;
        *(u32x4*)wp = (u32x4){q[0], q[1], q[2], q[3]}; *(u32x4*)(wp + 64) = (u32x4){q[4], q[5], 0u, 0u};
    }
    asm volatile("s_waitcnt lgkmcnt(0)" ::: "memory");
}
__device__ __forceinline__ void transpose_all(const Params& p, float* scr, int gw, int ngw, int lane) {
    constexpr int I_IN = 16 * (INC / 32), I_KV = 16 * 32, I_B = 8 * 32, I_OUT = 16 * 32, I_W1 = 16 * 512, I_W2 = 8 * 512;
    constexpr int NITEMS = I_IN + I_KV + 3 * I_B + I_OUT + I_W1 + I_W2;
    for (int it = gw; it < NITEMS; it += ngw) {
        int r = it;
        if (r < I_W1) { tw_item<TW_W1>(p, r, scr, lane); continue; } r -= I_W1;
        if (r < I_IN) { tw_item<TW_IN>(p, r, scr, lane); continue; } r -= I_IN;
        if (r < I_W2) { tw_item<TW_W2>(p, r, scr, lane); continue; } r -= I_W2;
        if (r < I_KV) { tw_item<TW_KV>(p, r, scr, lane); continue; } r -= I_KV;
        if (r < I_OUT) { tw_item<TW_OUT>(p, r, scr, lane); continue; } r -= I_OUT;
        if (r < I_B) { tw_item<TW_A>(p, r, scr, lane); continue; } r -= I_B;
        if (r < I_B) { tw_item<TW_C>(p, r, scr, lane); continue; } r -= I_B;
        tw_item<TW_M>(p, r, scr, lane);
    }
}

__device__ __forceinline__ void cvt_bf16_dev(const float* __restrict__ src, bf16_t* __restrict__ dst, size_t n8, size_t gtid, size_t gstride) {
    for (size_t i = gtid; i < n8; i += gstride) {
        const f32x4 a = *(const f32x4*)(src + i * 8), b = *(const f32x4*)(src + i * 8 + 4);
        u32x4 o; o.x = pk2(a.x, a.y); o.y = pk2(a.z, a.w); o.z = pk2(b.x, b.y); o.w = pk2(b.z, b.w);
        *(u32x4*)(dst + i * 8) = o;
    }
}

__device__ __forceinline__ void cvt_x_dev(const float* __restrict__ src, bf16_t* __restrict__ dst, unsigned char* __restrict__ dst8, size_t n32, size_t gtid, size_t gstride) {
    for (size_t i = gtid; i < n32; i += gstride) {
        float v[32];
#pragma unroll
        for (int q = 0; q < 8; ++q) { const f32x4 a = *(const f32x4*)(src + i * 32 + 4 * q); v[4 * q] = a.x; v[4 * q + 1] = a.y; v[4 * q + 2] = a.z; v[4 * q + 3] = a.w; }
#pragma unroll
        for (int q = 0; q < 4; ++q) { u32x4 o; o.x = pk2(v[8 * q], v[8 * q + 1]); o.y = pk2(v[8 * q + 2], v[8 * q + 3]); o.z = pk2(v[8 * q + 4], v[8 * q + 5]); o.w = pk2(v[8 * q + 6], v[8 * q + 7]); *(u32x4*)(dst + i * 32 + 8 * q) = o; }
        if constexpr (P1_FP6) {
            const size_t row = i >> 5; const int blk = (int)(i & 31), tt = blk >> 2, fq = blk & 3; const v6u_t q6 = pack32_fp6(v);
            unsigned char* xp = dst8 + row * 1024 + tt * 128 + 16 * fq;
            *(u32x4*)xp = (u32x4){q6[0], q6[1], q6[2], q6[3]}; *(u32x4*)(xp + 64) = (u32x4){q6[4], q6[5], 0u, 0u};
        } else {
#pragma unroll
            for (int q = 0; q < 2; ++q) { u32x4 q8; q8.x = pk4_fp8(v[16 * q], v[16 * q + 1], v[16 * q + 2], v[16 * q + 3]); q8.y = pk4_fp8(v[16 * q + 4], v[16 * q + 5], v[16 * q + 6], v[16 * q + 7]);
                q8.z = pk4_fp8(v[16 * q + 8], v[16 * q + 9], v[16 * q + 10], v[16 * q + 11]); q8.w = pk4_fp8(v[16 * q + 12], v[16 * q + 13], v[16 * q + 14], v[16 * q + 15]); *(u32x4*)(dst8 + i * 32 + 16 * q) = q8; }
        }
    }
}
__device__ __forceinline__ void wg8_dev(const Params& p, size_t gtid, size_t gstride) {
    for (size_t i = gtid; i < (size_t)INC * 64; i += gstride) { const int n = (int)(i % INC), k0 = (int)(i / INC) * 16, nl = win_logical(n); float v[16];
#pragma unroll
        for (int j = 0; j < 16; ++j) v[j] = WG8_SCALE * p.w_in[(size_t)(k0 + j) * INC + nl];
        u32x4 q; q.x = pk4_fp8(v[0], v[1], v[2], v[3]); q.y = pk4_fp8(v[4], v[5], v[6], v[7]); q.z = pk4_fp8(v[8], v[9], v[10], v[11]); q.w = pk4_fp8(v[12], v[13], v[14], v[15]);
        *(u32x4*)(p.ws + WS_WG8 + (size_t)n * 1024 + k0) = q; }
}

#ifndef STAG_US
#define STAG_US 0
#endif
__device__ __forceinline__ void delay_us(int us) { const unsigned long long t0 = __builtin_amdgcn_s_memrealtime(); while (__builtin_amdgcn_s_memrealtime() - t0 < (unsigned long long)us * 100ull) __builtin_amdgcn_s_sleep(16); }

struct Args { Params p; int ph_lo, ph_hi; };
typedef const __attribute__((address_space(4))) unsigned long long* KArgPtr;
__device__ __forceinline__ Params load_params(KArgPtr q) {
    asm volatile("" : "+s"(q));
    Params p;
    p.x = (const float*)(const GAS float*)q[0]; p.mem = (const float*)(const GAS float*)q[1]; p.pos = (const int*)(const GAS int*)q[2]; p.w_in = (const float*)(const GAS float*)q[3]; p.b_in = (const float*)(const GAS float*)q[4]; p.conv_w = (const float*)(const GAS float*)q[5]; p.conv_b = (const float*)(const GAS float*)q[6];
    p.conv_g = (const float*)(const GAS float*)q[7]; p.conv_bb = (const float*)(const GAS float*)q[8]; p.w_mem_kv = (const float*)(const GAS float*)q[9]; p.w_attn_o = (const float*)(const GAS float*)q[10]; p.w_conv_o = (const float*)(const GAS float*)q[11]; p.w_mem_o = (const float*)(const GAS float*)q[12];
    p.w_out = (const float*)(const GAS float*)q[13]; p.ln1_g = (const float*)(const GAS float*)q[14]; p.ln1_b = (const float*)(const GAS float*)q[15]; p.w_gr = (const float*)(const GAS float*)q[16]; p.b_gr = (const float*)(const GAS float*)q[17]; p.w_er = (const float*)(const GAS float*)q[18]; p.b_er = (const float*)(const GAS float*)q[19];
    p.w_eg = (const float*)(const GAS float*)q[20]; p.w_eu = (const float*)(const GAS float*)q[21]; p.w_ed = (const float*)(const GAS float*)q[22]; p.ln2_g = (const float*)(const GAS float*)q[23]; p.ln2_b = (const float*)(const GAS float*)q[24]; p.out = (float*)(GAS float*)q[25]; p.ws = (unsigned char*)(GAS unsigned char*)q[26];
    return p;
}
static_assert(sizeof(Params) == 27 * 8, "Params is 27 pointers");
constexpr int PH_P0 = 0, PH_CH0 = 1, PH_PER_CH = 5, PH_LN1 = PH_CH0 + PH_PER_CH * NCH, PH_MOE1 = PH_LN1 + 1, PH_MOE2 = PH_LN1 + 2, PH_LN2 = PH_LN1 + 3, PH_END = PH_LN1 + 4;

__global__ void __launch_bounds__(NTHR, 2) mk_fwd(Args args) {
    extern __shared__ __attribute__((aligned(16))) unsigned char lds_raw[];
    LAS unsigned char* lds = (LAS unsigned char*)lds_raw;
    const KArgPtr kargs = (KArgPtr)__builtin_amdgcn_kernarg_segment_ptr();
    const int wave = __builtin_amdgcn_readfirstlane((int)threadIdx.x >> 6);
    const int G = gridDim.x; const int bx = blockIdx.x; const int vcu = (G % 8 == 0) ? (bx % 8) * (G / 8) + bx / 8 : bx;
    volatile LAS unsigned* MISC = (volatile LAS unsigned*)(lds + LCTL_OFF);
    ClassTab* tab = (ClassTab*)(lds_raw + LCTL_OFF + 256);
    int* pan_cls = (int*)(lds_raw + LCTL_OFF + 512);
    int* toktab = (int*)(lds_raw + LTOK_OFF);
    for (int u = threadIdx.x; u < (LDS_BYTES - LCTL_OFF) / 4; u += NTHR) ((LAS unsigned*)(lds + LCTL_OFF))[u] = 0u;
    __syncthreads();
    const int lo = args.ph_lo, hi = args.ph_hi;
    unsigned* ctl; { const Params p = load_params(kargs); ctl = WSP(unsigned, WS_CTL); }
    XcdBarrier bar; bar.bar = ctl + CW_BAR; bar.x = 0; bar.st = nullptr;
    if (hi - lo > 1) bar = xcd_barrier_post(ctl + CW_BAR, MISC);
#ifndef PHMASK
#define PHMASK 0x3ff
#endif
#ifndef P1_QK_FP8
#define P1_QK_FP8 2
#endif
#if P1_QK_FP8 == 3
constexpr int P1_BF16_TILES = 4, P1_BF16_T0 = 18, P1_BF16_CUT = 4, P1_BF16_SKIP = 0, P1_FP8_TILES = 32, P1_FP8_T0 = 0, P1_FP8_CUT = 18, P1_FP8_SKIP = 4;
#elif P1_QK_FP8 == 2
constexpr int P1_BF16_TILES = 0, P1_BF16_T0 = 0, P1_BF16_CUT = 0, P1_BF16_SKIP = 0, P1_FP8_TILES = 36, P1_FP8_T0 = 0, P1_FP8_CUT = 36, P1_FP8_SKIP = 0;
#elif P1_QK_FP8
constexpr int P1_BF16_TILES = 6, P1_BF16_T0 = 18, P1_BF16_CUT = 6, P1_BF16_SKIP = 0, P1_FP8_TILES = 30, P1_FP8_T0 = 0, P1_FP8_CUT = 18, P1_FP8_SKIP = 6;
#else
constexpr int P1_BF16_TILES = 18, P1_BF16_T0 = 0, P1_BF16_CUT = 12, P1_BF16_SKIP = 6, P1_FP8_TILES = 18, P1_FP8_T0 = 12, P1_FP8_CUT = 6, P1_FP8_SKIP = 6;
#endif
#ifndef ATTN_V2
#define ATTN_V2 1
#endif
#ifndef PROBE_DUP
#define PROBE_DUP (-1)
#endif
#define NREP(b) ((PROBE_DUP == (b)) ? 2 : 1)
#define IN(k) (lo <= (k) && (k) < hi)
#define HAS(b) ((PHMASK >> (b)) & 1)
#define SEAM(k) do { if (IN(k) && IN((k) + 1)) xcd_barrier(bar); } while (0)

    if (HAS(0) && IN(PH_P0)) {
        const Params p = load_params(kargs);
        const size_t gtid = (size_t)bx * NTHR + opaque_tid(wave), gstride = (size_t)G * NTHR;
        for (int rep = 0; rep < NREP(0); ++rep) {
        { const int ptid = opaque_tid(wave); transpose_all(p, (float*)(lds_raw + RING_OFF) + (ptid >> 6) * (64 * 33), bx * NWAVES + (ptid >> 6), G * NWAVES, ptid & 63); }
        small_prep_dev(p, gtid, gstride);
        cvt_bf16_dev(p.mem, WSP(bf16_t, WS_MEMB), (size_t)NB * MEML * 1024 / 8, gtid, gstride);
        cvt_x_dev(p.x, WSP(bf16_t, WS_XB), p.ws + WS_XB8, (size_t)T * 1024 / 32, gtid, gstride);
        }
    }
    SEAM(PH_P0);
    if (PROBE_DUP == 10 && hi - lo > 1) for (int r = 0; r < 16; ++r) xcd_barrier(bar);

    for (int ch = 0; ch < NCH; ++ch) {
        const int ph0 = PH_CH0 + PH_PER_CH * ch;
        if (HAS(1) && IN(ph0)) {
            const Params p = load_params(kargs);
            const EpiMain em{WSP(float, WS_BIASP), p.pos, WSP(bf16_t, WS_QG), WSP(bf16_t, WS_CGLU), WSP(bf16_t, WS_QM), WSP(bf16_t, WS_GATES), ch * TC};
            for (int rep = 0; rep < NREP(1); ++rep) {
            {
                SchedMain S; S.to.init(TC / 256, P1_BF16_TILES, G, bx); S.nkv = ch == 0 ? (NB * MEML / 256) * 4 : 0; S.tile0 = P1_BF16_T0; S.cut = P1_BF16_CUT; S.skip = P1_BF16_SKIP; S.astep = 256 * 2048; S.bstep = 256 * 2048;
                S.XB = (const char*)(WSP(bf16_t, WS_XB) + (size_t)ch * TC * 1024); S.WIN = (const char*)WSP(bf16_t, WS_WIN); S.MEMB = (const char*)WSP(bf16_t, WS_MEMB); S.WKV = (const char*)WSP(bf16_t, WS_WKV);
                FastEpiMain E{em, EpiKV{WSP(bf16_t, WS_KM)}, 1.0f};
#ifndef NO_P1A
                pg8::gemm_phase<FastEpiMain, SchedMain, true, false, false>(lds + RING_OFF, nullptr, 1024, 1024, 1024, S, E, wave);
#endif
                if (PROBE_DUP == 16) { FastEpiStore E2{WSP(bf16_t, WS_MERGED), 1024, 1.0f}; pg8::gemm_phase<FastEpiStore, SchedMain, true, false, false>(lds + RING_OFF, nullptr, 1024, 1024, 1024, S, E2, wave); }
            }
            {
                SchedMain S; S.to.init(TC / 256, P1_FP8_TILES, G, bx); S.nkv = 0; S.tile0 = P1_FP8_T0; S.cut = P1_FP8_CUT; S.skip = P1_FP8_SKIP; S.astep = 256 * 1024; S.bstep = 256 * 1024;
                S.XB = (const char*)(p.ws + WS_XB8 + (size_t)ch * TC * 1024); S.WIN = (const char*)(p.ws + WS_WG8); S.MEMB = nullptr; S.WKV = nullptr;
                FastEpiMain E{em, EpiKV{WSP(bf16_t, WS_KM)}, 1.0f / WG8_SCALE};
#ifndef NO_P1B
                if (STAG_US > 0 && ((bx >> 3) & 1)) delay_us(STAG_US);
                pg8::gemm_phase<FastEpiMain, SchedMain, true, false, false, P1_FP6 ? 2 : 1>(lds + RING_OFF, nullptr, 512, 512, 512, S, E, wave);
#endif
                if (PROBE_DUP == 17) { FastEpiStore E2{WSP(bf16_t, WS_MERGED), 1024, 1.0f}; pg8::gemm_phase<FastEpiStore, SchedMain, true, false, false, true>(lds + RING_OFF, nullptr, 512, 512, 512, S, E2, wave); }
                if (PROBE_DUP == 19 || PROBE_DUP == 20) { SchedMain S2 = S; S2.bstep = 0; if (PROBE_DUP == 20) S2.astep = 0; FastEpiNull E2{WSP(bf16_t, WS_MERGED)}; pg8::gemm_phase<FastEpiNull, SchedMain, true, false, false, true>(lds + RING_OFF, nullptr, 512, 512, 512, S2, E2, wave); }
                if (PROBE_DUP == 21) { SchedMain S2 = S; S2.bstep = 0; S2.astep = 0; FastEpiNull E2{WSP(bf16_t, WS_MERGED)}; pg8::gemm_phase<FastEpiNull, SchedMain, true, false, false, true>(lds + RING_OFF, nullptr, 512, 512, 256, S2, E2, wave); }
                if (PROBE_DUP == 22) { SchedMain S2 = S; S2.bstep = 0; S2.astep = 0; FastEpiNull E2{WSP(bf16_t, WS_MERGED)}; pg8::gemm_phase<FastEpiNull, SchedMain, true, false, false, 3>(lds + RING_OFF, nullptr, 512, 512, 512, S2, E2, wave); }
                if (PROBE_DUP == 18) { FastEpiNull E2{WSP(bf16_t, WS_MERGED)}; pg8::gemm_phase<FastEpiNull, SchedMain, true, false, false, true>(lds + RING_OFF, nullptr, 512, 512, 512, S, E2, wave); }
            }
            }
        }
        SEAM(ph0);
        if (HAS(2) && IN(ph0 + 1)) {
            const Params p = load_params(kargs);
            constexpr int NDIL = BC * 12 * 8, NMEMB = BC * 4 * 8, NBLK = NDIL + NMEMB;
#if ATTN_V2
            for (int rep = 0; rep < NREP(2); ++rep) {
            const bool dummy = (PROBE_DUP == 2) && rep == 0;
            LAS char* rlds = (LAS char*)(lds + RING_OFF); LAS float* scr = (LAS float*)(lds + LTOK_OFF);
            if (wave >= 4) __builtin_amdgcn_s_setprio(1);
            for (int hd = vcu; hd < BC * 16; hd += G) {
                if (hd < BC * 12) { const int g = (hd % 12) >> 2; const size_t base = (size_t)hd * 2048 * 128;
                    swa::head_dilated(WSP(bf16_t, WS_QG) + base, dummy ? WSP(bf16_t, WS_MERGED) + (size_t)(hd & 127) * 2048 * 128 : WSP(bf16_t, WS_QG) + base, WSP(bf16_t, WS_KG) + base, WSP(bf16_t, WS_VG) + base, WSP(float, WS_LSE) + (size_t)hd * 2048, (2048 >> (2 * g)) - 1, rlds, scr, wave);
                } else { const int bh = hd - BC * 12, bl = bh >> 2, h = bh & 3; const size_t kvb = (size_t)(ch * BC * 4 + bh) * 256 * 128;
                    swa::head_mem(WSP(bf16_t, WS_QM) + (size_t)bh * 2048 * 128, WSP(bf16_t, WS_KM) + kvb, WSP(bf16_t, WS_VM) + kvb, (bf16_t*)(p.ws + WS_OMT + (P4_FP8 ? 1 : 2) * ((size_t)bl * 2048 * 512 + h * 128)), 512, rlds, scr, wave); }
            }
            __builtin_amdgcn_s_setprio(0);
            __syncthreads();
            }
            {
                const Params pc = load_params(kargs); const int ptid = opaque_tid(wave); volatile LAS unsigned* qslot = MISC + 4;
                for (;;) {
                    if (ptid == 0) *qslot = atomicAdd(ctl + CW_CONVQ + ch, 1u);
                    __syncthreads();
                    const int u = (int)*qslot;
                    if (u >= BC * 64) break;
                    conv_unit(pc, u, lds_raw + RING_OFF, ptid);
                }
            }
        }
#else
            for (int rep = 0; rep < NREP(2); ++rep) {
            const bool dummy = (PROBE_DUP == 2) && rep == 0;
            auto make_ref = [&](int L) -> swa::BlockRef {
                swa::BlockRef r;
                if (L < NDIL) { const int bgh = L >> 3, qb = L & 7, g = (bgh % 12) >> 2; const size_t base = (size_t)bgh * 2048 * 128;
                    r.Q = WSP(bf16_t, WS_QG) + base + (size_t)qb * 256 * 128; r.K = WSP(bf16_t, WS_KG) + base; r.V = WSP(bf16_t, WS_VG) + base; r.O = dummy ? WSP(bf16_t, WS_MERGED) + (base % (SZ_XB / 2 - 65536)) : (bf16_t*)r.Q;
                    r.LSE = WSP(float, WS_LSE) + (size_t)bgh * 2048 + qb * 256; r.P0 = qb * 256; r.W = 129; r.segmask = (2048 >> (2 * g)) - 1; r.skv = 2048; r.ostride = 128; }
                else { const int idx = L - NDIL, bh = idx >> 3, qb = idx & 7, bl = bh >> 2, h = bh & 3; const size_t kvb = (size_t)(ch * BC * 4 + bh) * 256 * 128;
                    r.Q = WSP(bf16_t, WS_QM) + ((size_t)bh * 2048 + qb * 256) * 128; r.K = WSP(bf16_t, WS_KM) + kvb; r.V = WSP(bf16_t, WS_VM) + kvb;
                    r.O = WSP(bf16_t, WS_OMT) + ((size_t)bl * 2048 + qb * 256) * 512 + h * 128; r.LSE = nullptr; r.P0 = 256; r.W = 1 << 20; r.segmask = (1 << 20) - 1; r.skv = 256; r.ostride = 512; }
                return r; };
            int L = vcu;
            if (L < NBLK) {
                swa::BlockRef cur = make_ref(L); swa::Seam Sm;
                swa::prime(cur, (char*)lds_raw + RING_OFF, Sm, wave);
                for (;;) {
                    const bool more = L + G < NBLK; const int Ln = more ? L + G : L;
                    const swa::BlockRef nxt = more ? make_ref(Ln) : cur;
                    swa::block(cur, nxt, (char*)lds_raw + RING_OFF, Sm, wave);
                    if (!more) break;
                    cur = nxt; L = Ln;
                }
            }
            __syncthreads();
            { const Params pc = load_params(kargs); const int ptid = opaque_tid(wave); for (int u = bx; u < BC * 64; u += G) conv_unit(pc, u, lds_raw + RING_OFF, ptid); }
            if (PROBE_DUP == 13) { const int ptid = opaque_tid(wave); for (int u = bx; u < BC * 64; u += G) conv_unit(p, u, lds_raw + RING_OFF, ptid); }
            if (PROBE_DUP == 14) {
                int L = NDIL + vcu;
                if (L < NBLK) { swa::BlockRef cur = make_ref(L); swa::Seam Sm; swa::prime(cur, (char*)lds_raw + RING_OFF, Sm, wave);
                    for (;;) { const bool more = L + G < NBLK; const int Ln = more ? L + G : L; const swa::BlockRef nxt = more ? make_ref(Ln) : cur; swa::block(cur, nxt, (char*)lds_raw + RING_OFF, Sm, wave); if (!more) break; cur = nxt; L = Ln; } }
                __syncthreads();
            }
            }
        }
#endif
        SEAM(ph0 + 1);
        if (HAS(3) && IN(ph0 + 2)) { const Params p = load_params(kargs); const int ptid = opaque_tid(wave); for (int rep = 0; rep < NREP(3); ++rep) for (int w = bx * NWAVES + (ptid >> 6); w < TC; w += 2 * G * NWAVES) { if (w + G * NWAVES < TC) combine_token2(p, w, w + G * NWAVES, ptid & 63); else combine_token(p, w, ptid & 63); } }
        SEAM(ph0 + 2);
        if (HAS(4) && IN(ph0 + 3)) {
            const Params p = load_params(kargs);
            SchedMerge S; S.to.init(TC / 256, 4, G, bx); S.A0 = (const char*)WSP(bf16_t, WS_OATT); S.W = (const char*)WSP(bf16_t, WS_WA);
            FastEpiMerge E{WSP(bf16_t, WS_GATES), WSP(bf16_t, WS_MERGED)};
            if (PROBE_DUP == 15) { FastEpiStore E2{WSP(bf16_t, WS_MERGED), 1024, 1.0f}; pg8::gemm_phase<FastEpiStore, SchedMerge, true, false, false>(lds + RING_OFF, nullptr, 512, 512, 512, S, E2, wave); }
#if P4_FP8
            for (int rep = 0; rep < NREP(4); ++rep) pg8::gemm_phase<FastEpiMerge, SchedMerge, true, false, false, 1>(lds + RING_OFF, nullptr, 256, 256, 256, S, E, wave);
#else
            for (int rep = 0; rep < NREP(4); ++rep) pg8::gemm_phase<FastEpiMerge, SchedMerge, true, false, false>(lds + RING_OFF, nullptr, 512, 512, 512, S, E, wave);
#endif
        }
        SEAM(ph0 + 3);
        if (HAS(5) && IN(ph0 + 4)) {
            const Params p = load_params(kargs);
#if P5_FP8
            SchedPlain S; S.to.init(TC / 256, 4, G, bx); S.A = (const char*)WSP(bf16_t, WS_MERGED); S.B = (const char*)WSP(bf16_t, WS_WOUT); S.astep = 256 * 1024; S.bstep = 256 * 1024;
            FastEpiStore E{(bf16_t*)p.out + (size_t)ch * TC * 1024, 1024, 1.0f / (M8_SCALE * W8_SCALE)};
            for (int rep = 0; rep < NREP(5); ++rep) pg8::gemm_phase<FastEpiStore, SchedPlain, true, false, false, 1>(lds + RING_OFF, nullptr, 512, 512, 512, S, E, wave);
#else
            SchedPlain S; S.to.init(TC / 256, 4, G, bx); S.A = (const char*)WSP(bf16_t, WS_MERGED); S.B = (const char*)WSP(bf16_t, WS_WOUT); S.astep = 256 * 2048; S.bstep = 256 * 2048;
            FastEpiStore E{(bf16_t*)p.out + (size_t)ch * TC * 1024, 1024, 1.0f};
            for (int rep = 0; rep < NREP(5); ++rep) pg8::gemm_phase<FastEpiStore, SchedPlain, true, false, false>(lds + RING_OFF, nullptr, 1024, 1024, 1024, S, E, wave);
#endif
        }
        if (ch + 1 == NCH) SEAM(ph0 + 4);
    }

    if (HAS(6) && IN(PH_LN1)) {
        const Params p = load_params(kargs);
        float* wr = (float*)(lds_raw + RING_OFF); int* cls_l = (int*)(wr + 20 * 1024); int* misc = cls_l + 64;
        for (int i = opaque_tid(wave); i < 20 * 1024; i += NTHR) wr[i] = WSP(float, WS_WRT)[i];
        __syncthreads();
        { for (int rep = 0; rep < NREP(6); ++rep) for (int u = bx; u < T / 64; u += G) { const int ptid = opaque_tid(wave); ln1_unit16(p, u, wr, cls_l, misc, ptid, (PROBE_DUP == 6) && rep == 0); } }
    }
    SEAM(PH_LN1);
    if (IN(PH_MOE1) || IN(PH_MOE2) || IN(PH_LN2)) {
        const int tid = opaque_tid(wave);
        if (tid == 0) class_tab_fill(ctl + CW_CNT, tab);
        __syncthreads();
        const int NP = tab->rowbase[NCLS] >> 8;
        for (int pm = tid; pm < NP; pm += NTHR) pan_cls[pm] = find_class(tab, pm * 256);
        __syncthreads();
    }
    if (HAS(7) && IN(PH_MOE1)) {
        const Params p = load_params(kargs);
        const int NP = tab->rowbase[NCLS] >> 8;
        SchedMoe S; S.to.init(NP, 8, G, bx); S.pan_cls = (LAS const int*)(lds + LCTL_OFF + 512); S.toktab = (LAS const int*)(lds + LTOK_OFF); S.H = nullptr; S.W1 = (const char*)WSP(bf16_t, WS_W1); S.W2 = nullptr; S.mode = 1;
        const int tid = opaque_tid(wave);
        for (int i = 0; i < MAXU; ++i) { int pm, pn; if (!S.to.tile(i, pm, pn)) break;
            if (tid < 256) { const int cls = pan_cls[pm]; int r = pm * 256 + tid - tab->rowbase[cls]; if (r >= tab->cnt[cls]) r = tab->cnt[cls] - 1; toktab[i * 256 + tid] = WSP(int, WS_LIST)[(size_t)cls * T + r]; } }
        __syncthreads();
        FastEpiMoe1 E{(LAS const int*)(lds + LTOK_OFF), WSP(float, WS_WTS), p.ws + WS_H};
        for (int rep = 0; rep < NREP(7); ++rep) pg8::gemm_phase<FastEpiMoe1, SchedMoe, true, true, false, true>(lds + RING_OFF, (const char*)(p.ws + WS_X1B8), 512, 512, 512, S, E, wave);
    }
    SEAM(PH_MOE1);
    if (HAS(8) && IN(PH_MOE2)) {
        const Params p = load_params(kargs);
        const int NP = tab->rowbase[NCLS] >> 8;
        SchedMoe S; S.to.init(NP, 4, G, bx); S.pan_cls = (LAS const int*)(lds + LCTL_OFF + 512); S.toktab = (LAS const int*)(lds + LTOK_OFF); S.H = (const char*)WSP(bf16_t, WS_H); S.W1 = nullptr; S.W2 = (const char*)WSP(bf16_t, WS_W2); S.mode = 2;
#if Y2_FP8
        FastEpiStore8 E{p.ws + WS_Y2, 1024, Y8_SCALE / (H8_SCALE * W8_SCALE)};
        for (int rep = 0; rep < NREP(8); ++rep) pg8::gemm_phase<FastEpiStore8, SchedMoe, true, false, true, true>(lds + RING_OFF, nullptr, 512, 4096, 512, S, E, wave);
#else
        FastEpiStore E{WSP(bf16_t, WS_Y2), 1024, 1.0f / (H8_SCALE * W8_SCALE)};
        for (int rep = 0; rep < NREP(8); ++rep) pg8::gemm_phase<FastEpiStore, SchedMoe, true, false, true, true>(lds + RING_OFF, nullptr, 512, 4096, 512, S, E, wave);
#endif
    }
    SEAM(PH_MOE2);
    if (HAS(9) && IN(PH_LN2)) {
        const Params p = load_params(kargs);
        const int tot = tab->rowbase[NCLS]; const int lane = opaque_tid(wave) & 63;
        for (int rep = 0; rep < NREP(9); ++rep)
        for (int prow = bx * NWAVES + wave; prow < tot; prow += 2 * G * NWAVES) {
            int tk[2], pr[2];
#pragma unroll
            for (int r = 0; r < 2; ++r) { pr[r] = prow + r * G * NWAVES; tk[r] = -1;
                if (pr[r] < tot) { const int cls = pan_cls[pr[r] >> 8]; const int i = pr[r] - tab->rowbase[cls]; if (i < tab->cnt[cls]) tk[r] = WSP(int, WS_LIST)[(size_t)cls * T + i]; } }
            ln2_rows<2>(p, tk, pr, lane, ((PROBE_DUP == 9) && rep == 0) ? (float*)(p.ws + 512 * MiB) : nullptr);
        }
    }
#undef IN
#undef HAS
#undef SEAM
}

#ifndef MK_MODE
#define MK_MODE 3
#endif
extern "C" void kernel_launch(void* const* d_in, const int* in_sizes, int n_in, void* d_out, int out_size, void* d_ws, size_t ws_size, hipStream_t stream) {
    if (n_in != 25 || ws_size < WS_END) { fprintf(stderr, "kernel_launch: unexpected n_in %d / ws_size %zu (need %zu)\n", n_in, ws_size, (size_t)WS_END); return; }
    static int grid = 0;
    if (grid == 0) {
        (void)hipFuncSetAttribute((const void*)k_ln1, hipFuncAttributeMaxDynamicSharedMemorySize, 20 * 1024 * 4 + 1024);
        if (hipFuncSetAttribute((const void*)mk_fwd, hipFuncAttributeMaxDynamicSharedMemorySize, LDS_BYTES) != hipSuccess) fprintf(stderr, "kernel_launch: hipFuncSetAttribute(mk_fwd, %d) failed\n", LDS_BYTES);
        int dev = 0, cus = 0; (void)hipGetDevice(&dev);
        if (hipDeviceGetAttribute(&cus, hipDeviceAttributeMultiprocessorCount, dev) != hipSuccess || cus <= 0) cus = 256;
        int per_cu = 0; (void)hipOccupancyMaxActiveBlocksPerMultiprocessor(&per_cu, (const void*)mk_fwd, NTHR, LDS_BYTES);
        if (per_cu < 1) fprintf(stderr, "kernel_launch: occupancy query reports %d blocks per CU for mk_fwd\n", per_cu);
        (void)hipGetLastError();
        grid = cus;
    }
    Params p{};
    p.x = (const float*)d_in[0]; p.mem = (const float*)d_in[1]; p.pos = (const int*)d_in[2];
    p.w_in = (const float*)d_in[3]; p.b_in = (const float*)d_in[4]; p.conv_w = (const float*)d_in[5]; p.conv_b = (const float*)d_in[6];
    p.conv_g = (const float*)d_in[7]; p.conv_bb = (const float*)d_in[8]; p.w_mem_kv = (const float*)d_in[9]; p.w_attn_o = (const float*)d_in[10];
    p.w_conv_o = (const float*)d_in[11]; p.w_mem_o = (const float*)d_in[12]; p.w_out = (const float*)d_in[13]; p.ln1_g = (const float*)d_in[14]; p.ln1_b = (const float*)d_in[15];
    p.w_gr = (const float*)d_in[16]; p.b_gr = (const float*)d_in[17]; p.w_er = (const float*)d_in[18]; p.b_er = (const float*)d_in[19];
    p.w_eg = (const float*)d_in[20]; p.w_eu = (const float*)d_in[21]; p.w_ed = (const float*)d_in[22]; p.ln2_g = (const float*)d_in[23]; p.ln2_b = (const float*)d_in[24];
    p.out = (float*)d_out; p.ws = (unsigned char*)d_ws;
    (void)hipMemsetAsync((char*)d_ws + WS_CTL, 0, CTL_BYTES, stream);
#if PROBE_DUP == 12
    (void)hipMemsetAsync((char*)d_ws + 944 * MiB, 0, 64 * MiB, stream);
#endif
    auto mk = [&](int lo, int hi) { Args a{}; a.p = p; a.ph_lo = lo; a.ph_hi = hi; hipLaunchKernelGGL(mk_fwd, dim3(grid), dim3(NTHR), LDS_BYTES, stream, a); };
#if MK_MODE == 3
    mk(0, PH_END);
#elif MK_MODE == 2
    for (int ph = 0; ph < PH_END; ++ph) mk(ph, ph + 1);
#elif MK_MODE == 1
    mk(PH_P0, PH_P0 + 1);
    for (int ch = 0; ch < NCH; ++ch) {
        const int ph0 = PH_CH0 + PH_PER_CH * ch;
        mk(ph0, ph0 + 1);
        k_nattn_dil<<<BC * 12 * 2048 / 4, 256, 0, stream>>>(p);
        k_nattn_mem<<<BC * 4 * 2048 / 4, 256, 0, stream>>>(p, ch);
        k_conv<<<BC * 64, 512, 0, stream>>>(p);
        mk(ph0 + 2, ph0 + 3); mk(ph0 + 3, ph0 + 4); mk(ph0 + 4, ph0 + 5);
    }
    mk(PH_LN1, PH_LN1 + 1); mk(PH_MOE1, PH_MOE1 + 1); mk(PH_MOE2, PH_MOE2 + 1); mk(PH_LN2, PH_LN2 + 1);
#else
    for (int w = 0; w < 8; ++w) k_transpose_w<<<2048, 256, 0, stream>>>(p, w);
    k_small_prep<<<(20 * 1024 + 255) / 256, 256, 0, stream>>>(p);
    k_cvt_bf16<<<2048, 256, 0, stream>>>(p.mem, (bf16_t*)((char*)d_ws + WS_MEMB), (size_t)NB * MEML * 1024 / 8);
    k_cvt_bf16<<<4096, 256, 0, stream>>>(p.x, (bf16_t*)((char*)d_ws + WS_XB), (size_t)T * 1024 / 8);
    k_ngemm_kv<<<dim3(1024 / 64, NB * MEML / 64), 256, 0, stream>>>(p, 0);
    for (int ch = 0; ch < NCH; ++ch) {
        k_ngemm_main<<<dim3(INC / 64, TC / 64), 256, 0, stream>>>(p, ch);
        k_nattn_dil<<<BC * 12 * 2048 / 4, 256, 0, stream>>>(p);
        k_nattn_mem<<<BC * 4 * 2048 / 4, 256, 0, stream>>>(p, ch);
        k_conv<<<BC * 64, 512, 0, stream>>>(p);
        k_combine<<<TC / 4, 256, 0, stream>>>(p);
        for (int br = 0; br < 3; ++br) k_ngemm_merge<<<dim3(1024 / 64, TC / 64), 256, 0, stream>>>(p, br);
        k_ngemm_mix<<<dim3(1024 / 64, TC / 64), 256, 0, stream>>>(p, ch);
    }
    k_ln1<<<256, 512, 20 * 1024 * 4 + 1024, stream>>>(p);
    k_ngemm_moe1<<<dim3(2048 / 64, MPAD / 64), 256, 0, stream>>>(p);
    k_ngemm_moe2<<<dim3(1024 / 64, MPAD / 64), 256, 0, stream>>>(p);
    k_ln2<<<MPAD / 4, 256, 0, stream>>>(p);
#endif
}
```

```cpp
#include <hip/hip_runtime.h>
#include <cstdio>
#include <cstdint>

constexpr int D = 1024, NB = 32, S = 2048, T = NB * S;
constexpr int NCH = 2, BC = NB / NCH, TC = T / NCH;
constexpr int INC = 9216;
constexpr int MEML = 256;
constexpr int NCLS = 24;
constexpr int MPAD = T + NCLS * 256;
constexpr float LN_EPS = 1e-5f;
constexpr float DN_ALPHA = 1.189207115002721f;
constexpr float ATT_SCALE = 0.08838834764831845f;

constexpr int C_Q = 0, C_K = 1536, C_V = 3072, C_GLU = 4608, C_QM = 5632, C_GATE = 6144;

constexpr size_t MiB = 1ull << 20;
constexpr size_t WS_CTL = 0, CTL_BYTES = 1 * MiB;
constexpr size_t WS_WIN = 1 * MiB;
constexpr size_t WS_BIASP = 19 * MiB;
constexpr size_t WS_WRT = 19 * MiB + 64 * 1024;
constexpr size_t WS_WKV = 20 * MiB;
constexpr size_t WS_WA = 22 * MiB, WS_WC = 23 * MiB, WS_WM = 24 * MiB;
constexpr size_t WS_WOUT = 25 * MiB;
constexpr size_t WS_W1 = 27 * MiB;
constexpr size_t WS_W2 = 59 * MiB;
constexpr size_t WS_MEMB = 75 * MiB;
constexpr size_t WS_CH = 91 * MiB;
constexpr size_t SZ_XB = (size_t)TC * 1024 * 2, SZ_QKV1 = (size_t)TC * 1536 * 2, SZ_512 = (size_t)TC * 512 * 2;
constexpr size_t WS_XB = WS_CH;
constexpr size_t WS_QG = WS_XB + (size_t)T * 1024 * 2, WS_KG = WS_QG + SZ_QKV1, WS_VG = WS_KG + SZ_QKV1;
constexpr size_t WS_CGLU = WS_VG + SZ_QKV1, WS_QM = WS_CGLU + SZ_512, WS_OATT = WS_QM + SZ_512, WS_CCONV = WS_OATT + SZ_512, WS_OMT = WS_CCONV + SZ_512;
constexpr size_t WS_GATES = WS_OMT + SZ_512;
constexpr size_t SZ_KM = (size_t)NB * 4 * MEML * 128 * 2;
constexpr size_t WS_KM = WS_GATES + (size_t)TC * 3072 * 2, WS_VM = WS_KM + SZ_KM;
constexpr size_t WS_LSE = WS_VM + SZ_KM;
constexpr size_t WS_MERGED = WS_LSE + 2 * MiB;
constexpr size_t WS_CH_END = WS_MERGED + SZ_XB;
constexpr size_t WS_X1B = WS_CH;
constexpr size_t WS_H = WS_X1B + (size_t)T * 1024 * 2;
constexpr size_t WS_Y2 = WS_H + (size_t)MPAD * 1024 * 2;
constexpr size_t WS_LIST = WS_Y2 + (size_t)MPAD * 1024 * 2;
constexpr size_t WS_WTS = WS_LIST + (size_t)NCLS * T * 4;
constexpr size_t WS_X1B8 = WS_WTS + (size_t)T * 8;
constexpr size_t WS_MOE_END = WS_X1B8 + (size_t)T * 1024;
#ifndef P5_FP8
#define P5_FP8 1
#endif
#ifndef O_FP8
#define O_FP8 1
#endif
#ifndef Y2_FP8
#define Y2_FP8 1
#endif
constexpr float Y8_SCALE = 16.0f;
#ifndef P4_FP8
#define P4_FP8 1
#endif
constexpr float O8_SCALE = 16.0f;
constexpr float M8_SCALE = 16.0f;
constexpr float W8_SCALE = 32.0f, H8_SCALE = 16.0f;
constexpr size_t WS_END = WS_CH_END > WS_MOE_END ? WS_CH_END : WS_MOE_END;
constexpr size_t WS_XB8 = 944 * MiB;
constexpr size_t WS_WG8 = 1008 * MiB;
constexpr float WG8_SCALE = 32.0f;
static_assert(WS_CH_END <= WS_XB8 && WS_WG8 + 9 * MiB <= 1024 * MiB, "fp8 operand buffers");
static_assert(WS_END <= 1024 * MiB, "workspace map exceeds 1 GiB");
constexpr int CW_CNT = 64;

typedef unsigned short bf16_t;
typedef float f32x4 __attribute__((ext_vector_type(4)));
typedef unsigned u32x4 __attribute__((ext_vector_type(4)));
typedef unsigned u32x2 __attribute__((ext_vector_type(2)));

__device__ __forceinline__ float bf2f(bf16_t b) { return __uint_as_float(((unsigned)b) << 16); }
__device__ __forceinline__ float bflo(unsigned w) { return __uint_as_float(w << 16); }
__device__ __forceinline__ float bfhi(unsigned w) { return __uint_as_float(w & 0xffff0000u); }
__device__ __forceinline__ unsigned f2bf(float f) { unsigned u = __float_as_uint(f); return (u + 0x7fffu + ((u >> 16) & 1u)) >> 16; }
typedef float f32x2_t __attribute__((ext_vector_type(2)));
typedef __bf16 bf16x2_t __attribute__((ext_vector_type(2)));
__device__ __forceinline__ unsigned pk2(float lo, float hi) { f32x2_t v = {lo, hi}; bf16x2_t b = __builtin_convertvector(v, bf16x2_t); return __builtin_bit_cast(unsigned, b); }
__device__ __forceinline__ float sigmoidf_(float x) { return __builtin_amdgcn_rcpf(1.0f + __builtin_amdgcn_exp2f(-1.4426950408889634f * x)); }
__device__ __forceinline__ float wave_sum(float v) {
#define DPP_F(x, ctrl) __int_as_float(__builtin_amdgcn_update_dpp(0, __float_as_int(x), ctrl, 0xf, 0xf, true))
    v += DPP_F(v, 0xB1);
    v += DPP_F(v, 0x4E);
    v += DPP_F(v, 0x141);
    v += DPP_F(v, 0x140);
#undef DPP_F
    { const auto r = __builtin_amdgcn_permlane16_swap(__float_as_uint(v), __float_as_uint(v), false, false); v = __uint_as_float(r[0]) + __uint_as_float(r[1]); }
    { const auto r = __builtin_amdgcn_permlane32_swap(__float_as_uint(v), __float_as_uint(v), false, false); v = __uint_as_float(r[0]) + __uint_as_float(r[1]); }
    return v;
}
__device__ __forceinline__ float wave_max(float v) {
#pragma unroll
    for (int o = 1; o < 64; o <<= 1) v = fmaxf(v, __shfl_xor(v, o));
    return v;
}
__device__ __forceinline__ unsigned pk4_fp8(float a, float b, float c, float d) { unsigned w = 0; w = __builtin_amdgcn_cvt_pk_fp8_f32(a, b, w, false); w = __builtin_amdgcn_cvt_pk_fp8_f32(c, d, w, true); return w; }
__device__ __forceinline__ unsigned pk4_fp8s(float a, float b, float c, float d) { return pk4_fp8(__builtin_amdgcn_fmed3f(a, -448.f, 448.f), __builtin_amdgcn_fmed3f(b, -448.f, 448.f), __builtin_amdgcn_fmed3f(c, -448.f, 448.f), __builtin_amdgcn_fmed3f(d, -448.f, 448.f)); }
__device__ __forceinline__ unsigned pk4_u8(float a, float b, float c, float d) {
    const unsigned ua = (unsigned)fmaxf(__builtin_rintf(a * 255.f), 1.f), ub = (unsigned)fmaxf(__builtin_rintf(b * 255.f), 1.f), uc = (unsigned)fmaxf(__builtin_rintf(c * 255.f), 1.f), ud = (unsigned)fmaxf(__builtin_rintf(d * 255.f), 1.f);
    return ua | (ub << 8) | (uc << 16) | (ud << 24); }
__device__ __forceinline__ float sig255(float x) { const float e = __builtin_amdgcn_exp2f(-1.4426950408889634f * x); return fmaxf(__builtin_rintf(__builtin_amdgcn_rcpf(__builtin_fmaf(e, 1.0f / 255.0f, 1.0f / 255.0f))), 1.0f); }
__device__ __forceinline__ unsigned pk4_sig_u8(float a, float b, float c, float d) { unsigned w = 0u;
    w = __builtin_amdgcn_cvt_pk_u8_f32(sig255(a), 0, w); w = __builtin_amdgcn_cvt_pk_u8_f32(sig255(b), 1, w); w = __builtin_amdgcn_cvt_pk_u8_f32(sig255(c), 2, w); w = __builtin_amdgcn_cvt_pk_u8_f32(sig255(d), 3, w); return w; }
__device__ __forceinline__ f32x4 u8x4_raw(unsigned w) { return (f32x4){(float)(w & 255u), (float)((w >> 8) & 255u), (float)((w >> 16) & 255u), (float)(w >> 24)}; }
__device__ __forceinline__ f32x4 u8x4_to_f32(unsigned w) { return (f32x4){(float)(w & 255u), (float)((w >> 8) & 255u), (float)((w >> 16) & 255u), (float)(w >> 24)} * (1.0f / 255.0f); }
#ifndef P1_FP6
#define P1_FP6 0
#endif
typedef float v16f_t __attribute__((ext_vector_type(16)));
typedef unsigned v6u_t __attribute__((ext_vector_type(6)));
__device__ __forceinline__ v6u_t pack32_fp6(const float (&v)[32]) {
    v16f_t a, b;
#pragma unroll
    for (int i = 0; i < 16; ++i) { a[i] = fminf(fmaxf(v[i], -7.5f), 7.5f); b[i] = fminf(fmaxf(v[16 + i], -7.5f), 7.5f); }
    return __builtin_amdgcn_cvt_scalef32_2xpk16_fp6_f32(a, b, 1.0f);
}
__device__ __forceinline__ int opaque_tid(int wave_s) { unsigned z = 0u; asm volatile("" : "+v"(z)); const int l = (int)__builtin_amdgcn_mbcnt_hi(~0u, __builtin_amdgcn_mbcnt_lo(~0u, z)); return (wave_s << 6) | l; }
__device__ __forceinline__ void rope_cs(float pos, int j, float& c, float& s) {
    const float invrev = __builtin_amdgcn_exp2f(-(float)j * (13.287712379549449f / 64.0f)) * 0.15915494309189535f;
    float rev = pos * invrev; rev = __builtin_amdgcn_fractf(rev);
    s = __builtin_amdgcn_sinf(rev); c = __builtin_amdgcn_cosf(rev);
}
__device__ __forceinline__ int rowperm(int g, int s) { return g == 0 ? s : (g == 1 ? ((s & 3) * 512 + (s >> 2)) : ((s & 15) * 128 + (s >> 4))); }
__host__ __device__ __forceinline__ int win_logical(int n) {
    if (n < C_V) { const int sec = n / 1536, r = n % 1536, gh = r / 128, p = r % 128, G = p >> 3, nn = (p >> 2) & 1, e = p & 3; return sec * 1536 + gh * 128 + 64 * nn + 4 * G + e; }
    if (n < C_GLU) return n;
    if (n < C_QM) { const int cc = n - C_GLU, G = cc >> 3, nn = (cc >> 2) & 1, e = cc & 3; return C_GLU + nn * 512 + 4 * G + e; }
    return n;
}

struct Params {
    const float *x, *mem; const int* pos;
    const float *w_in, *b_in, *conv_w, *conv_b, *conv_g, *conv_bb, *w_mem_kv, *w_attn_o, *w_conv_o, *w_mem_o, *w_out, *ln1_g, *ln1_b;
    const float *w_gr, *b_gr, *w_er, *b_er, *w_eg, *w_eu, *w_ed, *ln2_g, *ln2_b;
    float* out; unsigned char* ws;
};
#define WSP(T_, off) ((T_*)(p.ws + (off)))

__global__ void k_cvt_bf16(const float* __restrict__ src, bf16_t* __restrict__ dst, size_t n8) {
    for (size_t i = (size_t)blockIdx.x * blockDim.x + threadIdx.x; i < n8; i += (size_t)gridDim.x * blockDim.x) {
        const f32x4 a = *(const f32x4*)(src + i * 8), b = *(const f32x4*)(src + i * 8 + 4);
        u32x4 o; o.x = pk2(a.x, a.y); o.y = pk2(a.z, a.w); o.z = pk2(b.x, b.y); o.w = pk2(b.z, b.w);
        *(u32x4*)(dst + i * 8) = o;
    }
}
enum { TW_IN = 0, TW_KV, TW_A, TW_C, TW_M, TW_OUT, TW_W1, TW_W2 };
__device__ __forceinline__ void transpose_w_dev(const Params& p, int which, size_t gtid, size_t gstride) {
    int K, N, ldd; bf16_t* dst;
    switch (which) {
        case TW_IN: K = 1024; N = INC; ldd = 1024; dst = WSP(bf16_t, WS_WIN); break;
        case TW_KV: K = 1024; N = 1024; ldd = 1024; dst = WSP(bf16_t, WS_WKV); break;
        case TW_A: K = 512; N = 1024; ldd = 512; dst = WSP(bf16_t, WS_WA); break;
        case TW_C: K = 512; N = 1024; ldd = 512; dst = WSP(bf16_t, WS_WC); break;
        case TW_M: K = 512; N = 1024; ldd = 512; dst = WSP(bf16_t, WS_WM); break;
        case TW_OUT: K = 1024; N = 1024; ldd = 1024; dst = WSP(bf16_t, WS_WOUT); break;
        case TW_W1: K = 1024; N = 16 * 1024; ldd = 1024; dst = WSP(bf16_t, WS_W1); break;
        default: K = 512; N = 16 * 1024; ldd = 8192; dst = WSP(bf16_t, WS_W2); break;
    }
    const size_t total = (size_t)N * (K / 8);
    for (size_t i = gtid; i < total; i += gstride) {
        const int n = (int)(i % N), k0 = (int)(i / N) * 8;
        float v[8];
#pragma unroll
        for (int j = 0; j < 8; ++j) {
            const int k = k0 + j; float s;
            switch (which) {
                case TW_IN: s = p.w_in[(size_t)k * INC + win_logical(n)]; break;
                case TW_KV: s = p.w_mem_kv[(size_t)k * 1024 + n]; break;
                case TW_A: s = p.w_attn_o[(size_t)k * 1024 + n]; break;
                case TW_C: s = p.w_conv_o[(size_t)k * 1024 + n]; break;
                case TW_M: s = p.w_mem_o[(size_t)k * 1024 + n]; break;
                case TW_OUT: s = p.w_out[(size_t)k * 1024 + n]; break;
                case TW_W1: { const int e = n >> 10, c = n & 1023, G = c >> 3, nn = (c >> 2) & 1, ee = c & 3, jj = 4 * G + ee;
                              s = (nn ? p.w_eu : p.w_eg)[((size_t)e * 1024 + k) * 512 + jj]; } break;
                default: { const int e = n >> 10, c = n & 1023; s = p.w_ed[((size_t)e * 512 + k) * 1024 + c]; } break;
            }
            v[j] = s;
        }
        u32x4 o; o.x = pk2(v[0], v[1]); o.y = pk2(v[2], v[3]); o.z = pk2(v[4], v[5]); o.w = pk2(v[6], v[7]);
        size_t doff;
        if (which == TW_W2) { const int e = n >> 10, c = n & 1023; doff = (size_t)c * 8192 + e * 512 + k0; }
        else doff = (size_t)n * ldd + k0;
        *(u32x4*)(dst + doff) = o;
    }
}
__global__ void k_transpose_w(Params p, int which) { transpose_w_dev(p, which, (size_t)blockIdx.x * blockDim.x + threadIdx.x, (size_t)gridDim.x * blockDim.x); }
__device__ __forceinline__ void small_prep_dev(const Params& p, size_t gtid, size_t gstride) {
    for (size_t ii = gtid; ii < 20 * 1024; ii += gstride) { const int i = (int)ii;
        if (i < INC) WSP(float, WS_BIASP)[i] = p.b_in[win_logical(i)];
        const int e = i >> 10, k = i & 1023;
        WSP(float, WS_WRT)[i] = e < 4 ? p.w_gr[k * 4 + e] : p.w_er[((size_t)((e - 4) >> 2) * 1024 + k) * 4 + ((e - 4) & 3)]; }
}
__global__ void k_small_prep(Params p) { small_prep_dev(p, (size_t)blockIdx.x * blockDim.x + threadIdx.x, (size_t)gridDim.x * blockDim.x); }

struct EpiMain {
    const float* biasp; const int* pos; bf16_t *QG, *CGLU, *QM, *GATES; int tok0;
    static __device__ __forceinline__ void rope_freqs(int c0, float (&invrev)[4]) {
        const int j0 = ((c0 & 127) >> 3) * 4;
#pragma unroll
        for (int e = 0; e < 4; ++e) invrev[e] = __builtin_amdgcn_exp2f(-(float)(j0 + e) * (13.287712379549449f / 64.0f)) * 0.15915494309189535f;
    }
    template <int S> __device__ __forceinline__ void finish_s(int rl, int c0, float (&v)[8], float fpos, const float (&invrev)[4]) const {
        const int bl = rl >> 11, s = rl & 2047;
        if constexpr (S <= 1) {
            const int tcol = __builtin_amdgcn_readfirstlane(c0 & ~255);
            const int sec = tcol / 1536, r = c0 - sec * 1536, gh = r >> 7, pcol = r & 127, g = gh >> 2;
            if constexpr (S == 0) {
#pragma unroll
                for (int e = 0; e < 4; ++e) { const float rev = __builtin_amdgcn_fractf(fpos * invrev[e]); const float sn = __builtin_amdgcn_sinf(rev), c = __builtin_amdgcn_cosf(rev);
                    const float t1 = v[e], t2 = v[4 + e]; v[e] = t1 * c - t2 * sn; v[4 + e] = t2 * c + t1 * sn; }
            }
            bf16_t* base = QG + (size_t)sec * (SZ_QKV1 / 2);
            u32x4 o; o.x = pk2(v[0], v[1]); o.y = pk2(v[2], v[3]); o.z = pk2(v[4], v[5]); o.w = pk2(v[6], v[7]);
            *(u32x4*)(base + ((size_t)(bl * 12 + gh) * 2048 + rowperm(g, s)) * 128 + pcol) = o;
        } else if constexpr (S == 2) {
            const int j0 = (c0 - C_GLU) >> 1;
            u32x2 o; o.x = pk2(v[0] * sigmoidf_(v[4]), v[1] * sigmoidf_(v[5])); o.y = pk2(v[2] * sigmoidf_(v[6]), v[3] * sigmoidf_(v[7]));
            *(u32x2*)(CGLU + (size_t)rl * 512 + j0) = o;
        } else {
            const int cc = c0 - C_QM, h = cc >> 7, pcol = cc & 127;
            u32x4 o; o.x = pk2(v[0], v[1]); o.y = pk2(v[2], v[3]); o.z = pk2(v[4], v[5]); o.w = pk2(v[6], v[7]);
            *(u32x4*)(QM + ((size_t)(bl * 4 + h) * 2048 + s) * 128 + pcol) = o;
        }
    }
    __device__ __forceinline__ void finish(int rl, int c0, float (&v)[8], float fpos, const float (&invrev)[4]) const {
        const int bl = rl >> 11, s = rl & 2047;
        const int tcol = __builtin_amdgcn_readfirstlane(c0 & ~255);
        if (tcol < C_GLU) {
            const int sec = tcol / 1536, r = c0 - sec * 1536, gh = r >> 7, pcol = r & 127, g = gh >> 2;
            if (sec < 2) {
#pragma unroll
                for (int e = 0; e < 4; ++e) { const float rev = __builtin_amdgcn_fractf(fpos * invrev[e]); const float sn = __builtin_amdgcn_sinf(rev), c = __builtin_amdgcn_cosf(rev);
                    const float t1 = v[e], t2 = v[4 + e]; v[e] = t1 * c - t2 * sn; v[4 + e] = t2 * c + t1 * sn; }
            }
            bf16_t* base = QG + (size_t)sec * (SZ_QKV1 / 2);
            u32x4 o; o.x = pk2(v[0], v[1]); o.y = pk2(v[2], v[3]); o.z = pk2(v[4], v[5]); o.w = pk2(v[6], v[7]);
            *(u32x4*)(base + ((size_t)(bl * 12 + gh) * 2048 + rowperm(g, s)) * 128 + pcol) = o;
        } else if (tcol < C_QM) {
            const int j0 = (c0 - C_GLU) >> 1;
            u32x2 o; o.x = pk2(v[0] * sigmoidf_(v[4]), v[1] * sigmoidf_(v[5])); o.y = pk2(v[2] * sigmoidf_(v[6]), v[3] * sigmoidf_(v[7]));
            *(u32x2*)(CGLU + (size_t)rl * 512 + j0) = o;
        } else if (tcol < C_GATE) {
            const int cc = c0 - C_QM, h = cc >> 7, pcol = cc & 127;
            u32x4 o; o.x = pk2(v[0], v[1]); o.y = pk2(v[2], v[3]); o.z = pk2(v[4], v[5]); o.w = pk2(v[6], v[7]);
            *(u32x4*)(QM + ((size_t)(bl * 4 + h) * 2048 + s) * 128 + pcol) = o;
        } else {
            const int cc = c0 - C_GATE;
            u32x2 o; o.x = pk4_sig_u8(v[0], v[1], v[2], v[3]); o.y = pk4_sig_u8(v[4], v[5], v[6], v[7]);
            *(u32x2*)((unsigned char*)GATES + (size_t)rl * 3072 + cc) = o;
        }
    }
    __device__ __forceinline__ void operator()(int rl, int c0, float (&v)[8]) const {
        const f32x4 b0 = *(const f32x4*)(biasp + c0), b1 = *(const f32x4*)(biasp + c0 + 4);
        v[0] += b0.x; v[1] += b0.y; v[2] += b0.z; v[3] += b0.w; v[4] += b1.x; v[5] += b1.y; v[6] += b1.z; v[7] += b1.w;
        float invrev[4]; rope_freqs(c0, invrev);
        finish(rl, c0, v, c0 < C_V ? (float)pos[tok0 + rl] : 0.f, invrev);
    }
};
struct EpiKV {
    bf16_t *KM;
    __device__ __forceinline__ void operator()(int row, int c0, float (&v)[8]) const {
        const int bl = row >> 8, m = row & 255, isv = c0 >> 9, cc = c0 & 511, h = cc >> 7, pcol = cc & 127;
        u32x4 o; o.x = pk2(v[0], v[1]); o.y = pk2(v[2], v[3]); o.z = pk2(v[4], v[5]); o.w = pk2(v[6], v[7]);
        *(u32x4*)(KM + (size_t)isv * (SZ_KM / 2) + ((size_t)(bl * 4 + h) * 256 + m) * 128 + pcol) = o;
    }
};
struct EpiMerge {
    const bf16_t* GATES; bf16_t* MERGED; int br;
    __device__ __forceinline__ void operator()(int rl, int c0, float (&v)[8]) const {
        const u32x2 g = *(const u32x2*)((const unsigned char*)GATES + (size_t)rl * 3072 + br * 1024 + c0);
        const f32x4 g0 = u8x4_to_f32(g.x), g1 = u8x4_to_f32(g.y);
        float r[8] = {g0.x * v[0], g0.y * v[1], g0.z * v[2], g0.w * v[3], g1.x * v[4], g1.y * v[5], g1.z * v[6], g1.w * v[7]};
        bf16_t* mp = MERGED + (size_t)rl * 1024 + c0;
        if (br > 0) { const u32x4 m = *(const u32x4*)mp; r[0] += bflo(m.x); r[1] += bfhi(m.x); r[2] += bflo(m.y); r[3] += bfhi(m.y); r[4] += bflo(m.z); r[5] += bfhi(m.z); r[6] += bflo(m.w); r[7] += bfhi(m.w); }
        u32x4 o; o.x = pk2(r[0], r[1]); o.y = pk2(r[2], r[3]); o.z = pk2(r[4], r[5]); o.w = pk2(r[6], r[7]);
        *(u32x4*)mp = o;
    }
};
struct EpiMix {
    bf16_t* MIX; int tok0;
    __device__ __forceinline__ void operator()(int rl, int c0, float (&v)[8]) const {
        u32x4 o; o.x = pk2(v[0], v[1]); o.y = pk2(v[2], v[3]); o.z = pk2(v[4], v[5]); o.w = pk2(v[6], v[7]);
        *(u32x4*)(MIX + (size_t)(tok0 + rl) * 1024 + c0) = o;
    }
};
struct ClassTab { int cnt[NCLS], rowbase[NCLS + 1]; };
__device__ __forceinline__ void class_tab_fill(const unsigned* cntw, ClassTab* t) {
    int acc = 0;
    for (int c = 0; c < NCLS; ++c) { const int n = (int)cntw[c]; t->cnt[c] = n; t->rowbase[c] = acc; acc += ((n + 255) >> 8) << 8; }
    t->rowbase[NCLS] = acc;
}
__device__ __forceinline__ void class_experts(int cls, int& e_lo, int& e_hi) {
    const int g = cls / 6, pi = cls - g * 6;
    const int lo = pi < 3 ? 0 : (pi < 5 ? 1 : 2), hi = pi < 3 ? pi + 1 : (pi < 5 ? pi - 1 : 3);
    e_lo = g * 4 + lo; e_hi = g * 4 + hi;
}
struct EpiMoe1 {
    const int* list; const float* wts; bf16_t* H; int cls, cnt, rowbase;
    __device__ __forceinline__ void operator()(int prow, int c0, float (&v)[8]) const {
        int i = prow - rowbase; if (i >= cnt) i = cnt - 1;
        const int tok = list[i]; const int hi = c0 >> 10; const float w = wts[(size_t)tok * 2 + hi];
        const int j0 = hi * 512 + ((c0 & 1023) >> 1);
        float r[4];
#pragma unroll
        for (int e = 0; e < 4; ++e) { const float gt = v[e]; r[e] = gt * sigmoidf_(gt) * v[4 + e] * w; }
        u32x2 o; o.x = pk2(r[0], r[1]); o.y = pk2(r[2], r[3]);
        *(u32x2*)(H + (size_t)prow * 1024 + j0) = o;
    }
};
struct EpiMoe2 {
    bf16_t* Y2;
    __device__ __forceinline__ void operator()(int prow, int c0, float (&v)[8]) const {
        u32x4 o; o.x = pk2(v[0], v[1]); o.y = pk2(v[2], v[3]); o.z = pk2(v[4], v[5]); o.w = pk2(v[6], v[7]);
        *(u32x4*)(Y2 + (size_t)prow * 1024 + c0) = o;
    }
};

struct RowsPlain { const bf16_t* base; int ld; __device__ __forceinline__ const bf16_t* operator()(int r) const { return base + (size_t)r * ld; } };
template <class AF, class BF, class EF>
__device__ __forceinline__ void ngemm_tile(int row0, int col0, int K, const AF& af, const BF& bf, const EF& ef, int bkseg, long bjump) {
    __shared__ float As[64][33], Bs[64][33];
    const int tid = threadIdx.x, ty = tid >> 3, tx = tid & 7;
    float acc[2][8];
#pragma unroll
    for (int i = 0; i < 2; ++i)
#pragma unroll
        for (int j = 0; j < 8; ++j) acc[i][j] = 0.f;
    const int lr = tid >> 2, lk = (tid & 3) * 8;
    const bf16_t* ap = af(row0 + lr); const bf16_t* bp = bf(col0 + lr);
    for (int k0 = 0; k0 < K; k0 += 32) {
        const u32x4 a = *(const u32x4*)(ap + k0 + lk);
        const long bo = (long)k0 + lk + (long)(k0 / bkseg) * bjump;
        const u32x4 b = *(const u32x4*)(bp + bo);
        __syncthreads();
        As[lr][lk + 0] = bflo(a.x); As[lr][lk + 1] = bfhi(a.x); As[lr][lk + 2] = bflo(a.y); As[lr][lk + 3] = bfhi(a.y);
        As[lr][lk + 4] = bflo(a.z); As[lr][lk + 5] = bfhi(a.z); As[lr][lk + 6] = bflo(a.w); As[lr][lk + 7] = bfhi(a.w);
        Bs[lr][lk + 0] = bflo(b.x); Bs[lr][lk + 1] = bfhi(b.x); Bs[lr][lk + 2] = bflo(b.y); Bs[lr][lk + 3] = bfhi(b.y);
        Bs[lr][lk + 4] = bflo(b.z); Bs[lr][lk + 5] = bfhi(b.z); Bs[lr][lk + 6] = bflo(b.w); Bs[lr][lk + 7] = bfhi(b.w);
        __syncthreads();
#pragma unroll 8
        for (int kk = 0; kk < 32; ++kk) {
            const float a0 = As[2 * ty][kk], a1 = As[2 * ty + 1][kk];
#pragma unroll
            for (int j = 0; j < 8; ++j) { const float bv = Bs[8 * tx + j][kk]; acc[0][j] += a0 * bv; acc[1][j] += a1 * bv; }
        }
    }
    ef(row0 + 2 * ty, col0 + 8 * tx, acc[0]);
    ef(row0 + 2 * ty + 1, col0 + 8 * tx, acc[1]);
}
__global__ void __launch_bounds__(256) k_ngemm_main(Params p, int ch) {
    const int tok0 = ch * TC;
    EpiMain E{WSP(float, WS_BIASP), p.pos, WSP(bf16_t, WS_QG), WSP(bf16_t, WS_CGLU), WSP(bf16_t, WS_QM), WSP(bf16_t, WS_GATES), tok0};
    RowsPlain A{WSP(bf16_t, WS_XB) + (size_t)ch * TC * 1024, 1024}, Bm{WSP(bf16_t, WS_WIN), 1024};
    ngemm_tile(blockIdx.y * 64, blockIdx.x * 64, 1024, A, Bm, E, 1 << 30, 0);
}
__global__ void __launch_bounds__(256) k_ngemm_kv(Params p, int ch) {
    EpiKV E{WSP(bf16_t, WS_KM)};
    RowsPlain A{WSP(bf16_t, WS_MEMB), 1024}, Bm{WSP(bf16_t, WS_WKV), 1024};
    ngemm_tile(blockIdx.y * 64, blockIdx.x * 64, 1024, A, Bm, E, 1 << 30, 0);
}
__global__ void __launch_bounds__(256) k_ngemm_merge(Params p, int br) {
    EpiMerge E{WSP(bf16_t, WS_GATES), WSP(bf16_t, WS_MERGED), br};
    RowsPlain A{WSP(bf16_t, WS_OATT + (size_t)br * SZ_512), 512};
    RowsPlain Bm{WSP(bf16_t, WS_WA + (size_t)br * MiB), 512};
    ngemm_tile(blockIdx.y * 64, blockIdx.x * 64, 512, A, Bm, E, 1 << 30, 0);
}
__global__ void __launch_bounds__(256) k_ngemm_mix(Params p, int ch) {
    EpiMix E{(bf16_t*)p.out, ch * TC};
    RowsPlain A{WSP(bf16_t, WS_MERGED), 1024}, Bm{WSP(bf16_t, WS_WOUT), 1024};
    ngemm_tile(blockIdx.y * 64, blockIdx.x * 64, 1024, A, Bm, E, 1 << 30, 0);
}
struct RowsGather { const bf16_t* base; const int* list; int cnt, rowbase; __device__ __forceinline__ const bf16_t* operator()(int prow) const { int i = prow - rowbase; if (i >= cnt) i = cnt - 1; return base + (size_t)list[i] * 1024; } };
__device__ __forceinline__ int find_class(const ClassTab* t, int prow) { int c = 0;
    for (int i = 1; i < NCLS; ++i) if (prow >= t->rowbase[i]) c = i;
    return c; }
__global__ void __launch_bounds__(256) k_ngemm_moe1(Params p) {
    __shared__ ClassTab tabs; if (threadIdx.x == 0) class_tab_fill(WSP(unsigned, WS_CTL) + CW_CNT, &tabs); __syncthreads(); const ClassTab* tab = &tabs;
    const int row0 = blockIdx.y * 64; if (row0 >= tab->rowbase[NCLS]) return;
    const int cls = find_class(tab, row0); if (tab->cnt[cls] == 0) return;
    int e_lo, e_hi; class_experts(cls, e_lo, e_hi);
    const int col0 = blockIdx.x * 64, hi = col0 >> 10;
    const int* list = WSP(int, WS_LIST) + (size_t)cls * T;
    RowsGather A{WSP(bf16_t, WS_X1B), list, tab->cnt[cls], tab->rowbase[cls]};
    RowsPlain Bm{WSP(bf16_t, WS_W1) + ((size_t)(hi ? e_hi : e_lo) * 1024 - (size_t)hi * 1024) * 1024, 1024};
    EpiMoe1 E{list, WSP(float, WS_WTS), WSP(bf16_t, WS_H), cls, tab->cnt[cls], tab->rowbase[cls]};
    ngemm_tile(row0, col0, 1024, A, Bm, E, 1 << 30, 0);
}
__global__ void __launch_bounds__(256) k_ngemm_moe2(Params p) {
    __shared__ ClassTab tabs; if (threadIdx.x == 0) class_tab_fill(WSP(unsigned, WS_CTL) + CW_CNT, &tabs); __syncthreads(); const ClassTab* tab = &tabs;
    const int row0 = blockIdx.y * 64; if (row0 >= tab->rowbase[NCLS]) return;
    const int cls = find_class(tab, row0); if (tab->cnt[cls] == 0) return;
    int e_lo, e_hi; class_experts(cls, e_lo, e_hi);
    RowsPlain A{WSP(bf16_t, WS_H), 1024};
    RowsPlain Bm{WSP(bf16_t, WS_W2) + (size_t)e_lo * 512, 8192};
    EpiMoe2 E{WSP(bf16_t, WS_Y2)};
    ngemm_tile(row0, blockIdx.x * 64, 1024, A, Bm, E, 512, (long)(e_hi - e_lo - 1) * 512);
}

__device__ __forceinline__ void nattn_row(const bf16_t* qp, const bf16_t* kbase, const bf16_t* vbase, int nkeys, bf16_t* op, float* lsep, int lane) {
    const unsigned qw = *(const unsigned*)(qp + 2 * lane); const float q0 = bflo(qw), q1 = bfhi(qw);
    float sc[4] = {-INFINITY, -INFINITY, -INFINITY, -INFINITY};
#pragma unroll
    for (int kb = 0; kb < 4; ++kb) {
        for (int kk = 0; kk < 64; ++kk) { const int k = kb * 64 + kk; if (k >= nkeys) break;
            const unsigned kw = *(const unsigned*)(kbase + (size_t)k * 128 + 2 * lane);
            const float s = wave_sum(q0 * bflo(kw) + q1 * bfhi(kw)) * ATT_SCALE;
            if (lane == kk) sc[kb] = s; }
    }
    const float m = wave_max(fmaxf(fmaxf(sc[0], sc[1]), fmaxf(sc[2], sc[3])));
    float pr[4]; float ps = 0.f;
#pragma unroll
    for (int kb = 0; kb < 4; ++kb) { pr[kb] = __expf(sc[kb] - m); ps += pr[kb]; }
    const float l = wave_sum(ps);
    float a0 = 0.f, a1 = 0.f;
#pragma unroll
    for (int kb = 0; kb < 4; ++kb) {
        for (int kk = 0; kk < 64; ++kk) { const int k = kb * 64 + kk; if (k >= nkeys) break;
            const float pk = __shfl(pr[kb], kk);
            const unsigned vw = *(const unsigned*)(vbase + (size_t)k * 128 + 2 * lane);
            a0 += pk * bflo(vw); a1 += pk * bfhi(vw); }
    }
    const float inv = 1.0f / l;
    *(unsigned*)(op + 2 * lane) = pk2(a0 * inv, a1 * inv);
    if (lsep && lane == 0) *lsep = m + __logf(l);
}
__global__ void __launch_bounds__(256) k_nattn_dil(Params p) {
    const int lane = threadIdx.x & 63; const size_t w = (size_t)blockIdx.x * 4 + (threadIdx.x >> 6);
    if (w >= (size_t)BC * 12 * 2048) return;
    const int row = (int)(w & 2047); const int bgh = (int)(w >> 11); const int g = (bgh % 12) >> 2;
    const int seglen = 2048 >> (2 * g); const int pin = row & (seglen - 1); const int nk = pin + 1 < 129 ? pin + 1 : 129;
    bf16_t* Q = WSP(bf16_t, WS_QG) + ((size_t)bgh * 2048 + row) * 128;
    const bf16_t* K = WSP(bf16_t, WS_KG) + ((size_t)bgh * 2048 + row - nk + 1) * 128;
    const bf16_t* V = WSP(bf16_t, WS_VG) + ((size_t)bgh * 2048 + row - nk + 1) * 128;
    nattn_row(Q, K, V, nk, Q, WSP(float, WS_LSE) + (size_t)bgh * 2048 + row, lane);
}
__global__ void __launch_bounds__(256) k_nattn_mem(Params p, int ch) {
    const int lane = threadIdx.x & 63; const size_t w = (size_t)blockIdx.x * 4 + (threadIdx.x >> 6);
    if (w >= (size_t)BC * 4 * 2048) return;
    const int s = (int)(w & 2047); const int bh = (int)(w >> 11); const int bl = bh >> 2, h = bh & 3;
    const bf16_t* Q = WSP(bf16_t, WS_QM) + ((size_t)bh * 2048 + s) * 128;
    const bf16_t* K = WSP(bf16_t, WS_KM) + (size_t)(ch * BC * 4 + bh) * 256 * 128;
    const bf16_t* V = WSP(bf16_t, WS_VM) + (size_t)(ch * BC * 4 + bh) * 256 * 128;
    nattn_row(Q, K, V, 256, WSP(bf16_t, WS_OMT) + ((size_t)(bl * 2048 + s)) * 512 + h * 128, nullptr, lane);
}

__device__ __forceinline__ void combine_token(const Params& p, int rl, int lane) {
    const int bl = rl >> 11, s = rl & 2047, h = lane >> 4, d0 = (lane & 15) * 8;
    float ls[3]; u32x4 o[3];
#pragma unroll
    for (int g = 0; g < 3; ++g) { const size_t r = (size_t)(bl * 12 + g * 4 + h) * 2048 + rowperm(g, s);
        ls[g] = WSP(float, WS_LSE)[r]; o[g] = *(const u32x4*)(WSP(bf16_t, WS_QG) + r * 128 + d0); }
    const float m = fmaxf(ls[0], fmaxf(ls[1], ls[2]));
    float w0 = __expf(ls[0] - m), w1 = __expf(ls[1] - m), w2 = __expf(ls[2] - m); const float inv = 1.0f / (w0 + w1 + w2); w0 *= inv; w1 *= inv; w2 *= inv;
    u32x4 r;
    r.x = pk2(w0 * bflo(o[0].x) + w1 * bflo(o[1].x) + w2 * bflo(o[2].x), w0 * bfhi(o[0].x) + w1 * bfhi(o[1].x) + w2 * bfhi(o[2].x));
    r.y = pk2(w0 * bflo(o[0].y) + w1 * bflo(o[1].y) + w2 * bflo(o[2].y), w0 * bfhi(o[0].y) + w1 * bfhi(o[1].y) + w2 * bfhi(o[2].y));
    r.z = pk2(w0 * bflo(o[0].z) + w1 * bflo(o[1].z) + w2 * bflo(o[2].z), w0 * bfhi(o[0].z) + w1 * bfhi(o[1].z) + w2 * bfhi(o[2].z));
    r.w = pk2(w0 * bflo(o[0].w) + w1 * bflo(o[1].w) + w2 * bflo(o[2].w), w0 * bfhi(o[0].w) + w1 * bfhi(o[1].w) + w2 * bfhi(o[2].w));
#if P4_FP8
    u32x2 r8; r8.x = pk4_fp8(O8_SCALE * bflo(r.x), O8_SCALE * bfhi(r.x), O8_SCALE * bflo(r.y), O8_SCALE * bfhi(r.y)); r8.y = pk4_fp8(O8_SCALE * bflo(r.z), O8_SCALE * bfhi(r.z), O8_SCALE * bflo(r.w), O8_SCALE * bfhi(r.w));
    *(u32x2*)(p.ws + WS_OATT + (size_t)rl * 512 + h * 128 + d0) = r8;
#else
    *(u32x4*)(WSP(bf16_t, WS_OATT) + (size_t)rl * 512 + h * 128 + d0) = r;
#endif
}
__device__ __forceinline__ void combine_token2(const Params& p, int rl0, int rl1, int lane) {
    const int h = lane >> 4, d0 = (lane & 15) * 8;
#if O_FP8 && P4_FP8
    float ls[2][3]; u32x2 o8[2][3];
#pragma unroll
    for (int t = 0; t < 2; ++t) { const int rl = t ? rl1 : rl0; const int bl = rl >> 11, s = rl & 2047;
#pragma unroll
        for (int g = 0; g < 3; ++g) { const size_t r = (size_t)(bl * 12 + g * 4 + h) * 2048 + rowperm(g, s);
            ls[t][g] = WSP(float, WS_LSE)[r]; o8[t][g] = *(const u32x2*)(p.ws + WS_QG + r * 256 + d0); } }
#pragma unroll
    for (int t = 0; t < 2; ++t) { const int rl = t ? rl1 : rl0;
        const float m = fmaxf(ls[t][0], fmaxf(ls[t][1], ls[t][2]));
        float w0 = __expf(ls[t][0] - m), w1 = __expf(ls[t][1] - m), w2 = __expf(ls[t][2] - m); const float inv = 1.0f / (w0 + w1 + w2); w0 *= inv; w1 *= inv; w2 *= inv;
        float f[8] = {0.f, 0.f, 0.f, 0.f, 0.f, 0.f, 0.f, 0.f};
#pragma unroll
        for (int g = 0; g < 3; ++g) { const float wg = g == 0 ? w0 : (g == 1 ? w1 : w2);
            const auto a0 = __builtin_amdgcn_cvt_pk_f32_fp8(o8[t][g].x, false), a1 = __builtin_amdgcn_cvt_pk_f32_fp8(o8[t][g].x, true), a2 = __builtin_amdgcn_cvt_pk_f32_fp8(o8[t][g].y, false), a3 = __builtin_amdgcn_cvt_pk_f32_fp8(o8[t][g].y, true);
            f[0] += wg * a0[0]; f[1] += wg * a0[1]; f[2] += wg * a1[0]; f[3] += wg * a1[1]; f[4] += wg * a2[0]; f[5] += wg * a2[1]; f[6] += wg * a3[0]; f[7] += wg * a3[1]; }
        u32x2 r8; r8.x = pk4_fp8(f[0], f[1], f[2], f[3]); r8.y = pk4_fp8(f[4], f[5], f[6], f[7]);
        *(u32x2*)(p.ws + WS_OATT + (size_t)rl * 512 + h * 128 + d0) = r8;
    }
#else
    float ls[2][3]; u32x4 o[2][3];
#pragma unroll
    for (int t = 0; t < 2; ++t) { const int rl = t ? rl1 : rl0; const int bl = rl >> 11, s = rl & 2047;
#pragma unroll
        for (int g = 0; g < 3; ++g) { const size_t r = (size_t)(bl * 12 + g * 4 + h) * 2048 + rowperm(g, s);
            ls[t][g] = WSP(float, WS_LSE)[r]; o[t][g] = *(const u32x4*)(WSP(bf16_t, WS_QG) + r * 128 + d0); } }
#pragma unroll
    for (int t = 0; t < 2; ++t) { const int rl = t ? rl1 : rl0;
        const float m = fmaxf(ls[t][0], fmaxf(ls[t][1], ls[t][2]));
        float w0 = __expf(ls[t][0] - m), w1 = __expf(ls[t][1] - m), w2 = __expf(ls[t][2] - m); const float inv = 1.0f / (w0 + w1 + w2); w0 *= inv; w1 *= inv; w2 *= inv;
#define CMB(c, f) (w0 * f(o[t][0].c) + w1 * f(o[t][1].c) + w2 * f(o[t][2].c))
#if P4_FP8
        u32x4 r; r.x = pk2(CMB(x, bflo), CMB(x, bfhi)); r.y = pk2(CMB(y, bflo), CMB(y, bfhi)); r.z = pk2(CMB(z, bflo), CMB(z, bfhi)); r.w = pk2(CMB(w, bflo), CMB(w, bfhi));
        u32x2 r8; r8.x = pk4_fp8(O8_SCALE * bflo(r.x), O8_SCALE * bfhi(r.x), O8_SCALE * bflo(r.y), O8_SCALE * bfhi(r.y)); r8.y = pk4_fp8(O8_SCALE * bflo(r.z), O8_SCALE * bfhi(r.z), O8_SCALE * bflo(r.w), O8_SCALE * bfhi(r.w));
        *(u32x2*)(p.ws + WS_OATT + (size_t)rl * 512 + h * 128 + d0) = r8;
#else
        u32x4 r; r.x = pk2(CMB(x, bflo), CMB(x, bfhi)); r.y = pk2(CMB(y, bflo), CMB(y, bfhi)); r.z = pk2(CMB(z, bflo), CMB(z, bfhi)); r.w = pk2(CMB(w, bflo), CMB(w, bfhi));
        *(u32x4*)(WSP(bf16_t, WS_OATT) + (size_t)rl * 512 + h * 128 + d0) = r;
#endif
#undef CMB
    }
#endif
}
__global__ void __launch_bounds__(256) k_combine(Params p) {
    const int lane = threadIdx.x & 63; const int w = blockIdx.x * 4 + (threadIdx.x >> 6);
    if (w < TC) combine_token(p, w, lane);
}
constexpr int CONV_TILE = 62 * 1024, CONV_OUT = 32 * 1024, CONV_LDS = CONV_TILE + CONV_OUT + (8 * 32 + 64) * 4;
__device__ __forceinline__ void conv_unit(const Params& p, int u, unsigned char* lds, int tid_) {
    const int ch = tid_, lane = ch & 63, wv = ch >> 6;
    const int bl = u >> 6, s0 = (u & 63) * 32;
    bf16_t* tile = (bf16_t*)lds; bf16_t* otile = (bf16_t*)(lds + CONV_TILE); float* red = (float*)(lds + CONV_TILE + CONV_OUT);
    const bf16_t* cg = WSP(bf16_t, WS_CGLU) + (size_t)bl * 2048 * 512;
#pragma unroll
    for (int it = 0; it < 8; ++it) { const int c = it * 512 + ch; if (c < 62 * 64) { const int r = c >> 6, q = c & 63, s = s0 - 30 + r;
        u32x4 v = {0u, 0u, 0u, 0u}; if (s >= 0) v = *(const u32x4*)(cg + (size_t)s * 512 + q * 8);
        *(u32x4*)(tile + r * 512 + q * 8) = v; } }
    __syncthreads();
    float o[32]; const float cb = p.conv_b[ch];
#pragma unroll
    for (int i = 0; i < 32; ++i) o[i] = cb;
    {   float in[62];
#pragma unroll
        for (int i = 0; i < 62; ++i) in[i] = bf2f(tile[i * 512 + ch]);
#pragma unroll
        for (int j = 0; j < 31; ++j) { const float w = p.conv_w[j * 512 + ch];
#pragma unroll
            for (int i = 0; i < 32; ++i) o[i] += w * in[i + j]; } }
    float* mean = red + 256; float* rstd = red + 288;
#pragma unroll
    for (int i = 0; i < 32; ++i) { const float sr = wave_sum(o[i]); if (lane == 0) red[wv * 32 + i] = sr; }
    __syncthreads();
    if (ch < 32) { float sm = 0.f;
#pragma unroll
        for (int w = 0; w < 8; ++w) sm += red[w * 32 + ch];
        mean[ch] = sm * (1.0f / 512.0f); }
    __syncthreads();
#pragma unroll
    for (int i = 0; i < 32; ++i) { o[i] -= mean[i]; const float sr = wave_sum(o[i] * o[i]); if (lane == 0) red[wv * 32 + i] = sr; }
    __syncthreads();
    if (ch < 32) { float sm = 0.f;
#pragma unroll
        for (int w = 0; w < 8; ++w) sm += red[w * 32 + ch];
        rstd[ch] = 1.0f / sqrtf(sm * (1.0f / 512.0f) + LN_EPS); }
    __syncthreads();
    const float gg = p.conv_g[ch], bb = p.conv_bb[ch];
#pragma unroll
#if P4_FP8
    for (int i = 0; i < 32; ++i) { const float y = o[i] * rstd[i] * gg + bb; const float z = O8_SCALE * (y * sigmoidf_(y)); ((unsigned char*)otile)[i * 512 + ch] = (unsigned char)(__builtin_amdgcn_cvt_pk_fp8_f32(z, z, 0, false) & 255); }
    __syncthreads();
    unsigned char* outp = p.ws + WS_CCONV + ((size_t)bl * 2048 + s0) * 512;
#pragma unroll
    for (int it = 0; it < 2; ++it) { const int c = it * 512 + ch; *(u32x4*)(outp + (size_t)c * 16) = *(const u32x4*)((const unsigned char*)otile + c * 16); }
#else
    for (int i = 0; i < 32; ++i) { const float y = o[i] * rstd[i] * gg + bb; otile[i * 512 + ch] = (bf16_t)f2bf(y * sigmoidf_(y)); }
    __syncthreads();
    bf16_t* outp = WSP(bf16_t, WS_CCONV) + ((size_t)bl * 2048 + s0) * 512;
#pragma unroll
    for (int it = 0; it < 4; ++it) { const int c = it * 512 + ch; *(u32x4*)(outp + (size_t)c * 8) = *(const u32x4*)(otile + c * 8); }
#endif
    __syncthreads();
}
__global__ void __launch_bounds__(512) k_conv(Params p) {
    __shared__ __attribute__((aligned(16))) unsigned char cl[CONV_LDS];
    conv_unit(p, blockIdx.x, cl, threadIdx.x);
}
__device__ __forceinline__ void ln1_unit(const Params& p, int u, const float* wr, int* cls_l, int* misc, int tid_, bool dummy = false) {
    const int tid = tid_, lane = tid & 63, wv = tid >> 6;
    float gam[16], bet[16];
#pragma unroll
    for (int j = 0; j < 4; ++j) { const f32x4 g4 = *(const f32x4*)(p.ln1_g + 4 * lane + 256 * j), b4 = *(const f32x4*)(p.ln1_b + 4 * lane + 256 * j);
        gam[4 * j] = g4.x; gam[4 * j + 1] = g4.y; gam[4 * j + 2] = g4.z; gam[4 * j + 3] = g4.w; bet[4 * j] = b4.x; bet[4 * j + 1] = b4.y; bet[4 * j + 2] = b4.z; bet[4 * j + 3] = b4.w; }
    const int tok0 = u * 64 + wv * 8;
    u32x2 xq[2][4]; u32x2 mq[2][4];
#define LN1_LOAD(slot, rr) do { const bf16_t* xr_ = WSP(bf16_t, WS_XB) + (size_t)(tok0 + (rr)) * 1024 + 4 * lane; const bf16_t* mr_ = (const bf16_t*)p.out + (size_t)(tok0 + (rr)) * 1024 + 4 * lane; \
        _Pragma("unroll") for (int j = 0; j < 4; ++j) { xq[slot][j] = *(const u32x2*)(xr_ + 256 * j); mq[slot][j] = *(const u32x2*)(mr_ + 256 * j); } } while (0)
    LN1_LOAD(0, 0);
#pragma unroll
    for (int rr = 0; rr < 8; ++rr) {
        const int lr = wv * 8 + rr; const int tok = tok0 + rr;
        if (rr + 1 < 8) { if (rr & 1) LN1_LOAD(0, rr + 1); else LN1_LOAD(1, rr + 1); }
        float v[16]; float sm = 0.f;
#pragma unroll
        for (int j = 0; j < 4; ++j) { const u32x2 t = xq[rr & 1][j]; const u32x2 mm = mq[rr & 1][j];
            v[4 * j] = DN_ALPHA * bflo(t.x) + bflo(mm.x); v[4 * j + 1] = DN_ALPHA * bfhi(t.x) + bfhi(mm.x); v[4 * j + 2] = DN_ALPHA * bflo(t.y) + bflo(mm.y); v[4 * j + 3] = DN_ALPHA * bfhi(t.y) + bfhi(mm.y);
            sm += (v[4 * j] + v[4 * j + 1]) + (v[4 * j + 2] + v[4 * j + 3]); }
        const float mean = wave_sum(sm) * (1.0f / 1024.0f); float sq = 0.f;
#pragma unroll
        for (int i = 0; i < 16; ++i) { v[i] -= mean; sq += v[i] * v[i]; }
        const float rstd = 1.0f / sqrtf(wave_sum(sq) * (1.0f / 1024.0f) + LN_EPS);
#pragma unroll
        for (int i = 0; i < 16; ++i) v[i] = v[i] * rstd * gam[i] + bet[i];
        bf16_t* xb = WSP(bf16_t, dummy ? WS_H : WS_X1B) + (size_t)tok * 1024;
#pragma unroll
        for (int j = 0; j < 4; ++j) { u32x2 o; o.x = pk2(v[4 * j], v[4 * j + 1]); o.y = pk2(v[4 * j + 2], v[4 * j + 3]); *(u32x2*)(xb + 4 * lane + 256 * j) = o; }
        if (!dummy) { unsigned char* x8 = p.ws + WS_X1B8 + (size_t)tok * 1024;
#pragma unroll
            for (int j = 0; j < 4; ++j) *(unsigned*)(x8 + 4 * lane + 256 * j) = pk4_fp8(v[4 * j], v[4 * j + 1], v[4 * j + 2], v[4 * j + 3]); }
        float gl[4];
#pragma unroll
        for (int e = 0; e < 4; ++e) { float a = 0.f;
#pragma unroll
            for (int j = 0; j < 4; ++j) { const f32x4 w4 = *(const f32x4*)(wr + e * 1024 + 4 * lane + 256 * j); a += v[4 * j] * w4.x + v[4 * j + 1] * w4.y + v[4 * j + 2] * w4.z + v[4 * j + 3] * w4.w; }
            gl[e] = wave_sum(a) + p.b_gr[e]; }
        int gs = 0; float gm = gl[0];
#pragma unroll
        for (int e = 1; e < 4; ++e) if (gl[e] > gm) { gm = gl[e]; gs = e; }
        float gsum = 0.f;
#pragma unroll
        for (int e = 0; e < 4; ++e) gsum += __expf(gl[e] - gm);
        const float gprob = 1.0f / gsum;
        gs = __builtin_amdgcn_readfirstlane(gs);
        float el[4];
#pragma unroll
        for (int e = 0; e < 4; ++e) { float a = 0.f; const float* wp = wr + (4 + gs * 4 + e) * 1024;
#pragma unroll
            for (int j = 0; j < 4; ++j) { const f32x4 w4 = *(const f32x4*)(wp + 4 * lane + 256 * j); a += v[4 * j] * w4.x + v[4 * j + 1] * w4.y + v[4 * j + 2] * w4.z + v[4 * j + 3] * w4.w; }
            el[e] = wave_sum(a) + p.b_er[gs * 4 + e]; }
        int i1 = 0; float v1 = el[0];
#pragma unroll
        for (int e = 1; e < 4; ++e) if (el[e] > v1) { v1 = el[e]; i1 = e; }
        int i2 = -1; float v2 = -INFINITY;
#pragma unroll
        for (int e = 0; e < 4; ++e) if (e != i1 && el[e] > v2) { v2 = el[e]; i2 = e; }
        const float t2 = __expf(v2 - v1); const float w1 = gprob / (1.0f + t2), w2 = gprob * t2 / (1.0f + t2);
        const int lo = i1 < i2 ? i1 : i2, hi = i1 < i2 ? i2 : i1;
        const int pi = lo == 0 ? hi - 1 : (lo == 1 ? hi + 1 : 5);
        if (lane == 0 && !dummy) { cls_l[lr] = gs * 6 + pi; float* wt = WSP(float, WS_WTS) + (size_t)tok * 2; wt[0] = (i1 == lo) ? w1 : w2; wt[1] = (i1 == lo) ? w2 : w1; }
    }
#undef LN1_LOAD
    __syncthreads();
    if (dummy) return;
    if (tid < NCLS) { int n = 0; for (int r = 0; r < 64; ++r) n += (cls_l[r] == tid); misc[tid] = n ? (int)atomicAdd(WSP(unsigned, WS_CTL) + CW_CNT + tid, (unsigned)n) : 0; }
    __syncthreads();
    if (tid < 64) { const int c = cls_l[tid]; int rank = 0; for (int r = 0; r < tid; ++r) rank += (cls_l[r] == c);
        WSP(int, WS_LIST)[(size_t)c * T + misc[c] + rank] = u * 64 + tid; }
    __syncthreads();
}
__device__ __forceinline__ float row16_sum(float v) {
#define DPP_F(x, ctrl) __int_as_float(__builtin_amdgcn_update_dpp(0, __float_as_int(x), ctrl, 0xf, 0xf, true))
    v += DPP_F(v, 0xB1); v += DPP_F(v, 0x4E); v += DPP_F(v, 0x141); v += DPP_F(v, 0x140);
#undef DPP_F
    return v;
}
__device__ __forceinline__ void ln1_unit16(const Params& p, int u, const float* wr, int* cls_l, int* misc, int tid_, bool dummy = false) {
    const int tid = tid_, lane = tid & 63, wv = tid >> 6;
#pragma unroll 1
    for (int pass = 0; pass < 2; ++pass) {
        int q = lane >> 4, l16 = lane & 15; asm volatile("" : "+v"(q), "+v"(l16));
        const int lr = wv * 8 + pass * 4 + q; const int tok = u * 64 + lr;
        const bf16_t* xr = WSP(bf16_t, WS_XB) + (size_t)tok * 1024 + 4 * l16; const bf16_t* mr = (const bf16_t*)p.out + (size_t)tok * 1024 + 4 * l16;
        u32x2 xq[16], mq[16]; f32x4 g4[16], b4[16];
#pragma unroll
        for (int c = 0; c < 16; ++c) { xq[c] = *(const u32x2*)(xr + 64 * c); mq[c] = *(const u32x2*)(mr + 64 * c); }
#pragma unroll
        for (int c = 0; c < 16; ++c) { g4[c] = *(const f32x4*)(p.ln1_g + 64 * c + 4 * l16); b4[c] = *(const f32x4*)(p.ln1_b + 64 * c + 4 * l16); }
        float v[64]; float sm = 0.f;
#pragma unroll
        for (int c = 0; c < 16; ++c) { const u32x2 t = xq[c], mm = mq[c];
            v[4 * c] = DN_ALPHA * bflo(t.x) + bflo(mm.x); v[4 * c + 1] = DN_ALPHA * bfhi(t.x) + bfhi(mm.x); v[4 * c + 2] = DN_ALPHA * bflo(t.y) + bflo(mm.y); v[4 * c + 3] = DN_ALPHA * bfhi(t.y) + bfhi(mm.y);
            sm += (v[4 * c] + v[4 * c + 1]) + (v[4 * c + 2] + v[4 * c + 3]); }
        const float mean = row16_sum(sm) * (1.0f / 1024.0f); float sq = 0.f;
#pragma unroll
        for (int i = 0; i < 64; ++i) { v[i] -= mean; sq += v[i] * v[i]; }
        const float rstd = 1.0f / sqrtf(row16_sum(sq) * (1.0f / 1024.0f) + LN_EPS);
        bf16_t* xb = WSP(bf16_t, dummy ? WS_H : WS_X1B) + (size_t)tok * 1024 + 4 * l16; unsigned char* x8 = p.ws + WS_X1B8 + (size_t)tok * 1024 + 4 * l16;
#pragma unroll
        for (int c = 0; c < 16; ++c) {
            v[4 * c] = v[4 * c] * rstd * g4[c].x + b4[c].x; v[4 * c + 1] = v[4 * c + 1] * rstd * g4[c].y + b4[c].y; v[4 * c + 2] = v[4 * c + 2] * rstd * g4[c].z + b4[c].z; v[4 * c + 3] = v[4 * c + 3] * rstd * g4[c].w + b4[c].w;
            u32x2 o; o.x = pk2(v[4 * c], v[4 * c + 1]); o.y = pk2(v[4 * c + 2], v[4 * c + 3]); *(u32x2*)(xb + 64 * c) = o;
            if (!dummy) *(unsigned*)(x8 + 64 * c) = pk4_fp8(v[4 * c], v[4 * c + 1], v[4 * c + 2], v[4 * c + 3]); }
        asm volatile("" ::: "memory");
        float gl[4];
#pragma unroll
        for (int e = 0; e < 4; ++e) { float a = 0.f;
#pragma unroll
            for (int c = 0; c < 16; ++c) { const f32x4 w4 = *(const f32x4*)(wr + e * 1024 + 64 * c + 4 * l16); a += v[4 * c] * w4.x + v[4 * c + 1] * w4.y + v[4 * c + 2] * w4.z + v[4 * c + 3] * w4.w; }
            gl[e] = a; asm volatile("" ::: "memory"); }
#pragma unroll
        for (int e = 0; e < 4; ++e) gl[e] = row16_sum(gl[e]) + p.b_gr[e];
        int gs = 0; float gm = gl[0];
#pragma unroll
        for (int e = 1; e < 4; ++e) if (gl[e] > gm) { gm = gl[e]; gs = e; }
        float gsum = 0.f;
#pragma unroll
        for (int e = 0; e < 4; ++e) gsum += __expf(gl[e] - gm);
        const float gprob = 1.0f / gsum;
        float el[4]; const float* wpb = wr + (4 + gs * 4) * 1024 + 4 * l16;
#pragma unroll
        for (int e = 0; e < 4; ++e) { float a = 0.f;
#pragma unroll
            for (int c = 0; c < 16; ++c) { const f32x4 w4 = *(const f32x4*)(wpb + e * 1024 + 64 * c); a += v[4 * c] * w4.x + v[4 * c + 1] * w4.y + v[4 * c + 2] * w4.z + v[4 * c + 3] * w4.w; }
            el[e] = a; asm volatile("" ::: "memory"); }
#pragma unroll
        for (int e = 0; e < 4; ++e) el[e] = row16_sum(el[e]) + p.b_er[gs * 4 + e];
        int i1 = 0; float v1 = el[0];
#pragma unroll
        for (int e = 1; e < 4; ++e) if (el[e] > v1) { v1 = el[e]; i1 = e; }
        int i2 = -1; float v2 = -INFINITY;
#pragma unroll
        for (int e = 0; e < 4; ++e) if (e != i1 && el[e] > v2) { v2 = el[e]; i2 = e; }
        const float t2 = __expf(v2 - v1); const float w1 = gprob / (1.0f + t2), w2 = gprob * t2 / (1.0f + t2);
        const int lo = i1 < i2 ? i1 : i2, hi = i1 < i2 ? i2 : i1;
        const int pi = lo == 0 ? hi - 1 : (lo == 1 ? hi + 1 : 5);
        if (l16 == 0 && !dummy) { cls_l[lr] = gs * 6 + pi; float* wt = WSP(float, WS_WTS) + (size_t)tok * 2; wt[0] = (i1 == lo) ? w1 : w2; wt[1] = (i1 == lo) ? w2 : w1; }
    }
    __syncthreads();
    if (dummy) return;
    if (tid < NCLS) { int n = 0; for (int r = 0; r < 64; ++r) n += (cls_l[r] == tid); misc[tid] = n ? (int)atomicAdd(WSP(unsigned, WS_CTL) + CW_CNT + tid, (unsigned)n) : 0; }
    __syncthreads();
    if (tid < 64) { const int c = cls_l[tid]; int rank = 0; for (int r = 0; r < tid; ++r) rank += (cls_l[r] == c);
        WSP(int, WS_LIST)[(size_t)c * T + misc[c] + rank] = u * 64 + tid; }
    __syncthreads();
}
__global__ void __launch_bounds__(512) k_ln1(Params p) {
    extern __shared__ float dyn[];
    float* wr = dyn; int* cls_l = (int*)(dyn + 20 * 1024); int* misc = cls_l + 64;
    for (int i = threadIdx.x; i < 20 * 1024; i += 512) wr[i] = WSP(float, WS_WRT)[i];
    __syncthreads();
    for (int u = blockIdx.x; u < T / 64; u += gridDim.x) ln1_unit(p, u, wr, cls_l, misc, threadIdx.x);
}
template <int NR>
__device__ __forceinline__ void ln2_rows(const Params& p, const int (&tok)[NR], const int (&prow)[NR], int lane, float* dummy = nullptr) {
    u32x2 xa[NR][4];
#if Y2_FP8
    unsigned ya[NR][4];
#pragma unroll
    for (int r = 0; r < NR; ++r) if (tok[r] >= 0) { const bf16_t* xrow = WSP(bf16_t, WS_X1B) + (size_t)tok[r] * 1024 + 4 * lane; const unsigned char* yrow = p.ws + WS_Y2 + (size_t)prow[r] * 1024 + 4 * lane;
#pragma unroll
        for (int j = 0; j < 4; ++j) { xa[r][j] = *(const u32x2*)(xrow + 256 * j); ya[r][j] = *(const unsigned*)(yrow + 256 * j); } }
#else
    u32x2 ya[NR][4];
#pragma unroll
    for (int r = 0; r < NR; ++r) if (tok[r] >= 0) { const bf16_t* xrow = WSP(bf16_t, WS_X1B) + (size_t)tok[r] * 1024 + 4 * lane; const bf16_t* yrow = WSP(bf16_t, WS_Y2) + (size_t)prow[r] * 1024 + 4 * lane;
#pragma unroll
        for (int j = 0; j < 4; ++j) { xa[r][j] = *(const u32x2*)(xrow + 256 * j); ya[r][j] = *(const u32x2*)(yrow + 256 * j); } }
#endif
    f32x4 g4[4], b4[4];
#pragma unroll
    for (int j = 0; j < 4; ++j) { g4[j] = *(const f32x4*)(p.ln2_g + 4 * lane + 256 * j); b4[j] = *(const f32x4*)(p.ln2_b + 4 * lane + 256 * j); }
#pragma unroll
    for (int r = 0; r < NR; ++r) if (tok[r] >= 0) {
        float v[16]; float sm = 0.f;
#pragma unroll
        for (int j = 0; j < 4; ++j) { const u32x2 t = xa[r][j];
#if Y2_FP8
            const auto ylo = __builtin_amdgcn_cvt_pk_f32_fp8(ya[r][j], false), yhi = __builtin_amdgcn_cvt_pk_f32_fp8(ya[r][j], true);
            v[4 * j] = DN_ALPHA * bflo(t.x) + ylo[0] * (1.0f / Y8_SCALE); v[4 * j + 1] = DN_ALPHA * bfhi(t.x) + ylo[1] * (1.0f / Y8_SCALE); v[4 * j + 2] = DN_ALPHA * bflo(t.y) + yhi[0] * (1.0f / Y8_SCALE); v[4 * j + 3] = DN_ALPHA * bfhi(t.y) + yhi[1] * (1.0f / Y8_SCALE);
#else
            const u32x2 y = ya[r][j];
            v[4 * j] = DN_ALPHA * bflo(t.x) + bflo(y.x); v[4 * j + 1] = DN_ALPHA * bfhi(t.x) + bfhi(y.x); v[4 * j + 2] = DN_ALPHA * bflo(t.y) + bflo(y.y); v[4 * j + 3] = DN_ALPHA * bfhi(t.y) + bfhi(y.y);
#endif
            sm += (v[4 * j] + v[4 * j + 1]) + (v[4 * j + 2] + v[4 * j + 3]); }
        const float mean = wave_sum(sm) * (1.0f / 1024.0f); float sq = 0.f;
#pragma unroll
        for (int i2 = 0; i2 < 16; ++i2) { v[i2] -= mean; sq += v[i2] * v[i2]; }
        const float rstd = 1.0f / sqrtf(wave_sum(sq) * (1.0f / 1024.0f) + LN_EPS);
        float* orow = (dummy ? dummy : p.out) + (size_t)tok[r] * 1024 + 4 * lane;
#pragma unroll
        for (int j = 0; j < 4; ++j) *(f32x4*)(orow + 256 * j) = (f32x4){v[4 * j] * rstd * g4[j].x + b4[j].x, v[4 * j + 1] * rstd * g4[j].y + b4[j].y, v[4 * j + 2] * rstd * g4[j].z + b4[j].z, v[4 * j + 3] * rstd * g4[j].w + b4[j].w};
    }
}
__global__ void __launch_bounds__(256) k_ln2(Params p) {
    __shared__ ClassTab tabs; if (threadIdx.x == 0) class_tab_fill(WSP(unsigned, WS_CTL) + CW_CNT, &tabs); __syncthreads(); const ClassTab* tab = &tabs;
    const int lane = threadIdx.x & 63; const int prow = blockIdx.x * 4 + (threadIdx.x >> 6);
    if (prow >= tab->rowbase[NCLS]) return;
    const int cls = find_class(tab, prow); const int i = prow - tab->rowbase[cls]; if (i >= tab->cnt[cls]) return;
    const int tk[1] = {WSP(int, WS_LIST)[(size_t)cls * T + i]}, pr[1] = {prow};
    ln2_rows<1>(p, tk, pr, lane);
}


#define LAS __attribute__((address_space(3)))
#define GAS __attribute__((address_space(1)))
constexpr int RING_OFF = 0, RING_BYTES = 131072;
constexpr int LCTL_OFF = RING_BYTES;
constexpr int LTOK_OFF = LCTL_OFF + 4096, MAXU = 16;
constexpr int LDS_BYTES = LTOK_OFF + MAXU * 1024;
constexpr int NTHR = 512, NWAVES = 8;

#ifndef FP6_DIAG
#define FP6_DIAG 1
#endif
#if FP6_DIAG & 1
#define FP6_PRE "s_nop 3\n\t"
#else
#define FP6_PRE
#endif
#define FP6_DIAG_V0 ((FP6_DIAG >> 1) & 1)
namespace pg8 {
typedef short bf16x8 __attribute__((ext_vector_type(8)));
typedef int v4i_t __attribute__((ext_vector_type(4)));
typedef int v8i_t __attribute__((ext_vector_type(8)));
typedef int v6i_t __attribute__((ext_vector_type(6)));
typedef int v2i_t __attribute__((ext_vector_type(2)));
constexpr int BM = 256, BK = 64, HALF = 128, HTB = HALF * BK * 2, NXCD = 8, WGM = 8;
__host__ __device__ __forceinline__ int lds_byte(int r, int c) { const int st = (r >> 4) * 2 + (c >> 5), rr = r & 15, cc = c & 31, ob = rr * 64 + cc * 2; return st * 1024 + (ob ^ (((ob >> 9) & 1) << 5)); }
__host__ __device__ __forceinline__ void stage_rc(int b, int& R, int& C) { const int st = b / 1024, sb = b % 1024, swz = sb ^ (((sb >> 9) & 1) << 5); R = (st >> 1) * 16 + swz / 64; C = (st & 1) * 32 + (swz % 64) / 2; }
__host__ __device__ __forceinline__ int perm32(int rho) { const int n = rho >> 4, i = rho & 15; return 8 * (i >> 2) + 4 * n + (i & 3); }

struct Unit { const char* A; const char* B; int row0, col0, bjump, aux; };
struct TileOrder {
    int nM, nN, nwg, G, c;
    __device__ __forceinline__ void init(int nM_, int nN_, int G_, int c_) { nM = nM_; nN = nN_; nwg = nM * nN; G = G_; c = c_; }
    __device__ __forceinline__ bool tile(int i, int& pm, int& pn) const {
        const long L = (long)i * G + c; if (L >= nwg) return false;
        int wgid = (int)L; { const int q = nwg / NXCD, r = nwg % NXCD, xcd = wgid % NXCD, off = wgid / NXCD; wgid = (xcd < r ? xcd * (q + 1) : r * (q + 1) + (xcd - r) * q) + off; }
        const int nig = WGM * nN, gid = wgid / nig, fm = gid * WGM, gsz = (nM - fm) < WGM ? (nM - fm) : WGM;
        pm = fm + ((wgid % nig) % gsz); pn = (wgid % nig) / gsz; return true;
    }
};
__device__ __forceinline__ unsigned cvt_pk_bf16(float lo, float hi) { unsigned r; asm volatile("v_cvt_pk_bf16_f32 %0, %1, %2" : "=v"(r) : "v"(lo), "v"(hi)); return r; }

template <class EF> struct EpiRows {
    static constexpr bool PERM = true, KEEPS = false;
    EF ef;
    __device__ __forceinline__ bool keep_acc(const Unit&) const { return false; }
    __device__ __forceinline__ void operator()(f32x4 (&acc)[2][2][4][2], const Unit& u, int wr, int wc, int fr, int fq) const {
#pragma unroll
        for (int ai = 0; ai < 2; ++ai)
#pragma unroll
            for (int m = 0; m < 4; ++m) { const int row = u.row0 + ai * HALF + wr * 64 + m * 16 + fr;
#pragma unroll
                for (int bj = 0; bj < 2; ++bj) { const int c0 = u.col0 + bj * HALF + wc * 32 + 8 * fq;
                    float v[8] = {acc[ai][bj][m][0][0], acc[ai][bj][m][0][1], acc[ai][bj][m][0][2], acc[ai][bj][m][0][3], acc[ai][bj][m][1][0], acc[ai][bj][m][1][1], acc[ai][bj][m][1][2], acc[ai][bj][m][1][3]};
                    ef(u, row, c0, v); }
                asm volatile("" ::: "memory"); }
    }
};

template <class Epi, class Sched, bool ALIGN_EPI, bool GATHER, bool BJUMP, int LOWP = 0>
__device__ __forceinline__ void gemm_phase(LAS unsigned char* lds, const char* Abase, int lda, int ldb, int K, const Sched& S, const Epi& E, int wave_s) {
    const int tid = opaque_tid(wave_s), wid = __builtin_amdgcn_readfirstlane(tid >> 6), lane = tid & 63, wr = wid >> 2, wc = wid & 3, fr = lane & 15, fq = lane >> 4;
    const int nt = K / BK;
    unsigned voffA[2], voffB[2]; unsigned voffG[2][2], nvoffG[2][2];
#pragma unroll
    for (int i = 0; i < 2; ++i) { int R, C; stage_rc(tid * 16 + i * 8192, R, C); const int Rb = Epi::PERM ? ((R & ~31) + perm32(R & 31)) : R;
        voffA[i] = (unsigned)(R * lda + C) * 2u; voffB[i] = (unsigned)(Rb * ldb + C) * 2u; voffG[0][i] = voffG[1][i] = nvoffG[0][i] = nvoffG[1][i] = 0u; }
    const size_t kstep = (size_t)(BK * 2);
    const size_t hstepA = (size_t)HALF * lda * 2, hstepB = (size_t)HALF * ldb * 2;
    const unsigned ldsw = (unsigned)wid * 1024u;
    const int aoff = lds_byte(wr * 64 + fr, fq * 8), boff = lds_byte(wc * 32 + fr, fq * 8);
#define PG8_SA(b, h) (((b) * 2 + (h)) * HTB)
#define PG8_SB(b, h) ((4 + (b) * 2 + (h)) * HTB)
#define PG8_GLDS(gptr, ldsoff) __builtin_amdgcn_global_load_lds((const unsigned*)(gptr), (LAS unsigned*)(lds + (ldsoff)), 16, 0, 0)
#define PG8_STAGE_B(bufoff, gbase) do { _Pragma("unroll") for (int _i = 0; _i < 2; ++_i) PG8_GLDS((const char*)(gbase) + voffB[_i], (bufoff) + ldsw + _i * 8192); } while (0)
#define PG8_STAGE_A(bufoff, kptr, h, nx) do { if constexpr (GATHER) { _Pragma("unroll") for (int _i = 0; _i < 2; ++_i) PG8_GLDS((const char*)(kptr) + ((nx) ? nvoffG[h][_i] : voffG[h][_i]), (bufoff) + ldsw + _i * 8192); } \
        else { _Pragma("unroll") for (int _i = 0; _i < 2; ++_i) PG8_GLDS((const char*)(kptr) + (h) * hstepA + voffA[_i], (bufoff) + ldsw + _i * 8192); } } while (0)
#define PG8_GATHER_OFFS(dst, ord) do { LAS const int* _tk = S.toks(ord); _Pragma("unroll") for (int _h = 0; _h < 2; ++_h) _Pragma("unroll") for (int _i = 0; _i < 2; ++_i) { int _R, _C; stage_rc(tid * 16 + _i * 8192, _R, _C); \
        dst[_h][_i] = (unsigned)_tk[_h * HALF + _R] * (unsigned)(lda * 2) + (unsigned)(_C * 2); } } while (0)
#define PG8_LD16(addr) (*(const LAS bf16x8*)(addr))
#define PG8_LD8(addr) __builtin_bit_cast(bf16x8, __builtin_shufflevector(*(const LAS v2i_t*)(addr), *(const LAS v2i_t*)(addr), 0, 1, -1, -1))
#define PG8_LDA(dst, b, h) do { _Pragma("unroll") for (int m = 0; m < 4; ++m) { dst[m][0] = PG8_LD16(lds + PG8_SA(b, h) + aoff + m * 2048); \
        if constexpr (LOWP == 2) dst[m][1] = PG8_LD8(lds + PG8_SA(b, h) + aoff + m * 2048 + 1024); else dst[m][1] = PG8_LD16(lds + PG8_SA(b, h) + aoff + m * 2048 + 1024); } } while (0)
#define PG8_LDB(dst, b, h) do { _Pragma("unroll") for (int n = 0; n < 2; ++n) { dst[n][0] = PG8_LD16(lds + PG8_SB(b, h) + boff + n * 2048); \
        if constexpr (LOWP == 2) dst[n][1] = PG8_LD8(lds + PG8_SB(b, h) + boff + n * 2048 + 1024); else dst[n][1] = PG8_LD16(lds + PG8_SB(b, h) + boff + n * 2048 + 1024); } } while (0)
#define PG8_CAT8(lo, hi) __builtin_shufflevector(__builtin_bit_cast(v4i_t, lo), __builtin_bit_cast(v4i_t, hi), 0, 1, 2, 3, 4, 5, 6, 7)
#define PG8_CAT6(lo, hi) __builtin_shufflevector(__builtin_bit_cast(v4i_t, lo), __builtin_bit_cast(v4i_t, hi), 0, 1, 2, 3, 4, 5)
#define PG8_MMA(ai, bj, At, Bt, Z) do { __builtin_amdgcn_s_setprio(1); if constexpr (LOWP == 1) { _Pragma("unroll") for (int m = 0; m < 4; ++m) _Pragma("unroll") for (int n = 0; n < 2; ++n) \
        { const v8i_t b8_ = PG8_CAT8(Bt[n][0], Bt[n][1]), a8_ = PG8_CAT8(At[m][0], At[m][1]); \
          if (Z) asm volatile("v_mfma_f32_16x16x128_f8f6f4 %0, %1, %2, 0" : "=v"(acc[ai][bj][m][n]) : "v"(b8_), "v"(a8_)); \
          else asm volatile("v_mfma_f32_16x16x128_f8f6f4 %0, %1, %2, %0" : "+v"(acc[ai][bj][m][n]) : "v"(b8_), "v"(a8_)); } } \
        else if constexpr (LOWP == 2) { _Pragma("unroll") for (int m = 0; m < 4; ++m) _Pragma("unroll") for (int n = 0; n < 2; ++n) \
        { const v6i_t b6_ = PG8_CAT6(Bt[n][0], Bt[n][1]), a6_ = PG8_CAT6(At[m][0], At[m][1]); if (Z) acc[ai][bj][m][n] = (f32x4){0.f, 0.f, 0.f, 0.f}; asm volatile(FP6_PRE "v_mfma_f32_16x16x128_f8f6f4 %0, %1, %2, %0 cbsz:2 blgp:2" : "+v"(acc[ai][bj][m][n]) : "v"(b6_), "v"(a6_)); } } \
        else { _Pragma("unroll") for (int m = 0; m < 4; ++m) _Pragma("unroll") for (int n = 0; n < 2; ++n) { \
        acc[ai][bj][m][n] = __builtin_amdgcn_mfma_f32_16x16x32_bf16(Bt[n][0], At[m][0], (Z) ? (f32x4){0.f, 0.f, 0.f, 0.f} : acc[ai][bj][m][n], 0, 0, 0); \
        acc[ai][bj][m][n] = __builtin_amdgcn_mfma_f32_16x16x32_bf16(Bt[n][1], At[m][1], acc[ai][bj][m][n], 0, 0, 0); } } __builtin_amdgcn_s_setprio(0); } while (0)
#define PG8_WAIT_V(n) do { if (LOWP == 2 && FP6_DIAG_V0) asm volatile("s_waitcnt vmcnt(0)" ::: "memory"); else asm volatile("s_waitcnt vmcnt(" #n ")" ::: "memory"); } while (0)
#define PG8_WAIT_L(n) asm volatile("s_waitcnt lgkmcnt(" #n ")" ::: "memory")
#define PG8_BAR __builtin_amdgcn_s_barrier()
#define PG8_SCHED __builtin_amdgcn_sched_barrier(0)
    Unit cur, nxt; int ui = 0;
    if (!S.next(0, cur)) return;
    constexpr bool ZRESET = Epi::KEEPS || LOWP != 1;
    f32x4 acc[2][2][4][2];
    if constexpr (ZRESET) {
#pragma unroll
        for (int a = 0; a < 2; ++a)
#pragma unroll
            for (int b = 0; b < 2; ++b)
#pragma unroll
                for (int m = 0; m < 4; ++m)
#pragma unroll
                    for (int n = 0; n < 2; ++n) acc[a][b][m][n] = (f32x4){0.f, 0.f, 0.f, 0.f}; }
    bf16x8 At[4][2], B0[2][2], B1[2][2];
    const char* cA = GATHER ? Abase : cur.A; const char* cB = cur.B;
    if constexpr (GATHER) PG8_GATHER_OFFS(voffG, 0);
    PG8_STAGE_B(PG8_SB(0, 0), cB); PG8_STAGE_B(PG8_SB(0, 1), cB + hstepB); PG8_STAGE_A(PG8_SA(0, 0), cA, 0, false); PG8_STAGE_A(PG8_SA(0, 1), cA, 1, false);
    if (wr == 1) PG8_BAR;
    PG8_WAIT_V(2); PG8_BAR;
    PG8_STAGE_B(PG8_SB(1, 0), cB + kstep); PG8_STAGE_A(PG8_SA(1, 0), cA + kstep, 0, false); PG8_STAGE_B(PG8_SB(1, 1), cB + hstepB + kstep);
    PG8_WAIT_V(6); PG8_BAR;
    for (;;) {
        const bool has_next = S.next(ui + 1, nxt);
        if constexpr (GATHER) { if (has_next) PG8_GATHER_OFFS(nvoffG, ui + 1); else {
#pragma unroll
            for (int h = 0; h < 2; ++h)
#pragma unroll
                for (int i = 0; i < 2; ++i) nvoffG[h][i] = voffG[h][i]; } }
        const char* nA = GATHER ? Abase : (has_next ? nxt.A : cA); const char* nB = has_next ? nxt.B : cB;
#define PG8_ITER(t, ZF) do { \
            const bool last = ((t) == nt - 2); \
            const char* a1 = cA + (size_t)((t) + 1) * kstep; \
            const char* a2 = last ? nA : cA + (size_t)((t) + 2) * kstep; \
            const char* b2 = last ? nB : cB + (size_t)((t) + 2) * kstep + ((BJUMP && ((t) + 2) >= (nt >> 1)) ? cur.bjump : 0); \
            const char* a3 = a2 + kstep; const char* b3 = b2 + kstep; \
              \
            PG8_LDB(B0, 0, 0); PG8_LDB(B1, 0, 1); PG8_SCHED; PG8_LDA(At, 0, 0); PG8_STAGE_A(PG8_SA(1, 1), a1, 1, false); \
            PG8_WAIT_V(8); PG8_WAIT_L(0); PG8_BAR; PG8_MMA(0, 0, At, B0, ZF); PG8_MMA(0, 1, At, B1, ZF); PG8_BAR; PG8_SCHED; \
              \
            PG8_LDA(At, 0, 1); PG8_STAGE_B(PG8_SB(0, 0), b2); PG8_STAGE_B(PG8_SB(0, 1), b2 + hstepB); PG8_STAGE_A(PG8_SA(0, 0), a2, 0, last); \
            PG8_WAIT_V(8); PG8_WAIT_L(0); PG8_BAR; PG8_MMA(1, 0, At, B0, ZF); PG8_MMA(1, 1, At, B1, ZF); PG8_BAR; PG8_SCHED; \
              \
            PG8_LDB(B0, 1, 0); PG8_LDB(B1, 1, 1); PG8_SCHED; PG8_LDA(At, 1, 0); PG8_STAGE_A(PG8_SA(0, 1), a2, 1, last); \
            PG8_WAIT_V(8); PG8_WAIT_L(0); PG8_BAR; PG8_MMA(0, 0, At, B0, false); PG8_MMA(0, 1, At, B1, false); PG8_BAR; PG8_SCHED; \
              \
            PG8_LDA(At, 1, 1); PG8_STAGE_B(PG8_SB(1, 0), b3); PG8_STAGE_B(PG8_SB(1, 1), b3 + hstepB); PG8_STAGE_A(PG8_SA(1, 0), a3, 0, last); \
            PG8_WAIT_V(8); PG8_WAIT_L(0); PG8_BAR; PG8_MMA(1, 0, At, B0, false); PG8_MMA(1, 1, At, B1, false); PG8_BAR; PG8_SCHED; \
        } while (0)
        if constexpr (ZRESET) {
#pragma nounroll
            for (int t = 0; t < nt; t += 2) PG8_ITER(t, false);
        } else {
            PG8_ITER(0, true);
#pragma nounroll
            for (int t = 2; t < nt; t += 2) PG8_ITER(t, false);
        }
#undef PG8_ITER
        if constexpr (ALIGN_EPI) { if (wr == 0) PG8_BAR; }
        if constexpr (LOWP != 0) { asm volatile("s_nop 15\n\ts_nop 15" ::: "memory"); PG8_SCHED; }
        E(acc, cur, wr, wc, fr, fq);
        if (!has_next) break;
        if constexpr (ZRESET) { if (!E.keep_acc(cur)) {
#pragma unroll
            for (int a = 0; a < 2; ++a)
#pragma unroll
                for (int b = 0; b < 2; ++b)
#pragma unroll
                    for (int m = 0; m < 4; ++m)
#pragma unroll
                        for (int n = 0; n < 2; ++n) acc[a][b][m][n] = (f32x4){0.f, 0.f, 0.f, 0.f}; } }
        cur = nxt; cA = nA; cB = nB; ++ui;
        if constexpr (GATHER) {
#pragma unroll
            for (int h = 0; h < 2; ++h)
#pragma unroll
                for (int i = 0; i < 2; ++i) voffG[h][i] = nvoffG[h][i]; }
        if constexpr (ALIGN_EPI) { if (wr == 1) PG8_BAR; }
    }
    PG8_WAIT_V(0);
    if constexpr (!ALIGN_EPI) { if (wr == 0) PG8_BAR; }
    PG8_BAR;
#undef PG8_SA
#undef PG8_SB
#undef PG8_GLDS
#undef PG8_STAGE_A
#undef PG8_STAGE_B
#undef PG8_GATHER_OFFS
#undef PG8_LDA
#undef PG8_LDB
#undef PG8_MMA
#undef PG8_CAT8
#undef PG8_CAT6
#undef PG8_LD16
#undef PG8_LD8
#undef PG8_WAIT_V
#undef PG8_WAIT_L
#undef PG8_BAR
#undef PG8_SCHED
}
}

namespace swa {
typedef short bf16x8 __attribute__((ext_vector_type(8)));
typedef short s16x4 __attribute__((ext_vector_type(4)));
typedef float f32x16 __attribute__((ext_vector_type(16)));
constexpr int DH = 128, NW = 8, QBLK = 32, KVBLK = 64, QB = NW * QBLK;
constexpr int SHM_V = KVBLK * DH * 2, SHM_K = KVBLK * DH * 2;
constexpr int LDS_NEED = 2 * SHM_V + 2 * SHM_K + NW * 64 * 4;
constexpr float SCALE = 0.08838834764831845f, THR = 8.f;
#define KSWZ(row, colB) ((row) * 256 + ((colB) ^ (((row) & 7) << 4)))
#define SBAR() __builtin_amdgcn_sched_barrier(0)
__device__ __forceinline__ int v_st(int k, int c) { const int kk = (k & ~0xC) | ((k & 4) << 1) | ((k & 8) >> 1); return ((kk >> 3) * 4 + (c >> 5)) * 512 + ((kk & 7) * 32 + (c & 31)) * 2; }
__device__ __forceinline__ int v_rd_base(int lane) { return ((lane & 3) << 3) | (((lane >> 2) & 3) << 6) | (((lane >> 4) & 1) << 5) | (((lane >> 5) & 1) << 8); }
constexpr int v_rd_off(int d0, int ks, int half) { return d0 * 512 + ks * 4096 + half * 2048; }
__device__ __forceinline__ int crow(int r, int hi) { return (r & 3) + 8 * (r >> 2) + 4 * hi; }
__device__ __forceinline__ unsigned cvtpk(float lo, float hi) { unsigned r; asm volatile("v_cvt_pk_bf16_f32 %0, %1, %2" : "=v"(r) : "v"(lo), "v"(hi)); return r; }
__device__ __forceinline__ bf16x8 load8(const bf16_t* p) { return *reinterpret_cast<const bf16x8*>(p); }
__device__ __forceinline__ void mask_tile(f32x16& p0, f32x16& p1, int dq, unsigned W) {
    const float NEG = -__builtin_inff();
#pragma unroll
    for (int r = 0; r < 16; ++r) {
        const int c = (r & 3) + 8 * (r >> 2);
        if ((unsigned)(dq - c) >= W) p0[r] = NEG;
        if ((unsigned)(dq - c - 32) >= W) p1[r] = NEG;
    }
}
__device__ __forceinline__ void partialSM(f32x16& p0, f32x16& p1, float& m_reg, float& mn, float& alpha) {
    float pmax = p0[0]; for (int r = 1; r < 16; ++r) pmax = fmaxf(pmax, p0[r]); for (int r = 0; r < 16; ++r) pmax = fmaxf(pmax, p1[r]);
    { auto rr = __builtin_amdgcn_permlane32_swap(__float_as_uint(pmax), __float_as_uint(pmax), false, false);
      pmax = fmaxf(__uint_as_float(rr[0]), __uint_as_float(rr[1])); }
    constexpr float C2 = 1.4426950408889634f * SCALE;
    if (__builtin_expect(__all((pmax - m_reg) * SCALE <= THR), 1)) { mn = m_reg; alpha = 1.f; }
    else { mn = fmaxf(m_reg, pmax); alpha = __builtin_amdgcn_exp2f((m_reg - mn) * C2); m_reg = mn; }
    const float mnL = -mn * C2;
    for (int r = 0; r < 16; ++r) p0[r] = fmaf(p0[r], C2, mnL); for (int r = 0; r < 16; ++r) p1[r] = fmaf(p1[r], C2, mnL);
    for (int r = 0; r < 16; ++r) p0[r] = __builtin_amdgcn_exp2f(p0[r]);
}
__device__ __forceinline__ void finishSM(f32x16& p0, f32x16& p1, float alpha, float& l_reg, bf16x8& pa0, bf16x8& pa1, bf16x8& pa2, bf16x8& pa3) {
    for (int r = 0; r < 16; ++r) p1[r] = __builtin_amdgcn_exp2f(p1[r]);
    float ps = 0; for (int r = 0; r < 16; ++r) ps += p0[r]; for (int r = 0; r < 16; ++r) ps += p1[r];
    { auto rr = __builtin_amdgcn_permlane32_swap(__float_as_uint(ps), __float_as_uint(ps), false, false);
      ps = __uint_as_float(rr[0]) + __uint_as_float(rr[1]); }
    l_reg = l_reg * alpha + ps;
#define PK4(P, B_, OUT) do { unsigned a0 = cvtpk(P[B_+0], P[B_+1]), a1 = cvtpk(P[B_+2], P[B_+3]);                          \
        unsigned b0 = cvtpk(P[B_+4], P[B_+5]), b1 = cvtpk(P[B_+6], P[B_+7]);                                             \
        auto r0 = __builtin_amdgcn_permlane32_swap(a0, b0, false, false); auto r1 = __builtin_amdgcn_permlane32_swap(a1, b1, false, false); \
        u32x4 w = {r0[0], r1[0], r0[1], r1[1]}; OUT = *reinterpret_cast<bf16x8*>(&w); } while (0)
    PK4(p0, 0, pa0); PK4(p0, 8, pa1); PK4(p1, 0, pa2); PK4(p1, 8, pa3);
#undef PK4
}
template <int KB>
__device__ __forceinline__ void qkt(f32x16& p0, f32x16& p1, const char* K_lds, int r32, int hi, const bf16x8* qr, bool act) {
    if (!act) { const float NEG = -__builtin_inff();
#pragma unroll
        for (int r = 0; r < 16; ++r) { p0[r] = NEG; p1[r] = NEG; } return; }
    p0 = f32x16{}; p1 = f32x16{};
    const char* kb[4];
#pragma unroll
    for (int dd = 0; dd < 4; ++dd) kb[dd] = K_lds + KB * SHM_K + KSWZ(r32, (dd * 16 + hi * 8) * 2);
#pragma unroll
    for (int d0 = 0; d0 < 8; ++d0) { const char* a = kb[d0 & 3] + (d0 >> 2) * 128;
        bf16x8 b0 = *reinterpret_cast<const bf16x8*>(a);
        bf16x8 b1 = *reinterpret_cast<const bf16x8*>(a + 32 * 256);
        p0 = __builtin_amdgcn_mfma_f32_32x32x16_bf16(b0, qr[d0], p0, 0, 0, 0);
        p1 = __builtin_amdgcn_mfma_f32_32x32x16_bf16(b1, qr[d0], p1, 0, 0, 0); }
}
template <int VB>
__device__ __forceinline__ void pv_tile(f32x16* o, int vb0, bf16x8 pa0, bf16x8 pa1, bf16x8 pa2, bf16x8 pa3, bool act) {
    if (!act) return;
#define TRRD(dst, off) asm volatile("ds_read_b64_tr_b16 %0, %1 offset:%2" : "=&v"(dst) : "v"(vb0), "i"(off) : "memory")
#define PV_D0(d0) do { s16x4 l0, l1, l2, l3, h0, h1, h2, h3; constexpr int b_ = VB * SHM_V + v_rd_off(d0, 0, 0); \
        TRRD(l0, b_); TRRD(h0, b_ + 2048); TRRD(l1, b_ + 4096); TRRD(h1, b_ + 6144); TRRD(l2, b_ + 8192); TRRD(h2, b_ + 10240); TRRD(l3, b_ + 12288); TRRD(h3, b_ + 14336); \
        asm volatile("s_waitcnt lgkmcnt(0)" ::: "memory"); SBAR();   \
        o[d0] = __builtin_amdgcn_mfma_f32_32x32x16_bf16(pa0, (bf16x8){l0[0], l0[1], l0[2], l0[3], h0[0], h0[1], h0[2], h0[3]}, o[d0], 0, 0, 0);   \
        o[d0] = __builtin_amdgcn_mfma_f32_32x32x16_bf16(pa1, (bf16x8){l1[0], l1[1], l1[2], l1[3], h1[0], h1[1], h1[2], h1[3]}, o[d0], 0, 0, 0);   \
        o[d0] = __builtin_amdgcn_mfma_f32_32x32x16_bf16(pa2, (bf16x8){l2[0], l2[1], l2[2], l2[3], h2[0], h2[1], h2[2], h2[3]}, o[d0], 0, 0, 0);   \
        o[d0] = __builtin_amdgcn_mfma_f32_32x32x16_bf16(pa3, (bf16x8){l3[0], l3[1], l3[2], l3[3], h3[0], h3[1], h3[2], h3[3]}, o[d0], 0, 0, 0); } while (0)
    PV_D0(0); PV_D0(1); PV_D0(2); PV_D0(3);
#undef PV_D0
#undef TRRD
}
struct BlockRef { const bf16_t* Q; const bf16_t* K; const bf16_t* V; bf16_t* O; float* LSE; int P0, W, segmask, skv, ostride; };
struct Seam { bf16x8 qr[8]; bf16x8 st_v0, st_v1, st_k0, st_k1; };
__device__ __forceinline__ int imax(int a, int b) { return a > b ? a : b; }
__device__ __forceinline__ int blk_jlo(const BlockRef& b) { const int lowk = imax(b.P0 - b.W + 1, b.P0 & ~b.segmask); return lowk > 0 ? lowk / KVBLK : 0; }
#define ROW(p, k0, rr) ((p) + (size_t)((k0) + (rr)) * DH + sc)
#define VMW() asm volatile("s_waitcnt vmcnt(0)" ::: "memory")
#define VMWN(n) asm volatile("s_waitcnt vmcnt(%0)" :: "i"(n) : "memory")
#define SLOAD_H(Kp, Vp, k0) do { S.st_v0 = load8(ROW(Vp, k0, sr)); S.st_v1 = load8(ROW(Vp, k0, 32 + sr));              \
                         S.st_k0 = load8(ROW(Kp, k0, sr)); S.st_k1 = load8(ROW(Kp, k0, 32 + sr)); } while (0)
#define SWRITE_HK(bf) do { *(bf16x8*)(K_lds + (bf) * SHM_K + kws) = S.st_k0; *(bf16x8*)(K_lds + (bf) * SHM_K + kws + 32 * 256) = S.st_k1; } while (0)
#define SWRITE_HV(bf) do { *(bf16x8*)(V_lds + (bf) * SHM_V + vst0) = S.st_v0; *(bf16x8*)(V_lds + (bf) * SHM_V + vst1) = S.st_v1; } while (0)
#define SWRITE_H(bf) do { SWRITE_HV(bf); SWRITE_HK(bf); } while (0)
__device__ __forceinline__ void prime(const BlockRef& cur, char* lds, Seam& S, int wave_s) {
    const int tid = opaque_tid(wave_s), wid = __builtin_amdgcn_readfirstlane(tid >> 6), lane = tid & 63, r32 = lane & 31, hi = lane >> 5;
    const int sr = tid >> 4, sc = (tid & 15) * 8, kws = KSWZ(sr, sc * 2); char* K_lds = lds + 2 * SHM_V;
    const int kb0 = blk_jlo(cur) * KVBLK;
    for (int d0 = 0; d0 < 8; ++d0) S.qr[d0] = load8(cur.Q + (size_t)(wid * QBLK + r32) * DH + d0 * 16 + hi * 8);
    SLOAD_H(cur.K, cur.V, kb0); VMW(); SWRITE_HK(0);
    __syncthreads();
}
__device__ __forceinline__ void block(const BlockRef& cur, const BlockRef& nxt, char* lds, Seam& S, int wave_s) {
    const int tid = opaque_tid(wave_s), wid = __builtin_amdgcn_readfirstlane(tid >> 6), lane = tid & 63, r32 = lane & 31, hi = lane >> 5;
    const int W = cur.W;
    const int j_lo = blk_jlo(cur);
    int j_hi = (cur.P0 + QB - 1) / KVBLK + 1; if (j_hi > cur.skv / KVBLK) j_hi = cur.skv / KVBLK;
    const int NT = j_hi - j_lo;
    const int kbn = blk_jlo(nxt) * KVBLK;
    const int qlo = cur.P0 + wid * QBLK, qm = qlo + r32 - 4 * hi;
    const int segb = qlo & ~cur.segmask;
    const int lowk_w = imax(qlo - W + 1, segb);
    const int lowk_last = imax(qlo + QBLK - W, segb);
    const int wrow = ((qlo + r32) & cur.segmask) + 1;
    const unsigned Wl = (unsigned)(wrow < W ? wrow : W);
    char* V_lds = lds; char* K_lds = lds + 2 * SHM_V;
    float* ws = (float*)(lds + 2 * SHM_V + 2 * SHM_K) + wid * 64; float* li_l = ws, * al_l = ws + 32;
    float m_reg = -1e30f, l_reg = 0; f32x16 o[4] = {};
    const int sr = tid >> 4, sc = (tid & 15) * 8, vst0 = v_st(sr, sc), vst1 = v_st(32 + sr, sc), kws = KSWZ(sr, sc * 2);
    const int vb0 = (int)(uintptr_t)V_lds + v_rd_base(lane);
    const bf16_t* Kh = cur.K; const bf16_t* Vh = cur.V;
#define RESC(a) do { if (__any((a) < 1.f)) { if (hi == 0) al_l[r32] = (a); asm volatile("s_waitcnt lgkmcnt(0)" ::: "memory");              \
                     for (int d_ = 0; d_ < 4; ++d_) for (int r = 0; r < 16; ++r) o[d_][r] *= al_l[crow(r, hi)]; } } while (0)
#define KBASE(t) ((j_lo + (t)) * KVBLK)
#define ACT(t) (KBASE(t) <= qlo + QBLK - 1 && KBASE(t) + KVBLK - 1 >= lowk_w)
#define MASKT(P0_, P1_, t) do { const int kb_ = KBASE(t); if (ACT(t) && (kb_ + KVBLK - 1 > qlo || kb_ < lowk_last)) mask_tile(P0_, P1_, qm - kb_, Wl); } while (0)
    constexpr int NQL = 8;
#define SEAM_K0() do { VMWN(NQL); SWRITE_HK(0); SBAR(); } while (0)
    f32x16 pA0, pA1, pB0, pB1; float mnA, mnB, alA, alB; bf16x8 pa0, pa1, pa2, pa3;
    SWRITE_HV(0); SBAR();
    if (NT > 1) { SLOAD_H(Kh, Vh, KBASE(1)); }
    SBAR(); qkt<0>(pA0, pA1, K_lds, r32, hi, S.qr, ACT(0));
    MASKT(pA0, pA1, 0); partialSM(pA0, pA1, m_reg, mnA, alA);
    if (NT > 1) { VMW(); SWRITE_H(1); }
    __syncthreads();
#define HALF_STEP(PX0, PX1, mnX, alX, PY0, PY1, alY, t, KB, VB, SB) do {                                                      \
        SBAR(); if ((t) + 1 < NT) { SLOAD_H(Kh, Vh, KBASE((t) + 1)); SBAR(); }                                       \
        qkt<KB>(PX0, PX1, K_lds, r32, hi, S.qr, ACT(t));                                             \
        finishSM(PY0, PY1, alY, l_reg, pa0, pa1, pa2, pa3); SBAR();                                                           \
        pv_tile<VB>(o, vb0, pa0, pa1, pa2, pa3, ACT((t) - 1)); MASKT(PX0, PX1, (t)); partialSM(PX0, PX1, m_reg, mnX, alX);                                        \
        __syncthreads();                                                                                                      \
        if ((t) + 1 < NT) { VMW(); SWRITE_H(SB); }                                                                          \
        RESC(alX); __syncthreads(); } while (0)
    for (int t = 1; t + 1 < NT; t += 2) {
        HALF_STEP(pB0, pB1, mnB, alB, pA0, pA1, alA, t, 1, 0, 0);
        HALF_STEP(pA0, pA1, mnA, alA, pB0, pB1, alB, t + 1, 0, 1, 1);
    }
    const bool even = (NT & 1) == 0;
    if (even) { SBAR(); qkt<1>(pB0, pB1, K_lds, r32, hi, S.qr, ACT(NT - 1)); SBAR(); }
    SLOAD_H(nxt.K, nxt.V, kbn); SBAR();
#pragma unroll
    for (int d0 = 0; d0 < 8; ++d0) S.qr[d0] = load8(nxt.Q + (size_t)(wid * QBLK + r32) * DH + d0 * 16 + hi * 8);
    SBAR();
    finishSM(pA0, pA1, alA, l_reg, pa0, pa1, pa2, pa3); SBAR();
    pv_tile<0>(o, vb0, pa0, pa1, pa2, pa3, ACT(even ? NT - 2 : NT - 1));
    if (even) { MASKT(pB0, pB1, NT - 1); partialSM(pB0, pB1, m_reg, mnB, alB); __syncthreads(); RESC(alB);
        finishSM(pB0, pB1, alB, l_reg, pa0, pa1, pa2, pa3); SBAR(); pv_tile<1>(o, vb0, pa0, pa1, pa2, pa3, ACT(NT - 1)); }
    SBAR(); SEAM_K0();
    if (hi == 0) li_l[r32] = l_reg; asm volatile("s_waitcnt lgkmcnt(0)" ::: "memory");
    if (cur.LSE != nullptr && hi == 0) cur.LSE[wid * QBLK + r32] = m_reg * SCALE + __logf(l_reg);
    float rli[16];
#pragma unroll
    for (int r = 0; r < 16; ++r) rli[r] = __builtin_amdgcn_rcpf(li_l[crow(r, hi)]);
    bf16_t* Ow = cur.O + (size_t)(wid * QBLK) * cur.ostride;
#pragma unroll
    for (int r = 0; r < 16; ++r) { const int orow = crow(r, hi);
#pragma unroll
        for (int d0 = 0; d0 < 4; ++d0) { const float v = o[d0][r] * rli[r];
            const float vn = __shfl_xor(v, 1);
            if ((r32 & 1) == 0) *(unsigned*)(Ow + (size_t)orow * cur.ostride + d0 * 32 + r32) = cvtpk(v, vn); } }
    __syncthreads();
#undef RESC
#undef KBASE
#undef ACT
#undef MASKT
#undef SEAM_K0
#undef HALF_STEP
}

constexpr int RING_V = 4 * SHM_K;
__device__ __forceinline__ void qkt_rt(f32x16& p0, f32x16& p1, const LAS char* Kslot, int r32, int hi, const bf16x8* qr) {
    p0 = f32x16{}; p1 = f32x16{};
    const LAS char* kb[4];
#pragma unroll
    for (int dd = 0; dd < 4; ++dd) kb[dd] = Kslot + KSWZ(r32, (dd * 16 + hi * 8) * 2);
#pragma unroll
    for (int d0 = 0; d0 < 8; ++d0) { const LAS char* a = kb[d0 & 3] + (d0 >> 2) * 128;
        bf16x8 b0 = *(const LAS bf16x8*)(a);
        bf16x8 b1 = *(const LAS bf16x8*)(a + 32 * 256);
        p0 = __builtin_amdgcn_mfma_f32_32x32x16_bf16(b0, qr[d0], p0, 0, 0, 0);
        p1 = __builtin_amdgcn_mfma_f32_32x32x16_bf16(b1, qr[d0], p1, 0, 0, 0); }
}
__device__ __forceinline__ void pv_rt(f32x16* o, int vb, bf16x8 pa0, bf16x8 pa1, bf16x8 pa2, bf16x8 pa3) {
#define TRRD(dst, off) asm volatile("ds_read_b64_tr_b16 %0, %1 offset:%2" : "=&v"(dst) : "v"(vb), "i"(off) : "memory")
#define PV_D0(d0) do { s16x4 l0, l1, l2, l3, h0, h1, h2, h3; constexpr int b_ = v_rd_off(d0, 0, 0); \
        TRRD(l0, b_); TRRD(h0, b_ + 2048); TRRD(l1, b_ + 4096); TRRD(h1, b_ + 6144); TRRD(l2, b_ + 8192); TRRD(h2, b_ + 10240); TRRD(l3, b_ + 12288); TRRD(h3, b_ + 14336); \
        asm volatile("s_waitcnt lgkmcnt(0)" ::: "memory"); SBAR();   \
        o[d0] = __builtin_amdgcn_mfma_f32_32x32x16_bf16((bf16x8){l0[0], l0[1], l0[2], l0[3], h0[0], h0[1], h0[2], h0[3]}, pa0, o[d0], 0, 0, 0);   \
        o[d0] = __builtin_amdgcn_mfma_f32_32x32x16_bf16((bf16x8){l1[0], l1[1], l1[2], l1[3], h1[0], h1[1], h1[2], h1[3]}, pa1, o[d0], 0, 0, 0);   \
        o[d0] = __builtin_amdgcn_mfma_f32_32x32x16_bf16((bf16x8){l2[0], l2[1], l2[2], l2[3], h2[0], h2[1], h2[2], h2[3]}, pa2, o[d0], 0, 0, 0);   \
        o[d0] = __builtin_amdgcn_mfma_f32_32x32x16_bf16((bf16x8){l3[0], l3[1], l3[2], l3[3], h3[0], h3[1], h3[2], h3[3]}, pa3, o[d0], 0, 0, 0); } while (0)
    PV_D0(0); PV_D0(1); PV_D0(2); PV_D0(3);
#undef PV_D0
#undef TRRD
}
struct WaveState { float m, l; f32x16 o[4]; };
__device__ __forceinline__ void tile_step(WaveState& st, const bf16x8* qr, const LAS char* lds, int slot, int r32, int hi, int lane, bool need_mask, int dq, unsigned Wl) {
    f32x16 p0, p1; float mn, alpha; bf16x8 pa0, pa1, pa2, pa3;
    qkt_rt(p0, p1, lds + slot * SHM_K, r32, hi, qr);
    if (need_mask) mask_tile(p0, p1, dq, Wl);
    partialSM(p0, p1, st.m, mn, alpha);
    if (__any(alpha < 1.f)) {
#pragma unroll
        for (int d_ = 0; d_ < 4; ++d_)
#pragma unroll
            for (int r = 0; r < 16; ++r) st.o[d_][r] *= alpha; }
    finishSM(p0, p1, alpha, st.l, pa0, pa1, pa2, pa3); SBAR();
    pv_rt(st.o, (int)(unsigned)(uintptr_t)(lds + RING_V + slot * SHM_V) + v_rd_base(lane), pa0, pa1, pa2, pa3);
}
__device__ __forceinline__ void wave_store(const WaveState& st, bf16_t* Ow, int ostride, float* lse, int r32, int hi) {
    if (lse != nullptr && hi == 0) lse[r32] = st.m * SCALE + __logf(st.l);
    const float rl = __builtin_amdgcn_rcpf(st.l);
    bf16_t* rowp = Ow + (size_t)r32 * ostride + hi * 8;
#pragma unroll
    for (int d0 = 0; d0 < 4; ++d0)
#pragma unroll
        for (int k = 0; k < 4; k += 2) {
            unsigned ax = cvtpk(st.o[d0][4 * k] * rl, st.o[d0][4 * k + 1] * rl), ay = cvtpk(st.o[d0][4 * k + 2] * rl, st.o[d0][4 * k + 3] * rl);
            unsigned bx = cvtpk(st.o[d0][4 * k + 4] * rl, st.o[d0][4 * k + 5] * rl), by = cvtpk(st.o[d0][4 * k + 6] * rl, st.o[d0][4 * k + 7] * rl);
            { auto r = __builtin_amdgcn_permlane32_swap(ax, bx, false, false); ax = r[0]; bx = r[1]; }
            { auto r = __builtin_amdgcn_permlane32_swap(ay, by, false, false); ay = r[0]; by = r[1]; }
            *(u32x4*)(rowp + d0 * 32 + 8 * k) = (u32x4){ax, ay, bx, by};
        }
}
__device__ __forceinline__ void wave_store8(const WaveState& st, unsigned char* Ow, int ostride, int r32, int hi, float* lse = nullptr) {
    if (lse != nullptr && hi == 0) lse[r32] = st.m * SCALE + __logf(st.l);
    const float rl = O8_SCALE * __builtin_amdgcn_rcpf(st.l);
    unsigned char* rowp = Ow + (size_t)r32 * ostride + hi * 8;
#pragma unroll
    for (int d0 = 0; d0 < 4; ++d0)
#pragma unroll
        for (int k = 0; k < 4; k += 2) {
            unsigned a = pk4_fp8(st.o[d0][4 * k] * rl, st.o[d0][4 * k + 1] * rl, st.o[d0][4 * k + 2] * rl, st.o[d0][4 * k + 3] * rl);
            unsigned b = pk4_fp8(st.o[d0][4 * k + 4] * rl, st.o[d0][4 * k + 5] * rl, st.o[d0][4 * k + 6] * rl, st.o[d0][4 * k + 7] * rl);
            { auto r = __builtin_amdgcn_permlane32_swap(a, b, false, false); a = r[0]; b = r[1]; }
            *(u32x2*)(rowp + d0 * 32 + 8 * k) = (u32x2){a, b};
        }
}
__device__ __forceinline__ void wave_reset(WaveState& st) { st.m = -1e30f; st.l = 0.f;
#pragma unroll
    for (int d = 0; d < 4; ++d) st.o[d] = f32x16{}; }
#define HS_LOADQ(qr, Qrow0) do { _Pragma("unroll") for (int d0 = 0; d0 < 8; ++d0) qr[d0] = load8((Qrow0) + (size_t)(wid * QBLK + r32) * DH + d0 * 16 + hi * 8); } while (0)
#define HS_SLOAD(Kp, Vp, k0) do { st_v0 = load8(ROW(Vp, k0, sr)); st_v1 = load8(ROW(Vp, k0, 32 + sr)); st_k0 = load8(ROW(Kp, k0, sr)); st_k1 = load8(ROW(Kp, k0, 32 + sr)); } while (0)
#define HS_SWRITE(slot) do { *(LAS bf16x8*)(lds + (slot) * SHM_K + kws) = st_k0; *(LAS bf16x8*)(lds + (slot) * SHM_K + kws + 32 * 256) = st_k1; \
                             *(LAS bf16x8*)(lds + RING_V + (slot) * SHM_V + vst0) = st_v0; *(LAS bf16x8*)(lds + RING_V + (slot) * SHM_V + vst1) = st_v1; } while (0)
__device__ __forceinline__ void head_dilated(const bf16_t* Q, bf16_t* O, const bf16_t* K, const bf16_t* V, float* LSE, int segmask, LAS char* lds, LAS float* scr, int wave_s) {
    const int tid = opaque_tid(wave_s), wid = __builtin_amdgcn_readfirstlane(tid >> 6), lane = tid & 63, r32 = lane & 31, hi = lane >> 5, pair = wid >> 1;
    const int sr = tid >> 4, sc = (tid & 15) * 8, vst0 = v_st(sr, sc), vst1 = v_st(32 + sr, sc), kws = KSWZ(sr, sc * 2);
    constexpr int NT = 2048 / KVBLK, W = 129;
    bf16x8 st_v0, st_v1, st_k0, st_k1; bf16x8 qr[8]; WaveState st; wave_reset(st);
    HS_SLOAD(K, V, 0); HS_LOADQ(qr, Q); VMW(); HS_SWRITE(0); SBAR();
    HS_SLOAD(K, V, KVBLK); VMW(); HS_SWRITE(1);
    __syncthreads();
    for (int g = 1; g <= NT; ++g) {
        const bool ld = g + 1 < NT;
        if (ld) { HS_SLOAD(K, V, (g + 1) * KVBLK); SBAR(); }
        const int ph = (g - 1) & 3, qb = (g - 1) >> 2;
        if (ph != 3) {
            const int T = g - 3 + pair, qlo = qb * QB + wid * QBLK, segb = qlo & ~segmask;
            const int lowk_w = imax(qlo - W + 1, segb), lowk_last = imax(qlo + QBLK - W, segb), kb_ = T * KVBLK;
            if (T >= 0 && kb_ <= qlo + QBLK - 1 && kb_ + KVBLK - 1 >= lowk_w) {
                const int wrow = ((qlo + r32) & segmask) + 1;
                tile_step(st, qr, lds, T & 3, r32, hi, lane, (kb_ + KVBLK - 1 > qlo) || (kb_ < lowk_last), qlo + r32 - 4 * hi - kb_, (unsigned)(wrow < W ? wrow : W));
            }
            if (ph == 2 && qb + 1 < 2048 / QB) { SBAR(); HS_LOADQ(qr, Q + (size_t)(qb + 1) * QB * DH); }
        } else {
#if O_FP8 && P4_FP8
            wave_store8(st, (unsigned char*)(O + (size_t)(qb * QB + wid * QBLK) * DH), 2 * DH, r32, hi, LSE + qb * QB + wid * QBLK);
#else
            wave_store(st, O + (size_t)(qb * QB + wid * QBLK) * DH, DH, LSE + qb * QB + wid * QBLK, r32, hi);
#endif
            wave_reset(st);
        }
        __syncthreads();
        if (ld) { HS_SWRITE((g + 1) & 3); }
        __syncthreads();
    }
}
__device__ __forceinline__ void head_mem(const bf16_t* Q, const bf16_t* K, const bf16_t* V, bf16_t* O, int ostride, LAS char* lds, LAS float* scr, int wave_s) {
    const int tid = opaque_tid(wave_s), wid = __builtin_amdgcn_readfirstlane(tid >> 6), lane = tid & 63, r32 = lane & 31, hi = lane >> 5, pair = wid >> 1;
    const int sr = tid >> 4, sc = (tid & 15) * 8, vst0 = v_st(sr, sc), vst1 = v_st(32 + sr, sc), kws = KSWZ(sr, sc * 2);
    bf16x8 st_v0, st_v1, st_k0, st_k1; bf16x8 qr[8]; WaveState st;
#pragma unroll
    for (int t = 0; t < 4; ++t) { HS_SLOAD(K, V, t * KVBLK); VMW(); HS_SWRITE(t); SBAR(); }
    __syncthreads();
    for (int qb = 0; qb < 2048 / QB; ++qb) {
        HS_LOADQ(qr, Q + (size_t)qb * QB * DH); wave_reset(st);
        for (int t = 0; t < 4; ++t) tile_step(st, qr, lds, (t + pair) & 3, r32, hi, lane, false, 0, 0u);
#if P4_FP8
        wave_store8(st, (unsigned char*)O + (size_t)(qb * QB + wid * QBLK) * ostride, ostride, r32, hi);
#else
        wave_store(st, O + (size_t)(qb * QB + wid * QBLK) * ostride, ostride, nullptr, r32, hi);
#endif
    }
    __syncthreads();
}
#undef HS_LOADQ
#undef HS_SLOAD
#undef HS_SWRITE
#undef ROW
#undef VMW
#undef VMWN
#undef SLOAD_H
#undef SWRITE_HK
#undef SWRITE_HV
#undef SWRITE_H
#undef KSWZ
#undef SBAR
}

#define XB_TMO      128
#define XB_XCNT(j)  (256  + 64 * (j))
#define XB_XSUB(j)  (1280 + 64 * (j))
#define XB_XGEN(j)  (2304 + 64 * (j))
#define XB_TOP      3328
#define XB_TOPGEN   3392
#define XCD_BAR_WORDS 3456
#define XB_SPIN_CAP (1u << 18)
__device__ __forceinline__ unsigned xb_ld(unsigned* p)              { return __hip_atomic_load(p, __ATOMIC_RELAXED, __HIP_MEMORY_SCOPE_AGENT); }
__device__ __forceinline__ unsigned xb_add(unsigned* p, unsigned v) { return __hip_atomic_fetch_add(p, v, __ATOMIC_RELAXED, __HIP_MEMORY_SCOPE_AGENT); }
__device__ __forceinline__ unsigned xb_xcc_id() { return (unsigned)__builtin_amdgcn_s_getreg((3 << 11) | 20) & 0xFu; }
#define XB_SPIN(cond, bar) do { unsigned _sp = 0; while (cond) { __builtin_amdgcn_s_sleep(1); \
    if ((++_sp & 255u) == 0u) { if (xb_ld(&(bar)[XB_TMO])) break; if (_sp > XB_SPIN_CAP) { atomicAdd(&(bar)[XB_TMO], 1u); break; } } } } while (0)
struct XcdBarrier { unsigned* bar; unsigned x; volatile LAS unsigned* st; };
__device__ __forceinline__ XcdBarrier xcd_barrier_post(unsigned* bar, volatile LAS unsigned* st) {
    XcdBarrier b; b.bar = bar; b.x = xb_xcc_id(); b.st = st;
    if (threadIdx.x == 0) (void)xb_add(&bar[XB_XCNT(b.x)], 1u);
    return b;
}
__device__ __forceinline__ void xcd_barrier_complete(unsigned* bar, unsigned x, unsigned& nloc, unsigned& nx) {
    const unsigned G = gridDim.x * gridDim.y * gridDim.z;
    unsigned sum, cnt, mine, sp = 0u;
    for (;;) {
        sum = 0u; cnt = 0u; mine = 0u;
#pragma unroll
        for (unsigned j = 0; j < 16; ++j) { const unsigned c = xb_ld(&bar[XB_XCNT(j)]); sum += c; cnt += (c > 0u) ? 1u : 0u; mine = (j == x) ? c : mine; }
        if (sum == G) break;
        __builtin_amdgcn_s_sleep(1);
        if ((++sp & 255u) == 0u) { if (xb_ld(&bar[XB_TMO])) break; if (sp > XB_SPIN_CAP) { atomicAdd(&bar[XB_TMO], 1u); break; } }
    }
    nloc = mine > 0u ? mine : 1u; nx = cnt > 0u ? cnt : 1u;
}
__device__ __forceinline__ void xcd_barrier(const XcdBarrier& b) {
    asm volatile("s_waitcnt vmcnt(0)" ::: "memory");
    __syncthreads();
    if (threadIdx.x == 0) {
        unsigned* bar = b.bar; asm volatile("" : "+s"(bar)); bar = (unsigned*)(GAS unsigned*)bar;
        __builtin_amdgcn_s_waitcnt(0);
        unsigned nloc = b.st[0], nx = b.st[1];
        if (nloc == 0u) { xcd_barrier_complete(bar, b.x, nloc, nx); b.st[0] = nloc; b.st[1] = nx; }
        const unsigned old = xb_add(&bar[XB_XSUB(b.x)], 1u);
        const unsigned gen = old / nloc;
        if (old + 1u == (gen + 1u) * nloc) {
            __builtin_amdgcn_fence(__ATOMIC_RELEASE, "agent");
            asm volatile("s_waitcnt vmcnt(0)" ::: "memory");
            const unsigned og = xb_add(&bar[XB_TOP], 1u);
            const unsigned tg = og / nx;
            if (og + 1u == (tg + 1u) * nx) xb_add(&bar[XB_TOPGEN], 1u);
            else XB_SPIN(xb_ld(&bar[XB_TOPGEN]) == tg, bar);
            __builtin_amdgcn_fence(__ATOMIC_ACQUIRE, "agent");
            xb_add(&bar[XB_XGEN(b.x)], 1u);
            asm volatile("s_waitcnt vmcnt(0)" ::: "memory");
        } else {
            XB_SPIN(xb_ld(&bar[XB_XGEN(b.x)]) == gen, bar);
            __builtin_amdgcn_fence(__ATOMIC_ACQUIRE, "agent");
            asm volatile("s_waitcnt vmcnt(0)" ::: "memory");
        }
    }
    __syncthreads();
}
constexpr int CW_BAR = 4096, CW_CONVQ = 96;

#define ACC8(ai, bj, m) {acc[ai][bj][m][0][0], acc[ai][bj][m][0][1], acc[ai][bj][m][0][2], acc[ai][bj][m][0][3], acc[ai][bj][m][1][0], acc[ai][bj][m][1][1], acc[ai][bj][m][1][2], acc[ai][bj][m][1][3]}
struct FastEpiMain {
    static constexpr bool PERM = true, KEEPS = false; EpiMain mn; EpiKV kv; float ascale;
    __device__ __forceinline__ bool keep_acc(const pg8::Unit&) const { return false; }
    __device__ __forceinline__ void operator()(f32x4 (&acc)[2][2][4][2], const pg8::Unit& u, int wr, int wc, int fr, int fq) const {
        asm volatile("" : "+v"(fr), "+v"(fq));
        const int rowb = u.row0 + wr * 64 + fr, colb = u.col0 + wc * 32 + 8 * fq;
        if (u.aux != 0) {
#pragma unroll
            for (int ai = 0; ai < 2; ++ai)
#pragma unroll
                for (int m = 0; m < 4; ++m)
#pragma unroll
                    for (int bj = 0; bj < 2; ++bj) { float v[8] = ACC8(ai, bj, m); kv(rowb + ai * 128 + m * 16, colb + bj * 128, v); }
            return;
        }
        f32x4 bb[2][2];
#pragma unroll
        for (int bj = 0; bj < 2; ++bj) { bb[bj][0] = *(const f32x4*)(mn.biasp + colb + bj * 128); bb[bj][1] = *(const f32x4*)(mn.biasp + colb + bj * 128 + 4); }
        float fpos[2][4];
#pragma unroll
        for (int ai = 0; ai < 2; ++ai)
#pragma unroll
            for (int m = 0; m < 4; ++m) fpos[ai][m] = 0.f;
        if (u.col0 < C_V) {
#pragma unroll
            for (int ai = 0; ai < 2; ++ai)
#pragma unroll
                for (int m = 0; m < 4; ++m) fpos[ai][m] = (float)mn.pos[mn.tok0 + rowb + ai * 128 + m * 16];
        }
        if (u.col0 >= C_GATE) {
            typedef float v2f_t __attribute__((ext_vector_type(2)));
            const float s2 = -1.4426950408889634f * ascale; v2f_t bp[2][4];
#pragma unroll
            for (int bj = 0; bj < 2; ++bj) { bp[bj][0] = (v2f_t){bb[bj][0].x, bb[bj][0].y} * -1.4426950408889634f; bp[bj][1] = (v2f_t){bb[bj][0].z, bb[bj][0].w} * -1.4426950408889634f;
                bp[bj][2] = (v2f_t){bb[bj][1].x, bb[bj][1].y} * -1.4426950408889634f; bp[bj][3] = (v2f_t){bb[bj][1].z, bb[bj][1].w} * -1.4426950408889634f; }
            unsigned char* gp = (unsigned char*)mn.GATES + (size_t)rowb * 3072 + (colb - C_GATE);
#pragma unroll
            for (int ai = 0; ai < 2; ++ai)
#pragma unroll
                for (int m = 0; m < 4; ++m)
#pragma unroll
                    for (int bj = 0; bj < 2; ++bj) { const f32x4 a0 = acc[ai][bj][m][0], a1 = acc[ai][bj][m][1];
                        const v2f_t t[4] = {__builtin_elementwise_fma((v2f_t){a0.x, a0.y}, (v2f_t){s2, s2}, bp[bj][0]), __builtin_elementwise_fma((v2f_t){a0.z, a0.w}, (v2f_t){s2, s2}, bp[bj][1]),
                                            __builtin_elementwise_fma((v2f_t){a1.x, a1.y}, (v2f_t){s2, s2}, bp[bj][2]), __builtin_elementwise_fma((v2f_t){a1.z, a1.w}, (v2f_t){s2, s2}, bp[bj][3])};
                        unsigned w[2] = {0u, 0u};
#pragma unroll
                        for (int q = 0; q < 4; ++q) { v2f_t r;
#pragma unroll
                            for (int e = 0; e < 2; ++e) r[e] = __builtin_amdgcn_rcpf(__builtin_amdgcn_fmed3f(__builtin_fmaf(__builtin_amdgcn_exp2f(t[q][e]), 1.0f / 255.0f, 1.0f / 255.0f), 0.0f, 1.0f));
                            r = r + (v2f_t){0.5f, 0.5f};
                            w[q >> 1] = __builtin_amdgcn_cvt_pk_u8_f32(r[0], 2 * (q & 1), w[q >> 1]); w[q >> 1] = __builtin_amdgcn_cvt_pk_u8_f32(r[1], 2 * (q & 1) + 1, w[q >> 1]); }
                        *(u32x2*)(gp + (size_t)(ai * 128 + m * 16) * 3072 + bj * 128) = (u32x2){w[0], w[1]}; }
            return;
        }
        float invrev[4]; EpiMain::rope_freqs(colb, invrev);
#define FEM_LOOP(S_) do { _Pragma("unroll") for (int ai = 0; ai < 2; ++ai) _Pragma("unroll") for (int m = 0; m < 4; ++m) _Pragma("unroll") for (int bj = 0; bj < 2; ++bj) { float v[8] = ACC8(ai, bj, m); \
            _Pragma("unroll") for (int q = 0; q < 8; ++q) v[q] *= ascale; \
            v[0] += bb[bj][0].x; v[1] += bb[bj][0].y; v[2] += bb[bj][0].z; v[3] += bb[bj][0].w; v[4] += bb[bj][1].x; v[5] += bb[bj][1].y; v[6] += bb[bj][1].z; v[7] += bb[bj][1].w; \
            mn.template finish_s<S_>(rowb + ai * 128 + m * 16, colb + bj * 128, v, fpos[ai][m], invrev); } } while (0)
        if (u.col0 < C_GLU) {
            typedef float v2f_t __attribute__((ext_vector_type(2)));
            const int sec = u.col0 / 1536, r0 = colb - sec * 1536, gh0 = (u.col0 - sec * 1536) >> 7, pcol = r0 & 127, g = gh0 >> 2, sh = 2 * g;
            const int bl = rowb >> 11, s0 = rowb & 2047;
            bf16_t* p0 = mn.QG + (size_t)sec * (SZ_QKV1 / 2) + ((size_t)(bl * 12 + gh0) * 2048 + rowperm(g, s0)) * 128 + pcol;
            asm volatile("" : "+v"(invrev[0]), "+v"(invrev[1]), "+v"(invrev[2]), "+v"(invrev[3]));
#define FEM_QKV(ROT) do { _Pragma("unroll") for (int ai = 0; ai < 2; ++ai) _Pragma("unroll") for (int m = 0; m < 4; ++m) { \
                v2f_t C_[2], S_[2]; \
                if (ROT) { float c4[4], s4[4]; _Pragma("unroll") for (int e = 0; e < 4; ++e) { const float rev = __builtin_amdgcn_fractf(fpos[ai][m] * invrev[e]); s4[e] = __builtin_amdgcn_sinf(rev); c4[e] = __builtin_amdgcn_cosf(rev); } \
                    C_[0] = (v2f_t){c4[0], c4[1]}; C_[1] = (v2f_t){c4[2], c4[3]}; S_[0] = (v2f_t){s4[0], s4[1]}; S_[1] = (v2f_t){s4[2], s4[3]}; } \
                bf16_t* pr = p0 + (size_t)((16 * m + 128 * ai) >> sh) * 128; \
                _Pragma("unroll") for (int bj = 0; bj < 2; ++bj) { const f32x4 a0 = acc[ai][bj][m][0], a1 = acc[ai][bj][m][1]; const v2f_t as2 = {ascale, ascale}; \
                    v2f_t X[2] = {__builtin_elementwise_fma((v2f_t){a0.x, a0.y}, as2, (v2f_t){bb[bj][0].x, bb[bj][0].y}), __builtin_elementwise_fma((v2f_t){a0.z, a0.w}, as2, (v2f_t){bb[bj][0].z, bb[bj][0].w})}; \
                    v2f_t Y[2] = {__builtin_elementwise_fma((v2f_t){a1.x, a1.y}, as2, (v2f_t){bb[bj][1].x, bb[bj][1].y}), __builtin_elementwise_fma((v2f_t){a1.z, a1.w}, as2, (v2f_t){bb[bj][1].z, bb[bj][1].w})}; \
                    if (ROT) { _Pragma("unroll") for (int h = 0; h < 2; ++h) { const v2f_t x_ = X[h], y_ = Y[h]; X[h] = __builtin_elementwise_fma(-y_, S_[h], x_ * C_[h]); Y[h] = __builtin_elementwise_fma(x_, S_[h], y_ * C_[h]); } } \
                    u32x4 o; o.x = pk2(X[0].x, X[0].y); o.y = pk2(X[1].x, X[1].y); o.z = pk2(Y[0].x, Y[0].y); o.w = pk2(Y[1].x, Y[1].y); \
                    *(u32x4*)(pr + (size_t)bj * (2048 * 128)) = o; } } } while (0)
            if (u.col0 < C_V) FEM_QKV(true); else FEM_QKV(false);
#undef FEM_QKV
            return;
        }
        if (u.col0 < C_QM) FEM_LOOP(2); else FEM_LOOP(3);
#undef FEM_LOOP
    }
};
struct FastEpiGates {
    static constexpr bool PERM = true, KEEPS = false; const float* biasp; bf16_t* GATES; float ascale;
    __device__ __forceinline__ bool keep_acc(const pg8::Unit&) const { return false; }
    __device__ __forceinline__ void operator()(f32x4 (&acc)[2][2][4][2], const pg8::Unit& u, int wr, int wc, int fr, int fq) const {
        asm volatile("" : "+v"(fr), "+v"(fq));
        const int rowb = u.row0 + wr * 64 + fr, colb = u.col0 + wc * 32 + 8 * fq;
        f32x4 bb[2][2];
#pragma unroll
        for (int bj = 0; bj < 2; ++bj) { bb[bj][0] = *(const f32x4*)(biasp + colb + bj * 128); bb[bj][1] = *(const f32x4*)(biasp + colb + bj * 128 + 4); }
#pragma unroll
        for (int ai = 0; ai < 2; ++ai)
#pragma unroll
            for (int m = 0; m < 4; ++m)
#pragma unroll
                for (int bj = 0; bj < 2; ++bj) { const f32x4 a = acc[ai][bj][m][0] * ascale + bb[bj][0], b = acc[ai][bj][m][1] * ascale + bb[bj][1];
                    u32x4 o; o.x = pk2(sigmoidf_(a.x), sigmoidf_(a.y)); o.y = pk2(sigmoidf_(a.z), sigmoidf_(a.w)); o.z = pk2(sigmoidf_(b.x), sigmoidf_(b.y)); o.w = pk2(sigmoidf_(b.z), sigmoidf_(b.w));
                    *(u32x4*)(GATES + (size_t)(rowb + ai * 128 + m * 16) * 3072 + (colb + bj * 128 - C_GATE)) = o; }
    }
};
constexpr float P4_ASCALE = P4_FP8 ? 1.0f / (O8_SCALE * W8_SCALE) : 1.0f;
struct FastEpiMerge {
    static constexpr bool PERM = true, KEEPS = true; const bf16_t* GATES; bf16_t* MERGED;
    __device__ __forceinline__ bool keep_acc(const pg8::Unit& u) const { return u.aux < 2; }
    __device__ __forceinline__ void operator()(f32x4 (&acc)[2][2][4][2], const pg8::Unit& u, int wr, int wc, int fr, int fq) const {
        asm volatile("" : "+v"(fr), "+v"(fq));
        const int rowb = u.row0 + wr * 64 + fr, colb = u.col0 + wc * 32 + 8 * fq, br = u.aux;
        const unsigned char* gp = (const unsigned char*)GATES + (size_t)rowb * 3072 + br * 1024 + colb;
        bf16_t* mp = MERGED + (size_t)rowb * 1024 + colb;
#pragma unroll
        for (int ai = 0; ai < 2; ++ai) {
            u32x2 tg[4][2], tn[4][2];
#pragma unroll
            for (int m = 0; m < 4; ++m)
#pragma unroll
                for (int bj = 0; bj < 2; ++bj) { tg[m][bj] = *(const u32x2*)(gp + (size_t)(ai * 128 + m * 16) * 3072 + bj * 128);
                    if (br < 2) tn[m][bj] = *(const u32x2*)(gp + 1024 + (size_t)(ai * 128 + m * 16) * 3072 + bj * 128); }
            if (br < 2) {
#pragma unroll
                for (int m = 0; m < 4; ++m)
#pragma unroll
                    for (int bj = 0; bj < 2; ++bj) { const u32x2 g = tg[m][bj], n = tn[m][bj]; const f32x4 n0 = u8x4_raw(n.x), n1 = u8x4_raw(n.y);
                        const f32x4 r0 = {__builtin_amdgcn_rcpf(n0.x), __builtin_amdgcn_rcpf(n0.y), __builtin_amdgcn_rcpf(n0.z), __builtin_amdgcn_rcpf(n0.w)}, r1 = {__builtin_amdgcn_rcpf(n1.x), __builtin_amdgcn_rcpf(n1.y), __builtin_amdgcn_rcpf(n1.z), __builtin_amdgcn_rcpf(n1.w)};
                        acc[ai][bj][m][0] = acc[ai][bj][m][0] * (u8x4_raw(g.x) * r0); acc[ai][bj][m][1] = acc[ai][bj][m][1] * (u8x4_raw(g.y) * r1); }
            } else {
#pragma unroll
                for (int m = 0; m < 4; ++m)
#pragma unroll
                    for (int bj = 0; bj < 2; ++bj) { const u32x2 g = tg[m][bj];
#if P5_FP8
                        const f32x4 a = acc[ai][bj][m][0] * (u8x4_raw(g.x) * (P4_ASCALE * M8_SCALE / 255.0f)), b = acc[ai][bj][m][1] * (u8x4_raw(g.y) * (P4_ASCALE * M8_SCALE / 255.0f));
                        u32x2 o; o.x = pk4_fp8(a.x, a.y, a.z, a.w); o.y = pk4_fp8(b.x, b.y, b.z, b.w);
                        *(u32x2*)((unsigned char*)MERGED + (size_t)(rowb + ai * 128 + m * 16) * 1024 + colb + bj * 128) = o;
#else
                        const f32x4 a = acc[ai][bj][m][0] * (u8x4_raw(g.x) * (P4_ASCALE / 255.0f)), b = acc[ai][bj][m][1] * (u8x4_raw(g.y) * (P4_ASCALE / 255.0f));
                        u32x4 o; o.x = pk2(a.x, a.y); o.y = pk2(a.z, a.w); o.z = pk2(b.x, b.y); o.w = pk2(b.z, b.w);
                        *(u32x4*)(mp + (size_t)(ai * 128 + m * 16) * 1024 + bj * 128) = o;
#endif
                    }
            }
            asm volatile("" ::: "memory");
        }
    }
};
struct FastEpiStore8 {
    static constexpr bool PERM = true, KEEPS = false; unsigned char* O; int ld; float scale;
    __device__ __forceinline__ bool keep_acc(const pg8::Unit&) const { return false; }
    __device__ __forceinline__ void operator()(f32x4 (&acc)[2][2][4][2], const pg8::Unit& u, int wr, int wc, int fr, int fq) const {
        asm volatile("" : "+v"(fr), "+v"(fq));
        const int rowb = u.row0 + wr * 64 + fr, colb = u.col0 + wc * 32 + 8 * fq;
#pragma unroll
        for (int ai = 0; ai < 2; ++ai)
#pragma unroll
            for (int m = 0; m < 4; ++m)
#pragma unroll
                for (int bj = 0; bj < 2; ++bj) { const f32x4 a = acc[ai][bj][m][0] * scale, b = acc[ai][bj][m][1] * scale;
                    u32x2 o; o.x = pk4_fp8s(a.x, a.y, a.z, a.w); o.y = pk4_fp8s(b.x, b.y, b.z, b.w);
                    *(u32x2*)(O + (size_t)(rowb + ai * 128 + m * 16) * ld + colb + bj * 128) = o; }
    }
};
struct FastEpiStore {
    static constexpr bool PERM = true, KEEPS = false; bf16_t* O; int ld; float scale;
    __device__ __forceinline__ bool keep_acc(const pg8::Unit&) const { return false; }
    __device__ __forceinline__ void operator()(f32x4 (&acc)[2][2][4][2], const pg8::Unit& u, int wr, int wc, int fr, int fq) const {
        asm volatile("" : "+v"(fr), "+v"(fq));
        const int rowb = u.row0 + wr * 64 + fr, colb = u.col0 + wc * 32 + 8 * fq;
#pragma unroll
        for (int ai = 0; ai < 2; ++ai)
#pragma unroll
            for (int m = 0; m < 4; ++m)
#pragma unroll
                for (int bj = 0; bj < 2; ++bj) { const f32x4 a = acc[ai][bj][m][0] * scale, b = acc[ai][bj][m][1] * scale;
                    u32x4 o; o.x = pk2(a.x, a.y); o.y = pk2(a.z, a.w); o.z = pk2(b.x, b.y); o.w = pk2(b.z, b.w);
                    *(u32x4*)(O + (size_t)(rowb + ai * 128 + m * 16) * ld + colb + bj * 128) = o; }
    }
};
struct FastEpiNull {
    static constexpr bool PERM = true, KEEPS = false; bf16_t* O;
    __device__ __forceinline__ bool keep_acc(const pg8::Unit&) const { return false; }
    __device__ __forceinline__ void operator()(f32x4 (&acc)[2][2][4][2], const pg8::Unit& u, int wr, int wc, int fr, int fq) const {
        float s = 0.f;
#pragma unroll
        for (int ai = 0; ai < 2; ++ai)
#pragma unroll
            for (int m = 0; m < 4; ++m)
#pragma unroll
                for (int bj = 0; bj < 2; ++bj) { const f32x4 a = acc[ai][bj][m][0], b = acc[ai][bj][m][1]; s += a.x + a.y + a.z + a.w + b.x + b.y + b.z + b.w; }
        if (s == 1.2345e38f) O[u.row0 + fr] = (bf16_t)1;
    }
};
struct FastEpiMoe1 {
    static constexpr bool PERM = true, KEEPS = false; LAS const int* toktab; const float* wts; unsigned char* H8;
    __device__ __forceinline__ bool keep_acc(const pg8::Unit&) const { return false; }
    __device__ __forceinline__ void operator()(f32x4 (&acc)[2][2][4][2], const pg8::Unit& u, int wr, int wc, int fr, int fq) const {
        asm volatile("" : "+v"(fr), "+v"(fq));
        const int rloc = wr * 64 + fr, colb = u.col0 + wc * 32 + 8 * fq, hi = u.col0 >> 10;
        float w[2][4];
#pragma unroll
        for (int ai = 0; ai < 2; ++ai)
#pragma unroll
            for (int m = 0; m < 4; ++m) { const int tok = toktab[u.aux * 256 + rloc + ai * 128 + m * 16]; w[ai][m] = wts[(size_t)tok * 2 + hi] * (H8_SCALE / W8_SCALE); }
        constexpr float inv = 1.0f / W8_SCALE;
#pragma unroll
        for (int ai = 0; ai < 2; ++ai)
#pragma unroll
            for (int m = 0; m < 4; ++m)
#pragma unroll
                for (int bj = 0; bj < 2; ++bj) { const f32x4 gt = acc[ai][bj][m][0] * inv, up = acc[ai][bj][m][1]; const float ww = w[ai][m];
                    const int j0 = hi * 512 + (((colb + bj * 128) & 1023) >> 1);
                    float h[4] = {gt.x * sigmoidf_(gt.x) * up.x * ww, gt.y * sigmoidf_(gt.y) * up.y * ww, gt.z * sigmoidf_(gt.z) * up.z * ww, gt.w * sigmoidf_(gt.w) * up.w * ww};
#pragma unroll
                    for (int q = 0; q < 4; ++q) h[q] = fminf(fmaxf(h[q], -448.f), 448.f);
                    *(unsigned*)(H8 + (size_t)(u.row0 + rloc + ai * 128 + m * 16) * 1024 + j0) = pk4_fp8(h[0], h[1], h[2], h[3]); }
    }
};
#undef ACC8

struct SchedMain {
    pg8::TileOrder to; int nkv, tile0, cut, skip; size_t astep, bstep; const char *XB, *WIN, *MEMB, *WKV;
    __device__ __forceinline__ bool next(int i, pg8::Unit& u) const {
        int pm, pn;
        if (to.tile(i, pm, pn)) { const int ct = tile0 + (pn < cut ? pn : pn + skip); u.A = XB + (size_t)pm * astep; u.B = WIN + (size_t)ct * bstep; u.row0 = pm * 256; u.col0 = ct * 256; u.bjump = 0; u.aux = 0; return true; }
        const long L = (long)i * to.G + to.c - to.nwg; if (L >= nkv) return false;
        pm = (int)(L >> 2); pn = (int)(L & 3);
        u.A = MEMB + (size_t)pm * 256 * 2048; u.B = WKV + (size_t)pn * 256 * 2048; u.row0 = pm * 256; u.col0 = pn * 256; u.bjump = 0; u.aux = 1; return true;
    }
};
struct SchedMerge {
    pg8::TileOrder to; const char *A0, *W;
    __device__ __forceinline__ bool next(int i, pg8::Unit& u) const {
        const int ti = i / 3, br = i - ti * 3; int pm, pn; if (!to.tile(ti, pm, pn)) return false;
        u.A = A0 + (size_t)br * SZ_512 + (size_t)pm * 256 * (P4_FP8 ? 512 : 1024); u.B = W + (size_t)br * MiB + (size_t)pn * 256 * (P4_FP8 ? 512 : 1024); u.row0 = pm * 256; u.col0 = pn * 256; u.bjump = 0; u.aux = br; return true;
    }
};
struct SchedPlain {
    pg8::TileOrder to; const char *A, *B; size_t astep, bstep;
    __device__ __forceinline__ bool next(int i, pg8::Unit& u) const {
        int pm, pn; if (!to.tile(i, pm, pn)) return false;
        u.A = A + (size_t)pm * astep; u.B = B + (size_t)pn * bstep; u.row0 = pm * 256; u.col0 = pn * 256; u.bjump = 0; u.aux = 0; return true;
    }
};
struct SchedMoe {
    pg8::TileOrder to; LAS const int* pan_cls; LAS const int* toktab; const char *H, *W1, *W2; int mode;
    __device__ __forceinline__ LAS const int* toks(int i) const { return toktab + i * 256; }
    __device__ __forceinline__ bool next(int i, pg8::Unit& u) const {
        int pm, pn; if (!to.tile(i, pm, pn)) return false;
        const int cls = pan_cls[pm]; int e_lo, e_hi; class_experts(cls, e_lo, e_hi);
        u.row0 = pm * 256; u.col0 = pn * 256; u.aux = i; u.bjump = 0;
        if (mode == 1) { u.A = nullptr; u.B = W1 + ((size_t)(pn < 4 ? e_lo : e_hi) * 1024 + (size_t)(pn & 3) * 256) * 1024; }
        else { u.A = H + (size_t)pm * 256 * 1024; u.B = W2 + (size_t)pn * 256 * 8192 + (size_t)e_lo * 512; u.bjump = (e_hi - e_lo - 1) * 512; }
        return true;
    }
};

template <int WHICH> __device__ __forceinline__ float tw_src(const Params& p, int k, int n) {
    if constexpr (WHICH == TW_IN) return p.w_in[(size_t)k * INC + win_logical(n)];
    else if constexpr (WHICH == TW_KV) return p.w_mem_kv[(size_t)k * 1024 + n];
    else if constexpr (WHICH == TW_A) return p.w_attn_o[(size_t)k * 1024 + n];
    else if constexpr (WHICH == TW_C) return p.w_conv_o[(size_t)k * 1024 + n];
    else if constexpr (WHICH == TW_M) return p.w_mem_o[(size_t)k * 1024 + n];
    else if constexpr (WHICH == TW_OUT) return p.w_out[(size_t)k * 1024 + n];
    else if constexpr (WHICH == TW_W1) { const int e = n >> 10, c = n & 1023, G = c >> 3, nn = (c >> 2) & 1, ee = c & 3, jj = 4 * G + ee; return (nn ? p.w_eu : p.w_eg)[((size_t)e * 1024 + k) * 512 + jj]; }
    else { const int e = n >> 10, c = n & 1023; return p.w_ed[((size_t)e * 512 + k) * 1024 + c]; }
}
template <int WHICH> __device__ __forceinline__ void tw_item(const Params& p, int item, float* scr, int lane) {
    constexpr int N = WHICH == TW_IN ? INC : (WHICH >= TW_W1 ? 16 * 1024 : 1024);
    constexpr int ldd = (WHICH == TW_A || WHICH == TW_C || WHICH == TW_M) ? 512 : (WHICH == TW_W2 ? 8192 : 1024);
    constexpr size_t dsto = WHICH == TW_IN ? WS_WIN : WHICH == TW_KV ? WS_WKV : WHICH == TW_A ? WS_WA : WHICH == TW_C ? WS_WC : WHICH == TW_M ? WS_WM : WHICH == TW_OUT ? WS_WOUT : WHICH == TW_W1 ? WS_W1 : WS_W2;
    bf16_t* dst = WSP(bf16_t, dsto);
    constexpr int nblk = N / 32; const int kb = item / nblk, nb = item - kb * nblk, k0 = 64 * kb, n0 = 32 * nb;
#pragma unroll 8
    for (int i = 0; i < 32; ++i) { const int kk = 2 * i + (lane >> 5); scr[kk * 33 + (lane & 31)] = tw_src<WHICH>(p, k0 + kk, n0 + (lane & 31)); }
    asm volatile("s_waitcnt lgkmcnt(0)" ::: "memory");
    const int c = lane & 7;
#pragma unroll
    for (int j = 0; j < 4; ++j) { const int n = (lane >> 3) + 8 * j; const float* sp = scr + (8 * c) * 33 + n;
        const int nn = n0 + n; size_t doff;
        if constexpr (WHICH == TW_W2) doff = (size_t)(nn & 1023) * 8192 + (size_t)(nn >> 10) * 512 + k0 + 8 * c; else doff = (size_t)nn * ldd + k0 + 8 * c;
        if constexpr (WHICH >= TW_W1 || (P5_FP8 && WHICH == TW_OUT) || (P4_FP8 && (WHICH == TW_A || WHICH == TW_C || WHICH == TW_M))) {
            u32x2 o; o.x = pk4_fp8(W8_SCALE * sp[0 * 33], W8_SCALE * sp[1 * 33], W8_SCALE * sp[2 * 33], W8_SCALE * sp[3 * 33]); o.y = pk4_fp8(W8_SCALE * sp[4 * 33], W8_SCALE * sp[5 * 33], W8_SCALE * sp[6 * 33], W8_SCALE * sp[7 * 33]);
            *(u32x2*)((unsigned char*)dst + doff) = o;
        } else {
            u32x4 o; o.x = pk2(sp[0 * 33], sp[1 * 33]); o.y = pk2(sp[2 * 33], sp[3 * 33]); o.z = pk2(sp[4 * 33], sp[5 * 33]); o.w = pk2(sp[6 * 33], sp[7 * 33]);
            *(u32x4*)(dst + doff) = o;
            if constexpr (WHICH == TW_IN && !P1_FP6) {
                u32x2 q; q.x = pk4_fp8(WG8_SCALE * sp[0 * 33], WG8_SCALE * sp[1 * 33], WG8_SCALE * sp[2 * 33], WG8_SCALE * sp[3 * 33]); q.y = pk4_fp8(WG8_SCALE * sp[4 * 33], WG8_SCALE * sp[5 * 33], WG8_SCALE * sp[6 * 33], WG8_SCALE * sp[7 * 33]);
                *(u32x2*)(p.ws + WS_WG8 + doff) = q; } } }
    if constexpr (WHICH == TW_IN && P1_FP6) {
        const int n = lane & 31, b = lane >> 5, blk = (k0 >> 5) + b, tt = blk >> 2, fq = blk & 3; float v[32];
#pragma unroll
        for (int j = 0; j < 32; ++j) v[j] = WG8_SCALE * scr[(32 * b + j) * 33 + n];
        const v6u_t q = pack32_fp6(v);
        unsigned char* wp = p.ws + WS_WG8 + (size_t)(n0 + n) * 1024 + tt * 128 + 16 * fq;
        *(u32x4*)wp = (u32x4){q[0], q[1], q[2], q[3]}; *(u32x4*)(wp + 64) = (u32x4){q[4], q[5], 0u, 0u};
    }
    asm volatile("s_waitcnt lgkmcnt(0)" ::: "memory");
}
__device__ __forceinline__ void transpose_all(const Params& p, float* scr, int gw, int ngw, int lane) {
    constexpr int I_IN = 16 * (INC / 32), I_KV = 16 * 32, I_B = 8 * 32, I_OUT = 16 * 32, I_W1 = 16 * 512, I_W2 = 8 * 512;
    constexpr int NITEMS = I_IN + I_KV + 3 * I_B + I_OUT + I_W1 + I_W2;
    for (int it = gw; it < NITEMS; it += ngw) {
        int r = it;
        if (r < I_W1) { tw_item<TW_W1>(p, r, scr, lane); continue; } r -= I_W1;
        if (r < I_IN) { tw_item<TW_IN>(p, r, scr, lane); continue; } r -= I_IN;
        if (r < I_W2) { tw_item<TW_W2>(p, r, scr, lane); continue; } r -= I_W2;
        if (r < I_KV) { tw_item<TW_KV>(p, r, scr, lane); continue; } r -= I_KV;
        if (r < I_OUT) { tw_item<TW_OUT>(p, r, scr, lane); continue; } r -= I_OUT;
        if (r < I_B) { tw_item<TW_A>(p, r, scr, lane); continue; } r -= I_B;
        if (r < I_B) { tw_item<TW_C>(p, r, scr, lane); continue; } r -= I_B;
        tw_item<TW_M>(p, r, scr, lane);
    }
}

__device__ __forceinline__ void cvt_bf16_dev(const float* __restrict__ src, bf16_t* __restrict__ dst, size_t n8, size_t gtid, size_t gstride) {
    for (size_t i = gtid; i < n8; i += gstride) {
        const f32x4 a = *(const f32x4*)(src + i * 8), b = *(const f32x4*)(src + i * 8 + 4);
        u32x4 o; o.x = pk2(a.x, a.y); o.y = pk2(a.z, a.w); o.z = pk2(b.x, b.y); o.w = pk2(b.z, b.w);
        *(u32x4*)(dst + i * 8) = o;
    }
}

__device__ __forceinline__ void cvt_x_dev(const float* __restrict__ src, bf16_t* __restrict__ dst, unsigned char* __restrict__ dst8, size_t n32, size_t gtid, size_t gstride) {
    for (size_t i = gtid; i < n32; i += gstride) {
        float v[32];
#pragma unroll
        for (int q = 0; q < 8; ++q) { const f32x4 a = *(const f32x4*)(src + i * 32 + 4 * q); v[4 * q] = a.x; v[4 * q + 1] = a.y; v[4 * q + 2] = a.z; v[4 * q + 3] = a.w; }
#pragma unroll
        for (int q = 0; q < 4; ++q) { u32x4 o; o.x = pk2(v[8 * q], v[8 * q + 1]); o.y = pk2(v[8 * q + 2], v[8 * q + 3]); o.z = pk2(v[8 * q + 4], v[8 * q + 5]); o.w = pk2(v[8 * q + 6], v[8 * q + 7]); *(u32x4*)(dst + i * 32 + 8 * q) = o; }
        if constexpr (P1_FP6) {
            const size_t row = i >> 5; const int blk = (int)(i & 31), tt = blk >> 2, fq = blk & 3; const v6u_t q6 = pack32_fp6(v);
            unsigned char* xp = dst8 + row * 1024 + tt * 128 + 16 * fq;
            *(u32x4*)xp = (u32x4){q6[0], q6[1], q6[2], q6[3]}; *(u32x4*)(xp + 64) = (u32x4){q6[4], q6[5], 0u, 0u};
        } else {
#pragma unroll
            for (int q = 0; q < 2; ++q) { u32x4 q8; q8.x = pk4_fp8(v[16 * q], v[16 * q + 1], v[16 * q + 2], v[16 * q + 3]); q8.y = pk4_fp8(v[16 * q + 4], v[16 * q + 5], v[16 * q + 6], v[16 * q + 7]);
                q8.z = pk4_fp8(v[16 * q + 8], v[16 * q + 9], v[16 * q + 10], v[16 * q + 11]); q8.w = pk4_fp8(v[16 * q + 12], v[16 * q + 13], v[16 * q + 14], v[16 * q + 15]); *(u32x4*)(dst8 + i * 32 + 16 * q) = q8; }
        }
    }
}
__device__ __forceinline__ void wg8_dev(const Params& p, size_t gtid, size_t gstride) {
    for (size_t i = gtid; i < (size_t)INC * 64; i += gstride) { const int n = (int)(i % INC), k0 = (int)(i / INC) * 16, nl = win_logical(n); float v[16];
#pragma unroll
        for (int j = 0; j < 16; ++j) v[j] = WG8_SCALE * p.w_in[(size_t)(k0 + j) * INC + nl];
        u32x4 q; q.x = pk4_fp8(v[0], v[1], v[2], v[3]); q.y = pk4_fp8(v[4], v[5], v[6], v[7]); q.z = pk4_fp8(v[8], v[9], v[10], v[11]); q.w = pk4_fp8(v[12], v[13], v[14], v[15]);
        *(u32x4*)(p.ws + WS_WG8 + (size_t)n * 1024 + k0) = q; }
}

#ifndef STAG_US
#define STAG_US 0
#endif
__device__ __forceinline__ void delay_us(int us) { const unsigned long long t0 = __builtin_amdgcn_s_memrealtime(); while (__builtin_amdgcn_s_memrealtime() - t0 < (unsigned long long)us * 100ull) __builtin_amdgcn_s_sleep(16); }

struct Args { Params p; int ph_lo, ph_hi; };
typedef const __attribute__((address_space(4))) unsigned long long* KArgPtr;
__device__ __forceinline__ Params load_params(KArgPtr q) {
    asm volatile("" : "+s"(q));
    Params p;
    p.x = (const float*)(const GAS float*)q[0]; p.mem = (const float*)(const GAS float*)q[1]; p.pos = (const int*)(const GAS int*)q[2]; p.w_in = (const float*)(const GAS float*)q[3]; p.b_in = (const float*)(const GAS float*)q[4]; p.conv_w = (const float*)(const GAS float*)q[5]; p.conv_b = (const float*)(const GAS float*)q[6];
    p.conv_g = (const float*)(const GAS float*)q[7]; p.conv_bb = (const float*)(const GAS float*)q[8]; p.w_mem_kv = (const float*)(const GAS float*)q[9]; p.w_attn_o = (const float*)(const GAS float*)q[10]; p.w_conv_o = (const float*)(const GAS float*)q[11]; p.w_mem_o = (const float*)(const GAS float*)q[12];
    p.w_out = (const float*)(const GAS float*)q[13]; p.ln1_g = (const float*)(const GAS float*)q[14]; p.ln1_b = (const float*)(const GAS float*)q[15]; p.w_gr = (const float*)(const GAS float*)q[16]; p.b_gr = (const float*)(const GAS float*)q[17]; p.w_er = (const float*)(const GAS float*)q[18]; p.b_er = (const float*)(const GAS float*)q[19];
    p.w_eg = (const float*)(const GAS float*)q[20]; p.w_eu = (const float*)(const GAS float*)q[21]; p.w_ed = (const float*)(const GAS float*)q[22]; p.ln2_g = (const float*)(const GAS float*)q[23]; p.ln2_b = (const float*)(const GAS float*)q[24]; p.out = (float*)(GAS float*)q[25]; p.ws = (unsigned char*)(GAS unsigned char*)q[26];
    return p;
}
static_assert(sizeof(Params) == 27 * 8, "Params is 27 pointers");
constexpr int PH_P0 = 0, PH_CH0 = 1, PH_PER_CH = 5, PH_LN1 = PH_CH0 + PH_PER_CH * NCH, PH_MOE1 = PH_LN1 + 1, PH_MOE2 = PH_LN1 + 2, PH_LN2 = PH_LN1 + 3, PH_END = PH_LN1 + 4;

__global__ void __launch_bounds__(NTHR, 2) mk_fwd(Args args) {
    extern __shared__ __attribute__((aligned(16))) unsigned char lds_raw[];
    LAS unsigned char* lds = (LAS unsigned char*)lds_raw;
    const KArgPtr kargs = (KArgPtr)__builtin_amdgcn_kernarg_segment_ptr();
    const int wave = __builtin_amdgcn_readfirstlane((int)threadIdx.x >> 6);
    const int G = gridDim.x; const int bx = blockIdx.x; const int vcu = (G % 8 == 0) ? (bx % 8) * (G / 8) + bx / 8 : bx;
    volatile LAS unsigned* MISC = (volatile LAS unsigned*)(lds + LCTL_OFF);
    ClassTab* tab = (ClassTab*)(lds_raw + LCTL_OFF + 256);
    int* pan_cls = (int*)(lds_raw + LCTL_OFF + 512);
    int* toktab = (int*)(lds_raw + LTOK_OFF);
    for (int u = threadIdx.x; u < (LDS_BYTES - LCTL_OFF) / 4; u += NTHR) ((LAS unsigned*)(lds + LCTL_OFF))[u] = 0u;
    __syncthreads();
    const int lo = args.ph_lo, hi = args.ph_hi;
    unsigned* ctl; { const Params p = load_params(kargs); ctl = WSP(unsigned, WS_CTL); }
    XcdBarrier bar; bar.bar = ctl + CW_BAR; bar.x = 0; bar.st = nullptr;
    if (hi - lo > 1) bar = xcd_barrier_post(ctl + CW_BAR, MISC);
#ifndef PHMASK
#define PHMASK 0x3ff
#endif
#ifndef P1_QK_FP8
#define P1_QK_FP8 2
#endif
#if P1_QK_FP8 == 3
constexpr int P1_BF16_TILES = 4, P1_BF16_T0 = 18, P1_BF16_CUT = 4, P1_BF16_SKIP = 0, P1_FP8_TILES = 32, P1_FP8_T0 = 0, P1_FP8_CUT = 18, P1_FP8_SKIP = 4;
#elif P1_QK_FP8 == 2
constexpr int P1_BF16_TILES = 0, P1_BF16_T0 = 0, P1_BF16_CUT = 0, P1_BF16_SKIP = 0, P1_FP8_TILES = 36, P1_FP8_T0 = 0, P1_FP8_CUT = 36, P1_FP8_SKIP = 0;
#elif P1_QK_FP8
constexpr int P1_BF16_TILES = 6, P1_BF16_T0 = 18, P1_BF16_CUT = 6, P1_BF16_SKIP = 0, P1_FP8_TILES = 30, P1_FP8_T0 = 0, P1_FP8_CUT = 18, P1_FP8_SKIP = 6;
#else
constexpr int P1_BF16_TILES = 18, P1_BF16_T0 = 0, P1_BF16_CUT = 12, P1_BF16_SKIP = 6, P1_FP8_TILES = 18, P1_FP8_T0 = 12, P1_FP8_CUT = 6, P1_FP8_SKIP = 6;
#endif
#ifndef ATTN_V2
#define ATTN_V2 1
#endif
#ifndef PROBE_DUP
#define PROBE_DUP (-1)
#endif
#define NREP(b) ((PROBE_DUP == (b)) ? 2 : 1)
#define IN(k) (lo <= (k) && (k) < hi)
#define HAS(b) ((PHMASK >> (b)) & 1)
#define SEAM(k) do { if (IN(k) && IN((k) + 1)) xcd_barrier(bar); } while (0)

    if (HAS(0) && IN(PH_P0)) {
        const Params p = load_params(kargs);
        const size_t gtid = (size_t)bx * NTHR + opaque_tid(wave), gstride = (size_t)G * NTHR;
        for (int rep = 0; rep < NREP(0); ++rep) {
        { const int ptid = opaque_tid(wave); transpose_all(p, (float*)(lds_raw + RING_OFF) + (ptid >> 6) * (64 * 33), bx * NWAVES + (ptid >> 6), G * NWAVES, ptid & 63); }
        small_prep_dev(p, gtid, gstride);
        cvt_bf16_dev(p.mem, WSP(bf16_t, WS_MEMB), (size_t)NB * MEML * 1024 / 8, gtid, gstride);
        cvt_x_dev(p.x, WSP(bf16_t, WS_XB), p.ws + WS_XB8, (size_t)T * 1024 / 32, gtid, gstride);
        }
    }
    SEAM(PH_P0);
    if (PROBE_DUP == 10 && hi - lo > 1) for (int r = 0; r < 16; ++r) xcd_barrier(bar);

    for (int ch = 0; ch < NCH; ++ch) {
        const int ph0 = PH_CH0 + PH_PER_CH * ch;
        if (HAS(1) && IN(ph0)) {
            const Params p = load_params(kargs);
            const EpiMain em{WSP(float, WS_BIASP), p.pos, WSP(bf16_t, WS_QG), WSP(bf16_t, WS_CGLU), WSP(bf16_t, WS_QM), WSP(bf16_t, WS_GATES), ch * TC};
            for (int rep = 0; rep < NREP(1); ++rep) {
            {
                SchedMain S; S.to.init(TC / 256, P1_BF16_TILES, G, bx); S.nkv = ch == 0 ? (NB * MEML / 256) * 4 : 0; S.tile0 = P1_BF16_T0; S.cut = P1_BF16_CUT; S.skip = P1_BF16_SKIP; S.astep = 256 * 2048; S.bstep = 256 * 2048;
                S.XB = (const char*)(WSP(bf16_t, WS_XB) + (size_t)ch * TC * 1024); S.WIN = (const char*)WSP(bf16_t, WS_WIN); S.MEMB = (const char*)WSP(bf16_t, WS_MEMB); S.WKV = (const char*)WSP(bf16_t, WS_WKV);
                FastEpiMain E{em, EpiKV{WSP(bf16_t, WS_KM)}, 1.0f};
#ifndef NO_P1A
                pg8::gemm_phase<FastEpiMain, SchedMain, true, false, false>(lds + RING_OFF, nullptr, 1024, 1024, 1024, S, E, wave);
#endif
                if (PROBE_DUP == 16) { FastEpiStore E2{WSP(bf16_t, WS_MERGED), 1024, 1.0f}; pg8::gemm_phase<FastEpiStore, SchedMain, true, false, false>(lds + RING_OFF, nullptr, 1024, 1024, 1024, S, E2, wave); }
            }
            {
                SchedMain S; S.to.init(TC / 256, P1_FP8_TILES, G, bx); S.nkv = 0; S.tile0 = P1_FP8_T0; S.cut = P1_FP8_CUT; S.skip = P1_FP8_SKIP; S.astep = 256 * 1024; S.bstep = 256 * 1024;
                S.XB = (const char*)(p.ws + WS_XB8 + (size_t)ch * TC * 1024); S.WIN = (const char*)(p.ws + WS_WG8); S.MEMB = nullptr; S.WKV = nullptr;
                FastEpiMain E{em, EpiKV{WSP(bf16_t, WS_KM)}, 1.0f / WG8_SCALE};
#ifndef NO_P1B
                if (STAG_US > 0 && ((bx >> 3) & 1)) delay_us(STAG_US);
                pg8::gemm_phase<FastEpiMain, SchedMain, true, false, false, P1_FP6 ? 2 : 1>(lds + RING_OFF, nullptr, 512, 512, 512, S, E, wave);
#endif
                if (PROBE_DUP == 17) { FastEpiStore E2{WSP(bf16_t, WS_MERGED), 1024, 1.0f}; pg8::gemm_phase<FastEpiStore, SchedMain, true, false, false, true>(lds + RING_OFF, nullptr, 512, 512, 512, S, E2, wave); }
                if (PROBE_DUP == 19 || PROBE_DUP == 20) { SchedMain S2 = S; S2.bstep = 0; if (PROBE_DUP == 20) S2.astep = 0; FastEpiNull E2{WSP(bf16_t, WS_MERGED)}; pg8::gemm_phase<FastEpiNull, SchedMain, true, false, false, true>(lds + RING_OFF, nullptr, 512, 512, 512, S2, E2, wave); }
                if (PROBE_DUP == 21) { SchedMain S2 = S; S2.bstep = 0; S2.astep = 0; FastEpiNull E2{WSP(bf16_t, WS_MERGED)}; pg8::gemm_phase<FastEpiNull, SchedMain, true, false, false, true>(lds + RING_OFF, nullptr, 512, 512, 256, S2, E2, wave); }
                if (PROBE_DUP == 22) { SchedMain S2 = S; S2.bstep = 0; S2.astep = 0; FastEpiNull E2{WSP(bf16_t, WS_MERGED)}; pg8::gemm_phase<FastEpiNull, SchedMain, true, false, false, 3>(lds + RING_OFF, nullptr, 512, 512, 512, S2, E2, wave); }
                if (PROBE_DUP == 18) { FastEpiNull E2{WSP(bf16_t, WS_MERGED)}; pg8::gemm_phase<FastEpiNull, SchedMain, true, false, false, true>(lds + RING_OFF, nullptr, 512, 512, 512, S, E2, wave); }
            }
            }
        }
        SEAM(ph0);
        if (HAS(2) && IN(ph0 + 1)) {
            const Params p = load_params(kargs);
            constexpr int NDIL = BC * 12 * 8, NMEMB = BC * 4 * 8, NBLK = NDIL + NMEMB;
#if ATTN_V2
            for (int rep = 0; rep < NREP(2); ++rep) {
            const bool dummy = (PROBE_DUP == 2) && rep == 0;
            LAS char* rlds = (LAS char*)(lds + RING_OFF); LAS float* scr = (LAS float*)(lds + LTOK_OFF);
            if (wave >= 4) __builtin_amdgcn_s_setprio(1);
            for (int hd = vcu; hd < BC * 16; hd += G) {
                if (hd < BC * 12) { const int g = (hd % 12) >> 2; const size_t base = (size_t)hd * 2048 * 128;
                    swa::head_dilated(WSP(bf16_t, WS_QG) + base, dummy ? WSP(bf16_t, WS_MERGED) + (size_t)(hd & 127) * 2048 * 128 : WSP(bf16_t, WS_QG) + base, WSP(bf16_t, WS_KG) + base, WSP(bf16_t, WS_VG) + base, WSP(float, WS_LSE) + (size_t)hd * 2048, (2048 >> (2 * g)) - 1, rlds, scr, wave);
                } else { const int bh = hd - BC * 12, bl = bh >> 2, h = bh & 3; const size_t kvb = (size_t)(ch * BC * 4 + bh) * 256 * 128;
                    swa::head_mem(WSP(bf16_t, WS_QM) + (size_t)bh * 2048 * 128, WSP(bf16_t, WS_KM) + kvb, WSP(bf16_t, WS_VM) + kvb, (bf16_t*)(p.ws + WS_OMT + (P4_FP8 ? 1 : 2) * ((size_t)bl * 2048 * 512 + h * 128)), 512, rlds, scr, wave); }
            }
            __builtin_amdgcn_s_setprio(0);
            __syncthreads();
            }
            {
                const Params pc = load_params(kargs); const int ptid = opaque_tid(wave); volatile LAS unsigned* qslot = MISC + 4;
                for (;;) {
                    if (ptid == 0) *qslot = atomicAdd(ctl + CW_CONVQ + ch, 1u);
                    __syncthreads();
                    const int u = (int)*qslot;
                    if (u >= BC * 64) break;
                    conv_unit(pc, u, lds_raw + RING_OFF, ptid);
                }
            }
        }
#else
            for (int rep = 0; rep < NREP(2); ++rep) {
            const bool dummy = (PROBE_DUP == 2) && rep == 0;
            auto make_ref = [&](int L) -> swa::BlockRef {
                swa::BlockRef r;
                if (L < NDIL) { const int bgh = L >> 3, qb = L & 7, g = (bgh % 12) >> 2; const size_t base = (size_t)bgh * 2048 * 128;
                    r.Q = WSP(bf16_t, WS_QG) + base + (size_t)qb * 256 * 128; r.K = WSP(bf16_t, WS_KG) + base; r.V = WSP(bf16_t, WS_VG) + base; r.O = dummy ? WSP(bf16_t, WS_MERGED) + (base % (SZ_XB / 2 - 65536)) : (bf16_t*)r.Q;
                    r.LSE = WSP(float, WS_LSE) + (size_t)bgh * 2048 + qb * 256; r.P0 = qb * 256; r.W = 129; r.segmask = (2048 >> (2 * g)) - 1; r.skv = 2048; r.ostride = 128; }
                else { const int idx = L - NDIL, bh = idx >> 3, qb = idx & 7, bl = bh >> 2, h = bh & 3; const size_t kvb = (size_t)(ch * BC * 4 + bh) * 256 * 128;
                    r.Q = WSP(bf16_t, WS_QM) + ((size_t)bh * 2048 + qb * 256) * 128; r.K = WSP(bf16_t, WS_KM) + kvb; r.V = WSP(bf16_t, WS_VM) + kvb;
                    r.O = WSP(bf16_t, WS_OMT) + ((size_t)bl * 2048 + qb * 256) * 512 + h * 128; r.LSE = nullptr; r.P0 = 256; r.W = 1 << 20; r.segmask = (1 << 20) - 1; r.skv = 256; r.ostride = 512; }
                return r; };
            int L = vcu;
            if (L < NBLK) {
                swa::BlockRef cur = make_ref(L); swa::Seam Sm;
                swa::prime(cur, (char*)lds_raw + RING_OFF, Sm, wave);
                for (;;) {
                    const bool more = L + G < NBLK; const int Ln = more ? L + G : L;
                    const swa::BlockRef nxt = more ? make_ref(Ln) : cur;
                    swa::block(cur, nxt, (char*)lds_raw + RING_OFF, Sm, wave);
                    if (!more) break;
                    cur = nxt; L = Ln;
                }
            }
            __syncthreads();
            { const Params pc = load_params(kargs); const int ptid = opaque_tid(wave); for (int u = bx; u < BC * 64; u += G) conv_unit(pc, u, lds_raw + RING_OFF, ptid); }
            if (PROBE_DUP == 13) { const int ptid = opaque_tid(wave); for (int u = bx; u < BC * 64; u += G) conv_unit(p, u, lds_raw + RING_OFF, ptid); }
            if (PROBE_DUP == 14) {
                int L = NDIL + vcu;
                if (L < NBLK) { swa::BlockRef cur = make_ref(L); swa::Seam Sm; swa::prime(cur, (char*)lds_raw + RING_OFF, Sm, wave);
                    for (;;) { const bool more = L + G < NBLK; const int Ln = more ? L + G : L; const swa::BlockRef nxt = more ? make_ref(Ln) : cur; swa::block(cur, nxt, (char*)lds_raw + RING_OFF, Sm, wave); if (!more) break; cur = nxt; L = Ln; } }
                __syncthreads();
            }
            }
        }
#endif
        SEAM(ph0 + 1);
        if (HAS(3) && IN(ph0 + 2)) { const Params p = load_params(kargs); const int ptid = opaque_tid(wave); for (int rep = 0; rep < NREP(3); ++rep) for (int w = bx * NWAVES + (ptid >> 6); w < TC; w += 2 * G * NWAVES) { if (w + G * NWAVES < TC) combine_token2(p, w, w + G * NWAVES, ptid & 63); else if (O_FP8 && P4_FP8) combine_token2(p, w, w, ptid & 63); else combine_token(p, w, ptid & 63); } }
        SEAM(ph0 + 2);
        if (HAS(4) && IN(ph0 + 3)) {
            const Params p = load_params(kargs);
            SchedMerge S; S.to.init(TC / 256, 4, G, bx); S.A0 = (const char*)WSP(bf16_t, WS_OATT); S.W = (const char*)WSP(bf16_t, WS_WA);
            FastEpiMerge E{WSP(bf16_t, WS_GATES), WSP(bf16_t, WS_MERGED)};
            if (PROBE_DUP == 15) { FastEpiStore E2{WSP(bf16_t, WS_MERGED), 1024, 1.0f}; pg8::gemm_phase<FastEpiStore, SchedMerge, true, false, false>(lds + RING_OFF, nullptr, 512, 512, 512, S, E2, wave); }
#if P4_FP8
            for (int rep = 0; rep < NREP(4); ++rep) pg8::gemm_phase<FastEpiMerge, SchedMerge, true, false, false, 1>(lds + RING_OFF, nullptr, 256, 256, 256, S, E, wave);
#else
            for (int rep = 0; rep < NREP(4); ++rep) pg8::gemm_phase<FastEpiMerge, SchedMerge, true, false, false>(lds + RING_OFF, nullptr, 512, 512, 512, S, E, wave);
#endif
        }
        SEAM(ph0 + 3);
        if (HAS(5) && IN(ph0 + 4)) {
            const Params p = load_params(kargs);
#if P5_FP8
            SchedPlain S; S.to.init(TC / 256, 4, G, bx); S.A = (const char*)WSP(bf16_t, WS_MERGED); S.B = (const char*)WSP(bf16_t, WS_WOUT); S.astep = 256 * 1024; S.bstep = 256 * 1024;
            FastEpiStore E{(bf16_t*)p.out + (size_t)ch * TC * 1024, 1024, 1.0f / (M8_SCALE * W8_SCALE)};
            for (int rep = 0; rep < NREP(5); ++rep) pg8::gemm_phase<FastEpiStore, SchedPlain, true, false, false, 1>(lds + RING_OFF, nullptr, 512, 512, 512, S, E, wave);
#else
            SchedPlain S; S.to.init(TC / 256, 4, G, bx); S.A = (const char*)WSP(bf16_t, WS_MERGED); S.B = (const char*)WSP(bf16_t, WS_WOUT); S.astep = 256 * 2048; S.bstep = 256 * 2048;
            FastEpiStore E{(bf16_t*)p.out + (size_t)ch * TC * 1024, 1024, 1.0f};
            for (int rep = 0; rep < NREP(5); ++rep) pg8::gemm_phase<FastEpiStore, SchedPlain, true, false, false>(lds + RING_OFF, nullptr, 1024, 1024, 1024, S, E, wave);
#endif
        }
        SEAM(ph0 + 4);
    }

    if (HAS(6) && IN(PH_LN1)) {
        const Params p = load_params(kargs);
        float* wr = (float*)(lds_raw + RING_OFF); int* cls_l = (int*)(wr + 20 * 1024); int* misc = cls_l + 64;
        for (int i = opaque_tid(wave); i < 20 * 1024; i += NTHR) wr[i] = WSP(float, WS_WRT)[i];
        __syncthreads();
        { for (int rep = 0; rep < NREP(6); ++rep) for (int u = bx; u < T / 64; u += G) { const int ptid = opaque_tid(wave); ln1_unit16(p, u, wr, cls_l, misc, ptid, (PROBE_DUP == 6) && rep == 0); } }
    }
    SEAM(PH_LN1);
    if (IN(PH_MOE1) || IN(PH_MOE2) || IN(PH_LN2)) {
        const int tid = opaque_tid(wave);
        if (tid == 0) class_tab_fill(ctl + CW_CNT, tab);
        __syncthreads();
        const int NP = tab->rowbase[NCLS] >> 8;
        for (int pm = tid; pm < NP; pm += NTHR) pan_cls[pm] = find_class(tab, pm * 256);
        __syncthreads();
    }
    if (HAS(7) && IN(PH_MOE1)) {
        const Params p = load_params(kargs);
        const int NP = tab->rowbase[NCLS] >> 8;
        SchedMoe S; S.to.init(NP, 8, G, bx); S.pan_cls = (LAS const int*)(lds + LCTL_OFF + 512); S.toktab = (LAS const int*)(lds + LTOK_OFF); S.H = nullptr; S.W1 = (const char*)WSP(bf16_t, WS_W1); S.W2 = nullptr; S.mode = 1;
        const int tid = opaque_tid(wave);
        for (int i = 0; i < MAXU; ++i) { int pm, pn; if (!S.to.tile(i, pm, pn)) break;
            if (tid < 256) { const int cls = pan_cls[pm]; int r = pm * 256 + tid - tab->rowbase[cls]; if (r >= tab->cnt[cls]) r = tab->cnt[cls] - 1; toktab[i * 256 + tid] = WSP(int, WS_LIST)[(size_t)cls * T + r]; } }
        __syncthreads();
        FastEpiMoe1 E{(LAS const int*)(lds + LTOK_OFF), WSP(float, WS_WTS), p.ws + WS_H};
        for (int rep = 0; rep < NREP(7); ++rep) pg8::gemm_phase<FastEpiMoe1, SchedMoe, true, true, false, true>(lds + RING_OFF, (const char*)(p.ws + WS_X1B8), 512, 512, 512, S, E, wave);
    }
    SEAM(PH_MOE1);
    if (HAS(8) && IN(PH_MOE2)) {
        const Params p = load_params(kargs);
        const int NP = tab->rowbase[NCLS] >> 8;
        SchedMoe S; S.to.init(NP, 4, G, bx); S.pan_cls = (LAS const int*)(lds + LCTL_OFF + 512); S.toktab = (LAS const int*)(lds + LTOK_OFF); S.H = (const char*)WSP(bf16_t, WS_H); S.W1 = nullptr; S.W2 = (const char*)WSP(bf16_t, WS_W2); S.mode = 2;
#if Y2_FP8
        FastEpiStore8 E{p.ws + WS_Y2, 1024, Y8_SCALE / (H8_SCALE * W8_SCALE)};
        for (int rep = 0; rep < NREP(8); ++rep) pg8::gemm_phase<FastEpiStore8, SchedMoe, true, false, true, true>(lds + RING_OFF, nullptr, 512, 4096, 512, S, E, wave);
#else
        FastEpiStore E{WSP(bf16_t, WS_Y2), 1024, 1.0f / (H8_SCALE * W8_SCALE)};
        for (int rep = 0; rep < NREP(8); ++rep) pg8::gemm_phase<FastEpiStore, SchedMoe, true, false, true, true>(lds + RING_OFF, nullptr, 512, 4096, 512, S, E, wave);
#endif
    }
    SEAM(PH_MOE2);
    if (HAS(9) && IN(PH_LN2)) {
        const Params p = load_params(kargs);
        const int tot = tab->rowbase[NCLS]; const int lane = opaque_tid(wave) & 63;
        for (int rep = 0; rep < NREP(9); ++rep)
        for (int prow = bx * NWAVES + wave; prow < tot; prow += 2 * G * NWAVES) {
            int tk[2], pr[2];
#pragma unroll
            for (int r = 0; r < 2; ++r) { pr[r] = prow + r * G * NWAVES; tk[r] = -1;
                if (pr[r] < tot) { const int cls = pan_cls[pr[r] >> 8]; const int i = pr[r] - tab->rowbase[cls]; if (i < tab->cnt[cls]) tk[r] = WSP(int, WS_LIST)[(size_t)cls * T + i]; } }
            ln2_rows<2>(p, tk, pr, lane, ((PROBE_DUP == 9) && rep == 0) ? (float*)(p.ws + 512 * MiB) : nullptr);
        }
    }
#undef IN
#undef HAS
#undef SEAM
}

#ifndef MK_MODE
#define MK_MODE 3
#endif
extern "C" void kernel_launch(void* const* d_in, const int* in_sizes, int n_in, void* d_out, int out_size, void* d_ws, size_t ws_size, hipStream_t stream) {
    if (n_in != 25 || ws_size < WS_END) { fprintf(stderr, "kernel_launch: unexpected n_in %d / ws_size %zu (need %zu)\n", n_in, ws_size, (size_t)WS_END); return; }
    static int grid = 0;
    if (grid == 0) {
        (void)hipFuncSetAttribute((const void*)k_ln1, hipFuncAttributeMaxDynamicSharedMemorySize, 20 * 1024 * 4 + 1024);
        if (hipFuncSetAttribute((const void*)mk_fwd, hipFuncAttributeMaxDynamicSharedMemorySize, LDS_BYTES) != hipSuccess) fprintf(stderr, "kernel_launch: hipFuncSetAttribute(mk_fwd, %d) failed\n", LDS_BYTES);
        int dev = 0, cus = 0; (void)hipGetDevice(&dev);
        if (hipDeviceGetAttribute(&cus, hipDeviceAttributeMultiprocessorCount, dev) != hipSuccess || cus <= 0) cus = 256;
        int per_cu = 0; (void)hipOccupancyMaxActiveBlocksPerMultiprocessor(&per_cu, (const void*)mk_fwd, NTHR, LDS_BYTES);
        if (per_cu < 1) fprintf(stderr, "kernel_launch: occupancy query reports %d blocks per CU for mk_fwd\n", per_cu);
        (void)hipGetLastError();
        grid = cus;
    }
    Params p{};
    p.x = (const float*)d_in[0]; p.mem = (const float*)d_in[1]; p.pos = (const int*)d_in[2];
    p.w_in = (const float*)d_in[3]; p.b_in = (const float*)d_in[4]; p.conv_w = (const float*)d_in[5]; p.conv_b = (const float*)d_in[6];
    p.conv_g = (const float*)d_in[7]; p.conv_bb = (const float*)d_in[8]; p.w_mem_kv = (const float*)d_in[9]; p.w_attn_o = (const float*)d_in[10];
    p.w_conv_o = (const float*)d_in[11]; p.w_mem_o = (const float*)d_in[12]; p.w_out = (const float*)d_in[13]; p.ln1_g = (const float*)d_in[14]; p.ln1_b = (const float*)d_in[15];
    p.w_gr = (const float*)d_in[16]; p.b_gr = (const float*)d_in[17]; p.w_er = (const float*)d_in[18]; p.b_er = (const float*)d_in[19];
    p.w_eg = (const float*)d_in[20]; p.w_eu = (const float*)d_in[21]; p.w_ed = (const float*)d_in[22]; p.ln2_g = (const float*)d_in[23]; p.ln2_b = (const float*)d_in[24];
    p.out = (float*)d_out; p.ws = (unsigned char*)d_ws;
    (void)hipMemsetAsync((char*)d_ws + WS_CTL, 0, CTL_BYTES, stream);
#if PROBE_DUP == 12
    (void)hipMemsetAsync((char*)d_ws + 944 * MiB, 0, 64 * MiB, stream);
#endif
    auto mk = [&](int lo, int hi) { Args a{}; a.p = p; a.ph_lo = lo; a.ph_hi = hi; hipLaunchKernelGGL(mk_fwd, dim3(grid), dim3(NTHR), LDS_BYTES, stream, a); };
#if MK_MODE == 3
    mk(0, PH_END);
#elif MK_MODE == 2
    for (int ph = 0; ph < PH_END; ++ph) mk(ph, ph + 1);
#elif MK_MODE == 1
    mk(PH_P0, PH_P0 + 1);
    for (int ch = 0; ch < NCH; ++ch) {
        const int ph0 = PH_CH0 + PH_PER_CH * ch;
        mk(ph0, ph0 + 1);
        k_nattn_dil<<<BC * 12 * 2048 / 4, 256, 0, stream>>>(p);
        k_nattn_mem<<<BC * 4 * 2048 / 4, 256, 0, stream>>>(p, ch);
        k_conv<<<BC * 64, 512, 0, stream>>>(p);
        mk(ph0 + 2, ph0 + 3); mk(ph0 + 3, ph0 + 4); mk(ph0 + 4, ph0 + 5);
    }
    mk(PH_LN1, PH_LN1 + 1); mk(PH_MOE1, PH_MOE1 + 1); mk(PH_MOE2, PH_MOE2 + 1); mk(PH_LN2, PH_LN2 + 1);
#else
    for (int w = 0; w < 8; ++w) k_transpose_w<<<2048, 256, 0, stream>>>(p, w);
    k_small_prep<<<(20 * 1024 + 255) / 256, 256, 0, stream>>>(p);
    k_cvt_bf16<<<2048, 256, 0, stream>>>(p.mem, (bf16_t*)((char*)d_ws + WS_MEMB), (size_t)NB * MEML * 1024 / 8);
    k_cvt_bf16<<<4096, 256, 0, stream>>>(p.x, (bf16_t*)((char*)d_ws + WS_XB), (size_t)T * 1024 / 8);
    k_ngemm_kv<<<dim3(1024 / 64, NB * MEML / 64), 256, 0, stream>>>(p, 0);
    for (int ch = 0; ch < NCH; ++ch) {
        k_ngemm_main<<<dim3(INC / 64, TC / 64), 256, 0, stream>>>(p, ch);
        k_nattn_dil<<<BC * 12 * 2048 / 4, 256, 0, stream>>>(p);
        k_nattn_mem<<<BC * 4 * 2048 / 4, 256, 0, stream>>>(p, ch);
        k_conv<<<BC * 64, 512, 0, stream>>>(p);
        k_combine<<<TC / 4, 256, 0, stream>>>(p);
        for (int br = 0; br < 3; ++br) k_ngemm_merge<<<dim3(1024 / 64, TC / 64), 256, 0, stream>>>(p, br);
        k_ngemm_mix<<<dim3(1024 / 64, TC / 64), 256, 0, stream>>>(p, ch);
    }
    k_ln1<<<256, 512, 20 * 1024 * 4 + 1024, stream>>>(p);
    k_ngemm_moe1<<<dim3(2048 / 64, MPAD / 64), 256, 0, stream>>>(p);
    k_ngemm_moe2<<<dim3(1024 / 64, MPAD / 64), 256, 0, stream>>>(p);
    k_ln2<<<MPAD / 4, 256, 0, stream>>>(p);
#endif
}
```

```cpp
#include <hip/hip_runtime.h>
#include <cstdio>
#include <cstdint>

constexpr int D = 1024, NB = 32, S = 2048, T = NB * S;
constexpr int NCH = 2, BC = NB / NCH, TC = T / NCH;
constexpr int INC = 9216;
constexpr int MEML = 256;
constexpr int NCLS = 24;
constexpr int MPAD = T + NCLS * 256;
constexpr float LN_EPS = 1e-5f;
constexpr float DN_ALPHA = 1.189207115002721f;
constexpr float ATT_SCALE = 0.08838834764831845f;

constexpr int C_Q = 0, C_K = 1536, C_V = 3072, C_GLU = 4608, C_QM = 5632, C_GATE = 6144;

constexpr size_t MiB = 1ull << 20;
constexpr size_t WS_CTL = 0, CTL_BYTES = 1 * MiB;
constexpr size_t WS_WIN = 1 * MiB;
constexpr size_t WS_BIASP = 19 * MiB;
constexpr size_t WS_WRT = 19 * MiB + 64 * 1024;
constexpr size_t WS_WKV = 20 * MiB;
constexpr size_t WS_WA = 22 * MiB, WS_WC = 23 * MiB, WS_WM = 24 * MiB;
constexpr size_t WS_WOUT = 25 * MiB;
constexpr size_t WS_W1 = 27 * MiB;
constexpr size_t WS_W2 = 59 * MiB;
constexpr size_t WS_MEMB = 75 * MiB;
constexpr size_t WS_CH = 91 * MiB;
constexpr size_t SZ_XB = (size_t)TC * 1024 * 2, SZ_QKV1 = (size_t)TC * 1536 * 2, SZ_512 = (size_t)TC * 512 * 2;
constexpr size_t WS_XB = WS_CH;
constexpr size_t WS_QG = WS_XB + (size_t)T * 1024 * 2, WS_KG = WS_QG + SZ_QKV1, WS_VG = WS_KG + SZ_QKV1;
constexpr size_t WS_CGLU = WS_VG + SZ_QKV1, WS_QM = WS_CGLU + SZ_512, WS_OATT = WS_QM + SZ_512, WS_CCONV = WS_OATT + SZ_512, WS_OMT = WS_CCONV + SZ_512;
constexpr size_t WS_GATES = WS_OMT + SZ_512;
constexpr size_t SZ_KM = (size_t)NB * 4 * MEML * 128 * 2;
constexpr size_t WS_KM = WS_GATES + (size_t)TC * 3072 * 2, WS_VM = WS_KM + SZ_KM;
constexpr size_t WS_LSE = WS_VM + SZ_KM;
constexpr size_t WS_MERGED = WS_LSE + 2 * MiB;
constexpr size_t WS_CH_END = WS_MERGED + SZ_XB;
constexpr size_t WS_X1B = WS_CH;
constexpr size_t WS_H = WS_X1B + (size_t)T * 1024 * 2;
constexpr size_t WS_Y2 = WS_H + (size_t)MPAD * 1024 * 2;
constexpr size_t WS_LIST = WS_Y2 + (size_t)MPAD * 1024 * 2;
constexpr size_t WS_WTS = WS_LIST + (size_t)NCLS * T * 4;
constexpr size_t WS_X1B8 = WS_WTS + (size_t)T * 8;
constexpr size_t WS_MOE_END = WS_X1B8 + (size_t)T * 1024;
#ifndef P5_FP8
#define P5_FP8 1
#endif
#ifndef QKV_FP8
#define QKV_FP8 1
#endif
#ifndef O_FP8
#define O_FP8 1
#endif
#ifndef Y2_FP8
#define Y2_FP8 1
#endif
constexpr float Y8_SCALE = 16.0f;
#ifndef P4_FP8
#define P4_FP8 1
#endif
constexpr float O8_SCALE = 16.0f;
constexpr float M8_SCALE = 16.0f;
constexpr float W8_SCALE = 32.0f, H8_SCALE = 16.0f;
constexpr size_t WS_END = WS_CH_END > WS_MOE_END ? WS_CH_END : WS_MOE_END;
constexpr size_t WS_XB8 = 944 * MiB;
constexpr size_t WS_WG8 = 1008 * MiB;
constexpr float WG8_SCALE = 32.0f;
static_assert(WS_CH_END <= WS_XB8 && WS_WG8 + 9 * MiB <= 1024 * MiB, "fp8 operand buffers");
static_assert(WS_END <= 1024 * MiB, "workspace map exceeds 1 GiB");
constexpr int CW_CNT = 64;

typedef unsigned short bf16_t;
typedef float f32x4 __attribute__((ext_vector_type(4)));
typedef unsigned u32x4 __attribute__((ext_vector_type(4)));
typedef unsigned u32x2 __attribute__((ext_vector_type(2)));

__device__ __forceinline__ float bf2f(bf16_t b) { return __uint_as_float(((unsigned)b) << 16); }
__device__ __forceinline__ float bflo(unsigned w) { return __uint_as_float(w << 16); }
__device__ __forceinline__ float bfhi(unsigned w) { return __uint_as_float(w & 0xffff0000u); }
__device__ __forceinline__ unsigned f2bf(float f) { unsigned u = __float_as_uint(f); return (u + 0x7fffu + ((u >> 16) & 1u)) >> 16; }
typedef float f32x2_t __attribute__((ext_vector_type(2)));
typedef __bf16 bf16x2_t __attribute__((ext_vector_type(2)));
__device__ __forceinline__ unsigned pk2(float lo, float hi) { f32x2_t v = {lo, hi}; bf16x2_t b = __builtin_convertvector(v, bf16x2_t); return __builtin_bit_cast(unsigned, b); }
__device__ __forceinline__ float sigmoidf_(float x) { return __builtin_amdgcn_rcpf(1.0f + __builtin_amdgcn_exp2f(-1.4426950408889634f * x)); }
__device__ __forceinline__ float wave_sum(float v) {
#define DPP_F(x, ctrl) __int_as_float(__builtin_amdgcn_update_dpp(0, __float_as_int(x), ctrl, 0xf, 0xf, true))
    v += DPP_F(v, 0xB1);
    v += DPP_F(v, 0x4E);
    v += DPP_F(v, 0x141);
    v += DPP_F(v, 0x140);
#undef DPP_F
    { const auto r = __builtin_amdgcn_permlane16_swap(__float_as_uint(v), __float_as_uint(v), false, false); v = __uint_as_float(r[0]) + __uint_as_float(r[1]); }
    { const auto r = __builtin_amdgcn_permlane32_swap(__float_as_uint(v), __float_as_uint(v), false, false); v = __uint_as_float(r[0]) + __uint_as_float(r[1]); }
    return v;
}
__device__ __forceinline__ float wave_max(float v) {
#pragma unroll
    for (int o = 1; o < 64; o <<= 1) v = fmaxf(v, __shfl_xor(v, o));
    return v;
}
__device__ __forceinline__ unsigned pk4_fp8(float a, float b, float c, float d) { unsigned w = 0; w = __builtin_amdgcn_cvt_pk_fp8_f32(a, b, w, false); w = __builtin_amdgcn_cvt_pk_fp8_f32(c, d, w, true); return w; }
__device__ __forceinline__ unsigned pk4_fp8s(float a, float b, float c, float d) { return pk4_fp8(__builtin_amdgcn_fmed3f(a, -448.f, 448.f), __builtin_amdgcn_fmed3f(b, -448.f, 448.f), __builtin_amdgcn_fmed3f(c, -448.f, 448.f), __builtin_amdgcn_fmed3f(d, -448.f, 448.f)); }
__device__ __forceinline__ unsigned pk4_u8(float a, float b, float c, float d) {
    const unsigned ua = (unsigned)fmaxf(__builtin_rintf(a * 255.f), 1.f), ub = (unsigned)fmaxf(__builtin_rintf(b * 255.f), 1.f), uc = (unsigned)fmaxf(__builtin_rintf(c * 255.f), 1.f), ud = (unsigned)fmaxf(__builtin_rintf(d * 255.f), 1.f);
    return ua | (ub << 8) | (uc << 16) | (ud << 24); }
__device__ __forceinline__ float sig255(float x) { const float e = __builtin_amdgcn_exp2f(-1.4426950408889634f * x); return fmaxf(__builtin_rintf(__builtin_amdgcn_rcpf(__builtin_fmaf(e, 1.0f / 255.0f, 1.0f / 255.0f))), 1.0f); }
__device__ __forceinline__ unsigned pk4_sig_u8(float a, float b, float c, float d) { unsigned w = 0u;
    w = __builtin_amdgcn_cvt_pk_u8_f32(sig255(a), 0, w); w = __builtin_amdgcn_cvt_pk_u8_f32(sig255(b), 1, w); w = __builtin_amdgcn_cvt_pk_u8_f32(sig255(c), 2, w); w = __builtin_amdgcn_cvt_pk_u8_f32(sig255(d), 3, w); return w; }
__device__ __forceinline__ f32x4 u8x4_raw(unsigned w) { return (f32x4){(float)(w & 255u), (float)((w >> 8) & 255u), (float)((w >> 16) & 255u), (float)(w >> 24)}; }
__device__ __forceinline__ f32x4 u8x4_to_f32(unsigned w) { return (f32x4){(float)(w & 255u), (float)((w >> 8) & 255u), (float)((w >> 16) & 255u), (float)(w >> 24)} * (1.0f / 255.0f); }
#ifndef P1_FP6
#define P1_FP6 0
#endif
typedef float v16f_t __attribute__((ext_vector_type(16)));
typedef unsigned v6u_t __attribute__((ext_vector_type(6)));
__device__ __forceinline__ v6u_t pack32_fp6(const float (&v)[32]) {
    v16f_t a, b;
#pragma unroll
    for (int i = 0; i < 16; ++i) { a[i] = fminf(fmaxf(v[i], -7.5f), 7.5f); b[i] = fminf(fmaxf(v[16 + i], -7.5f), 7.5f); }
    return __builtin_amdgcn_cvt_scalef32_2xpk16_fp6_f32(a, b, 1.0f);
}
__device__ __forceinline__ int opaque_tid(int wave_s) { unsigned z = 0u; asm volatile("" : "+v"(z)); const int l = (int)__builtin_amdgcn_mbcnt_hi(~0u, __builtin_amdgcn_mbcnt_lo(~0u, z)); return (wave_s << 6) | l; }
__device__ __forceinline__ void rope_cs(float pos, int j, float& c, float& s) {
    const float invrev = __builtin_amdgcn_exp2f(-(float)j * (13.287712379549449f / 64.0f)) * 0.15915494309189535f;
    float rev = pos * invrev; rev = __builtin_amdgcn_fractf(rev);
    s = __builtin_amdgcn_sinf(rev); c = __builtin_amdgcn_cosf(rev);
}
__device__ __forceinline__ int rowperm(int g, int s) { return g == 0 ? s : (g == 1 ? ((s & 3) * 512 + (s >> 2)) : ((s & 15) * 128 + (s >> 4))); }
__host__ __device__ __forceinline__ int win_logical(int n) {
    if (n < C_V) { const int sec = n / 1536, r = n % 1536, gh = r / 128, p = r % 128, G = p >> 3, nn = (p >> 2) & 1, e = p & 3; return sec * 1536 + gh * 128 + 64 * nn + 4 * G + e; }
    if (n < C_GLU) return n;
    if (n < C_QM) { const int cc = n - C_GLU, G = cc >> 3, nn = (cc >> 2) & 1, e = cc & 3; return C_GLU + nn * 512 + 4 * G + e; }
    return n;
}

struct Params {
    const float *x, *mem; const int* pos;
    const float *w_in, *b_in, *conv_w, *conv_b, *conv_g, *conv_bb, *w_mem_kv, *w_attn_o, *w_conv_o, *w_mem_o, *w_out, *ln1_g, *ln1_b;
    const float *w_gr, *b_gr, *w_er, *b_er, *w_eg, *w_eu, *w_ed, *ln2_g, *ln2_b;
    float* out; unsigned char* ws;
};
#define WSP(T_, off) ((T_*)(p.ws + (off)))

__global__ void k_cvt_bf16(const float* __restrict__ src, bf16_t* __restrict__ dst, size_t n8) {
    for (size_t i = (size_t)blockIdx.x * blockDim.x + threadIdx.x; i < n8; i += (size_t)gridDim.x * blockDim.x) {
        const f32x4 a = *(const f32x4*)(src + i * 8), b = *(const f32x4*)(src + i * 8 + 4);
        u32x4 o; o.x = pk2(a.x, a.y); o.y = pk2(a.z, a.w); o.z = pk2(b.x, b.y); o.w = pk2(b.z, b.w);
        *(u32x4*)(dst + i * 8) = o;
    }
}
enum { TW_IN = 0, TW_KV, TW_A, TW_C, TW_M, TW_OUT, TW_W1, TW_W2 };
__device__ __forceinline__ void transpose_w_dev(const Params& p, int which, size_t gtid, size_t gstride) {
    int K, N, ldd; bf16_t* dst;
    switch (which) {
        case TW_IN: K = 1024; N = INC; ldd = 1024; dst = WSP(bf16_t, WS_WIN); break;
        case TW_KV: K = 1024; N = 1024; ldd = 1024; dst = WSP(bf16_t, WS_WKV); break;
        case TW_A: K = 512; N = 1024; ldd = 512; dst = WSP(bf16_t, WS_WA); break;
        case TW_C: K = 512; N = 1024; ldd = 512; dst = WSP(bf16_t, WS_WC); break;
        case TW_M: K = 512; N = 1024; ldd = 512; dst = WSP(bf16_t, WS_WM); break;
        case TW_OUT: K = 1024; N = 1024; ldd = 1024; dst = WSP(bf16_t, WS_WOUT); break;
        case TW_W1: K = 1024; N = 16 * 1024; ldd = 1024; dst = WSP(bf16_t, WS_W1); break;
        default: K = 512; N = 16 * 1024; ldd = 8192; dst = WSP(bf16_t, WS_W2); break;
    }
    const size_t total = (size_t)N * (K / 8);
    for (size_t i = gtid; i < total; i += gstride) {
        const int n = (int)(i % N), k0 = (int)(i / N) * 8;
        float v[8];
#pragma unroll
        for (int j = 0; j < 8; ++j) {
            const int k = k0 + j; float s;
            switch (which) {
                case TW_IN: s = p.w_in[(size_t)k * INC + win_logical(n)]; break;
                case TW_KV: s = p.w_mem_kv[(size_t)k * 1024 + n]; break;
                case TW_A: s = p.w_attn_o[(size_t)k * 1024 + n]; break;
                case TW_C: s = p.w_conv_o[(size_t)k * 1024 + n]; break;
                case TW_M: s = p.w_mem_o[(size_t)k * 1024 + n]; break;
                case TW_OUT: s = p.w_out[(size_t)k * 1024 + n]; break;
                case TW_W1: { const int e = n >> 10, c = n & 1023, G = c >> 3, nn = (c >> 2) & 1, ee = c & 3, jj = 4 * G + ee;
                              s = (nn ? p.w_eu : p.w_eg)[((size_t)e * 1024 + k) * 512 + jj]; } break;
                default: { const int e = n >> 10, c = n & 1023; s = p.w_ed[((size_t)e * 512 + k) * 1024 + c]; } break;
            }
            v[j] = s;
        }
        u32x4 o; o.x = pk2(v[0], v[1]); o.y = pk2(v[2], v[3]); o.z = pk2(v[4], v[5]); o.w = pk2(v[6], v[7]);
        size_t doff;
        if (which == TW_W2) { const int e = n >> 10, c = n & 1023; doff = (size_t)c * 8192 + e * 512 + k0; }
        else doff = (size_t)n * ldd + k0;
        *(u32x4*)(dst + doff) = o;
    }
}
__global__ void k_transpose_w(Params p, int which) { transpose_w_dev(p, which, (size_t)blockIdx.x * blockDim.x + threadIdx.x, (size_t)gridDim.x * blockDim.x); }
__device__ __forceinline__ void small_prep_dev(const Params& p, size_t gtid, size_t gstride) {
    for (size_t ii = gtid; ii < 20 * 1024; ii += gstride) { const int i = (int)ii;
        if (i < INC) WSP(float, WS_BIASP)[i] = p.b_in[win_logical(i)];
        const int e = i >> 10, k = i & 1023;
        WSP(float, WS_WRT)[i] = e < 4 ? p.w_gr[k * 4 + e] : p.w_er[((size_t)((e - 4) >> 2) * 1024 + k) * 4 + ((e - 4) & 3)]; }
}
__global__ void k_small_prep(Params p) { small_prep_dev(p, (size_t)blockIdx.x * blockDim.x + threadIdx.x, (size_t)gridDim.x * blockDim.x); }

struct EpiMain {
    const float* biasp; const int* pos; bf16_t *QG, *CGLU, *QM, *GATES; int tok0;
    static __device__ __forceinline__ void rope_freqs(int c0, float (&invrev)[4]) {
        const int j0 = ((c0 & 127) >> 3) * 4;
#pragma unroll
        for (int e = 0; e < 4; ++e) invrev[e] = __builtin_amdgcn_exp2f(-(float)(j0 + e) * (13.287712379549449f / 64.0f)) * 0.15915494309189535f;
    }
    template <int S> __device__ __forceinline__ void finish_s(int rl, int c0, float (&v)[8], float fpos, const float (&invrev)[4]) const {
        const int bl = rl >> 11, s = rl & 2047;
        if constexpr (S <= 1) {
            const int tcol = __builtin_amdgcn_readfirstlane(c0 & ~255);
            const int sec = tcol / 1536, r = c0 - sec * 1536, gh = r >> 7, pcol = r & 127, g = gh >> 2;
            if constexpr (S == 0) {
#pragma unroll
                for (int e = 0; e < 4; ++e) { const float rev = __builtin_amdgcn_fractf(fpos * invrev[e]); const float sn = __builtin_amdgcn_sinf(rev), c = __builtin_amdgcn_cosf(rev);
                    const float t1 = v[e], t2 = v[4 + e]; v[e] = t1 * c - t2 * sn; v[4 + e] = t2 * c + t1 * sn; }
            }
            bf16_t* base = QG + (size_t)sec * (SZ_QKV1 / 2);
            u32x4 o; o.x = pk2(v[0], v[1]); o.y = pk2(v[2], v[3]); o.z = pk2(v[4], v[5]); o.w = pk2(v[6], v[7]);
            *(u32x4*)(base + ((size_t)(bl * 12 + gh) * 2048 + rowperm(g, s)) * 128 + pcol) = o;
        } else if constexpr (S == 2) {
            const int j0 = (c0 - C_GLU) >> 1;
            u32x2 o; o.x = pk2(v[0] * sigmoidf_(v[4]), v[1] * sigmoidf_(v[5])); o.y = pk2(v[2] * sigmoidf_(v[6]), v[3] * sigmoidf_(v[7]));
            *(u32x2*)(CGLU + (size_t)rl * 512 + j0) = o;
        } else {
            const int cc = c0 - C_QM, h = cc >> 7, pcol = cc & 127;
            u32x4 o; o.x = pk2(v[0], v[1]); o.y = pk2(v[2], v[3]); o.z = pk2(v[4], v[5]); o.w = pk2(v[6], v[7]);
            *(u32x4*)(QM + ((size_t)(bl * 4 + h) * 2048 + s) * 128 + pcol) = o;
        }
    }
    __device__ __forceinline__ void finish(int rl, int c0, float (&v)[8], float fpos, const float (&invrev)[4]) const {
        const int bl = rl >> 11, s = rl & 2047;
        const int tcol = __builtin_amdgcn_readfirstlane(c0 & ~255);
        if (tcol < C_GLU) {
            const int sec = tcol / 1536, r = c0 - sec * 1536, gh = r >> 7, pcol = r & 127, g = gh >> 2;
            if (sec < 2) {
#pragma unroll
                for (int e = 0; e < 4; ++e) { const float rev = __builtin_amdgcn_fractf(fpos * invrev[e]); const float sn = __builtin_amdgcn_sinf(rev), c = __builtin_amdgcn_cosf(rev);
                    const float t1 = v[e], t2 = v[4 + e]; v[e] = t1 * c - t2 * sn; v[4 + e] = t2 * c + t1 * sn; }
            }
            bf16_t* base = QG + (size_t)sec * (SZ_QKV1 / 2);
            u32x4 o; o.x = pk2(v[0], v[1]); o.y = pk2(v[2], v[3]); o.z = pk2(v[4], v[5]); o.w = pk2(v[6], v[7]);
            *(u32x4*)(base + ((size_t)(bl * 12 + gh) * 2048 + rowperm(g, s)) * 128 + pcol) = o;
        } else if (tcol < C_QM) {
            const int j0 = (c0 - C_GLU) >> 1;
            u32x2 o; o.x = pk2(v[0] * sigmoidf_(v[4]), v[1] * sigmoidf_(v[5])); o.y = pk2(v[2] * sigmoidf_(v[6]), v[3] * sigmoidf_(v[7]));
            *(u32x2*)(CGLU + (size_t)rl * 512 + j0) = o;
        } else if (tcol < C_GATE) {
            const int cc = c0 - C_QM, h = cc >> 7, pcol = cc & 127;
            u32x4 o; o.x = pk2(v[0], v[1]); o.y = pk2(v[2], v[3]); o.z = pk2(v[4], v[5]); o.w = pk2(v[6], v[7]);
            *(u32x4*)(QM + ((size_t)(bl * 4 + h) * 2048 + s) * 128 + pcol) = o;
        } else {
            const int cc = c0 - C_GATE;
            u32x2 o; o.x = pk4_sig_u8(v[0], v[1], v[2], v[3]); o.y = pk4_sig_u8(v[4], v[5], v[6], v[7]);
            *(u32x2*)((unsigned char*)GATES + (size_t)rl * 3072 + cc) = o;
        }
    }
    __device__ __forceinline__ void operator()(int rl, int c0, float (&v)[8]) const {
        const f32x4 b0 = *(const f32x4*)(biasp + c0), b1 = *(const f32x4*)(biasp + c0 + 4);
        v[0] += b0.x; v[1] += b0.y; v[2] += b0.z; v[3] += b0.w; v[4] += b1.x; v[5] += b1.y; v[6] += b1.z; v[7] += b1.w;
        float invrev[4]; rope_freqs(c0, invrev);
        finish(rl, c0, v, c0 < C_V ? (float)pos[tok0 + rl] : 0.f, invrev);
    }
};
struct EpiKV {
    bf16_t *KM;
    __device__ __forceinline__ void operator()(int row, int c0, float (&v)[8]) const {
        const int bl = row >> 8, m = row & 255, isv = c0 >> 9, cc = c0 & 511, h = cc >> 7, pcol = cc & 127;
        u32x4 o; o.x = pk2(v[0], v[1]); o.y = pk2(v[2], v[3]); o.z = pk2(v[4], v[5]); o.w = pk2(v[6], v[7]);
        *(u32x4*)(KM + (size_t)isv * (SZ_KM / 2) + ((size_t)(bl * 4 + h) * 256 + m) * 128 + pcol) = o;
    }
};
struct EpiMerge {
    const bf16_t* GATES; bf16_t* MERGED; int br;
    __device__ __forceinline__ void operator()(int rl, int c0, float (&v)[8]) const {
        const u32x2 g = *(const u32x2*)((const unsigned char*)GATES + (size_t)rl * 3072 + br * 1024 + c0);
        const f32x4 g0 = u8x4_to_f32(g.x), g1 = u8x4_to_f32(g.y);
        float r[8] = {g0.x * v[0], g0.y * v[1], g0.z * v[2], g0.w * v[3], g1.x * v[4], g1.y * v[5], g1.z * v[6], g1.w * v[7]};
        bf16_t* mp = MERGED + (size_t)rl * 1024 + c0;
        if (br > 0) { const u32x4 m = *(const u32x4*)mp; r[0] += bflo(m.x); r[1] += bfhi(m.x); r[2] += bflo(m.y); r[3] += bfhi(m.y); r[4] += bflo(m.z); r[5] += bfhi(m.z); r[6] += bflo(m.w); r[7] += bfhi(m.w); }
        u32x4 o; o.x = pk2(r[0], r[1]); o.y = pk2(r[2], r[3]); o.z = pk2(r[4], r[5]); o.w = pk2(r[6], r[7]);
        *(u32x4*)mp = o;
    }
};
struct EpiMix {
    bf16_t* MIX; int tok0;
    __device__ __forceinline__ void operator()(int rl, int c0, float (&v)[8]) const {
        u32x4 o; o.x = pk2(v[0], v[1]); o.y = pk2(v[2], v[3]); o.z = pk2(v[4], v[5]); o.w = pk2(v[6], v[7]);
        *(u32x4*)(MIX + (size_t)(tok0 + rl) * 1024 + c0) = o;
    }
};
struct ClassTab { int cnt[NCLS], rowbase[NCLS + 1]; };
__device__ __forceinline__ void class_tab_fill(const unsigned* cntw, ClassTab* t) {
    int acc = 0;
    for (int c = 0; c < NCLS; ++c) { const int n = (int)cntw[c]; t->cnt[c] = n; t->rowbase[c] = acc; acc += ((n + 255) >> 8) << 8; }
    t->rowbase[NCLS] = acc;
}
__device__ __forceinline__ void class_experts(int cls, int& e_lo, int& e_hi) {
    const int g = cls / 6, pi = cls - g * 6;
    const int lo = pi < 3 ? 0 : (pi < 5 ? 1 : 2), hi = pi < 3 ? pi + 1 : (pi < 5 ? pi - 1 : 3);
    e_lo = g * 4 + lo; e_hi = g * 4 + hi;
}
struct EpiMoe1 {
    const int* list; const float* wts; bf16_t* H; int cls, cnt, rowbase;
    __device__ __forceinline__ void operator()(int prow, int c0, float (&v)[8]) const {
        int i = prow - rowbase; if (i >= cnt) i = cnt - 1;
        const int tok = list[i]; const int hi = c0 >> 10; const float w = wts[(size_t)tok * 2 + hi];
        const int j0 = hi * 512 + ((c0 & 1023) >> 1);
        float r[4];
#pragma unroll
        for (int e = 0; e < 4; ++e) { const float gt = v[e]; r[e] = gt * sigmoidf_(gt) * v[4 + e] * w; }
        u32x2 o; o.x = pk2(r[0], r[1]); o.y = pk2(r[2], r[3]);
        *(u32x2*)(H + (size_t)prow * 1024 + j0) = o;
    }
};
struct EpiMoe2 {
    bf16_t* Y2;
    __device__ __forceinline__ void operator()(int prow, int c0, float (&v)[8]) const {
        u32x4 o; o.x = pk2(v[0], v[1]); o.y = pk2(v[2], v[3]); o.z = pk2(v[4], v[5]); o.w = pk2(v[6], v[7]);
        *(u32x4*)(Y2 + (size_t)prow * 1024 + c0) = o;
    }
};

struct RowsPlain { const bf16_t* base; int ld; __device__ __forceinline__ const bf16_t* operator()(int r) const { return base + (size_t)r * ld; } };
template <class AF, class BF, class EF>
__device__ __forceinline__ void ngemm_tile(int row0, int col0, int K, const AF& af, const BF& bf, const EF& ef, int bkseg, long bjump) {
    __shared__ float As[64][33], Bs[64][33];
    const int tid = threadIdx.x, ty = tid >> 3, tx = tid & 7;
    float acc[2][8];
#pragma unroll
    for (int i = 0; i < 2; ++i)
#pragma unroll
        for (int j = 0; j < 8; ++j) acc[i][j] = 0.f;
    const int lr = tid >> 2, lk = (tid & 3) * 8;
    const bf16_t* ap = af(row0 + lr); const bf16_t* bp = bf(col0 + lr);
    for (int k0 = 0; k0 < K; k0 += 32) {
        const u32x4 a = *(const u32x4*)(ap + k0 + lk);
        const long bo = (long)k0 + lk + (long)(k0 / bkseg) * bjump;
        const u32x4 b = *(const u32x4*)(bp + bo);
        __syncthreads();
        As[lr][lk + 0] = bflo(a.x); As[lr][lk + 1] = bfhi(a.x); As[lr][lk + 2] = bflo(a.y); As[lr][lk + 3] = bfhi(a.y);
        As[lr][lk + 4] = bflo(a.z); As[lr][lk + 5] = bfhi(a.z); As[lr][lk + 6] = bflo(a.w); As[lr][lk + 7] = bfhi(a.w);
        Bs[lr][lk + 0] = bflo(b.x); Bs[lr][lk + 1] = bfhi(b.x); Bs[lr][lk + 2] = bflo(b.y); Bs[lr][lk + 3] = bfhi(b.y);
        Bs[lr][lk + 4] = bflo(b.z); Bs[lr][lk + 5] = bfhi(b.z); Bs[lr][lk + 6] = bflo(b.w); Bs[lr][lk + 7] = bfhi(b.w);
        __syncthreads();
#pragma unroll 8
        for (int kk = 0; kk < 32; ++kk) {
            const float a0 = As[2 * ty][kk], a1 = As[2 * ty + 1][kk];
#pragma unroll
            for (int j = 0; j < 8; ++j) { const float bv = Bs[8 * tx + j][kk]; acc[0][j] += a0 * bv; acc[1][j] += a1 * bv; }
        }
    }
    ef(row0 + 2 * ty, col0 + 8 * tx, acc[0]);
    ef(row0 + 2 * ty + 1, col0 + 8 * tx, acc[1]);
}
__global__ void __launch_bounds__(256) k_ngemm_main(Params p, int ch) {
    const int tok0 = ch * TC;
    EpiMain E{WSP(float, WS_BIASP), p.pos, WSP(bf16_t, WS_QG), WSP(bf16_t, WS_CGLU), WSP(bf16_t, WS_QM), WSP(bf16_t, WS_GATES), tok0};
    RowsPlain A{WSP(bf16_t, WS_XB) + (size_t)ch * TC * 1024, 1024}, Bm{WSP(bf16_t, WS_WIN), 1024};
    ngemm_tile(blockIdx.y * 64, blockIdx.x * 64, 1024, A, Bm, E, 1 << 30, 0);
}
__global__ void __launch_bounds__(256) k_ngemm_kv(Params p, int ch) {
    EpiKV E{WSP(bf16_t, WS_KM)};
    RowsPlain A{WSP(bf16_t, WS_MEMB), 1024}, Bm{WSP(bf16_t, WS_WKV), 1024};
    ngemm_tile(blockIdx.y * 64, blockIdx.x * 64, 1024, A, Bm, E, 1 << 30, 0);
}
__global__ void __launch_bounds__(256) k_ngemm_merge(Params p, int br) {
    EpiMerge E{WSP(bf16_t, WS_GATES), WSP(bf16_t, WS_MERGED), br};
    RowsPlain A{WSP(bf16_t, WS_OATT + (size_t)br * SZ_512), 512};
    RowsPlain Bm{WSP(bf16_t, WS_WA + (size_t)br * MiB), 512};
    ngemm_tile(blockIdx.y * 64, blockIdx.x * 64, 512, A, Bm, E, 1 << 30, 0);
}
__global__ void __launch_bounds__(256) k_ngemm_mix(Params p, int ch) {
    EpiMix E{(bf16_t*)p.out, ch * TC};
    RowsPlain A{WSP(bf16_t, WS_MERGED), 1024}, Bm{WSP(bf16_t, WS_WOUT), 1024};
    ngemm_tile(blockIdx.y * 64, blockIdx.x * 64, 1024, A, Bm, E, 1 << 30, 0);
}
struct RowsGather { const bf16_t* base; const int* list; int cnt, rowbase; __device__ __forceinline__ const bf16_t* operator()(int prow) const { int i = prow - rowbase; if (i >= cnt) i = cnt - 1; return base + (size_t)list[i] * 1024; } };
__device__ __forceinline__ int find_class(const ClassTab* t, int prow) { int c = 0;
    for (int i = 1; i < NCLS; ++i) if (prow >= t->rowbase[i]) c = i;
    return c; }
__global__ void __launch_bounds__(256) k_ngemm_moe1(Params p) {
    __shared__ ClassTab tabs; if (threadIdx.x == 0) class_tab_fill(WSP(unsigned, WS_CTL) + CW_CNT, &tabs); __syncthreads(); const ClassTab* tab = &tabs;
    const int row0 = blockIdx.y * 64; if (row0 >= tab->rowbase[NCLS]) return;
    const int cls = find_class(tab, row0); if (tab->cnt[cls] == 0) return;
    int e_lo, e_hi; class_experts(cls, e_lo, e_hi);
    const int col0 = blockIdx.x * 64, hi = col0 >> 10;
    const int* list = WSP(int, WS_LIST) + (size_t)cls * T;
    RowsGather A{WSP(bf16_t, WS_X1B), list, tab->cnt[cls], tab->rowbase[cls]};
    RowsPlain Bm{WSP(bf16_t, WS_W1) + ((size_t)(hi ? e_hi : e_lo) * 1024 - (size_t)hi * 1024) * 1024, 1024};
    EpiMoe1 E{list, WSP(float, WS_WTS), WSP(bf16_t, WS_H), cls, tab->cnt[cls], tab->rowbase[cls]};
    ngemm_tile(row0, col0, 1024, A, Bm, E, 1 << 30, 0);
}
__global__ void __launch_bounds__(256) k_ngemm_moe2(Params p) {
    __shared__ ClassTab tabs; if (threadIdx.x == 0) class_tab_fill(WSP(unsigned, WS_CTL) + CW_CNT, &tabs); __syncthreads(); const ClassTab* tab = &tabs;
    const int row0 = blockIdx.y * 64; if (row0 >= tab->rowbase[NCLS]) return;
    const int cls = find_class(tab, row0); if (tab->cnt[cls] == 0) return;
    int e_lo, e_hi; class_experts(cls, e_lo, e_hi);
    RowsPlain A{WSP(bf16_t, WS_H), 1024};
    RowsPlain Bm{WSP(bf16_t, WS_W2) + (size_t)e_lo * 512, 8192};
    EpiMoe2 E{WSP(bf16_t, WS_Y2)};
    ngemm_tile(row0, blockIdx.x * 64, 1024, A, Bm, E, 512, (long)(e_hi - e_lo - 1) * 512);
}

__device__ __forceinline__ void nattn_row(const bf16_t* qp, const bf16_t* kbase, const bf16_t* vbase, int nkeys, bf16_t* op, float* lsep, int lane) {
    const unsigned qw = *(const unsigned*)(qp + 2 * lane); const float q0 = bflo(qw), q1 = bfhi(qw);
    float sc[4] = {-INFINITY, -INFINITY, -INFINITY, -INFINITY};
#pragma unroll
    for (int kb = 0; kb < 4; ++kb) {
        for (int kk = 0; kk < 64; ++kk) { const int k = kb * 64 + kk; if (k >= nkeys) break;
            const unsigned kw = *(const unsigned*)(kbase + (size_t)k * 128 + 2 * lane);
            const float s = wave_sum(q0 * bflo(kw) + q1 * bfhi(kw)) * ATT_SCALE;
            if (lane == kk) sc[kb] = s; }
    }
    const float m = wave_max(fmaxf(fmaxf(sc[0], sc[1]), fmaxf(sc[2], sc[3])));
    float pr[4]; float ps = 0.f;
#pragma unroll
    for (int kb = 0; kb < 4; ++kb) { pr[kb] = __expf(sc[kb] - m); ps += pr[kb]; }
    const float l = wave_sum(ps);
    float a0 = 0.f, a1 = 0.f;
#pragma unroll
    for (int kb = 0; kb < 4; ++kb) {
        for (int kk = 0; kk < 64; ++kk) { const int k = kb * 64 + kk; if (k >= nkeys) break;
            const float pk = __shfl(pr[kb], kk);
            const unsigned vw = *(const unsigned*)(vbase + (size_t)k * 128 + 2 * lane);
            a0 += pk * bflo(vw); a1 += pk * bfhi(vw); }
    }
    const float inv = 1.0f / l;
    *(unsigned*)(op + 2 * lane) = pk2(a0 * inv, a1 * inv);
    if (lsep && lane == 0) *lsep = m + __logf(l);
}
__global__ void __launch_bounds__(256) k_nattn_dil(Params p) {
    const int lane = threadIdx.x & 63; const size_t w = (size_t)blockIdx.x * 4 + (threadIdx.x >> 6);
    if (w >= (size_t)BC * 12 * 2048) return;
    const int row = (int)(w & 2047); const int bgh = (int)(w >> 11); const int g = (bgh % 12) >> 2;
    const int seglen = 2048 >> (2 * g); const int pin = row & (seglen - 1); const int nk = pin + 1 < 129 ? pin + 1 : 129;
    bf16_t* Q = WSP(bf16_t, WS_QG) + ((size_t)bgh * 2048 + row) * 128;
    const bf16_t* K = WSP(bf16_t, WS_KG) + ((size_t)bgh * 2048 + row - nk + 1) * 128;
    const bf16_t* V = WSP(bf16_t, WS_VG) + ((size_t)bgh * 2048 + row - nk + 1) * 128;
    nattn_row(Q, K, V, nk, Q, WSP(float, WS_LSE) + (size_t)bgh * 2048 + row, lane);
}
__global__ void __launch_bounds__(256) k_nattn_mem(Params p, int ch) {
    const int lane = threadIdx.x & 63; const size_t w = (size_t)blockIdx.x * 4 + (threadIdx.x >> 6);
    if (w >= (size_t)BC * 4 * 2048) return;
    const int s = (int)(w & 2047); const int bh = (int)(w >> 11); const int bl = bh >> 2, h = bh & 3;
    const bf16_t* Q = WSP(bf16_t, WS_QM) + ((size_t)bh * 2048 + s) * 128;
    const bf16_t* K = WSP(bf16_t, WS_KM) + (size_t)(ch * BC * 4 + bh) * 256 * 128;
    const bf16_t* V = WSP(bf16_t, WS_VM) + (size_t)(ch * BC * 4 + bh) * 256 * 128;
    nattn_row(Q, K, V, 256, WSP(bf16_t, WS_OMT) + ((size_t)(bl * 2048 + s)) * 512 + h * 128, nullptr, lane);
}

__device__ __forceinline__ void combine_token(const Params& p, int rl, int lane) {
    const int bl = rl >> 11, s = rl & 2047, h = lane >> 4, d0 = (lane & 15) * 8;
    float ls[3]; u32x4 o[3];
#pragma unroll
    for (int g = 0; g < 3; ++g) { const size_t r = (size_t)(bl * 12 + g * 4 + h) * 2048 + rowperm(g, s);
        ls[g] = WSP(float, WS_LSE)[r]; o[g] = *(const u32x4*)(WSP(bf16_t, WS_QG) + r * 128 + d0); }
    const float m = fmaxf(ls[0], fmaxf(ls[1], ls[2]));
    float w0 = __expf(ls[0] - m), w1 = __expf(ls[1] - m), w2 = __expf(ls[2] - m); const float inv = 1.0f / (w0 + w1 + w2); w0 *= inv; w1 *= inv; w2 *= inv;
    u32x4 r;
    r.x = pk2(w0 * bflo(o[0].x) + w1 * bflo(o[1].x) + w2 * bflo(o[2].x), w0 * bfhi(o[0].x) + w1 * bfhi(o[1].x) + w2 * bfhi(o[2].x));
    r.y = pk2(w0 * bflo(o[0].y) + w1 * bflo(o[1].y) + w2 * bflo(o[2].y), w0 * bfhi(o[0].y) + w1 * bfhi(o[1].y) + w2 * bfhi(o[2].y));
    r.z = pk2(w0 * bflo(o[0].z) + w1 * bflo(o[1].z) + w2 * bflo(o[2].z), w0 * bfhi(o[0].z) + w1 * bfhi(o[1].z) + w2 * bfhi(o[2].z));
    r.w = pk2(w0 * bflo(o[0].w) + w1 * bflo(o[1].w) + w2 * bflo(o[2].w), w0 * bfhi(o[0].w) + w1 * bfhi(o[1].w) + w2 * bfhi(o[2].w));
#if P4_FP8
    u32x2 r8; r8.x = pk4_fp8(O8_SCALE * bflo(r.x), O8_SCALE * bfhi(r.x), O8_SCALE * bflo(r.y), O8_SCALE * bfhi(r.y)); r8.y = pk4_fp8(O8_SCALE * bflo(r.z), O8_SCALE * bfhi(r.z), O8_SCALE * bflo(r.w), O8_SCALE * bfhi(r.w));
    *(u32x2*)(p.ws + WS_OATT + (size_t)rl * 512 + h * 128 + d0) = r8;
#else
    *(u32x4*)(WSP(bf16_t, WS_OATT) + (size_t)rl * 512 + h * 128 + d0) = r;
#endif
}
__device__ __forceinline__ void combine_token2(const Params& p, int rl0, int rl1, int lane) {
    const int h = lane >> 4, d0 = (lane & 15) * 8;
#if O_FP8 && P4_FP8
    float ls[2][3]; u32x2 o8[2][3];
#pragma unroll
    for (int t = 0; t < 2; ++t) { const int rl = t ? rl1 : rl0; const int bl = rl >> 11, s = rl & 2047;
#pragma unroll
        for (int g = 0; g < 3; ++g) { const size_t r = (size_t)(bl * 12 + g * 4 + h) * 2048 + rowperm(g, s);
            ls[t][g] = WSP(float, WS_LSE)[r]; o8[t][g] = *(const u32x2*)(p.ws + WS_QG + r * 256 + d0); } }
#pragma unroll
    for (int t = 0; t < 2; ++t) { const int rl = t ? rl1 : rl0;
        const float m = fmaxf(ls[t][0], fmaxf(ls[t][1], ls[t][2]));
        float w0 = __expf(ls[t][0] - m), w1 = __expf(ls[t][1] - m), w2 = __expf(ls[t][2] - m); const float inv = 1.0f / (w0 + w1 + w2); w0 *= inv; w1 *= inv; w2 *= inv;
        float f[8] = {0.f, 0.f, 0.f, 0.f, 0.f, 0.f, 0.f, 0.f};
#pragma unroll
        for (int g = 0; g < 3; ++g) { const float wg = g == 0 ? w0 : (g == 1 ? w1 : w2);
            const auto a0 = __builtin_amdgcn_cvt_pk_f32_fp8(o8[t][g].x, false), a1 = __builtin_amdgcn_cvt_pk_f32_fp8(o8[t][g].x, true), a2 = __builtin_amdgcn_cvt_pk_f32_fp8(o8[t][g].y, false), a3 = __builtin_amdgcn_cvt_pk_f32_fp8(o8[t][g].y, true);
            f[0] += wg * a0[0]; f[1] += wg * a0[1]; f[2] += wg * a1[0]; f[3] += wg * a1[1]; f[4] += wg * a2[0]; f[5] += wg * a2[1]; f[6] += wg * a3[0]; f[7] += wg * a3[1]; }
        u32x2 r8; r8.x = pk4_fp8(f[0], f[1], f[2], f[3]); r8.y = pk4_fp8(f[4], f[5], f[6], f[7]);
        *(u32x2*)(p.ws + WS_OATT + (size_t)rl * 512 + h * 128 + d0) = r8;
    }
#else
    float ls[2][3]; u32x4 o[2][3];
#pragma unroll
    for (int t = 0; t < 2; ++t) { const int rl = t ? rl1 : rl0; const int bl = rl >> 11, s = rl & 2047;
#pragma unroll
        for (int g = 0; g < 3; ++g) { const size_t r = (size_t)(bl * 12 + g * 4 + h) * 2048 + rowperm(g, s);
            ls[t][g] = WSP(float, WS_LSE)[r]; o[t][g] = *(const u32x4*)(WSP(bf16_t, WS_QG) + r * 128 + d0); } }
#pragma unroll
    for (int t = 0; t < 2; ++t) { const int rl = t ? rl1 : rl0;
        const float m = fmaxf(ls[t][0], fmaxf(ls[t][1], ls[t][2]));
        float w0 = __expf(ls[t][0] - m), w1 = __expf(ls[t][1] - m), w2 = __expf(ls[t][2] - m); const float inv = 1.0f / (w0 + w1 + w2); w0 *= inv; w1 *= inv; w2 *= inv;
#define CMB(c, f) (w0 * f(o[t][0].c) + w1 * f(o[t][1].c) + w2 * f(o[t][2].c))
#if P4_FP8
        u32x4 r; r.x = pk2(CMB(x, bflo), CMB(x, bfhi)); r.y = pk2(CMB(y, bflo), CMB(y, bfhi)); r.z = pk2(CMB(z, bflo), CMB(z, bfhi)); r.w = pk2(CMB(w, bflo), CMB(w, bfhi));
        u32x2 r8; r8.x = pk4_fp8(O8_SCALE * bflo(r.x), O8_SCALE * bfhi(r.x), O8_SCALE * bflo(r.y), O8_SCALE * bfhi(r.y)); r8.y = pk4_fp8(O8_SCALE * bflo(r.z), O8_SCALE * bfhi(r.z), O8_SCALE * bflo(r.w), O8_SCALE * bfhi(r.w));
        *(u32x2*)(p.ws + WS_OATT + (size_t)rl * 512 + h * 128 + d0) = r8;
#else
        u32x4 r; r.x = pk2(CMB(x, bflo), CMB(x, bfhi)); r.y = pk2(CMB(y, bflo), CMB(y, bfhi)); r.z = pk2(CMB(z, bflo), CMB(z, bfhi)); r.w = pk2(CMB(w, bflo), CMB(w, bfhi));
        *(u32x4*)(WSP(bf16_t, WS_OATT) + (size_t)rl * 512 + h * 128 + d0) = r;
#endif
#undef CMB
    }
#endif
}
__global__ void __launch_bounds__(256) k_combine(Params p) {
    const int lane = threadIdx.x & 63; const int w = blockIdx.x * 4 + (threadIdx.x >> 6);
    if (w < TC) combine_token(p, w, lane);
}
constexpr int CONV_TILE = 62 * 1024, CONV_OUT = 32 * 1024, CONV_LDS = CONV_TILE + CONV_OUT + (8 * 32 + 64) * 4;
__device__ __forceinline__ void conv_unit(const Params& p, int u, unsigned char* lds, int tid_) {
    const int ch = tid_, lane = ch & 63, wv = ch >> 6;
    const int bl = u >> 6, s0 = (u & 63) * 32;
    bf16_t* tile = (bf16_t*)lds; bf16_t* otile = (bf16_t*)(lds + CONV_TILE); float* red = (float*)(lds + CONV_TILE + CONV_OUT);
    const bf16_t* cg = WSP(bf16_t, WS_CGLU) + (size_t)bl * 2048 * 512;
#pragma unroll
    for (int it = 0; it < 8; ++it) { const int c = it * 512 + ch; if (c < 62 * 64) { const int r = c >> 6, q = c & 63, s = s0 - 30 + r;
        u32x4 v = {0u, 0u, 0u, 0u}; if (s >= 0) v = *(const u32x4*)(cg + (size_t)s * 512 + q * 8);
        *(u32x4*)(tile + r * 512 + q * 8) = v; } }
    __syncthreads();
    float o[32]; const float cb = p.conv_b[ch];
#pragma unroll
    for (int i = 0; i < 32; ++i) o[i] = cb;
    {   float in[62];
#pragma unroll
        for (int i = 0; i < 62; ++i) in[i] = bf2f(tile[i * 512 + ch]);
#pragma unroll
        for (int j = 0; j < 31; ++j) { const float w = p.conv_w[j * 512 + ch];
#pragma unroll
            for (int i = 0; i < 32; ++i) o[i] += w * in[i + j]; } }
    float* mean = red + 256; float* rstd = red + 288;
#pragma unroll
    for (int i = 0; i < 32; ++i) { const float sr = wave_sum(o[i]); if (lane == 0) red[wv * 32 + i] = sr; }
    __syncthreads();
    if (ch < 32) { float sm = 0.f;
#pragma unroll
        for (int w = 0; w < 8; ++w) sm += red[w * 32 + ch];
        mean[ch] = sm * (1.0f / 512.0f); }
    __syncthreads();
#pragma unroll
    for (int i = 0; i < 32; ++i) { o[i] -= mean[i]; const float sr = wave_sum(o[i] * o[i]); if (lane == 0) red[wv * 32 + i] = sr; }
    __syncthreads();
    if (ch < 32) { float sm = 0.f;
#pragma unroll
        for (int w = 0; w < 8; ++w) sm += red[w * 32 + ch];
        rstd[ch] = 1.0f / sqrtf(sm * (1.0f / 512.0f) + LN_EPS); }
    __syncthreads();
    const float gg = p.conv_g[ch], bb = p.conv_bb[ch];
#pragma unroll
#if P4_FP8
    for (int i = 0; i < 32; ++i) { const float y = o[i] * rstd[i] * gg + bb; const float z = O8_SCALE * (y * sigmoidf_(y)); ((unsigned char*)otile)[i * 512 + ch] = (unsigned char)(__builtin_amdgcn_cvt_pk_fp8_f32(z, z, 0, false) & 255); }
    __syncthreads();
    unsigned char* outp = p.ws + WS_CCONV + ((size_t)bl * 2048 + s0) * 512;
#pragma unroll
    for (int it = 0; it < 2; ++it) { const int c = it * 512 + ch; *(u32x4*)(outp + (size_t)c * 16) = *(const u32x4*)((const unsigned char*)otile + c * 16); }
#else
    for (int i = 0; i < 32; ++i) { const float y = o[i] * rstd[i] * gg + bb; otile[i * 512 + ch] = (bf16_t)f2bf(y * sigmoidf_(y)); }
    __syncthreads();
    bf16_t* outp = WSP(bf16_t, WS_CCONV) + ((size_t)bl * 2048 + s0) * 512;
#pragma unroll
    for (int it = 0; it < 4; ++it) { const int c = it * 512 + ch; *(u32x4*)(outp + (size_t)c * 8) = *(const u32x4*)(otile + c * 8); }
#endif
    __syncthreads();
}
__global__ void __launch_bounds__(512) k_conv(Params p) {
    __shared__ __attribute__((aligned(16))) unsigned char cl[CONV_LDS];
    conv_unit(p, blockIdx.x, cl, threadIdx.x);
}
__device__ __forceinline__ void ln1_unit(const Params& p, int u, const float* wr, int* cls_l, int* misc, int tid_, bool dummy = false) {
    const int tid = tid_, lane = tid & 63, wv = tid >> 6;
    float gam[16], bet[16];
#pragma unroll
    for (int j = 0; j < 4; ++j) { const f32x4 g4 = *(const f32x4*)(p.ln1_g + 4 * lane + 256 * j), b4 = *(const f32x4*)(p.ln1_b + 4 * lane + 256 * j);
        gam[4 * j] = g4.x; gam[4 * j + 1] = g4.y; gam[4 * j + 2] = g4.z; gam[4 * j + 3] = g4.w; bet[4 * j] = b4.x; bet[4 * j + 1] = b4.y; bet[4 * j + 2] = b4.z; bet[4 * j + 3] = b4.w; }
    const int tok0 = u * 64 + wv * 8;
    u32x2 xq[2][4]; u32x2 mq[2][4];
#define LN1_LOAD(slot, rr) do { const bf16_t* xr_ = WSP(bf16_t, WS_XB) + (size_t)(tok0 + (rr)) * 1024 + 4 * lane; const bf16_t* mr_ = (const bf16_t*)p.out + (size_t)(tok0 + (rr)) * 1024 + 4 * lane; \
        _Pragma("unroll") for (int j = 0; j < 4; ++j) { xq[slot][j] = *(const u32x2*)(xr_ + 256 * j); mq[slot][j] = *(const u32x2*)(mr_ + 256 * j); } } while (0)
    LN1_LOAD(0, 0);
#pragma unroll
    for (int rr = 0; rr < 8; ++rr) {
        const int lr = wv * 8 + rr; const int tok = tok0 + rr;
        if (rr + 1 < 8) { if (rr & 1) LN1_LOAD(0, rr + 1); else LN1_LOAD(1, rr + 1); }
        float v[16]; float sm = 0.f;
#pragma unroll
        for (int j = 0; j < 4; ++j) { const u32x2 t = xq[rr & 1][j]; const u32x2 mm = mq[rr & 1][j];
            v[4 * j] = DN_ALPHA * bflo(t.x) + bflo(mm.x); v[4 * j + 1] = DN_ALPHA * bfhi(t.x) + bfhi(mm.x); v[4 * j + 2] = DN_ALPHA * bflo(t.y) + bflo(mm.y); v[4 * j + 3] = DN_ALPHA * bfhi(t.y) + bfhi(mm.y);
            sm += (v[4 * j] + v[4 * j + 1]) + (v[4 * j + 2] + v[4 * j + 3]); }
        const float mean = wave_sum(sm) * (1.0f / 1024.0f); float sq = 0.f;
#pragma unroll
        for (int i = 0; i < 16; ++i) { v[i] -= mean; sq += v[i] * v[i]; }
        const float rstd = 1.0f / sqrtf(wave_sum(sq) * (1.0f / 1024.0f) + LN_EPS);
#pragma unroll
        for (int i = 0; i < 16; ++i) v[i] = v[i] * rstd * gam[i] + bet[i];
        bf16_t* xb = WSP(bf16_t, dummy ? WS_H : WS_X1B) + (size_t)tok * 1024;
#pragma unroll
        for (int j = 0; j < 4; ++j) { u32x2 o; o.x = pk2(v[4 * j], v[4 * j + 1]); o.y = pk2(v[4 * j + 2], v[4 * j + 3]); *(u32x2*)(xb + 4 * lane + 256 * j) = o; }
        if (!dummy) { unsigned char* x8 = p.ws + WS_X1B8 + (size_t)tok * 1024;
#pragma unroll
            for (int j = 0; j < 4; ++j) *(unsigned*)(x8 + 4 * lane + 256 * j) = pk4_fp8(v[4 * j], v[4 * j + 1], v[4 * j + 2], v[4 * j + 3]); }
        float gl[4];
#pragma unroll
        for (int e = 0; e < 4; ++e) { float a = 0.f;
#pragma unroll
            for (int j = 0; j < 4; ++j) { const f32x4 w4 = *(const f32x4*)(wr + e * 1024 + 4 * lane + 256 * j); a += v[4 * j] * w4.x + v[4 * j + 1] * w4.y + v[4 * j + 2] * w4.z + v[4 * j + 3] * w4.w; }
            gl[e] = wave_sum(a) + p.b_gr[e]; }
        int gs = 0; float gm = gl[0];
#pragma unroll
        for (int e = 1; e < 4; ++e) if (gl[e] > gm) { gm = gl[e]; gs = e; }
        float gsum = 0.f;
#pragma unroll
        for (int e = 0; e < 4; ++e) gsum += __expf(gl[e] - gm);
        const float gprob = 1.0f / gsum;
        gs = __builtin_amdgcn_readfirstlane(gs);
        float el[4];
#pragma unroll
        for (int e = 0; e < 4; ++e) { float a = 0.f; const float* wp = wr + (4 + gs * 4 + e) * 1024;
#pragma unroll
            for (int j = 0; j < 4; ++j) { const f32x4 w4 = *(const f32x4*)(wp + 4 * lane + 256 * j); a += v[4 * j] * w4.x + v[4 * j + 1] * w4.y + v[4 * j + 2] * w4.z + v[4 * j + 3] * w4.w; }
            el[e] = wave_sum(a) + p.b_er[gs * 4 + e]; }
        int i1 = 0; float v1 = el[0];
#pragma unroll
        for (int e = 1; e < 4; ++e) if (el[e] > v1) { v1 = el[e]; i1 = e; }
        int i2 = -1; float v2 = -INFINITY;
#pragma unroll
        for (int e = 0; e < 4; ++e) if (e != i1 && el[e] > v2) { v2 = el[e]; i2 = e; }
        const float t2 = __expf(v2 - v1); const float w1 = gprob / (1.0f + t2), w2 = gprob * t2 / (1.0f + t2);
        const int lo = i1 < i2 ? i1 : i2, hi = i1 < i2 ? i2 : i1;
        const int pi = lo == 0 ? hi - 1 : (lo == 1 ? hi + 1 : 5);
        if (lane == 0 && !dummy) { cls_l[lr] = gs * 6 + pi; float* wt = WSP(float, WS_WTS) + (size_t)tok * 2; wt[0] = (i1 == lo) ? w1 : w2; wt[1] = (i1 == lo) ? w2 : w1; }
    }
#undef LN1_LOAD
    __syncthreads();
    if (dummy) return;
    if (tid < NCLS) { int n = 0; for (int r = 0; r < 64; ++r) n += (cls_l[r] == tid); misc[tid] = n ? (int)atomicAdd(WSP(unsigned, WS_CTL) + CW_CNT + tid, (unsigned)n) : 0; }
    __syncthreads();
    if (tid < 64) { const int c = cls_l[tid]; int rank = 0; for (int r = 0; r < tid; ++r) rank += (cls_l[r] == c);
        WSP(int, WS_LIST)[(size_t)c * T + misc[c] + rank] = u * 64 + tid; }
    __syncthreads();
}
__device__ __forceinline__ float row16_sum(float v) {
#define DPP_F(x, ctrl) __int_as_float(__builtin_amdgcn_update_dpp(0, __float_as_int(x), ctrl, 0xf, 0xf, true))
    v += DPP_F(v, 0xB1); v += DPP_F(v, 0x4E); v += DPP_F(v, 0x141); v += DPP_F(v, 0x140);
#undef DPP_F
    return v;
}
__device__ __forceinline__ void ln1_unit16(const Params& p, int u, const float* wr, int* cls_l, int* misc, int tid_, bool dummy = false) {
    const int tid = tid_, lane = tid & 63, wv = tid >> 6;
#pragma unroll 1
    for (int pass = 0; pass < 2; ++pass) {
        int q = lane >> 4, l16 = lane & 15; asm volatile("" : "+v"(q), "+v"(l16));
        const int lr = wv * 8 + pass * 4 + q; const int tok = u * 64 + lr;
        const bf16_t* xr = WSP(bf16_t, WS_XB) + (size_t)tok * 1024 + 4 * l16; const bf16_t* mr = (const bf16_t*)p.out + (size_t)tok * 1024 + 4 * l16;
        u32x2 xq[16], mq[16]; f32x4 g4[16], b4[16];
#pragma unroll
        for (int c = 0; c < 16; ++c) { xq[c] = *(const u32x2*)(xr + 64 * c); mq[c] = *(const u32x2*)(mr + 64 * c); }
#pragma unroll
        for (int c = 0; c < 16; ++c) { g4[c] = *(const f32x4*)(p.ln1_g + 64 * c + 4 * l16); b4[c] = *(const f32x4*)(p.ln1_b + 64 * c + 4 * l16); }
        float v[64]; float sm = 0.f;
#pragma unroll
        for (int c = 0; c < 16; ++c) { const u32x2 t = xq[c], mm = mq[c];
            v[4 * c] = DN_ALPHA * bflo(t.x) + bflo(mm.x); v[4 * c + 1] = DN_ALPHA * bfhi(t.x) + bfhi(mm.x); v[4 * c + 2] = DN_ALPHA * bflo(t.y) + bflo(mm.y); v[4 * c + 3] = DN_ALPHA * bfhi(t.y) + bfhi(mm.y);
            sm += (v[4 * c] + v[4 * c + 1]) + (v[4 * c + 2] + v[4 * c + 3]); }
        const float mean = row16_sum(sm) * (1.0f / 1024.0f); float sq = 0.f;
#pragma unroll
        for (int i = 0; i < 64; ++i) { v[i] -= mean; sq += v[i] * v[i]; }
        const float rstd = 1.0f / sqrtf(row16_sum(sq) * (1.0f / 1024.0f) + LN_EPS);
        bf16_t* xb = WSP(bf16_t, dummy ? WS_H : WS_X1B) + (size_t)tok * 1024 + 4 * l16; unsigned char* x8 = p.ws + WS_X1B8 + (size_t)tok * 1024 + 4 * l16;
#pragma unroll
        for (int c = 0; c < 16; ++c) {
            v[4 * c] = v[4 * c] * rstd * g4[c].x + b4[c].x; v[4 * c + 1] = v[4 * c + 1] * rstd * g4[c].y + b4[c].y; v[4 * c + 2] = v[4 * c + 2] * rstd * g4[c].z + b4[c].z; v[4 * c + 3] = v[4 * c + 3] * rstd * g4[c].w + b4[c].w;
            u32x2 o; o.x = pk2(v[4 * c], v[4 * c + 1]); o.y = pk2(v[4 * c + 2], v[4 * c + 3]); *(u32x2*)(xb + 64 * c) = o;
            if (!dummy) *(unsigned*)(x8 + 64 * c) = pk4_fp8(v[4 * c], v[4 * c + 1], v[4 * c + 2], v[4 * c + 3]); }
        asm volatile("" ::: "memory");
        float gl[4];
#pragma unroll
        for (int e = 0; e < 4; ++e) { float a = 0.f;
#pragma unroll
            for (int c = 0; c < 16; ++c) { const f32x4 w4 = *(const f32x4*)(wr + e * 1024 + 64 * c + 4 * l16); a += v[4 * c] * w4.x + v[4 * c + 1] * w4.y + v[4 * c + 2] * w4.z + v[4 * c + 3] * w4.w; }
            gl[e] = a; asm volatile("" ::: "memory"); }
#pragma unroll
        for (int e = 0; e < 4; ++e) gl[e] = row16_sum(gl[e]) + p.b_gr[e];
        int gs = 0; float gm = gl[0];
#pragma unroll
        for (int e = 1; e < 4; ++e) if (gl[e] > gm) { gm = gl[e]; gs = e; }
        float gsum = 0.f;
#pragma unroll
        for (int e = 0; e < 4; ++e) gsum += __expf(gl[e] - gm);
        const float gprob = 1.0f / gsum;
        float el[4]; const float* wpb = wr + (4 + gs * 4) * 1024 + 4 * l16;
#pragma unroll
        for (int e = 0; e < 4; ++e) { float a = 0.f;
#pragma unroll
            for (int c = 0; c < 16; ++c) { const f32x4 w4 = *(const f32x4*)(wpb + e * 1024 + 64 * c); a += v[4 * c] * w4.x + v[4 * c + 1] * w4.y + v[4 * c + 2] * w4.z + v[4 * c + 3] * w4.w; }
            el[e] = a; asm volatile("" ::: "memory"); }
#pragma unroll
        for (int e = 0; e < 4; ++e) el[e] = row16_sum(el[e]) + p.b_er[gs * 4 + e];
        int i1 = 0; float v1 = el[0];
#pragma unroll
        for (int e = 1; e < 4; ++e) if (el[e] > v1) { v1 = el[e]; i1 = e; }
        int i2 = -1; float v2 = -INFINITY;
#pragma unroll
        for (int e = 0; e < 4; ++e) if (e != i1 && el[e] > v2) { v2 = el[e]; i2 = e; }
        const float t2 = __expf(v2 - v1); const float w1 = gprob / (1.0f + t2), w2 = gprob * t2 / (1.0f + t2);
        const int lo = i1 < i2 ? i1 : i2, hi = i1 < i2 ? i2 : i1;
        const int pi = lo == 0 ? hi - 1 : (lo == 1 ? hi + 1 : 5);
        if (l16 == 0 && !dummy) { cls_l[lr] = gs * 6 + pi; float* wt = WSP(float, WS_WTS) + (size_t)tok * 2; wt[0] = (i1 == lo) ? w1 : w2; wt[1] = (i1 == lo) ? w2 : w1; }
    }
    __syncthreads();
    if (dummy) return;
    if (tid < NCLS) { int n = 0; for (int r = 0; r < 64; ++r) n += (cls_l[r] == tid); misc[tid] = n ? (int)atomicAdd(WSP(unsigned, WS_CTL) + CW_CNT + tid, (unsigned)n) : 0; }
    __syncthreads();
    if (tid < 64) { const int c = cls_l[tid]; int rank = 0; for (int r = 0; r < tid; ++r) rank += (cls_l[r] == c);
        WSP(int, WS_LIST)[(size_t)c * T + misc[c] + rank] = u * 64 + tid; }
    __syncthreads();
}
__global__ void __launch_bounds__(512) k_ln1(Params p) {
    extern __shared__ float dyn[];
    float* wr = dyn; int* cls_l = (int*)(dyn + 20 * 1024); int* misc = cls_l + 64;
    for (int i = threadIdx.x; i < 20 * 1024; i += 512) wr[i] = WSP(float, WS_WRT)[i];
    __syncthreads();
    for (int u = blockIdx.x; u < T / 64; u += gridDim.x) ln1_unit(p, u, wr, cls_l, misc, threadIdx.x);
}
template <int NR>
__device__ __forceinline__ void ln2_rows(const Params& p, const int (&tok)[NR], const int (&prow)[NR], int lane, float* dummy = nullptr) {
    u32x2 xa[NR][4];
#if Y2_FP8
    unsigned ya[NR][4];
#pragma unroll
    for (int r = 0; r < NR; ++r) if (tok[r] >= 0) { const bf16_t* xrow = WSP(bf16_t, WS_X1B) + (size_t)tok[r] * 1024 + 4 * lane; const unsigned char* yrow = p.ws + WS_Y2 + (size_t)prow[r] * 1024 + 4 * lane;
#pragma unroll
        for (int j = 0; j < 4; ++j) { xa[r][j] = *(const u32x2*)(xrow + 256 * j); ya[r][j] = *(const unsigned*)(yrow + 256 * j); } }
#else
    u32x2 ya[NR][4];
#pragma unroll
    for (int r = 0; r < NR; ++r) if (tok[r] >= 0) { const bf16_t* xrow = WSP(bf16_t, WS_X1B) + (size_t)tok[r] * 1024 + 4 * lane; const bf16_t* yrow = WSP(bf16_t, WS_Y2) + (size_t)prow[r] * 1024 + 4 * lane;
#pragma unroll
        for (int j = 0; j < 4; ++j) { xa[r][j] = *(const u32x2*)(xrow + 256 * j); ya[r][j] = *(const u32x2*)(yrow + 256 * j); } }
#endif
    f32x4 g4[4], b4[4];
#pragma unroll
    for (int j = 0; j < 4; ++j) { g4[j] = *(const f32x4*)(p.ln2_g + 4 * lane + 256 * j); b4[j] = *(const f32x4*)(p.ln2_b + 4 * lane + 256 * j); }
#pragma unroll
    for (int r = 0; r < NR; ++r) if (tok[r] >= 0) {
        float v[16]; float sm = 0.f;
#pragma unroll
        for (int j = 0; j < 4; ++j) { const u32x2 t = xa[r][j];
#if Y2_FP8
            const auto ylo = __builtin_amdgcn_cvt_pk_f32_fp8(ya[r][j], false), yhi = __builtin_amdgcn_cvt_pk_f32_fp8(ya[r][j], true);
            v[4 * j] = DN_ALPHA * bflo(t.x) + ylo[0] * (1.0f / Y8_SCALE); v[4 * j + 1] = DN_ALPHA * bfhi(t.x) + ylo[1] * (1.0f / Y8_SCALE); v[4 * j + 2] = DN_ALPHA * bflo(t.y) + yhi[0] * (1.0f / Y8_SCALE); v[4 * j + 3] = DN_ALPHA * bfhi(t.y) + yhi[1] * (1.0f / Y8_SCALE);
#else
            const u32x2 y = ya[r][j];
            v[4 * j] = DN_ALPHA * bflo(t.x) + bflo(y.x); v[4 * j + 1] = DN_ALPHA * bfhi(t.x) + bfhi(y.x); v[4 * j + 2] = DN_ALPHA * bflo(t.y) + bflo(y.y); v[4 * j + 3] = DN_ALPHA * bfhi(t.y) + bfhi(y.y);
#endif
            sm += (v[4 * j] + v[4 * j + 1]) + (v[4 * j + 2] + v[4 * j + 3]); }
        const float mean = wave_sum(sm) * (1.0f / 1024.0f); float sq = 0.f;
#pragma unroll
        for (int i2 = 0; i2 < 16; ++i2) { v[i2] -= mean; sq += v[i2] * v[i2]; }
        const float rstd = 1.0f / sqrtf(wave_sum(sq) * (1.0f / 1024.0f) + LN_EPS);
        float* orow = (dummy ? dummy : p.out) + (size_t)tok[r] * 1024 + 4 * lane;
#pragma unroll
        for (int j = 0; j < 4; ++j) *(f32x4*)(orow + 256 * j) = (f32x4){v[4 * j] * rstd * g4[j].x + b4[j].x, v[4 * j + 1] * rstd * g4[j].y + b4[j].y, v[4 * j + 2] * rstd * g4[j].z + b4[j].z, v[4 * j + 3] * rstd * g4[j].w + b4[j].w};
    }
}
__global__ void __launch_bounds__(256) k_ln2(Params p) {
    __shared__ ClassTab tabs; if (threadIdx.x == 0) class_tab_fill(WSP(unsigned, WS_CTL) + CW_CNT, &tabs); __syncthreads(); const ClassTab* tab = &tabs;
    const int lane = threadIdx.x & 63; const int prow = blockIdx.x * 4 + (threadIdx.x >> 6);
    if (prow >= tab->rowbase[NCLS]) return;
    const int cls = find_class(tab, prow); const int i = prow - tab->rowbase[cls]; if (i >= tab->cnt[cls]) return;
    const int tk[1] = {WSP(int, WS_LIST)[(size_t)cls * T + i]}, pr[1] = {prow};
    ln2_rows<1>(p, tk, pr, lane);
}


#define LAS __attribute__((address_space(3)))
#define GAS __attribute__((address_space(1)))
constexpr int RING_OFF = 0, RING_BYTES = 131072;
constexpr int LCTL_OFF = RING_BYTES;
constexpr int LTOK_OFF = LCTL_OFF + 4096, MAXU = 16;
constexpr int LDS_BYTES = LTOK_OFF + MAXU * 1024;
constexpr int NTHR = 512, NWAVES = 8;

#ifndef FP6_DIAG
#define FP6_DIAG 1
#endif
#if FP6_DIAG & 1
#define FP6_PRE "s_nop 3\n\t"
#else
#define FP6_PRE
#endif
#define FP6_DIAG_V0 ((FP6_DIAG >> 1) & 1)
namespace pg8 {
typedef short bf16x8 __attribute__((ext_vector_type(8)));
typedef int v4i_t __attribute__((ext_vector_type(4)));
typedef int v8i_t __attribute__((ext_vector_type(8)));
typedef int v6i_t __attribute__((ext_vector_type(6)));
typedef int v2i_t __attribute__((ext_vector_type(2)));
constexpr int BM = 256, BK = 64, HALF = 128, HTB = HALF * BK * 2, NXCD = 8, WGM = 8;
__host__ __device__ __forceinline__ int lds_byte(int r, int c) { const int st = (r >> 4) * 2 + (c >> 5), rr = r & 15, cc = c & 31, ob = rr * 64 + cc * 2; return st * 1024 + (ob ^ (((ob >> 9) & 1) << 5)); }
__host__ __device__ __forceinline__ void stage_rc(int b, int& R, int& C) { const int st = b / 1024, sb = b % 1024, swz = sb ^ (((sb >> 9) & 1) << 5); R = (st >> 1) * 16 + swz / 64; C = (st & 1) * 32 + (swz % 64) / 2; }
__host__ __device__ __forceinline__ int perm32(int rho) { const int n = rho >> 4, i = rho & 15; return 8 * (i >> 2) + 4 * n + (i & 3); }

struct Unit { const char* A; const char* B; int row0, col0, bjump, aux; };
struct TileOrder {
    int nM, nN, nwg, G, c;
    __device__ __forceinline__ void init(int nM_, int nN_, int G_, int c_) { nM = nM_; nN = nN_; nwg = nM * nN; G = G_; c = c_; }
    __device__ __forceinline__ bool tile(int i, int& pm, int& pn) const {
        const long L = (long)i * G + c; if (L >= nwg) return false;
        int wgid = (int)L; { const int q = nwg / NXCD, r = nwg % NXCD, xcd = wgid % NXCD, off = wgid / NXCD; wgid = (xcd < r ? xcd * (q + 1) : r * (q + 1) + (xcd - r) * q) + off; }
        const int nig = WGM * nN, gid = wgid / nig, fm = gid * WGM, gsz = (nM - fm) < WGM ? (nM - fm) : WGM;
        pm = fm + ((wgid % nig) % gsz); pn = (wgid % nig) / gsz; return true;
    }
};
__device__ __forceinline__ unsigned cvt_pk_bf16(float lo, float hi) { unsigned r; asm volatile("v_cvt_pk_bf16_f32 %0, %1, %2" : "=v"(r) : "v"(lo), "v"(hi)); return r; }

template <class EF> struct EpiRows {
    static constexpr bool PERM = true, KEEPS = false;
    EF ef;
    __device__ __forceinline__ bool keep_acc(const Unit&) const { return false; }
    __device__ __forceinline__ void operator()(f32x4 (&acc)[2][2][4][2], const Unit& u, int wr, int wc, int fr, int fq) const {
#pragma unroll
        for (int ai = 0; ai < 2; ++ai)
#pragma unroll
            for (int m = 0; m < 4; ++m) { const int row = u.row0 + ai * HALF + wr * 64 + m * 16 + fr;
#pragma unroll
                for (int bj = 0; bj < 2; ++bj) { const int c0 = u.col0 + bj * HALF + wc * 32 + 8 * fq;
                    float v[8] = {acc[ai][bj][m][0][0], acc[ai][bj][m][0][1], acc[ai][bj][m][0][2], acc[ai][bj][m][0][3], acc[ai][bj][m][1][0], acc[ai][bj][m][1][1], acc[ai][bj][m][1][2], acc[ai][bj][m][1][3]};
                    ef(u, row, c0, v); }
                asm volatile("" ::: "memory"); }
    }
};

template <class Epi, class Sched, bool ALIGN_EPI, bool GATHER, bool BJUMP, int LOWP = 0>
__device__ __forceinline__ void gemm_phase(LAS unsigned char* lds, const char* Abase, int lda, int ldb, int K, const Sched& S, const Epi& E, int wave_s) {
    const int tid = opaque_tid(wave_s), wid = __builtin_amdgcn_readfirstlane(tid >> 6), lane = tid & 63, wr = wid >> 2, wc = wid & 3, fr = lane & 15, fq = lane >> 4;
    const int nt = K / BK;
    unsigned voffA[2], voffB[2]; unsigned voffG[2][2], nvoffG[2][2];
#pragma unroll
    for (int i = 0; i < 2; ++i) { int R, C; stage_rc(tid * 16 + i * 8192, R, C); const int Rb = Epi::PERM ? ((R & ~31) + perm32(R & 31)) : R;
        voffA[i] = (unsigned)(R * lda + C) * 2u; voffB[i] = (unsigned)(Rb * ldb + C) * 2u; voffG[0][i] = voffG[1][i] = nvoffG[0][i] = nvoffG[1][i] = 0u; }
    const size_t kstep = (size_t)(BK * 2);
    const size_t hstepA = (size_t)HALF * lda * 2, hstepB = (size_t)HALF * ldb * 2;
    const unsigned ldsw = (unsigned)wid * 1024u;
    const int aoff = lds_byte(wr * 64 + fr, fq * 8), boff = lds_byte(wc * 32 + fr, fq * 8);
#define PG8_SA(b, h) (((b) * 2 + (h)) * HTB)
#define PG8_SB(b, h) ((4 + (b) * 2 + (h)) * HTB)
#define PG8_GLDS(gptr, ldsoff) __builtin_amdgcn_global_load_lds((const unsigned*)(gptr), (LAS unsigned*)(lds + (ldsoff)), 16, 0, 0)
#define PG8_STAGE_B(bufoff, gbase) do { _Pragma("unroll") for (int _i = 0; _i < 2; ++_i) PG8_GLDS((const char*)(gbase) + voffB[_i], (bufoff) + ldsw + _i * 8192); } while (0)
#define PG8_STAGE_A(bufoff, kptr, h, nx) do { if constexpr (GATHER) { _Pragma("unroll") for (int _i = 0; _i < 2; ++_i) PG8_GLDS((const char*)(kptr) + ((nx) ? nvoffG[h][_i] : voffG[h][_i]), (bufoff) + ldsw + _i * 8192); } \
        else { _Pragma("unroll") for (int _i = 0; _i < 2; ++_i) PG8_GLDS((const char*)(kptr) + (h) * hstepA + voffA[_i], (bufoff) + ldsw + _i * 8192); } } while (0)
#define PG8_GATHER_OFFS(dst, ord) do { LAS const int* _tk = S.toks(ord); _Pragma("unroll") for (int _h = 0; _h < 2; ++_h) _Pragma("unroll") for (int _i = 0; _i < 2; ++_i) { int _R, _C; stage_rc(tid * 16 + _i * 8192, _R, _C); \
        dst[_h][_i] = (unsigned)_tk[_h * HALF + _R] * (unsigned)(lda * 2) + (unsigned)(_C * 2); } } while (0)
#define PG8_LD16(addr) (*(const LAS bf16x8*)(addr))
#define PG8_LD8(addr) __builtin_bit_cast(bf16x8, __builtin_shufflevector(*(const LAS v2i_t*)(addr), *(const LAS v2i_t*)(addr), 0, 1, -1, -1))
#define PG8_LDA(dst, b, h) do { _Pragma("unroll") for (int m = 0; m < 4; ++m) { dst[m][0] = PG8_LD16(lds + PG8_SA(b, h) + aoff + m * 2048); \
        if constexpr (LOWP == 2) dst[m][1] = PG8_LD8(lds + PG8_SA(b, h) + aoff + m * 2048 + 1024); else dst[m][1] = PG8_LD16(lds + PG8_SA(b, h) + aoff + m * 2048 + 1024); } } while (0)
#define PG8_LDB(dst, b, h) do { _Pragma("unroll") for (int n = 0; n < 2; ++n) { dst[n][0] = PG8_LD16(lds + PG8_SB(b, h) + boff + n * 2048); \
        if constexpr (LOWP == 2) dst[n][1] = PG8_LD8(lds + PG8_SB(b, h) + boff + n * 2048 + 1024); else dst[n][1] = PG8_LD16(lds + PG8_SB(b, h) + boff + n * 2048 + 1024); } } while (0)
#define PG8_CAT8(lo, hi) __builtin_shufflevector(__builtin_bit_cast(v4i_t, lo), __builtin_bit_cast(v4i_t, hi), 0, 1, 2, 3, 4, 5, 6, 7)
#define PG8_CAT6(lo, hi) __builtin_shufflevector(__builtin_bit_cast(v4i_t, lo), __builtin_bit_cast(v4i_t, hi), 0, 1, 2, 3, 4, 5)
#define PG8_MMA(ai, bj, At, Bt, Z) do { __builtin_amdgcn_s_setprio(1); if constexpr (LOWP == 1) { _Pragma("unroll") for (int m = 0; m < 4; ++m) _Pragma("unroll") for (int n = 0; n < 2; ++n) \
        { const v8i_t b8_ = PG8_CAT8(Bt[n][0], Bt[n][1]), a8_ = PG8_CAT8(At[m][0], At[m][1]); \
          if (Z) asm volatile("v_mfma_f32_16x16x128_f8f6f4 %0, %1, %2, 0" : "=v"(acc[ai][bj][m][n]) : "v"(b8_), "v"(a8_)); \
          else asm volatile("v_mfma_f32_16x16x128_f8f6f4 %0, %1, %2, %0" : "+v"(acc[ai][bj][m][n]) : "v"(b8_), "v"(a8_)); } } \
        else if constexpr (LOWP == 2) { _Pragma("unroll") for (int m = 0; m < 4; ++m) _Pragma("unroll") for (int n = 0; n < 2; ++n) \
        { const v6i_t b6_ = PG8_CAT6(Bt[n][0], Bt[n][1]), a6_ = PG8_CAT6(At[m][0], At[m][1]); if (Z) acc[ai][bj][m][n] = (f32x4){0.f, 0.f, 0.f, 0.f}; asm volatile(FP6_PRE "v_mfma_f32_16x16x128_f8f6f4 %0, %1, %2, %0 cbsz:2 blgp:2" : "+v"(acc[ai][bj][m][n]) : "v"(b6_), "v"(a6_)); } } \
        else { _Pragma("unroll") for (int m = 0; m < 4; ++m) _Pragma("unroll") for (int n = 0; n < 2; ++n) { \
        acc[ai][bj][m][n] = __builtin_amdgcn_mfma_f32_16x16x32_bf16(Bt[n][0], At[m][0], (Z) ? (f32x4){0.f, 0.f, 0.f, 0.f} : acc[ai][bj][m][n], 0, 0, 0); \
        acc[ai][bj][m][n] = __builtin_amdgcn_mfma_f32_16x16x32_bf16(Bt[n][1], At[m][1], acc[ai][bj][m][n], 0, 0, 0); } } __builtin_amdgcn_s_setprio(0); } while (0)
#define PG8_WAIT_V(n) do { if (LOWP == 2 && FP6_DIAG_V0) asm volatile("s_waitcnt vmcnt(0)" ::: "memory"); else asm volatile("s_waitcnt vmcnt(" #n ")" ::: "memory"); } while (0)
#define PG8_WAIT_L(n) asm volatile("s_waitcnt lgkmcnt(" #n ")" ::: "memory")
#define PG8_BAR __builtin_amdgcn_s_barrier()
#define PG8_SCHED __builtin_amdgcn_sched_barrier(0)
    Unit cur, nxt; int ui = 0;
    if (!S.next(0, cur)) return;
    constexpr bool ZRESET = Epi::KEEPS || LOWP != 1;
    f32x4 acc[2][2][4][2];
    if constexpr (ZRESET) {
#pragma unroll
        for (int a = 0; a < 2; ++a)
#pragma unroll
            for (int b = 0; b < 2; ++b)
#pragma unroll
                for (int m = 0; m < 4; ++m)
#pragma unroll
                    for (int n = 0; n < 2; ++n) acc[a][b][m][n] = (f32x4){0.f, 0.f, 0.f, 0.f}; }
    bf16x8 At[4][2], B0[2][2], B1[2][2];
    const char* cA = GATHER ? Abase : cur.A; const char* cB = cur.B;
    if constexpr (GATHER) PG8_GATHER_OFFS(voffG, 0);
    PG8_STAGE_B(PG8_SB(0, 0), cB); PG8_STAGE_B(PG8_SB(0, 1), cB + hstepB); PG8_STAGE_A(PG8_SA(0, 0), cA, 0, false); PG8_STAGE_A(PG8_SA(0, 1), cA, 1, false);
    if (wr == 1) PG8_BAR;
    PG8_WAIT_V(2); PG8_BAR;
    PG8_STAGE_B(PG8_SB(1, 0), cB + kstep); PG8_STAGE_A(PG8_SA(1, 0), cA + kstep, 0, false); PG8_STAGE_B(PG8_SB(1, 1), cB + hstepB + kstep);
    PG8_WAIT_V(6); PG8_BAR;
    for (;;) {
        const bool has_next = S.next(ui + 1, nxt);
        if constexpr (GATHER) { if (has_next) PG8_GATHER_OFFS(nvoffG, ui + 1); else {
#pragma unroll
            for (int h = 0; h < 2; ++h)
#pragma unroll
                for (int i = 0; i < 2; ++i) nvoffG[h][i] = voffG[h][i]; } }
        const char* nA = GATHER ? Abase : (has_next ? nxt.A : cA); const char* nB = has_next ? nxt.B : cB;
#define PG8_ITER(t, ZF) do { \
            const bool last = ((t) == nt - 2); \
            const char* a1 = cA + (size_t)((t) + 1) * kstep; \
            const char* a2 = last ? nA : cA + (size_t)((t) + 2) * kstep; \
            const char* b2 = last ? nB : cB + (size_t)((t) + 2) * kstep + ((BJUMP && ((t) + 2) >= (nt >> 1)) ? cur.bjump : 0); \
            const char* a3 = a2 + kstep; const char* b3 = b2 + kstep; \
              \
            PG8_LDB(B0, 0, 0); PG8_LDB(B1, 0, 1); PG8_SCHED; PG8_LDA(At, 0, 0); PG8_STAGE_A(PG8_SA(1, 1), a1, 1, false); \
            PG8_WAIT_V(8); PG8_WAIT_L(0); PG8_BAR; PG8_MMA(0, 0, At, B0, ZF); PG8_MMA(0, 1, At, B1, ZF); PG8_BAR; PG8_SCHED; \
              \
            PG8_LDA(At, 0, 1); PG8_STAGE_B(PG8_SB(0, 0), b2); PG8_STAGE_B(PG8_SB(0, 1), b2 + hstepB); PG8_STAGE_A(PG8_SA(0, 0), a2, 0, last); \
            PG8_WAIT_V(8); PG8_WAIT_L(0); PG8_BAR; PG8_MMA(1, 0, At, B0, ZF); PG8_MMA(1, 1, At, B1, ZF); PG8_BAR; PG8_SCHED; \
              \
            PG8_LDB(B0, 1, 0); PG8_LDB(B1, 1, 1); PG8_SCHED; PG8_LDA(At, 1, 0); PG8_STAGE_A(PG8_SA(0, 1), a2, 1, last); \
            PG8_WAIT_V(8); PG8_WAIT_L(0); PG8_BAR; PG8_MMA(0, 0, At, B0, false); PG8_MMA(0, 1, At, B1, false); PG8_BAR; PG8_SCHED; \
              \
            PG8_LDA(At, 1, 1); PG8_STAGE_B(PG8_SB(1, 0), b3); PG8_STAGE_B(PG8_SB(1, 1), b3 + hstepB); PG8_STAGE_A(PG8_SA(1, 0), a3, 0, last); \
            PG8_WAIT_V(8); PG8_WAIT_L(0); PG8_BAR; PG8_MMA(1, 0, At, B0, false); PG8_MMA(1, 1, At, B1, false); PG8_BAR; PG8_SCHED; \
        } while (0)
        if constexpr (ZRESET) {
#pragma nounroll
            for (int t = 0; t < nt; t += 2) PG8_ITER(t, false);
        } else {
            PG8_ITER(0, true);
#pragma nounroll
            for (int t = 2; t < nt; t += 2) PG8_ITER(t, false);
        }
#undef PG8_ITER
        if constexpr (ALIGN_EPI) { if (wr == 0) PG8_BAR; }
        if constexpr (LOWP != 0) { asm volatile("s_nop 15\n\ts_nop 15" ::: "memory"); PG8_SCHED; }
        E(acc, cur, wr, wc, fr, fq);
        if (!has_next) break;
        if constexpr (ZRESET) { if (!E.keep_acc(cur)) {
#pragma unroll
            for (int a = 0; a < 2; ++a)
#pragma unroll
                for (int b = 0; b < 2; ++b)
#pragma unroll
                    for (int m = 0; m < 4; ++m)
#pragma unroll
                        for (int n = 0; n < 2; ++n) acc[a][b][m][n] = (f32x4){0.f, 0.f, 0.f, 0.f}; } }
        cur = nxt; cA = nA; cB = nB; ++ui;
        if constexpr (GATHER) {
#pragma unroll
            for (int h = 0; h < 2; ++h)
#pragma unroll
                for (int i = 0; i < 2; ++i) voffG[h][i] = nvoffG[h][i]; }
        if constexpr (ALIGN_EPI) { if (wr == 1) PG8_BAR; }
    }
    PG8_WAIT_V(0);
    if constexpr (!ALIGN_EPI) { if (wr == 0) PG8_BAR; }
    PG8_BAR;
#undef PG8_SA
#undef PG8_SB
#undef PG8_GLDS
#undef PG8_STAGE_A
#undef PG8_STAGE_B
#undef PG8_GATHER_OFFS
#undef PG8_LDA
#undef PG8_LDB
#undef PG8_MMA
#undef PG8_CAT8
#undef PG8_CAT6
#undef PG8_LD16
#undef PG8_LD8
#undef PG8_WAIT_V
#undef PG8_WAIT_L
#undef PG8_BAR
#undef PG8_SCHED
}
}

namespace swa {
typedef short bf16x8 __attribute__((ext_vector_type(8)));
typedef short s16x4 __attribute__((ext_vector_type(4)));
typedef float f32x16 __attribute__((ext_vector_type(16)));
constexpr int DH = 128, NW = 8, QBLK = 32, KVBLK = 64, QB = NW * QBLK;
constexpr int SHM_V = KVBLK * DH * 2, SHM_K = KVBLK * DH * 2;
constexpr int LDS_NEED = 2 * SHM_V + 2 * SHM_K + NW * 64 * 4;
constexpr float SCALE = 0.08838834764831845f, THR = 8.f;
#define KSWZ(row, colB) ((row) * 256 + ((colB) ^ (((row) & 7) << 4)))
#define SBAR() __builtin_amdgcn_sched_barrier(0)
__device__ __forceinline__ int v_st(int k, int c) { const int kk = (k & ~0xC) | ((k & 4) << 1) | ((k & 8) >> 1); return ((kk >> 3) * 4 + (c >> 5)) * 512 + ((kk & 7) * 32 + (c & 31)) * 2; }
__device__ __forceinline__ int v_rd_base(int lane) { return ((lane & 3) << 3) | (((lane >> 2) & 3) << 6) | (((lane >> 4) & 1) << 5) | (((lane >> 5) & 1) << 8); }
constexpr int v_rd_off(int d0, int ks, int half) { return d0 * 512 + ks * 4096 + half * 2048; }
__device__ __forceinline__ int crow(int r, int hi) { return (r & 3) + 8 * (r >> 2) + 4 * hi; }
__device__ __forceinline__ unsigned cvtpk(float lo, float hi) { unsigned r; asm volatile("v_cvt_pk_bf16_f32 %0, %1, %2" : "=v"(r) : "v"(lo), "v"(hi)); return r; }
__device__ __forceinline__ bf16x8 load8(const bf16_t* p) { return *reinterpret_cast<const bf16x8*>(p); }
__device__ __forceinline__ void mask_tile(f32x16& p0, f32x16& p1, int dq, unsigned W) {
    const float NEG = -__builtin_inff();
#pragma unroll
    for (int r = 0; r < 16; ++r) {
        const int c = (r & 3) + 8 * (r >> 2);
        if ((unsigned)(dq - c) >= W) p0[r] = NEG;
        if ((unsigned)(dq - c - 32) >= W) p1[r] = NEG;
    }
}
__device__ __forceinline__ void partialSM(f32x16& p0, f32x16& p1, float& m_reg, float& mn, float& alpha) {
    float pmax = p0[0]; for (int r = 1; r < 16; ++r) pmax = fmaxf(pmax, p0[r]); for (int r = 0; r < 16; ++r) pmax = fmaxf(pmax, p1[r]);
    { auto rr = __builtin_amdgcn_permlane32_swap(__float_as_uint(pmax), __float_as_uint(pmax), false, false);
      pmax = fmaxf(__uint_as_float(rr[0]), __uint_as_float(rr[1])); }
    constexpr float C2 = 1.4426950408889634f * SCALE;
    if (__builtin_expect(__all((pmax - m_reg) * SCALE <= THR), 1)) { mn = m_reg; alpha = 1.f; }
    else { mn = fmaxf(m_reg, pmax); alpha = __builtin_amdgcn_exp2f((m_reg - mn) * C2); m_reg = mn; }
    const float mnL = -mn * C2;
    for (int r = 0; r < 16; ++r) p0[r] = fmaf(p0[r], C2, mnL); for (int r = 0; r < 16; ++r) p1[r] = fmaf(p1[r], C2, mnL);
    for (int r = 0; r < 16; ++r) p0[r] = __builtin_amdgcn_exp2f(p0[r]);
}
__device__ __forceinline__ void finishSM(f32x16& p0, f32x16& p1, float alpha, float& l_reg, bf16x8& pa0, bf16x8& pa1, bf16x8& pa2, bf16x8& pa3) {
    for (int r = 0; r < 16; ++r) p1[r] = __builtin_amdgcn_exp2f(p1[r]);
    float ps = 0; for (int r = 0; r < 16; ++r) ps += p0[r]; for (int r = 0; r < 16; ++r) ps += p1[r];
    { auto rr = __builtin_amdgcn_permlane32_swap(__float_as_uint(ps), __float_as_uint(ps), false, false);
      ps = __uint_as_float(rr[0]) + __uint_as_float(rr[1]); }
    l_reg = l_reg * alpha + ps;
#define PK4(P, B_, OUT) do { unsigned a0 = cvtpk(P[B_+0], P[B_+1]), a1 = cvtpk(P[B_+2], P[B_+3]);                          \
        unsigned b0 = cvtpk(P[B_+4], P[B_+5]), b1 = cvtpk(P[B_+6], P[B_+7]);                                             \
        auto r0 = __builtin_amdgcn_permlane32_swap(a0, b0, false, false); auto r1 = __builtin_amdgcn_permlane32_swap(a1, b1, false, false); \
        u32x4 w = {r0[0], r1[0], r0[1], r1[1]}; OUT = *reinterpret_cast<bf16x8*>(&w); } while (0)
    PK4(p0, 0, pa0); PK4(p0, 8, pa1); PK4(p1, 0, pa2); PK4(p1, 8, pa3);
#undef PK4
}
template <int KB>
__device__ __forceinline__ void qkt(f32x16& p0, f32x16& p1, const char* K_lds, int r32, int hi, const bf16x8* qr, bool act) {
    if (!act) { const float NEG = -__builtin_inff();
#pragma unroll
        for (int r = 0; r < 16; ++r) { p0[r] = NEG; p1[r] = NEG; } return; }
    p0 = f32x16{}; p1 = f32x16{};
    const char* kb[4];
#pragma unroll
    for (int dd = 0; dd < 4; ++dd) kb[dd] = K_lds + KB * SHM_K + KSWZ(r32, (dd * 16 + hi * 8) * 2);
#pragma unroll
    for (int d0 = 0; d0 < 8; ++d0) { const char* a = kb[d0 & 3] + (d0 >> 2) * 128;
        bf16x8 b0 = *reinterpret_cast<const bf16x8*>(a);
        bf16x8 b1 = *reinterpret_cast<const bf16x8*>(a + 32 * 256);
        p0 = __builtin_amdgcn_mfma_f32_32x32x16_bf16(b0, qr[d0], p0, 0, 0, 0);
        p1 = __builtin_amdgcn_mfma_f32_32x32x16_bf16(b1, qr[d0], p1, 0, 0, 0); }
}
template <int VB>
__device__ __forceinline__ void pv_tile(f32x16* o, int vb0, bf16x8 pa0, bf16x8 pa1, bf16x8 pa2, bf16x8 pa3, bool act) {
    if (!act) return;
#define TRRD(dst, off) asm volatile("ds_read_b64_tr_b16 %0, %1 offset:%2" : "=&v"(dst) : "v"(vb0), "i"(off) : "memory")
#define PV_D0(d0) do { s16x4 l0, l1, l2, l3, h0, h1, h2, h3; constexpr int b_ = VB * SHM_V + v_rd_off(d0, 0, 0); \
        TRRD(l0, b_); TRRD(h0, b_ + 2048); TRRD(l1, b_ + 4096); TRRD(h1, b_ + 6144); TRRD(l2, b_ + 8192); TRRD(h2, b_ + 10240); TRRD(l3, b_ + 12288); TRRD(h3, b_ + 14336); \
        asm volatile("s_waitcnt lgkmcnt(0)" ::: "memory"); SBAR();   \
        o[d0] = __builtin_amdgcn_mfma_f32_32x32x16_bf16(pa0, (bf16x8){l0[0], l0[1], l0[2], l0[3], h0[0], h0[1], h0[2], h0[3]}, o[d0], 0, 0, 0);   \
        o[d0] = __builtin_amdgcn_mfma_f32_32x32x16_bf16(pa1, (bf16x8){l1[0], l1[1], l1[2], l1[3], h1[0], h1[1], h1[2], h1[3]}, o[d0], 0, 0, 0);   \
        o[d0] = __builtin_amdgcn_mfma_f32_32x32x16_bf16(pa2, (bf16x8){l2[0], l2[1], l2[2], l2[3], h2[0], h2[1], h2[2], h2[3]}, o[d0], 0, 0, 0);   \
        o[d0] = __builtin_amdgcn_mfma_f32_32x32x16_bf16(pa3, (bf16x8){l3[0], l3[1], l3[2], l3[3], h3[0], h3[1], h3[2], h3[3]}, o[d0], 0, 0, 0); } while (0)
    PV_D0(0); PV_D0(1); PV_D0(2); PV_D0(3);
#undef PV_D0
#undef TRRD
}
struct BlockRef { const bf16_t* Q; const bf16_t* K; const bf16_t* V; bf16_t* O; float* LSE; int P0, W, segmask, skv, ostride; };
struct Seam { bf16x8 qr[8]; bf16x8 st_v0, st_v1, st_k0, st_k1; };
__device__ __forceinline__ int imax(int a, int b) { return a > b ? a : b; }
__device__ __forceinline__ int blk_jlo(const BlockRef& b) { const int lowk = imax(b.P0 - b.W + 1, b.P0 & ~b.segmask); return lowk > 0 ? lowk / KVBLK : 0; }
#define ROW(p, k0, rr) ((p) + (size_t)((k0) + (rr)) * DH + sc)
#define VMW() asm volatile("s_waitcnt vmcnt(0)" ::: "memory")
#define VMWN(n) asm volatile("s_waitcnt vmcnt(%0)" :: "i"(n) : "memory")
#define SLOAD_H(Kp, Vp, k0) do { S.st_v0 = load8(ROW(Vp, k0, sr)); S.st_v1 = load8(ROW(Vp, k0, 32 + sr));              \
                         S.st_k0 = load8(ROW(Kp, k0, sr)); S.st_k1 = load8(ROW(Kp, k0, 32 + sr)); } while (0)
#define SWRITE_HK(bf) do { *(bf16x8*)(K_lds + (bf) * SHM_K + kws) = S.st_k0; *(bf16x8*)(K_lds + (bf) * SHM_K + kws + 32 * 256) = S.st_k1; } while (0)
#define SWRITE_HV(bf) do { *(bf16x8*)(V_lds + (bf) * SHM_V + vst0) = S.st_v0; *(bf16x8*)(V_lds + (bf) * SHM_V + vst1) = S.st_v1; } while (0)
#define SWRITE_H(bf) do { SWRITE_HV(bf); SWRITE_HK(bf); } while (0)
__device__ __forceinline__ void prime(const BlockRef& cur, char* lds, Seam& S, int wave_s) {
    const int tid = opaque_tid(wave_s), wid = __builtin_amdgcn_readfirstlane(tid >> 6), lane = tid & 63, r32 = lane & 31, hi = lane >> 5;
    const int sr = tid >> 4, sc = (tid & 15) * 8, kws = KSWZ(sr, sc * 2); char* K_lds = lds + 2 * SHM_V;
    const int kb0 = blk_jlo(cur) * KVBLK;
    for (int d0 = 0; d0 < 8; ++d0) S.qr[d0] = load8(cur.Q + (size_t)(wid * QBLK + r32) * DH + d0 * 16 + hi * 8);
    SLOAD_H(cur.K, cur.V, kb0); VMW(); SWRITE_HK(0);
    __syncthreads();
}
__device__ __forceinline__ void block(const BlockRef& cur, const BlockRef& nxt, char* lds, Seam& S, int wave_s) {
    const int tid = opaque_tid(wave_s), wid = __builtin_amdgcn_readfirstlane(tid >> 6), lane = tid & 63, r32 = lane & 31, hi = lane >> 5;
    const int W = cur.W;
    const int j_lo = blk_jlo(cur);
    int j_hi = (cur.P0 + QB - 1) / KVBLK + 1; if (j_hi > cur.skv / KVBLK) j_hi = cur.skv / KVBLK;
    const int NT = j_hi - j_lo;
    const int kbn = blk_jlo(nxt) * KVBLK;
    const int qlo = cur.P0 + wid * QBLK, qm = qlo + r32 - 4 * hi;
    const int segb = qlo & ~cur.segmask;
    const int lowk_w = imax(qlo - W + 1, segb);
    const int lowk_last = imax(qlo + QBLK - W, segb);
    const int wrow = ((qlo + r32) & cur.segmask) + 1;
    const unsigned Wl = (unsigned)(wrow < W ? wrow : W);
    char* V_lds = lds; char* K_lds = lds + 2 * SHM_V;
    float* ws = (float*)(lds + 2 * SHM_V + 2 * SHM_K) + wid * 64; float* li_l = ws, * al_l = ws + 32;
    float m_reg = -1e30f, l_reg = 0; f32x16 o[4] = {};
    const int sr = tid >> 4, sc = (tid & 15) * 8, vst0 = v_st(sr, sc), vst1 = v_st(32 + sr, sc), kws = KSWZ(sr, sc * 2);
    const int vb0 = (int)(uintptr_t)V_lds + v_rd_base(lane);
    const bf16_t* Kh = cur.K; const bf16_t* Vh = cur.V;
#define RESC(a) do { if (__any((a) < 1.f)) { if (hi == 0) al_l[r32] = (a); asm volatile("s_waitcnt lgkmcnt(0)" ::: "memory");              \
                     for (int d_ = 0; d_ < 4; ++d_) for (int r = 0; r < 16; ++r) o[d_][r] *= al_l[crow(r, hi)]; } } while (0)
#define KBASE(t) ((j_lo + (t)) * KVBLK)
#define ACT(t) (KBASE(t) <= qlo + QBLK - 1 && KBASE(t) + KVBLK - 1 >= lowk_w)
#define MASKT(P0_, P1_, t) do { const int kb_ = KBASE(t); if (ACT(t) && (kb_ + KVBLK - 1 > qlo || kb_ < lowk_last)) mask_tile(P0_, P1_, qm - kb_, Wl); } while (0)
    constexpr int NQL = 8;
#define SEAM_K0() do { VMWN(NQL); SWRITE_HK(0); SBAR(); } while (0)
    f32x16 pA0, pA1, pB0, pB1; float mnA, mnB, alA, alB; bf16x8 pa0, pa1, pa2, pa3;
    SWRITE_HV(0); SBAR();
    if (NT > 1) { SLOAD_H(Kh, Vh, KBASE(1)); }
    SBAR(); qkt<0>(pA0, pA1, K_lds, r32, hi, S.qr, ACT(0));
    MASKT(pA0, pA1, 0); partialSM(pA0, pA1, m_reg, mnA, alA);
    if (NT > 1) { VMW(); SWRITE_H(1); }
    __syncthreads();
#define HALF_STEP(PX0, PX1, mnX, alX, PY0, PY1, alY, t, KB, VB, SB) do {                                                      \
        SBAR(); if ((t) + 1 < NT) { SLOAD_H(Kh, Vh, KBASE((t) + 1)); SBAR(); }                                       \
        qkt<KB>(PX0, PX1, K_lds, r32, hi, S.qr, ACT(t));                                             \
        finishSM(PY0, PY1, alY, l_reg, pa0, pa1, pa2, pa3); SBAR();                                                           \
        pv_tile<VB>(o, vb0, pa0, pa1, pa2, pa3, ACT((t) - 1)); MASKT(PX0, PX1, (t)); partialSM(PX0, PX1, m_reg, mnX, alX);                                        \
        __syncthreads();                                                                                                      \
        if ((t) + 1 < NT) { VMW(); SWRITE_H(SB); }                                                                          \
        RESC(alX); __syncthreads(); } while (0)
    for (int t = 1; t + 1 < NT; t += 2) {
        HALF_STEP(pB0, pB1, mnB, alB, pA0, pA1, alA, t, 1, 0, 0);
        HALF_STEP(pA0, pA1, mnA, alA, pB0, pB1, alB, t + 1, 0, 1, 1);
    }
    const bool even = (NT & 1) == 0;
    if (even) { SBAR(); qkt<1>(pB0, pB1, K_lds, r32, hi, S.qr, ACT(NT - 1)); SBAR(); }
    SLOAD_H(nxt.K, nxt.V, kbn); SBAR();
#pragma unroll
    for (int d0 = 0; d0 < 8; ++d0) S.qr[d0] = load8(nxt.Q + (size_t)(wid * QBLK + r32) * DH + d0 * 16 + hi * 8);
    SBAR();
    finishSM(pA0, pA1, alA, l_reg, pa0, pa1, pa2, pa3); SBAR();
    pv_tile<0>(o, vb0, pa0, pa1, pa2, pa3, ACT(even ? NT - 2 : NT - 1));
    if (even) { MASKT(pB0, pB1, NT - 1); partialSM(pB0, pB1, m_reg, mnB, alB); __syncthreads(); RESC(alB);
        finishSM(pB0, pB1, alB, l_reg, pa0, pa1, pa2, pa3); SBAR(); pv_tile<1>(o, vb0, pa0, pa1, pa2, pa3, ACT(NT - 1)); }
    SBAR(); SEAM_K0();
    if (hi == 0) li_l[r32] = l_reg; asm volatile("s_waitcnt lgkmcnt(0)" ::: "memory");
    if (cur.LSE != nullptr && hi == 0) cur.LSE[wid * QBLK + r32] = m_reg * SCALE + __logf(l_reg);
    float rli[16];
#pragma unroll
    for (int r = 0; r < 16; ++r) rli[r] = __builtin_amdgcn_rcpf(li_l[crow(r, hi)]);
    bf16_t* Ow = cur.O + (size_t)(wid * QBLK) * cur.ostride;
#pragma unroll
    for (int r = 0; r < 16; ++r) { const int orow = crow(r, hi);
#pragma unroll
        for (int d0 = 0; d0 < 4; ++d0) { const float v = o[d0][r] * rli[r];
            const float vn = __shfl_xor(v, 1);
            if ((r32 & 1) == 0) *(unsigned*)(Ow + (size_t)orow * cur.ostride + d0 * 32 + r32) = cvtpk(v, vn); } }
    __syncthreads();
#undef RESC
#undef KBASE
#undef ACT
#undef MASKT
#undef SEAM_K0
#undef HALF_STEP
}

constexpr int RING_V = 4 * SHM_K;
__device__ __forceinline__ void qkt_rt(f32x16& p0, f32x16& p1, const LAS char* Kslot, int r32, int hi, const bf16x8* qr) {
    p0 = f32x16{}; p1 = f32x16{};
    const LAS char* kb[4];
#pragma unroll
    for (int dd = 0; dd < 4; ++dd) kb[dd] = Kslot + KSWZ(r32, (dd * 16 + hi * 8) * 2);
#pragma unroll
    for (int d0 = 0; d0 < 8; ++d0) { const LAS char* a = kb[d0 & 3] + (d0 >> 2) * 128;
        bf16x8 b0 = *(const LAS bf16x8*)(a);
        bf16x8 b1 = *(const LAS bf16x8*)(a + 32 * 256);
        p0 = __builtin_amdgcn_mfma_f32_32x32x16_bf16(b0, qr[d0], p0, 0, 0, 0);
        p1 = __builtin_amdgcn_mfma_f32_32x32x16_bf16(b1, qr[d0], p1, 0, 0, 0); }
}
__device__ __forceinline__ void pv_rt(f32x16* o, int vb, bf16x8 pa0, bf16x8 pa1, bf16x8 pa2, bf16x8 pa3) {
#define TRRD(dst, off) asm volatile("ds_read_b64_tr_b16 %0, %1 offset:%2" : "=&v"(dst) : "v"(vb), "i"(off) : "memory")
#define PV_D0(d0) do { s16x4 l0, l1, l2, l3, h0, h1, h2, h3; constexpr int b_ = v_rd_off(d0, 0, 0); \
        TRRD(l0, b_); TRRD(h0, b_ + 2048); TRRD(l1, b_ + 4096); TRRD(h1, b_ + 6144); TRRD(l2, b_ + 8192); TRRD(h2, b_ + 10240); TRRD(l3, b_ + 12288); TRRD(h3, b_ + 14336); \
        asm volatile("s_waitcnt lgkmcnt(0)" ::: "memory"); SBAR();   \
        o[d0] = __builtin_amdgcn_mfma_f32_32x32x16_bf16((bf16x8){l0[0], l0[1], l0[2], l0[3], h0[0], h0[1], h0[2], h0[3]}, pa0, o[d0], 0, 0, 0);   \
        o[d0] = __builtin_amdgcn_mfma_f32_32x32x16_bf16((bf16x8){l1[0], l1[1], l1[2], l1[3], h1[0], h1[1], h1[2], h1[3]}, pa1, o[d0], 0, 0, 0);   \
        o[d0] = __builtin_amdgcn_mfma_f32_32x32x16_bf16((bf16x8){l2[0], l2[1], l2[2], l2[3], h2[0], h2[1], h2[2], h2[3]}, pa2, o[d0], 0, 0, 0);   \
        o[d0] = __builtin_amdgcn_mfma_f32_32x32x16_bf16((bf16x8){l3[0], l3[1], l3[2], l3[3], h3[0], h3[1], h3[2], h3[3]}, pa3, o[d0], 0, 0, 0); } while (0)
    PV_D0(0); PV_D0(1); PV_D0(2); PV_D0(3);
#undef PV_D0
#undef TRRD
}
struct WaveState { float m, l; f32x16 o[4]; };
__device__ __forceinline__ void tile_step(WaveState& st, const bf16x8* qr, const LAS char* lds, int slot, int r32, int hi, int lane, bool need_mask, int dq, unsigned Wl) {
    f32x16 p0, p1; float mn, alpha; bf16x8 pa0, pa1, pa2, pa3;
    qkt_rt(p0, p1, lds + slot * SHM_K, r32, hi, qr);
    if (need_mask) mask_tile(p0, p1, dq, Wl);
    partialSM(p0, p1, st.m, mn, alpha);
    if (__any(alpha < 1.f)) {
#pragma unroll
        for (int d_ = 0; d_ < 4; ++d_)
#pragma unroll
            for (int r = 0; r < 16; ++r) st.o[d_][r] *= alpha; }
    finishSM(p0, p1, alpha, st.l, pa0, pa1, pa2, pa3); SBAR();
    pv_rt(st.o, (int)(unsigned)(uintptr_t)(lds + RING_V + slot * SHM_V) + v_rd_base(lane), pa0, pa1, pa2, pa3);
}
__device__ __forceinline__ void wave_store(const WaveState& st, bf16_t* Ow, int ostride, float* lse, int r32, int hi) {
    if (lse != nullptr && hi == 0) lse[r32] = st.m * SCALE + __logf(st.l);
    const float rl = __builtin_amdgcn_rcpf(st.l);
    bf16_t* rowp = Ow + (size_t)r32 * ostride + hi * 8;
#pragma unroll
    for (int d0 = 0; d0 < 4; ++d0)
#pragma unroll
        for (int k = 0; k < 4; k += 2) {
            unsigned ax = cvtpk(st.o[d0][4 * k] * rl, st.o[d0][4 * k + 1] * rl), ay = cvtpk(st.o[d0][4 * k + 2] * rl, st.o[d0][4 * k + 3] * rl);
            unsigned bx = cvtpk(st.o[d0][4 * k + 4] * rl, st.o[d0][4 * k + 5] * rl), by = cvtpk(st.o[d0][4 * k + 6] * rl, st.o[d0][4 * k + 7] * rl);
            { auto r = __builtin_amdgcn_permlane32_swap(ax, bx, false, false); ax = r[0]; bx = r[1]; }
            { auto r = __builtin_amdgcn_permlane32_swap(ay, by, false, false); ay = r[0]; by = r[1]; }
            *(u32x4*)(rowp + d0 * 32 + 8 * k) = (u32x4){ax, ay, bx, by};
        }
}
__device__ __forceinline__ void wave_store8(const WaveState& st, unsigned char* Ow, int ostride, int r32, int hi, float* lse = nullptr) {
    if (lse != nullptr && hi == 0) lse[r32] = st.m * SCALE + __logf(st.l);
    const float rl = O8_SCALE * __builtin_amdgcn_rcpf(st.l);
    unsigned char* rowp = Ow + (size_t)r32 * ostride + hi * 8;
#pragma unroll
    for (int d0 = 0; d0 < 4; ++d0)
#pragma unroll
        for (int k = 0; k < 4; k += 2) {
            unsigned a = pk4_fp8(st.o[d0][4 * k] * rl, st.o[d0][4 * k + 1] * rl, st.o[d0][4 * k + 2] * rl, st.o[d0][4 * k + 3] * rl);
            unsigned b = pk4_fp8(st.o[d0][4 * k + 4] * rl, st.o[d0][4 * k + 5] * rl, st.o[d0][4 * k + 6] * rl, st.o[d0][4 * k + 7] * rl);
            { auto r = __builtin_amdgcn_permlane32_swap(a, b, false, false); a = r[0]; b = r[1]; }
            *(u32x2*)(rowp + d0 * 32 + 8 * k) = (u32x2){a, b};
        }
}
__device__ __forceinline__ void wave_reset(WaveState& st) { st.m = -1e30f; st.l = 0.f;
#pragma unroll
    for (int d = 0; d < 4; ++d) st.o[d] = f32x16{}; }
#define HS_LOADQ(qr, Qrow0) do { _Pragma("unroll") for (int d0 = 0; d0 < 8; ++d0) qr[d0] = load8((Qrow0) + (size_t)(wid * QBLK + r32) * DH + d0 * 16 + hi * 8); } while (0)
#define HS_SLOAD(Kp, Vp, k0) do { st_v0 = load8(ROW(Vp, k0, sr)); st_v1 = load8(ROW(Vp, k0, 32 + sr)); st_k0 = load8(ROW(Kp, k0, sr)); st_k1 = load8(ROW(Kp, k0, 32 + sr)); } while (0)
#define HS_SWRITE(slot) do { *(LAS bf16x8*)(lds + (slot) * SHM_K + kws) = st_k0; *(LAS bf16x8*)(lds + (slot) * SHM_K + kws + 32 * 256) = st_k1; \
                             *(LAS bf16x8*)(lds + RING_V + (slot) * SHM_V + vst0) = st_v0; *(LAS bf16x8*)(lds + RING_V + (slot) * SHM_V + vst1) = st_v1; } while (0)
__device__ __forceinline__ bf16x8 fp8x8_to_bf16(u32x2 w) {
    const auto a = __builtin_amdgcn_cvt_pk_f32_fp8(w.x, false), b = __builtin_amdgcn_cvt_pk_f32_fp8(w.x, true), c = __builtin_amdgcn_cvt_pk_f32_fp8(w.y, false), d = __builtin_amdgcn_cvt_pk_f32_fp8(w.y, true);
    u32x4 o = {pk2(a[0], a[1]), pk2(b[0], b[1]), pk2(c[0], c[1]), pk2(d[0], d[1])}; return *reinterpret_cast<bf16x8*>(&o);
}
#define ROW8(p, k0, rr) ((const unsigned char*)(p) + (size_t)((k0) + (rr)) * (DH * 2) + sc)
#define HS_LOADQ8(Qrow0) do { _Pragma("unroll") for (int d0 = 0; d0 < 8; ++d0) qraw[d0] = *(const u32x2*)((const unsigned char*)(Qrow0) + (size_t)(wid * QBLK + r32) * (DH * 2) + d0 * 16 + hi * 8); } while (0)
#define HS_CVTQ() do { _Pragma("unroll") for (int d0 = 0; d0 < 8; ++d0) qr[d0] = fp8x8_to_bf16(qraw[d0]); } while (0)
#define HS_SLOAD8(Kp, Vp, k0) do { s8_v0 = *(const u32x2*)ROW8(Vp, k0, sr); s8_v1 = *(const u32x2*)ROW8(Vp, k0, 32 + sr); s8_k0 = *(const u32x2*)ROW8(Kp, k0, sr); s8_k1 = *(const u32x2*)ROW8(Kp, k0, 32 + sr); } while (0)
#define HS_SWRITE8(slot) do { *(LAS bf16x8*)(lds + (slot) * SHM_K + kws) = fp8x8_to_bf16(s8_k0); *(LAS bf16x8*)(lds + (slot) * SHM_K + kws + 32 * 256) = fp8x8_to_bf16(s8_k1); \
                              *(LAS bf16x8*)(lds + RING_V + (slot) * SHM_V + vst0) = fp8x8_to_bf16(s8_v0); *(LAS bf16x8*)(lds + RING_V + (slot) * SHM_V + vst1) = fp8x8_to_bf16(s8_v1); } while (0)
__device__ __forceinline__ void head_dilated(const bf16_t* Q, bf16_t* O, const bf16_t* K, const bf16_t* V, float* LSE, int segmask, LAS char* lds, LAS float* scr, int wave_s) {
    const int tid = opaque_tid(wave_s), wid = __builtin_amdgcn_readfirstlane(tid >> 6), lane = tid & 63, r32 = lane & 31, hi = lane >> 5, pair = wid >> 1;
    const int sr = tid >> 4, sc = (tid & 15) * 8, vst0 = v_st(sr, sc), vst1 = v_st(32 + sr, sc), kws = KSWZ(sr, sc * 2);
    constexpr int NT = 2048 / KVBLK, W = 129;
#if QKV_FP8
    u32x2 s8_v0, s8_v1, s8_k0, s8_k1, qraw[8]; bf16x8 qr[8]; WaveState st; wave_reset(st);
    HS_SLOAD8(K, V, 0); HS_LOADQ8(Q); VMW(); HS_SWRITE8(0); HS_CVTQ(); SBAR();
    HS_SLOAD8(K, V, KVBLK); VMW(); HS_SWRITE8(1);
#else
    bf16x8 st_v0, st_v1, st_k0, st_k1; bf16x8 qr[8]; WaveState st; wave_reset(st);
    HS_SLOAD(K, V, 0); HS_LOADQ(qr, Q); VMW(); HS_SWRITE(0); SBAR();
    HS_SLOAD(K, V, KVBLK); VMW(); HS_SWRITE(1);
#endif
    __syncthreads();
#if QKV_FP8
#pragma unroll 4
#endif
    for (int g = 1; g <= NT; ++g) {
        const bool ld = g + 1 < NT;
#if QKV_FP8
        if (ld) { HS_SLOAD8(K, V, (g + 1) * KVBLK); SBAR(); }
#else
        if (ld) { HS_SLOAD(K, V, (g + 1) * KVBLK); SBAR(); }
#endif
        const int ph = (g - 1) & 3, qb = (g - 1) >> 2;
#if QKV_FP8
        if (ph == 0 && g > 1) HS_CVTQ();
#endif
        if (ph != 3) {
            const int T = g - 3 + pair, qlo = qb * QB + wid * QBLK, segb = qlo & ~segmask;
            const int lowk_w = imax(qlo - W + 1, segb), lowk_last = imax(qlo + QBLK - W, segb), kb_ = T * KVBLK;
            if (T >= 0 && kb_ <= qlo + QBLK - 1 && kb_ + KVBLK - 1 >= lowk_w) {
                const int wrow = ((qlo + r32) & segmask) + 1;
                tile_step(st, qr, lds, T & 3, r32, hi, lane, (kb_ + KVBLK - 1 > qlo) || (kb_ < lowk_last), qlo + r32 - 4 * hi - kb_, (unsigned)(wrow < W ? wrow : W));
            }
#if QKV_FP8
            if (ph == 2 && qb + 1 < 2048 / QB) { SBAR(); HS_LOADQ8(Q + (size_t)(qb + 1) * QB * DH); }
#else
            if (ph == 2 && qb + 1 < 2048 / QB) { SBAR(); HS_LOADQ(qr, Q + (size_t)(qb + 1) * QB * DH); }
#endif
        } else {
#if O_FP8 && P4_FP8
            wave_store8(st, (unsigned char*)(O + (size_t)(qb * QB + wid * QBLK) * DH), 2 * DH, r32, hi, LSE + qb * QB + wid * QBLK);
#else
            wave_store(st, O + (size_t)(qb * QB + wid * QBLK) * DH, DH, LSE + qb * QB + wid * QBLK, r32, hi);
#endif
            wave_reset(st);
        }
        __syncthreads();
#if QKV_FP8
        if (ld) { HS_SWRITE8((g + 1) & 3); }
#else
        if (ld) { HS_SWRITE((g + 1) & 3); }
#endif
        __syncthreads();
    }
}
__device__ __forceinline__ void head_mem(const bf16_t* Q, const bf16_t* K, const bf16_t* V, bf16_t* O, int ostride, LAS char* lds, LAS float* scr, int wave_s) {
    const int tid = opaque_tid(wave_s), wid = __builtin_amdgcn_readfirstlane(tid >> 6), lane = tid & 63, r32 = lane & 31, hi = lane >> 5, pair = wid >> 1;
    const int sr = tid >> 4, sc = (tid & 15) * 8, vst0 = v_st(sr, sc), vst1 = v_st(32 + sr, sc), kws = KSWZ(sr, sc * 2);
    bf16x8 st_v0, st_v1, st_k0, st_k1; bf16x8 qr[8]; WaveState st;
#pragma unroll
    for (int t = 0; t < 4; ++t) { HS_SLOAD(K, V, t * KVBLK); VMW(); HS_SWRITE(t); SBAR(); }
    __syncthreads();
    for (int qb = 0; qb < 2048 / QB; ++qb) {
        HS_LOADQ(qr, Q + (size_t)qb * QB * DH); wave_reset(st);
        for (int t = 0; t < 4; ++t) tile_step(st, qr, lds, (t + pair) & 3, r32, hi, lane, false, 0, 0u);
#if P4_FP8
        wave_store8(st, (unsigned char*)O + (size_t)(qb * QB + wid * QBLK) * ostride, ostride, r32, hi);
#else
        wave_store(st, O + (size_t)(qb * QB + wid * QBLK) * ostride, ostride, nullptr, r32, hi);
#endif
    }
    __syncthreads();
}
#undef HS_LOADQ
#undef HS_LOADQ8
#undef HS_CVTQ
#undef HS_SLOAD8
#undef HS_SWRITE8
#undef ROW8
#undef HS_SLOAD
#undef HS_SWRITE
#undef ROW
#undef VMW
#undef VMWN
#undef SLOAD_H
#undef SWRITE_HK
#undef SWRITE_HV
#undef SWRITE_H
#undef KSWZ
#undef SBAR
}

#define XB_TMO      128
#define XB_XCNT(j)  (256  + 64 * (j))
#define XB_XSUB(j)  (1280 + 64 * (j))
#define XB_XGEN(j)  (2304 + 64 * (j))
#define XB_TOP      3328
#define XB_TOPGEN   3392
#define XCD_BAR_WORDS 3456
#define XB_SPIN_CAP (1u << 18)
__device__ __forceinline__ unsigned xb_ld(unsigned* p)              { return __hip_atomic_load(p, __ATOMIC_RELAXED, __HIP_MEMORY_SCOPE_AGENT); }
__device__ __forceinline__ unsigned xb_add(unsigned* p, unsigned v) { return __hip_atomic_fetch_add(p, v, __ATOMIC_RELAXED, __HIP_MEMORY_SCOPE_AGENT); }
__device__ __forceinline__ unsigned xb_xcc_id() { return (unsigned)__builtin_amdgcn_s_getreg((3 << 11) | 20) & 0xFu; }
#define XB_SPIN(cond, bar) do { unsigned _sp = 0; while (cond) { __builtin_amdgcn_s_sleep(1); \
    if ((++_sp & 255u) == 0u) { if (xb_ld(&(bar)[XB_TMO])) break; if (_sp > XB_SPIN_CAP) { atomicAdd(&(bar)[XB_TMO], 1u); break; } } } } while (0)
struct XcdBarrier { unsigned* bar; unsigned x; volatile LAS unsigned* st; };
__device__ __forceinline__ XcdBarrier xcd_barrier_post(unsigned* bar, volatile LAS unsigned* st) {
    XcdBarrier b; b.bar = bar; b.x = xb_xcc_id(); b.st = st;
    if (threadIdx.x == 0) (void)xb_add(&bar[XB_XCNT(b.x)], 1u);
    return b;
}
__device__ __forceinline__ void xcd_barrier_complete(unsigned* bar, unsigned x, unsigned& nloc, unsigned& nx) {
    const unsigned G = gridDim.x * gridDim.y * gridDim.z;
    unsigned sum, cnt, mine, sp = 0u;
    for (;;) {
        sum = 0u; cnt = 0u; mine = 0u;
#pragma unroll
        for (unsigned j = 0; j < 16; ++j) { const unsigned c = xb_ld(&bar[XB_XCNT(j)]); sum += c; cnt += (c > 0u) ? 1u : 0u; mine = (j == x) ? c : mine; }
        if (sum == G) break;
        __builtin_amdgcn_s_sleep(1);
        if ((++sp & 255u) == 0u) { if (xb_ld(&bar[XB_TMO])) break; if (sp > XB_SPIN_CAP) { atomicAdd(&bar[XB_TMO], 1u); break; } }
    }
    nloc = mine > 0u ? mine : 1u; nx = cnt > 0u ? cnt : 1u;
}
__device__ __forceinline__ void xcd_barrier(const XcdBarrier& b) {
    asm volatile("s_waitcnt vmcnt(0)" ::: "memory");
    __syncthreads();
    if (threadIdx.x == 0) {
        unsigned* bar = b.bar; asm volatile("" : "+s"(bar)); bar = (unsigned*)(GAS unsigned*)bar;
        __builtin_amdgcn_s_waitcnt(0);
        unsigned nloc = b.st[0], nx = b.st[1];
        if (nloc == 0u) { xcd_barrier_complete(bar, b.x, nloc, nx); b.st[0] = nloc; b.st[1] = nx; }
        const unsigned old = xb_add(&bar[XB_XSUB(b.x)], 1u);
        const unsigned gen = old / nloc;
        if (old + 1u == (gen + 1u) * nloc) {
            __builtin_amdgcn_fence(__ATOMIC_RELEASE, "agent");
            asm volatile("s_waitcnt vmcnt(0)" ::: "memory");
            const unsigned og = xb_add(&bar[XB_TOP], 1u);
            const unsigned tg = og / nx;
            if (og + 1u == (tg + 1u) * nx) xb_add(&bar[XB_TOPGEN], 1u);
            else XB_SPIN(xb_ld(&bar[XB_TOPGEN]) == tg, bar);
            __builtin_amdgcn_fence(__ATOMIC_ACQUIRE, "agent");
            xb_add(&bar[XB_XGEN(b.x)], 1u);
            asm volatile("s_waitcnt vmcnt(0)" ::: "memory");
        } else {
            XB_SPIN(xb_ld(&bar[XB_XGEN(b.x)]) == gen, bar);
            __builtin_amdgcn_fence(__ATOMIC_ACQUIRE, "agent");
            asm volatile("s_waitcnt vmcnt(0)" ::: "memory");
        }
    }
    __syncthreads();
}
constexpr int CW_BAR = 4096, CW_CONVQ = 96;

#define ACC8(ai, bj, m) {acc[ai][bj][m][0][0], acc[ai][bj][m][0][1], acc[ai][bj][m][0][2], acc[ai][bj][m][0][3], acc[ai][bj][m][1][0], acc[ai][bj][m][1][1], acc[ai][bj][m][1][2], acc[ai][bj][m][1][3]}
struct FastEpiMain {
    static constexpr bool PERM = true, KEEPS = false; EpiMain mn; EpiKV kv; float ascale;
    __device__ __forceinline__ bool keep_acc(const pg8::Unit&) const { return false; }
    __device__ __forceinline__ void operator()(f32x4 (&acc)[2][2][4][2], const pg8::Unit& u, int wr, int wc, int fr, int fq) const {
        asm volatile("" : "+v"(fr), "+v"(fq));
        const int rowb = u.row0 + wr * 64 + fr, colb = u.col0 + wc * 32 + 8 * fq;
        if (u.aux != 0) {
#pragma unroll
            for (int ai = 0; ai < 2; ++ai)
#pragma unroll
                for (int m = 0; m < 4; ++m)
#pragma unroll
                    for (int bj = 0; bj < 2; ++bj) { float v[8] = ACC8(ai, bj, m); kv(rowb + ai * 128 + m * 16, colb + bj * 128, v); }
            return;
        }
        f32x4 bb[2][2];
#pragma unroll
        for (int bj = 0; bj < 2; ++bj) { bb[bj][0] = *(const f32x4*)(mn.biasp + colb + bj * 128); bb[bj][1] = *(const f32x4*)(mn.biasp + colb + bj * 128 + 4); }
        float fpos[2][4];
#pragma unroll
        for (int ai = 0; ai < 2; ++ai)
#pragma unroll
            for (int m = 0; m < 4; ++m) fpos[ai][m] = 0.f;
        if (u.col0 < C_V) {
#pragma unroll
            for (int ai = 0; ai < 2; ++ai)
#pragma unroll
                for (int m = 0; m < 4; ++m) fpos[ai][m] = (float)mn.pos[mn.tok0 + rowb + ai * 128 + m * 16];
        }
        if (u.col0 >= C_GATE) {
            typedef float v2f_t __attribute__((ext_vector_type(2)));
            const float s2 = -1.4426950408889634f * ascale; v2f_t bp[2][4];
#pragma unroll
            for (int bj = 0; bj < 2; ++bj) { bp[bj][0] = (v2f_t){bb[bj][0].x, bb[bj][0].y} * -1.4426950408889634f; bp[bj][1] = (v2f_t){bb[bj][0].z, bb[bj][0].w} * -1.4426950408889634f;
                bp[bj][2] = (v2f_t){bb[bj][1].x, bb[bj][1].y} * -1.4426950408889634f; bp[bj][3] = (v2f_t){bb[bj][1].z, bb[bj][1].w} * -1.4426950408889634f; }
            unsigned char* gp = (unsigned char*)mn.GATES + (size_t)rowb * 3072 + (colb - C_GATE);
#pragma unroll
            for (int ai = 0; ai < 2; ++ai)
#pragma unroll
                for (int m = 0; m < 4; ++m)
#pragma unroll
                    for (int bj = 0; bj < 2; ++bj) { const f32x4 a0 = acc[ai][bj][m][0], a1 = acc[ai][bj][m][1];
                        const v2f_t t[4] = {__builtin_elementwise_fma((v2f_t){a0.x, a0.y}, (v2f_t){s2, s2}, bp[bj][0]), __builtin_elementwise_fma((v2f_t){a0.z, a0.w}, (v2f_t){s2, s2}, bp[bj][1]),
                                            __builtin_elementwise_fma((v2f_t){a1.x, a1.y}, (v2f_t){s2, s2}, bp[bj][2]), __builtin_elementwise_fma((v2f_t){a1.z, a1.w}, (v2f_t){s2, s2}, bp[bj][3])};
                        unsigned w[2] = {0u, 0u};
#pragma unroll
                        for (int q = 0; q < 4; ++q) { v2f_t r;
#pragma unroll
                            for (int e = 0; e < 2; ++e) r[e] = __builtin_amdgcn_rcpf(__builtin_amdgcn_fmed3f(__builtin_fmaf(__builtin_amdgcn_exp2f(t[q][e]), 1.0f / 255.0f, 1.0f / 255.0f), 0.0f, 1.0f));
                            r = r + (v2f_t){0.5f, 0.5f};
                            w[q >> 1] = __builtin_amdgcn_cvt_pk_u8_f32(r[0], 2 * (q & 1), w[q >> 1]); w[q >> 1] = __builtin_amdgcn_cvt_pk_u8_f32(r[1], 2 * (q & 1) + 1, w[q >> 1]); }
                        *(u32x2*)(gp + (size_t)(ai * 128 + m * 16) * 3072 + bj * 128) = (u32x2){w[0], w[1]}; }
            return;
        }
        float invrev[4]; EpiMain::rope_freqs(colb, invrev);
#define FEM_LOOP(S_) do { _Pragma("unroll") for (int ai = 0; ai < 2; ++ai) _Pragma("unroll") for (int m = 0; m < 4; ++m) _Pragma("unroll") for (int bj = 0; bj < 2; ++bj) { float v[8] = ACC8(ai, bj, m); \
            _Pragma("unroll") for (int q = 0; q < 8; ++q) v[q] *= ascale; \
            v[0] += bb[bj][0].x; v[1] += bb[bj][0].y; v[2] += bb[bj][0].z; v[3] += bb[bj][0].w; v[4] += bb[bj][1].x; v[5] += bb[bj][1].y; v[6] += bb[bj][1].z; v[7] += bb[bj][1].w; \
            mn.template finish_s<S_>(rowb + ai * 128 + m * 16, colb + bj * 128, v, fpos[ai][m], invrev); } } while (0)
        if (u.col0 < C_GLU) {
            typedef float v2f_t __attribute__((ext_vector_type(2)));
            const int sec = u.col0 / 1536, r0 = colb - sec * 1536, gh0 = (u.col0 - sec * 1536) >> 7, pcol = r0 & 127, g = gh0 >> 2, sh = 2 * g;
            const int bl = rowb >> 11, s0 = rowb & 2047;
            bf16_t* p0 = mn.QG + (size_t)sec * (SZ_QKV1 / 2) + ((size_t)(bl * 12 + gh0) * 2048 + rowperm(g, s0)) * 128 + pcol;
            asm volatile("" : "+v"(invrev[0]), "+v"(invrev[1]), "+v"(invrev[2]), "+v"(invrev[3]));
#define FEM_QKV(ROT) do { _Pragma("unroll") for (int ai = 0; ai < 2; ++ai) _Pragma("unroll") for (int m = 0; m < 4; ++m) { \
                v2f_t C_[2], S_[2]; \
                if (ROT) { float c4[4], s4[4]; _Pragma("unroll") for (int e = 0; e < 4; ++e) { const float rev = __builtin_amdgcn_fractf(fpos[ai][m] * invrev[e]); s4[e] = __builtin_amdgcn_sinf(rev); c4[e] = __builtin_amdgcn_cosf(rev); } \
                    C_[0] = (v2f_t){c4[0], c4[1]}; C_[1] = (v2f_t){c4[2], c4[3]}; S_[0] = (v2f_t){s4[0], s4[1]}; S_[1] = (v2f_t){s4[2], s4[3]}; } \
                bf16_t* pr = p0 + (size_t)((16 * m + 128 * ai) >> sh) * 128; \
                _Pragma("unroll") for (int bj = 0; bj < 2; ++bj) { const f32x4 a0 = acc[ai][bj][m][0], a1 = acc[ai][bj][m][1]; const v2f_t as2 = {ascale, ascale}; \
                    v2f_t X[2] = {__builtin_elementwise_fma((v2f_t){a0.x, a0.y}, as2, (v2f_t){bb[bj][0].x, bb[bj][0].y}), __builtin_elementwise_fma((v2f_t){a0.z, a0.w}, as2, (v2f_t){bb[bj][0].z, bb[bj][0].w})}; \
                    v2f_t Y[2] = {__builtin_elementwise_fma((v2f_t){a1.x, a1.y}, as2, (v2f_t){bb[bj][1].x, bb[bj][1].y}), __builtin_elementwise_fma((v2f_t){a1.z, a1.w}, as2, (v2f_t){bb[bj][1].z, bb[bj][1].w})}; \
                    if (ROT) { _Pragma("unroll") for (int h = 0; h < 2; ++h) { const v2f_t x_ = X[h], y_ = Y[h]; X[h] = __builtin_elementwise_fma(-y_, S_[h], x_ * C_[h]); Y[h] = __builtin_elementwise_fma(x_, S_[h], y_ * C_[h]); } } \
                    if (QKV_FP8) { u32x2 o8; o8.x = pk4_fp8(X[0].x, X[0].y, X[1].x, X[1].y); o8.y = pk4_fp8(Y[0].x, Y[0].y, Y[1].x, Y[1].y); \
                        *(u32x2*)((unsigned char*)(pr - pcol) + pcol + (size_t)bj * (2048 * 256)) = o8; }     \
                    else { u32x4 o; o.x = pk2(X[0].x, X[0].y); o.y = pk2(X[1].x, X[1].y); o.z = pk2(Y[0].x, Y[0].y); o.w = pk2(Y[1].x, Y[1].y); \
                        *(u32x4*)(pr + (size_t)bj * (2048 * 128)) = o; } } } } while (0)
            if (u.col0 < C_V) FEM_QKV(true); else FEM_QKV(false);
#undef FEM_QKV
            return;
        }
        if (u.col0 < C_QM) FEM_LOOP(2); else FEM_LOOP(3);
#undef FEM_LOOP
    }
};
struct FastEpiGates {
    static constexpr bool PERM = true, KEEPS = false; const float* biasp; bf16_t* GATES; float ascale;
    __device__ __forceinline__ bool keep_acc(const pg8::Unit&) const { return false; }
    __device__ __forceinline__ void operator()(f32x4 (&acc)[2][2][4][2], const pg8::Unit& u, int wr, int wc, int fr, int fq) const {
        asm volatile("" : "+v"(fr), "+v"(fq));
        const int rowb = u.row0 + wr * 64 + fr, colb = u.col0 + wc * 32 + 8 * fq;
        f32x4 bb[2][2];
#pragma unroll
        for (int bj = 0; bj < 2; ++bj) { bb[bj][0] = *(const f32x4*)(biasp + colb + bj * 128); bb[bj][1] = *(const f32x4*)(biasp + colb + bj * 128 + 4); }
#pragma unroll
        for (int ai = 0; ai < 2; ++ai)
#pragma unroll
            for (int m = 0; m < 4; ++m)
#pragma unroll
                for (int bj = 0; bj < 2; ++bj) { const f32x4 a = acc[ai][bj][m][0] * ascale + bb[bj][0], b = acc[ai][bj][m][1] * ascale + bb[bj][1];
                    u32x4 o; o.x = pk2(sigmoidf_(a.x), sigmoidf_(a.y)); o.y = pk2(sigmoidf_(a.z), sigmoidf_(a.w)); o.z = pk2(sigmoidf_(b.x), sigmoidf_(b.y)); o.w = pk2(sigmoidf_(b.z), sigmoidf_(b.w));
                    *(u32x4*)(GATES + (size_t)(rowb + ai * 128 + m * 16) * 3072 + (colb + bj * 128 - C_GATE)) = o; }
    }
};
constexpr float P4_ASCALE = P4_FP8 ? 1.0f / (O8_SCALE * W8_SCALE) : 1.0f;
struct FastEpiMerge {
    static constexpr bool PERM = true, KEEPS = true; const bf16_t* GATES; bf16_t* MERGED;
    __device__ __forceinline__ bool keep_acc(const pg8::Unit& u) const { return u.aux < 2; }
    __device__ __forceinline__ void operator()(f32x4 (&acc)[2][2][4][2], const pg8::Unit& u, int wr, int wc, int fr, int fq) const {
        asm volatile("" : "+v"(fr), "+v"(fq));
        const int rowb = u.row0 + wr * 64 + fr, colb = u.col0 + wc * 32 + 8 * fq, br = u.aux;
        const unsigned char* gp = (const unsigned char*)GATES + (size_t)rowb * 3072 + br * 1024 + colb;
        bf16_t* mp = MERGED + (size_t)rowb * 1024 + colb;
#pragma unroll
        for (int ai = 0; ai < 2; ++ai) {
            u32x2 tg[4][2], tn[4][2];
#pragma unroll
            for (int m = 0; m < 4; ++m)
#pragma unroll
                for (int bj = 0; bj < 2; ++bj) { tg[m][bj] = *(const u32x2*)(gp + (size_t)(ai * 128 + m * 16) * 3072 + bj * 128);
                    if (br < 2) tn[m][bj] = *(const u32x2*)(gp + 1024 + (size_t)(ai * 128 + m * 16) * 3072 + bj * 128); }
            if (br < 2) {
#pragma unroll
                for (int m = 0; m < 4; ++m)
#pragma unroll
                    for (int bj = 0; bj < 2; ++bj) { const u32x2 g = tg[m][bj], n = tn[m][bj]; const f32x4 n0 = u8x4_raw(n.x), n1 = u8x4_raw(n.y);
                        const f32x4 r0 = {__builtin_amdgcn_rcpf(n0.x), __builtin_amdgcn_rcpf(n0.y), __builtin_amdgcn_rcpf(n0.z), __builtin_amdgcn_rcpf(n0.w)}, r1 = {__builtin_amdgcn_rcpf(n1.x), __builtin_amdgcn_rcpf(n1.y), __builtin_amdgcn_rcpf(n1.z), __builtin_amdgcn_rcpf(n1.w)};
                        acc[ai][bj][m][0] = acc[ai][bj][m][0] * (u8x4_raw(g.x) * r0); acc[ai][bj][m][1] = acc[ai][bj][m][1] * (u8x4_raw(g.y) * r1); }
            } else {
#pragma unroll
                for (int m = 0; m < 4; ++m)
#pragma unroll
                    for (int bj = 0; bj < 2; ++bj) { const u32x2 g = tg[m][bj];
#if P5_FP8
                        const f32x4 a = acc[ai][bj][m][0] * (u8x4_raw(g.x) * (P4_ASCALE * M8_SCALE / 255.0f)), b = acc[ai][bj][m][1] * (u8x4_raw(g.y) * (P4_ASCALE * M8_SCALE / 255.0f));
                        u32x2 o; o.x = pk4_fp8(a.x, a.y, a.z, a.w); o.y = pk4_fp8(b.x, b.y, b.z, b.w);
                        *(u32x2*)((unsigned char*)MERGED + (size_t)(rowb + ai * 128 + m * 16) * 1024 + colb + bj * 128) = o;
#else
                        const f32x4 a = acc[ai][bj][m][0] * (u8x4_raw(g.x) * (P4_ASCALE / 255.0f)), b = acc[ai][bj][m][1] * (u8x4_raw(g.y) * (P4_ASCALE / 255.0f));
                        u32x4 o; o.x = pk2(a.x, a.y); o.y = pk2(a.z, a.w); o.z = pk2(b.x, b.y); o.w = pk2(b.z, b.w);
                        *(u32x4*)(mp + (size_t)(ai * 128 + m * 16) * 1024 + bj * 128) = o;
#endif
                    }
            }
            asm volatile("" ::: "memory");
        }
    }
};
struct FastEpiStore8 {
    static constexpr bool PERM = true, KEEPS = false; unsigned char* O; int ld; float scale;
    __device__ __forceinline__ bool keep_acc(const pg8::Unit&) const { return false; }
    __device__ __forceinline__ void operator()(f32x4 (&acc)[2][2][4][2], const pg8::Unit& u, int wr, int wc, int fr, int fq) const {
        asm volatile("" : "+v"(fr), "+v"(fq));
        const int rowb = u.row0 + wr * 64 + fr, colb = u.col0 + wc * 32 + 8 * fq;
#pragma unroll
        for (int ai = 0; ai < 2; ++ai)
#pragma unroll
            for (int m = 0; m < 4; ++m)
#pragma unroll
                for (int bj = 0; bj < 2; ++bj) { const f32x4 a = acc[ai][bj][m][0] * scale, b = acc[ai][bj][m][1] * scale;
                    u32x2 o; o.x = pk4_fp8s(a.x, a.y, a.z, a.w); o.y = pk4_fp8s(b.x, b.y, b.z, b.w);
                    *(u32x2*)(O + (size_t)(rowb + ai * 128 + m * 16) * ld + colb + bj * 128) = o; }
    }
};
struct FastEpiStore {
    static constexpr bool PERM = true, KEEPS = false; bf16_t* O; int ld; float scale;
    __device__ __forceinline__ bool keep_acc(const pg8::Unit&) const { return false; }
    __device__ __forceinline__ void operator()(f32x4 (&acc)[2][2][4][2], const pg8::Unit& u, int wr, int wc, int fr, int fq) const {
        asm volatile("" : "+v"(fr), "+v"(fq));
        const int rowb = u.row0 + wr * 64 + fr, colb = u.col0 + wc * 32 + 8 * fq;
#pragma unroll
        for (int ai = 0; ai < 2; ++ai)
#pragma unroll
            for (int m = 0; m < 4; ++m)
#pragma unroll
                for (int bj = 0; bj < 2; ++bj) { const f32x4 a = acc[ai][bj][m][0] * scale, b = acc[ai][bj][m][1] * scale;
                    u32x4 o; o.x = pk2(a.x, a.y); o.y = pk2(a.z, a.w); o.z = pk2(b.x, b.y); o.w = pk2(b.z, b.w);
                    *(u32x4*)(O + (size_t)(rowb + ai * 128 + m * 16) * ld + colb + bj * 128) = o; }
    }
};
struct FastEpiNull {
    static constexpr bool PERM = true, KEEPS = false; bf16_t* O;
    __device__ __forceinline__ bool keep_acc(const pg8::Unit&) const { return false; }
    __device__ __forceinline__ void operator()(f32x4 (&acc)[2][2][4][2], const pg8::Unit& u, int wr, int wc, int fr, int fq) const {
        float s = 0.f;
#pragma unroll
        for (int ai = 0; ai < 2; ++ai)
#pragma unroll
            for (int m = 0; m < 4; ++m)
#pragma unroll
                for (int bj = 0; bj < 2; ++bj) { const f32x4 a = acc[ai][bj][m][0], b = acc[ai][bj][m][1]; s += a.x + a.y + a.z + a.w + b.x + b.y + b.z + b.w; }
        if (s == 1.2345e38f) O[u.row0 + fr] = (bf16_t)1;
    }
};
struct FastEpiMoe1 {
    static constexpr bool PERM = true, KEEPS = false; LAS const int* toktab; const float* wts; unsigned char* H8;
    __device__ __forceinline__ bool keep_acc(const pg8::Unit&) const { return false; }
    __device__ __forceinline__ void operator()(f32x4 (&acc)[2][2][4][2], const pg8::Unit& u, int wr, int wc, int fr, int fq) const {
        asm volatile("" : "+v"(fr), "+v"(fq));
        const int rloc = wr * 64 + fr, colb = u.col0 + wc * 32 + 8 * fq, hi = u.col0 >> 10;
        float w[2][4];
#pragma unroll
        for (int ai = 0; ai < 2; ++ai)
#pragma unroll
            for (int m = 0; m < 4; ++m) { const int tok = toktab[u.aux * 256 + rloc + ai * 128 + m * 16]; w[ai][m] = wts[(size_t)tok * 2 + hi] * (H8_SCALE / W8_SCALE); }
        constexpr float inv = 1.0f / W8_SCALE;
#pragma unroll
        for (int ai = 0; ai < 2; ++ai)
#pragma unroll
            for (int m = 0; m < 4; ++m)
#pragma unroll
                for (int bj = 0; bj < 2; ++bj) { const f32x4 gt = acc[ai][bj][m][0] * inv, up = acc[ai][bj][m][1]; const float ww = w[ai][m];
                    const int j0 = hi * 512 + (((colb + bj * 128) & 1023) >> 1);
                    float h[4] = {gt.x * sigmoidf_(gt.x) * up.x * ww, gt.y * sigmoidf_(gt.y) * up.y * ww, gt.z * sigmoidf_(gt.z) * up.z * ww, gt.w * sigmoidf_(gt.w) * up.w * ww};
#pragma unroll
                    for (int q = 0; q < 4; ++q) h[q] = fminf(fmaxf(h[q], -448.f), 448.f);
                    *(unsigned*)(H8 + (size_t)(u.row0 + rloc + ai * 128 + m * 16) * 1024 + j0) = pk4_fp8(h[0], h[1], h[2], h[3]); }
    }
};
#undef ACC8

struct SchedMain {
    pg8::TileOrder to; int nkv, tile0, cut, skip; size_t astep, bstep; const char *XB, *WIN, *MEMB, *WKV;
    __device__ __forceinline__ bool next(int i, pg8::Unit& u) const {
        int pm, pn;
        if (to.tile(i, pm, pn)) { const int ct = tile0 + (pn < cut ? pn : pn + skip); u.A = XB + (size_t)pm * astep; u.B = WIN + (size_t)ct * bstep; u.row0 = pm * 256; u.col0 = ct * 256; u.bjump = 0; u.aux = 0; return true; }
        const long L = (long)i * to.G + to.c - to.nwg; if (L >= nkv) return false;
        pm = (int)(L >> 2); pn = (int)(L & 3);
        u.A = MEMB + (size_t)pm * 256 * 2048; u.B = WKV + (size_t)pn * 256 * 2048; u.row0 = pm * 256; u.col0 = pn * 256; u.bjump = 0; u.aux = 1; return true;
    }
};
struct SchedMerge {
    pg8::TileOrder to; const char *A0, *W;
    __device__ __forceinline__ bool next(int i, pg8::Unit& u) const {
        const int ti = i / 3, br = i - ti * 3; int pm, pn; if (!to.tile(ti, pm, pn)) return false;
        u.A = A0 + (size_t)br * SZ_512 + (size_t)pm * 256 * (P4_FP8 ? 512 : 1024); u.B = W + (size_t)br * MiB + (size_t)pn * 256 * (P4_FP8 ? 512 : 1024); u.row0 = pm * 256; u.col0 = pn * 256; u.bjump = 0; u.aux = br; return true;
    }
};
struct SchedPlain {
    pg8::TileOrder to; const char *A, *B; size_t astep, bstep;
    __device__ __forceinline__ bool next(int i, pg8::Unit& u) const {
        int pm, pn; if (!to.tile(i, pm, pn)) return false;
        u.A = A + (size_t)pm * astep; u.B = B + (size_t)pn * bstep; u.row0 = pm * 256; u.col0 = pn * 256; u.bjump = 0; u.aux = 0; return true;
    }
};
struct SchedMoe {
    pg8::TileOrder to; LAS const int* pan_cls; LAS const int* toktab; const char *H, *W1, *W2; int mode;
    __device__ __forceinline__ LAS const int* toks(int i) const { return toktab + i * 256; }
    __device__ __forceinline__ bool next(int i, pg8::Unit& u) const {
        int pm, pn; if (!to.tile(i, pm, pn)) return false;
        const int cls = pan_cls[pm]; int e_lo, e_hi; class_experts(cls, e_lo, e_hi);
        u.row0 = pm * 256; u.col0 = pn * 256; u.aux = i; u.bjump = 0;
        if (mode == 1) { u.A = nullptr; u.B = W1 + ((size_t)(pn < 4 ? e_lo : e_hi) * 1024 + (size_t)(pn & 3) * 256) * 1024; }
        else { u.A = H + (size_t)pm * 256 * 1024; u.B = W2 + (size_t)pn * 256 * 8192 + (size_t)e_lo * 512; u.bjump = (e_hi - e_lo - 1) * 512; }
        return true;
    }
};

template <int WHICH> __device__ __forceinline__ float tw_src(const Params& p, int k, int n) {
    if constexpr (WHICH == TW_IN) return p.w_in[(size_t)k * INC + win_logical(n)];
    else if constexpr (WHICH == TW_KV) return p.w_mem_kv[(size_t)k * 1024 + n];
    else if constexpr (WHICH == TW_A) return p.w_attn_o[(size_t)k * 1024 + n];
    else if constexpr (WHICH == TW_C) return p.w_conv_o[(size_t)k * 1024 + n];
    else if constexpr (WHICH == TW_M) return p.w_mem_o[(size_t)k * 1024 + n];
    else if constexpr (WHICH == TW_OUT) return p.w_out[(size_t)k * 1024 + n];
    else if constexpr (WHICH == TW_W1) { const int e = n >> 10, c = n & 1023, G = c >> 3, nn = (c >> 2) & 1, ee = c & 3, jj = 4 * G + ee; return (nn ? p.w_eu : p.w_eg)[((size_t)e * 1024 + k) * 512 + jj]; }
    else { const int e = n >> 10, c = n & 1023; return p.w_ed[((size_t)e * 512 + k) * 1024 + c]; }
}
template <int WHICH> __device__ __forceinline__ void tw_item(const Params& p, int item, float* scr, int lane) {
    constexpr int N = WHICH == TW_IN ? INC : (WHICH >= TW_W1 ? 16 * 1024 : 1024);
    constexpr int ldd = (WHICH == TW_A || WHICH == TW_C || WHICH == TW_M) ? 512 : (WHICH == TW_W2 ? 8192 : 1024);
    constexpr size_t dsto = WHICH == TW_IN ? WS_WIN : WHICH == TW_KV ? WS_WKV : WHICH == TW_A ? WS_WA : WHICH == TW_C ? WS_WC : WHICH == TW_M ? WS_WM : WHICH == TW_OUT ? WS_WOUT : WHICH == TW_W1 ? WS_W1 : WS_W2;
    bf16_t* dst = WSP(bf16_t, dsto);
    constexpr int nblk = N / 32; const int kb = item / nblk, nb = item - kb * nblk, k0 = 64 * kb, n0 = 32 * nb;
#pragma unroll 8
    for (int i = 0; i < 32; ++i) { const int kk = 2 * i + (lane >> 5); scr[kk * 33 + (lane & 31)] = tw_src<WHICH>(p, k0 + kk, n0 + (lane & 31)); }
    asm volatile("s_waitcnt lgkmcnt(0)" ::: "memory");
    const int c = lane & 7;
#pragma unroll
    for (int j = 0; j < 4; ++j) { const int n = (lane >> 3) + 8 * j; const float* sp = scr + (8 * c) * 33 + n;
        const int nn = n0 + n; size_t doff;
        if constexpr (WHICH == TW_W2) doff = (size_t)(nn & 1023) * 8192 + (size_t)(nn >> 10) * 512 + k0 + 8 * c; else doff = (size_t)nn * ldd + k0 + 8 * c;
        if constexpr (WHICH >= TW_W1 || (P5_FP8 && WHICH == TW_OUT) || (P4_FP8 && (WHICH == TW_A || WHICH == TW_C || WHICH == TW_M))) {
            u32x2 o; o.x = pk4_fp8(W8_SCALE * sp[0 * 33], W8_SCALE * sp[1 * 33], W8_SCALE * sp[2 * 33], W8_SCALE * sp[3 * 33]); o.y = pk4_fp8(W8_SCALE * sp[4 * 33], W8_SCALE * sp[5 * 33], W8_SCALE * sp[6 * 33], W8_SCALE * sp[7 * 33]);
            *(u32x2*)((unsigned char*)dst + doff) = o;
        } else {
            u32x4 o; o.x = pk2(sp[0 * 33], sp[1 * 33]); o.y = pk2(sp[2 * 33], sp[3 * 33]); o.z = pk2(sp[4 * 33], sp[5 * 33]); o.w = pk2(sp[6 * 33], sp[7 * 33]);
            *(u32x4*)(dst + doff) = o;
            if constexpr (WHICH == TW_IN && !P1_FP6) {
                u32x2 q; q.x = pk4_fp8(WG8_SCALE * sp[0 * 33], WG8_SCALE * sp[1 * 33], WG8_SCALE * sp[2 * 33], WG8_SCALE * sp[3 * 33]); q.y = pk4_fp8(WG8_SCALE * sp[4 * 33], WG8_SCALE * sp[5 * 33], WG8_SCALE * sp[6 * 33], WG8_SCALE * sp[7 * 33]);
                *(u32x2*)(p.ws + WS_WG8 + doff) = q; } } }
    if constexpr (WHICH == TW_IN && P1_FP6) {
        const int n = lane & 31, b = lane >> 5, blk = (k0 >> 5) + b, tt = blk >> 2, fq = blk & 3; float v[32];
#pragma unroll
        for (int j = 0; j < 32; ++j) v[j] = WG8_SCALE * scr[(32 * b + j) * 33 + n];
        const v6u_t q = pack32_fp6(v);
        unsigned char* wp = p.ws + WS_WG8 + (size_t)(n0 + n) * 1024 + tt * 128 + 16 * fq;
        *(u32x4*)wp = (u32x4){q[0], q[1], q[2], q[3]}; *(u32x4*)(wp + 64) = (u32x4){q[4], q[5], 0u, 0u};
    }
    asm volatile("s_waitcnt lgkmcnt(0)" ::: "memory");
}
__device__ __forceinline__ void transpose_all(const Params& p, float* scr, int gw, int ngw, int lane) {
    constexpr int I_IN = 16 * (INC / 32), I_KV = 16 * 32, I_B = 8 * 32, I_OUT = 16 * 32, I_W1 = 16 * 512, I_W2 = 8 * 512;
    constexpr int NITEMS = I_IN + I_KV + 3 * I_B + I_OUT + I_W1 + I_W2;
    for (int it = gw; it < NITEMS; it += ngw) {
        int r = it;
        if (r < I_W1) { tw_item<TW_W1>(p, r, scr, lane); continue; } r -= I_W1;
        if (r < I_IN) { tw_item<TW_IN>(p, r, scr, lane); continue; } r -= I_IN;
        if (r < I_W2) { tw_item<TW_W2>(p, r, scr, lane); continue; } r -= I_W2;
        if (r < I_KV) { tw_item<TW_KV>(p, r, scr, lane); continue; } r -= I_KV;
        if (r < I_OUT) { tw_item<TW_OUT>(p, r, scr, lane); continue; } r -= I_OUT;
        if (r < I_B) { tw_item<TW_A>(p, r, scr, lane); continue; } r -= I_B;
        if (r < I_B) { tw_item<TW_C>(p, r, scr, lane); continue; } r -= I_B;
        tw_item<TW_M>(p, r, scr, lane);
    }
}

__device__ __forceinline__ void cvt_bf16_dev(const float* __restrict__ src, bf16_t* __restrict__ dst, size_t n8, size_t gtid, size_t gstride) {
    for (size_t i = gtid; i < n8; i += gstride) {
        const f32x4 a = *(const f32x4*)(src + i * 8), b = *(const f32x4*)(src + i * 8 + 4);
        u32x4 o; o.x = pk2(a.x, a.y); o.y = pk2(a.z, a.w); o.z = pk2(b.x, b.y); o.w = pk2(b.z, b.w);
        *(u32x4*)(dst + i * 8) = o;
    }
}

__device__ __forceinline__ void cvt_x_dev(const float* __restrict__ src, bf16_t* __restrict__ dst, unsigned char* __restrict__ dst8, size_t n32, size_t gtid, size_t gstride) {
    for (size_t i = gtid; i < n32; i += gstride) {
        float v[32];
#pragma unroll
        for (int q = 0; q < 8; ++q) { const f32x4 a = *(const f32x4*)(src + i * 32 + 4 * q); v[4 * q] = a.x; v[4 * q + 1] = a.y; v[4 * q + 2] = a.z; v[4 * q + 3] = a.w; }
#pragma unroll
        for (int q = 0; q < 4; ++q) { u32x4 o; o.x = pk2(v[8 * q], v[8 * q + 1]); o.y = pk2(v[8 * q + 2], v[8 * q + 3]); o.z = pk2(v[8 * q + 4], v[8 * q + 5]); o.w = pk2(v[8 * q + 6], v[8 * q + 7]); *(u32x4*)(dst + i * 32 + 8 * q) = o; }
        if constexpr (P1_FP6) {
            const size_t row = i >> 5; const int blk = (int)(i & 31), tt = blk >> 2, fq = blk & 3; const v6u_t q6 = pack32_fp6(v);
            unsigned char* xp = dst8 + row * 1024 + tt * 128 + 16 * fq;
            *(u32x4*)xp = (u32x4){q6[0], q6[1], q6[2], q6[3]}; *(u32x4*)(xp + 64) = (u32x4){q6[4], q6[5], 0u, 0u};
        } else {
#pragma unroll
            for (int q = 0; q < 2; ++q) { u32x4 q8; q8.x = pk4_fp8(v[16 * q], v[16 * q + 1], v[16 * q + 2], v[16 * q + 3]); q8.y = pk4_fp8(v[16 * q + 4], v[16 * q + 5], v[16 * q + 6], v[16 * q + 7]);
                q8.z = pk4_fp8(v[16 * q + 8], v[16 * q + 9], v[16 * q + 10], v[16 * q + 11]); q8.w = pk4_fp8(v[16 * q + 12], v[16 * q + 13], v[16 * q + 14], v[16 * q + 15]); *(u32x4*)(dst8 + i * 32 + 16 * q) = q8; }
        }
    }
}
__device__ __forceinline__ void wg8_dev(const Params& p, size_t gtid, size_t gstride) {
    for (size_t i = gtid; i < (size_t)INC * 64; i += gstride) { const int n = (int)(i % INC), k0 = (int)(i / INC) * 16, nl = win_logical(n); float v[16];
#pragma unroll
        for (int j = 0; j < 16; ++j) v[j] = WG8_SCALE * p.w_in[(size_t)(k0 + j) * INC + nl];
        u32x4 q; q.x = pk4_fp8(v[0], v[1], v[2], v[3]); q.y = pk4_fp8(v[4], v[5], v[6], v[7]); q.z = pk4_fp8(v[8], v[9], v[10], v[11]); q.w = pk4_fp8(v[12], v[13], v[14], v[15]);
        *(u32x4*)(p.ws + WS_WG8 + (size_t)n * 1024 + k0) = q; }
}

#ifndef STAG_US
#define STAG_US 0
#endif
__device__ __forceinline__ void delay_us(int us) { const unsigned long long t0 = __builtin_amdgcn_s_memrealtime(); while (__builtin_amdgcn_s_memrealtime() - t0 < (unsigned long long)us * 100ull) __builtin_amdgcn_s_sleep(16); }

struct Args { Params p; int ph_lo, ph_hi; };
typedef const __attribute__((address_space(4))) unsigned long long* KArgPtr;
__device__ __forceinline__ Params load_params(KArgPtr q) {
    asm volatile("" : "+s"(q));
    Params p;
    p.x = (const float*)(const GAS float*)q[0]; p.mem = (const float*)(const GAS float*)q[1]; p.pos = (const int*)(const GAS int*)q[2]; p.w_in = (const float*)(const GAS float*)q[3]; p.b_in = (const float*)(const GAS float*)q[4]; p.conv_w = (const float*)(const GAS float*)q[5]; p.conv_b = (const float*)(const GAS float*)q[6];
    p.conv_g = (const float*)(const GAS float*)q[7]; p.conv_bb = (const float*)(const GAS float*)q[8]; p.w_mem_kv = (const float*)(const GAS float*)q[9]; p.w_attn_o = (const float*)(const GAS float*)q[10]; p.w_conv_o = (const float*)(const GAS float*)q[11]; p.w_mem_o = (const float*)(const GAS float*)q[12];
    p.w_out = (const float*)(const GAS float*)q[13]; p.ln1_g = (const float*)(const GAS float*)q[14]; p.ln1_b = (const float*)(const GAS float*)q[15]; p.w_gr = (const float*)(const GAS float*)q[16]; p.b_gr = (const float*)(const GAS float*)q[17]; p.w_er = (const float*)(const GAS float*)q[18]; p.b_er = (const float*)(const GAS float*)q[19];
    p.w_eg = (const float*)(const GAS float*)q[20]; p.w_eu = (const float*)(const GAS float*)q[21]; p.w_ed = (const float*)(const GAS float*)q[22]; p.ln2_g = (const float*)(const GAS float*)q[23]; p.ln2_b = (const float*)(const GAS float*)q[24]; p.out = (float*)(GAS float*)q[25]; p.ws = (unsigned char*)(GAS unsigned char*)q[26];
    return p;
}
static_assert(sizeof(Params) == 27 * 8, "Params is 27 pointers");
constexpr int PH_P0 = 0, PH_CH0 = 1, PH_PER_CH = 5, PH_LN1 = PH_CH0 + PH_PER_CH * NCH, PH_MOE1 = PH_LN1 + 1, PH_MOE2 = PH_LN1 + 2, PH_LN2 = PH_LN1 + 3, PH_END = PH_LN1 + 4;

__global__ void __launch_bounds__(NTHR, 2) mk_fwd(Args args) {
    extern __shared__ __attribute__((aligned(16))) unsigned char lds_raw[];
    LAS unsigned char* lds = (LAS unsigned char*)lds_raw;
    const KArgPtr kargs = (KArgPtr)__builtin_amdgcn_kernarg_segment_ptr();
    const int wave = __builtin_amdgcn_readfirstlane((int)threadIdx.x >> 6);
    const int G = gridDim.x; const int bx = blockIdx.x; const int vcu = (G % 8 == 0) ? (bx % 8) * (G / 8) + bx / 8 : bx;
    volatile LAS unsigned* MISC = (volatile LAS unsigned*)(lds + LCTL_OFF);
    ClassTab* tab = (ClassTab*)(lds_raw + LCTL_OFF + 256);
    int* pan_cls = (int*)(lds_raw + LCTL_OFF + 512);
    int* toktab = (int*)(lds_raw + LTOK_OFF);
    for (int u = threadIdx.x; u < (LDS_BYTES - LCTL_OFF) / 4; u += NTHR) ((LAS unsigned*)(lds + LCTL_OFF))[u] = 0u;
    __syncthreads();
    const int lo = args.ph_lo, hi = args.ph_hi;
    unsigned* ctl; { const Params p = load_params(kargs); ctl = WSP(unsigned, WS_CTL); }
    XcdBarrier bar; bar.bar = ctl + CW_BAR; bar.x = 0; bar.st = nullptr;
    if (hi - lo > 1) bar = xcd_barrier_post(ctl + CW_BAR, MISC);
#ifndef PHMASK
#define PHMASK 0x3ff
#endif
#ifndef P1_QK_FP8
#define P1_QK_FP8 2
#endif
#if P1_QK_FP8 == 3
constexpr int P1_BF16_TILES = 4, P1_BF16_T0 = 18, P1_BF16_CUT = 4, P1_BF16_SKIP = 0, P1_FP8_TILES = 32, P1_FP8_T0 = 0, P1_FP8_CUT = 18, P1_FP8_SKIP = 4;
#elif P1_QK_FP8 == 2
constexpr int P1_BF16_TILES = 0, P1_BF16_T0 = 0, P1_BF16_CUT = 0, P1_BF16_SKIP = 0, P1_FP8_TILES = 36, P1_FP8_T0 = 0, P1_FP8_CUT = 36, P1_FP8_SKIP = 0;
#elif P1_QK_FP8
constexpr int P1_BF16_TILES = 6, P1_BF16_T0 = 18, P1_BF16_CUT = 6, P1_BF16_SKIP = 0, P1_FP8_TILES = 30, P1_FP8_T0 = 0, P1_FP8_CUT = 18, P1_FP8_SKIP = 6;
#else
constexpr int P1_BF16_TILES = 18, P1_BF16_T0 = 0, P1_BF16_CUT = 12, P1_BF16_SKIP = 6, P1_FP8_TILES = 18, P1_FP8_T0 = 12, P1_FP8_CUT = 6, P1_FP8_SKIP = 6;
#endif
#ifndef ATTN_V2
#define ATTN_V2 1
#endif
#ifndef PROBE_DUP
#define PROBE_DUP (-1)
#endif
#define NREP(b) ((PROBE_DUP == (b)) ? 2 : 1)
#define IN(k) (lo <= (k) && (k) < hi)
#define HAS(b) ((PHMASK >> (b)) & 1)
#define SEAM(k) do { if (IN(k) && IN((k) + 1)) xcd_barrier(bar); } while (0)

    if (HAS(0) && IN(PH_P0)) {
        const Params p = load_params(kargs);
        const size_t gtid = (size_t)bx * NTHR + opaque_tid(wave), gstride = (size_t)G * NTHR;
        for (int rep = 0; rep < NREP(0); ++rep) {
        { const int ptid = opaque_tid(wave); transpose_all(p, (float*)(lds_raw + RING_OFF) + (ptid >> 6) * (64 * 33), bx * NWAVES + (ptid >> 6), G * NWAVES, ptid & 63); }
        small_prep_dev(p, gtid, gstride);
        cvt_bf16_dev(p.mem, WSP(bf16_t, WS_MEMB), (size_t)NB * MEML * 1024 / 8, gtid, gstride);
        cvt_x_dev(p.x, WSP(bf16_t, WS_XB), p.ws + WS_XB8, (size_t)T * 1024 / 32, gtid, gstride);
        }
    }
    SEAM(PH_P0);
    if (PROBE_DUP == 10 && hi - lo > 1) for (int r = 0; r < 16; ++r) xcd_barrier(bar);

    for (int ch = 0; ch < NCH; ++ch) {
        const int ph0 = PH_CH0 + PH_PER_CH * ch;
        if (HAS(1) && IN(ph0)) {
            const Params p = load_params(kargs);
            const EpiMain em{WSP(float, WS_BIASP), p.pos, WSP(bf16_t, WS_QG), WSP(bf16_t, WS_CGLU), WSP(bf16_t, WS_QM), WSP(bf16_t, WS_GATES), ch * TC};
            for (int rep = 0; rep < NREP(1); ++rep) {
            {
                SchedMain S; S.to.init(TC / 256, P1_BF16_TILES, G, bx); S.nkv = ch == 0 ? (NB * MEML / 256) * 4 : 0; S.tile0 = P1_BF16_T0; S.cut = P1_BF16_CUT; S.skip = P1_BF16_SKIP; S.astep = 256 * 2048; S.bstep = 256 * 2048;
                S.XB = (const char*)(WSP(bf16_t, WS_XB) + (size_t)ch * TC * 1024); S.WIN = (const char*)WSP(bf16_t, WS_WIN); S.MEMB = (const char*)WSP(bf16_t, WS_MEMB); S.WKV = (const char*)WSP(bf16_t, WS_WKV);
                FastEpiMain E{em, EpiKV{WSP(bf16_t, WS_KM)}, 1.0f};
#ifndef NO_P1A
                pg8::gemm_phase<FastEpiMain, SchedMain, true, false, false>(lds + RING_OFF, nullptr, 1024, 1024, 1024, S, E, wave);
#endif
                if (PROBE_DUP == 16) { FastEpiStore E2{WSP(bf16_t, WS_MERGED), 1024, 1.0f}; pg8::gemm_phase<FastEpiStore, SchedMain, true, false, false>(lds + RING_OFF, nullptr, 1024, 1024, 1024, S, E2, wave); }
            }
            {
                SchedMain S; S.to.init(TC / 256, P1_FP8_TILES, G, bx); S.nkv = 0; S.tile0 = P1_FP8_T0; S.cut = P1_FP8_CUT; S.skip = P1_FP8_SKIP; S.astep = 256 * 1024; S.bstep = 256 * 1024;
                S.XB = (const char*)(p.ws + WS_XB8 + (size_t)ch * TC * 1024); S.WIN = (const char*)(p.ws + WS_WG8); S.MEMB = nullptr; S.WKV = nullptr;
                FastEpiMain E{em, EpiKV{WSP(bf16_t, WS_KM)}, 1.0f / WG8_SCALE};
#ifndef NO_P1B
                if (STAG_US > 0 && ((bx >> 3) & 1)) delay_us(STAG_US);
                pg8::gemm_phase<FastEpiMain, SchedMain, true, false, false, P1_FP6 ? 2 : 1>(lds + RING_OFF, nullptr, 512, 512, 512, S, E, wave);
#endif
                if (PROBE_DUP == 17) { FastEpiStore E2{WSP(bf16_t, WS_MERGED), 1024, 1.0f}; pg8::gemm_phase<FastEpiStore, SchedMain, true, false, false, true>(lds + RING_OFF, nullptr, 512, 512, 512, S, E2, wave); }
                if (PROBE_DUP == 19 || PROBE_DUP == 20) { SchedMain S2 = S; S2.bstep = 0; if (PROBE_DUP == 20) S2.astep = 0; FastEpiNull E2{WSP(bf16_t, WS_MERGED)}; pg8::gemm_phase<FastEpiNull, SchedMain, true, false, false, true>(lds + RING_OFF, nullptr, 512, 512, 512, S2, E2, wave); }
                if (PROBE_DUP == 21) { SchedMain S2 = S; S2.bstep = 0; S2.astep = 0; FastEpiNull E2{WSP(bf16_t, WS_MERGED)}; pg8::gemm_phase<FastEpiNull, SchedMain, true, false, false, true>(lds + RING_OFF, nullptr, 512, 512, 256, S2, E2, wave); }
                if (PROBE_DUP == 22) { SchedMain S2 = S; S2.bstep = 0; S2.astep = 0; FastEpiNull E2{WSP(bf16_t, WS_MERGED)}; pg8::gemm_phase<FastEpiNull, SchedMain, true, false, false, 3>(lds + RING_OFF, nullptr, 512, 512, 512, S2, E2, wave); }
                if (PROBE_DUP == 18) { FastEpiNull E2{WSP(bf16_t, WS_MERGED)}; pg8::gemm_phase<FastEpiNull, SchedMain, true, false, false, true>(lds + RING_OFF, nullptr, 512, 512, 512, S, E2, wave); }
            }
            }
        }
        SEAM(ph0);
        if (HAS(2) && IN(ph0 + 1)) {
            const Params p = load_params(kargs);
            constexpr int NDIL = BC * 12 * 8, NMEMB = BC * 4 * 8, NBLK = NDIL + NMEMB;
#if ATTN_V2
            for (int rep = 0; rep < NREP(2); ++rep) {
            const bool dummy = (PROBE_DUP == 2) && rep == 0;
            LAS char* rlds = (LAS char*)(lds + RING_OFF); LAS float* scr = (LAS float*)(lds + LTOK_OFF);
            if (wave >= 4) __builtin_amdgcn_s_setprio(1);
            for (int hd = vcu; hd < BC * 16; hd += G) {
                if (hd < BC * 12) { const int g = (hd % 12) >> 2; const size_t base = (size_t)hd * 2048 * 128;
                    swa::head_dilated(WSP(bf16_t, WS_QG) + base, dummy ? WSP(bf16_t, WS_MERGED) + (size_t)(hd & 127) * 2048 * 128 : WSP(bf16_t, WS_QG) + base, WSP(bf16_t, WS_KG) + base, WSP(bf16_t, WS_VG) + base, WSP(float, WS_LSE) + (size_t)hd * 2048, (2048 >> (2 * g)) - 1, rlds, scr, wave);
                } else { const int bh = hd - BC * 12, bl = bh >> 2, h = bh & 3; const size_t kvb = (size_t)(ch * BC * 4 + bh) * 256 * 128;
                    swa::head_mem(WSP(bf16_t, WS_QM) + (size_t)bh * 2048 * 128, WSP(bf16_t, WS_KM) + kvb, WSP(bf16_t, WS_VM) + kvb, (bf16_t*)(p.ws + WS_OMT + (P4_FP8 ? 1 : 2) * ((size_t)bl * 2048 * 512 + h * 128)), 512, rlds, scr, wave); }
            }
            __builtin_amdgcn_s_setprio(0);
            __syncthreads();
            }
            {
                const Params pc = load_params(kargs); const int ptid = opaque_tid(wave); volatile LAS unsigned* qslot = MISC + 4;
                for (;;) {
                    if (ptid == 0) *qslot = atomicAdd(ctl + CW_CONVQ + ch, 1u);
                    __syncthreads();
                    const int u = (int)*qslot;
                    if (u >= BC * 64) break;
                    conv_unit(pc, u, lds_raw + RING_OFF, ptid);
                }
            }
        }
#else
            for (int rep = 0; rep < NREP(2); ++rep) {
            const bool dummy = (PROBE_DUP == 2) && rep == 0;
            auto make_ref = [&](int L) -> swa::BlockRef {
                swa::BlockRef r;
                if (L < NDIL) { const int bgh = L >> 3, qb = L & 7, g = (bgh % 12) >> 2; const size_t base = (size_t)bgh * 2048 * 128;
                    r.Q = WSP(bf16_t, WS_QG) + base + (size_t)qb * 256 * 128; r.K = WSP(bf16_t, WS_KG) + base; r.V = WSP(bf16_t, WS_VG) + base; r.O = dummy ? WSP(bf16_t, WS_MERGED) + (base % (SZ_XB / 2 - 65536)) : (bf16_t*)r.Q;
                    r.LSE = WSP(float, WS_LSE) + (size_t)bgh * 2048 + qb * 256; r.P0 = qb * 256; r.W = 129; r.segmask = (2048 >> (2 * g)) - 1; r.skv = 2048; r.ostride = 128; }
                else { const int idx = L - NDIL, bh = idx >> 3, qb = idx & 7, bl = bh >> 2, h = bh & 3; const size_t kvb = (size_t)(ch * BC * 4 + bh) * 256 * 128;
                    r.Q = WSP(bf16_t, WS_QM) + ((size_t)bh * 2048 + qb * 256) * 128; r.K = WSP(bf16_t, WS_KM) + kvb; r.V = WSP(bf16_t, WS_VM) + kvb;
                    r.O = WSP(bf16_t, WS_OMT) + ((size_t)bl * 2048 + qb * 256) * 512 + h * 128; r.LSE = nullptr; r.P0 = 256; r.W = 1 << 20; r.segmask = (1 << 20) - 1; r.skv = 256; r.ostride = 512; }
                return r; };
            int L = vcu;
            if (L < NBLK) {
                swa::BlockRef cur = make_ref(L); swa::Seam Sm;
                swa::prime(cur, (char*)lds_raw + RING_OFF, Sm, wave);
                for (;;) {
                    const bool more = L + G < NBLK; const int Ln = more ? L + G : L;
                    const swa::BlockRef nxt = more ? make_ref(Ln) : cur;
                    swa::block(cur, nxt, (char*)lds_raw + RING_OFF, Sm, wave);
                    if (!more) break;
                    cur = nxt; L = Ln;
                }
            }
            __syncthreads();
            { const Params pc = load_params(kargs); const int ptid = opaque_tid(wave); for (int u = bx; u < BC * 64; u += G) conv_unit(pc, u, lds_raw + RING_OFF, ptid); }
            if (PROBE_DUP == 13) { const int ptid = opaque_tid(wave); for (int u = bx; u < BC * 64; u += G) conv_unit(p, u, lds_raw + RING_OFF, ptid); }
            if (PROBE_DUP == 14) {
                int L = NDIL + vcu;
                if (L < NBLK) { swa::BlockRef cur = make_ref(L); swa::Seam Sm; swa::prime(cur, (char*)lds_raw + RING_OFF, Sm, wave);
                    for (;;) { const bool more = L + G < NBLK; const int Ln = more ? L + G : L; const swa::BlockRef nxt = more ? make_ref(Ln) : cur; swa::block(cur, nxt, (char*)lds_raw + RING_OFF, Sm, wave); if (!more) break; cur = nxt; L = Ln; } }
                __syncthreads();
            }
            }
        }
#endif
        SEAM(ph0 + 1);
        if (HAS(3) && IN(ph0 + 2)) { const Params p = load_params(kargs); const int ptid = opaque_tid(wave); for (int rep = 0; rep < NREP(3); ++rep) for (int w = bx * NWAVES + (ptid >> 6); w < TC; w += 2 * G * NWAVES) { if (w + G * NWAVES < TC) combine_token2(p, w, w + G * NWAVES, ptid & 63); else if (O_FP8 && P4_FP8) combine_token2(p, w, w, ptid & 63); else combine_token(p, w, ptid & 63); } }
        SEAM(ph0 + 2);
        if (HAS(4) && IN(ph0 + 3)) {
            const Params p = load_params(kargs);
            SchedMerge S; S.to.init(TC / 256, 4, G, bx); S.A0 = (const char*)WSP(bf16_t, WS_OATT); S.W = (const char*)WSP(bf16_t, WS_WA);
            FastEpiMerge E{WSP(bf16_t, WS_GATES), WSP(bf16_t, WS_MERGED)};
            if (PROBE_DUP == 15) { FastEpiStore E2{WSP(bf16_t, WS_MERGED), 1024, 1.0f}; pg8::gemm_phase<FastEpiStore, SchedMerge, true, false, false>(lds + RING_OFF, nullptr, 512, 512, 512, S, E2, wave); }
#if P4_FP8
            for (int rep = 0; rep < NREP(4); ++rep) pg8::gemm_phase<FastEpiMerge, SchedMerge, true, false, false, 1>(lds + RING_OFF, nullptr, 256, 256, 256, S, E, wave);
#else
            for (int rep = 0; rep < NREP(4); ++rep) pg8::gemm_phase<FastEpiMerge, SchedMerge, true, false, false>(lds + RING_OFF, nullptr, 512, 512, 512, S, E, wave);
#endif
        }
        SEAM(ph0 + 3);
        if (HAS(5) && IN(ph0 + 4)) {
            const Params p = load_params(kargs);
#if P5_FP8
            SchedPlain S; S.to.init(TC / 256, 4, G, bx); S.A = (const char*)WSP(bf16_t, WS_MERGED); S.B = (const char*)WSP(bf16_t, WS_WOUT); S.astep = 256 * 1024; S.bstep = 256 * 1024;
            FastEpiStore E{(bf16_t*)p.out + (size_t)ch * TC * 1024, 1024, 1.0f / (M8_SCALE * W8_SCALE)};
            for (int rep = 0; rep < NREP(5); ++rep) pg8::gemm_phase<FastEpiStore, SchedPlain, true, false, false, 1>(lds + RING_OFF, nullptr, 512, 512, 512, S, E, wave);
#else
            SchedPlain S; S.to.init(TC / 256, 4, G, bx); S.A = (const char*)WSP(bf16_t, WS_MERGED); S.B = (const char*)WSP(bf16_t, WS_WOUT); S.astep = 256 * 2048; S.bstep = 256 * 2048;
            FastEpiStore E{(bf16_t*)p.out + (size_t)ch * TC * 1024, 1024, 1.0f};
            for (int rep = 0; rep < NREP(5); ++rep) pg8::gemm_phase<FastEpiStore, SchedPlain, true, false, false>(lds + RING_OFF, nullptr, 1024, 1024, 1024, S, E, wave);
#endif
        }
        SEAM(ph0 + 4);
    }

    if (HAS(6) && IN(PH_LN1)) {
        const Params p = load_params(kargs);
        float* wr = (float*)(lds_raw + RING_OFF); int* cls_l = (int*)(wr + 20 * 1024); int* misc = cls_l + 64;
        for (int i = opaque_tid(wave); i < 20 * 1024; i += NTHR) wr[i] = WSP(float, WS_WRT)[i];
        __syncthreads();
        { for (int rep = 0; rep < NREP(6); ++rep) for (int u = bx; u < T / 64; u += G) { const int ptid = opaque_tid(wave); ln1_unit16(p, u, wr, cls_l, misc, ptid, (PROBE_DUP == 6) && rep == 0); } }
    }
    SEAM(PH_LN1);
    if (IN(PH_MOE1) || IN(PH_MOE2) || IN(PH_LN2)) {
        const int tid = opaque_tid(wave);
        if (tid == 0) class_tab_fill(ctl + CW_CNT, tab);
        __syncthreads();
        const int NP = tab->rowbase[NCLS] >> 8;
        for (int pm = tid; pm < NP; pm += NTHR) pan_cls[pm] = find_class(tab, pm * 256);
        __syncthreads();
    }
    if (HAS(7) && IN(PH_MOE1)) {
        const Params p = load_params(kargs);
        const int NP = tab->rowbase[NCLS] >> 8;
        SchedMoe S; S.to.init(NP, 8, G, bx); S.pan_cls = (LAS const int*)(lds + LCTL_OFF + 512); S.toktab = (LAS const int*)(lds + LTOK_OFF); S.H = nullptr; S.W1 = (const char*)WSP(bf16_t, WS_W1); S.W2 = nullptr; S.mode = 1;
        const int tid = opaque_tid(wave);
        for (int i = 0; i < MAXU; ++i) { int pm, pn; if (!S.to.tile(i, pm, pn)) break;
            if (tid < 256) { const int cls = pan_cls[pm]; int r = pm * 256 + tid - tab->rowbase[cls]; if (r >= tab->cnt[cls]) r = tab->cnt[cls] - 1; toktab[i * 256 + tid] = WSP(int, WS_LIST)[(size_t)cls * T + r]; } }
        __syncthreads();
        FastEpiMoe1 E{(LAS const int*)(lds + LTOK_OFF), WSP(float, WS_WTS), p.ws + WS_H};
        for (int rep = 0; rep < NREP(7); ++rep) pg8::gemm_phase<FastEpiMoe1, SchedMoe, true, true, false, true>(lds + RING_OFF, (const char*)(p.ws + WS_X1B8), 512, 512, 512, S, E, wave);
    }
    SEAM(PH_MOE1);
    if (HAS(8) && IN(PH_MOE2)) {
        const Params p = load_params(kargs);
        const int NP = tab->rowbase[NCLS] >> 8;
        SchedMoe S; S.to.init(NP, 4, G, bx); S.pan_cls = (LAS const int*)(lds + LCTL_OFF + 512); S.toktab = (LAS const int*)(lds + LTOK_OFF); S.H = (const char*)WSP(bf16_t, WS_H); S.W1 = nullptr; S.W2 = (const char*)WSP(bf16_t, WS_W2); S.mode = 2;
#if Y2_FP8
        FastEpiStore8 E{p.ws + WS_Y2, 1024, Y8_SCALE / (H8_SCALE * W8_SCALE)};
        for (int rep = 0; rep < NREP(8); ++rep) pg8::gemm_phase<FastEpiStore8, SchedMoe, true, false, true, true>(lds + RING_OFF, nullptr, 512, 4096, 512, S, E, wave);
#else
        FastEpiStore E{WSP(bf16_t, WS_Y2), 1024, 1.0f / (H8_SCALE * W8_SCALE)};
        for (int rep = 0; rep < NREP(8); ++rep) pg8::gemm_phase<FastEpiStore, SchedMoe, true, false, true, true>(lds + RING_OFF, nullptr, 512, 4096, 512, S, E, wave);
#endif
    }
    SEAM(PH_MOE2);
    if (HAS(9) && IN(PH_LN2)) {
        const Params p = load_params(kargs);
        const int tot = tab->rowbase[NCLS]; const int lane = opaque_tid(wave) & 63;
        for (int rep = 0; rep < NREP(9); ++rep)
        for (int prow = bx * NWAVES + wave; prow < tot; prow += 2 * G * NWAVES) {
            int tk[2], pr[2];
#pragma unroll
            for (int r = 0; r < 2; ++r) { pr[r] = prow + r * G * NWAVES; tk[r] = -1;
                if (pr[r] < tot) { const int cls = pan_cls[pr[r] >> 8]; const int i = pr[r] - tab->rowbase[cls]; if (i < tab->cnt[cls]) tk[r] = WSP(int, WS_LIST)[(size_t)cls * T + i]; } }
            ln2_rows<2>(p, tk, pr, lane, ((PROBE_DUP == 9) && rep == 0) ? (float*)(p.ws + 512 * MiB) : nullptr);
        }
    }
#undef IN
#undef HAS
#undef SEAM
}

#ifndef MK_MODE
#define MK_MODE 3
#endif
extern "C" void kernel_launch(void* const* d_in, const int* in_sizes, int n_in, void* d_out, int out_size, void* d_ws, size_t ws_size, hipStream_t stream) {
    if (n_in != 25 || ws_size < WS_END) { fprintf(stderr, "kernel_launch: unexpected n_in %d / ws_size %zu (need %zu)\n", n_in, ws_size, (size_t)WS_END); return; }
    static int grid = 0;
    if (grid == 0) {
        (void)hipFuncSetAttribute((const void*)k_ln1, hipFuncAttributeMaxDynamicSharedMemorySize, 20 * 1024 * 4 + 1024);
        if (hipFuncSetAttribute((const void*)mk_fwd, hipFuncAttributeMaxDynamicSharedMemorySize, LDS_BYTES) != hipSuccess) fprintf(stderr, "kernel_launch: hipFuncSetAttribute(mk_fwd, %d) failed\n", LDS_BYTES);
        int dev = 0, cus = 0; (void)hipGetDevice(&dev);
        if (hipDeviceGetAttribute(&cus, hipDeviceAttributeMultiprocessorCount, dev) != hipSuccess || cus <= 0) cus = 256;
        int per_cu = 0; (void)hipOccupancyMaxActiveBlocksPerMultiprocessor(&per_cu, (const void*)mk_fwd, NTHR, LDS_BYTES);
        if (per_cu < 1) fprintf(stderr, "kernel_launch: occupancy query reports %d blocks per CU for mk_fwd\n", per_cu);
        (void)hipGetLastError();
        grid = cus;
    }
    Params p{};
    p.x = (const float*)d_in[0]; p.mem = (const float*)d_in[1]; p.pos = (const int*)d_in[2];
    p.w_in = (const float*)d_in[3]; p.b_in = (const float*)d_in[4]; p.conv_w = (const float*)d_in[5]; p.conv_b = (const float*)d_in[6];
    p.conv_g = (const float*)d_in[7]; p.conv_bb = (const float*)d_in[8]; p.w_mem_kv = (const float*)d_in[9]; p.w_attn_o = (const float*)d_in[10];
    p.w_conv_o = (const float*)d_in[11]; p.w_mem_o = (const float*)d_in[12]; p.w_out = (const float*)d_in[13]; p.ln1_g = (const float*)d_in[14]; p.ln1_b = (const float*)d_in[15];
    p.w_gr = (const float*)d_in[16]; p.b_gr = (const float*)d_in[17]; p.w_er = (const float*)d_in[18]; p.b_er = (const float*)d_in[19];
    p.w_eg = (const float*)d_in[20]; p.w_eu = (const float*)d_in[21]; p.w_ed = (const float*)d_in[22]; p.ln2_g = (const float*)d_in[23]; p.ln2_b = (const float*)d_in[24];
    p.out = (float*)d_out; p.ws = (unsigned char*)d_ws;
    (void)hipMemsetAsync((char*)d_ws + WS_CTL, 0, CTL_BYTES, stream);
#if PROBE_DUP == 12
    (void)hipMemsetAsync((char*)d_ws + 944 * MiB, 0, 64 * MiB, stream);
#endif
    auto mk = [&](int lo, int hi) { Args a{}; a.p = p; a.ph_lo = lo; a.ph_hi = hi; hipLaunchKernelGGL(mk_fwd, dim3(grid), dim3(NTHR), LDS_BYTES, stream, a); };
#if MK_MODE == 3
    mk(0, PH_END);
#elif MK_MODE == 2
    for (int ph = 0; ph < PH_END; ++ph) mk(ph, ph + 1);
#elif MK_MODE == 1
    mk(PH_P0, PH_P0 + 1);
    for (int ch = 0; ch < NCH; ++ch) {
        const int ph0 = PH_CH0 + PH_PER_CH * ch;
        mk(ph0, ph0 + 1);
        k_nattn_dil<<<BC * 12 * 2048 / 4, 256, 0, stream>>>(p);
        k_nattn_mem<<<BC * 4 * 2048 / 4, 256, 0, stream>>>(p, ch);
        k_conv<<<BC * 64, 512, 0, stream>>>(p);
        mk(ph0 + 2, ph0 + 3); mk(ph0 + 3, ph0 + 4); mk(ph0 + 4, ph0 + 5);
    }
    mk(PH_LN1, PH_LN1 + 1); mk(PH_MOE1, PH_MOE1 + 1); mk(PH_MOE2, PH_MOE2 + 1); mk(PH_LN2, PH_LN2 + 1);
#else
    for (int w = 0; w < 8; ++w) k_transpose_w<<<2048, 256, 0, stream>>>(p, w);
    k_small_prep<<<(20 * 1024 + 255) / 256, 256, 0, stream>>>(p);
    k_cvt_bf16<<<2048, 256, 0, stream>>>(p.mem, (bf16_t*)((char*)d_ws + WS_MEMB), (size_t)NB * MEML * 1024 / 8);
    k_cvt_bf16<<<4096, 256, 0, stream>>>(p.x, (bf16_t*)((char*)d_ws + WS_XB), (size_t)T * 1024 / 8);
    k_ngemm_kv<<<dim3(1024 / 64, NB * MEML / 64), 256, 0, stream>>>(p, 0);
    for (int ch = 0; ch < NCH; ++ch) {
        k_ngemm_main<<<dim3(INC / 64, TC / 64), 256, 0, stream>>>(p, ch);
        k_nattn_dil<<<BC * 12 * 2048 / 4, 256, 0, stream>>>(p);
        k_nattn_mem<<<BC * 4 * 2048 / 4, 256, 0, stream>>>(p, ch);
        k_conv<<<BC * 64, 512, 0, stream>>>(p);
        k_combine<<<TC / 4, 256, 0, stream>>>(p);
        for (int br = 0; br < 3; ++br) k_ngemm_merge<<<dim3(1024 / 64, TC / 64), 256, 0, stream>>>(p, br);
        k_ngemm_mix<<<dim3(1024 / 64, TC / 64), 256, 0, stream>>>(p, ch);
    }
    k_ln1<<<256, 512, 20 * 1024 * 4 + 1024, stream>>>(p);
    k_ngemm_moe1<<<dim3(2048 / 64, MPAD / 64), 256, 0, stream>>>(p);
    k_ngemm_moe2<<<dim3(1024 / 64, MPAD / 64), 256, 0, stream>>>(p);
    k_ln2<<<MPAD / 4, 256, 0, stream>>>(p);
#endif
}
```

```cpp
#include <hip/hip_runtime.h>
#include <cstdio>
#include <cstdint>

constexpr int D = 1024, NB = 32, S = 2048, T = NB * S;
constexpr int NCH = 2, BC = NB / NCH, TC = T / NCH;
constexpr int INC = 9216;
constexpr int MEML = 256;
constexpr int NCLS = 24;
constexpr int MPAD = T + NCLS * 256;
constexpr float LN_EPS = 1e-5f;
constexpr float DN_ALPHA = 1.189207115002721f;
constexpr float ATT_SCALE = 0.08838834764831845f;

constexpr int C_Q = 0, C_K = 1536, C_V = 3072, C_GLU = 4608, C_QM = 5632, C_GATE = 6144;

constexpr size_t MiB = 1ull << 20;
constexpr size_t WS_CTL = 0, CTL_BYTES = 1 * MiB;
constexpr size_t WS_WIN = 1 * MiB;
constexpr size_t WS_BIASP = 19 * MiB;
constexpr size_t WS_WRT = 19 * MiB + 64 * 1024;
constexpr size_t WS_WKV = 20 * MiB;
constexpr size_t WS_WA = 22 * MiB, WS_WC = 23 * MiB, WS_WM = 24 * MiB;
constexpr size_t WS_WOUT = 25 * MiB;
constexpr size_t WS_W1 = 27 * MiB;
constexpr size_t WS_W2 = 59 * MiB;
constexpr size_t WS_MEMB = 75 * MiB;
constexpr size_t WS_CH = 91 * MiB;
constexpr size_t SZ_XB = (size_t)TC * 1024 * 2, SZ_QKV1 = (size_t)TC * 1536 * 2, SZ_512 = (size_t)TC * 512 * 2;
constexpr size_t WS_XB = WS_CH;
constexpr size_t WS_QG = WS_XB + (size_t)T * 1024 * 2, WS_KG = WS_QG + SZ_QKV1, WS_VG = WS_KG + SZ_QKV1;
constexpr size_t WS_CGLU = WS_VG + SZ_QKV1, WS_QM = WS_CGLU + SZ_512, WS_OATT = WS_QM + SZ_512, WS_CCONV = WS_OATT + SZ_512, WS_OMT = WS_CCONV + SZ_512;
constexpr size_t WS_GATES = WS_OMT + SZ_512;
constexpr size_t SZ_KM = (size_t)NB * 4 * MEML * 128 * 2;
constexpr size_t WS_KM = WS_GATES + (size_t)TC * 3072 * 2, WS_VM = WS_KM + SZ_KM;
constexpr size_t WS_LSE = WS_VM + SZ_KM;
constexpr size_t WS_MERGED = WS_LSE + 2 * MiB;
constexpr size_t WS_CH_END = WS_MERGED + SZ_XB;
constexpr size_t WS_X1B = WS_CH;
constexpr size_t WS_H = WS_X1B + (size_t)T * 1024 * 2;
constexpr size_t WS_Y2 = WS_H + (size_t)MPAD * 1024 * 2;
constexpr size_t WS_LIST = WS_Y2 + (size_t)MPAD * 1024 * 2;
constexpr size_t WS_WTS = WS_LIST + (size_t)NCLS * T * 4;
constexpr size_t WS_X1B8 = WS_WTS + (size_t)T * 8;
constexpr size_t WS_MOE_END = WS_X1B8 + (size_t)T * 1024;
#ifndef P5_FP8
#define P5_FP8 1
#endif
#ifndef CQ_FP8
#define CQ_FP8 1
#endif
constexpr float C8_SCALE = 16.0f;
#ifndef QKV_FP8
#define QKV_FP8 1
#endif
#ifndef O_FP8
#define O_FP8 1
#endif
#ifndef Y2_FP8
#define Y2_FP8 1
#endif
constexpr float Y8_SCALE = 16.0f;
#ifndef P4_FP8
#define P4_FP8 1
#endif
constexpr float O8_SCALE = 16.0f;
constexpr float M8_SCALE = 16.0f;
constexpr float W8_SCALE = 32.0f, H8_SCALE = 16.0f;
constexpr size_t WS_END = WS_CH_END > WS_MOE_END ? WS_CH_END : WS_MOE_END;
constexpr size_t WS_XB8 = 944 * MiB;
constexpr size_t WS_WG8 = 1008 * MiB;
constexpr float WG8_SCALE = 32.0f;
static_assert(WS_CH_END <= WS_XB8 && WS_WG8 + 9 * MiB <= 1024 * MiB, "fp8 operand buffers");
static_assert(WS_END <= 1024 * MiB, "workspace map exceeds 1 GiB");
constexpr int CW_CNT = 64;

typedef unsigned short bf16_t;
typedef float f32x4 __attribute__((ext_vector_type(4)));
typedef unsigned u32x4 __attribute__((ext_vector_type(4)));
typedef unsigned u32x2 __attribute__((ext_vector_type(2)));

__device__ __forceinline__ float bf2f(bf16_t b) { return __uint_as_float(((unsigned)b) << 16); }
__device__ __forceinline__ float bflo(unsigned w) { return __uint_as_float(w << 16); }
__device__ __forceinline__ float bfhi(unsigned w) { return __uint_as_float(w & 0xffff0000u); }
__device__ __forceinline__ unsigned f2bf(float f) { unsigned u = __float_as_uint(f); return (u + 0x7fffu + ((u >> 16) & 1u)) >> 16; }
typedef float f32x2_t __attribute__((ext_vector_type(2)));
typedef __bf16 bf16x2_t __attribute__((ext_vector_type(2)));
__device__ __forceinline__ unsigned pk2(float lo, float hi) { f32x2_t v = {lo, hi}; bf16x2_t b = __builtin_convertvector(v, bf16x2_t); return __builtin_bit_cast(unsigned, b); }
__device__ __forceinline__ float sigmoidf_(float x) { return __builtin_amdgcn_rcpf(1.0f + __builtin_amdgcn_exp2f(-1.4426950408889634f * x)); }
__device__ __forceinline__ float wave_sum(float v) {
#define DPP_F(x, ctrl) __int_as_float(__builtin_amdgcn_update_dpp(0, __float_as_int(x), ctrl, 0xf, 0xf, true))
    v += DPP_F(v, 0xB1);
    v += DPP_F(v, 0x4E);
    v += DPP_F(v, 0x141);
    v += DPP_F(v, 0x140);
#undef DPP_F
    { const auto r = __builtin_amdgcn_permlane16_swap(__float_as_uint(v), __float_as_uint(v), false, false); v = __uint_as_float(r[0]) + __uint_as_float(r[1]); }
    { const auto r = __builtin_amdgcn_permlane32_swap(__float_as_uint(v), __float_as_uint(v), false, false); v = __uint_as_float(r[0]) + __uint_as_float(r[1]); }
    return v;
}
__device__ __forceinline__ float wave_max(float v) {
#pragma unroll
    for (int o = 1; o < 64; o <<= 1) v = fmaxf(v, __shfl_xor(v, o));
    return v;
}
__device__ __forceinline__ unsigned pk4_fp8(float a, float b, float c, float d) { unsigned w = 0; w = __builtin_amdgcn_cvt_pk_fp8_f32(a, b, w, false); w = __builtin_amdgcn_cvt_pk_fp8_f32(c, d, w, true); return w; }
__device__ __forceinline__ unsigned pk4_fp8s(float a, float b, float c, float d) { return pk4_fp8(__builtin_amdgcn_fmed3f(a, -448.f, 448.f), __builtin_amdgcn_fmed3f(b, -448.f, 448.f), __builtin_amdgcn_fmed3f(c, -448.f, 448.f), __builtin_amdgcn_fmed3f(d, -448.f, 448.f)); }
__device__ __forceinline__ unsigned pk4_u8(float a, float b, float c, float d) {
    const unsigned ua = (unsigned)fmaxf(__builtin_rintf(a * 255.f), 1.f), ub = (unsigned)fmaxf(__builtin_rintf(b * 255.f), 1.f), uc = (unsigned)fmaxf(__builtin_rintf(c * 255.f), 1.f), ud = (unsigned)fmaxf(__builtin_rintf(d * 255.f), 1.f);
    return ua | (ub << 8) | (uc << 16) | (ud << 24); }
__device__ __forceinline__ float sig255(float x) { const float e = __builtin_amdgcn_exp2f(-1.4426950408889634f * x); return fmaxf(__builtin_rintf(__builtin_amdgcn_rcpf(__builtin_fmaf(e, 1.0f / 255.0f, 1.0f / 255.0f))), 1.0f); }
__device__ __forceinline__ unsigned pk4_sig_u8(float a, float b, float c, float d) { unsigned w = 0u;
    w = __builtin_amdgcn_cvt_pk_u8_f32(sig255(a), 0, w); w = __builtin_amdgcn_cvt_pk_u8_f32(sig255(b), 1, w); w = __builtin_amdgcn_cvt_pk_u8_f32(sig255(c), 2, w); w = __builtin_amdgcn_cvt_pk_u8_f32(sig255(d), 3, w); return w; }
__device__ __forceinline__ f32x4 u8x4_raw(unsigned w) { return (f32x4){(float)(w & 255u), (float)((w >> 8) & 255u), (float)((w >> 16) & 255u), (float)(w >> 24)}; }
__device__ __forceinline__ f32x4 u8x4_to_f32(unsigned w) { return (f32x4){(float)(w & 255u), (float)((w >> 8) & 255u), (float)((w >> 16) & 255u), (float)(w >> 24)} * (1.0f / 255.0f); }
#ifndef P1_FP6
#define P1_FP6 0
#endif
typedef float v16f_t __attribute__((ext_vector_type(16)));
typedef unsigned v6u_t __attribute__((ext_vector_type(6)));
__device__ __forceinline__ v6u_t pack32_fp6(const float (&v)[32]) {
    v16f_t a, b;
#pragma unroll
    for (int i = 0; i < 16; ++i) { a[i] = fminf(fmaxf(v[i], -7.5f), 7.5f); b[i] = fminf(fmaxf(v[16 + i], -7.5f), 7.5f); }
    return __builtin_amdgcn_cvt_scalef32_2xpk16_fp6_f32(a, b, 1.0f);
}
__device__ __forceinline__ int opaque_tid(int wave_s) { unsigned z = 0u; asm volatile("" : "+v"(z)); const int l = (int)__builtin_amdgcn_mbcnt_hi(~0u, __builtin_amdgcn_mbcnt_lo(~0u, z)); return (wave_s << 6) | l; }
__device__ __forceinline__ void rope_cs(float pos, int j, float& c, float& s) {
    const float invrev = __builtin_amdgcn_exp2f(-(float)j * (13.287712379549449f / 64.0f)) * 0.15915494309189535f;
    float rev = pos * invrev; rev = __builtin_amdgcn_fractf(rev);
    s = __builtin_amdgcn_sinf(rev); c = __builtin_amdgcn_cosf(rev);
}
__device__ __forceinline__ int rowperm(int g, int s) { return g == 0 ? s : (g == 1 ? ((s & 3) * 512 + (s >> 2)) : ((s & 15) * 128 + (s >> 4))); }
__host__ __device__ __forceinline__ int win_logical(int n) {
    if (n < C_V) { const int sec = n / 1536, r = n % 1536, gh = r / 128, p = r % 128, G = p >> 3, nn = (p >> 2) & 1, e = p & 3; return sec * 1536 + gh * 128 + 64 * nn + 4 * G + e; }
    if (n < C_GLU) return n;
    if (n < C_QM) { const int cc = n - C_GLU, G = cc >> 3, nn = (cc >> 2) & 1, e = cc & 3; return C_GLU + nn * 512 + 4 * G + e; }
    return n;
}

struct Params {
    const float *x, *mem; const int* pos;
    const float *w_in, *b_in, *conv_w, *conv_b, *conv_g, *conv_bb, *w_mem_kv, *w_attn_o, *w_conv_o, *w_mem_o, *w_out, *ln1_g, *ln1_b;
    const float *w_gr, *b_gr, *w_er, *b_er, *w_eg, *w_eu, *w_ed, *ln2_g, *ln2_b;
    float* out; unsigned char* ws;
};
#define WSP(T_, off) ((T_*)(p.ws + (off)))

__global__ void k_cvt_bf16(const float* __restrict__ src, bf16_t* __restrict__ dst, size_t n8) {
    for (size_t i = (size_t)blockIdx.x * blockDim.x + threadIdx.x; i < n8; i += (size_t)gridDim.x * blockDim.x) {
        const f32x4 a = *(const f32x4*)(src + i * 8), b = *(const f32x4*)(src + i * 8 + 4);
        u32x4 o; o.x = pk2(a.x, a.y); o.y = pk2(a.z, a.w); o.z = pk2(b.x, b.y); o.w = pk2(b.z, b.w);
        *(u32x4*)(dst + i * 8) = o;
    }
}
enum { TW_IN = 0, TW_KV, TW_A, TW_C, TW_M, TW_OUT, TW_W1, TW_W2 };
__device__ __forceinline__ void transpose_w_dev(const Params& p, int which, size_t gtid, size_t gstride) {
    int K, N, ldd; bf16_t* dst;
    switch (which) {
        case TW_IN: K = 1024; N = INC; ldd = 1024; dst = WSP(bf16_t, WS_WIN); break;
        case TW_KV: K = 1024; N = 1024; ldd = 1024; dst = WSP(bf16_t, WS_WKV); break;
        case TW_A: K = 512; N = 1024; ldd = 512; dst = WSP(bf16_t, WS_WA); break;
        case TW_C: K = 512; N = 1024; ldd = 512; dst = WSP(bf16_t, WS_WC); break;
        case TW_M: K = 512; N = 1024; ldd = 512; dst = WSP(bf16_t, WS_WM); break;
        case TW_OUT: K = 1024; N = 1024; ldd = 1024; dst = WSP(bf16_t, WS_WOUT); break;
        case TW_W1: K = 1024; N = 16 * 1024; ldd = 1024; dst = WSP(bf16_t, WS_W1); break;
        default: K = 512; N = 16 * 1024; ldd = 8192; dst = WSP(bf16_t, WS_W2); break;
    }
    const size_t total = (size_t)N * (K / 8);
    for (size_t i = gtid; i < total; i += gstride) {
        const int n = (int)(i % N), k0 = (int)(i / N) * 8;
        float v[8];
#pragma unroll
        for (int j = 0; j < 8; ++j) {
            const int k = k0 + j; float s;
            switch (which) {
                case TW_IN: s = p.w_in[(size_t)k * INC + win_logical(n)]; break;
                case TW_KV: s = p.w_mem_kv[(size_t)k * 1024 + n]; break;
                case TW_A: s = p.w_attn_o[(size_t)k * 1024 + n]; break;
                case TW_C: s = p.w_conv_o[(size_t)k * 1024 + n]; break;
                case TW_M: s = p.w_mem_o[(size_t)k * 1024 + n]; break;
                case TW_OUT: s = p.w_out[(size_t)k * 1024 + n]; break;
                case TW_W1: { const int e = n >> 10, c = n & 1023, G = c >> 3, nn = (c >> 2) & 1, ee = c & 3, jj = 4 * G + ee;
                              s = (nn ? p.w_eu : p.w_eg)[((size_t)e * 1024 + k) * 512 + jj]; } break;
                default: { const int e = n >> 10, c = n & 1023; s = p.w_ed[((size_t)e * 512 + k) * 1024 + c]; } break;
            }
            v[j] = s;
        }
        u32x4 o; o.x = pk2(v[0], v[1]); o.y = pk2(v[2], v[3]); o.z = pk2(v[4], v[5]); o.w = pk2(v[6], v[7]);
        size_t doff;
        if (which == TW_W2) { const int e = n >> 10, c = n & 1023; doff = (size_t)c * 8192 + e * 512 + k0; }
        else doff = (size_t)n * ldd + k0;
        *(u32x4*)(dst + doff) = o;
    }
}
__global__ void k_transpose_w(Params p, int which) { transpose_w_dev(p, which, (size_t)blockIdx.x * blockDim.x + threadIdx.x, (size_t)gridDim.x * blockDim.x); }
__device__ __forceinline__ void small_prep_dev(const Params& p, size_t gtid, size_t gstride) {
    for (size_t ii = gtid; ii < 20 * 1024; ii += gstride) { const int i = (int)ii;
        if (i < INC) WSP(float, WS_BIASP)[i] = p.b_in[win_logical(i)];
        const int e = i >> 10, k = i & 1023;
        WSP(float, WS_WRT)[i] = e < 4 ? p.w_gr[k * 4 + e] : p.w_er[((size_t)((e - 4) >> 2) * 1024 + k) * 4 + ((e - 4) & 3)]; }
}
__global__ void k_small_prep(Params p) { small_prep_dev(p, (size_t)blockIdx.x * blockDim.x + threadIdx.x, (size_t)gridDim.x * blockDim.x); }

struct EpiMain {
    const float* biasp; const int* pos; bf16_t *QG, *CGLU, *QM, *GATES; int tok0;
    static __device__ __forceinline__ void rope_freqs(int c0, float (&invrev)[4]) {
        const int j0 = ((c0 & 127) >> 3) * 4;
#pragma unroll
        for (int e = 0; e < 4; ++e) invrev[e] = __builtin_amdgcn_exp2f(-(float)(j0 + e) * (13.287712379549449f / 64.0f)) * 0.15915494309189535f;
    }
    template <int S> __device__ __forceinline__ void finish_s(int rl, int c0, float (&v)[8], float fpos, const float (&invrev)[4]) const {
        const int bl = rl >> 11, s = rl & 2047;
        if constexpr (S <= 1) {
            const int tcol = __builtin_amdgcn_readfirstlane(c0 & ~255);
            const int sec = tcol / 1536, r = c0 - sec * 1536, gh = r >> 7, pcol = r & 127, g = gh >> 2;
            if constexpr (S == 0) {
#pragma unroll
                for (int e = 0; e < 4; ++e) { const float rev = __builtin_amdgcn_fractf(fpos * invrev[e]); const float sn = __builtin_amdgcn_sinf(rev), c = __builtin_amdgcn_cosf(rev);
                    const float t1 = v[e], t2 = v[4 + e]; v[e] = t1 * c - t2 * sn; v[4 + e] = t2 * c + t1 * sn; }
            }
            bf16_t* base = QG + (size_t)sec * (SZ_QKV1 / 2);
            u32x4 o; o.x = pk2(v[0], v[1]); o.y = pk2(v[2], v[3]); o.z = pk2(v[4], v[5]); o.w = pk2(v[6], v[7]);
            *(u32x4*)(base + ((size_t)(bl * 12 + gh) * 2048 + rowperm(g, s)) * 128 + pcol) = o;
        } else if constexpr (S == 2) {
            const int j0 = (c0 - C_GLU) >> 1;
#if CQ_FP8
            *(unsigned*)((unsigned char*)CGLU + (size_t)rl * 512 + j0) = pk4_fp8(C8_SCALE * v[0] * sigmoidf_(v[4]), C8_SCALE * v[1] * sigmoidf_(v[5]), C8_SCALE * v[2] * sigmoidf_(v[6]), C8_SCALE * v[3] * sigmoidf_(v[7]));
#else
            u32x2 o; o.x = pk2(v[0] * sigmoidf_(v[4]), v[1] * sigmoidf_(v[5])); o.y = pk2(v[2] * sigmoidf_(v[6]), v[3] * sigmoidf_(v[7]));
            *(u32x2*)(CGLU + (size_t)rl * 512 + j0) = o;
#endif
        } else {
            const int cc = c0 - C_QM, h = cc >> 7, pcol = cc & 127;
#if CQ_FP8
            u32x2 o8; o8.x = pk4_fp8(v[0], v[1], v[2], v[3]); o8.y = pk4_fp8(v[4], v[5], v[6], v[7]);
            *(u32x2*)((unsigned char*)QM + ((size_t)(bl * 4 + h) * 2048 + s) * 256 + pcol) = o8;
#else
            u32x4 o; o.x = pk2(v[0], v[1]); o.y = pk2(v[2], v[3]); o.z = pk2(v[4], v[5]); o.w = pk2(v[6], v[7]);
            *(u32x4*)(QM + ((size_t)(bl * 4 + h) * 2048 + s) * 128 + pcol) = o;
#endif
        }
    }
    __device__ __forceinline__ void finish(int rl, int c0, float (&v)[8], float fpos, const float (&invrev)[4]) const {
        const int bl = rl >> 11, s = rl & 2047;
        const int tcol = __builtin_amdgcn_readfirstlane(c0 & ~255);
        if (tcol < C_GLU) {
            const int sec = tcol / 1536, r = c0 - sec * 1536, gh = r >> 7, pcol = r & 127, g = gh >> 2;
            if (sec < 2) {
#pragma unroll
                for (int e = 0; e < 4; ++e) { const float rev = __builtin_amdgcn_fractf(fpos * invrev[e]); const float sn = __builtin_amdgcn_sinf(rev), c = __builtin_amdgcn_cosf(rev);
                    const float t1 = v[e], t2 = v[4 + e]; v[e] = t1 * c - t2 * sn; v[4 + e] = t2 * c + t1 * sn; }
            }
            bf16_t* base = QG + (size_t)sec * (SZ_QKV1 / 2);
            u32x4 o; o.x = pk2(v[0], v[1]); o.y = pk2(v[2], v[3]); o.z = pk2(v[4], v[5]); o.w = pk2(v[6], v[7]);
            *(u32x4*)(base + ((size_t)(bl * 12 + gh) * 2048 + rowperm(g, s)) * 128 + pcol) = o;
        } else if (tcol < C_QM) {
            const int j0 = (c0 - C_GLU) >> 1;
            u32x2 o; o.x = pk2(v[0] * sigmoidf_(v[4]), v[1] * sigmoidf_(v[5])); o.y = pk2(v[2] * sigmoidf_(v[6]), v[3] * sigmoidf_(v[7]));
            *(u32x2*)(CGLU + (size_t)rl * 512 + j0) = o;
        } else if (tcol < C_GATE) {
            const int cc = c0 - C_QM, h = cc >> 7, pcol = cc & 127;
            u32x4 o; o.x = pk2(v[0], v[1]); o.y = pk2(v[2], v[3]); o.z = pk2(v[4], v[5]); o.w = pk2(v[6], v[7]);
            *(u32x4*)(QM + ((size_t)(bl * 4 + h) * 2048 + s) * 128 + pcol) = o;
        } else {
            const int cc = c0 - C_GATE;
            u32x2 o; o.x = pk4_sig_u8(v[0], v[1], v[2], v[3]); o.y = pk4_sig_u8(v[4], v[5], v[6], v[7]);
            *(u32x2*)((unsigned char*)GATES + (size_t)rl * 3072 + cc) = o;
        }
    }
    __device__ __forceinline__ void operator()(int rl, int c0, float (&v)[8]) const {
        const f32x4 b0 = *(const f32x4*)(biasp + c0), b1 = *(const f32x4*)(biasp + c0 + 4);
        v[0] += b0.x; v[1] += b0.y; v[2] += b0.z; v[3] += b0.w; v[4] += b1.x; v[5] += b1.y; v[6] += b1.z; v[7] += b1.w;
        float invrev[4]; rope_freqs(c0, invrev);
        finish(rl, c0, v, c0 < C_V ? (float)pos[tok0 + rl] : 0.f, invrev);
    }
};
struct EpiKV {
    bf16_t *KM;
    __device__ __forceinline__ void operator()(int row, int c0, float (&v)[8]) const {
        const int bl = row >> 8, m = row & 255, isv = c0 >> 9, cc = c0 & 511, h = cc >> 7, pcol = cc & 127;
        u32x4 o; o.x = pk2(v[0], v[1]); o.y = pk2(v[2], v[3]); o.z = pk2(v[4], v[5]); o.w = pk2(v[6], v[7]);
        *(u32x4*)(KM + (size_t)isv * (SZ_KM / 2) + ((size_t)(bl * 4 + h) * 256 + m) * 128 + pcol) = o;
    }
};
struct EpiMerge {
    const bf16_t* GATES; bf16_t* MERGED; int br;
    __device__ __forceinline__ void operator()(int rl, int c0, float (&v)[8]) const {
        const u32x2 g = *(const u32x2*)((const unsigned char*)GATES + (size_t)rl * 3072 + br * 1024 + c0);
        const f32x4 g0 = u8x4_to_f32(g.x), g1 = u8x4_to_f32(g.y);
        float r[8] = {g0.x * v[0], g0.y * v[1], g0.z * v[2], g0.w * v[3], g1.x * v[4], g1.y * v[5], g1.z * v[6], g1.w * v[7]};
        bf16_t* mp = MERGED + (size_t)rl * 1024 + c0;
        if (br > 0) { const u32x4 m = *(const u32x4*)mp; r[0] += bflo(m.x); r[1] += bfhi(m.x); r[2] += bflo(m.y); r[3] += bfhi(m.y); r[4] += bflo(m.z); r[5] += bfhi(m.z); r[6] += bflo(m.w); r[7] += bfhi(m.w); }
        u32x4 o; o.x = pk2(r[0], r[1]); o.y = pk2(r[2], r[3]); o.z = pk2(r[4], r[5]); o.w = pk2(r[6], r[7]);
        *(u32x4*)mp = o;
    }
};
struct EpiMix {
    bf16_t* MIX; int tok0;
    __device__ __forceinline__ void operator()(int rl, int c0, float (&v)[8]) const {
        u32x4 o; o.x = pk2(v[0], v[1]); o.y = pk2(v[2], v[3]); o.z = pk2(v[4], v[5]); o.w = pk2(v[6], v[7]);
        *(u32x4*)(MIX + (size_t)(tok0 + rl) * 1024 + c0) = o;
    }
};
struct ClassTab { int cnt[NCLS], rowbase[NCLS + 1]; };
__device__ __forceinline__ void class_tab_fill(const unsigned* cntw, ClassTab* t) {
    int acc = 0;
    for (int c = 0; c < NCLS; ++c) { const int n = (int)cntw[c]; t->cnt[c] = n; t->rowbase[c] = acc; acc += ((n + 255) >> 8) << 8; }
    t->rowbase[NCLS] = acc;
}
__device__ __forceinline__ void class_experts(int cls, int& e_lo, int& e_hi) {
    const int g = cls / 6, pi = cls - g * 6;
    const int lo = pi < 3 ? 0 : (pi < 5 ? 1 : 2), hi = pi < 3 ? pi + 1 : (pi < 5 ? pi - 1 : 3);
    e_lo = g * 4 + lo; e_hi = g * 4 + hi;
}
struct EpiMoe1 {
    const int* list; const float* wts; bf16_t* H; int cls, cnt, rowbase;
    __device__ __forceinline__ void operator()(int prow, int c0, float (&v)[8]) const {
        int i = prow - rowbase; if (i >= cnt) i = cnt - 1;
        const int tok = list[i]; const int hi = c0 >> 10; const float w = wts[(size_t)tok * 2 + hi];
        const int j0 = hi * 512 + ((c0 & 1023) >> 1);
        float r[4];
#pragma unroll
        for (int e = 0; e < 4; ++e) { const float gt = v[e]; r[e] = gt * sigmoidf_(gt) * v[4 + e] * w; }
        u32x2 o; o.x = pk2(r[0], r[1]); o.y = pk2(r[2], r[3]);
        *(u32x2*)(H + (size_t)prow * 1024 + j0) = o;
    }
};
struct EpiMoe2 {
    bf16_t* Y2;
    __device__ __forceinline__ void operator()(int prow, int c0, float (&v)[8]) const {
        u32x4 o; o.x = pk2(v[0], v[1]); o.y = pk2(v[2], v[3]); o.z = pk2(v[4], v[5]); o.w = pk2(v[6], v[7]);
        *(u32x4*)(Y2 + (size_t)prow * 1024 + c0) = o;
    }
};

struct RowsPlain { const bf16_t* base; int ld; __device__ __forceinline__ const bf16_t* operator()(int r) const { return base + (size_t)r * ld; } };
template <class AF, class BF, class EF>
__device__ __forceinline__ void ngemm_tile(int row0, int col0, int K, const AF& af, const BF& bf, const EF& ef, int bkseg, long bjump) {
    __shared__ float As[64][33], Bs[64][33];
    const int tid = threadIdx.x, ty = tid >> 3, tx = tid & 7;
    float acc[2][8];
#pragma unroll
    for (int i = 0; i < 2; ++i)
#pragma unroll
        for (int j = 0; j < 8; ++j) acc[i][j] = 0.f;
    const int lr = tid >> 2, lk = (tid & 3) * 8;
    const bf16_t* ap = af(row0 + lr); const bf16_t* bp = bf(col0 + lr);
    for (int k0 = 0; k0 < K; k0 += 32) {
        const u32x4 a = *(const u32x4*)(ap + k0 + lk);
        const long bo = (long)k0 + lk + (long)(k0 / bkseg) * bjump;
        const u32x4 b = *(const u32x4*)(bp + bo);
        __syncthreads();
        As[lr][lk + 0] = bflo(a.x); As[lr][lk + 1] = bfhi(a.x); As[lr][lk + 2] = bflo(a.y); As[lr][lk + 3] = bfhi(a.y);
        As[lr][lk + 4] = bflo(a.z); As[lr][lk + 5] = bfhi(a.z); As[lr][lk + 6] = bflo(a.w); As[lr][lk + 7] = bfhi(a.w);
        Bs[lr][lk + 0] = bflo(b.x); Bs[lr][lk + 1] = bfhi(b.x); Bs[lr][lk + 2] = bflo(b.y); Bs[lr][lk + 3] = bfhi(b.y);
        Bs[lr][lk + 4] = bflo(b.z); Bs[lr][lk + 5] = bfhi(b.z); Bs[lr][lk + 6] = bflo(b.w); Bs[lr][lk + 7] = bfhi(b.w);
        __syncthreads();
#pragma unroll 8
        for (int kk = 0; kk < 32; ++kk) {
            const float a0 = As[2 * ty][kk], a1 = As[2 * ty + 1][kk];
#pragma unroll
            for (int j = 0; j < 8; ++j) { const float bv = Bs[8 * tx + j][kk]; acc[0][j] += a0 * bv; acc[1][j] += a1 * bv; }
        }
    }
    ef(row0 + 2 * ty, col0 + 8 * tx, acc[0]);
    ef(row0 + 2 * ty + 1, col0 + 8 * tx, acc[1]);
}
__global__ void __launch_bounds__(256) k_ngemm_main(Params p, int ch) {
    const int tok0 = ch * TC;
    EpiMain E{WSP(float, WS_BIASP), p.pos, WSP(bf16_t, WS_QG), WSP(bf16_t, WS_CGLU), WSP(bf16_t, WS_QM), WSP(bf16_t, WS_GATES), tok0};
    RowsPlain A{WSP(bf16_t, WS_XB) + (size_t)ch * TC * 1024, 1024}, Bm{WSP(bf16_t, WS_WIN), 1024};
    ngemm_tile(blockIdx.y * 64, blockIdx.x * 64, 1024, A, Bm, E, 1 << 30, 0);
}
__global__ void __launch_bounds__(256) k_ngemm_kv(Params p, int ch) {
    EpiKV E{WSP(bf16_t, WS_KM)};
    RowsPlain A{WSP(bf16_t, WS_MEMB), 1024}, Bm{WSP(bf16_t, WS_WKV), 1024};
    ngemm_tile(blockIdx.y * 64, blockIdx.x * 64, 1024, A, Bm, E, 1 << 30, 0);
}
__global__ void __launch_bounds__(256) k_ngemm_merge(Params p, int br) {
    EpiMerge E{WSP(bf16_t, WS_GATES), WSP(bf16_t, WS_MERGED), br};
    RowsPlain A{WSP(bf16_t, WS_OATT + (size_t)br * SZ_512), 512};
    RowsPlain Bm{WSP(bf16_t, WS_WA + (size_t)br * MiB), 512};
    ngemm_tile(blockIdx.y * 64, blockIdx.x * 64, 512, A, Bm, E, 1 << 30, 0);
}
__global__ void __launch_bounds__(256) k_ngemm_mix(Params p, int ch) {
    EpiMix E{(bf16_t*)p.out, ch * TC};
    RowsPlain A{WSP(bf16_t, WS_MERGED), 1024}, Bm{WSP(bf16_t, WS_WOUT), 1024};
    ngemm_tile(blockIdx.y * 64, blockIdx.x * 64, 1024, A, Bm, E, 1 << 30, 0);
}
struct RowsGather { const bf16_t* base; const int* list; int cnt, rowbase; __device__ __forceinline__ const bf16_t* operator()(int prow) const { int i = prow - rowbase; if (i >= cnt) i = cnt - 1; return base + (size_t)list[i] * 1024; } };
__device__ __forceinline__ int find_class(const ClassTab* t, int prow) { int c = 0;
    for (int i = 1; i < NCLS; ++i) if (prow >= t->rowbase[i]) c = i;
    return c; }
__global__ void __launch_bounds__(256) k_ngemm_moe1(Params p) {
    __shared__ ClassTab tabs; if (threadIdx.x == 0) class_tab_fill(WSP(unsigned, WS_CTL) + CW_CNT, &tabs); __syncthreads(); const ClassTab* tab = &tabs;
    const int row0 = blockIdx.y * 64; if (row0 >= tab->rowbase[NCLS]) return;
    const int cls = find_class(tab, row0); if (tab->cnt[cls] == 0) return;
    int e_lo, e_hi; class_experts(cls, e_lo, e_hi);
    const int col0 = blockIdx.x * 64, hi = col0 >> 10;
    const int* list = WSP(int, WS_LIST) + (size_t)cls * T;
    RowsGather A{WSP(bf16_t, WS_X1B), list, tab->cnt[cls], tab->rowbase[cls]};
    RowsPlain Bm{WSP(bf16_t, WS_W1) + ((size_t)(hi ? e_hi : e_lo) * 1024 - (size_t)hi * 1024) * 1024, 1024};
    EpiMoe1 E{list, WSP(float, WS_WTS), WSP(bf16_t, WS_H), cls, tab->cnt[cls], tab->rowbase[cls]};
    ngemm_tile(row0, col0, 1024, A, Bm, E, 1 << 30, 0);
}
__global__ void __launch_bounds__(256) k_ngemm_moe2(Params p) {
    __shared__ ClassTab tabs; if (threadIdx.x == 0) class_tab_fill(WSP(unsigned, WS_CTL) + CW_CNT, &tabs); __syncthreads(); const ClassTab* tab = &tabs;
    const int row0 = blockIdx.y * 64; if (row0 >= tab->rowbase[NCLS]) return;
    const int cls = find_class(tab, row0); if (tab->cnt[cls] == 0) return;
    int e_lo, e_hi; class_experts(cls, e_lo, e_hi);
    RowsPlain A{WSP(bf16_t, WS_H), 1024};
    RowsPlain Bm{WSP(bf16_t, WS_W2) + (size_t)e_lo * 512, 8192};
    EpiMoe2 E{WSP(bf16_t, WS_Y2)};
    ngemm_tile(row0, blockIdx.x * 64, 1024, A, Bm, E, 512, (long)(e_hi - e_lo - 1) * 512);
}

__device__ __forceinline__ void nattn_row(const bf16_t* qp, const bf16_t* kbase, const bf16_t* vbase, int nkeys, bf16_t* op, float* lsep, int lane) {
    const unsigned qw = *(const unsigned*)(qp + 2 * lane); const float q0 = bflo(qw), q1 = bfhi(qw);
    float sc[4] = {-INFINITY, -INFINITY, -INFINITY, -INFINITY};
#pragma unroll
    for (int kb = 0; kb < 4; ++kb) {
        for (int kk = 0; kk < 64; ++kk) { const int k = kb * 64 + kk; if (k >= nkeys) break;
            const unsigned kw = *(const unsigned*)(kbase + (size_t)k * 128 + 2 * lane);
            const float s = wave_sum(q0 * bflo(kw) + q1 * bfhi(kw)) * ATT_SCALE;
            if (lane == kk) sc[kb] = s; }
    }
    const float m = wave_max(fmaxf(fmaxf(sc[0], sc[1]), fmaxf(sc[2], sc[3])));
    float pr[4]; float ps = 0.f;
#pragma unroll
    for (int kb = 0; kb < 4; ++kb) { pr[kb] = __expf(sc[kb] - m); ps += pr[kb]; }
    const float l = wave_sum(ps);
    float a0 = 0.f, a1 = 0.f;
#pragma unroll
    for (int kb = 0; kb < 4; ++kb) {
        for (int kk = 0; kk < 64; ++kk) { const int k = kb * 64 + kk; if (k >= nkeys) break;
            const float pk = __shfl(pr[kb], kk);
            const unsigned vw = *(const unsigned*)(vbase + (size_t)k * 128 + 2 * lane);
            a0 += pk * bflo(vw); a1 += pk * bfhi(vw); }
    }
    const float inv = 1.0f / l;
    *(unsigned*)(op + 2 * lane) = pk2(a0 * inv, a1 * inv);
    if (lsep && lane == 0) *lsep = m + __logf(l);
}
__global__ void __launch_bounds__(256) k_nattn_dil(Params p) {
    const int lane = threadIdx.x & 63; const size_t w = (size_t)blockIdx.x * 4 + (threadIdx.x >> 6);
    if (w >= (size_t)BC * 12 * 2048) return;
    const int row = (int)(w & 2047); const int bgh = (int)(w >> 11); const int g = (bgh % 12) >> 2;
    const int seglen = 2048 >> (2 * g); const int pin = row & (seglen - 1); const int nk = pin + 1 < 129 ? pin + 1 : 129;
    bf16_t* Q = WSP(bf16_t, WS_QG) + ((size_t)bgh * 2048 + row) * 128;
    const bf16_t* K = WSP(bf16_t, WS_KG) + ((size_t)bgh * 2048 + row - nk + 1) * 128;
    const bf16_t* V = WSP(bf16_t, WS_VG) + ((size_t)bgh * 2048 + row - nk + 1) * 128;
    nattn_row(Q, K, V, nk, Q, WSP(float, WS_LSE) + (size_t)bgh * 2048 + row, lane);
}
__global__ void __launch_bounds__(256) k_nattn_mem(Params p, int ch) {
    const int lane = threadIdx.x & 63; const size_t w = (size_t)blockIdx.x * 4 + (threadIdx.x >> 6);
    if (w >= (size_t)BC * 4 * 2048) return;
    const int s = (int)(w & 2047); const int bh = (int)(w >> 11); const int bl = bh >> 2, h = bh & 3;
    const bf16_t* Q = WSP(bf16_t, WS_QM) + ((size_t)bh * 2048 + s) * 128;
    const bf16_t* K = WSP(bf16_t, WS_KM) + (size_t)(ch * BC * 4 + bh) * 256 * 128;
    const bf16_t* V = WSP(bf16_t, WS_VM) + (size_t)(ch * BC * 4 + bh) * 256 * 128;
    nattn_row(Q, K, V, 256, WSP(bf16_t, WS_OMT) + ((size_t)(bl * 2048 + s)) * 512 + h * 128, nullptr, lane);
}

__device__ __forceinline__ void combine_token(const Params& p, int rl, int lane) {
    const int bl = rl >> 11, s = rl & 2047, h = lane >> 4, d0 = (lane & 15) * 8;
    float ls[3]; u32x4 o[3];
#pragma unroll
    for (int g = 0; g < 3; ++g) { const size_t r = (size_t)(bl * 12 + g * 4 + h) * 2048 + rowperm(g, s);
        ls[g] = WSP(float, WS_LSE)[r]; o[g] = *(const u32x4*)(WSP(bf16_t, WS_QG) + r * 128 + d0); }
    const float m = fmaxf(ls[0], fmaxf(ls[1], ls[2]));
    float w0 = __expf(ls[0] - m), w1 = __expf(ls[1] - m), w2 = __expf(ls[2] - m); const float inv = 1.0f / (w0 + w1 + w2); w0 *= inv; w1 *= inv; w2 *= inv;
    u32x4 r;
    r.x = pk2(w0 * bflo(o[0].x) + w1 * bflo(o[1].x) + w2 * bflo(o[2].x), w0 * bfhi(o[0].x) + w1 * bfhi(o[1].x) + w2 * bfhi(o[2].x));
    r.y = pk2(w0 * bflo(o[0].y) + w1 * bflo(o[1].y) + w2 * bflo(o[2].y), w0 * bfhi(o[0].y) + w1 * bfhi(o[1].y) + w2 * bfhi(o[2].y));
    r.z = pk2(w0 * bflo(o[0].z) + w1 * bflo(o[1].z) + w2 * bflo(o[2].z), w0 * bfhi(o[0].z) + w1 * bfhi(o[1].z) + w2 * bfhi(o[2].z));
    r.w = pk2(w0 * bflo(o[0].w) + w1 * bflo(o[1].w) + w2 * bflo(o[2].w), w0 * bfhi(o[0].w) + w1 * bfhi(o[1].w) + w2 * bfhi(o[2].w));
#if P4_FP8
    u32x2 r8; r8.x = pk4_fp8(O8_SCALE * bflo(r.x), O8_SCALE * bfhi(r.x), O8_SCALE * bflo(r.y), O8_SCALE * bfhi(r.y)); r8.y = pk4_fp8(O8_SCALE * bflo(r.z), O8_SCALE * bfhi(r.z), O8_SCALE * bflo(r.w), O8_SCALE * bfhi(r.w));
    *(u32x2*)(p.ws + WS_OATT + (size_t)rl * 512 + h * 128 + d0) = r8;
#else
    *(u32x4*)(WSP(bf16_t, WS_OATT) + (size_t)rl * 512 + h * 128 + d0) = r;
#endif
}
__device__ __forceinline__ void combine_token2(const Params& p, int rl0, int rl1, int lane) {
    const int h = lane >> 4, d0 = (lane & 15) * 8;
#if O_FP8 && P4_FP8
    float ls[2][3]; u32x2 o8[2][3];
#pragma unroll
    for (int t = 0; t < 2; ++t) { const int rl = t ? rl1 : rl0; const int bl = rl >> 11, s = rl & 2047;
#pragma unroll
        for (int g = 0; g < 3; ++g) { const size_t r = (size_t)(bl * 12 + g * 4 + h) * 2048 + rowperm(g, s);
            ls[t][g] = WSP(float, WS_LSE)[r]; o8[t][g] = *(const u32x2*)(p.ws + WS_QG + r * 256 + d0); } }
#pragma unroll
    for (int t = 0; t < 2; ++t) { const int rl = t ? rl1 : rl0;
        const float m = fmaxf(ls[t][0], fmaxf(ls[t][1], ls[t][2]));
        float w0 = __expf(ls[t][0] - m), w1 = __expf(ls[t][1] - m), w2 = __expf(ls[t][2] - m); const float inv = 1.0f / (w0 + w1 + w2); w0 *= inv; w1 *= inv; w2 *= inv;
        float f[8] = {0.f, 0.f, 0.f, 0.f, 0.f, 0.f, 0.f, 0.f};
#pragma unroll
        for (int g = 0; g < 3; ++g) { const float wg = g == 0 ? w0 : (g == 1 ? w1 : w2);
            const auto a0 = __builtin_amdgcn_cvt_pk_f32_fp8(o8[t][g].x, false), a1 = __builtin_amdgcn_cvt_pk_f32_fp8(o8[t][g].x, true), a2 = __builtin_amdgcn_cvt_pk_f32_fp8(o8[t][g].y, false), a3 = __builtin_amdgcn_cvt_pk_f32_fp8(o8[t][g].y, true);
            f[0] += wg * a0[0]; f[1] += wg * a0[1]; f[2] += wg * a1[0]; f[3] += wg * a1[1]; f[4] += wg * a2[0]; f[5] += wg * a2[1]; f[6] += wg * a3[0]; f[7] += wg * a3[1]; }
        u32x2 r8; r8.x = pk4_fp8(f[0], f[1], f[2], f[3]); r8.y = pk4_fp8(f[4], f[5], f[6], f[7]);
        *(u32x2*)(p.ws + WS_OATT + (size_t)rl * 512 + h * 128 + d0) = r8;
    }
#else
    float ls[2][3]; u32x4 o[2][3];
#pragma unroll
    for (int t = 0; t < 2; ++t) { const int rl = t ? rl1 : rl0; const int bl = rl >> 11, s = rl & 2047;
#pragma unroll
        for (int g = 0; g < 3; ++g) { const size_t r = (size_t)(bl * 12 + g * 4 + h) * 2048 + rowperm(g, s);
            ls[t][g] = WSP(float, WS_LSE)[r]; o[t][g] = *(const u32x4*)(WSP(bf16_t, WS_QG) + r * 128 + d0); } }
#pragma unroll
    for (int t = 0; t < 2; ++t) { const int rl = t ? rl1 : rl0;
        const float m = fmaxf(ls[t][0], fmaxf(ls[t][1], ls[t][2]));
        float w0 = __expf(ls[t][0] - m), w1 = __expf(ls[t][1] - m), w2 = __expf(ls[t][2] - m); const float inv = 1.0f / (w0 + w1 + w2); w0 *= inv; w1 *= inv; w2 *= inv;
#define CMB(c, f) (w0 * f(o[t][0].c) + w1 * f(o[t][1].c) + w2 * f(o[t][2].c))
#if P4_FP8
        u32x4 r; r.x = pk2(CMB(x, bflo), CMB(x, bfhi)); r.y = pk2(CMB(y, bflo), CMB(y, bfhi)); r.z = pk2(CMB(z, bflo), CMB(z, bfhi)); r.w = pk2(CMB(w, bflo), CMB(w, bfhi));
        u32x2 r8; r8.x = pk4_fp8(O8_SCALE * bflo(r.x), O8_SCALE * bfhi(r.x), O8_SCALE * bflo(r.y), O8_SCALE * bfhi(r.y)); r8.y = pk4_fp8(O8_SCALE * bflo(r.z), O8_SCALE * bfhi(r.z), O8_SCALE * bflo(r.w), O8_SCALE * bfhi(r.w));
        *(u32x2*)(p.ws + WS_OATT + (size_t)rl * 512 + h * 128 + d0) = r8;
#else
        u32x4 r; r.x = pk2(CMB(x, bflo), CMB(x, bfhi)); r.y = pk2(CMB(y, bflo), CMB(y, bfhi)); r.z = pk2(CMB(z, bflo), CMB(z, bfhi)); r.w = pk2(CMB(w, bflo), CMB(w, bfhi));
        *(u32x4*)(WSP(bf16_t, WS_OATT) + (size_t)rl * 512 + h * 128 + d0) = r;
#endif
#undef CMB
    }
#endif
}
__global__ void __launch_bounds__(256) k_combine(Params p) {
    const int lane = threadIdx.x & 63; const int w = blockIdx.x * 4 + (threadIdx.x >> 6);
    if (w < TC) combine_token(p, w, lane);
}
constexpr int CONV_TILE = 62 * 1024, CONV_OUT = 32 * 1024, CONV_LDS = CONV_TILE + CONV_OUT + (8 * 32 + 64) * 4;
__device__ __forceinline__ void conv_unit(const Params& p, int u, unsigned char* lds, int tid_) {
    const int ch = tid_, lane = ch & 63, wv = ch >> 6;
    const int bl = u >> 6, s0 = (u & 63) * 32;
    bf16_t* tile = (bf16_t*)lds; bf16_t* otile = (bf16_t*)(lds + CONV_TILE); float* red = (float*)(lds + CONV_TILE + CONV_OUT);
#if CQ_FP8
    const unsigned char* cg8 = p.ws + WS_CGLU + (size_t)bl * 2048 * 512; unsigned char* tile8 = (unsigned char*)tile;
#pragma unroll
    for (int it = 0; it < 4; ++it) { const int c = it * 512 + ch; if (c < 62 * 32) { const int r = c >> 5, q = c & 31, s = s0 - 30 + r;
        u32x4 v = {0u, 0u, 0u, 0u}; if (s >= 0) v = *(const u32x4*)(cg8 + (size_t)s * 512 + q * 16);
        *(u32x4*)(tile8 + r * 512 + q * 16) = v; } }
#else
    const bf16_t* cg = WSP(bf16_t, WS_CGLU) + (size_t)bl * 2048 * 512;
#pragma unroll
    for (int it = 0; it < 8; ++it) { const int c = it * 512 + ch; if (c < 62 * 64) { const int r = c >> 6, q = c & 63, s = s0 - 30 + r;
        u32x4 v = {0u, 0u, 0u, 0u}; if (s >= 0) v = *(const u32x4*)(cg + (size_t)s * 512 + q * 8);
        *(u32x4*)(tile + r * 512 + q * 8) = v; } }
#endif
    __syncthreads();
    float o[32]; const float cb = p.conv_b[ch];
#pragma unroll
    for (int i = 0; i < 32; ++i) o[i] = cb;
    {   float in[62];
#pragma unroll
#if CQ_FP8
        for (int i = 0; i < 62; ++i) in[i] = __builtin_amdgcn_cvt_f32_fp8((unsigned)tile8[i * 512 + ch], 0);
#else
        for (int i = 0; i < 62; ++i) in[i] = bf2f(tile[i * 512 + ch]);
#endif
#pragma unroll
        for (int j = 0; j < 31; ++j) { const float w = p.conv_w[j * 512 + ch] * (CQ_FP8 ? 1.0f / C8_SCALE : 1.0f);
#pragma unroll
            for (int i = 0; i < 32; ++i) o[i] += w * in[i + j]; } }
    float* mean = red + 256; float* rstd = red + 288;
#pragma unroll
    for (int i = 0; i < 32; ++i) { const float sr = wave_sum(o[i]); if (lane == 0) red[wv * 32 + i] = sr; }
    __syncthreads();
    if (ch < 32) { float sm = 0.f;
#pragma unroll
        for (int w = 0; w < 8; ++w) sm += red[w * 32 + ch];
        mean[ch] = sm * (1.0f / 512.0f); }
    __syncthreads();
#pragma unroll
    for (int i = 0; i < 32; ++i) { o[i] -= mean[i]; const float sr = wave_sum(o[i] * o[i]); if (lane == 0) red[wv * 32 + i] = sr; }
    __syncthreads();
    if (ch < 32) { float sm = 0.f;
#pragma unroll
        for (int w = 0; w < 8; ++w) sm += red[w * 32 + ch];
        rstd[ch] = 1.0f / sqrtf(sm * (1.0f / 512.0f) + LN_EPS); }
    __syncthreads();
    const float gg = p.conv_g[ch], bb = p.conv_bb[ch];
#pragma unroll
#if P4_FP8
    for (int i = 0; i < 32; ++i) { const float y = o[i] * rstd[i] * gg + bb; const float z = O8_SCALE * (y * sigmoidf_(y)); ((unsigned char*)otile)[i * 512 + ch] = (unsigned char)(__builtin_amdgcn_cvt_pk_fp8_f32(z, z, 0, false) & 255); }
    __syncthreads();
    unsigned char* outp = p.ws + WS_CCONV + ((size_t)bl * 2048 + s0) * 512;
#pragma unroll
    for (int it = 0; it < 2; ++it) { const int c = it * 512 + ch; *(u32x4*)(outp + (size_t)c * 16) = *(const u32x4*)((const unsigned char*)otile + c * 16); }
#else
    for (int i = 0; i < 32; ++i) { const float y = o[i] * rstd[i] * gg + bb; otile[i * 512 + ch] = (bf16_t)f2bf(y * sigmoidf_(y)); }
    __syncthreads();
    bf16_t* outp = WSP(bf16_t, WS_CCONV) + ((size_t)bl * 2048 + s0) * 512;
#pragma unroll
    for (int it = 0; it < 4; ++it) { const int c = it * 512 + ch; *(u32x4*)(outp + (size_t)c * 8) = *(const u32x4*)(otile + c * 8); }
#endif
    __syncthreads();
}
__global__ void __launch_bounds__(512) k_conv(Params p) {
    __shared__ __attribute__((aligned(16))) unsigned char cl[CONV_LDS];
    conv_unit(p, blockIdx.x, cl, threadIdx.x);
}
__device__ __forceinline__ void ln1_unit(const Params& p, int u, const float* wr, int* cls_l, int* misc, int tid_, bool dummy = false) {
    const int tid = tid_, lane = tid & 63, wv = tid >> 6;
    float gam[16], bet[16];
#pragma unroll
    for (int j = 0; j < 4; ++j) { const f32x4 g4 = *(const f32x4*)(p.ln1_g + 4 * lane + 256 * j), b4 = *(const f32x4*)(p.ln1_b + 4 * lane + 256 * j);
        gam[4 * j] = g4.x; gam[4 * j + 1] = g4.y; gam[4 * j + 2] = g4.z; gam[4 * j + 3] = g4.w; bet[4 * j] = b4.x; bet[4 * j + 1] = b4.y; bet[4 * j + 2] = b4.z; bet[4 * j + 3] = b4.w; }
    const int tok0 = u * 64 + wv * 8;
    u32x2 xq[2][4]; u32x2 mq[2][4];
#define LN1_LOAD(slot, rr) do { const bf16_t* xr_ = WSP(bf16_t, WS_XB) + (size_t)(tok0 + (rr)) * 1024 + 4 * lane; const bf16_t* mr_ = (const bf16_t*)p.out + (size_t)(tok0 + (rr)) * 1024 + 4 * lane; \
        _Pragma("unroll") for (int j = 0; j < 4; ++j) { xq[slot][j] = *(const u32x2*)(xr_ + 256 * j); mq[slot][j] = *(const u32x2*)(mr_ + 256 * j); } } while (0)
    LN1_LOAD(0, 0);
#pragma unroll
    for (int rr = 0; rr < 8; ++rr) {
        const int lr = wv * 8 + rr; const int tok = tok0 + rr;
        if (rr + 1 < 8) { if (rr & 1) LN1_LOAD(0, rr + 1); else LN1_LOAD(1, rr + 1); }
        float v[16]; float sm = 0.f;
#pragma unroll
        for (int j = 0; j < 4; ++j) { const u32x2 t = xq[rr & 1][j]; const u32x2 mm = mq[rr & 1][j];
            v[4 * j] = DN_ALPHA * bflo(t.x) + bflo(mm.x); v[4 * j + 1] = DN_ALPHA * bfhi(t.x) + bfhi(mm.x); v[4 * j + 2] = DN_ALPHA * bflo(t.y) + bflo(mm.y); v[4 * j + 3] = DN_ALPHA * bfhi(t.y) + bfhi(mm.y);
            sm += (v[4 * j] + v[4 * j + 1]) + (v[4 * j + 2] + v[4 * j + 3]); }
        const float mean = wave_sum(sm) * (1.0f / 1024.0f); float sq = 0.f;
#pragma unroll
        for (int i = 0; i < 16; ++i) { v[i] -= mean; sq += v[i] * v[i]; }
        const float rstd = 1.0f / sqrtf(wave_sum(sq) * (1.0f / 1024.0f) + LN_EPS);
#pragma unroll
        for (int i = 0; i < 16; ++i) v[i] = v[i] * rstd * gam[i] + bet[i];
        bf16_t* xb = WSP(bf16_t, dummy ? WS_H : WS_X1B) + (size_t)tok * 1024;
#pragma unroll
        for (int j = 0; j < 4; ++j) { u32x2 o; o.x = pk2(v[4 * j], v[4 * j + 1]); o.y = pk2(v[4 * j + 2], v[4 * j + 3]); *(u32x2*)(xb + 4 * lane + 256 * j) = o; }
        if (!dummy) { unsigned char* x8 = p.ws + WS_X1B8 + (size_t)tok * 1024;
#pragma unroll
            for (int j = 0; j < 4; ++j) *(unsigned*)(x8 + 4 * lane + 256 * j) = pk4_fp8(v[4 * j], v[4 * j + 1], v[4 * j + 2], v[4 * j + 3]); }
        float gl[4];
#pragma unroll
        for (int e = 0; e < 4; ++e) { float a = 0.f;
#pragma unroll
            for (int j = 0; j < 4; ++j) { const f32x4 w4 = *(const f32x4*)(wr + e * 1024 + 4 * lane + 256 * j); a += v[4 * j] * w4.x + v[4 * j + 1] * w4.y + v[4 * j + 2] * w4.z + v[4 * j + 3] * w4.w; }
            gl[e] = wave_sum(a) + p.b_gr[e]; }
        int gs = 0; float gm = gl[0];
#pragma unroll
        for (int e = 1; e < 4; ++e) if (gl[e] > gm) { gm = gl[e]; gs = e; }
        float gsum = 0.f;
#pragma unroll
        for (int e = 0; e < 4; ++e) gsum += __expf(gl[e] - gm);
        const float gprob = 1.0f / gsum;
        gs = __builtin_amdgcn_readfirstlane(gs);
        float el[4];
#pragma unroll
        for (int e = 0; e < 4; ++e) { float a = 0.f; const float* wp = wr + (4 + gs * 4 + e) * 1024;
#pragma unroll
            for (int j = 0; j < 4; ++j) { const f32x4 w4 = *(const f32x4*)(wp + 4 * lane + 256 * j); a += v[4 * j] * w4.x + v[4 * j + 1] * w4.y + v[4 * j + 2] * w4.z + v[4 * j + 3] * w4.w; }
            el[e] = wave_sum(a) + p.b_er[gs * 4 + e]; }
        int i1 = 0; float v1 = el[0];
#pragma unroll
        for (int e = 1; e < 4; ++e) if (el[e] > v1) { v1 = el[e]; i1 = e; }
        int i2 = -1; float v2 = -INFINITY;
#pragma unroll
        for (int e = 0; e < 4; ++e) if (e != i1 && el[e] > v2) { v2 = el[e]; i2 = e; }
        const float t2 = __expf(v2 - v1); const float w1 = gprob / (1.0f + t2), w2 = gprob * t2 / (1.0f + t2);
        const int lo = i1 < i2 ? i1 : i2, hi = i1 < i2 ? i2 : i1;
        const int pi = lo == 0 ? hi - 1 : (lo == 1 ? hi + 1 : 5);
        if (lane == 0 && !dummy) { cls_l[lr] = gs * 6 + pi; float* wt = WSP(float, WS_WTS) + (size_t)tok * 2; wt[0] = (i1 == lo) ? w1 : w2; wt[1] = (i1 == lo) ? w2 : w1; }
    }
#undef LN1_LOAD
    __syncthreads();
    if (dummy) return;
    if (tid < NCLS) { int n = 0; for (int r = 0; r < 64; ++r) n += (cls_l[r] == tid); misc[tid] = n ? (int)atomicAdd(WSP(unsigned, WS_CTL) + CW_CNT + tid, (unsigned)n) : 0; }
    __syncthreads();
    if (tid < 64) { const int c = cls_l[tid]; int rank = 0; for (int r = 0; r < tid; ++r) rank += (cls_l[r] == c);
        WSP(int, WS_LIST)[(size_t)c * T + misc[c] + rank] = u * 64 + tid; }
    __syncthreads();
}
__device__ __forceinline__ float row16_sum(float v) {
#define DPP_F(x, ctrl) __int_as_float(__builtin_amdgcn_update_dpp(0, __float_as_int(x), ctrl, 0xf, 0xf, true))
    v += DPP_F(v, 0xB1); v += DPP_F(v, 0x4E); v += DPP_F(v, 0x141); v += DPP_F(v, 0x140);
#undef DPP_F
    return v;
}
__device__ __forceinline__ void ln1_unit16(const Params& p, int u, const float* wr, int* cls_l, int* misc, int tid_, bool dummy = false) {
    const int tid = tid_, lane = tid & 63, wv = tid >> 6;
#pragma unroll 1
    for (int pass = 0; pass < 2; ++pass) {
        int q = lane >> 4, l16 = lane & 15; asm volatile("" : "+v"(q), "+v"(l16));
        const int lr = wv * 8 + pass * 4 + q; const int tok = u * 64 + lr;
        const bf16_t* xr = WSP(bf16_t, WS_XB) + (size_t)tok * 1024 + 4 * l16; const bf16_t* mr = (const bf16_t*)p.out + (size_t)tok * 1024 + 4 * l16;
        u32x2 xq[16], mq[16]; f32x4 g4[16], b4[16];
#pragma unroll
        for (int c = 0; c < 16; ++c) { xq[c] = *(const u32x2*)(xr + 64 * c); mq[c] = *(const u32x2*)(mr + 64 * c); }
#pragma unroll
        for (int c = 0; c < 16; ++c) { g4[c] = *(const f32x4*)(p.ln1_g + 64 * c + 4 * l16); b4[c] = *(const f32x4*)(p.ln1_b + 64 * c + 4 * l16); }
        float v[64]; float sm = 0.f;
#pragma unroll
        for (int c = 0; c < 16; ++c) { const u32x2 t = xq[c], mm = mq[c];
            v[4 * c] = DN_ALPHA * bflo(t.x) + bflo(mm.x); v[4 * c + 1] = DN_ALPHA * bfhi(t.x) + bfhi(mm.x); v[4 * c + 2] = DN_ALPHA * bflo(t.y) + bflo(mm.y); v[4 * c + 3] = DN_ALPHA * bfhi(t.y) + bfhi(mm.y);
            sm += (v[4 * c] + v[4 * c + 1]) + (v[4 * c + 2] + v[4 * c + 3]); }
        const float mean = row16_sum(sm) * (1.0f / 1024.0f); float sq = 0.f;
#pragma unroll
        for (int i = 0; i < 64; ++i) { v[i] -= mean; sq += v[i] * v[i]; }
        const float rstd = 1.0f / sqrtf(row16_sum(sq) * (1.0f / 1024.0f) + LN_EPS);
        bf16_t* xb = WSP(bf16_t, dummy ? WS_H : WS_X1B) + (size_t)tok * 1024 + 4 * l16; unsigned char* x8 = p.ws + WS_X1B8 + (size_t)tok * 1024 + 4 * l16;
#pragma unroll
        for (int c = 0; c < 16; ++c) {
            v[4 * c] = v[4 * c] * rstd * g4[c].x + b4[c].x; v[4 * c + 1] = v[4 * c + 1] * rstd * g4[c].y + b4[c].y; v[4 * c + 2] = v[4 * c + 2] * rstd * g4[c].z + b4[c].z; v[4 * c + 3] = v[4 * c + 3] * rstd * g4[c].w + b4[c].w;
            u32x2 o; o.x = pk2(v[4 * c], v[4 * c + 1]); o.y = pk2(v[4 * c + 2], v[4 * c + 3]); *(u32x2*)(xb + 64 * c) = o;
            if (!dummy) *(unsigned*)(x8 + 64 * c) = pk4_fp8(v[4 * c], v[4 * c + 1], v[4 * c + 2], v[4 * c + 3]); }
        asm volatile("" ::: "memory");
        float gl[4];
#pragma unroll
        for (int e = 0; e < 4; ++e) { float a = 0.f;
#pragma unroll
            for (int c = 0; c < 16; ++c) { const f32x4 w4 = *(const f32x4*)(wr + e * 1024 + 64 * c + 4 * l16); a += v[4 * c] * w4.x + v[4 * c + 1] * w4.y + v[4 * c + 2] * w4.z + v[4 * c + 3] * w4.w; }
            gl[e] = a; asm volatile("" ::: "memory"); }
#pragma unroll
        for (int e = 0; e < 4; ++e) gl[e] = row16_sum(gl[e]) + p.b_gr[e];
        int gs = 0; float gm = gl[0];
#pragma unroll
        for (int e = 1; e < 4; ++e) if (gl[e] > gm) { gm = gl[e]; gs = e; }
        float gsum = 0.f;
#pragma unroll
        for (int e = 0; e < 4; ++e) gsum += __expf(gl[e] - gm);
        const float gprob = 1.0f / gsum;
        float el[4]; const float* wpb = wr + (4 + gs * 4) * 1024 + 4 * l16;
#pragma unroll
        for (int e = 0; e < 4; ++e) { float a = 0.f;
#pragma unroll
            for (int c = 0; c < 16; ++c) { const f32x4 w4 = *(const f32x4*)(wpb + e * 1024 + 64 * c); a += v[4 * c] * w4.x + v[4 * c + 1] * w4.y + v[4 * c + 2] * w4.z + v[4 * c + 3] * w4.w; }
            el[e] = a; asm volatile("" ::: "memory"); }
#pragma unroll
        for (int e = 0; e < 4; ++e) el[e] = row16_sum(el[e]) + p.b_er[gs * 4 + e];
        int i1 = 0; float v1 = el[0];
#pragma unroll
        for (int e = 1; e < 4; ++e) if (el[e] > v1) { v1 = el[e]; i1 = e; }
        int i2 = -1; float v2 = -INFINITY;
#pragma unroll
        for (int e = 0; e < 4; ++e) if (e != i1 && el[e] > v2) { v2 = el[e]; i2 = e; }
        const float t2 = __expf(v2 - v1); const float w1 = gprob / (1.0f + t2), w2 = gprob * t2 / (1.0f + t2);
        const int lo = i1 < i2 ? i1 : i2, hi = i1 < i2 ? i2 : i1;
        const int pi = lo == 0 ? hi - 1 : (lo == 1 ? hi + 1 : 5);
        if (l16 == 0 && !dummy) { cls_l[lr] = gs * 6 + pi; float* wt = WSP(float, WS_WTS) + (size_t)tok * 2; wt[0] = (i1 == lo) ? w1 : w2; wt[1] = (i1 == lo) ? w2 : w1; }
    }
    __syncthreads();
    if (dummy) return;
    if (tid < NCLS) { int n = 0; for (int r = 0; r < 64; ++r) n += (cls_l[r] == tid); misc[tid] = n ? (int)atomicAdd(WSP(unsigned, WS_CTL) + CW_CNT + tid, (unsigned)n) : 0; }
    __syncthreads();
    if (tid < 64) { const int c = cls_l[tid]; int rank = 0; for (int r = 0; r < tid; ++r) rank += (cls_l[r] == c);
        WSP(int, WS_LIST)[(size_t)c * T + misc[c] + rank] = u * 64 + tid; }
    __syncthreads();
}
__global__ void __launch_bounds__(512) k_ln1(Params p) {
    extern __shared__ float dyn[];
    float* wr = dyn; int* cls_l = (int*)(dyn + 20 * 1024); int* misc = cls_l + 64;
    for (int i = threadIdx.x; i < 20 * 1024; i += 512) wr[i] = WSP(float, WS_WRT)[i];
    __syncthreads();
    for (int u = blockIdx.x; u < T / 64; u += gridDim.x) ln1_unit(p, u, wr, cls_l, misc, threadIdx.x);
}
template <int NR>
__device__ __forceinline__ void ln2_rows(const Params& p, const int (&tok)[NR], const int (&prow)[NR], int lane, float* dummy = nullptr) {
    u32x2 xa[NR][4];
#if Y2_FP8
    unsigned ya[NR][4];
#pragma unroll
    for (int r = 0; r < NR; ++r) if (tok[r] >= 0) { const bf16_t* xrow = WSP(bf16_t, WS_X1B) + (size_t)tok[r] * 1024 + 4 * lane; const unsigned char* yrow = p.ws + WS_Y2 + (size_t)prow[r] * 1024 + 4 * lane;
#pragma unroll
        for (int j = 0; j < 4; ++j) { xa[r][j] = *(const u32x2*)(xrow + 256 * j); ya[r][j] = *(const unsigned*)(yrow + 256 * j); } }
#else
    u32x2 ya[NR][4];
#pragma unroll
    for (int r = 0; r < NR; ++r) if (tok[r] >= 0) { const bf16_t* xrow = WSP(bf16_t, WS_X1B) + (size_t)tok[r] * 1024 + 4 * lane; const bf16_t* yrow = WSP(bf16_t, WS_Y2) + (size_t)prow[r] * 1024 + 4 * lane;
#pragma unroll
        for (int j = 0; j < 4; ++j) { xa[r][j] = *(const u32x2*)(xrow + 256 * j); ya[r][j] = *(const u32x2*)(yrow + 256 * j); } }
#endif
    f32x4 g4[4], b4[4];
#pragma unroll
    for (int j = 0; j < 4; ++j) { g4[j] = *(const f32x4*)(p.ln2_g + 4 * lane + 256 * j); b4[j] = *(const f32x4*)(p.ln2_b + 4 * lane + 256 * j); }
#pragma unroll
    for (int r = 0; r < NR; ++r) if (tok[r] >= 0) {
        float v[16]; float sm = 0.f;
#pragma unroll
        for (int j = 0; j < 4; ++j) { const u32x2 t = xa[r][j];
#if Y2_FP8
            const auto ylo = __builtin_amdgcn_cvt_pk_f32_fp8(ya[r][j], false), yhi = __builtin_amdgcn_cvt_pk_f32_fp8(ya[r][j], true);
            v[4 * j] = DN_ALPHA * bflo(t.x) + ylo[0] * (1.0f / Y8_SCALE); v[4 * j + 1] = DN_ALPHA * bfhi(t.x) + ylo[1] * (1.0f / Y8_SCALE); v[4 * j + 2] = DN_ALPHA * bflo(t.y) + yhi[0] * (1.0f / Y8_SCALE); v[4 * j + 3] = DN_ALPHA * bfhi(t.y) + yhi[1] * (1.0f / Y8_SCALE);
#else
            const u32x2 y = ya[r][j];
            v[4 * j] = DN_ALPHA * bflo(t.x) + bflo(y.x); v[4 * j + 1] = DN_ALPHA * bfhi(t.x) + bfhi(y.x); v[4 * j + 2] = DN_ALPHA * bflo(t.y) + bflo(y.y); v[4 * j + 3] = DN_ALPHA * bfhi(t.y) + bfhi(y.y);
#endif
            sm += (v[4 * j] + v[4 * j + 1]) + (v[4 * j + 2] + v[4 * j + 3]); }
        const float mean = wave_sum(sm) * (1.0f / 1024.0f); float sq = 0.f;
#pragma unroll
        for (int i2 = 0; i2 < 16; ++i2) { v[i2] -= mean; sq += v[i2] * v[i2]; }
        const float rstd = 1.0f / sqrtf(wave_sum(sq) * (1.0f / 1024.0f) + LN_EPS);
        float* orow = (dummy ? dummy : p.out) + (size_t)tok[r] * 1024 + 4 * lane;
#pragma unroll
        for (int j = 0; j < 4; ++j) *(f32x4*)(orow + 256 * j) = (f32x4){v[4 * j] * rstd * g4[j].x + b4[j].x, v[4 * j + 1] * rstd * g4[j].y + b4[j].y, v[4 * j + 2] * rstd * g4[j].z + b4[j].z, v[4 * j + 3] * rstd * g4[j].w + b4[j].w};
    }
}
__global__ void __launch_bounds__(256) k_ln2(Params p) {
    __shared__ ClassTab tabs; if (threadIdx.x == 0) class_tab_fill(WSP(unsigned, WS_CTL) + CW_CNT, &tabs); __syncthreads(); const ClassTab* tab = &tabs;
    const int lane = threadIdx.x & 63; const int prow = blockIdx.x * 4 + (threadIdx.x >> 6);
    if (prow >= tab->rowbase[NCLS]) return;
    const int cls = find_class(tab, prow); const int i = prow - tab->rowbase[cls]; if (i >= tab->cnt[cls]) return;
    const int tk[1] = {WSP(int, WS_LIST)[(size_t)cls * T + i]}, pr[1] = {prow};
    ln2_rows<1>(p, tk, pr, lane);
}


#define LAS __attribute__((address_space(3)))
#define GAS __attribute__((address_space(1)))
constexpr int RING_OFF = 0, RING_BYTES = 131072;
constexpr int LCTL_OFF = RING_BYTES;
constexpr int LTOK_OFF = LCTL_OFF + 4096, MAXU = 16;
constexpr int LDS_BYTES = LTOK_OFF + MAXU * 1024;
constexpr int NTHR = 512, NWAVES = 8;

#ifndef FP6_DIAG
#define FP6_DIAG 1
#endif
#if FP6_DIAG & 1
#define FP6_PRE "s_nop 3\n\t"
#else
#define FP6_PRE
#endif
#define FP6_DIAG_V0 ((FP6_DIAG >> 1) & 1)
namespace pg8 {
typedef short bf16x8 __attribute__((ext_vector_type(8)));
typedef int v4i_t __attribute__((ext_vector_type(4)));
typedef int v8i_t __attribute__((ext_vector_type(8)));
typedef int v6i_t __attribute__((ext_vector_type(6)));
typedef int v2i_t __attribute__((ext_vector_type(2)));
constexpr int BM = 256, BK = 64, HALF = 128, HTB = HALF * BK * 2, NXCD = 8, WGM = 8;
__host__ __device__ __forceinline__ int lds_byte(int r, int c) { const int st = (r >> 4) * 2 + (c >> 5), rr = r & 15, cc = c & 31, ob = rr * 64 + cc * 2; return st * 1024 + (ob ^ (((ob >> 9) & 1) << 5)); }
__host__ __device__ __forceinline__ void stage_rc(int b, int& R, int& C) { const int st = b / 1024, sb = b % 1024, swz = sb ^ (((sb >> 9) & 1) << 5); R = (st >> 1) * 16 + swz / 64; C = (st & 1) * 32 + (swz % 64) / 2; }
__host__ __device__ __forceinline__ int perm32(int rho) { const int n = rho >> 4, i = rho & 15; return 8 * (i >> 2) + 4 * n + (i & 3); }

struct Unit { const char* A; const char* B; int row0, col0, bjump, aux; };
struct TileOrder {
    int nM, nN, nwg, G, c;
    __device__ __forceinline__ void init(int nM_, int nN_, int G_, int c_) { nM = nM_; nN = nN_; nwg = nM * nN; G = G_; c = c_; }
    __device__ __forceinline__ bool tile(int i, int& pm, int& pn) const {
        const long L = (long)i * G + c; if (L >= nwg) return false;
        int wgid = (int)L; { const int q = nwg / NXCD, r = nwg % NXCD, xcd = wgid % NXCD, off = wgid / NXCD; wgid = (xcd < r ? xcd * (q + 1) : r * (q + 1) + (xcd - r) * q) + off; }
        const int nig = WGM * nN, gid = wgid / nig, fm = gid * WGM, gsz = (nM - fm) < WGM ? (nM - fm) : WGM;
        pm = fm + ((wgid % nig) % gsz); pn = (wgid % nig) / gsz; return true;
    }
};
__device__ __forceinline__ unsigned cvt_pk_bf16(float lo, float hi) { unsigned r; asm volatile("v_cvt_pk_bf16_f32 %0, %1, %2" : "=v"(r) : "v"(lo), "v"(hi)); return r; }

template <class EF> struct EpiRows {
    static constexpr bool PERM = true, KEEPS = false;
    EF ef;
    __device__ __forceinline__ bool keep_acc(const Unit&) const { return false; }
    __device__ __forceinline__ void operator()(f32x4 (&acc)[2][2][4][2], const Unit& u, int wr, int wc, int fr, int fq) const {
#pragma unroll
        for (int ai = 0; ai < 2; ++ai)
#pragma unroll
            for (int m = 0; m < 4; ++m) { const int row = u.row0 + ai * HALF + wr * 64 + m * 16 + fr;
#pragma unroll
                for (int bj = 0; bj < 2; ++bj) { const int c0 = u.col0 + bj * HALF + wc * 32 + 8 * fq;
                    float v[8] = {acc[ai][bj][m][0][0], acc[ai][bj][m][0][1], acc[ai][bj][m][0][2], acc[ai][bj][m][0][3], acc[ai][bj][m][1][0], acc[ai][bj][m][1][1], acc[ai][bj][m][1][2], acc[ai][bj][m][1][3]};
                    ef(u, row, c0, v); }
                asm volatile("" ::: "memory"); }
    }
};

template <class Epi, class Sched, bool ALIGN_EPI, bool GATHER, bool BJUMP, int LOWP = 0>
__device__ __forceinline__ void gemm_phase(LAS unsigned char* lds, const char* Abase, int lda, int ldb, int K, const Sched& S, const Epi& E, int wave_s) {
    const int tid = opaque_tid(wave_s), wid = __builtin_amdgcn_readfirstlane(tid >> 6), lane = tid & 63, wr = wid >> 2, wc = wid & 3, fr = lane & 15, fq = lane >> 4;
    const int nt = K / BK;
    unsigned voffA[2], voffB[2]; unsigned voffG[2][2], nvoffG[2][2];
#pragma unroll
    for (int i = 0; i < 2; ++i) { int R, C; stage_rc(tid * 16 + i * 8192, R, C); const int Rb = Epi::PERM ? ((R & ~31) + perm32(R & 31)) : R;
        voffA[i] = (unsigned)(R * lda + C) * 2u; voffB[i] = (unsigned)(Rb * ldb + C) * 2u; voffG[0][i] = voffG[1][i] = nvoffG[0][i] = nvoffG[1][i] = 0u; }
    const size_t kstep = (size_t)(BK * 2);
    const size_t hstepA = (size_t)HALF * lda * 2, hstepB = (size_t)HALF * ldb * 2;
    const unsigned ldsw = (unsigned)wid * 1024u;
    const int aoff = lds_byte(wr * 64 + fr, fq * 8), boff = lds_byte(wc * 32 + fr, fq * 8);
#define PG8_SA(b, h) (((b) * 2 + (h)) * HTB)
#define PG8_SB(b, h) ((4 + (b) * 2 + (h)) * HTB)
#define PG8_GLDS(gptr, ldsoff) __builtin_amdgcn_global_load_lds((const unsigned*)(gptr), (LAS unsigned*)(lds + (ldsoff)), 16, 0, 0)
#define PG8_STAGE_B(bufoff, gbase) do { _Pragma("unroll") for (int _i = 0; _i < 2; ++_i) PG8_GLDS((const char*)(gbase) + voffB[_i], (bufoff) + ldsw + _i * 8192); } while (0)
#define PG8_STAGE_A(bufoff, kptr, h, nx) do { if constexpr (GATHER) { _Pragma("unroll") for (int _i = 0; _i < 2; ++_i) PG8_GLDS((const char*)(kptr) + ((nx) ? nvoffG[h][_i] : voffG[h][_i]), (bufoff) + ldsw + _i * 8192); } \
        else { _Pragma("unroll") for (int _i = 0; _i < 2; ++_i) PG8_GLDS((const char*)(kptr) + (h) * hstepA + voffA[_i], (bufoff) + ldsw + _i * 8192); } } while (0)
#define PG8_GATHER_OFFS(dst, ord) do { LAS const int* _tk = S.toks(ord); _Pragma("unroll") for (int _h = 0; _h < 2; ++_h) _Pragma("unroll") for (int _i = 0; _i < 2; ++_i) { int _R, _C; stage_rc(tid * 16 + _i * 8192, _R, _C); \
        dst[_h][_i] = (unsigned)_tk[_h * HALF + _R] * (unsigned)(lda * 2) + (unsigned)(_C * 2); } } while (0)
#define PG8_LD16(addr) (*(const LAS bf16x8*)(addr))
#define PG8_LD8(addr) __builtin_bit_cast(bf16x8, __builtin_shufflevector(*(const LAS v2i_t*)(addr), *(const LAS v2i_t*)(addr), 0, 1, -1, -1))
#define PG8_LDA(dst, b, h) do { _Pragma("unroll") for (int m = 0; m < 4; ++m) { dst[m][0] = PG8_LD16(lds + PG8_SA(b, h) + aoff + m * 2048); \
        if constexpr (LOWP == 2) dst[m][1] = PG8_LD8(lds + PG8_SA(b, h) + aoff + m * 2048 + 1024); else dst[m][1] = PG8_LD16(lds + PG8_SA(b, h) + aoff + m * 2048 + 1024); } } while (0)
#define PG8_LDB(dst, b, h) do { _Pragma("unroll") for (int n = 0; n < 2; ++n) { dst[n][0] = PG8_LD16(lds + PG8_SB(b, h) + boff + n * 2048); \
        if constexpr (LOWP == 2) dst[n][1] = PG8_LD8(lds + PG8_SB(b, h) + boff + n * 2048 + 1024); else dst[n][1] = PG8_LD16(lds + PG8_SB(b, h) + boff + n * 2048 + 1024); } } while (0)
#define PG8_CAT8(lo, hi) __builtin_shufflevector(__builtin_bit_cast(v4i_t, lo), __builtin_bit_cast(v4i_t, hi), 0, 1, 2, 3, 4, 5, 6, 7)
#define PG8_CAT6(lo, hi) __builtin_shufflevector(__builtin_bit_cast(v4i_t, lo), __builtin_bit_cast(v4i_t, hi), 0, 1, 2, 3, 4, 5)
#define PG8_MMA(ai, bj, At, Bt, Z) do { __builtin_amdgcn_s_setprio(1); if constexpr (LOWP == 1) { _Pragma("unroll") for (int m = 0; m < 4; ++m) _Pragma("unroll") for (int n = 0; n < 2; ++n) \
        { const v8i_t b8_ = PG8_CAT8(Bt[n][0], Bt[n][1]), a8_ = PG8_CAT8(At[m][0], At[m][1]); \
          if (Z) asm volatile("v_mfma_f32_16x16x128_f8f6f4 %0, %1, %2, 0" : "=v"(acc[ai][bj][m][n]) : "v"(b8_), "v"(a8_)); \
          else asm volatile("v_mfma_f32_16x16x128_f8f6f4 %0, %1, %2, %0" : "+v"(acc[ai][bj][m][n]) : "v"(b8_), "v"(a8_)); } } \
        else if constexpr (LOWP == 2) { _Pragma("unroll") for (int m = 0; m < 4; ++m) _Pragma("unroll") for (int n = 0; n < 2; ++n) \
        { const v6i_t b6_ = PG8_CAT6(Bt[n][0], Bt[n][1]), a6_ = PG8_CAT6(At[m][0], At[m][1]); if (Z) acc[ai][bj][m][n] = (f32x4){0.f, 0.f, 0.f, 0.f}; asm volatile(FP6_PRE "v_mfma_f32_16x16x128_f8f6f4 %0, %1, %2, %0 cbsz:2 blgp:2" : "+v"(acc[ai][bj][m][n]) : "v"(b6_), "v"(a6_)); } } \
        else { _Pragma("unroll") for (int m = 0; m < 4; ++m) _Pragma("unroll") for (int n = 0; n < 2; ++n) { \
        acc[ai][bj][m][n] = __builtin_amdgcn_mfma_f32_16x16x32_bf16(Bt[n][0], At[m][0], (Z) ? (f32x4){0.f, 0.f, 0.f, 0.f} : acc[ai][bj][m][n], 0, 0, 0); \
        acc[ai][bj][m][n] = __builtin_amdgcn_mfma_f32_16x16x32_bf16(Bt[n][1], At[m][1], acc[ai][bj][m][n], 0, 0, 0); } } __builtin_amdgcn_s_setprio(0); } while (0)
#define PG8_WAIT_V(n) do { if (LOWP == 2 && FP6_DIAG_V0) asm volatile("s_waitcnt vmcnt(0)" ::: "memory"); else asm volatile("s_waitcnt vmcnt(" #n ")" ::: "memory"); } while (0)
#define PG8_WAIT_L(n) asm volatile("s_waitcnt lgkmcnt(" #n ")" ::: "memory")
#define PG8_BAR __builtin_amdgcn_s_barrier()
#define PG8_SCHED __builtin_amdgcn_sched_barrier(0)
    Unit cur, nxt; int ui = 0;
    if (!S.next(0, cur)) return;
    constexpr bool ZRESET = Epi::KEEPS || LOWP != 1;
    f32x4 acc[2][2][4][2];
    if constexpr (ZRESET) {
#pragma unroll
        for (int a = 0; a < 2; ++a)
#pragma unroll
            for (int b = 0; b < 2; ++b)
#pragma unroll
                for (int m = 0; m < 4; ++m)
#pragma unroll
                    for (int n = 0; n < 2; ++n) acc[a][b][m][n] = (f32x4){0.f, 0.f, 0.f, 0.f}; }
    bf16x8 At[4][2], B0[2][2], B1[2][2];
    const char* cA = GATHER ? Abase : cur.A; const char* cB = cur.B;
    if constexpr (GATHER) PG8_GATHER_OFFS(voffG, 0);
    PG8_STAGE_B(PG8_SB(0, 0), cB); PG8_STAGE_B(PG8_SB(0, 1), cB + hstepB); PG8_STAGE_A(PG8_SA(0, 0), cA, 0, false); PG8_STAGE_A(PG8_SA(0, 1), cA, 1, false);
    if (wr == 1) PG8_BAR;
    PG8_WAIT_V(2); PG8_BAR;
    PG8_STAGE_B(PG8_SB(1, 0), cB + kstep); PG8_STAGE_A(PG8_SA(1, 0), cA + kstep, 0, false); PG8_STAGE_B(PG8_SB(1, 1), cB + hstepB + kstep);
    PG8_WAIT_V(6); PG8_BAR;
    for (;;) {
        const bool has_next = S.next(ui + 1, nxt);
        if constexpr (GATHER) { if (has_next) PG8_GATHER_OFFS(nvoffG, ui + 1); else {
#pragma unroll
            for (int h = 0; h < 2; ++h)
#pragma unroll
                for (int i = 0; i < 2; ++i) nvoffG[h][i] = voffG[h][i]; } }
        const char* nA = GATHER ? Abase : (has_next ? nxt.A : cA); const char* nB = has_next ? nxt.B : cB;
#define PG8_ITER(t, ZF) do { \
            const bool last = ((t) == nt - 2); \
            const char* a1 = cA + (size_t)((t) + 1) * kstep; \
            const char* a2 = last ? nA : cA + (size_t)((t) + 2) * kstep; \
            const char* b2 = last ? nB : cB + (size_t)((t) + 2) * kstep + ((BJUMP && ((t) + 2) >= (nt >> 1)) ? cur.bjump : 0); \
            const char* a3 = a2 + kstep; const char* b3 = b2 + kstep; \
              \
            PG8_LDB(B0, 0, 0); PG8_LDB(B1, 0, 1); PG8_SCHED; PG8_LDA(At, 0, 0); PG8_STAGE_A(PG8_SA(1, 1), a1, 1, false); \
            PG8_WAIT_V(8); PG8_WAIT_L(0); PG8_BAR; PG8_MMA(0, 0, At, B0, ZF); PG8_MMA(0, 1, At, B1, ZF); PG8_BAR; PG8_SCHED; \
              \
            PG8_LDA(At, 0, 1); PG8_STAGE_B(PG8_SB(0, 0), b2); PG8_STAGE_B(PG8_SB(0, 1), b2 + hstepB); PG8_STAGE_A(PG8_SA(0, 0), a2, 0, last); \
            PG8_WAIT_V(8); PG8_WAIT_L(0); PG8_BAR; PG8_MMA(1, 0, At, B0, ZF); PG8_MMA(1, 1, At, B1, ZF); PG8_BAR; PG8_SCHED; \
              \
            PG8_LDB(B0, 1, 0); PG8_LDB(B1, 1, 1); PG8_SCHED; PG8_LDA(At, 1, 0); PG8_STAGE_A(PG8_SA(0, 1), a2, 1, last); \
            PG8_WAIT_V(8); PG8_WAIT_L(0); PG8_BAR; PG8_MMA(0, 0, At, B0, false); PG8_MMA(0, 1, At, B1, false); PG8_BAR; PG8_SCHED; \
              \
            PG8_LDA(At, 1, 1); PG8_STAGE_B(PG8_SB(1, 0), b3); PG8_STAGE_B(PG8_SB(1, 1), b3 + hstepB); PG8_STAGE_A(PG8_SA(1, 0), a3, 0, last); \
            PG8_WAIT_V(8); PG8_WAIT_L(0); PG8_BAR; PG8_MMA(1, 0, At, B0, false); PG8_MMA(1, 1, At, B1, false); PG8_BAR; PG8_SCHED; \
        } while (0)
        if constexpr (ZRESET) {
#pragma nounroll
            for (int t = 0; t < nt; t += 2) PG8_ITER(t, false);
        } else {
            PG8_ITER(0, true);
#pragma nounroll
            for (int t = 2; t < nt; t += 2) PG8_ITER(t, false);
        }
#undef PG8_ITER
        if constexpr (ALIGN_EPI) { if (wr == 0) PG8_BAR; }
        if constexpr (LOWP != 0) { asm volatile("s_nop 15\n\ts_nop 15" ::: "memory"); PG8_SCHED; }
        E(acc, cur, wr, wc, fr, fq);
        if (!has_next) break;
        if constexpr (ZRESET) { if (!E.keep_acc(cur)) {
#pragma unroll
            for (int a = 0; a < 2; ++a)
#pragma unroll
                for (int b = 0; b < 2; ++b)
#pragma unroll
                    for (int m = 0; m < 4; ++m)
#pragma unroll
                        for (int n = 0; n < 2; ++n) acc[a][b][m][n] = (f32x4){0.f, 0.f, 0.f, 0.f}; } }
        cur = nxt; cA = nA; cB = nB; ++ui;
        if constexpr (GATHER) {
#pragma unroll
            for (int h = 0; h < 2; ++h)
#pragma unroll
                for (int i = 0; i < 2; ++i) voffG[h][i] = nvoffG[h][i]; }
        if constexpr (ALIGN_EPI) { if (wr == 1) PG8_BAR; }
    }
    PG8_WAIT_V(0);
    if constexpr (!ALIGN_EPI) { if (wr == 0) PG8_BAR; }
    PG8_BAR;
#undef PG8_SA
#undef PG8_SB
#undef PG8_GLDS
#undef PG8_STAGE_A
#undef PG8_STAGE_B
#undef PG8_GATHER_OFFS
#undef PG8_LDA
#undef PG8_LDB
#undef PG8_MMA
#undef PG8_CAT8
#undef PG8_CAT6
#undef PG8_LD16
#undef PG8_LD8
#undef PG8_WAIT_V
#undef PG8_WAIT_L
#undef PG8_BAR
#undef PG8_SCHED
}
}

namespace swa {
typedef short bf16x8 __attribute__((ext_vector_type(8)));
typedef short s16x4 __attribute__((ext_vector_type(4)));
typedef float f32x16 __attribute__((ext_vector_type(16)));
constexpr int DH = 128, NW = 8, QBLK = 32, KVBLK = 64, QB = NW * QBLK;
constexpr int SHM_V = KVBLK * DH * 2, SHM_K = KVBLK * DH * 2;
constexpr int LDS_NEED = 2 * SHM_V + 2 * SHM_K + NW * 64 * 4;
constexpr float SCALE = 0.08838834764831845f, THR = 8.f;
#define KSWZ(row, colB) ((row) * 256 + ((colB) ^ (((row) & 7) << 4)))
#define SBAR() __builtin_amdgcn_sched_barrier(0)
__device__ __forceinline__ int v_st(int k, int c) { const int kk = (k & ~0xC) | ((k & 4) << 1) | ((k & 8) >> 1); return ((kk >> 3) * 4 + (c >> 5)) * 512 + ((kk & 7) * 32 + (c & 31)) * 2; }
__device__ __forceinline__ int v_rd_base(int lane) { return ((lane & 3) << 3) | (((lane >> 2) & 3) << 6) | (((lane >> 4) & 1) << 5) | (((lane >> 5) & 1) << 8); }
constexpr int v_rd_off(int d0, int ks, int half) { return d0 * 512 + ks * 4096 + half * 2048; }
__device__ __forceinline__ int crow(int r, int hi) { return (r & 3) + 8 * (r >> 2) + 4 * hi; }
__device__ __forceinline__ unsigned cvtpk(float lo, float hi) { unsigned r; asm volatile("v_cvt_pk_bf16_f32 %0, %1, %2" : "=v"(r) : "v"(lo), "v"(hi)); return r; }
__device__ __forceinline__ bf16x8 load8(const bf16_t* p) { return *reinterpret_cast<const bf16x8*>(p); }
__device__ __forceinline__ void mask_tile(f32x16& p0, f32x16& p1, int dq, unsigned W) {
    const float NEG = -__builtin_inff();
#pragma unroll
    for (int r = 0; r < 16; ++r) {
        const int c = (r & 3) + 8 * (r >> 2);
        if ((unsigned)(dq - c) >= W) p0[r] = NEG;
        if ((unsigned)(dq - c - 32) >= W) p1[r] = NEG;
    }
}
__device__ __forceinline__ void partialSM(f32x16& p0, f32x16& p1, float& m_reg, float& mn, float& alpha) {
    float pmax = p0[0]; for (int r = 1; r < 16; ++r) pmax = fmaxf(pmax, p0[r]); for (int r = 0; r < 16; ++r) pmax = fmaxf(pmax, p1[r]);
    { auto rr = __builtin_amdgcn_permlane32_swap(__float_as_uint(pmax), __float_as_uint(pmax), false, false);
      pmax = fmaxf(__uint_as_float(rr[0]), __uint_as_float(rr[1])); }
    constexpr float C2 = 1.4426950408889634f * SCALE;
    if (__builtin_expect(__all((pmax - m_reg) * SCALE <= THR), 1)) { mn = m_reg; alpha = 1.f; }
    else { mn = fmaxf(m_reg, pmax); alpha = __builtin_amdgcn_exp2f((m_reg - mn) * C2); m_reg = mn; }
    const float mnL = -mn * C2;
    for (int r = 0; r < 16; ++r) p0[r] = fmaf(p0[r], C2, mnL); for (int r = 0; r < 16; ++r) p1[r] = fmaf(p1[r], C2, mnL);
    for (int r = 0; r < 16; ++r) p0[r] = __builtin_amdgcn_exp2f(p0[r]);
}
__device__ __forceinline__ void finishSM(f32x16& p0, f32x16& p1, float alpha, float& l_reg, bf16x8& pa0, bf16x8& pa1, bf16x8& pa2, bf16x8& pa3) {
    for (int r = 0; r < 16; ++r) p1[r] = __builtin_amdgcn_exp2f(p1[r]);
    float ps = 0; for (int r = 0; r < 16; ++r) ps += p0[r]; for (int r = 0; r < 16; ++r) ps += p1[r];
    { auto rr = __builtin_amdgcn_permlane32_swap(__float_as_uint(ps), __float_as_uint(ps), false, false);
      ps = __uint_as_float(rr[0]) + __uint_as_float(rr[1]); }
    l_reg = l_reg * alpha + ps;
#define PK4(P, B_, OUT) do { unsigned a0 = cvtpk(P[B_+0], P[B_+1]), a1 = cvtpk(P[B_+2], P[B_+3]);                          \
        unsigned b0 = cvtpk(P[B_+4], P[B_+5]), b1 = cvtpk(P[B_+6], P[B_+7]);                                             \
        auto r0 = __builtin_amdgcn_permlane32_swap(a0, b0, false, false); auto r1 = __builtin_amdgcn_permlane32_swap(a1, b1, false, false); \
        u32x4 w = {r0[0], r1[0], r0[1], r1[1]}; OUT = *reinterpret_cast<bf16x8*>(&w); } while (0)
    PK4(p0, 0, pa0); PK4(p0, 8, pa1); PK4(p1, 0, pa2); PK4(p1, 8, pa3);
#undef PK4
}
template <int KB>
__device__ __forceinline__ void qkt(f32x16& p0, f32x16& p1, const char* K_lds, int r32, int hi, const bf16x8* qr, bool act) {
    if (!act) { const float NEG = -__builtin_inff();
#pragma unroll
        for (int r = 0; r < 16; ++r) { p0[r] = NEG; p1[r] = NEG; } return; }
    p0 = f32x16{}; p1 = f32x16{};
    const char* kb[4];
#pragma unroll
    for (int dd = 0; dd < 4; ++dd) kb[dd] = K_lds + KB * SHM_K + KSWZ(r32, (dd * 16 + hi * 8) * 2);
#pragma unroll
    for (int d0 = 0; d0 < 8; ++d0) { const char* a = kb[d0 & 3] + (d0 >> 2) * 128;
        bf16x8 b0 = *reinterpret_cast<const bf16x8*>(a);
        bf16x8 b1 = *reinterpret_cast<const bf16x8*>(a + 32 * 256);
        p0 = __builtin_amdgcn_mfma_f32_32x32x16_bf16(b0, qr[d0], p0, 0, 0, 0);
        p1 = __builtin_amdgcn_mfma_f32_32x32x16_bf16(b1, qr[d0], p1, 0, 0, 0); }
}
template <int VB>
__device__ __forceinline__ void pv_tile(f32x16* o, int vb0, bf16x8 pa0, bf16x8 pa1, bf16x8 pa2, bf16x8 pa3, bool act) {
    if (!act) return;
#define TRRD(dst, off) asm volatile("ds_read_b64_tr_b16 %0, %1 offset:%2" : "=&v"(dst) : "v"(vb0), "i"(off) : "memory")
#define PV_D0(d0) do { s16x4 l0, l1, l2, l3, h0, h1, h2, h3; constexpr int b_ = VB * SHM_V + v_rd_off(d0, 0, 0); \
        TRRD(l0, b_); TRRD(h0, b_ + 2048); TRRD(l1, b_ + 4096); TRRD(h1, b_ + 6144); TRRD(l2, b_ + 8192); TRRD(h2, b_ + 10240); TRRD(l3, b_ + 12288); TRRD(h3, b_ + 14336); \
        asm volatile("s_waitcnt lgkmcnt(0)" ::: "memory"); SBAR();   \
        o[d0] = __builtin_amdgcn_mfma_f32_32x32x16_bf16(pa0, (bf16x8){l0[0], l0[1], l0[2], l0[3], h0[0], h0[1], h0[2], h0[3]}, o[d0], 0, 0, 0);   \
        o[d0] = __builtin_amdgcn_mfma_f32_32x32x16_bf16(pa1, (bf16x8){l1[0], l1[1], l1[2], l1[3], h1[0], h1[1], h1[2], h1[3]}, o[d0], 0, 0, 0);   \
        o[d0] = __builtin_amdgcn_mfma_f32_32x32x16_bf16(pa2, (bf16x8){l2[0], l2[1], l2[2], l2[3], h2[0], h2[1], h2[2], h2[3]}, o[d0], 0, 0, 0);   \
        o[d0] = __builtin_amdgcn_mfma_f32_32x32x16_bf16(pa3, (bf16x8){l3[0], l3[1], l3[2], l3[3], h3[0], h3[1], h3[2], h3[3]}, o[d0], 0, 0, 0); } while (0)
    PV_D0(0); PV_D0(1); PV_D0(2); PV_D0(3);
#undef PV_D0
#undef TRRD
}
struct BlockRef { const bf16_t* Q; const bf16_t* K; const bf16_t* V; bf16_t* O; float* LSE; int P0, W, segmask, skv, ostride; };
struct Seam { bf16x8 qr[8]; bf16x8 st_v0, st_v1, st_k0, st_k1; };
__device__ __forceinline__ int imax(int a, int b) { return a > b ? a : b; }
__device__ __forceinline__ int blk_jlo(const BlockRef& b) { const int lowk = imax(b.P0 - b.W + 1, b.P0 & ~b.segmask); return lowk > 0 ? lowk / KVBLK : 0; }
#define ROW(p, k0, rr) ((p) + (size_t)((k0) + (rr)) * DH + sc)
#define VMW() asm volatile("s_waitcnt vmcnt(0)" ::: "memory")
#define VMWN(n) asm volatile("s_waitcnt vmcnt(%0)" :: "i"(n) : "memory")
#define SLOAD_H(Kp, Vp, k0) do { S.st_v0 = load8(ROW(Vp, k0, sr)); S.st_v1 = load8(ROW(Vp, k0, 32 + sr));              \
                         S.st_k0 = load8(ROW(Kp, k0, sr)); S.st_k1 = load8(ROW(Kp, k0, 32 + sr)); } while (0)
#define SWRITE_HK(bf) do { *(bf16x8*)(K_lds + (bf) * SHM_K + kws) = S.st_k0; *(bf16x8*)(K_lds + (bf) * SHM_K + kws + 32 * 256) = S.st_k1; } while (0)
#define SWRITE_HV(bf) do { *(bf16x8*)(V_lds + (bf) * SHM_V + vst0) = S.st_v0; *(bf16x8*)(V_lds + (bf) * SHM_V + vst1) = S.st_v1; } while (0)
#define SWRITE_H(bf) do { SWRITE_HV(bf); SWRITE_HK(bf); } while (0)
__device__ __forceinline__ void prime(const BlockRef& cur, char* lds, Seam& S, int wave_s) {
    const int tid = opaque_tid(wave_s), wid = __builtin_amdgcn_readfirstlane(tid >> 6), lane = tid & 63, r32 = lane & 31, hi = lane >> 5;
    const int sr = tid >> 4, sc = (tid & 15) * 8, kws = KSWZ(sr, sc * 2); char* K_lds = lds + 2 * SHM_V;
    const int kb0 = blk_jlo(cur) * KVBLK;
    for (int d0 = 0; d0 < 8; ++d0) S.qr[d0] = load8(cur.Q + (size_t)(wid * QBLK + r32) * DH + d0 * 16 + hi * 8);
    SLOAD_H(cur.K, cur.V, kb0); VMW(); SWRITE_HK(0);
    __syncthreads();
}
__device__ __forceinline__ void block(const BlockRef& cur, const BlockRef& nxt, char* lds, Seam& S, int wave_s) {
    const int tid = opaque_tid(wave_s), wid = __builtin_amdgcn_readfirstlane(tid >> 6), lane = tid & 63, r32 = lane & 31, hi = lane >> 5;
    const int W = cur.W;
    const int j_lo = blk_jlo(cur);
    int j_hi = (cur.P0 + QB - 1) / KVBLK + 1; if (j_hi > cur.skv / KVBLK) j_hi = cur.skv / KVBLK;
    const int NT = j_hi - j_lo;
    const int kbn = blk_jlo(nxt) * KVBLK;
    const int qlo = cur.P0 + wid * QBLK, qm = qlo + r32 - 4 * hi;
    const int segb = qlo & ~cur.segmask;
    const int lowk_w = imax(qlo - W + 1, segb);
    const int lowk_last = imax(qlo + QBLK - W, segb);
    const int wrow = ((qlo + r32) & cur.segmask) + 1;
    const unsigned Wl = (unsigned)(wrow < W ? wrow : W);
    char* V_lds = lds; char* K_lds = lds + 2 * SHM_V;
    float* ws = (float*)(lds + 2 * SHM_V + 2 * SHM_K) + wid * 64; float* li_l = ws, * al_l = ws + 32;
    float m_reg = -1e30f, l_reg = 0; f32x16 o[4] = {};
    const int sr = tid >> 4, sc = (tid & 15) * 8, vst0 = v_st(sr, sc), vst1 = v_st(32 + sr, sc), kws = KSWZ(sr, sc * 2);
    const int vb0 = (int)(uintptr_t)V_lds + v_rd_base(lane);
    const bf16_t* Kh = cur.K; const bf16_t* Vh = cur.V;
#define RESC(a) do { if (__any((a) < 1.f)) { if (hi == 0) al_l[r32] = (a); asm volatile("s_waitcnt lgkmcnt(0)" ::: "memory");              \
                     for (int d_ = 0; d_ < 4; ++d_) for (int r = 0; r < 16; ++r) o[d_][r] *= al_l[crow(r, hi)]; } } while (0)
#define KBASE(t) ((j_lo + (t)) * KVBLK)
#define ACT(t) (KBASE(t) <= qlo + QBLK - 1 && KBASE(t) + KVBLK - 1 >= lowk_w)
#define MASKT(P0_, P1_, t) do { const int kb_ = KBASE(t); if (ACT(t) && (kb_ + KVBLK - 1 > qlo || kb_ < lowk_last)) mask_tile(P0_, P1_, qm - kb_, Wl); } while (0)
    constexpr int NQL = 8;
#define SEAM_K0() do { VMWN(NQL); SWRITE_HK(0); SBAR(); } while (0)
    f32x16 pA0, pA1, pB0, pB1; float mnA, mnB, alA, alB; bf16x8 pa0, pa1, pa2, pa3;
    SWRITE_HV(0); SBAR();
    if (NT > 1) { SLOAD_H(Kh, Vh, KBASE(1)); }
    SBAR(); qkt<0>(pA0, pA1, K_lds, r32, hi, S.qr, ACT(0));
    MASKT(pA0, pA1, 0); partialSM(pA0, pA1, m_reg, mnA, alA);
    if (NT > 1) { VMW(); SWRITE_H(1); }
    __syncthreads();
#define HALF_STEP(PX0, PX1, mnX, alX, PY0, PY1, alY, t, KB, VB, SB) do {                                                      \
        SBAR(); if ((t) + 1 < NT) { SLOAD_H(Kh, Vh, KBASE((t) + 1)); SBAR(); }                                       \
        qkt<KB>(PX0, PX1, K_lds, r32, hi, S.qr, ACT(t));                                             \
        finishSM(PY0, PY1, alY, l_reg, pa0, pa1, pa2, pa3); SBAR();                                                           \
        pv_tile<VB>(o, vb0, pa0, pa1, pa2, pa3, ACT((t) - 1)); MASKT(PX0, PX1, (t)); partialSM(PX0, PX1, m_reg, mnX, alX);                                        \
        __syncthreads();                                                                                                      \
        if ((t) + 1 < NT) { VMW(); SWRITE_H(SB); }                                                                          \
        RESC(alX); __syncthreads(); } while (0)
    for (int t = 1; t + 1 < NT; t += 2) {
        HALF_STEP(pB0, pB1, mnB, alB, pA0, pA1, alA, t, 1, 0, 0);
        HALF_STEP(pA0, pA1, mnA, alA, pB0, pB1, alB, t + 1, 0, 1, 1);
    }
    const bool even = (NT & 1) == 0;
    if (even) { SBAR(); qkt<1>(pB0, pB1, K_lds, r32, hi, S.qr, ACT(NT - 1)); SBAR(); }
    SLOAD_H(nxt.K, nxt.V, kbn); SBAR();
#pragma unroll
    for (int d0 = 0; d0 < 8; ++d0) S.qr[d0] = load8(nxt.Q + (size_t)(wid * QBLK + r32) * DH + d0 * 16 + hi * 8);
    SBAR();
    finishSM(pA0, pA1, alA, l_reg, pa0, pa1, pa2, pa3); SBAR();
    pv_tile<0>(o, vb0, pa0, pa1, pa2, pa3, ACT(even ? NT - 2 : NT - 1));
    if (even) { MASKT(pB0, pB1, NT - 1); partialSM(pB0, pB1, m_reg, mnB, alB); __syncthreads(); RESC(alB);
        finishSM(pB0, pB1, alB, l_reg, pa0, pa1, pa2, pa3); SBAR(); pv_tile<1>(o, vb0, pa0, pa1, pa2, pa3, ACT(NT - 1)); }
    SBAR(); SEAM_K0();
    if (hi == 0) li_l[r32] = l_reg; asm volatile("s_waitcnt lgkmcnt(0)" ::: "memory");
    if (cur.LSE != nullptr && hi == 0) cur.LSE[wid * QBLK + r32] = m_reg * SCALE + __logf(l_reg);
    float rli[16];
#pragma unroll
    for (int r = 0; r < 16; ++r) rli[r] = __builtin_amdgcn_rcpf(li_l[crow(r, hi)]);
    bf16_t* Ow = cur.O + (size_t)(wid * QBLK) * cur.ostride;
#pragma unroll
    for (int r = 0; r < 16; ++r) { const int orow = crow(r, hi);
#pragma unroll
        for (int d0 = 0; d0 < 4; ++d0) { const float v = o[d0][r] * rli[r];
            const float vn = __shfl_xor(v, 1);
            if ((r32 & 1) == 0) *(unsigned*)(Ow + (size_t)orow * cur.ostride + d0 * 32 + r32) = cvtpk(v, vn); } }
    __syncthreads();
#undef RESC
#undef KBASE
#undef ACT
#undef MASKT
#undef SEAM_K0
#undef HALF_STEP
}

constexpr int RING_V = 4 * SHM_K;
__device__ __forceinline__ void qkt_rt(f32x16& p0, f32x16& p1, const LAS char* Kslot, int r32, int hi, const bf16x8* qr) {
    p0 = f32x16{}; p1 = f32x16{};
    const LAS char* kb[4];
#pragma unroll
    for (int dd = 0; dd < 4; ++dd) kb[dd] = Kslot + KSWZ(r32, (dd * 16 + hi * 8) * 2);
#pragma unroll
    for (int d0 = 0; d0 < 8; ++d0) { const LAS char* a = kb[d0 & 3] + (d0 >> 2) * 128;
        bf16x8 b0 = *(const LAS bf16x8*)(a);
        bf16x8 b1 = *(const LAS bf16x8*)(a + 32 * 256);
        p0 = __builtin_amdgcn_mfma_f32_32x32x16_bf16(b0, qr[d0], p0, 0, 0, 0);
        p1 = __builtin_amdgcn_mfma_f32_32x32x16_bf16(b1, qr[d0], p1, 0, 0, 0); }
}
__device__ __forceinline__ void pv_rt(f32x16* o, int vb, bf16x8 pa0, bf16x8 pa1, bf16x8 pa2, bf16x8 pa3) {
#define TRRD(dst, off) asm volatile("ds_read_b64_tr_b16 %0, %1 offset:%2" : "=&v"(dst) : "v"(vb), "i"(off) : "memory")
#define PV_D0(d0) do { s16x4 l0, l1, l2, l3, h0, h1, h2, h3; constexpr int b_ = v_rd_off(d0, 0, 0); \
        TRRD(l0, b_); TRRD(h0, b_ + 2048); TRRD(l1, b_ + 4096); TRRD(h1, b_ + 6144); TRRD(l2, b_ + 8192); TRRD(h2, b_ + 10240); TRRD(l3, b_ + 12288); TRRD(h3, b_ + 14336); \
        asm volatile("s_waitcnt lgkmcnt(0)" ::: "memory"); SBAR();   \
        o[d0] = __builtin_amdgcn_mfma_f32_32x32x16_bf16((bf16x8){l0[0], l0[1], l0[2], l0[3], h0[0], h0[1], h0[2], h0[3]}, pa0, o[d0], 0, 0, 0);   \
        o[d0] = __builtin_amdgcn_mfma_f32_32x32x16_bf16((bf16x8){l1[0], l1[1], l1[2], l1[3], h1[0], h1[1], h1[2], h1[3]}, pa1, o[d0], 0, 0, 0);   \
        o[d0] = __builtin_amdgcn_mfma_f32_32x32x16_bf16((bf16x8){l2[0], l2[1], l2[2], l2[3], h2[0], h2[1], h2[2], h2[3]}, pa2, o[d0], 0, 0, 0);   \
        o[d0] = __builtin_amdgcn_mfma_f32_32x32x16_bf16((bf16x8){l3[0], l3[1], l3[2], l3[3], h3[0], h3[1], h3[2], h3[3]}, pa3, o[d0], 0, 0, 0); } while (0)
    PV_D0(0); PV_D0(1); PV_D0(2); PV_D0(3);
#undef PV_D0
#undef TRRD
}
struct WaveState { float m, l; f32x16 o[4]; };
__device__ __forceinline__ void tile_step(WaveState& st, const bf16x8* qr, const LAS char* lds, int slot, int r32, int hi, int lane, bool need_mask, int dq, unsigned Wl) {
    f32x16 p0, p1; float mn, alpha; bf16x8 pa0, pa1, pa2, pa3;
    qkt_rt(p0, p1, lds + slot * SHM_K, r32, hi, qr);
    if (need_mask) mask_tile(p0, p1, dq, Wl);
    partialSM(p0, p1, st.m, mn, alpha);
    if (__any(alpha < 1.f)) {
#pragma unroll
        for (int d_ = 0; d_ < 4; ++d_)
#pragma unroll
            for (int r = 0; r < 16; ++r) st.o[d_][r] *= alpha; }
    finishSM(p0, p1, alpha, st.l, pa0, pa1, pa2, pa3); SBAR();
    pv_rt(st.o, (int)(unsigned)(uintptr_t)(lds + RING_V + slot * SHM_V) + v_rd_base(lane), pa0, pa1, pa2, pa3);
}
__device__ __forceinline__ void wave_store(const WaveState& st, bf16_t* Ow, int ostride, float* lse, int r32, int hi) {
    if (lse != nullptr && hi == 0) lse[r32] = st.m * SCALE + __logf(st.l);
    const float rl = __builtin_amdgcn_rcpf(st.l);
    bf16_t* rowp = Ow + (size_t)r32 * ostride + hi * 8;
#pragma unroll
    for (int d0 = 0; d0 < 4; ++d0)
#pragma unroll
        for (int k = 0; k < 4; k += 2) {
            unsigned ax = cvtpk(st.o[d0][4 * k] * rl, st.o[d0][4 * k + 1] * rl), ay = cvtpk(st.o[d0][4 * k + 2] * rl, st.o[d0][4 * k + 3] * rl);
            unsigned bx = cvtpk(st.o[d0][4 * k + 4] * rl, st.o[d0][4 * k + 5] * rl), by = cvtpk(st.o[d0][4 * k + 6] * rl, st.o[d0][4 * k + 7] * rl);
            { auto r = __builtin_amdgcn_permlane32_swap(ax, bx, false, false); ax = r[0]; bx = r[1]; }
            { auto r = __builtin_amdgcn_permlane32_swap(ay, by, false, false); ay = r[0]; by = r[1]; }
            *(u32x4*)(rowp + d0 * 32 + 8 * k) = (u32x4){ax, ay, bx, by};
        }
}
__device__ __forceinline__ void wave_store8(const WaveState& st, unsigned char* Ow, int ostride, int r32, int hi, float* lse = nullptr) {
    if (lse != nullptr && hi == 0) lse[r32] = st.m * SCALE + __logf(st.l);
    const float rl = O8_SCALE * __builtin_amdgcn_rcpf(st.l);
    unsigned char* rowp = Ow + (size_t)r32 * ostride + hi * 8;
#pragma unroll
    for (int d0 = 0; d0 < 4; ++d0)
#pragma unroll
        for (int k = 0; k < 4; k += 2) {
            unsigned a = pk4_fp8(st.o[d0][4 * k] * rl, st.o[d0][4 * k + 1] * rl, st.o[d0][4 * k + 2] * rl, st.o[d0][4 * k + 3] * rl);
            unsigned b = pk4_fp8(st.o[d0][4 * k + 4] * rl, st.o[d0][4 * k + 5] * rl, st.o[d0][4 * k + 6] * rl, st.o[d0][4 * k + 7] * rl);
            { auto r = __builtin_amdgcn_permlane32_swap(a, b, false, false); a = r[0]; b = r[1]; }
            *(u32x2*)(rowp + d0 * 32 + 8 * k) = (u32x2){a, b};
        }
}
__device__ __forceinline__ void wave_reset(WaveState& st) { st.m = -1e30f; st.l = 0.f;
#pragma unroll
    for (int d = 0; d < 4; ++d) st.o[d] = f32x16{}; }
#define HS_LOADQ(qr, Qrow0) do { _Pragma("unroll") for (int d0 = 0; d0 < 8; ++d0) qr[d0] = load8((Qrow0) + (size_t)(wid * QBLK + r32) * DH + d0 * 16 + hi * 8); } while (0)
#define HS_SLOAD(Kp, Vp, k0) do { st_v0 = load8(ROW(Vp, k0, sr)); st_v1 = load8(ROW(Vp, k0, 32 + sr)); st_k0 = load8(ROW(Kp, k0, sr)); st_k1 = load8(ROW(Kp, k0, 32 + sr)); } while (0)
#define HS_SWRITE(slot) do { *(LAS bf16x8*)(lds + (slot) * SHM_K + kws) = st_k0; *(LAS bf16x8*)(lds + (slot) * SHM_K + kws + 32 * 256) = st_k1; \
                             *(LAS bf16x8*)(lds + RING_V + (slot) * SHM_V + vst0) = st_v0; *(LAS bf16x8*)(lds + RING_V + (slot) * SHM_V + vst1) = st_v1; } while (0)
__device__ __forceinline__ bf16x8 fp8x8_to_bf16(u32x2 w) {
    const auto a = __builtin_amdgcn_cvt_pk_f32_fp8(w.x, false), b = __builtin_amdgcn_cvt_pk_f32_fp8(w.x, true), c = __builtin_amdgcn_cvt_pk_f32_fp8(w.y, false), d = __builtin_amdgcn_cvt_pk_f32_fp8(w.y, true);
    u32x4 o = {pk2(a[0], a[1]), pk2(b[0], b[1]), pk2(c[0], c[1]), pk2(d[0], d[1])}; return *reinterpret_cast<bf16x8*>(&o);
}
#define ROW8(p, k0, rr) ((const unsigned char*)(p) + (size_t)((k0) + (rr)) * (DH * 2) + sc)
#define HS_LOADQ8(Qrow0) do { _Pragma("unroll") for (int d0 = 0; d0 < 8; ++d0) qraw[d0] = *(const u32x2*)((const unsigned char*)(Qrow0) + (size_t)(wid * QBLK + r32) * (DH * 2) + d0 * 16 + hi * 8); } while (0)
#define HS_CVTQ() do { _Pragma("unroll") for (int d0 = 0; d0 < 8; ++d0) qr[d0] = fp8x8_to_bf16(qraw[d0]); } while (0)
#define HS_SLOAD8(Kp, Vp, k0) do { s8_v0 = *(const u32x2*)ROW8(Vp, k0, sr); s8_v1 = *(const u32x2*)ROW8(Vp, k0, 32 + sr); s8_k0 = *(const u32x2*)ROW8(Kp, k0, sr); s8_k1 = *(const u32x2*)ROW8(Kp, k0, 32 + sr); } while (0)
#define HS_SWRITE8(slot) do { *(LAS bf16x8*)(lds + (slot) * SHM_K + kws) = fp8x8_to_bf16(s8_k0); *(LAS bf16x8*)(lds + (slot) * SHM_K + kws + 32 * 256) = fp8x8_to_bf16(s8_k1); \
                              *(LAS bf16x8*)(lds + RING_V + (slot) * SHM_V + vst0) = fp8x8_to_bf16(s8_v0); *(LAS bf16x8*)(lds + RING_V + (slot) * SHM_V + vst1) = fp8x8_to_bf16(s8_v1); } while (0)
__device__ __forceinline__ void head_dilated(const bf16_t* Q, bf16_t* O, const bf16_t* K, const bf16_t* V, float* LSE, int segmask, LAS char* lds, LAS float* scr, int wave_s) {
    const int tid = opaque_tid(wave_s), wid = __builtin_amdgcn_readfirstlane(tid >> 6), lane = tid & 63, r32 = lane & 31, hi = lane >> 5, pair = wid >> 1;
    const int sr = tid >> 4, sc = (tid & 15) * 8, vst0 = v_st(sr, sc), vst1 = v_st(32 + sr, sc), kws = KSWZ(sr, sc * 2);
    constexpr int NT = 2048 / KVBLK, W = 129;
#if QKV_FP8
    u32x2 s8_v0, s8_v1, s8_k0, s8_k1, qraw[8]; bf16x8 qr[8]; WaveState st; wave_reset(st);
    HS_SLOAD8(K, V, 0); HS_LOADQ8(Q); VMW(); HS_SWRITE8(0); HS_CVTQ(); SBAR();
    HS_SLOAD8(K, V, KVBLK); VMW(); HS_SWRITE8(1);
#else
    bf16x8 st_v0, st_v1, st_k0, st_k1; bf16x8 qr[8]; WaveState st; wave_reset(st);
    HS_SLOAD(K, V, 0); HS_LOADQ(qr, Q); VMW(); HS_SWRITE(0); SBAR();
    HS_SLOAD(K, V, KVBLK); VMW(); HS_SWRITE(1);
#endif
    __syncthreads();
#if QKV_FP8
#pragma unroll 4
#endif
    for (int g = 1; g <= NT; ++g) {
        const bool ld = g + 1 < NT;
#if QKV_FP8
        if (ld) { HS_SLOAD8(K, V, (g + 1) * KVBLK); SBAR(); }
#else
        if (ld) { HS_SLOAD(K, V, (g + 1) * KVBLK); SBAR(); }
#endif
        const int ph = (g - 1) & 3, qb = (g - 1) >> 2;
#if QKV_FP8
        if (ph == 0 && g > 1) HS_CVTQ();
#endif
        if (ph != 3) {
            const int T = g - 3 + pair, qlo = qb * QB + wid * QBLK, segb = qlo & ~segmask;
            const int lowk_w = imax(qlo - W + 1, segb), lowk_last = imax(qlo + QBLK - W, segb), kb_ = T * KVBLK;
            if (T >= 0 && kb_ <= qlo + QBLK - 1 && kb_ + KVBLK - 1 >= lowk_w) {
                const int wrow = ((qlo + r32) & segmask) + 1;
                tile_step(st, qr, lds, T & 3, r32, hi, lane, (kb_ + KVBLK - 1 > qlo) || (kb_ < lowk_last), qlo + r32 - 4 * hi - kb_, (unsigned)(wrow < W ? wrow : W));
            }
#if QKV_FP8
            if (ph == 2 && qb + 1 < 2048 / QB) { SBAR(); HS_LOADQ8(Q + (size_t)(qb + 1) * QB * DH); }
#else
            if (ph == 2 && qb + 1 < 2048 / QB) { SBAR(); HS_LOADQ(qr, Q + (size_t)(qb + 1) * QB * DH); }
#endif
        } else {
#if O_FP8 && P4_FP8
            wave_store8(st, (unsigned char*)(O + (size_t)(qb * QB + wid * QBLK) * DH), 2 * DH, r32, hi, LSE + qb * QB + wid * QBLK);
#else
            wave_store(st, O + (size_t)(qb * QB + wid * QBLK) * DH, DH, LSE + qb * QB + wid * QBLK, r32, hi);
#endif
            wave_reset(st);
        }
        __syncthreads();
#if QKV_FP8
        if (ld) { HS_SWRITE8((g + 1) & 3); }
#else
        if (ld) { HS_SWRITE((g + 1) & 3); }
#endif
        __syncthreads();
    }
}
__device__ __forceinline__ void head_mem(const bf16_t* Q, const bf16_t* K, const bf16_t* V, bf16_t* O, int ostride, LAS char* lds, LAS float* scr, int wave_s) {
    const int tid = opaque_tid(wave_s), wid = __builtin_amdgcn_readfirstlane(tid >> 6), lane = tid & 63, r32 = lane & 31, hi = lane >> 5, pair = wid >> 1;
    const int sr = tid >> 4, sc = (tid & 15) * 8, vst0 = v_st(sr, sc), vst1 = v_st(32 + sr, sc), kws = KSWZ(sr, sc * 2);
    bf16x8 st_v0, st_v1, st_k0, st_k1; bf16x8 qr[8]; WaveState st;
#pragma unroll
    for (int t = 0; t < 4; ++t) { HS_SLOAD(K, V, t * KVBLK); VMW(); HS_SWRITE(t); SBAR(); }
    __syncthreads();
    for (int qb = 0; qb < 2048 / QB; ++qb) {
#if CQ_FP8
        { u32x2 qraw[8]; HS_LOADQ8(Q + (size_t)qb * QB * DH); HS_CVTQ(); } wave_reset(st);
#else
        HS_LOADQ(qr, Q + (size_t)qb * QB * DH); wave_reset(st);
#endif
        for (int t = 0; t < 4; ++t) tile_step(st, qr, lds, (t + pair) & 3, r32, hi, lane, false, 0, 0u);
#if P4_FP8
        wave_store8(st, (unsigned char*)O + (size_t)(qb * QB + wid * QBLK) * ostride, ostride, r32, hi);
#else
        wave_store(st, O + (size_t)(qb * QB + wid * QBLK) * ostride, ostride, nullptr, r32, hi);
#endif
    }
    __syncthreads();
}
#undef HS_LOADQ
#undef HS_LOADQ8
#undef HS_CVTQ
#undef HS_SLOAD8
#undef HS_SWRITE8
#undef ROW8
#undef HS_SLOAD
#undef HS_SWRITE
#undef ROW
#undef VMW
#undef VMWN
#undef SLOAD_H
#undef SWRITE_HK
#undef SWRITE_HV
#undef SWRITE_H
#undef KSWZ
#undef SBAR
}

#define XB_TMO      128
#define XB_XCNT(j)  (256  + 64 * (j))
#define XB_XSUB(j)  (1280 + 64 * (j))
#define XB_XGEN(j)  (2304 + 64 * (j))
#define XB_TOP      3328
#define XB_TOPGEN   3392
#define XCD_BAR_WORDS 3456
#define XB_SPIN_CAP (1u << 18)
__device__ __forceinline__ unsigned xb_ld(unsigned* p)              { return __hip_atomic_load(p, __ATOMIC_RELAXED, __HIP_MEMORY_SCOPE_AGENT); }
__device__ __forceinline__ unsigned xb_add(unsigned* p, unsigned v) { return __hip_atomic_fetch_add(p, v, __ATOMIC_RELAXED, __HIP_MEMORY_SCOPE_AGENT); }
__device__ __forceinline__ unsigned xb_xcc_id() { return (unsigned)__builtin_amdgcn_s_getreg((3 << 11) | 20) & 0xFu; }
#define XB_SPIN(cond, bar) do { unsigned _sp = 0; while (cond) { __builtin_amdgcn_s_sleep(1); \
    if ((++_sp & 255u) == 0u) { if (xb_ld(&(bar)[XB_TMO])) break; if (_sp > XB_SPIN_CAP) { atomicAdd(&(bar)[XB_TMO], 1u); break; } } } } while (0)
struct XcdBarrier { unsigned* bar; unsigned x; volatile LAS unsigned* st; };
__device__ __forceinline__ XcdBarrier xcd_barrier_post(unsigned* bar, volatile LAS unsigned* st) {
    XcdBarrier b; b.bar = bar; b.x = xb_xcc_id(); b.st = st;
    if (threadIdx.x == 0) (void)xb_add(&bar[XB_XCNT(b.x)], 1u);
    return b;
}
__device__ __forceinline__ void xcd_barrier_complete(unsigned* bar, unsigned x, unsigned& nloc, unsigned& nx) {
    const unsigned G = gridDim.x * gridDim.y * gridDim.z;
    unsigned sum, cnt, mine, sp = 0u;
    for (;;) {
        sum = 0u; cnt = 0u; mine = 0u;
#pragma unroll
        for (unsigned j = 0; j < 16; ++j) { const unsigned c = xb_ld(&bar[XB_XCNT(j)]); sum += c; cnt += (c > 0u) ? 1u : 0u; mine = (j == x) ? c : mine; }
        if (sum == G) break;
        __builtin_amdgcn_s_sleep(1);
        if ((++sp & 255u) == 0u) { if (xb_ld(&bar[XB_TMO])) break; if (sp > XB_SPIN_CAP) { atomicAdd(&bar[XB_TMO], 1u); break; } }
    }
    nloc = mine > 0u ? mine : 1u; nx = cnt > 0u ? cnt : 1u;
}
__device__ __forceinline__ void xcd_barrier(const XcdBarrier& b) {
    asm volatile("s_waitcnt vmcnt(0)" ::: "memory");
    __syncthreads();
    if (threadIdx.x == 0) {
        unsigned* bar = b.bar; asm volatile("" : "+s"(bar)); bar = (unsigned*)(GAS unsigned*)bar;
        __builtin_amdgcn_s_waitcnt(0);
        unsigned nloc = b.st[0], nx = b.st[1];
        if (nloc == 0u) { xcd_barrier_complete(bar, b.x, nloc, nx); b.st[0] = nloc; b.st[1] = nx; }
        const unsigned old = xb_add(&bar[XB_XSUB(b.x)], 1u);
        const unsigned gen = old / nloc;
        if (old + 1u == (gen + 1u) * nloc) {
            __builtin_amdgcn_fence(__ATOMIC_RELEASE, "agent");
            asm volatile("s_waitcnt vmcnt(0)" ::: "memory");
            const unsigned og = xb_add(&bar[XB_TOP], 1u);
            const unsigned tg = og / nx;
            if (og + 1u == (tg + 1u) * nx) xb_add(&bar[XB_TOPGEN], 1u);
            else XB_SPIN(xb_ld(&bar[XB_TOPGEN]) == tg, bar);
            __builtin_amdgcn_fence(__ATOMIC_ACQUIRE, "agent");
            xb_add(&bar[XB_XGEN(b.x)], 1u);
            asm volatile("s_waitcnt vmcnt(0)" ::: "memory");
        } else {
            XB_SPIN(xb_ld(&bar[XB_XGEN(b.x)]) == gen, bar);
            __builtin_amdgcn_fence(__ATOMIC_ACQUIRE, "agent");
            asm volatile("s_waitcnt vmcnt(0)" ::: "memory");
        }
    }
    __syncthreads();
}
constexpr int CW_BAR = 4096, CW_CONVQ = 96;

#define ACC8(ai, bj, m) {acc[ai][bj][m][0][0], acc[ai][bj][m][0][1], acc[ai][bj][m][0][2], acc[ai][bj][m][0][3], acc[ai][bj][m][1][0], acc[ai][bj][m][1][1], acc[ai][bj][m][1][2], acc[ai][bj][m][1][3]}
struct FastEpiMain {
    static constexpr bool PERM = true, KEEPS = false; EpiMain mn; EpiKV kv; float ascale;
    __device__ __forceinline__ bool keep_acc(const pg8::Unit&) const { return false; }
    __device__ __forceinline__ void operator()(f32x4 (&acc)[2][2][4][2], const pg8::Unit& u, int wr, int wc, int fr, int fq) const {
        asm volatile("" : "+v"(fr), "+v"(fq));
        const int rowb = u.row0 + wr * 64 + fr, colb = u.col0 + wc * 32 + 8 * fq;
        if (u.aux != 0) {
#pragma unroll
            for (int ai = 0; ai < 2; ++ai)
#pragma unroll
                for (int m = 0; m < 4; ++m)
#pragma unroll
                    for (int bj = 0; bj < 2; ++bj) { float v[8] = ACC8(ai, bj, m); kv(rowb + ai * 128 + m * 16, colb + bj * 128, v); }
            return;
        }
        f32x4 bb[2][2];
#pragma unroll
        for (int bj = 0; bj < 2; ++bj) { bb[bj][0] = *(const f32x4*)(mn.biasp + colb + bj * 128); bb[bj][1] = *(const f32x4*)(mn.biasp + colb + bj * 128 + 4); }
        float fpos[2][4];
#pragma unroll
        for (int ai = 0; ai < 2; ++ai)
#pragma unroll
            for (int m = 0; m < 4; ++m) fpos[ai][m] = 0.f;
        if (u.col0 < C_V) {
#pragma unroll
            for (int ai = 0; ai < 2; ++ai)
#pragma unroll
                for (int m = 0; m < 4; ++m) fpos[ai][m] = (float)mn.pos[mn.tok0 + rowb + ai * 128 + m * 16];
        }
        if (u.col0 >= C_GATE) {
            typedef float v2f_t __attribute__((ext_vector_type(2)));
            const float s2 = -1.4426950408889634f * ascale; v2f_t bp[2][4];
#pragma unroll
            for (int bj = 0; bj < 2; ++bj) { bp[bj][0] = (v2f_t){bb[bj][0].x, bb[bj][0].y} * -1.4426950408889634f; bp[bj][1] = (v2f_t){bb[bj][0].z, bb[bj][0].w} * -1.4426950408889634f;
                bp[bj][2] = (v2f_t){bb[bj][1].x, bb[bj][1].y} * -1.4426950408889634f; bp[bj][3] = (v2f_t){bb[bj][1].z, bb[bj][1].w} * -1.4426950408889634f; }
            unsigned char* gp = (unsigned char*)mn.GATES + (size_t)rowb * 3072 + (colb - C_GATE);
#pragma unroll
            for (int ai = 0; ai < 2; ++ai)
#pragma unroll
                for (int m = 0; m < 4; ++m)
#pragma unroll
                    for (int bj = 0; bj < 2; ++bj) { const f32x4 a0 = acc[ai][bj][m][0], a1 = acc[ai][bj][m][1];
                        const v2f_t t[4] = {__builtin_elementwise_fma((v2f_t){a0.x, a0.y}, (v2f_t){s2, s2}, bp[bj][0]), __builtin_elementwise_fma((v2f_t){a0.z, a0.w}, (v2f_t){s2, s2}, bp[bj][1]),
                                            __builtin_elementwise_fma((v2f_t){a1.x, a1.y}, (v2f_t){s2, s2}, bp[bj][2]), __builtin_elementwise_fma((v2f_t){a1.z, a1.w}, (v2f_t){s2, s2}, bp[bj][3])};
                        unsigned w[2] = {0u, 0u};
#pragma unroll
                        for (int q = 0; q < 4; ++q) { v2f_t r;
#pragma unroll
                            for (int e = 0; e < 2; ++e) r[e] = __builtin_amdgcn_rcpf(__builtin_amdgcn_fmed3f(__builtin_fmaf(__builtin_amdgcn_exp2f(t[q][e]), 1.0f / 255.0f, 1.0f / 255.0f), 0.0f, 1.0f));
                            r = r + (v2f_t){0.5f, 0.5f};
                            w[q >> 1] = __builtin_amdgcn_cvt_pk_u8_f32(r[0], 2 * (q & 1), w[q >> 1]); w[q >> 1] = __builtin_amdgcn_cvt_pk_u8_f32(r[1], 2 * (q & 1) + 1, w[q >> 1]); }
                        *(u32x2*)(gp + (size_t)(ai * 128 + m * 16) * 3072 + bj * 128) = (u32x2){w[0], w[1]}; }
            return;
        }
        float invrev[4]; EpiMain::rope_freqs(colb, invrev);
#define FEM_LOOP(S_) do { _Pragma("unroll") for (int ai = 0; ai < 2; ++ai) _Pragma("unroll") for (int m = 0; m < 4; ++m) _Pragma("unroll") for (int bj = 0; bj < 2; ++bj) { float v[8] = ACC8(ai, bj, m); \
            _Pragma("unroll") for (int q = 0; q < 8; ++q) v[q] *= ascale; \
            v[0] += bb[bj][0].x; v[1] += bb[bj][0].y; v[2] += bb[bj][0].z; v[3] += bb[bj][0].w; v[4] += bb[bj][1].x; v[5] += bb[bj][1].y; v[6] += bb[bj][1].z; v[7] += bb[bj][1].w; \
            mn.template finish_s<S_>(rowb + ai * 128 + m * 16, colb + bj * 128, v, fpos[ai][m], invrev); } } while (0)
        if (u.col0 < C_GLU) {
            typedef float v2f_t __attribute__((ext_vector_type(2)));
            const int sec = u.col0 / 1536, r0 = colb - sec * 1536, gh0 = (u.col0 - sec * 1536) >> 7, pcol = r0 & 127, g = gh0 >> 2, sh = 2 * g;
            const int bl = rowb >> 11, s0 = rowb & 2047;
            bf16_t* p0 = mn.QG + (size_t)sec * (SZ_QKV1 / 2) + ((size_t)(bl * 12 + gh0) * 2048 + rowperm(g, s0)) * 128 + pcol;
            asm volatile("" : "+v"(invrev[0]), "+v"(invrev[1]), "+v"(invrev[2]), "+v"(invrev[3]));
#define FEM_QKV(ROT) do { _Pragma("unroll") for (int ai = 0; ai < 2; ++ai) _Pragma("unroll") for (int m = 0; m < 4; ++m) { \
                v2f_t C_[2], S_[2]; \
                if (ROT) { float c4[4], s4[4]; _Pragma("unroll") for (int e = 0; e < 4; ++e) { const float rev = __builtin_amdgcn_fractf(fpos[ai][m] * invrev[e]); s4[e] = __builtin_amdgcn_sinf(rev); c4[e] = __builtin_amdgcn_cosf(rev); } \
                    C_[0] = (v2f_t){c4[0], c4[1]}; C_[1] = (v2f_t){c4[2], c4[3]}; S_[0] = (v2f_t){s4[0], s4[1]}; S_[1] = (v2f_t){s4[2], s4[3]}; } \
                bf16_t* pr = p0 + (size_t)((16 * m + 128 * ai) >> sh) * 128; \
                _Pragma("unroll") for (int bj = 0; bj < 2; ++bj) { const f32x4 a0 = acc[ai][bj][m][0], a1 = acc[ai][bj][m][1]; const v2f_t as2 = {ascale, ascale}; \
                    v2f_t X[2] = {__builtin_elementwise_fma((v2f_t){a0.x, a0.y}, as2, (v2f_t){bb[bj][0].x, bb[bj][0].y}), __builtin_elementwise_fma((v2f_t){a0.z, a0.w}, as2, (v2f_t){bb[bj][0].z, bb[bj][0].w})}; \
                    v2f_t Y[2] = {__builtin_elementwise_fma((v2f_t){a1.x, a1.y}, as2, (v2f_t){bb[bj][1].x, bb[bj][1].y}), __builtin_elementwise_fma((v2f_t){a1.z, a1.w}, as2, (v2f_t){bb[bj][1].z, bb[bj][1].w})}; \
                    if (ROT) { _Pragma("unroll") for (int h = 0; h < 2; ++h) { const v2f_t x_ = X[h], y_ = Y[h]; X[h] = __builtin_elementwise_fma(-y_, S_[h], x_ * C_[h]); Y[h] = __builtin_elementwise_fma(x_, S_[h], y_ * C_[h]); } } \
                    if (QKV_FP8) { u32x2 o8; o8.x = pk4_fp8(X[0].x, X[0].y, X[1].x, X[1].y); o8.y = pk4_fp8(Y[0].x, Y[0].y, Y[1].x, Y[1].y); \
                        *(u32x2*)((unsigned char*)(pr - pcol) + pcol + (size_t)bj * (2048 * 256)) = o8; }     \
                    else { u32x4 o; o.x = pk2(X[0].x, X[0].y); o.y = pk2(X[1].x, X[1].y); o.z = pk2(Y[0].x, Y[0].y); o.w = pk2(Y[1].x, Y[1].y); \
                        *(u32x4*)(pr + (size_t)bj * (2048 * 128)) = o; } } } } while (0)
            if (u.col0 < C_V) FEM_QKV(true); else FEM_QKV(false);
#undef FEM_QKV
            return;
        }
        if (u.col0 < C_QM) FEM_LOOP(2); else FEM_LOOP(3);
#undef FEM_LOOP
    }
};
struct FastEpiGates {
    static constexpr bool PERM = true, KEEPS = false; const float* biasp; bf16_t* GATES; float ascale;
    __device__ __forceinline__ bool keep_acc(const pg8::Unit&) const { return false; }
    __device__ __forceinline__ void operator()(f32x4 (&acc)[2][2][4][2], const pg8::Unit& u, int wr, int wc, int fr, int fq) const {
        asm volatile("" : "+v"(fr), "+v"(fq));
        const int rowb = u.row0 + wr * 64 + fr, colb = u.col0 + wc * 32 + 8 * fq;
        f32x4 bb[2][2];
#pragma unroll
        for (int bj = 0; bj < 2; ++bj) { bb[bj][0] = *(const f32x4*)(biasp + colb + bj * 128); bb[bj][1] = *(const f32x4*)(biasp + colb + bj * 128 + 4); }
#pragma unroll
        for (int ai = 0; ai < 2; ++ai)
#pragma unroll
            for (int m = 0; m < 4; ++m)
#pragma unroll
                for (int bj = 0; bj < 2; ++bj) { const f32x4 a = acc[ai][bj][m][0] * ascale + bb[bj][0], b = acc[ai][bj][m][1] * ascale + bb[bj][1];
                    u32x4 o; o.x = pk2(sigmoidf_(a.x), sigmoidf_(a.y)); o.y = pk2(sigmoidf_(a.z), sigmoidf_(a.w)); o.z = pk2(sigmoidf_(b.x), sigmoidf_(b.y)); o.w = pk2(sigmoidf_(b.z), sigmoidf_(b.w));
                    *(u32x4*)(GATES + (size_t)(rowb + ai * 128 + m * 16) * 3072 + (colb + bj * 128 - C_GATE)) = o; }
    }
};
constexpr float P4_ASCALE = P4_FP8 ? 1.0f / (O8_SCALE * W8_SCALE) : 1.0f;
struct FastEpiMerge {
    static constexpr bool PERM = true, KEEPS = true; const bf16_t* GATES; bf16_t* MERGED;
    __device__ __forceinline__ bool keep_acc(const pg8::Unit& u) const { return u.aux < 2; }
    __device__ __forceinline__ void operator()(f32x4 (&acc)[2][2][4][2], const pg8::Unit& u, int wr, int wc, int fr, int fq) const {
        asm volatile("" : "+v"(fr), "+v"(fq));
        const int rowb = u.row0 + wr * 64 + fr, colb = u.col0 + wc * 32 + 8 * fq, br = u.aux;
        const unsigned char* gp = (const unsigned char*)GATES + (size_t)rowb * 3072 + br * 1024 + colb;
        bf16_t* mp = MERGED + (size_t)rowb * 1024 + colb;
#pragma unroll
        for (int ai = 0; ai < 2; ++ai) {
            u32x2 tg[4][2], tn[4][2];
#pragma unroll
            for (int m = 0; m < 4; ++m)
#pragma unroll
                for (int bj = 0; bj < 2; ++bj) { tg[m][bj] = *(const u32x2*)(gp + (size_t)(ai * 128 + m * 16) * 3072 + bj * 128);
                    if (br < 2) tn[m][bj] = *(const u32x2*)(gp + 1024 + (size_t)(ai * 128 + m * 16) * 3072 + bj * 128); }
            if (br < 2) {
#pragma unroll
                for (int m = 0; m < 4; ++m)
#pragma unroll
                    for (int bj = 0; bj < 2; ++bj) { const u32x2 g = tg[m][bj], n = tn[m][bj]; const f32x4 n0 = u8x4_raw(n.x), n1 = u8x4_raw(n.y);
                        const f32x4 r0 = {__builtin_amdgcn_rcpf(n0.x), __builtin_amdgcn_rcpf(n0.y), __builtin_amdgcn_rcpf(n0.z), __builtin_amdgcn_rcpf(n0.w)}, r1 = {__builtin_amdgcn_rcpf(n1.x), __builtin_amdgcn_rcpf(n1.y), __builtin_amdgcn_rcpf(n1.z), __builtin_amdgcn_rcpf(n1.w)};
                        acc[ai][bj][m][0] = acc[ai][bj][m][0] * (u8x4_raw(g.x) * r0); acc[ai][bj][m][1] = acc[ai][bj][m][1] * (u8x4_raw(g.y) * r1); }
            } else {
#pragma unroll
                for (int m = 0; m < 4; ++m)
#pragma unroll
                    for (int bj = 0; bj < 2; ++bj) { const u32x2 g = tg[m][bj];
#if P5_FP8
                        const f32x4 a = acc[ai][bj][m][0] * (u8x4_raw(g.x) * (P4_ASCALE * M8_SCALE / 255.0f)), b = acc[ai][bj][m][1] * (u8x4_raw(g.y) * (P4_ASCALE * M8_SCALE / 255.0f));
                        u32x2 o; o.x = pk4_fp8(a.x, a.y, a.z, a.w); o.y = pk4_fp8(b.x, b.y, b.z, b.w);
                        *(u32x2*)((unsigned char*)MERGED + (size_t)(rowb + ai * 128 + m * 16) * 1024 + colb + bj * 128) = o;
#else
                        const f32x4 a = acc[ai][bj][m][0] * (u8x4_raw(g.x) * (P4_ASCALE / 255.0f)), b = acc[ai][bj][m][1] * (u8x4_raw(g.y) * (P4_ASCALE / 255.0f));
                        u32x4 o; o.x = pk2(a.x, a.y); o.y = pk2(a.z, a.w); o.z = pk2(b.x, b.y); o.w = pk2(b.z, b.w);
                        *(u32x4*)(mp + (size_t)(ai * 128 + m * 16) * 1024 + bj * 128) = o;
#endif
                    }
            }
            asm volatile("" ::: "memory");
        }
    }
};
struct FastEpiStore8 {
    static constexpr bool PERM = true, KEEPS = false; unsigned char* O; int ld; float scale;
    __device__ __forceinline__ bool keep_acc(const pg8::Unit&) const { return false; }
    __device__ __forceinline__ void operator()(f32x4 (&acc)[2][2][4][2], const pg8::Unit& u, int wr, int wc, int fr, int fq) const {
        asm volatile("" : "+v"(fr), "+v"(fq));
        const int rowb = u.row0 + wr * 64 + fr, colb = u.col0 + wc * 32 + 8 * fq;
#pragma unroll
        for (int ai = 0; ai < 2; ++ai)
#pragma unroll
            for (int m = 0; m < 4; ++m)
#pragma unroll
                for (int bj = 0; bj < 2; ++bj) { const f32x4 a = acc[ai][bj][m][0] * scale, b = acc[ai][bj][m][1] * scale;
                    u32x2 o; o.x = pk4_fp8s(a.x, a.y, a.z, a.w); o.y = pk4_fp8s(b.x, b.y, b.z, b.w);
                    *(u32x2*)(O + (size_t)(rowb + ai * 128 + m * 16) * ld + colb + bj * 128) = o; }
    }
};
struct FastEpiStore {
    static constexpr bool PERM = true, KEEPS = false; bf16_t* O; int ld; float scale;
    __device__ __forceinline__ bool keep_acc(const pg8::Unit&) const { return false; }
    __device__ __forceinline__ void operator()(f32x4 (&acc)[2][2][4][2], const pg8::Unit& u, int wr, int wc, int fr, int fq) const {
        asm volatile("" : "+v"(fr), "+v"(fq));
        const int rowb = u.row0 + wr * 64 + fr, colb = u.col0 + wc * 32 + 8 * fq;
#pragma unroll
        for (int ai = 0; ai < 2; ++ai)
#pragma unroll
            for (int m = 0; m < 4; ++m)
#pragma unroll
                for (int bj = 0; bj < 2; ++bj) { const f32x4 a = acc[ai][bj][m][0] * scale, b = acc[ai][bj][m][1] * scale;
                    u32x4 o; o.x = pk2(a.x, a.y); o.y = pk2(a.z, a.w); o.z = pk2(b.x, b.y); o.w = pk2(b.z, b.w);
                    *(u32x4*)(O + (size_t)(rowb + ai * 128 + m * 16) * ld + colb + bj * 128) = o; }
    }
};
struct FastEpiNull {
    static constexpr bool PERM = true, KEEPS = false; bf16_t* O;
    __device__ __forceinline__ bool keep_acc(const pg8::Unit&) const { return false; }
    __device__ __forceinline__ void operator()(f32x4 (&acc)[2][2][4][2], const pg8::Unit& u, int wr, int wc, int fr, int fq) const {
        float s = 0.f;
#pragma unroll
        for (int ai = 0; ai < 2; ++ai)
#pragma unroll
            for (int m = 0; m < 4; ++m)
#pragma unroll
                for (int bj = 0; bj < 2; ++bj) { const f32x4 a = acc[ai][bj][m][0], b = acc[ai][bj][m][1]; s += a.x + a.y + a.z + a.w + b.x + b.y + b.z + b.w; }
        if (s == 1.2345e38f) O[u.row0 + fr] = (bf16_t)1;
    }
};
struct FastEpiMoe1 {
    static constexpr bool PERM = true, KEEPS = false; LAS const int* toktab; const float* wts; unsigned char* H8;
    __device__ __forceinline__ bool keep_acc(const pg8::Unit&) const { return false; }
    __device__ __forceinline__ void operator()(f32x4 (&acc)[2][2][4][2], const pg8::Unit& u, int wr, int wc, int fr, int fq) const {
        asm volatile("" : "+v"(fr), "+v"(fq));
        const int rloc = wr * 64 + fr, colb = u.col0 + wc * 32 + 8 * fq, hi = u.col0 >> 10;
        float w[2][4];
#pragma unroll
        for (int ai = 0; ai < 2; ++ai)
#pragma unroll
            for (int m = 0; m < 4; ++m) { const int tok = toktab[u.aux * 256 + rloc + ai * 128 + m * 16]; w[ai][m] = wts[(size_t)tok * 2 + hi] * (H8_SCALE / W8_SCALE); }
        constexpr float inv = 1.0f / W8_SCALE;
#pragma unroll
        for (int ai = 0; ai < 2; ++ai)
#pragma unroll
            for (int m = 0; m < 4; ++m)
#pragma unroll
                for (int bj = 0; bj < 2; ++bj) { const f32x4 gt = acc[ai][bj][m][0] * inv, up = acc[ai][bj][m][1]; const float ww = w[ai][m];
                    const int j0 = hi * 512 + (((colb + bj * 128) & 1023) >> 1);
                    float h[4] = {gt.x * sigmoidf_(gt.x) * up.x * ww, gt.y * sigmoidf_(gt.y) * up.y * ww, gt.z * sigmoidf_(gt.z) * up.z * ww, gt.w * sigmoidf_(gt.w) * up.w * ww};
#pragma unroll
                    for (int q = 0; q < 4; ++q) h[q] = fminf(fmaxf(h[q], -448.f), 448.f);
                    *(unsigned*)(H8 + (size_t)(u.row0 + rloc + ai * 128 + m * 16) * 1024 + j0) = pk4_fp8(h[0], h[1], h[2], h[3]); }
    }
};
#undef ACC8

struct SchedMain {
    pg8::TileOrder to; int nkv, tile0, cut, skip; size_t astep, bstep; const char *XB, *WIN, *MEMB, *WKV;
    __device__ __forceinline__ bool next(int i, pg8::Unit& u) const {
        int pm, pn;
        if (to.tile(i, pm, pn)) { const int ct = tile0 + (pn < cut ? pn : pn + skip); u.A = XB + (size_t)pm * astep; u.B = WIN + (size_t)ct * bstep; u.row0 = pm * 256; u.col0 = ct * 256; u.bjump = 0; u.aux = 0; return true; }
        const long L = (long)i * to.G + to.c - to.nwg; if (L >= nkv) return false;
        pm = (int)(L >> 2); pn = (int)(L & 3);
        u.A = MEMB + (size_t)pm * 256 * 2048; u.B = WKV + (size_t)pn * 256 * 2048; u.row0 = pm * 256; u.col0 = pn * 256; u.bjump = 0; u.aux = 1; return true;
    }
};
struct SchedMerge {
    pg8::TileOrder to; const char *A0, *W;
    __device__ __forceinline__ bool next(int i, pg8::Unit& u) const {
        const int ti = i / 3, br = i - ti * 3; int pm, pn; if (!to.tile(ti, pm, pn)) return false;
        u.A = A0 + (size_t)br * SZ_512 + (size_t)pm * 256 * (P4_FP8 ? 512 : 1024); u.B = W + (size_t)br * MiB + (size_t)pn * 256 * (P4_FP8 ? 512 : 1024); u.row0 = pm * 256; u.col0 = pn * 256; u.bjump = 0; u.aux = br; return true;
    }
};
struct SchedPlain {
    pg8::TileOrder to; const char *A, *B; size_t astep, bstep;
    __device__ __forceinline__ bool next(int i, pg8::Unit& u) const {
        int pm, pn; if (!to.tile(i, pm, pn)) return false;
        u.A = A + (size_t)pm * astep; u.B = B + (size_t)pn * bstep; u.row0 = pm * 256; u.col0 = pn * 256; u.bjump = 0; u.aux = 0; return true;
    }
};
struct SchedMoe {
    pg8::TileOrder to; LAS const int* pan_cls; LAS const int* toktab; const char *H, *W1, *W2; int mode;
    __device__ __forceinline__ LAS const int* toks(int i) const { return toktab + i * 256; }
    __device__ __forceinline__ bool next(int i, pg8::Unit& u) const {
        int pm, pn; if (!to.tile(i, pm, pn)) return false;
        const int cls = pan_cls[pm]; int e_lo, e_hi; class_experts(cls, e_lo, e_hi);
        u.row0 = pm * 256; u.col0 = pn * 256; u.aux = i; u.bjump = 0;
        if (mode == 1) { u.A = nullptr; u.B = W1 + ((size_t)(pn < 4 ? e_lo : e_hi) * 1024 + (size_t)(pn & 3) * 256) * 1024; }
        else { u.A = H + (size_t)pm * 256 * 1024; u.B = W2 + (size_t)pn * 256 * 8192 + (size_t)e_lo * 512; u.bjump = (e_hi - e_lo - 1) * 512; }
        return true;
    }
};

template <int WHICH> __device__ __forceinline__ float tw_src(const Params& p, int k, int n) {
    if constexpr (WHICH == TW_IN) return p.w_in[(size_t)k * INC + win_logical(n)];
    else if constexpr (WHICH == TW_KV) return p.w_mem_kv[(size_t)k * 1024 + n];
    else if constexpr (WHICH == TW_A) return p.w_attn_o[(size_t)k * 1024 + n];
    else if constexpr (WHICH == TW_C) return p.w_conv_o[(size_t)k * 1024 + n];
    else if constexpr (WHICH == TW_M) return p.w_mem_o[(size_t)k * 1024 + n];
    else if constexpr (WHICH == TW_OUT) return p.w_out[(size_t)k * 1024 + n];
    else if constexpr (WHICH == TW_W1) { const int e = n >> 10, c = n & 1023, G = c >> 3, nn = (c >> 2) & 1, ee = c & 3, jj = 4 * G + ee; return (nn ? p.w_eu : p.w_eg)[((size_t)e * 1024 + k) * 512 + jj]; }
    else { const int e = n >> 10, c = n & 1023; return p.w_ed[((size_t)e * 512 + k) * 1024 + c]; }
}
template <int WHICH> __device__ __forceinline__ void tw_item(const Params& p, int item, float* scr, int lane) {
    constexpr int N = WHICH == TW_IN ? INC : (WHICH >= TW_W1 ? 16 * 1024 : 1024);
    constexpr int ldd = (WHICH == TW_A || WHICH == TW_C || WHICH == TW_M) ? 512 : (WHICH == TW_W2 ? 8192 : 1024);
    constexpr size_t dsto = WHICH == TW_IN ? WS_WIN : WHICH == TW_KV ? WS_WKV : WHICH == TW_A ? WS_WA : WHICH == TW_C ? WS_WC : WHICH == TW_M ? WS_WM : WHICH == TW_OUT ? WS_WOUT : WHICH == TW_W1 ? WS_W1 : WS_W2;
    bf16_t* dst = WSP(bf16_t, dsto);
    constexpr int nblk = N / 32; const int kb = item / nblk, nb = item - kb * nblk, k0 = 64 * kb, n0 = 32 * nb;
#pragma unroll 8
    for (int i = 0; i < 32; ++i) { const int kk = 2 * i + (lane >> 5); scr[kk * 33 + (lane & 31)] = tw_src<WHICH>(p, k0 + kk, n0 + (lane & 31)); }
    asm volatile("s_waitcnt lgkmcnt(0)" ::: "memory");
    const int c = lane & 7;
#pragma unroll
    for (int j = 0; j < 4; ++j) { const int n = (lane >> 3) + 8 * j; const float* sp = scr + (8 * c) * 33 + n;
        const int nn = n0 + n; size_t doff;
        if constexpr (WHICH == TW_W2) doff = (size_t)(nn & 1023) * 8192 + (size_t)(nn >> 10) * 512 + k0 + 8 * c; else doff = (size_t)nn * ldd + k0 + 8 * c;
        if constexpr (WHICH >= TW_W1 || (P5_FP8 && WHICH == TW_OUT) || (P4_FP8 && (WHICH == TW_A || WHICH == TW_C || WHICH == TW_M))) {
            u32x2 o; o.x = pk4_fp8(W8_SCALE * sp[0 * 33], W8_SCALE * sp[1 * 33], W8_SCALE * sp[2 * 33], W8_SCALE * sp[3 * 33]); o.y = pk4_fp8(W8_SCALE * sp[4 * 33], W8_SCALE * sp[5 * 33], W8_SCALE * sp[6 * 33], W8_SCALE * sp[7 * 33]);
            *(u32x2*)((unsigned char*)dst + doff) = o;
        } else {
            u32x4 o; o.x = pk2(sp[0 * 33], sp[1 * 33]); o.y = pk2(sp[2 * 33], sp[3 * 33]); o.z = pk2(sp[4 * 33], sp[5 * 33]); o.w = pk2(sp[6 * 33], sp[7 * 33]);
            *(u32x4*)(dst + doff) = o;
            if constexpr (WHICH == TW_IN && !P1_FP6) {
                u32x2 q; q.x = pk4_fp8(WG8_SCALE * sp[0 * 33], WG8_SCALE * sp[1 * 33], WG8_SCALE * sp[2 * 33], WG8_SCALE * sp[3 * 33]); q.y = pk4_fp8(WG8_SCALE * sp[4 * 33], WG8_SCALE * sp[5 * 33], WG8_SCALE * sp[6 * 33], WG8_SCALE * sp[7 * 33]);
                *(u32x2*)(p.ws + WS_WG8 + doff) = q; } } }
    if constexpr (WHICH == TW_IN && P1_FP6) {
        const int n = lane & 31, b = lane >> 5, blk = (k0 >> 5) + b, tt = blk >> 2, fq = blk & 3; float v[32];
#pragma unroll
        for (int j = 0; j < 32; ++j) v[j] = WG8_SCALE * scr[(32 * b + j) * 33 + n];
        const v6u_t q = pack32_fp6(v);
        unsigned char* wp = p.ws + WS_WG8 + (size_t)(n0 + n) * 1024 + tt * 128 + 16 * fq;
        *(u32x4*)wp = (u32x4){q[0], q[1], q[2], q[3]}; *(u32x4*)(wp + 64) = (u32x4){q[4], q[5], 0u, 0u};
    }
    asm volatile("s_waitcnt lgkmcnt(0)" ::: "memory");
}
__device__ __forceinline__ void transpose_all(const Params& p, float* scr, int gw, int ngw, int lane) {
    constexpr int I_IN = 16 * (INC / 32), I_KV = 16 * 32, I_B = 8 * 32, I_OUT = 16 * 32, I_W1 = 16 * 512, I_W2 = 8 * 512;
    constexpr int NITEMS = I_IN + I_KV + 3 * I_B + I_OUT + I_W1 + I_W2;
    for (int it = gw; it < NITEMS; it += ngw) {
        int r = it;
        if (r < I_W1) { tw_item<TW_W1>(p, r, scr, lane); continue; } r -= I_W1;
        if (r < I_IN) { tw_item<TW_IN>(p, r, scr, lane); continue; } r -= I_IN;
        if (r < I_W2) { tw_item<TW_W2>(p, r, scr, lane); continue; } r -= I_W2;
        if (r < I_KV) { tw_item<TW_KV>(p, r, scr, lane); continue; } r -= I_KV;
        if (r < I_OUT) { tw_item<TW_OUT>(p, r, scr, lane); continue; } r -= I_OUT;
        if (r < I_B) { tw_item<TW_A>(p, r, scr, lane); continue; } r -= I_B;
        if (r < I_B) { tw_item<TW_C>(p, r, scr, lane); continue; } r -= I_B;
        tw_item<TW_M>(p, r, scr, lane);
    }
}

__device__ __forceinline__ void cvt_bf16_dev(const float* __restrict__ src, bf16_t* __restrict__ dst, size_t n8, size_t gtid, size_t gstride) {
    for (size_t i = gtid; i < n8; i += gstride) {
        const f32x4 a = *(const f32x4*)(src + i * 8), b = *(const f32x4*)(src + i * 8 + 4);
        u32x4 o; o.x = pk2(a.x, a.y); o.y = pk2(a.z, a.w); o.z = pk2(b.x, b.y); o.w = pk2(b.z, b.w);
        *(u32x4*)(dst + i * 8) = o;
    }
}

__device__ __forceinline__ void cvt_x_dev(const float* __restrict__ src, bf16_t* __restrict__ dst, unsigned char* __restrict__ dst8, size_t n32, size_t gtid, size_t gstride) {
    for (size_t i = gtid; i < n32; i += gstride) {
        float v[32];
#pragma unroll
        for (int q = 0; q < 8; ++q) { const f32x4 a = *(const f32x4*)(src + i * 32 + 4 * q); v[4 * q] = a.x; v[4 * q + 1] = a.y; v[4 * q + 2] = a.z; v[4 * q + 3] = a.w; }
#pragma unroll
        for (int q = 0; q < 4; ++q) { u32x4 o; o.x = pk2(v[8 * q], v[8 * q + 1]); o.y = pk2(v[8 * q + 2], v[8 * q + 3]); o.z = pk2(v[8 * q + 4], v[8 * q + 5]); o.w = pk2(v[8 * q + 6], v[8 * q + 7]); *(u32x4*)(dst + i * 32 + 8 * q) = o; }
        if constexpr (P1_FP6) {
            const size_t row = i >> 5; const int blk = (int)(i & 31), tt = blk >> 2, fq = blk & 3; const v6u_t q6 = pack32_fp6(v);
            unsigned char* xp = dst8 + row * 1024 + tt * 128 + 16 * fq;
            *(u32x4*)xp = (u32x4){q6[0], q6[1], q6[2], q6[3]}; *(u32x4*)(xp + 64) = (u32x4){q6[4], q6[5], 0u, 0u};
        } else {
#pragma unroll
            for (int q = 0; q < 2; ++q) { u32x4 q8; q8.x = pk4_fp8(v[16 * q], v[16 * q + 1], v[16 * q + 2], v[16 * q + 3]); q8.y = pk4_fp8(v[16 * q + 4], v[16 * q + 5], v[16 * q + 6], v[16 * q + 7]);
                q8.z = pk4_fp8(v[16 * q + 8], v[16 * q + 9], v[16 * q + 10], v[16 * q + 11]); q8.w = pk4_fp8(v[16 * q + 12], v[16 * q + 13], v[16 * q + 14], v[16 * q + 15]); *(u32x4*)(dst8 + i * 32 + 16 * q) = q8; }
        }
    }
}
__device__ __forceinline__ void wg8_dev(const Params& p, size_t gtid, size_t gstride) {
    for (size_t i = gtid; i < (size_t)INC * 64; i += gstride) { const int n = (int)(i % INC), k0 = (int)(i / INC) * 16, nl = win_logical(n); float v[16];
#pragma unroll
        for (int j = 0; j < 16; ++j) v[j] = WG8_SCALE * p.w_in[(size_t)(k0 + j) * INC + nl];
        u32x4 q; q.x = pk4_fp8(v[0], v[1], v[2], v[3]); q.y = pk4_fp8(v[4], v[5], v[6], v[7]); q.z = pk4_fp8(v[8], v[9], v[10], v[11]); q.w = pk4_fp8(v[12], v[13], v[14], v[15]);
        *(u32x4*)(p.ws + WS_WG8 + (size_t)n * 1024 + k0) = q; }
}

#ifndef STAG_US
#define STAG_US 0
#endif
__device__ __forceinline__ void delay_us(int us) { const unsigned long long t0 = __builtin_amdgcn_s_memrealtime(); while (__builtin_amdgcn_s_memrealtime() - t0 < (unsigned long long)us * 100ull) __builtin_amdgcn_s_sleep(16); }

struct Args { Params p; int ph_lo, ph_hi; };
typedef const __attribute__((address_space(4))) unsigned long long* KArgPtr;
__device__ __forceinline__ Params load_params(KArgPtr q) {
    asm volatile("" : "+s"(q));
    Params p;
    p.x = (const float*)(const GAS float*)q[0]; p.mem = (const float*)(const GAS float*)q[1]; p.pos = (const int*)(const GAS int*)q[2]; p.w_in = (const float*)(const GAS float*)q[3]; p.b_in = (const float*)(const GAS float*)q[4]; p.conv_w = (const float*)(const GAS float*)q[5]; p.conv_b = (const float*)(const GAS float*)q[6];
    p.conv_g = (const float*)(const GAS float*)q[7]; p.conv_bb = (const float*)(const GAS float*)q[8]; p.w_mem_kv = (const float*)(const GAS float*)q[9]; p.w_attn_o = (const float*)(const GAS float*)q[10]; p.w_conv_o = (const float*)(const GAS float*)q[11]; p.w_mem_o = (const float*)(const GAS float*)q[12];
    p.w_out = (const float*)(const GAS float*)q[13]; p.ln1_g = (const float*)(const GAS float*)q[14]; p.ln1_b = (const float*)(const GAS float*)q[15]; p.w_gr = (const float*)(const GAS float*)q[16]; p.b_gr = (const float*)(const GAS float*)q[17]; p.w_er = (const float*)(const GAS float*)q[18]; p.b_er = (const float*)(const GAS float*)q[19];
    p.w_eg = (const float*)(const GAS float*)q[20]; p.w_eu = (const float*)(const GAS float*)q[21]; p.w_ed = (const float*)(const GAS float*)q[22]; p.ln2_g = (const float*)(const GAS float*)q[23]; p.ln2_b = (const float*)(const GAS float*)q[24]; p.out = (float*)(GAS float*)q[25]; p.ws = (unsigned char*)(GAS unsigned char*)q[26];
    return p;
}
static_assert(sizeof(Params) == 27 * 8, "Params is 27 pointers");
constexpr int PH_P0 = 0, PH_CH0 = 1, PH_PER_CH = 5, PH_LN1 = PH_CH0 + PH_PER_CH * NCH, PH_MOE1 = PH_LN1 + 1, PH_MOE2 = PH_LN1 + 2, PH_LN2 = PH_LN1 + 3, PH_END = PH_LN1 + 4;

__global__ void __launch_bounds__(NTHR, 2) mk_fwd(Args args) {
    extern __shared__ __attribute__((aligned(16))) unsigned char lds_raw[];
    LAS unsigned char* lds = (LAS unsigned char*)lds_raw;
    const KArgPtr kargs = (KArgPtr)__builtin_amdgcn_kernarg_segment_ptr();
    const int wave = __builtin_amdgcn_readfirstlane((int)threadIdx.x >> 6);
    const int G = gridDim.x; const int bx = blockIdx.x; const int vcu = (G % 8 == 0) ? (bx % 8) * (G / 8) + bx / 8 : bx;
    volatile LAS unsigned* MISC = (volatile LAS unsigned*)(lds + LCTL_OFF);
    ClassTab* tab = (ClassTab*)(lds_raw + LCTL_OFF + 256);
    int* pan_cls = (int*)(lds_raw + LCTL_OFF + 512);
    int* toktab = (int*)(lds_raw + LTOK_OFF);
    for (int u = threadIdx.x; u < (LDS_BYTES - LCTL_OFF) / 4; u += NTHR) ((LAS unsigned*)(lds + LCTL_OFF))[u] = 0u;
    __syncthreads();
    const int lo = args.ph_lo, hi = args.ph_hi;
    unsigned* ctl; { const Params p = load_params(kargs); ctl = WSP(unsigned, WS_CTL); }
    XcdBarrier bar; bar.bar = ctl + CW_BAR; bar.x = 0; bar.st = nullptr;
    if (hi - lo > 1) bar = xcd_barrier_post(ctl + CW_BAR, MISC);
#ifndef PHMASK
#define PHMASK 0x3ff
#endif
#ifndef P1_QK_FP8
#define P1_QK_FP8 2
#endif
#if P1_QK_FP8 == 3
constexpr int P1_BF16_TILES = 4, P1_BF16_T0 = 18, P1_BF16_CUT = 4, P1_BF16_SKIP = 0, P1_FP8_TILES = 32, P1_FP8_T0 = 0, P1_FP8_CUT = 18, P1_FP8_SKIP = 4;
#elif P1_QK_FP8 == 2
constexpr int P1_BF16_TILES = 0, P1_BF16_T0 = 0, P1_BF16_CUT = 0, P1_BF16_SKIP = 0, P1_FP8_TILES = 36, P1_FP8_T0 = 0, P1_FP8_CUT = 36, P1_FP8_SKIP = 0;
#elif P1_QK_FP8
constexpr int P1_BF16_TILES = 6, P1_BF16_T0 = 18, P1_BF16_CUT = 6, P1_BF16_SKIP = 0, P1_FP8_TILES = 30, P1_FP8_T0 = 0, P1_FP8_CUT = 18, P1_FP8_SKIP = 6;
#else
constexpr int P1_BF16_TILES = 18, P1_BF16_T0 = 0, P1_BF16_CUT = 12, P1_BF16_SKIP = 6, P1_FP8_TILES = 18, P1_FP8_T0 = 12, P1_FP8_CUT = 6, P1_FP8_SKIP = 6;
#endif
#ifndef ATTN_V2
#define ATTN_V2 1
#endif
#ifndef PROBE_DUP
#define PROBE_DUP (-1)
#endif
#define NREP(b) ((PROBE_DUP == (b)) ? 2 : 1)
#define IN(k) (lo <= (k) && (k) < hi)
#define HAS(b) ((PHMASK >> (b)) & 1)
#define SEAM(k) do { if (IN(k) && IN((k) + 1)) xcd_barrier(bar); } while (0)

    if (HAS(0) && IN(PH_P0)) {
        const Params p = load_params(kargs);
        const size_t gtid = (size_t)bx * NTHR + opaque_tid(wave), gstride = (size_t)G * NTHR;
        for (int rep = 0; rep < NREP(0); ++rep) {
        { const int ptid = opaque_tid(wave); transpose_all(p, (float*)(lds_raw + RING_OFF) + (ptid >> 6) * (64 * 33), bx * NWAVES + (ptid >> 6), G * NWAVES, ptid & 63); }
        small_prep_dev(p, gtid, gstride);
        cvt_bf16_dev(p.mem, WSP(bf16_t, WS_MEMB), (size_t)NB * MEML * 1024 / 8, gtid, gstride);
        cvt_x_dev(p.x, WSP(bf16_t, WS_XB), p.ws + WS_XB8, (size_t)T * 1024 / 32, gtid, gstride);
        }
    }
    SEAM(PH_P0);
    if (PROBE_DUP == 10 && hi - lo > 1) for (int r = 0; r < 16; ++r) xcd_barrier(bar);

    for (int ch = 0; ch < NCH; ++ch) {
        const int ph0 = PH_CH0 + PH_PER_CH * ch;
        if (HAS(1) && IN(ph0)) {
            const Params p = load_params(kargs);
            const EpiMain em{WSP(float, WS_BIASP), p.pos, WSP(bf16_t, WS_QG), WSP(bf16_t, WS_CGLU), WSP(bf16_t, WS_QM), WSP(bf16_t, WS_GATES), ch * TC};
            for (int rep = 0; rep < NREP(1); ++rep) {
            {
                SchedMain S; S.to.init(TC / 256, P1_BF16_TILES, G, bx); S.nkv = ch == 0 ? (NB * MEML / 256) * 4 : 0; S.tile0 = P1_BF16_T0; S.cut = P1_BF16_CUT; S.skip = P1_BF16_SKIP; S.astep = 256 * 2048; S.bstep = 256 * 2048;
                S.XB = (const char*)(WSP(bf16_t, WS_XB) + (size_t)ch * TC * 1024); S.WIN = (const char*)WSP(bf16_t, WS_WIN); S.MEMB = (const char*)WSP(bf16_t, WS_MEMB); S.WKV = (const char*)WSP(bf16_t, WS_WKV);
                FastEpiMain E{em, EpiKV{WSP(bf16_t, WS_KM)}, 1.0f};
#ifndef NO_P1A
                pg8::gemm_phase<FastEpiMain, SchedMain, true, false, false>(lds + RING_OFF, nullptr, 1024, 1024, 1024, S, E, wave);
#endif
                if (PROBE_DUP == 16) { FastEpiStore E2{WSP(bf16_t, WS_MERGED), 1024, 1.0f}; pg8::gemm_phase<FastEpiStore, SchedMain, true, false, false>(lds + RING_OFF, nullptr, 1024, 1024, 1024, S, E2, wave); }
            }
            {
                SchedMain S; S.to.init(TC / 256, P1_FP8_TILES, G, bx); S.nkv = 0; S.tile0 = P1_FP8_T0; S.cut = P1_FP8_CUT; S.skip = P1_FP8_SKIP; S.astep = 256 * 1024; S.bstep = 256 * 1024;
                S.XB = (const char*)(p.ws + WS_XB8 + (size_t)ch * TC * 1024); S.WIN = (const char*)(p.ws + WS_WG8); S.MEMB = nullptr; S.WKV = nullptr;
                FastEpiMain E{em, EpiKV{WSP(bf16_t, WS_KM)}, 1.0f / WG8_SCALE};
#ifndef NO_P1B
                if (STAG_US > 0 && ((bx >> 3) & 1)) delay_us(STAG_US);
                pg8::gemm_phase<FastEpiMain, SchedMain, true, false, false, P1_FP6 ? 2 : 1>(lds + RING_OFF, nullptr, 512, 512, 512, S, E, wave);
#endif
                if (PROBE_DUP == 17) { FastEpiStore E2{WSP(bf16_t, WS_MERGED), 1024, 1.0f}; pg8::gemm_phase<FastEpiStore, SchedMain, true, false, false, true>(lds + RING_OFF, nullptr, 512, 512, 512, S, E2, wave); }
                if (PROBE_DUP == 19 || PROBE_DUP == 20) { SchedMain S2 = S; S2.bstep = 0; if (PROBE_DUP == 20) S2.astep = 0; FastEpiNull E2{WSP(bf16_t, WS_MERGED)}; pg8::gemm_phase<FastEpiNull, SchedMain, true, false, false, true>(lds + RING_OFF, nullptr, 512, 512, 512, S2, E2, wave); }
                if (PROBE_DUP == 21) { SchedMain S2 = S; S2.bstep = 0; S2.astep = 0; FastEpiNull E2{WSP(bf16_t, WS_MERGED)}; pg8::gemm_phase<FastEpiNull, SchedMain, true, false, false, true>(lds + RING_OFF, nullptr, 512, 512, 256, S2, E2, wave); }
                if (PROBE_DUP == 22) { SchedMain S2 = S; S2.bstep = 0; S2.astep = 0; FastEpiNull E2{WSP(bf16_t, WS_MERGED)}; pg8::gemm_phase<FastEpiNull, SchedMain, true, false, false, 3>(lds + RING_OFF, nullptr, 512, 512, 512, S2, E2, wave); }
                if (PROBE_DUP == 18) { FastEpiNull E2{WSP(bf16_t, WS_MERGED)}; pg8::gemm_phase<FastEpiNull, SchedMain, true, false, false, true>(lds + RING_OFF, nullptr, 512, 512, 512, S, E2, wave); }
            }
            }
        }
        SEAM(ph0);
        if (HAS(2) && IN(ph0 + 1)) {
            const Params p = load_params(kargs);
            constexpr int NDIL = BC * 12 * 8, NMEMB = BC * 4 * 8, NBLK = NDIL + NMEMB;
#if ATTN_V2
            for (int rep = 0; rep < NREP(2); ++rep) {
            const bool dummy = (PROBE_DUP == 2) && rep == 0;
            LAS char* rlds = (LAS char*)(lds + RING_OFF); LAS float* scr = (LAS float*)(lds + LTOK_OFF);
            if (wave >= 4) __builtin_amdgcn_s_setprio(1);
            for (int hd = vcu; hd < BC * 16; hd += G) {
                if (hd < BC * 12) { const int g = (hd % 12) >> 2; const size_t base = (size_t)hd * 2048 * 128;
                    swa::head_dilated(WSP(bf16_t, WS_QG) + base, dummy ? WSP(bf16_t, WS_MERGED) + (size_t)(hd & 127) * 2048 * 128 : WSP(bf16_t, WS_QG) + base, WSP(bf16_t, WS_KG) + base, WSP(bf16_t, WS_VG) + base, WSP(float, WS_LSE) + (size_t)hd * 2048, (2048 >> (2 * g)) - 1, rlds, scr, wave);
                } else { const int bh = hd - BC * 12, bl = bh >> 2, h = bh & 3; const size_t kvb = (size_t)(ch * BC * 4 + bh) * 256 * 128;
                    swa::head_mem(WSP(bf16_t, WS_QM) + (size_t)bh * 2048 * 128, WSP(bf16_t, WS_KM) + kvb, WSP(bf16_t, WS_VM) + kvb, (bf16_t*)(p.ws + WS_OMT + (P4_FP8 ? 1 : 2) * ((size_t)bl * 2048 * 512 + h * 128)), 512, rlds, scr, wave); }
            }
            __builtin_amdgcn_s_setprio(0);
            __syncthreads();
            }
            {
                const Params pc = load_params(kargs); const int ptid = opaque_tid(wave); volatile LAS unsigned* qslot = MISC + 4;
                for (;;) {
                    if (ptid == 0) *qslot = atomicAdd(ctl + CW_CONVQ + ch, 1u);
                    __syncthreads();
                    const int u = (int)*qslot;
                    if (u >= BC * 64) break;
                    conv_unit(pc, u, lds_raw + RING_OFF, ptid);
                }
            }
        }
#else
            for (int rep = 0; rep < NREP(2); ++rep) {
            const bool dummy = (PROBE_DUP == 2) && rep == 0;
            auto make_ref = [&](int L) -> swa::BlockRef {
                swa::BlockRef r;
                if (L < NDIL) { const int bgh = L >> 3, qb = L & 7, g = (bgh % 12) >> 2; const size_t base = (size_t)bgh * 2048 * 128;
                    r.Q = WSP(bf16_t, WS_QG) + base + (size_t)qb * 256 * 128; r.K = WSP(bf16_t, WS_KG) + base; r.V = WSP(bf16_t, WS_VG) + base; r.O = dummy ? WSP(bf16_t, WS_MERGED) + (base % (SZ_XB / 2 - 65536)) : (bf16_t*)r.Q;
                    r.LSE = WSP(float, WS_LSE) + (size_t)bgh * 2048 + qb * 256; r.P0 = qb * 256; r.W = 129; r.segmask = (2048 >> (2 * g)) - 1; r.skv = 2048; r.ostride = 128; }
                else { const int idx = L - NDIL, bh = idx >> 3, qb = idx & 7, bl = bh >> 2, h = bh & 3; const size_t kvb = (size_t)(ch * BC * 4 + bh) * 256 * 128;
                    r.Q = WSP(bf16_t, WS_QM) + ((size_t)bh * 2048 + qb * 256) * 128; r.K = WSP(bf16_t, WS_KM) + kvb; r.V = WSP(bf16_t, WS_VM) + kvb;
                    r.O = WSP(bf16_t, WS_OMT) + ((size_t)bl * 2048 + qb * 256) * 512 + h * 128; r.LSE = nullptr; r.P0 = 256; r.W = 1 << 20; r.segmask = (1 << 20) - 1; r.skv = 256; r.ostride = 512; }
                return r; };
            int L = vcu;
            if (L < NBLK) {
                swa::BlockRef cur = make_ref(L); swa::Seam Sm;
                swa::prime(cur, (char*)lds_raw + RING_OFF, Sm, wave);
                for (;;) {
                    const bool more = L + G < NBLK; const int Ln = more ? L + G : L;
                    const swa::BlockRef nxt = more ? make_ref(Ln) : cur;
                    swa::block(cur, nxt, (char*)lds_raw + RING_OFF, Sm, wave);
                    if (!more) break;
                    cur = nxt; L = Ln;
                }
            }
            __syncthreads();
            { const Params pc = load_params(kargs); const int ptid = opaque_tid(wave); for (int u = bx; u < BC * 64; u += G) conv_unit(pc, u, lds_raw + RING_OFF, ptid); }
            if (PROBE_DUP == 13) { const int ptid = opaque_tid(wave); for (int u = bx; u < BC * 64; u += G) conv_unit(p, u, lds_raw + RING_OFF, ptid); }
            if (PROBE_DUP == 14) {
                int L = NDIL + vcu;
                if (L < NBLK) { swa::BlockRef cur = make_ref(L); swa::Seam Sm; swa::prime(cur, (char*)lds_raw + RING_OFF, Sm, wave);
                    for (;;) { const bool more = L + G < NBLK; const int Ln = more ? L + G : L; const swa::BlockRef nxt = more ? make_ref(Ln) : cur; swa::block(cur, nxt, (char*)lds_raw + RING_OFF, Sm, wave); if (!more) break; cur = nxt; L = Ln; } }
                __syncthreads();
            }
            }
        }
#endif
        SEAM(ph0 + 1);
        if (HAS(3) && IN(ph0 + 2)) { const Params p = load_params(kargs); const int ptid = opaque_tid(wave); for (int rep = 0; rep < NREP(3); ++rep) for (int w = bx * NWAVES + (ptid >> 6); w < TC; w += 2 * G * NWAVES) { if (w + G * NWAVES < TC) combine_token2(p, w, w + G * NWAVES, ptid & 63); else if (O_FP8 && P4_FP8) combine_token2(p, w, w, ptid & 63); else combine_token(p, w, ptid & 63); } }
        SEAM(ph0 + 2);
        if (HAS(4) && IN(ph0 + 3)) {
            const Params p = load_params(kargs);
            SchedMerge S; S.to.init(TC / 256, 4, G, bx); S.A0 = (const char*)WSP(bf16_t, WS_OATT); S.W = (const char*)WSP(bf16_t, WS_WA);
            FastEpiMerge E{WSP(bf16_t, WS_GATES), WSP(bf16_t, WS_MERGED)};
            if (PROBE_DUP == 15) { FastEpiStore E2{WSP(bf16_t, WS_MERGED), 1024, 1.0f}; pg8::gemm_phase<FastEpiStore, SchedMerge, true, false, false>(lds + RING_OFF, nullptr, 512, 512, 512, S, E2, wave); }
#if P4_FP8
            for (int rep = 0; rep < NREP(4); ++rep) pg8::gemm_phase<FastEpiMerge, SchedMerge, true, false, false, 1>(lds + RING_OFF, nullptr, 256, 256, 256, S, E, wave);
#else
            for (int rep = 0; rep < NREP(4); ++rep) pg8::gemm_phase<FastEpiMerge, SchedMerge, true, false, false>(lds + RING_OFF, nullptr, 512, 512, 512, S, E, wave);
#endif
        }
        SEAM(ph0 + 3);
        if (HAS(5) && IN(ph0 + 4)) {
            const Params p = load_params(kargs);
#if P5_FP8
            SchedPlain S; S.to.init(TC / 256, 4, G, bx); S.A = (const char*)WSP(bf16_t, WS_MERGED); S.B = (const char*)WSP(bf16_t, WS_WOUT); S.astep = 256 * 1024; S.bstep = 256 * 1024;
            FastEpiStore E{(bf16_t*)p.out + (size_t)ch * TC * 1024, 1024, 1.0f / (M8_SCALE * W8_SCALE)};
            for (int rep = 0; rep < NREP(5); ++rep) pg8::gemm_phase<FastEpiStore, SchedPlain, true, false, false, 1>(lds + RING_OFF, nullptr, 512, 512, 512, S, E, wave);
#else
            SchedPlain S; S.to.init(TC / 256, 4, G, bx); S.A = (const char*)WSP(bf16_t, WS_MERGED); S.B = (const char*)WSP(bf16_t, WS_WOUT); S.astep = 256 * 2048; S.bstep = 256 * 2048;
            FastEpiStore E{(bf16_t*)p.out + (size_t)ch * TC * 1024, 1024, 1.0f};
            for (int rep = 0; rep < NREP(5); ++rep) pg8::gemm_phase<FastEpiStore, SchedPlain, true, false, false>(lds + RING_OFF, nullptr, 1024, 1024, 1024, S, E, wave);
#endif
        }
        SEAM(ph0 + 4);
    }

    if (HAS(6) && IN(PH_LN1)) {
        const Params p = load_params(kargs);
        float* wr = (float*)(lds_raw + RING_OFF); int* cls_l = (int*)(wr + 20 * 1024); int* misc = cls_l + 64;
        for (int i = opaque_tid(wave); i < 20 * 1024; i += NTHR) wr[i] = WSP(float, WS_WRT)[i];
        __syncthreads();
        { for (int rep = 0; rep < NREP(6); ++rep) for (int u = bx; u < T / 64; u += G) { const int ptid = opaque_tid(wave); ln1_unit16(p, u, wr, cls_l, misc, ptid, (PROBE_DUP == 6) && rep == 0); } }
    }
    SEAM(PH_LN1);
    if (IN(PH_MOE1) || IN(PH_MOE2) || IN(PH_LN2)) {
        const int tid = opaque_tid(wave);
        if (tid == 0) class_tab_fill(ctl + CW_CNT, tab);
        __syncthreads();
        const int NP = tab->rowbase[NCLS] >> 8;
        for (int pm = tid; pm < NP; pm += NTHR) pan_cls[pm] = find_class(tab, pm * 256);
        __syncthreads();
    }
    if (HAS(7) && IN(PH_MOE1)) {
        const Params p = load_params(kargs);
        const int NP = tab->rowbase[NCLS] >> 8;
        SchedMoe S; S.to.init(NP, 8, G, bx); S.pan_cls = (LAS const int*)(lds + LCTL_OFF + 512); S.toktab = (LAS const int*)(lds + LTOK_OFF); S.H = nullptr; S.W1 = (const char*)WSP(bf16_t, WS_W1); S.W2 = nullptr; S.mode = 1;
        const int tid = opaque_tid(wave);
        for (int i = 0; i < MAXU; ++i) { int pm, pn; if (!S.to.tile(i, pm, pn)) break;
            if (tid < 256) { const int cls = pan_cls[pm]; int r = pm * 256 + tid - tab->rowbase[cls]; if (r >= tab->cnt[cls]) r = tab->cnt[cls] - 1; toktab[i * 256 + tid] = WSP(int, WS_LIST)[(size_t)cls * T + r]; } }
        __syncthreads();
        FastEpiMoe1 E{(LAS const int*)(lds + LTOK_OFF), WSP(float, WS_WTS), p.ws + WS_H};
        for (int rep = 0; rep < NREP(7); ++rep) pg8::gemm_phase<FastEpiMoe1, SchedMoe, true, true, false, true>(lds + RING_OFF, (const char*)(p.ws + WS_X1B8), 512, 512, 512, S, E, wave);
    }
    SEAM(PH_MOE1);
    if (HAS(8) && IN(PH_MOE2)) {
        const Params p = load_params(kargs);
        const int NP = tab->rowbase[NCLS] >> 8;
        SchedMoe S; S.to.init(NP, 4, G, bx); S.pan_cls = (LAS const int*)(lds + LCTL_OFF + 512); S.toktab = (LAS const int*)(lds + LTOK_OFF); S.H = (const char*)WSP(bf16_t, WS_H); S.W1 = nullptr; S.W2 = (const char*)WSP(bf16_t, WS_W2); S.mode = 2;
#if Y2_FP8
        FastEpiStore8 E{p.ws + WS_Y2, 1024, Y8_SCALE / (H8_SCALE * W8_SCALE)};
        for (int rep = 0; rep < NREP(8); ++rep) pg8::gemm_phase<FastEpiStore8, SchedMoe, true, false, true, true>(lds + RING_OFF, nullptr, 512, 4096, 512, S, E, wave);
#else
        FastEpiStore E{WSP(bf16_t, WS_Y2), 1024, 1.0f / (H8_SCALE * W8_SCALE)};
        for (int rep = 0; rep < NREP(8); ++rep) pg8::gemm_phase<FastEpiStore, SchedMoe, true, false, true, true>(lds + RING_OFF, nullptr, 512, 4096, 512, S, E, wave);
#endif
    }
    SEAM(PH_MOE2);
    if (HAS(9) && IN(PH_LN2)) {
        const Params p = load_params(kargs);
        const int tot = tab->rowbase[NCLS]; const int lane = opaque_tid(wave) & 63;
        for (int rep = 0; rep < NREP(9); ++rep)
        for (int prow = bx * NWAVES + wave; prow < tot; prow += 2 * G * NWAVES) {
            int tk[2], pr[2];
#pragma unroll
            for (int r = 0; r < 2; ++r) { pr[r] = prow + r * G * NWAVES; tk[r] = -1;
                if (pr[r] < tot) { const int cls = pan_cls[pr[r] >> 8]; const int i = pr[r] - tab->rowbase[cls]; if (i < tab->cnt[cls]) tk[r] = WSP(int, WS_LIST)[(size_t)cls * T + i]; } }
            ln2_rows<2>(p, tk, pr, lane, ((PROBE_DUP == 9) && rep == 0) ? (float*)(p.ws + 512 * MiB) : nullptr);
        }
    }
#undef IN
#undef HAS
#undef SEAM
}

#ifndef MK_MODE
#define MK_MODE 3
#endif
extern "C" void kernel_launch(void* const* d_in, const int* in_sizes, int n_in, void* d_out, int out_size, void* d_ws, size_t ws_size, hipStream_t stream) {
    if (n_in != 25 || ws_size < WS_END) { fprintf(stderr, "kernel_launch: unexpected n_in %d / ws_size %zu (need %zu)\n", n_in, ws_size, (size_t)WS_END); return; }
    static int grid = 0;
    if (grid == 0) {
        (void)hipFuncSetAttribute((const void*)k_ln1, hipFuncAttributeMaxDynamicSharedMemorySize, 20 * 1024 * 4 + 1024);
        if (hipFuncSetAttribute((const void*)mk_fwd, hipFuncAttributeMaxDynamicSharedMemorySize, LDS_BYTES) != hipSuccess) fprintf(stderr, "kernel_launch: hipFuncSetAttribute(mk_fwd, %d) failed\n", LDS_BYTES);
        int dev = 0, cus = 0; (void)hipGetDevice(&dev);
        if (hipDeviceGetAttribute(&cus, hipDeviceAttributeMultiprocessorCount, dev) != hipSuccess || cus <= 0) cus = 256;
        int per_cu = 0; (void)hipOccupancyMaxActiveBlocksPerMultiprocessor(&per_cu, (const void*)mk_fwd, NTHR, LDS_BYTES);
        if (per_cu < 1) fprintf(stderr, "kernel_launch: occupancy query reports %d blocks per CU for mk_fwd\n", per_cu);
        (void)hipGetLastError();
        grid = cus;
    }
    Params p{};
    p.x = (const float*)d_in[0]; p.mem = (const float*)d_in[1]; p.pos = (const int*)d_in[2];
    p.w_in = (const float*)d_in[3]; p.b_in = (const float*)d_in[4]; p.conv_w = (const float*)d_in[5]; p.conv_b = (const float*)d_in[6];
    p.conv_g = (const float*)d_in[7]; p.conv_bb = (const float*)d_in[8]; p.w_mem_kv = (const float*)d_in[9]; p.w_attn_o = (const float*)d_in[10];
    p.w_conv_o = (const float*)d_in[11]; p.w_mem_o = (const float*)d_in[12]; p.w_out = (const float*)d_in[13]; p.ln1_g = (const float*)d_in[14]; p.ln1_b = (const float*)d_in[15];
    p.w_gr = (const float*)d_in[16]; p.b_gr = (const float*)d_in[17]; p.w_er = (const float*)d_in[18]; p.b_er = (const float*)d_in[19];
    p.w_eg = (const float*)d_in[20]; p.w_eu = (const float*)d_in[21]; p.w_ed = (const float*)d_in[22]; p.ln2_g = (const float*)d_in[23]; p.ln2_b = (const float*)d_in[24];
    p.out = (float*)d_out; p.ws = (unsigned char*)d_ws;
    (void)hipMemsetAsync((char*)d_ws + WS_CTL, 0, CTL_BYTES, stream);
#if PROBE_DUP == 12
    (void)hipMemsetAsync((char*)d_ws + 944 * MiB, 0, 64 * MiB, stream);
#endif
    auto mk = [&](int lo, int hi) { Args a{}; a.p = p; a.ph_lo = lo; a.ph_hi = hi; hipLaunchKernelGGL(mk_fwd, dim3(grid), dim3(NTHR), LDS_BYTES, stream, a); };
#if MK_MODE == 3
    mk(0, PH_END);
#elif MK_MODE == 2
    for (int ph = 0; ph < PH_END; ++ph) mk(ph, ph + 1);
#elif MK_MODE == 1
    mk(PH_P0, PH_P0 + 1);
    for (int ch = 0; ch < NCH; ++ch) {
        const int ph0 = PH_CH0 + PH_PER_CH * ch;
        mk(ph0, ph0 + 1);
        k_nattn_dil<<<BC * 12 * 2048 / 4, 256, 0, stream>>>(p);
        k_nattn_mem<<<BC * 4 * 2048 / 4, 256, 0, stream>>>(p, ch);
        k_conv<<<BC * 64, 512, 0, stream>>>(p);
        mk(ph0 + 2, ph0 + 3); mk(ph0 + 3, ph0 + 4); mk(ph0 + 4, ph0 + 5);
    }
    mk(PH_LN1, PH_LN1 + 1); mk(PH_MOE1, PH_MOE1 + 1); mk(PH_MOE2, PH_MOE2 + 1); mk(PH_LN2, PH_LN2 + 1);
#else
    for (int w = 0; w < 8; ++w) k_transpose_w<<<2048, 256, 0, stream>>>(p, w);
    k_small_prep<<<(20 * 1024 + 255) / 256, 256, 0, stream>>>(p);
    k_cvt_bf16<<<2048, 256, 0, stream>>>(p.mem, (bf16_t*)((char*)d_ws + WS_MEMB), (size_t)NB * MEML * 1024 / 8);
    k_cvt_bf16<<<4096, 256, 0, stream>>>(p.x, (bf16_t*)((char*)d_ws + WS_XB), (size_t)T * 1024 / 8);
    k_ngemm_kv<<<dim3(1024 / 64, NB * MEML / 64), 256, 0, stream>>>(p, 0);
    for (int ch = 0; ch < NCH; ++ch) {
        k_ngemm_main<<<dim3(INC / 64, TC / 64), 256, 0, stream>>>(p, ch);
        k_nattn_dil<<<BC * 12 * 2048 / 4, 256, 0, stream>>>(p);
        k_nattn_mem<<<BC * 4 * 2048 / 4, 256, 0, stream>>>(p, ch);
        k_conv<<<BC * 64, 512, 0, stream>>>(p);
        k_combine<<<TC / 4, 256, 0, stream>>>(p);
        for (int br = 0; br < 3; ++br) k_ngemm_merge<<<dim3(1024 / 64, TC / 64), 256, 0, stream>>>(p, br);
        k_ngemm_mix<<<dim3(1024 / 64, TC / 64), 256, 0, stream>>>(p, ch);
    }
    k_ln1<<<256, 512, 20 * 1024 * 4 + 1024, stream>>>(p);
    k_ngemm_moe1<<<dim3(2048 / 64, MPAD / 64), 256, 0, stream>>>(p);
    k_ngemm_moe2<<<dim3(1024 / 64, MPAD / 64), 256, 0, stream>>>(p);
    k_ln2<<<MPAD / 4, 256, 0, stream>>>(p);
#endif
}
```

```cpp
#include <hip/hip_runtime.h>
#include <cstdio>
#include <cstdint>

constexpr int D = 1024, NB = 32, S = 2048, T = NB * S;
constexpr int NCH = 2, BC = NB / NCH, TC = T / NCH;
constexpr int INC = 9216;
constexpr int MEML = 256;
constexpr int NCLS = 24;
constexpr int MPAD = T + NCLS * 256;
constexpr float LN_EPS = 1e-5f;
constexpr float DN_ALPHA = 1.189207115002721f;
constexpr float ATT_SCALE = 0.08838834764831845f;

constexpr int C_Q = 0, C_K = 1536, C_V = 3072, C_GLU = 4608, C_QM = 5632, C_GATE = 6144;

constexpr size_t MiB = 1ull << 20;
constexpr size_t WS_CTL = 0, CTL_BYTES = 1 * MiB;
constexpr size_t WS_WIN = 1 * MiB;
constexpr size_t WS_BIASP = 19 * MiB;
constexpr size_t WS_WRT = 19 * MiB + 64 * 1024;
constexpr size_t WS_WKV = 20 * MiB;
constexpr size_t WS_WA = 22 * MiB, WS_WC = 23 * MiB, WS_WM = 24 * MiB;
constexpr size_t WS_WOUT = 25 * MiB;
constexpr size_t WS_W1 = 27 * MiB;
constexpr size_t WS_W2 = 59 * MiB;
constexpr size_t WS_MEMB = 75 * MiB;
constexpr size_t WS_CH = 91 * MiB;
constexpr size_t SZ_XB = (size_t)TC * 1024 * 2, SZ_QKV1 = (size_t)TC * 1536 * 2, SZ_512 = (size_t)TC * 512 * 2;
constexpr size_t WS_XB = WS_CH;
constexpr size_t WS_QG = WS_XB + (size_t)T * 1024 * 2, WS_KG = WS_QG + SZ_QKV1, WS_VG = WS_KG + SZ_QKV1;
constexpr size_t WS_CGLU = WS_VG + SZ_QKV1, WS_QM = WS_CGLU + SZ_512, WS_OATT = WS_QM + SZ_512, WS_CCONV = WS_OATT + SZ_512, WS_OMT = WS_CCONV + SZ_512;
constexpr size_t WS_GATES = WS_OMT + SZ_512;
constexpr size_t SZ_KM = (size_t)NB * 4 * MEML * 128 * 2;
constexpr size_t WS_KM = WS_GATES + (size_t)TC * 3072 * 2, WS_VM = WS_KM + SZ_KM;
constexpr size_t WS_LSE = WS_VM + SZ_KM;
constexpr size_t WS_MERGED = WS_LSE + 2 * MiB;
constexpr size_t WS_CH_END = WS_MERGED + SZ_XB;
constexpr size_t WS_X1B = WS_CH;
constexpr size_t WS_H = WS_X1B + (size_t)T * 1024 * 2;
constexpr size_t WS_Y2 = WS_H + (size_t)MPAD * 1024 * 2;
constexpr size_t WS_LIST = WS_Y2 + (size_t)MPAD * 1024 * 2;
constexpr size_t WS_WTS = WS_LIST + (size_t)NCLS * T * 4;
constexpr size_t WS_X1B8 = WS_WTS + (size_t)T * 8;
constexpr size_t WS_MOE_END = WS_X1B8 + (size_t)T * 1024;
#ifndef P5_FP8
#define P5_FP8 1
#endif
#ifndef P1_QK_FP8
#define P1_QK_FP8 2
#endif
#ifndef CQ_FP8
#define CQ_FP8 1
#endif
constexpr float C8_SCALE = 16.0f;
#ifndef QKV_FP8
#define QKV_FP8 1
#endif
#ifndef O_FP8
#define O_FP8 1
#endif
#ifndef Y2_FP8
#define Y2_FP8 1
#endif
constexpr float Y8_SCALE = 16.0f;
#ifndef P4_FP8
#define P4_FP8 1
#endif
constexpr float O8_SCALE = 16.0f;
constexpr float M8_SCALE = 16.0f;
constexpr float W8_SCALE = 32.0f, H8_SCALE = 16.0f;
constexpr size_t WS_END = WS_CH_END > WS_MOE_END ? WS_CH_END : WS_MOE_END;
constexpr size_t WS_XB8 = 944 * MiB;
constexpr size_t WS_WG8 = 1008 * MiB;
constexpr float WG8_SCALE = 32.0f;
static_assert(WS_CH_END <= WS_XB8 && WS_WG8 + 9 * MiB <= 1024 * MiB, "fp8 operand buffers");
static_assert(WS_END <= 1024 * MiB, "workspace map exceeds 1 GiB");
constexpr int CW_CNT = 64;

typedef unsigned short bf16_t;
typedef float f32x4 __attribute__((ext_vector_type(4)));
typedef unsigned u32x4 __attribute__((ext_vector_type(4)));
typedef unsigned u32x2 __attribute__((ext_vector_type(2)));

__device__ __forceinline__ float bf2f(bf16_t b) { return __uint_as_float(((unsigned)b) << 16); }
__device__ __forceinline__ float bflo(unsigned w) { return __uint_as_float(w << 16); }
__device__ __forceinline__ float bfhi(unsigned w) { return __uint_as_float(w & 0xffff0000u); }
__device__ __forceinline__ unsigned f2bf(float f) { unsigned u = __float_as_uint(f); return (u + 0x7fffu + ((u >> 16) & 1u)) >> 16; }
typedef float f32x2_t __attribute__((ext_vector_type(2)));
typedef __bf16 bf16x2_t __attribute__((ext_vector_type(2)));
__device__ __forceinline__ unsigned pk2(float lo, float hi) { f32x2_t v = {lo, hi}; bf16x2_t b = __builtin_convertvector(v, bf16x2_t); return __builtin_bit_cast(unsigned, b); }
__device__ __forceinline__ float sigmoidf_(float x) { return __builtin_amdgcn_rcpf(1.0f + __builtin_amdgcn_exp2f(-1.4426950408889634f * x)); }
__device__ __forceinline__ float wave_sum(float v) {
#define DPP_F(x, ctrl) __int_as_float(__builtin_amdgcn_update_dpp(0, __float_as_int(x), ctrl, 0xf, 0xf, true))
    v += DPP_F(v, 0xB1);
    v += DPP_F(v, 0x4E);
    v += DPP_F(v, 0x141);
    v += DPP_F(v, 0x140);
#undef DPP_F
    { const auto r = __builtin_amdgcn_permlane16_swap(__float_as_uint(v), __float_as_uint(v), false, false); v = __uint_as_float(r[0]) + __uint_as_float(r[1]); }
    { const auto r = __builtin_amdgcn_permlane32_swap(__float_as_uint(v), __float_as_uint(v), false, false); v = __uint_as_float(r[0]) + __uint_as_float(r[1]); }
    return v;
}
__device__ __forceinline__ float wave_max(float v) {
#pragma unroll
    for (int o = 1; o < 64; o <<= 1) v = fmaxf(v, __shfl_xor(v, o));
    return v;
}
__device__ __forceinline__ unsigned pk4_fp8(float a, float b, float c, float d) { unsigned w = 0; w = __builtin_amdgcn_cvt_pk_fp8_f32(a, b, w, false); w = __builtin_amdgcn_cvt_pk_fp8_f32(c, d, w, true); return w; }
__device__ __forceinline__ unsigned pk4_fp8s(float a, float b, float c, float d) { return pk4_fp8(__builtin_amdgcn_fmed3f(a, -448.f, 448.f), __builtin_amdgcn_fmed3f(b, -448.f, 448.f), __builtin_amdgcn_fmed3f(c, -448.f, 448.f), __builtin_amdgcn_fmed3f(d, -448.f, 448.f)); }
__device__ __forceinline__ unsigned pk4_u8(float a, float b, float c, float d) {
    const unsigned ua = (unsigned)fmaxf(__builtin_rintf(a * 255.f), 1.f), ub = (unsigned)fmaxf(__builtin_rintf(b * 255.f), 1.f), uc = (unsigned)fmaxf(__builtin_rintf(c * 255.f), 1.f), ud = (unsigned)fmaxf(__builtin_rintf(d * 255.f), 1.f);
    return ua | (ub << 8) | (uc << 16) | (ud << 24); }
__device__ __forceinline__ float sig255(float x) { const float e = __builtin_amdgcn_exp2f(-1.4426950408889634f * x); return fmaxf(__builtin_rintf(__builtin_amdgcn_rcpf(__builtin_fmaf(e, 1.0f / 255.0f, 1.0f / 255.0f))), 1.0f); }
__device__ __forceinline__ unsigned pk4_sig_u8(float a, float b, float c, float d) { unsigned w = 0u;
    w = __builtin_amdgcn_cvt_pk_u8_f32(sig255(a), 0, w); w = __builtin_amdgcn_cvt_pk_u8_f32(sig255(b), 1, w); w = __builtin_amdgcn_cvt_pk_u8_f32(sig255(c), 2, w); w = __builtin_amdgcn_cvt_pk_u8_f32(sig255(d), 3, w); return w; }
__device__ __forceinline__ f32x4 u8x4_raw(unsigned w) { return (f32x4){(float)(w & 255u), (float)((w >> 8) & 255u), (float)((w >> 16) & 255u), (float)(w >> 24)}; }
__device__ __forceinline__ f32x4 u8x4_to_f32(unsigned w) { return (f32x4){(float)(w & 255u), (float)((w >> 8) & 255u), (float)((w >> 16) & 255u), (float)(w >> 24)} * (1.0f / 255.0f); }
#ifndef P1_FP6
#define P1_FP6 0
#endif
typedef float v16f_t __attribute__((ext_vector_type(16)));
typedef unsigned v6u_t __attribute__((ext_vector_type(6)));
__device__ __forceinline__ v6u_t pack32_fp6(const float (&v)[32]) {
    v16f_t a, b;
#pragma unroll
    for (int i = 0; i < 16; ++i) { a[i] = fminf(fmaxf(v[i], -7.5f), 7.5f); b[i] = fminf(fmaxf(v[16 + i], -7.5f), 7.5f); }
    return __builtin_amdgcn_cvt_scalef32_2xpk16_fp6_f32(a, b, 1.0f);
}
__device__ __forceinline__ int opaque_tid(int wave_s) { unsigned z = 0u; asm volatile("" : "+v"(z)); const int l = (int)__builtin_amdgcn_mbcnt_hi(~0u, __builtin_amdgcn_mbcnt_lo(~0u, z)); return (wave_s << 6) | l; }
__device__ __forceinline__ void rope_cs(float pos, int j, float& c, float& s) {
    const float invrev = __builtin_amdgcn_exp2f(-(float)j * (13.287712379549449f / 64.0f)) * 0.15915494309189535f;
    float rev = pos * invrev; rev = __builtin_amdgcn_fractf(rev);
    s = __builtin_amdgcn_sinf(rev); c = __builtin_amdgcn_cosf(rev);
}
__device__ __forceinline__ int rowperm(int g, int s) { return g == 0 ? s : (g == 1 ? ((s & 3) * 512 + (s >> 2)) : ((s & 15) * 128 + (s >> 4))); }
__host__ __device__ __forceinline__ int win_logical(int n) {
    if (n < C_V) { const int sec = n / 1536, r = n % 1536, gh = r / 128, p = r % 128, G = p >> 3, nn = (p >> 2) & 1, e = p & 3; return sec * 1536 + gh * 128 + 64 * nn + 4 * G + e; }
    if (n < C_GLU) return n;
    if (n < C_QM) { const int cc = n - C_GLU, G = cc >> 3, nn = (cc >> 2) & 1, e = cc & 3; return C_GLU + nn * 512 + 4 * G + e; }
    return n;
}

struct Params {
    const float *x, *mem; const int* pos;
    const float *w_in, *b_in, *conv_w, *conv_b, *conv_g, *conv_bb, *w_mem_kv, *w_attn_o, *w_conv_o, *w_mem_o, *w_out, *ln1_g, *ln1_b;
    const float *w_gr, *b_gr, *w_er, *b_er, *w_eg, *w_eu, *w_ed, *ln2_g, *ln2_b;
    float* out; unsigned char* ws;
};
#define WSP(T_, off) ((T_*)(p.ws + (off)))

__global__ void k_cvt_bf16(const float* __restrict__ src, bf16_t* __restrict__ dst, size_t n8) {
    for (size_t i = (size_t)blockIdx.x * blockDim.x + threadIdx.x; i < n8; i += (size_t)gridDim.x * blockDim.x) {
        const f32x4 a = *(const f32x4*)(src + i * 8), b = *(const f32x4*)(src + i * 8 + 4);
        u32x4 o; o.x = pk2(a.x, a.y); o.y = pk2(a.z, a.w); o.z = pk2(b.x, b.y); o.w = pk2(b.z, b.w);
        *(u32x4*)(dst + i * 8) = o;
    }
}
enum { TW_IN = 0, TW_KV, TW_A, TW_C, TW_M, TW_OUT, TW_W1, TW_W2 };
__device__ __forceinline__ void transpose_w_dev(const Params& p, int which, size_t gtid, size_t gstride) {
    int K, N, ldd; bf16_t* dst;
    switch (which) {
        case TW_IN: K = 1024; N = INC; ldd = 1024; dst = WSP(bf16_t, WS_WIN); break;
        case TW_KV: K = 1024; N = 1024; ldd = 1024; dst = WSP(bf16_t, WS_WKV); break;
        case TW_A: K = 512; N = 1024; ldd = 512; dst = WSP(bf16_t, WS_WA); break;
        case TW_C: K = 512; N = 1024; ldd = 512; dst = WSP(bf16_t, WS_WC); break;
        case TW_M: K = 512; N = 1024; ldd = 512; dst = WSP(bf16_t, WS_WM); break;
        case TW_OUT: K = 1024; N = 1024; ldd = 1024; dst = WSP(bf16_t, WS_WOUT); break;
        case TW_W1: K = 1024; N = 16 * 1024; ldd = 1024; dst = WSP(bf16_t, WS_W1); break;
        default: K = 512; N = 16 * 1024; ldd = 8192; dst = WSP(bf16_t, WS_W2); break;
    }
    const size_t total = (size_t)N * (K / 8);
    for (size_t i = gtid; i < total; i += gstride) {
        const int n = (int)(i % N), k0 = (int)(i / N) * 8;
        float v[8];
#pragma unroll
        for (int j = 0; j < 8; ++j) {
            const int k = k0 + j; float s;
            switch (which) {
                case TW_IN: s = p.w_in[(size_t)k * INC + win_logical(n)]; break;
                case TW_KV: s = p.w_mem_kv[(size_t)k * 1024 + n]; break;
                case TW_A: s = p.w_attn_o[(size_t)k * 1024 + n]; break;
                case TW_C: s = p.w_conv_o[(size_t)k * 1024 + n]; break;
                case TW_M: s = p.w_mem_o[(size_t)k * 1024 + n]; break;
                case TW_OUT: s = p.w_out[(size_t)k * 1024 + n]; break;
                case TW_W1: { const int e = n >> 10, c = n & 1023, G = c >> 3, nn = (c >> 2) & 1, ee = c & 3, jj = 4 * G + ee;
                              s = (nn ? p.w_eu : p.w_eg)[((size_t)e * 1024 + k) * 512 + jj]; } break;
                default: { const int e = n >> 10, c = n & 1023; s = p.w_ed[((size_t)e * 512 + k) * 1024 + c]; } break;
            }
            v[j] = s;
        }
        u32x4 o; o.x = pk2(v[0], v[1]); o.y = pk2(v[2], v[3]); o.z = pk2(v[4], v[5]); o.w = pk2(v[6], v[7]);
        size_t doff;
        if (which == TW_W2) { const int e = n >> 10, c = n & 1023; doff = (size_t)c * 8192 + e * 512 + k0; }
        else doff = (size_t)n * ldd + k0;
        *(u32x4*)(dst + doff) = o;
    }
}
__global__ void k_transpose_w(Params p, int which) { transpose_w_dev(p, which, (size_t)blockIdx.x * blockDim.x + threadIdx.x, (size_t)gridDim.x * blockDim.x); }
__device__ __forceinline__ void small_prep_dev(const Params& p, size_t gtid, size_t gstride) {
    for (size_t ii = gtid; ii < 20 * 1024; ii += gstride) { const int i = (int)ii;
        if (i < INC) WSP(float, WS_BIASP)[i] = p.b_in[win_logical(i)];
        const int e = i >> 10, k = i & 1023;
        WSP(float, WS_WRT)[i] = e < 4 ? p.w_gr[k * 4 + e] : p.w_er[((size_t)((e - 4) >> 2) * 1024 + k) * 4 + ((e - 4) & 3)]; }
}
__global__ void k_small_prep(Params p) { small_prep_dev(p, (size_t)blockIdx.x * blockDim.x + threadIdx.x, (size_t)gridDim.x * blockDim.x); }

struct EpiMain {
    const float* biasp; const int* pos; bf16_t *QG, *CGLU, *QM, *GATES; int tok0;
    static __device__ __forceinline__ void rope_freqs(int c0, float (&invrev)[4]) {
        const int j0 = ((c0 & 127) >> 3) * 4;
#pragma unroll
        for (int e = 0; e < 4; ++e) invrev[e] = __builtin_amdgcn_exp2f(-(float)(j0 + e) * (13.287712379549449f / 64.0f)) * 0.15915494309189535f;
    }
    template <int S> __device__ __forceinline__ void finish_s(int rl, int c0, float (&v)[8], float fpos, const float (&invrev)[4]) const {
        const int bl = rl >> 11, s = rl & 2047;
        if constexpr (S <= 1) {
            const int tcol = __builtin_amdgcn_readfirstlane(c0 & ~255);
            const int sec = tcol / 1536, r = c0 - sec * 1536, gh = r >> 7, pcol = r & 127, g = gh >> 2;
            if constexpr (S == 0) {
#pragma unroll
                for (int e = 0; e < 4; ++e) { const float rev = __builtin_amdgcn_fractf(fpos * invrev[e]); const float sn = __builtin_amdgcn_sinf(rev), c = __builtin_amdgcn_cosf(rev);
                    const float t1 = v[e], t2 = v[4 + e]; v[e] = t1 * c - t2 * sn; v[4 + e] = t2 * c + t1 * sn; }
            }
            bf16_t* base = QG + (size_t)sec * (SZ_QKV1 / 2);
            u32x4 o; o.x = pk2(v[0], v[1]); o.y = pk2(v[2], v[3]); o.z = pk2(v[4], v[5]); o.w = pk2(v[6], v[7]);
            *(u32x4*)(base + ((size_t)(bl * 12 + gh) * 2048 + rowperm(g, s)) * 128 + pcol) = o;
        } else if constexpr (S == 2) {
            const int j0 = (c0 - C_GLU) >> 1;
#if CQ_FP8
            *(unsigned*)((unsigned char*)CGLU + (size_t)rl * 512 + j0) = pk4_fp8(C8_SCALE * v[0] * sigmoidf_(v[4]), C8_SCALE * v[1] * sigmoidf_(v[5]), C8_SCALE * v[2] * sigmoidf_(v[6]), C8_SCALE * v[3] * sigmoidf_(v[7]));
#else
            u32x2 o; o.x = pk2(v[0] * sigmoidf_(v[4]), v[1] * sigmoidf_(v[5])); o.y = pk2(v[2] * sigmoidf_(v[6]), v[3] * sigmoidf_(v[7]));
            *(u32x2*)(CGLU + (size_t)rl * 512 + j0) = o;
#endif
        } else {
            const int cc = c0 - C_QM, h = cc >> 7, pcol = cc & 127;
#if CQ_FP8
            u32x2 o8; o8.x = pk4_fp8(v[0], v[1], v[2], v[3]); o8.y = pk4_fp8(v[4], v[5], v[6], v[7]);
            *(u32x2*)((unsigned char*)QM + ((size_t)(bl * 4 + h) * 2048 + s) * 256 + pcol) = o8;
#else
            u32x4 o; o.x = pk2(v[0], v[1]); o.y = pk2(v[2], v[3]); o.z = pk2(v[4], v[5]); o.w = pk2(v[6], v[7]);
            *(u32x4*)(QM + ((size_t)(bl * 4 + h) * 2048 + s) * 128 + pcol) = o;
#endif
        }
    }
    __device__ __forceinline__ void finish(int rl, int c0, float (&v)[8], float fpos, const float (&invrev)[4]) const {
        const int bl = rl >> 11, s = rl & 2047;
        const int tcol = __builtin_amdgcn_readfirstlane(c0 & ~255);
        if (tcol < C_GLU) {
            const int sec = tcol / 1536, r = c0 - sec * 1536, gh = r >> 7, pcol = r & 127, g = gh >> 2;
            if (sec < 2) {
#pragma unroll
                for (int e = 0; e < 4; ++e) { const float rev = __builtin_amdgcn_fractf(fpos * invrev[e]); const float sn = __builtin_amdgcn_sinf(rev), c = __builtin_amdgcn_cosf(rev);
                    const float t1 = v[e], t2 = v[4 + e]; v[e] = t1 * c - t2 * sn; v[4 + e] = t2 * c + t1 * sn; }
            }
            bf16_t* base = QG + (size_t)sec * (SZ_QKV1 / 2);
            u32x4 o; o.x = pk2(v[0], v[1]); o.y = pk2(v[2], v[3]); o.z = pk2(v[4], v[5]); o.w = pk2(v[6], v[7]);
            *(u32x4*)(base + ((size_t)(bl * 12 + gh) * 2048 + rowperm(g, s)) * 128 + pcol) = o;
        } else if (tcol < C_QM) {
            const int j0 = (c0 - C_GLU) >> 1;
            u32x2 o; o.x = pk2(v[0] * sigmoidf_(v[4]), v[1] * sigmoidf_(v[5])); o.y = pk2(v[2] * sigmoidf_(v[6]), v[3] * sigmoidf_(v[7]));
            *(u32x2*)(CGLU + (size_t)rl * 512 + j0) = o;
        } else if (tcol < C_GATE) {
            const int cc = c0 - C_QM, h = cc >> 7, pcol = cc & 127;
            u32x4 o; o.x = pk2(v[0], v[1]); o.y = pk2(v[2], v[3]); o.z = pk2(v[4], v[5]); o.w = pk2(v[6], v[7]);
            *(u32x4*)(QM + ((size_t)(bl * 4 + h) * 2048 + s) * 128 + pcol) = o;
        } else {
            const int cc = c0 - C_GATE;
            u32x2 o; o.x = pk4_sig_u8(v[0], v[1], v[2], v[3]); o.y = pk4_sig_u8(v[4], v[5], v[6], v[7]);
            *(u32x2*)((unsigned char*)GATES + (size_t)rl * 3072 + cc) = o;
        }
    }
    __device__ __forceinline__ void operator()(int rl, int c0, float (&v)[8]) const {
        const f32x4 b0 = *(const f32x4*)(biasp + c0), b1 = *(const f32x4*)(biasp + c0 + 4);
        v[0] += b0.x; v[1] += b0.y; v[2] += b0.z; v[3] += b0.w; v[4] += b1.x; v[5] += b1.y; v[6] += b1.z; v[7] += b1.w;
        float invrev[4]; rope_freqs(c0, invrev);
        finish(rl, c0, v, c0 < C_V ? (float)pos[tok0 + rl] : 0.f, invrev);
    }
};
struct EpiKV {
    bf16_t *KM;
    __device__ __forceinline__ void operator()(int row, int c0, float (&v)[8]) const {
        const int bl = row >> 8, m = row & 255, isv = c0 >> 9, cc = c0 & 511, h = cc >> 7, pcol = cc & 127;
        u32x4 o; o.x = pk2(v[0], v[1]); o.y = pk2(v[2], v[3]); o.z = pk2(v[4], v[5]); o.w = pk2(v[6], v[7]);
        *(u32x4*)(KM + (size_t)isv * (SZ_KM / 2) + ((size_t)(bl * 4 + h) * 256 + m) * 128 + pcol) = o;
    }
};
struct EpiMerge {
    const bf16_t* GATES; bf16_t* MERGED; int br;
    __device__ __forceinline__ void operator()(int rl, int c0, float (&v)[8]) const {
        const u32x2 g = *(const u32x2*)((const unsigned char*)GATES + (size_t)rl * 3072 + br * 1024 + c0);
        const f32x4 g0 = u8x4_to_f32(g.x), g1 = u8x4_to_f32(g.y);
        float r[8] = {g0.x * v[0], g0.y * v[1], g0.z * v[2], g0.w * v[3], g1.x * v[4], g1.y * v[5], g1.z * v[6], g1.w * v[7]};
        bf16_t* mp = MERGED + (size_t)rl * 1024 + c0;
        if (br > 0) { const u32x4 m = *(const u32x4*)mp; r[0] += bflo(m.x); r[1] += bfhi(m.x); r[2] += bflo(m.y); r[3] += bfhi(m.y); r[4] += bflo(m.z); r[5] += bfhi(m.z); r[6] += bflo(m.w); r[7] += bfhi(m.w); }
        u32x4 o; o.x = pk2(r[0], r[1]); o.y = pk2(r[2], r[3]); o.z = pk2(r[4], r[5]); o.w = pk2(r[6], r[7]);
        *(u32x4*)mp = o;
    }
};
struct EpiMix {
    bf16_t* MIX; int tok0;
    __device__ __forceinline__ void operator()(int rl, int c0, float (&v)[8]) const {
        u32x4 o; o.x = pk2(v[0], v[1]); o.y = pk2(v[2], v[3]); o.z = pk2(v[4], v[5]); o.w = pk2(v[6], v[7]);
        *(u32x4*)(MIX + (size_t)(tok0 + rl) * 1024 + c0) = o;
    }
};
struct ClassTab { int cnt[NCLS], rowbase[NCLS + 1]; };
__device__ __forceinline__ void class_tab_fill(const unsigned* cntw, ClassTab* t) {
    int acc = 0;
    for (int c = 0; c < NCLS; ++c) { const int n = (int)cntw[c]; t->cnt[c] = n; t->rowbase[c] = acc; acc += ((n + 255) >> 8) << 8; }
    t->rowbase[NCLS] = acc;
}
__device__ __forceinline__ void class_experts(int cls, int& e_lo, int& e_hi) {
    const int g = cls / 6, pi = cls - g * 6;
    const int lo = pi < 3 ? 0 : (pi < 5 ? 1 : 2), hi = pi < 3 ? pi + 1 : (pi < 5 ? pi - 1 : 3);
    e_lo = g * 4 + lo; e_hi = g * 4 + hi;
}
struct EpiMoe1 {
    const int* list; const float* wts; bf16_t* H; int cls, cnt, rowbase;
    __device__ __forceinline__ void operator()(int prow, int c0, float (&v)[8]) const {
        int i = prow - rowbase; if (i >= cnt) i = cnt - 1;
        const int tok = list[i]; const int hi = c0 >> 10; const float w = wts[(size_t)tok * 2 + hi];
        const int j0 = hi * 512 + ((c0 & 1023) >> 1);
        float r[4];
#pragma unroll
        for (int e = 0; e < 4; ++e) { const float gt = v[e]; r[e] = gt * sigmoidf_(gt) * v[4 + e] * w; }
        u32x2 o; o.x = pk2(r[0], r[1]); o.y = pk2(r[2], r[3]);
        *(u32x2*)(H + (size_t)prow * 1024 + j0) = o;
    }
};
struct EpiMoe2 {
    bf16_t* Y2;
    __device__ __forceinline__ void operator()(int prow, int c0, float (&v)[8]) const {
        u32x4 o; o.x = pk2(v[0], v[1]); o.y = pk2(v[2], v[3]); o.z = pk2(v[4], v[5]); o.w = pk2(v[6], v[7]);
        *(u32x4*)(Y2 + (size_t)prow * 1024 + c0) = o;
    }
};

struct RowsPlain { const bf16_t* base; int ld; __device__ __forceinline__ const bf16_t* operator()(int r) const { return base + (size_t)r * ld; } };
template <class AF, class BF, class EF>
__device__ __forceinline__ void ngemm_tile(int row0, int col0, int K, const AF& af, const BF& bf, const EF& ef, int bkseg, long bjump) {
    __shared__ float As[64][33], Bs[64][33];
    const int tid = threadIdx.x, ty = tid >> 3, tx = tid & 7;
    float acc[2][8];
#pragma unroll
    for (int i = 0; i < 2; ++i)
#pragma unroll
        for (int j = 0; j < 8; ++j) acc[i][j] = 0.f;
    const int lr = tid >> 2, lk = (tid & 3) * 8;
    const bf16_t* ap = af(row0 + lr); const bf16_t* bp = bf(col0 + lr);
    for (int k0 = 0; k0 < K; k0 += 32) {
        const u32x4 a = *(const u32x4*)(ap + k0 + lk);
        const long bo = (long)k0 + lk + (long)(k0 / bkseg) * bjump;
        const u32x4 b = *(const u32x4*)(bp + bo);
        __syncthreads();
        As[lr][lk + 0] = bflo(a.x); As[lr][lk + 1] = bfhi(a.x); As[lr][lk + 2] = bflo(a.y); As[lr][lk + 3] = bfhi(a.y);
        As[lr][lk + 4] = bflo(a.z); As[lr][lk + 5] = bfhi(a.z); As[lr][lk + 6] = bflo(a.w); As[lr][lk + 7] = bfhi(a.w);
        Bs[lr][lk + 0] = bflo(b.x); Bs[lr][lk + 1] = bfhi(b.x); Bs[lr][lk + 2] = bflo(b.y); Bs[lr][lk + 3] = bfhi(b.y);
        Bs[lr][lk + 4] = bflo(b.z); Bs[lr][lk + 5] = bfhi(b.z); Bs[lr][lk + 6] = bflo(b.w); Bs[lr][lk + 7] = bfhi(b.w);
        __syncthreads();
#pragma unroll 8
        for (int kk = 0; kk < 32; ++kk) {
            const float a0 = As[2 * ty][kk], a1 = As[2 * ty + 1][kk];
#pragma unroll
            for (int j = 0; j < 8; ++j) { const float bv = Bs[8 * tx + j][kk]; acc[0][j] += a0 * bv; acc[1][j] += a1 * bv; }
        }
    }
    ef(row0 + 2 * ty, col0 + 8 * tx, acc[0]);
    ef(row0 + 2 * ty + 1, col0 + 8 * tx, acc[1]);
}
__global__ void __launch_bounds__(256) k_ngemm_main(Params p, int ch) {
    const int tok0 = ch * TC;
    EpiMain E{WSP(float, WS_BIASP), p.pos, WSP(bf16_t, WS_QG), WSP(bf16_t, WS_CGLU), WSP(bf16_t, WS_QM), WSP(bf16_t, WS_GATES), tok0};
    RowsPlain A{WSP(bf16_t, WS_XB) + (size_t)ch * TC * 1024, 1024}, Bm{WSP(bf16_t, WS_WIN), 1024};
    ngemm_tile(blockIdx.y * 64, blockIdx.x * 64, 1024, A, Bm, E, 1 << 30, 0);
}
__global__ void __launch_bounds__(256) k_ngemm_kv(Params p, int ch) {
    EpiKV E{WSP(bf16_t, WS_KM)};
    RowsPlain A{WSP(bf16_t, WS_MEMB), 1024}, Bm{WSP(bf16_t, WS_WKV), 1024};
    ngemm_tile(blockIdx.y * 64, blockIdx.x * 64, 1024, A, Bm, E, 1 << 30, 0);
}
__global__ void __launch_bounds__(256) k_ngemm_merge(Params p, int br) {
    EpiMerge E{WSP(bf16_t, WS_GATES), WSP(bf16_t, WS_MERGED), br};
    RowsPlain A{WSP(bf16_t, WS_OATT + (size_t)br * SZ_512), 512};
    RowsPlain Bm{WSP(bf16_t, WS_WA + (size_t)br * MiB), 512};
    ngemm_tile(blockIdx.y * 64, blockIdx.x * 64, 512, A, Bm, E, 1 << 30, 0);
}
__global__ void __launch_bounds__(256) k_ngemm_mix(Params p, int ch) {
    EpiMix E{(bf16_t*)p.out, ch * TC};
    RowsPlain A{WSP(bf16_t, WS_MERGED), 1024}, Bm{WSP(bf16_t, WS_WOUT), 1024};
    ngemm_tile(blockIdx.y * 64, blockIdx.x * 64, 1024, A, Bm, E, 1 << 30, 0);
}
struct RowsGather { const bf16_t* base; const int* list; int cnt, rowbase; __device__ __forceinline__ const bf16_t* operator()(int prow) const { int i = prow - rowbase; if (i >= cnt) i = cnt - 1; return base + (size_t)list[i] * 1024; } };
__device__ __forceinline__ int find_class(const ClassTab* t, int prow) { int c = 0;
    for (int i = 1; i < NCLS; ++i) if (prow >= t->rowbase[i]) c = i;
    return c; }
__global__ void __launch_bounds__(256) k_ngemm_moe1(Params p) {
    __shared__ ClassTab tabs; if (threadIdx.x == 0) class_tab_fill(WSP(unsigned, WS_CTL) + CW_CNT, &tabs); __syncthreads(); const ClassTab* tab = &tabs;
    const int row0 = blockIdx.y * 64; if (row0 >= tab->rowbase[NCLS]) return;
    const int cls = find_class(tab, row0); if (tab->cnt[cls] == 0) return;
    int e_lo, e_hi; class_experts(cls, e_lo, e_hi);
    const int col0 = blockIdx.x * 64, hi = col0 >> 10;
    const int* list = WSP(int, WS_LIST) + (size_t)cls * T;
    RowsGather A{WSP(bf16_t, WS_X1B), list, tab->cnt[cls], tab->rowbase[cls]};
    RowsPlain Bm{WSP(bf16_t, WS_W1) + ((size_t)(hi ? e_hi : e_lo) * 1024 - (size_t)hi * 1024) * 1024, 1024};
    EpiMoe1 E{list, WSP(float, WS_WTS), WSP(bf16_t, WS_H), cls, tab->cnt[cls], tab->rowbase[cls]};
    ngemm_tile(row0, col0, 1024, A, Bm, E, 1 << 30, 0);
}
__global__ void __launch_bounds__(256) k_ngemm_moe2(Params p) {
    __shared__ ClassTab tabs; if (threadIdx.x == 0) class_tab_fill(WSP(unsigned, WS_CTL) + CW_CNT, &tabs); __syncthreads(); const ClassTab* tab = &tabs;
    const int row0 = blockIdx.y * 64; if (row0 >= tab->rowbase[NCLS]) return;
    const int cls = find_class(tab, row0); if (tab->cnt[cls] == 0) return;
    int e_lo, e_hi; class_experts(cls, e_lo, e_hi);
    RowsPlain A{WSP(bf16_t, WS_H), 1024};
    RowsPlain Bm{WSP(bf16_t, WS_W2) + (size_t)e_lo * 512, 8192};
    EpiMoe2 E{WSP(bf16_t, WS_Y2)};
    ngemm_tile(row0, blockIdx.x * 64, 1024, A, Bm, E, 512, (long)(e_hi - e_lo - 1) * 512);
}

__device__ __forceinline__ void nattn_row(const bf16_t* qp, const bf16_t* kbase, const bf16_t* vbase, int nkeys, bf16_t* op, float* lsep, int lane) {
    const unsigned qw = *(const unsigned*)(qp + 2 * lane); const float q0 = bflo(qw), q1 = bfhi(qw);
    float sc[4] = {-INFINITY, -INFINITY, -INFINITY, -INFINITY};
#pragma unroll
    for (int kb = 0; kb < 4; ++kb) {
        for (int kk = 0; kk < 64; ++kk) { const int k = kb * 64 + kk; if (k >= nkeys) break;
            const unsigned kw = *(const unsigned*)(kbase + (size_t)k * 128 + 2 * lane);
            const float s = wave_sum(q0 * bflo(kw) + q1 * bfhi(kw)) * ATT_SCALE;
            if (lane == kk) sc[kb] = s; }
    }
    const float m = wave_max(fmaxf(fmaxf(sc[0], sc[1]), fmaxf(sc[2], sc[3])));
    float pr[4]; float ps = 0.f;
#pragma unroll
    for (int kb = 0; kb < 4; ++kb) { pr[kb] = __expf(sc[kb] - m); ps += pr[kb]; }
    const float l = wave_sum(ps);
    float a0 = 0.f, a1 = 0.f;
#pragma unroll
    for (int kb = 0; kb < 4; ++kb) {
        for (int kk = 0; kk < 64; ++kk) { const int k = kb * 64 + kk; if (k >= nkeys) break;
            const float pk = __shfl(pr[kb], kk);
            const unsigned vw = *(const unsigned*)(vbase + (size_t)k * 128 + 2 * lane);
            a0 += pk * bflo(vw); a1 += pk * bfhi(vw); }
    }
    const float inv = 1.0f / l;
    *(unsigned*)(op + 2 * lane) = pk2(a0 * inv, a1 * inv);
    if (lsep && lane == 0) *lsep = m + __logf(l);
}
__global__ void __launch_bounds__(256) k_nattn_dil(Params p) {
    const int lane = threadIdx.x & 63; const size_t w = (size_t)blockIdx.x * 4 + (threadIdx.x >> 6);
    if (w >= (size_t)BC * 12 * 2048) return;
    const int row = (int)(w & 2047); const int bgh = (int)(w >> 11); const int g = (bgh % 12) >> 2;
    const int seglen = 2048 >> (2 * g); const int pin = row & (seglen - 1); const int nk = pin + 1 < 129 ? pin + 1 : 129;
    bf16_t* Q = WSP(bf16_t, WS_QG) + ((size_t)bgh * 2048 + row) * 128;
    const bf16_t* K = WSP(bf16_t, WS_KG) + ((size_t)bgh * 2048 + row - nk + 1) * 128;
    const bf16_t* V = WSP(bf16_t, WS_VG) + ((size_t)bgh * 2048 + row - nk + 1) * 128;
    nattn_row(Q, K, V, nk, Q, WSP(float, WS_LSE) + (size_t)bgh * 2048 + row, lane);
}
__global__ void __launch_bounds__(256) k_nattn_mem(Params p, int ch) {
    const int lane = threadIdx.x & 63; const size_t w = (size_t)blockIdx.x * 4 + (threadIdx.x >> 6);
    if (w >= (size_t)BC * 4 * 2048) return;
    const int s = (int)(w & 2047); const int bh = (int)(w >> 11); const int bl = bh >> 2, h = bh & 3;
    const bf16_t* Q = WSP(bf16_t, WS_QM) + ((size_t)bh * 2048 + s) * 128;
    const bf16_t* K = WSP(bf16_t, WS_KM) + (size_t)(ch * BC * 4 + bh) * 256 * 128;
    const bf16_t* V = WSP(bf16_t, WS_VM) + (size_t)(ch * BC * 4 + bh) * 256 * 128;
    nattn_row(Q, K, V, 256, WSP(bf16_t, WS_OMT) + ((size_t)(bl * 2048 + s)) * 512 + h * 128, nullptr, lane);
}

__device__ __forceinline__ void combine_token(const Params& p, int rl, int lane) {
    const int bl = rl >> 11, s = rl & 2047, h = lane >> 4, d0 = (lane & 15) * 8;
    float ls[3]; u32x4 o[3];
#pragma unroll
    for (int g = 0; g < 3; ++g) { const size_t r = (size_t)(bl * 12 + g * 4 + h) * 2048 + rowperm(g, s);
        ls[g] = WSP(float, WS_LSE)[r]; o[g] = *(const u32x4*)(WSP(bf16_t, WS_QG) + r * 128 + d0); }
    const float m = fmaxf(ls[0], fmaxf(ls[1], ls[2]));
    float w0 = __expf(ls[0] - m), w1 = __expf(ls[1] - m), w2 = __expf(ls[2] - m); const float inv = 1.0f / (w0 + w1 + w2); w0 *= inv; w1 *= inv; w2 *= inv;
    u32x4 r;
    r.x = pk2(w0 * bflo(o[0].x) + w1 * bflo(o[1].x) + w2 * bflo(o[2].x), w0 * bfhi(o[0].x) + w1 * bfhi(o[1].x) + w2 * bfhi(o[2].x));
    r.y = pk2(w0 * bflo(o[0].y) + w1 * bflo(o[1].y) + w2 * bflo(o[2].y), w0 * bfhi(o[0].y) + w1 * bfhi(o[1].y) + w2 * bfhi(o[2].y));
    r.z = pk2(w0 * bflo(o[0].z) + w1 * bflo(o[1].z) + w2 * bflo(o[2].z), w0 * bfhi(o[0].z) + w1 * bfhi(o[1].z) + w2 * bfhi(o[2].z));
    r.w = pk2(w0 * bflo(o[0].w) + w1 * bflo(o[1].w) + w2 * bflo(o[2].w), w0 * bfhi(o[0].w) + w1 * bfhi(o[1].w) + w2 * bfhi(o[2].w));
#if P4_FP8
    u32x2 r8; r8.x = pk4_fp8(O8_SCALE * bflo(r.x), O8_SCALE * bfhi(r.x), O8_SCALE * bflo(r.y), O8_SCALE * bfhi(r.y)); r8.y = pk4_fp8(O8_SCALE * bflo(r.z), O8_SCALE * bfhi(r.z), O8_SCALE * bflo(r.w), O8_SCALE * bfhi(r.w));
    *(u32x2*)(p.ws + WS_OATT + (size_t)rl * 512 + h * 128 + d0) = r8;
#else
    *(u32x4*)(WSP(bf16_t, WS_OATT) + (size_t)rl * 512 + h * 128 + d0) = r;
#endif
}
__device__ __forceinline__ void combine_token2(const Params& p, int rl0, int rl1, int lane) {
    const int h = lane >> 4, d0 = (lane & 15) * 8;
#if O_FP8 && P4_FP8
    float ls[2][3]; u32x2 o8[2][3];
#pragma unroll
    for (int t = 0; t < 2; ++t) { const int rl = t ? rl1 : rl0; const int bl = rl >> 11, s = rl & 2047;
#pragma unroll
        for (int g = 0; g < 3; ++g) { const size_t r = (size_t)(bl * 12 + g * 4 + h) * 2048 + rowperm(g, s);
            ls[t][g] = WSP(float, WS_LSE)[r]; o8[t][g] = *(const u32x2*)(p.ws + WS_QG + r * 256 + d0); } }
#pragma unroll
    for (int t = 0; t < 2; ++t) { const int rl = t ? rl1 : rl0;
        const float m = fmaxf(ls[t][0], fmaxf(ls[t][1], ls[t][2]));
        float w0 = __expf(ls[t][0] - m), w1 = __expf(ls[t][1] - m), w2 = __expf(ls[t][2] - m); const float inv = 1.0f / (w0 + w1 + w2); w0 *= inv; w1 *= inv; w2 *= inv;
        float f[8] = {0.f, 0.f, 0.f, 0.f, 0.f, 0.f, 0.f, 0.f};
#pragma unroll
        for (int g = 0; g < 3; ++g) { const float wg = g == 0 ? w0 : (g == 1 ? w1 : w2);
            const auto a0 = __builtin_amdgcn_cvt_pk_f32_fp8(o8[t][g].x, false), a1 = __builtin_amdgcn_cvt_pk_f32_fp8(o8[t][g].x, true), a2 = __builtin_amdgcn_cvt_pk_f32_fp8(o8[t][g].y, false), a3 = __builtin_amdgcn_cvt_pk_f32_fp8(o8[t][g].y, true);
            f[0] += wg * a0[0]; f[1] += wg * a0[1]; f[2] += wg * a1[0]; f[3] += wg * a1[1]; f[4] += wg * a2[0]; f[5] += wg * a2[1]; f[6] += wg * a3[0]; f[7] += wg * a3[1]; }
        u32x2 r8; r8.x = pk4_fp8(f[0], f[1], f[2], f[3]); r8.y = pk4_fp8(f[4], f[5], f[6], f[7]);
        *(u32x2*)(p.ws + WS_OATT + (size_t)rl * 512 + h * 128 + d0) = r8;
    }
#else
    float ls[2][3]; u32x4 o[2][3];
#pragma unroll
    for (int t = 0; t < 2; ++t) { const int rl = t ? rl1 : rl0; const int bl = rl >> 11, s = rl & 2047;
#pragma unroll
        for (int g = 0; g < 3; ++g) { const size_t r = (size_t)(bl * 12 + g * 4 + h) * 2048 + rowperm(g, s);
            ls[t][g] = WSP(float, WS_LSE)[r]; o[t][g] = *(const u32x4*)(WSP(bf16_t, WS_QG) + r * 128 + d0); } }
#pragma unroll
    for (int t = 0; t < 2; ++t) { const int rl = t ? rl1 : rl0;
        const float m = fmaxf(ls[t][0], fmaxf(ls[t][1], ls[t][2]));
        float w0 = __expf(ls[t][0] - m), w1 = __expf(ls[t][1] - m), w2 = __expf(ls[t][2] - m); const float inv = 1.0f / (w0 + w1 + w2); w0 *= inv; w1 *= inv; w2 *= inv;
#define CMB(c, f) (w0 * f(o[t][0].c) + w1 * f(o[t][1].c) + w2 * f(o[t][2].c))
#if P4_FP8
        u32x4 r; r.x = pk2(CMB(x, bflo), CMB(x, bfhi)); r.y = pk2(CMB(y, bflo), CMB(y, bfhi)); r.z = pk2(CMB(z, bflo), CMB(z, bfhi)); r.w = pk2(CMB(w, bflo), CMB(w, bfhi));
        u32x2 r8; r8.x = pk4_fp8(O8_SCALE * bflo(r.x), O8_SCALE * bfhi(r.x), O8_SCALE * bflo(r.y), O8_SCALE * bfhi(r.y)); r8.y = pk4_fp8(O8_SCALE * bflo(r.z), O8_SCALE * bfhi(r.z), O8_SCALE * bflo(r.w), O8_SCALE * bfhi(r.w));
        *(u32x2*)(p.ws + WS_OATT + (size_t)rl * 512 + h * 128 + d0) = r8;
#else
        u32x4 r; r.x = pk2(CMB(x, bflo), CMB(x, bfhi)); r.y = pk2(CMB(y, bflo), CMB(y, bfhi)); r.z = pk2(CMB(z, bflo), CMB(z, bfhi)); r.w = pk2(CMB(w, bflo), CMB(w, bfhi));
        *(u32x4*)(WSP(bf16_t, WS_OATT) + (size_t)rl * 512 + h * 128 + d0) = r;
#endif
#undef CMB
    }
#endif
}
__global__ void __launch_bounds__(256) k_combine(Params p) {
    const int lane = threadIdx.x & 63; const int w = blockIdx.x * 4 + (threadIdx.x >> 6);
    if (w < TC) combine_token(p, w, lane);
}
constexpr int CONV_TILE = 62 * 1024, CONV_OUT = 32 * 1024, CONV_LDS = CONV_TILE + CONV_OUT + (8 * 32 + 64) * 4;
__device__ __forceinline__ void conv_unit(const Params& p, int u, unsigned char* lds, int tid_) {
    const int ch = tid_, lane = ch & 63, wv = ch >> 6;
    const int bl = u >> 6, s0 = (u & 63) * 32;
    bf16_t* tile = (bf16_t*)lds; bf16_t* otile = (bf16_t*)(lds + CONV_TILE); float* red = (float*)(lds + CONV_TILE + CONV_OUT);
#if CQ_FP8
    const unsigned char* cg8 = p.ws + WS_CGLU + (size_t)bl * 2048 * 512; unsigned char* tile8 = (unsigned char*)tile;
#pragma unroll
    for (int it = 0; it < 4; ++it) { const int c = it * 512 + ch; if (c < 62 * 32) { const int r = c >> 5, q = c & 31, s = s0 - 30 + r;
        u32x4 v = {0u, 0u, 0u, 0u}; if (s >= 0) v = *(const u32x4*)(cg8 + (size_t)s * 512 + q * 16);
        *(u32x4*)(tile8 + r * 512 + q * 16) = v; } }
#else
    const bf16_t* cg = WSP(bf16_t, WS_CGLU) + (size_t)bl * 2048 * 512;
#pragma unroll
    for (int it = 0; it < 8; ++it) { const int c = it * 512 + ch; if (c < 62 * 64) { const int r = c >> 6, q = c & 63, s = s0 - 30 + r;
        u32x4 v = {0u, 0u, 0u, 0u}; if (s >= 0) v = *(const u32x4*)(cg + (size_t)s * 512 + q * 8);
        *(u32x4*)(tile + r * 512 + q * 8) = v; } }
#endif
    __syncthreads();
    float o[32]; const float cb = p.conv_b[ch];
#pragma unroll
    for (int i = 0; i < 32; ++i) o[i] = cb;
    {   float in[62];
#pragma unroll
#if CQ_FP8
        for (int i = 0; i < 62; ++i) in[i] = __builtin_amdgcn_cvt_f32_fp8((unsigned)tile8[i * 512 + ch], 0);
#else
        for (int i = 0; i < 62; ++i) in[i] = bf2f(tile[i * 512 + ch]);
#endif
#pragma unroll
        for (int j = 0; j < 31; ++j) { const float w = p.conv_w[j * 512 + ch] * (CQ_FP8 ? 1.0f / C8_SCALE : 1.0f);
#pragma unroll
            for (int i = 0; i < 32; ++i) o[i] += w * in[i + j]; } }
    float* mean = red + 256; float* rstd = red + 288;
#pragma unroll
    for (int i = 0; i < 32; ++i) { const float sr = wave_sum(o[i]); if (lane == 0) red[wv * 32 + i] = sr; }
    __syncthreads();
    if (ch < 32) { float sm = 0.f;
#pragma unroll
        for (int w = 0; w < 8; ++w) sm += red[w * 32 + ch];
        mean[ch] = sm * (1.0f / 512.0f); }
    __syncthreads();
#pragma unroll
    for (int i = 0; i < 32; ++i) { o[i] -= mean[i]; const float sr = wave_sum(o[i] * o[i]); if (lane == 0) red[wv * 32 + i] = sr; }
    __syncthreads();
    if (ch < 32) { float sm = 0.f;
#pragma unroll
        for (int w = 0; w < 8; ++w) sm += red[w * 32 + ch];
        rstd[ch] = 1.0f / sqrtf(sm * (1.0f / 512.0f) + LN_EPS); }
    __syncthreads();
    const float gg = p.conv_g[ch], bb = p.conv_bb[ch];
#pragma unroll
#if P4_FP8
    for (int i = 0; i < 32; ++i) { const float y = o[i] * rstd[i] * gg + bb; const float z = O8_SCALE * (y * sigmoidf_(y)); ((unsigned char*)otile)[i * 512 + ch] = (unsigned char)(__builtin_amdgcn_cvt_pk_fp8_f32(z, z, 0, false) & 255); }
    __syncthreads();
    unsigned char* outp = p.ws + WS_CCONV + ((size_t)bl * 2048 + s0) * 512;
#pragma unroll
    for (int it = 0; it < 2; ++it) { const int c = it * 512 + ch; *(u32x4*)(outp + (size_t)c * 16) = *(const u32x4*)((const unsigned char*)otile + c * 16); }
#else
    for (int i = 0; i < 32; ++i) { const float y = o[i] * rstd[i] * gg + bb; otile[i * 512 + ch] = (bf16_t)f2bf(y * sigmoidf_(y)); }
    __syncthreads();
    bf16_t* outp = WSP(bf16_t, WS_CCONV) + ((size_t)bl * 2048 + s0) * 512;
#pragma unroll
    for (int it = 0; it < 4; ++it) { const int c = it * 512 + ch; *(u32x4*)(outp + (size_t)c * 8) = *(const u32x4*)(otile + c * 8); }
#endif
    __syncthreads();
}
__global__ void __launch_bounds__(512) k_conv(Params p) {
    __shared__ __attribute__((aligned(16))) unsigned char cl[CONV_LDS];
    conv_unit(p, blockIdx.x, cl, threadIdx.x);
}
__device__ __forceinline__ void ln1_unit(const Params& p, int u, const float* wr, int* cls_l, int* misc, int tid_, bool dummy = false) {
    const int tid = tid_, lane = tid & 63, wv = tid >> 6;
    float gam[16], bet[16];
#pragma unroll
    for (int j = 0; j < 4; ++j) { const f32x4 g4 = *(const f32x4*)(p.ln1_g + 4 * lane + 256 * j), b4 = *(const f32x4*)(p.ln1_b + 4 * lane + 256 * j);
        gam[4 * j] = g4.x; gam[4 * j + 1] = g4.y; gam[4 * j + 2] = g4.z; gam[4 * j + 3] = g4.w; bet[4 * j] = b4.x; bet[4 * j + 1] = b4.y; bet[4 * j + 2] = b4.z; bet[4 * j + 3] = b4.w; }
    const int tok0 = u * 64 + wv * 8;
    u32x2 xq[2][4]; u32x2 mq[2][4];
#define LN1_LOAD(slot, rr) do { const bf16_t* xr_ = WSP(bf16_t, WS_XB) + (size_t)(tok0 + (rr)) * 1024 + 4 * lane; const bf16_t* mr_ = (const bf16_t*)p.out + (size_t)(tok0 + (rr)) * 1024 + 4 * lane; \
        _Pragma("unroll") for (int j = 0; j < 4; ++j) { xq[slot][j] = *(const u32x2*)(xr_ + 256 * j); mq[slot][j] = *(const u32x2*)(mr_ + 256 * j); } } while (0)
    LN1_LOAD(0, 0);
#pragma unroll
    for (int rr = 0; rr < 8; ++rr) {
        const int lr = wv * 8 + rr; const int tok = tok0 + rr;
        if (rr + 1 < 8) { if (rr & 1) LN1_LOAD(0, rr + 1); else LN1_LOAD(1, rr + 1); }
        float v[16]; float sm = 0.f;
#pragma unroll
        for (int j = 0; j < 4; ++j) { const u32x2 t = xq[rr & 1][j]; const u32x2 mm = mq[rr & 1][j];
            v[4 * j] = DN_ALPHA * bflo(t.x) + bflo(mm.x); v[4 * j + 1] = DN_ALPHA * bfhi(t.x) + bfhi(mm.x); v[4 * j + 2] = DN_ALPHA * bflo(t.y) + bflo(mm.y); v[4 * j + 3] = DN_ALPHA * bfhi(t.y) + bfhi(mm.y);
            sm += (v[4 * j] + v[4 * j + 1]) + (v[4 * j + 2] + v[4 * j + 3]); }
        const float mean = wave_sum(sm) * (1.0f / 1024.0f); float sq = 0.f;
#pragma unroll
        for (int i = 0; i < 16; ++i) { v[i] -= mean; sq += v[i] * v[i]; }
        const float rstd = 1.0f / sqrtf(wave_sum(sq) * (1.0f / 1024.0f) + LN_EPS);
#pragma unroll
        for (int i = 0; i < 16; ++i) v[i] = v[i] * rstd * gam[i] + bet[i];
        bf16_t* xb = WSP(bf16_t, dummy ? WS_H : WS_X1B) + (size_t)tok * 1024;
#pragma unroll
        for (int j = 0; j < 4; ++j) { u32x2 o; o.x = pk2(v[4 * j], v[4 * j + 1]); o.y = pk2(v[4 * j + 2], v[4 * j + 3]); *(u32x2*)(xb + 4 * lane + 256 * j) = o; }
        if (!dummy) { unsigned char* x8 = p.ws + WS_X1B8 + (size_t)tok * 1024;
#pragma unroll
            for (int j = 0; j < 4; ++j) *(unsigned*)(x8 + 4 * lane + 256 * j) = pk4_fp8(v[4 * j], v[4 * j + 1], v[4 * j + 2], v[4 * j + 3]); }
        float gl[4];
#pragma unroll
        for (int e = 0; e < 4; ++e) { float a = 0.f;
#pragma unroll
            for (int j = 0; j < 4; ++j) { const f32x4 w4 = *(const f32x4*)(wr + e * 1024 + 4 * lane + 256 * j); a += v[4 * j] * w4.x + v[4 * j + 1] * w4.y + v[4 * j + 2] * w4.z + v[4 * j + 3] * w4.w; }
            gl[e] = wave_sum(a) + p.b_gr[e]; }
        int gs = 0; float gm = gl[0];
#pragma unroll
        for (int e = 1; e < 4; ++e) if (gl[e] > gm) { gm = gl[e]; gs = e; }
        float gsum = 0.f;
#pragma unroll
        for (int e = 0; e < 4; ++e) gsum += __expf(gl[e] - gm);
        const float gprob = 1.0f / gsum;
        gs = __builtin_amdgcn_readfirstlane(gs);
        float el[4];
#pragma unroll
        for (int e = 0; e < 4; ++e) { float a = 0.f; const float* wp = wr + (4 + gs * 4 + e) * 1024;
#pragma unroll
            for (int j = 0; j < 4; ++j) { const f32x4 w4 = *(const f32x4*)(wp + 4 * lane + 256 * j); a += v[4 * j] * w4.x + v[4 * j + 1] * w4.y + v[4 * j + 2] * w4.z + v[4 * j + 3] * w4.w; }
            el[e] = wave_sum(a) + p.b_er[gs * 4 + e]; }
        int i1 = 0; float v1 = el[0];
#pragma unroll
        for (int e = 1; e < 4; ++e) if (el[e] > v1) { v1 = el[e]; i1 = e; }
        int i2 = -1; float v2 = -INFINITY;
#pragma unroll
        for (int e = 0; e < 4; ++e) if (e != i1 && el[e] > v2) { v2 = el[e]; i2 = e; }
        const float t2 = __expf(v2 - v1); const float w1 = gprob / (1.0f + t2), w2 = gprob * t2 / (1.0f + t2);
        const int lo = i1 < i2 ? i1 : i2, hi = i1 < i2 ? i2 : i1;
        const int pi = lo == 0 ? hi - 1 : (lo == 1 ? hi + 1 : 5);
        if (lane == 0 && !dummy) { cls_l[lr] = gs * 6 + pi; float* wt = WSP(float, WS_WTS) + (size_t)tok * 2; wt[0] = (i1 == lo) ? w1 : w2; wt[1] = (i1 == lo) ? w2 : w1; }
    }
#undef LN1_LOAD
    __syncthreads();
    if (dummy) return;
    if (tid < NCLS) { int n = 0; for (int r = 0; r < 64; ++r) n += (cls_l[r] == tid); misc[tid] = n ? (int)atomicAdd(WSP(unsigned, WS_CTL) + CW_CNT + tid, (unsigned)n) : 0; }
    __syncthreads();
    if (tid < 64) { const int c = cls_l[tid]; int rank = 0; for (int r = 0; r < tid; ++r) rank += (cls_l[r] == c);
        WSP(int, WS_LIST)[(size_t)c * T + misc[c] + rank] = u * 64 + tid; }
    __syncthreads();
}
__device__ __forceinline__ float row16_sum(float v) {
#define DPP_F(x, ctrl) __int_as_float(__builtin_amdgcn_update_dpp(0, __float_as_int(x), ctrl, 0xf, 0xf, true))
    v += DPP_F(v, 0xB1); v += DPP_F(v, 0x4E); v += DPP_F(v, 0x141); v += DPP_F(v, 0x140);
#undef DPP_F
    return v;
}
__device__ __forceinline__ void ln1_unit16(const Params& p, int u, const float* wr, int* cls_l, int* misc, int tid_, bool dummy = false) {
    const int tid = tid_, lane = tid & 63, wv = tid >> 6;
#pragma unroll 1
    for (int pass = 0; pass < 2; ++pass) {
        int q = lane >> 4, l16 = lane & 15; asm volatile("" : "+v"(q), "+v"(l16));
        const int lr = wv * 8 + pass * 4 + q; const int tok = u * 64 + lr;
        const bf16_t* xr = WSP(bf16_t, WS_XB) + (size_t)tok * 1024 + 4 * l16; const bf16_t* mr = (const bf16_t*)p.out + (size_t)tok * 1024 + 4 * l16;
        u32x2 xq[16], mq[16]; f32x4 g4[16], b4[16];
#pragma unroll
        for (int c = 0; c < 16; ++c) { xq[c] = *(const u32x2*)(xr + 64 * c); mq[c] = *(const u32x2*)(mr + 64 * c); }
#pragma unroll
        for (int c = 0; c < 16; ++c) { g4[c] = *(const f32x4*)(p.ln1_g + 64 * c + 4 * l16); b4[c] = *(const f32x4*)(p.ln1_b + 64 * c + 4 * l16); }
        float v[64]; float sm = 0.f;
#pragma unroll
        for (int c = 0; c < 16; ++c) { const u32x2 t = xq[c], mm = mq[c];
            v[4 * c] = DN_ALPHA * bflo(t.x) + bflo(mm.x); v[4 * c + 1] = DN_ALPHA * bfhi(t.x) + bfhi(mm.x); v[4 * c + 2] = DN_ALPHA * bflo(t.y) + bflo(mm.y); v[4 * c + 3] = DN_ALPHA * bfhi(t.y) + bfhi(mm.y);
            sm += (v[4 * c] + v[4 * c + 1]) + (v[4 * c + 2] + v[4 * c + 3]); }
        const float mean = row16_sum(sm) * (1.0f / 1024.0f); float sq = 0.f;
#pragma unroll
        for (int i = 0; i < 64; ++i) { v[i] -= mean; sq += v[i] * v[i]; }
        const float rstd = 1.0f / sqrtf(row16_sum(sq) * (1.0f / 1024.0f) + LN_EPS);
        bf16_t* xb = WSP(bf16_t, dummy ? WS_H : WS_X1B) + (size_t)tok * 1024 + 4 * l16; unsigned char* x8 = p.ws + WS_X1B8 + (size_t)tok * 1024 + 4 * l16;
#pragma unroll
        for (int c = 0; c < 16; ++c) {
            v[4 * c] = v[4 * c] * rstd * g4[c].x + b4[c].x; v[4 * c + 1] = v[4 * c + 1] * rstd * g4[c].y + b4[c].y; v[4 * c + 2] = v[4 * c + 2] * rstd * g4[c].z + b4[c].z; v[4 * c + 3] = v[4 * c + 3] * rstd * g4[c].w + b4[c].w;
            u32x2 o; o.x = pk2(v[4 * c], v[4 * c + 1]); o.y = pk2(v[4 * c + 2], v[4 * c + 3]); *(u32x2*)(xb + 64 * c) = o;
            if (!dummy) *(unsigned*)(x8 + 64 * c) = pk4_fp8(v[4 * c], v[4 * c + 1], v[4 * c + 2], v[4 * c + 3]); }
        asm volatile("" ::: "memory");
        float gl[4];
#pragma unroll
        for (int e = 0; e < 4; ++e) { float a = 0.f;
#pragma unroll
            for (int c = 0; c < 16; ++c) { const f32x4 w4 = *(const f32x4*)(wr + e * 1024 + 64 * c + 4 * l16); a += v[4 * c] * w4.x + v[4 * c + 1] * w4.y + v[4 * c + 2] * w4.z + v[4 * c + 3] * w4.w; }
            gl[e] = a; asm volatile("" ::: "memory"); }
#pragma unroll
        for (int e = 0; e < 4; ++e) gl[e] = row16_sum(gl[e]) + p.b_gr[e];
        int gs = 0; float gm = gl[0];
#pragma unroll
        for (int e = 1; e < 4; ++e) if (gl[e] > gm) { gm = gl[e]; gs = e; }
        float gsum = 0.f;
#pragma unroll
        for (int e = 0; e < 4; ++e) gsum += __expf(gl[e] - gm);
        const float gprob = 1.0f / gsum;
        float el[4]; const float* wpb = wr + (4 + gs * 4) * 1024 + 4 * l16;
#pragma unroll
        for (int e = 0; e < 4; ++e) { float a = 0.f;
#pragma unroll
            for (int c = 0; c < 16; ++c) { const f32x4 w4 = *(const f32x4*)(wpb + e * 1024 + 64 * c); a += v[4 * c] * w4.x + v[4 * c + 1] * w4.y + v[4 * c + 2] * w4.z + v[4 * c + 3] * w4.w; }
            el[e] = a; asm volatile("" ::: "memory"); }
#pragma unroll
        for (int e = 0; e < 4; ++e) el[e] = row16_sum(el[e]) + p.b_er[gs * 4 + e];
        int i1 = 0; float v1 = el[0];
#pragma unroll
        for (int e = 1; e < 4; ++e) if (el[e] > v1) { v1 = el[e]; i1 = e; }
        int i2 = -1; float v2 = -INFINITY;
#pragma unroll
        for (int e = 0; e < 4; ++e) if (e != i1 && el[e] > v2) { v2 = el[e]; i2 = e; }
        const float t2 = __expf(v2 - v1); const float w1 = gprob / (1.0f + t2), w2 = gprob * t2 / (1.0f + t2);
        const int lo = i1 < i2 ? i1 : i2, hi = i1 < i2 ? i2 : i1;
        const int pi = lo == 0 ? hi - 1 : (lo == 1 ? hi + 1 : 5);
        if (l16 == 0 && !dummy) { cls_l[lr] = gs * 6 + pi; float* wt = WSP(float, WS_WTS) + (size_t)tok * 2; wt[0] = (i1 == lo) ? w1 : w2; wt[1] = (i1 == lo) ? w2 : w1; }
    }
    __syncthreads();
    if (dummy) return;
    if (tid < NCLS) { int n = 0; for (int r = 0; r < 64; ++r) n += (cls_l[r] == tid); misc[tid] = n ? (int)atomicAdd(WSP(unsigned, WS_CTL) + CW_CNT + tid, (unsigned)n) : 0; }
    __syncthreads();
    if (tid < 64) { const int c = cls_l[tid]; int rank = 0; for (int r = 0; r < tid; ++r) rank += (cls_l[r] == c);
        WSP(int, WS_LIST)[(size_t)c * T + misc[c] + rank] = u * 64 + tid; }
    __syncthreads();
}
__global__ void __launch_bounds__(512) k_ln1(Params p) {
    extern __shared__ float dyn[];
    float* wr = dyn; int* cls_l = (int*)(dyn + 20 * 1024); int* misc = cls_l + 64;
    for (int i = threadIdx.x; i < 20 * 1024; i += 512) wr[i] = WSP(float, WS_WRT)[i];
    __syncthreads();
    for (int u = blockIdx.x; u < T / 64; u += gridDim.x) ln1_unit(p, u, wr, cls_l, misc, threadIdx.x);
}
template <int NR>
__device__ __forceinline__ void ln2_rows(const Params& p, const int (&tok)[NR], const int (&prow)[NR], int lane, float* dummy = nullptr) {
    u32x2 xa[NR][4];
#if Y2_FP8
    unsigned ya[NR][4];
#pragma unroll
    for (int r = 0; r < NR; ++r) if (tok[r] >= 0) { const bf16_t* xrow = WSP(bf16_t, WS_X1B) + (size_t)tok[r] * 1024 + 4 * lane; const unsigned char* yrow = p.ws + WS_Y2 + (size_t)prow[r] * 1024 + 4 * lane;
#pragma unroll
        for (int j = 0; j < 4; ++j) { xa[r][j] = *(const u32x2*)(xrow + 256 * j); ya[r][j] = *(const unsigned*)(yrow + 256 * j); } }
#else
    u32x2 ya[NR][4];
#pragma unroll
    for (int r = 0; r < NR; ++r) if (tok[r] >= 0) { const bf16_t* xrow = WSP(bf16_t, WS_X1B) + (size_t)tok[r] * 1024 + 4 * lane; const bf16_t* yrow = WSP(bf16_t, WS_Y2) + (size_t)prow[r] * 1024 + 4 * lane;
#pragma unroll
        for (int j = 0; j < 4; ++j) { xa[r][j] = *(const u32x2*)(xrow + 256 * j); ya[r][j] = *(const u32x2*)(yrow + 256 * j); } }
#endif
    f32x4 g4[4], b4[4];
#pragma unroll
    for (int j = 0; j < 4; ++j) { g4[j] = *(const f32x4*)(p.ln2_g + 4 * lane + 256 * j); b4[j] = *(const f32x4*)(p.ln2_b + 4 * lane + 256 * j); }
#pragma unroll
    for (int r = 0; r < NR; ++r) if (tok[r] >= 0) {
        float v[16]; float sm = 0.f;
#pragma unroll
        for (int j = 0; j < 4; ++j) { const u32x2 t = xa[r][j];
#if Y2_FP8
            const auto ylo = __builtin_amdgcn_cvt_pk_f32_fp8(ya[r][j], false), yhi = __builtin_amdgcn_cvt_pk_f32_fp8(ya[r][j], true);
            v[4 * j] = DN_ALPHA * bflo(t.x) + ylo[0] * (1.0f / Y8_SCALE); v[4 * j + 1] = DN_ALPHA * bfhi(t.x) + ylo[1] * (1.0f / Y8_SCALE); v[4 * j + 2] = DN_ALPHA * bflo(t.y) + yhi[0] * (1.0f / Y8_SCALE); v[4 * j + 3] = DN_ALPHA * bfhi(t.y) + yhi[1] * (1.0f / Y8_SCALE);
#else
            const u32x2 y = ya[r][j];
            v[4 * j] = DN_ALPHA * bflo(t.x) + bflo(y.x); v[4 * j + 1] = DN_ALPHA * bfhi(t.x) + bfhi(y.x); v[4 * j + 2] = DN_ALPHA * bflo(t.y) + bflo(y.y); v[4 * j + 3] = DN_ALPHA * bfhi(t.y) + bfhi(y.y);
#endif
            sm += (v[4 * j] + v[4 * j + 1]) + (v[4 * j + 2] + v[4 * j + 3]); }
        const float mean = wave_sum(sm) * (1.0f / 1024.0f); float sq = 0.f;
#pragma unroll
        for (int i2 = 0; i2 < 16; ++i2) { v[i2] -= mean; sq += v[i2] * v[i2]; }
        const float rstd = 1.0f / sqrtf(wave_sum(sq) * (1.0f / 1024.0f) + LN_EPS);
        float* orow = (dummy ? dummy : p.out) + (size_t)tok[r] * 1024 + 4 * lane;
#pragma unroll
        for (int j = 0; j < 4; ++j) *(f32x4*)(orow + 256 * j) = (f32x4){v[4 * j] * rstd * g4[j].x + b4[j].x, v[4 * j + 1] * rstd * g4[j].y + b4[j].y, v[4 * j + 2] * rstd * g4[j].z + b4[j].z, v[4 * j + 3] * rstd * g4[j].w + b4[j].w};
    }
}
__global__ void __launch_bounds__(256) k_ln2(Params p) {
    __shared__ ClassTab tabs; if (threadIdx.x == 0) class_tab_fill(WSP(unsigned, WS_CTL) + CW_CNT, &tabs); __syncthreads(); const ClassTab* tab = &tabs;
    const int lane = threadIdx.x & 63; const int prow = blockIdx.x * 4 + (threadIdx.x >> 6);
    if (prow >= tab->rowbase[NCLS]) return;
    const int cls = find_class(tab, prow); const int i = prow - tab->rowbase[cls]; if (i >= tab->cnt[cls]) return;
    const int tk[1] = {WSP(int, WS_LIST)[(size_t)cls * T + i]}, pr[1] = {prow};
    ln2_rows<1>(p, tk, pr, lane);
}


#define LAS __attribute__((address_space(3)))
#define GAS __attribute__((address_space(1)))
constexpr int RING_OFF = 0, RING_BYTES = 131072;
constexpr int LCTL_OFF = RING_BYTES;
constexpr int LTOK_OFF = LCTL_OFF + 4096, MAXU = 16;
constexpr int LDS_BYTES = LTOK_OFF + MAXU * 1024;
constexpr int NTHR = 512, NWAVES = 8;

#ifndef FP6_DIAG
#define FP6_DIAG 1
#endif
#if FP6_DIAG & 1
#define FP6_PRE "s_nop 3\n\t"
#else
#define FP6_PRE
#endif
#define FP6_DIAG_V0 ((FP6_DIAG >> 1) & 1)
namespace pg8 {
typedef short bf16x8 __attribute__((ext_vector_type(8)));
typedef int v4i_t __attribute__((ext_vector_type(4)));
typedef int v8i_t __attribute__((ext_vector_type(8)));
typedef int v6i_t __attribute__((ext_vector_type(6)));
typedef int v2i_t __attribute__((ext_vector_type(2)));
constexpr int BM = 256, BK = 64, HALF = 128, HTB = HALF * BK * 2, NXCD = 8, WGM = 8;
__host__ __device__ __forceinline__ int lds_byte(int r, int c) { const int st = (r >> 4) * 2 + (c >> 5), rr = r & 15, cc = c & 31, ob = rr * 64 + cc * 2; return st * 1024 + (ob ^ (((ob >> 9) & 1) << 5)); }
__host__ __device__ __forceinline__ void stage_rc(int b, int& R, int& C) { const int st = b / 1024, sb = b % 1024, swz = sb ^ (((sb >> 9) & 1) << 5); R = (st >> 1) * 16 + swz / 64; C = (st & 1) * 32 + (swz % 64) / 2; }
__host__ __device__ __forceinline__ int perm32(int rho) { const int n = rho >> 4, i = rho & 15; return 8 * (i >> 2) + 4 * n + (i & 3); }

struct Unit { const char* A; const char* B; int row0, col0, bjump, aux; };
struct TileOrder {
    int nM, nN, nwg, G, c;
    __device__ __forceinline__ void init(int nM_, int nN_, int G_, int c_) { nM = nM_; nN = nN_; nwg = nM * nN; G = G_; c = c_; }
    __device__ __forceinline__ bool tile(int i, int& pm, int& pn) const {
        const long L = (long)i * G + c; if (L >= nwg) return false;
        int wgid = (int)L; { const int q = nwg / NXCD, r = nwg % NXCD, xcd = wgid % NXCD, off = wgid / NXCD; wgid = (xcd < r ? xcd * (q + 1) : r * (q + 1) + (xcd - r) * q) + off; }
        const int nig = WGM * nN, gid = wgid / nig, fm = gid * WGM, gsz = (nM - fm) < WGM ? (nM - fm) : WGM;
        pm = fm + ((wgid % nig) % gsz); pn = (wgid % nig) / gsz; return true;
    }
};
__device__ __forceinline__ unsigned cvt_pk_bf16(float lo, float hi) { unsigned r; asm volatile("v_cvt_pk_bf16_f32 %0, %1, %2" : "=v"(r) : "v"(lo), "v"(hi)); return r; }

template <class EF> struct EpiRows {
    static constexpr bool PERM = true, KEEPS = false;
    EF ef;
    __device__ __forceinline__ bool keep_acc(const Unit&) const { return false; }
    __device__ __forceinline__ void operator()(f32x4 (&acc)[2][2][4][2], const Unit& u, int wr, int wc, int fr, int fq) const {
#pragma unroll
        for (int ai = 0; ai < 2; ++ai)
#pragma unroll
            for (int m = 0; m < 4; ++m) { const int row = u.row0 + ai * HALF + wr * 64 + m * 16 + fr;
#pragma unroll
                for (int bj = 0; bj < 2; ++bj) { const int c0 = u.col0 + bj * HALF + wc * 32 + 8 * fq;
                    float v[8] = {acc[ai][bj][m][0][0], acc[ai][bj][m][0][1], acc[ai][bj][m][0][2], acc[ai][bj][m][0][3], acc[ai][bj][m][1][0], acc[ai][bj][m][1][1], acc[ai][bj][m][1][2], acc[ai][bj][m][1][3]};
                    ef(u, row, c0, v); }
                asm volatile("" ::: "memory"); }
    }
};

template <class Epi, class Sched, bool ALIGN_EPI, bool GATHER, bool BJUMP, int LOWP = 0>
__device__ __forceinline__ void gemm_phase(LAS unsigned char* lds, const char* Abase, int lda, int ldb, int K, const Sched& S, const Epi& E, int wave_s) {
    const int tid = opaque_tid(wave_s), wid = __builtin_amdgcn_readfirstlane(tid >> 6), lane = tid & 63, wr = wid >> 2, wc = wid & 3, fr = lane & 15, fq = lane >> 4;
    const int nt = K / BK;
    unsigned voffA[2], voffB[2]; unsigned voffG[2][2], nvoffG[2][2];
#pragma unroll
    for (int i = 0; i < 2; ++i) { int R, C; stage_rc(tid * 16 + i * 8192, R, C); const int Rb = Epi::PERM ? ((R & ~31) + perm32(R & 31)) : R;
        voffA[i] = (unsigned)(R * lda + C) * 2u; voffB[i] = (unsigned)(Rb * ldb + C) * 2u; voffG[0][i] = voffG[1][i] = nvoffG[0][i] = nvoffG[1][i] = 0u; }
    const size_t kstep = (size_t)(BK * 2);
    const size_t hstepA = (size_t)HALF * lda * 2, hstepB = (size_t)HALF * ldb * 2;
    const unsigned ldsw = (unsigned)wid * 1024u;
    const int aoff = lds_byte(wr * 64 + fr, fq * 8), boff = lds_byte(wc * 32 + fr, fq * 8);
#define PG8_SA(b, h) (((b) * 2 + (h)) * HTB)
#define PG8_SB(b, h) ((4 + (b) * 2 + (h)) * HTB)
#define PG8_GLDS(gptr, ldsoff) __builtin_amdgcn_global_load_lds((const unsigned*)(gptr), (LAS unsigned*)(lds + (ldsoff)), 16, 0, 0)
#define PG8_STAGE_B(bufoff, gbase) do { _Pragma("unroll") for (int _i = 0; _i < 2; ++_i) PG8_GLDS((const char*)(gbase) + voffB[_i], (bufoff) + ldsw + _i * 8192); } while (0)
#define PG8_STAGE_A(bufoff, kptr, h, nx) do { if constexpr (GATHER) { _Pragma("unroll") for (int _i = 0; _i < 2; ++_i) PG8_GLDS((const char*)(kptr) + ((nx) ? nvoffG[h][_i] : voffG[h][_i]), (bufoff) + ldsw + _i * 8192); } \
        else { _Pragma("unroll") for (int _i = 0; _i < 2; ++_i) PG8_GLDS((const char*)(kptr) + (h) * hstepA + voffA[_i], (bufoff) + ldsw + _i * 8192); } } while (0)
#define PG8_GATHER_OFFS(dst, ord) do { LAS const int* _tk = S.toks(ord); _Pragma("unroll") for (int _h = 0; _h < 2; ++_h) _Pragma("unroll") for (int _i = 0; _i < 2; ++_i) { int _R, _C; stage_rc(tid * 16 + _i * 8192, _R, _C); \
        dst[_h][_i] = (unsigned)_tk[_h * HALF + _R] * (unsigned)(lda * 2) + (unsigned)(_C * 2); } } while (0)
#define PG8_LD16(addr) (*(const LAS bf16x8*)(addr))
#define PG8_LD8(addr) __builtin_bit_cast(bf16x8, __builtin_shufflevector(*(const LAS v2i_t*)(addr), *(const LAS v2i_t*)(addr), 0, 1, -1, -1))
#define PG8_LDA(dst, b, h) do { _Pragma("unroll") for (int m = 0; m < 4; ++m) { dst[m][0] = PG8_LD16(lds + PG8_SA(b, h) + aoff + m * 2048); \
        if constexpr (LOWP == 2) dst[m][1] = PG8_LD8(lds + PG8_SA(b, h) + aoff + m * 2048 + 1024); else dst[m][1] = PG8_LD16(lds + PG8_SA(b, h) + aoff + m * 2048 + 1024); } } while (0)
#define PG8_LDB(dst, b, h) do { _Pragma("unroll") for (int n = 0; n < 2; ++n) { dst[n][0] = PG8_LD16(lds + PG8_SB(b, h) + boff + n * 2048); \
        if constexpr (LOWP == 2) dst[n][1] = PG8_LD8(lds + PG8_SB(b, h) + boff + n * 2048 + 1024); else dst[n][1] = PG8_LD16(lds + PG8_SB(b, h) + boff + n * 2048 + 1024); } } while (0)
#define PG8_CAT8(lo, hi) __builtin_shufflevector(__builtin_bit_cast(v4i_t, lo), __builtin_bit_cast(v4i_t, hi), 0, 1, 2, 3, 4, 5, 6, 7)
#define PG8_CAT6(lo, hi) __builtin_shufflevector(__builtin_bit_cast(v4i_t, lo), __builtin_bit_cast(v4i_t, hi), 0, 1, 2, 3, 4, 5)
#define PG8_MMA(ai, bj, At, Bt, Z) do { __builtin_amdgcn_s_setprio(1); if constexpr (LOWP == 1) { _Pragma("unroll") for (int m = 0; m < 4; ++m) _Pragma("unroll") for (int n = 0; n < 2; ++n) \
        { const v8i_t b8_ = PG8_CAT8(Bt[n][0], Bt[n][1]), a8_ = PG8_CAT8(At[m][0], At[m][1]); \
          if (Z) asm volatile("v_mfma_f32_16x16x128_f8f6f4 %0, %1, %2, 0" : "=v"(acc[ai][bj][m][n]) : "v"(b8_), "v"(a8_)); \
          else asm volatile("v_mfma_f32_16x16x128_f8f6f4 %0, %1, %2, %0" : "+v"(acc[ai][bj][m][n]) : "v"(b8_), "v"(a8_)); } } \
        else if constexpr (LOWP == 2) { _Pragma("unroll") for (int m = 0; m < 4; ++m) _Pragma("unroll") for (int n = 0; n < 2; ++n) \
        { const v6i_t b6_ = PG8_CAT6(Bt[n][0], Bt[n][1]), a6_ = PG8_CAT6(At[m][0], At[m][1]); if (Z) acc[ai][bj][m][n] = (f32x4){0.f, 0.f, 0.f, 0.f}; asm volatile(FP6_PRE "v_mfma_f32_16x16x128_f8f6f4 %0, %1, %2, %0 cbsz:2 blgp:2" : "+v"(acc[ai][bj][m][n]) : "v"(b6_), "v"(a6_)); } } \
        else { _Pragma("unroll") for (int m = 0; m < 4; ++m) _Pragma("unroll") for (int n = 0; n < 2; ++n) { \
        acc[ai][bj][m][n] = __builtin_amdgcn_mfma_f32_16x16x32_bf16(Bt[n][0], At[m][0], (Z) ? (f32x4){0.f, 0.f, 0.f, 0.f} : acc[ai][bj][m][n], 0, 0, 0); \
        acc[ai][bj][m][n] = __builtin_amdgcn_mfma_f32_16x16x32_bf16(Bt[n][1], At[m][1], acc[ai][bj][m][n], 0, 0, 0); } } __builtin_amdgcn_s_setprio(0); } while (0)
#define PG8_WAIT_V(n) do { if (LOWP == 2 && FP6_DIAG_V0) asm volatile("s_waitcnt vmcnt(0)" ::: "memory"); else asm volatile("s_waitcnt vmcnt(" #n ")" ::: "memory"); } while (0)
#define PG8_WAIT_L(n) asm volatile("s_waitcnt lgkmcnt(" #n ")" ::: "memory")
#define PG8_BAR __builtin_amdgcn_s_barrier()
#define PG8_SCHED __builtin_amdgcn_sched_barrier(0)
    Unit cur, nxt; int ui = 0;
    if (!S.next(0, cur)) return;
    constexpr bool ZRESET = Epi::KEEPS || LOWP != 1;
    f32x4 acc[2][2][4][2];
    if constexpr (ZRESET) {
#pragma unroll
        for (int a = 0; a < 2; ++a)
#pragma unroll
            for (int b = 0; b < 2; ++b)
#pragma unroll
                for (int m = 0; m < 4; ++m)
#pragma unroll
                    for (int n = 0; n < 2; ++n) acc[a][b][m][n] = (f32x4){0.f, 0.f, 0.f, 0.f}; }
    bf16x8 At[4][2], B0[2][2], B1[2][2];
    const char* cA = GATHER ? Abase : cur.A; const char* cB = cur.B;
    if constexpr (GATHER) PG8_GATHER_OFFS(voffG, 0);
    PG8_STAGE_B(PG8_SB(0, 0), cB); PG8_STAGE_B(PG8_SB(0, 1), cB + hstepB); PG8_STAGE_A(PG8_SA(0, 0), cA, 0, false); PG8_STAGE_A(PG8_SA(0, 1), cA, 1, false);
    if (wr == 1) PG8_BAR;
    PG8_WAIT_V(2); PG8_BAR;
    PG8_STAGE_B(PG8_SB(1, 0), cB + kstep); PG8_STAGE_A(PG8_SA(1, 0), cA + kstep, 0, false); PG8_STAGE_B(PG8_SB(1, 1), cB + hstepB + kstep);
    PG8_WAIT_V(6); PG8_BAR;
    for (;;) {
        const bool has_next = S.next(ui + 1, nxt);
        if constexpr (GATHER) { if (has_next) PG8_GATHER_OFFS(nvoffG, ui + 1); else {
#pragma unroll
            for (int h = 0; h < 2; ++h)
#pragma unroll
                for (int i = 0; i < 2; ++i) nvoffG[h][i] = voffG[h][i]; } }
        const char* nA = GATHER ? Abase : (has_next ? nxt.A : cA); const char* nB = has_next ? nxt.B : cB;
#define PG8_ITER(t, ZF) do { \
            const bool last = ((t) == nt - 2); \
            const char* a1 = cA + (size_t)((t) + 1) * kstep; \
            const char* a2 = last ? nA : cA + (size_t)((t) + 2) * kstep; \
            const char* b2 = last ? nB : cB + (size_t)((t) + 2) * kstep + ((BJUMP && ((t) + 2) >= (nt >> 1)) ? cur.bjump : 0); \
            const char* a3 = a2 + kstep; const char* b3 = b2 + kstep; \
              \
            PG8_LDB(B0, 0, 0); PG8_LDB(B1, 0, 1); PG8_SCHED; PG8_LDA(At, 0, 0); PG8_STAGE_A(PG8_SA(1, 1), a1, 1, false); \
            PG8_WAIT_V(8); PG8_WAIT_L(0); PG8_BAR; PG8_MMA(0, 0, At, B0, ZF); PG8_MMA(0, 1, At, B1, ZF); PG8_BAR; PG8_SCHED; \
              \
            PG8_LDA(At, 0, 1); PG8_STAGE_B(PG8_SB(0, 0), b2); PG8_STAGE_B(PG8_SB(0, 1), b2 + hstepB); PG8_STAGE_A(PG8_SA(0, 0), a2, 0, last); \
            PG8_WAIT_V(8); PG8_WAIT_L(0); PG8_BAR; PG8_MMA(1, 0, At, B0, ZF); PG8_MMA(1, 1, At, B1, ZF); PG8_BAR; PG8_SCHED; \
              \
            PG8_LDB(B0, 1, 0); PG8_LDB(B1, 1, 1); PG8_SCHED; PG8_LDA(At, 1, 0); PG8_STAGE_A(PG8_SA(0, 1), a2, 1, last); \
            PG8_WAIT_V(8); PG8_WAIT_L(0); PG8_BAR; PG8_MMA(0, 0, At, B0, false); PG8_MMA(0, 1, At, B1, false); PG8_BAR; PG8_SCHED; \
              \
            PG8_LDA(At, 1, 1); PG8_STAGE_B(PG8_SB(1, 0), b3); PG8_STAGE_B(PG8_SB(1, 1), b3 + hstepB); PG8_STAGE_A(PG8_SA(1, 0), a3, 0, last); \
            PG8_WAIT_V(8); PG8_WAIT_L(0); PG8_BAR; PG8_MMA(1, 0, At, B0, false); PG8_MMA(1, 1, At, B1, false); PG8_BAR; PG8_SCHED; \
        } while (0)
        if constexpr (ZRESET) {
#pragma nounroll
            for (int t = 0; t < nt; t += 2) PG8_ITER(t, false);
        } else {
            PG8_ITER(0, true);
#pragma nounroll
            for (int t = 2; t < nt; t += 2) PG8_ITER(t, false);
        }
#undef PG8_ITER
        if constexpr (ALIGN_EPI) { if (wr == 0) PG8_BAR; }
        if constexpr (LOWP != 0) { asm volatile("s_nop 15\n\ts_nop 15" ::: "memory"); PG8_SCHED; }
        E(acc, cur, wr, wc, fr, fq);
        if (!has_next) break;
        if constexpr (ZRESET) { if (!E.keep_acc(cur)) {
#pragma unroll
            for (int a = 0; a < 2; ++a)
#pragma unroll
                for (int b = 0; b < 2; ++b)
#pragma unroll
                    for (int m = 0; m < 4; ++m)
#pragma unroll
                        for (int n = 0; n < 2; ++n) acc[a][b][m][n] = (f32x4){0.f, 0.f, 0.f, 0.f}; } }
        cur = nxt; cA = nA; cB = nB; ++ui;
        if constexpr (GATHER) {
#pragma unroll
            for (int h = 0; h < 2; ++h)
#pragma unroll
                for (int i = 0; i < 2; ++i) voffG[h][i] = nvoffG[h][i]; }
        if constexpr (ALIGN_EPI) { if (wr == 1) PG8_BAR; }
    }
    PG8_WAIT_V(0);
    if constexpr (!ALIGN_EPI) { if (wr == 0) PG8_BAR; }
    PG8_BAR;
#undef PG8_SA
#undef PG8_SB
#undef PG8_GLDS
#undef PG8_STAGE_A
#undef PG8_STAGE_B
#undef PG8_GATHER_OFFS
#undef PG8_LDA
#undef PG8_LDB
#undef PG8_MMA
#undef PG8_CAT8
#undef PG8_CAT6
#undef PG8_LD16
#undef PG8_LD8
#undef PG8_WAIT_V
#undef PG8_WAIT_L
#undef PG8_BAR
#undef PG8_SCHED
}
}

namespace swa {
typedef short bf16x8 __attribute__((ext_vector_type(8)));
typedef short s16x4 __attribute__((ext_vector_type(4)));
typedef float f32x16 __attribute__((ext_vector_type(16)));
constexpr int DH = 128, NW = 8, QBLK = 32, KVBLK = 64, QB = NW * QBLK;
constexpr int SHM_V = KVBLK * DH * 2, SHM_K = KVBLK * DH * 2;
constexpr int LDS_NEED = 2 * SHM_V + 2 * SHM_K + NW * 64 * 4;
constexpr float SCALE = 0.08838834764831845f, THR = 8.f;
#define KSWZ(row, colB) ((row) * 256 + ((colB) ^ (((row) & 7) << 4)))
#define SBAR() __builtin_amdgcn_sched_barrier(0)
__device__ __forceinline__ int v_st(int k, int c) { const int kk = (k & ~0xC) | ((k & 4) << 1) | ((k & 8) >> 1); return ((kk >> 3) * 4 + (c >> 5)) * 512 + ((kk & 7) * 32 + (c & 31)) * 2; }
__device__ __forceinline__ int v_rd_base(int lane) { return ((lane & 3) << 3) | (((lane >> 2) & 3) << 6) | (((lane >> 4) & 1) << 5) | (((lane >> 5) & 1) << 8); }
constexpr int v_rd_off(int d0, int ks, int half) { return d0 * 512 + ks * 4096 + half * 2048; }
__device__ __forceinline__ int crow(int r, int hi) { return (r & 3) + 8 * (r >> 2) + 4 * hi; }
__device__ __forceinline__ unsigned cvtpk(float lo, float hi) { unsigned r; asm volatile("v_cvt_pk_bf16_f32 %0, %1, %2" : "=v"(r) : "v"(lo), "v"(hi)); return r; }
__device__ __forceinline__ bf16x8 load8(const bf16_t* p) { return *reinterpret_cast<const bf16x8*>(p); }
__device__ __forceinline__ void mask_tile(f32x16& p0, f32x16& p1, int dq, unsigned W) {
    const float NEG = -__builtin_inff();
#pragma unroll
    for (int r = 0; r < 16; ++r) {
        const int c = (r & 3) + 8 * (r >> 2);
        if ((unsigned)(dq - c) >= W) p0[r] = NEG;
        if ((unsigned)(dq - c - 32) >= W) p1[r] = NEG;
    }
}
__device__ __forceinline__ void partialSM(f32x16& p0, f32x16& p1, float& m_reg, float& mn, float& alpha) {
    float pmax = p0[0]; for (int r = 1; r < 16; ++r) pmax = fmaxf(pmax, p0[r]); for (int r = 0; r < 16; ++r) pmax = fmaxf(pmax, p1[r]);
    { auto rr = __builtin_amdgcn_permlane32_swap(__float_as_uint(pmax), __float_as_uint(pmax), false, false);
      pmax = fmaxf(__uint_as_float(rr[0]), __uint_as_float(rr[1])); }
    constexpr float C2 = 1.4426950408889634f * SCALE;
    if (__builtin_expect(__all((pmax - m_reg) * SCALE <= THR), 1)) { mn = m_reg; alpha = 1.f; }
    else { mn = fmaxf(m_reg, pmax); alpha = __builtin_amdgcn_exp2f((m_reg - mn) * C2); m_reg = mn; }
    const float mnL = -mn * C2;
    for (int r = 0; r < 16; ++r) p0[r] = fmaf(p0[r], C2, mnL); for (int r = 0; r < 16; ++r) p1[r] = fmaf(p1[r], C2, mnL);
    for (int r = 0; r < 16; ++r) p0[r] = __builtin_amdgcn_exp2f(p0[r]);
}
__device__ __forceinline__ void finishSM(f32x16& p0, f32x16& p1, float alpha, float& l_reg, bf16x8& pa0, bf16x8& pa1, bf16x8& pa2, bf16x8& pa3) {
    for (int r = 0; r < 16; ++r) p1[r] = __builtin_amdgcn_exp2f(p1[r]);
    float ps = 0; for (int r = 0; r < 16; ++r) ps += p0[r]; for (int r = 0; r < 16; ++r) ps += p1[r];
    { auto rr = __builtin_amdgcn_permlane32_swap(__float_as_uint(ps), __float_as_uint(ps), false, false);
      ps = __uint_as_float(rr[0]) + __uint_as_float(rr[1]); }
    l_reg = l_reg * alpha + ps;
#define PK4(P, B_, OUT) do { unsigned a0 = cvtpk(P[B_+0], P[B_+1]), a1 = cvtpk(P[B_+2], P[B_+3]);                          \
        unsigned b0 = cvtpk(P[B_+4], P[B_+5]), b1 = cvtpk(P[B_+6], P[B_+7]);                                             \
        auto r0 = __builtin_amdgcn_permlane32_swap(a0, b0, false, false); auto r1 = __builtin_amdgcn_permlane32_swap(a1, b1, false, false); \
        u32x4 w = {r0[0], r1[0], r0[1], r1[1]}; OUT = *reinterpret_cast<bf16x8*>(&w); } while (0)
    PK4(p0, 0, pa0); PK4(p0, 8, pa1); PK4(p1, 0, pa2); PK4(p1, 8, pa3);
#undef PK4
}
template <int KB>
__device__ __forceinline__ void qkt(f32x16& p0, f32x16& p1, const char* K_lds, int r32, int hi, const bf16x8* qr, bool act) {
    if (!act) { const float NEG = -__builtin_inff();
#pragma unroll
        for (int r = 0; r < 16; ++r) { p0[r] = NEG; p1[r] = NEG; } return; }
    p0 = f32x16{}; p1 = f32x16{};
    const char* kb[4];
#pragma unroll
    for (int dd = 0; dd < 4; ++dd) kb[dd] = K_lds + KB * SHM_K + KSWZ(r32, (dd * 16 + hi * 8) * 2);
#pragma unroll
    for (int d0 = 0; d0 < 8; ++d0) { const char* a = kb[d0 & 3] + (d0 >> 2) * 128;
        bf16x8 b0 = *reinterpret_cast<const bf16x8*>(a);
        bf16x8 b1 = *reinterpret_cast<const bf16x8*>(a + 32 * 256);
        p0 = __builtin_amdgcn_mfma_f32_32x32x16_bf16(b0, qr[d0], p0, 0, 0, 0);
        p1 = __builtin_amdgcn_mfma_f32_32x32x16_bf16(b1, qr[d0], p1, 0, 0, 0); }
}
template <int VB>
__device__ __forceinline__ void pv_tile(f32x16* o, int vb0, bf16x8 pa0, bf16x8 pa1, bf16x8 pa2, bf16x8 pa3, bool act) {
    if (!act) return;
#define TRRD(dst, off) asm volatile("ds_read_b64_tr_b16 %0, %1 offset:%2" : "=&v"(dst) : "v"(vb0), "i"(off) : "memory")
#define PV_D0(d0) do { s16x4 l0, l1, l2, l3, h0, h1, h2, h3; constexpr int b_ = VB * SHM_V + v_rd_off(d0, 0, 0); \
        TRRD(l0, b_); TRRD(h0, b_ + 2048); TRRD(l1, b_ + 4096); TRRD(h1, b_ + 6144); TRRD(l2, b_ + 8192); TRRD(h2, b_ + 10240); TRRD(l3, b_ + 12288); TRRD(h3, b_ + 14336); \
        asm volatile("s_waitcnt lgkmcnt(0)" ::: "memory"); SBAR();   \
        o[d0] = __builtin_amdgcn_mfma_f32_32x32x16_bf16(pa0, (bf16x8){l0[0], l0[1], l0[2], l0[3], h0[0], h0[1], h0[2], h0[3]}, o[d0], 0, 0, 0);   \
        o[d0] = __builtin_amdgcn_mfma_f32_32x32x16_bf16(pa1, (bf16x8){l1[0], l1[1], l1[2], l1[3], h1[0], h1[1], h1[2], h1[3]}, o[d0], 0, 0, 0);   \
        o[d0] = __builtin_amdgcn_mfma_f32_32x32x16_bf16(pa2, (bf16x8){l2[0], l2[1], l2[2], l2[3], h2[0], h2[1], h2[2], h2[3]}, o[d0], 0, 0, 0);   \
        o[d0] = __builtin_amdgcn_mfma_f32_32x32x16_bf16(pa3, (bf16x8){l3[0], l3[1], l3[2], l3[3], h3[0], h3[1], h3[2], h3[3]}, o[d0], 0, 0, 0); } while (0)
    PV_D0(0); PV_D0(1); PV_D0(2); PV_D0(3);
#undef PV_D0
#undef TRRD
}
struct BlockRef { const bf16_t* Q; const bf16_t* K; const bf16_t* V; bf16_t* O; float* LSE; int P0, W, segmask, skv, ostride; };
struct Seam { bf16x8 qr[8]; bf16x8 st_v0, st_v1, st_k0, st_k1; };
__device__ __forceinline__ int imax(int a, int b) { return a > b ? a : b; }
__device__ __forceinline__ int blk_jlo(const BlockRef& b) { const int lowk = imax(b.P0 - b.W + 1, b.P0 & ~b.segmask); return lowk > 0 ? lowk / KVBLK : 0; }
#define ROW(p, k0, rr) ((p) + (size_t)((k0) + (rr)) * DH + sc)
#define VMW() asm volatile("s_waitcnt vmcnt(0)" ::: "memory")
#define VMWN(n) asm volatile("s_waitcnt vmcnt(%0)" :: "i"(n) : "memory")
#define SLOAD_H(Kp, Vp, k0) do { S.st_v0 = load8(ROW(Vp, k0, sr)); S.st_v1 = load8(ROW(Vp, k0, 32 + sr));              \
                         S.st_k0 = load8(ROW(Kp, k0, sr)); S.st_k1 = load8(ROW(Kp, k0, 32 + sr)); } while (0)
#define SWRITE_HK(bf) do { *(bf16x8*)(K_lds + (bf) * SHM_K + kws) = S.st_k0; *(bf16x8*)(K_lds + (bf) * SHM_K + kws + 32 * 256) = S.st_k1; } while (0)
#define SWRITE_HV(bf) do { *(bf16x8*)(V_lds + (bf) * SHM_V + vst0) = S.st_v0; *(bf16x8*)(V_lds + (bf) * SHM_V + vst1) = S.st_v1; } while (0)
#define SWRITE_H(bf) do { SWRITE_HV(bf); SWRITE_HK(bf); } while (0)
__device__ __forceinline__ void prime(const BlockRef& cur, char* lds, Seam& S, int wave_s) {
    const int tid = opaque_tid(wave_s), wid = __builtin_amdgcn_readfirstlane(tid >> 6), lane = tid & 63, r32 = lane & 31, hi = lane >> 5;
    const int sr = tid >> 4, sc = (tid & 15) * 8, kws = KSWZ(sr, sc * 2); char* K_lds = lds + 2 * SHM_V;
    const int kb0 = blk_jlo(cur) * KVBLK;
    for (int d0 = 0; d0 < 8; ++d0) S.qr[d0] = load8(cur.Q + (size_t)(wid * QBLK + r32) * DH + d0 * 16 + hi * 8);
    SLOAD_H(cur.K, cur.V, kb0); VMW(); SWRITE_HK(0);
    __syncthreads();
}
__device__ __forceinline__ void block(const BlockRef& cur, const BlockRef& nxt, char* lds, Seam& S, int wave_s) {
    const int tid = opaque_tid(wave_s), wid = __builtin_amdgcn_readfirstlane(tid >> 6), lane = tid & 63, r32 = lane & 31, hi = lane >> 5;
    const int W = cur.W;
    const int j_lo = blk_jlo(cur);
    int j_hi = (cur.P0 + QB - 1) / KVBLK + 1; if (j_hi > cur.skv / KVBLK) j_hi = cur.skv / KVBLK;
    const int NT = j_hi - j_lo;
    const int kbn = blk_jlo(nxt) * KVBLK;
    const int qlo = cur.P0 + wid * QBLK, qm = qlo + r32 - 4 * hi;
    const int segb = qlo & ~cur.segmask;
    const int lowk_w = imax(qlo - W + 1, segb);
    const int lowk_last = imax(qlo + QBLK - W, segb);
    const int wrow = ((qlo + r32) & cur.segmask) + 1;
    const unsigned Wl = (unsigned)(wrow < W ? wrow : W);
    char* V_lds = lds; char* K_lds = lds + 2 * SHM_V;
    float* ws = (float*)(lds + 2 * SHM_V + 2 * SHM_K) + wid * 64; float* li_l = ws, * al_l = ws + 32;
    float m_reg = -1e30f, l_reg = 0; f32x16 o[4] = {};
    const int sr = tid >> 4, sc = (tid & 15) * 8, vst0 = v_st(sr, sc), vst1 = v_st(32 + sr, sc), kws = KSWZ(sr, sc * 2);
    const int vb0 = (int)(uintptr_t)V_lds + v_rd_base(lane);
    const bf16_t* Kh = cur.K; const bf16_t* Vh = cur.V;
#define RESC(a) do { if (__any((a) < 1.f)) { if (hi == 0) al_l[r32] = (a); asm volatile("s_waitcnt lgkmcnt(0)" ::: "memory");              \
                     for (int d_ = 0; d_ < 4; ++d_) for (int r = 0; r < 16; ++r) o[d_][r] *= al_l[crow(r, hi)]; } } while (0)
#define KBASE(t) ((j_lo + (t)) * KVBLK)
#define ACT(t) (KBASE(t) <= qlo + QBLK - 1 && KBASE(t) + KVBLK - 1 >= lowk_w)
#define MASKT(P0_, P1_, t) do { const int kb_ = KBASE(t); if (ACT(t) && (kb_ + KVBLK - 1 > qlo || kb_ < lowk_last)) mask_tile(P0_, P1_, qm - kb_, Wl); } while (0)
    constexpr int NQL = 8;
#define SEAM_K0() do { VMWN(NQL); SWRITE_HK(0); SBAR(); } while (0)
    f32x16 pA0, pA1, pB0, pB1; float mnA, mnB, alA, alB; bf16x8 pa0, pa1, pa2, pa3;
    SWRITE_HV(0); SBAR();
    if (NT > 1) { SLOAD_H(Kh, Vh, KBASE(1)); }
    SBAR(); qkt<0>(pA0, pA1, K_lds, r32, hi, S.qr, ACT(0));
    MASKT(pA0, pA1, 0); partialSM(pA0, pA1, m_reg, mnA, alA);
    if (NT > 1) { VMW(); SWRITE_H(1); }
    __syncthreads();
#define HALF_STEP(PX0, PX1, mnX, alX, PY0, PY1, alY, t, KB, VB, SB) do {                                                      \
        SBAR(); if ((t) + 1 < NT) { SLOAD_H(Kh, Vh, KBASE((t) + 1)); SBAR(); }                                       \
        qkt<KB>(PX0, PX1, K_lds, r32, hi, S.qr, ACT(t));                                             \
        finishSM(PY0, PY1, alY, l_reg, pa0, pa1, pa2, pa3); SBAR();                                                           \
        pv_tile<VB>(o, vb0, pa0, pa1, pa2, pa3, ACT((t) - 1)); MASKT(PX0, PX1, (t)); partialSM(PX0, PX1, m_reg, mnX, alX);                                        \
        __syncthreads();                                                                                                      \
        if ((t) + 1 < NT) { VMW(); SWRITE_H(SB); }                                                                          \
        RESC(alX); __syncthreads(); } while (0)
    for (int t = 1; t + 1 < NT; t += 2) {
        HALF_STEP(pB0, pB1, mnB, alB, pA0, pA1, alA, t, 1, 0, 0);
        HALF_STEP(pA0, pA1, mnA, alA, pB0, pB1, alB, t + 1, 0, 1, 1);
    }
    const bool even = (NT & 1) == 0;
    if (even) { SBAR(); qkt<1>(pB0, pB1, K_lds, r32, hi, S.qr, ACT(NT - 1)); SBAR(); }
    SLOAD_H(nxt.K, nxt.V, kbn); SBAR();
#pragma unroll
    for (int d0 = 0; d0 < 8; ++d0) S.qr[d0] = load8(nxt.Q + (size_t)(wid * QBLK + r32) * DH + d0 * 16 + hi * 8);
    SBAR();
    finishSM(pA0, pA1, alA, l_reg, pa0, pa1, pa2, pa3); SBAR();
    pv_tile<0>(o, vb0, pa0, pa1, pa2, pa3, ACT(even ? NT - 2 : NT - 1));
    if (even) { MASKT(pB0, pB1, NT - 1); partialSM(pB0, pB1, m_reg, mnB, alB); __syncthreads(); RESC(alB);
        finishSM(pB0, pB1, alB, l_reg, pa0, pa1, pa2, pa3); SBAR(); pv_tile<1>(o, vb0, pa0, pa1, pa2, pa3, ACT(NT - 1)); }
    SBAR(); SEAM_K0();
    if (hi == 0) li_l[r32] = l_reg; asm volatile("s_waitcnt lgkmcnt(0)" ::: "memory");
    if (cur.LSE != nullptr && hi == 0) cur.LSE[wid * QBLK + r32] = m_reg * SCALE + __logf(l_reg);
    float rli[16];
#pragma unroll
    for (int r = 0; r < 16; ++r) rli[r] = __builtin_amdgcn_rcpf(li_l[crow(r, hi)]);
    bf16_t* Ow = cur.O + (size_t)(wid * QBLK) * cur.ostride;
#pragma unroll
    for (int r = 0; r < 16; ++r) { const int orow = crow(r, hi);
#pragma unroll
        for (int d0 = 0; d0 < 4; ++d0) { const float v = o[d0][r] * rli[r];
            const float vn = __shfl_xor(v, 1);
            if ((r32 & 1) == 0) *(unsigned*)(Ow + (size_t)orow * cur.ostride + d0 * 32 + r32) = cvtpk(v, vn); } }
    __syncthreads();
#undef RESC
#undef KBASE
#undef ACT
#undef MASKT
#undef SEAM_K0
#undef HALF_STEP
}

constexpr int RING_V = 4 * SHM_K;
__device__ __forceinline__ void qkt_rt(f32x16& p0, f32x16& p1, const LAS char* Kslot, int r32, int hi, const bf16x8* qr) {
    p0 = f32x16{}; p1 = f32x16{};
    const LAS char* kb[4];
#pragma unroll
    for (int dd = 0; dd < 4; ++dd) kb[dd] = Kslot + KSWZ(r32, (dd * 16 + hi * 8) * 2);
#pragma unroll
    for (int d0 = 0; d0 < 8; ++d0) { const LAS char* a = kb[d0 & 3] + (d0 >> 2) * 128;
        bf16x8 b0 = *(const LAS bf16x8*)(a);
        bf16x8 b1 = *(const LAS bf16x8*)(a + 32 * 256);
        p0 = __builtin_amdgcn_mfma_f32_32x32x16_bf16(b0, qr[d0], p0, 0, 0, 0);
        p1 = __builtin_amdgcn_mfma_f32_32x32x16_bf16(b1, qr[d0], p1, 0, 0, 0); }
}
__device__ __forceinline__ void pv_rt(f32x16* o, int vb, bf16x8 pa0, bf16x8 pa1, bf16x8 pa2, bf16x8 pa3) {
#define TRRD(dst, off) asm volatile("ds_read_b64_tr_b16 %0, %1 offset:%2" : "=&v"(dst) : "v"(vb), "i"(off) : "memory")
#define PV_D0(d0) do { s16x4 l0, l1, l2, l3, h0, h1, h2, h3; constexpr int b_ = v_rd_off(d0, 0, 0); \
        TRRD(l0, b_); TRRD(h0, b_ + 2048); TRRD(l1, b_ + 4096); TRRD(h1, b_ + 6144); TRRD(l2, b_ + 8192); TRRD(h2, b_ + 10240); TRRD(l3, b_ + 12288); TRRD(h3, b_ + 14336); \
        asm volatile("s_waitcnt lgkmcnt(0)" ::: "memory"); SBAR();   \
        o[d0] = __builtin_amdgcn_mfma_f32_32x32x16_bf16((bf16x8){l0[0], l0[1], l0[2], l0[3], h0[0], h0[1], h0[2], h0[3]}, pa0, o[d0], 0, 0, 0);   \
        o[d0] = __builtin_amdgcn_mfma_f32_32x32x16_bf16((bf16x8){l1[0], l1[1], l1[2], l1[3], h1[0], h1[1], h1[2], h1[3]}, pa1, o[d0], 0, 0, 0);   \
        o[d0] = __builtin_amdgcn_mfma_f32_32x32x16_bf16((bf16x8){l2[0], l2[1], l2[2], l2[3], h2[0], h2[1], h2[2], h2[3]}, pa2, o[d0], 0, 0, 0);   \
        o[d0] = __builtin_amdgcn_mfma_f32_32x32x16_bf16((bf16x8){l3[0], l3[1], l3[2], l3[3], h3[0], h3[1], h3[2], h3[3]}, pa3, o[d0], 0, 0, 0); } while (0)
    PV_D0(0); PV_D0(1); PV_D0(2); PV_D0(3);
#undef PV_D0
#undef TRRD
}
struct WaveState { float m, l; f32x16 o[4]; };
__device__ __forceinline__ void tile_step(WaveState& st, const bf16x8* qr, const LAS char* lds, int slot, int r32, int hi, int lane, bool need_mask, int dq, unsigned Wl) {
    f32x16 p0, p1; float mn, alpha; bf16x8 pa0, pa1, pa2, pa3;
    qkt_rt(p0, p1, lds + slot * SHM_K, r32, hi, qr);
    if (need_mask) mask_tile(p0, p1, dq, Wl);
    partialSM(p0, p1, st.m, mn, alpha);
    if (__any(alpha < 1.f)) {
#pragma unroll
        for (int d_ = 0; d_ < 4; ++d_)
#pragma unroll
            for (int r = 0; r < 16; ++r) st.o[d_][r] *= alpha; }
    finishSM(p0, p1, alpha, st.l, pa0, pa1, pa2, pa3); SBAR();
    pv_rt(st.o, (int)(unsigned)(uintptr_t)(lds + RING_V + slot * SHM_V) + v_rd_base(lane), pa0, pa1, pa2, pa3);
}
__device__ __forceinline__ void wave_store(const WaveState& st, bf16_t* Ow, int ostride, float* lse, int r32, int hi) {
    if (lse != nullptr && hi == 0) lse[r32] = st.m * SCALE + __logf(st.l);
    const float rl = __builtin_amdgcn_rcpf(st.l);
    bf16_t* rowp = Ow + (size_t)r32 * ostride + hi * 8;
#pragma unroll
    for (int d0 = 0; d0 < 4; ++d0)
#pragma unroll
        for (int k = 0; k < 4; k += 2) {
            unsigned ax = cvtpk(st.o[d0][4 * k] * rl, st.o[d0][4 * k + 1] * rl), ay = cvtpk(st.o[d0][4 * k + 2] * rl, st.o[d0][4 * k + 3] * rl);
            unsigned bx = cvtpk(st.o[d0][4 * k + 4] * rl, st.o[d0][4 * k + 5] * rl), by = cvtpk(st.o[d0][4 * k + 6] * rl, st.o[d0][4 * k + 7] * rl);
            { auto r = __builtin_amdgcn_permlane32_swap(ax, bx, false, false); ax = r[0]; bx = r[1]; }
            { auto r = __builtin_amdgcn_permlane32_swap(ay, by, false, false); ay = r[0]; by = r[1]; }
            *(u32x4*)(rowp + d0 * 32 + 8 * k) = (u32x4){ax, ay, bx, by};
        }
}
__device__ __forceinline__ void wave_store8(const WaveState& st, unsigned char* Ow, int ostride, int r32, int hi, float* lse = nullptr) {
    if (lse != nullptr && hi == 0) lse[r32] = st.m * SCALE + __logf(st.l);
    const float rl = O8_SCALE * __builtin_amdgcn_rcpf(st.l);
    unsigned char* rowp = Ow + (size_t)r32 * ostride + hi * 8;
#pragma unroll
    for (int d0 = 0; d0 < 4; ++d0)
#pragma unroll
        for (int k = 0; k < 4; k += 2) {
            unsigned a = pk4_fp8(st.o[d0][4 * k] * rl, st.o[d0][4 * k + 1] * rl, st.o[d0][4 * k + 2] * rl, st.o[d0][4 * k + 3] * rl);
            unsigned b = pk4_fp8(st.o[d0][4 * k + 4] * rl, st.o[d0][4 * k + 5] * rl, st.o[d0][4 * k + 6] * rl, st.o[d0][4 * k + 7] * rl);
            { auto r = __builtin_amdgcn_permlane32_swap(a, b, false, false); a = r[0]; b = r[1]; }
            *(u32x2*)(rowp + d0 * 32 + 8 * k) = (u32x2){a, b};
        }
}
__device__ __forceinline__ void wave_reset(WaveState& st) { st.m = -1e30f; st.l = 0.f;
#pragma unroll
    for (int d = 0; d < 4; ++d) st.o[d] = f32x16{}; }
#define HS_LOADQ(qr, Qrow0) do { _Pragma("unroll") for (int d0 = 0; d0 < 8; ++d0) qr[d0] = load8((Qrow0) + (size_t)(wid * QBLK + r32) * DH + d0 * 16 + hi * 8); } while (0)
#define HS_SLOAD(Kp, Vp, k0) do { st_v0 = load8(ROW(Vp, k0, sr)); st_v1 = load8(ROW(Vp, k0, 32 + sr)); st_k0 = load8(ROW(Kp, k0, sr)); st_k1 = load8(ROW(Kp, k0, 32 + sr)); } while (0)
#define HS_SWRITE(slot) do { *(LAS bf16x8*)(lds + (slot) * SHM_K + kws) = st_k0; *(LAS bf16x8*)(lds + (slot) * SHM_K + kws + 32 * 256) = st_k1; \
                             *(LAS bf16x8*)(lds + RING_V + (slot) * SHM_V + vst0) = st_v0; *(LAS bf16x8*)(lds + RING_V + (slot) * SHM_V + vst1) = st_v1; } while (0)
__device__ __forceinline__ bf16x8 fp8x8_to_bf16(u32x2 w) {
    const auto a = __builtin_amdgcn_cvt_pk_f32_fp8(w.x, false), b = __builtin_amdgcn_cvt_pk_f32_fp8(w.x, true), c = __builtin_amdgcn_cvt_pk_f32_fp8(w.y, false), d = __builtin_amdgcn_cvt_pk_f32_fp8(w.y, true);
    u32x4 o = {pk2(a[0], a[1]), pk2(b[0], b[1]), pk2(c[0], c[1]), pk2(d[0], d[1])}; return *reinterpret_cast<bf16x8*>(&o);
}
#define ROW8(p, k0, rr) ((const unsigned char*)(p) + (size_t)((k0) + (rr)) * (DH * 2) + sc)
#define HS_LOADQ8(Qrow0) do { _Pragma("unroll") for (int d0 = 0; d0 < 8; ++d0) qraw[d0] = *(const u32x2*)((const unsigned char*)(Qrow0) + (size_t)(wid * QBLK + r32) * (DH * 2) + d0 * 16 + hi * 8); } while (0)
#define HS_CVTQ() do { _Pragma("unroll") for (int d0 = 0; d0 < 8; ++d0) qr[d0] = fp8x8_to_bf16(qraw[d0]); } while (0)
#define HS_SLOAD8(Kp, Vp, k0) do { s8_v0 = *(const u32x2*)ROW8(Vp, k0, sr); s8_v1 = *(const u32x2*)ROW8(Vp, k0, 32 + sr); s8_k0 = *(const u32x2*)ROW8(Kp, k0, sr); s8_k1 = *(const u32x2*)ROW8(Kp, k0, 32 + sr); } while (0)
#define HS_SWRITE8(slot) do { *(LAS bf16x8*)(lds + (slot) * SHM_K + kws) = fp8x8_to_bf16(s8_k0); *(LAS bf16x8*)(lds + (slot) * SHM_K + kws + 32 * 256) = fp8x8_to_bf16(s8_k1); \
                              *(LAS bf16x8*)(lds + RING_V + (slot) * SHM_V + vst0) = fp8x8_to_bf16(s8_v0); *(LAS bf16x8*)(lds + RING_V + (slot) * SHM_V + vst1) = fp8x8_to_bf16(s8_v1); } while (0)
__device__ __forceinline__ void head_dilated(const bf16_t* Q, bf16_t* O, const bf16_t* K, const bf16_t* V, float* LSE, int segmask, LAS char* lds, LAS float* scr, int wave_s) {
    const int tid = opaque_tid(wave_s), wid = __builtin_amdgcn_readfirstlane(tid >> 6), lane = tid & 63, r32 = lane & 31, hi = lane >> 5, pair = wid >> 1;
    const int sr = tid >> 4, sc = (tid & 15) * 8, vst0 = v_st(sr, sc), vst1 = v_st(32 + sr, sc), kws = KSWZ(sr, sc * 2);
    constexpr int NT = 2048 / KVBLK, W = 129;
#if QKV_FP8
    u32x2 s8_v0, s8_v1, s8_k0, s8_k1, qraw[8]; bf16x8 qr[8]; WaveState st; wave_reset(st);
    HS_SLOAD8(K, V, 0); HS_LOADQ8(Q); VMW(); HS_SWRITE8(0); HS_CVTQ(); SBAR();
    HS_SLOAD8(K, V, KVBLK); VMW(); HS_SWRITE8(1);
#else
    bf16x8 st_v0, st_v1, st_k0, st_k1; bf16x8 qr[8]; WaveState st; wave_reset(st);
    HS_SLOAD(K, V, 0); HS_LOADQ(qr, Q); VMW(); HS_SWRITE(0); SBAR();
    HS_SLOAD(K, V, KVBLK); VMW(); HS_SWRITE(1);
#endif
    __syncthreads();
#if QKV_FP8
#pragma unroll 4
#endif
    for (int g = 1; g <= NT; ++g) {
        const bool ld = g + 1 < NT;
#if QKV_FP8
        if (ld) { HS_SLOAD8(K, V, (g + 1) * KVBLK); SBAR(); }
#else
        if (ld) { HS_SLOAD(K, V, (g + 1) * KVBLK); SBAR(); }
#endif
        const int ph = (g - 1) & 3, qb = (g - 1) >> 2;
#if QKV_FP8
        if (ph == 0 && g > 1) HS_CVTQ();
#endif
        if (ph != 3) {
            const int T = g - 3 + pair, qlo = qb * QB + wid * QBLK, segb = qlo & ~segmask;
            const int lowk_w = imax(qlo - W + 1, segb), lowk_last = imax(qlo + QBLK - W, segb), kb_ = T * KVBLK;
            if (T >= 0 && kb_ <= qlo + QBLK - 1 && kb_ + KVBLK - 1 >= lowk_w) {
                const int wrow = ((qlo + r32) & segmask) + 1;
                tile_step(st, qr, lds, T & 3, r32, hi, lane, (kb_ + KVBLK - 1 > qlo) || (kb_ < lowk_last), qlo + r32 - 4 * hi - kb_, (unsigned)(wrow < W ? wrow : W));
            }
#if QKV_FP8
            if (ph == 2 && qb + 1 < 2048 / QB) { SBAR(); HS_LOADQ8(Q + (size_t)(qb + 1) * QB * DH); }
#else
            if (ph == 2 && qb + 1 < 2048 / QB) { SBAR(); HS_LOADQ(qr, Q + (size_t)(qb + 1) * QB * DH); }
#endif
        } else {
#if O_FP8 && P4_FP8
            wave_store8(st, (unsigned char*)(O + (size_t)(qb * QB + wid * QBLK) * DH), 2 * DH, r32, hi, LSE + qb * QB + wid * QBLK);
#else
            wave_store(st, O + (size_t)(qb * QB + wid * QBLK) * DH, DH, LSE + qb * QB + wid * QBLK, r32, hi);
#endif
            wave_reset(st);
        }
        __syncthreads();
#if QKV_FP8
        if (ld) { HS_SWRITE8((g + 1) & 3); }
#else
        if (ld) { HS_SWRITE((g + 1) & 3); }
#endif
        __syncthreads();
    }
}
__device__ __forceinline__ void head_mem(const bf16_t* Q, const bf16_t* K, const bf16_t* V, bf16_t* O, int ostride, LAS char* lds, LAS float* scr, int wave_s) {
    const int tid = opaque_tid(wave_s), wid = __builtin_amdgcn_readfirstlane(tid >> 6), lane = tid & 63, r32 = lane & 31, hi = lane >> 5, pair = wid >> 1;
    const int sr = tid >> 4, sc = (tid & 15) * 8, vst0 = v_st(sr, sc), vst1 = v_st(32 + sr, sc), kws = KSWZ(sr, sc * 2);
    bf16x8 st_v0, st_v1, st_k0, st_k1; bf16x8 qr[8]; WaveState st;
#pragma unroll
    for (int t = 0; t < 4; ++t) { HS_SLOAD(K, V, t * KVBLK); VMW(); HS_SWRITE(t); SBAR(); }
    __syncthreads();
    for (int qb = 0; qb < 2048 / QB; ++qb) {
#if CQ_FP8
        { u32x2 qraw[8]; HS_LOADQ8(Q + (size_t)qb * QB * DH); HS_CVTQ(); } wave_reset(st);
#else
        HS_LOADQ(qr, Q + (size_t)qb * QB * DH); wave_reset(st);
#endif
        for (int t = 0; t < 4; ++t) tile_step(st, qr, lds, (t + pair) & 3, r32, hi, lane, false, 0, 0u);
#if P4_FP8
        wave_store8(st, (unsigned char*)O + (size_t)(qb * QB + wid * QBLK) * ostride, ostride, r32, hi);
#else
        wave_store(st, O + (size_t)(qb * QB + wid * QBLK) * ostride, ostride, nullptr, r32, hi);
#endif
    }
    __syncthreads();
}
#undef HS_LOADQ
#undef HS_LOADQ8
#undef HS_CVTQ
#undef HS_SLOAD8
#undef HS_SWRITE8
#undef ROW8
#undef HS_SLOAD
#undef HS_SWRITE
#undef ROW
#undef VMW
#undef VMWN
#undef SLOAD_H
#undef SWRITE_HK
#undef SWRITE_HV
#undef SWRITE_H
#undef KSWZ
#undef SBAR
}

#define XB_TMO      128
#define XB_XCNT(j)  (256  + 64 * (j))
#define XB_XSUB(j)  (1280 + 64 * (j))
#define XB_XGEN(j)  (2304 + 64 * (j))
#define XB_TOP      3328
#define XB_TOPGEN   3392
#define XCD_BAR_WORDS 3456
#define XB_SPIN_CAP (1u << 18)
__device__ __forceinline__ unsigned xb_ld(unsigned* p)              { return __hip_atomic_load(p, __ATOMIC_RELAXED, __HIP_MEMORY_SCOPE_AGENT); }
__device__ __forceinline__ unsigned xb_add(unsigned* p, unsigned v) { return __hip_atomic_fetch_add(p, v, __ATOMIC_RELAXED, __HIP_MEMORY_SCOPE_AGENT); }
__device__ __forceinline__ unsigned xb_xcc_id() { return (unsigned)__builtin_amdgcn_s_getreg((3 << 11) | 20) & 0xFu; }
#define XB_SPIN(cond, bar) do { unsigned _sp = 0; while (cond) { __builtin_amdgcn_s_sleep(1); \
    if ((++_sp & 255u) == 0u) { if (xb_ld(&(bar)[XB_TMO])) break; if (_sp > XB_SPIN_CAP) { atomicAdd(&(bar)[XB_TMO], 1u); break; } } } } while (0)
struct XcdBarrier { unsigned* bar; unsigned x; volatile LAS unsigned* st; };
__device__ __forceinline__ XcdBarrier xcd_barrier_post(unsigned* bar, volatile LAS unsigned* st) {
    XcdBarrier b; b.bar = bar; b.x = xb_xcc_id(); b.st = st;
    if (threadIdx.x == 0) (void)xb_add(&bar[XB_XCNT(b.x)], 1u);
    return b;
}
__device__ __forceinline__ void xcd_barrier_complete(unsigned* bar, unsigned x, unsigned& nloc, unsigned& nx) {
    const unsigned G = gridDim.x * gridDim.y * gridDim.z;
    unsigned sum, cnt, mine, sp = 0u;
    for (;;) {
        sum = 0u; cnt = 0u; mine = 0u;
#pragma unroll
        for (unsigned j = 0; j < 16; ++j) { const unsigned c = xb_ld(&bar[XB_XCNT(j)]); sum += c; cnt += (c > 0u) ? 1u : 0u; mine = (j == x) ? c : mine; }
        if (sum == G) break;
        __builtin_amdgcn_s_sleep(1);
        if ((++sp & 255u) == 0u) { if (xb_ld(&bar[XB_TMO])) break; if (sp > XB_SPIN_CAP) { atomicAdd(&bar[XB_TMO], 1u); break; } }
    }
    nloc = mine > 0u ? mine : 1u; nx = cnt > 0u ? cnt : 1u;
}
__device__ __forceinline__ void xcd_barrier(const XcdBarrier& b) {
    asm volatile("s_waitcnt vmcnt(0)" ::: "memory");
    __syncthreads();
    if (threadIdx.x == 0) {
        unsigned* bar = b.bar; asm volatile("" : "+s"(bar)); bar = (unsigned*)(GAS unsigned*)bar;
        __builtin_amdgcn_s_waitcnt(0);
        unsigned nloc = b.st[0], nx = b.st[1];
        if (nloc == 0u) { xcd_barrier_complete(bar, b.x, nloc, nx); b.st[0] = nloc; b.st[1] = nx; }
        const unsigned old = xb_add(&bar[XB_XSUB(b.x)], 1u);
        const unsigned gen = old / nloc;
        if (old + 1u == (gen + 1u) * nloc) {
            __builtin_amdgcn_fence(__ATOMIC_RELEASE, "agent");
            asm volatile("s_waitcnt vmcnt(0)" ::: "memory");
            const unsigned og = xb_add(&bar[XB_TOP], 1u);
            const unsigned tg = og / nx;
            if (og + 1u == (tg + 1u) * nx) xb_add(&bar[XB_TOPGEN], 1u);
            else XB_SPIN(xb_ld(&bar[XB_TOPGEN]) == tg, bar);
            __builtin_amdgcn_fence(__ATOMIC_ACQUIRE, "agent");
            xb_add(&bar[XB_XGEN(b.x)], 1u);
            asm volatile("s_waitcnt vmcnt(0)" ::: "memory");
        } else {
            XB_SPIN(xb_ld(&bar[XB_XGEN(b.x)]) == gen, bar);
            __builtin_amdgcn_fence(__ATOMIC_ACQUIRE, "agent");
            asm volatile("s_waitcnt vmcnt(0)" ::: "memory");
        }
    }
    __syncthreads();
}
constexpr int CW_BAR = 4096, CW_CONVQ = 96;

#define ACC8(ai, bj, m) {acc[ai][bj][m][0][0], acc[ai][bj][m][0][1], acc[ai][bj][m][0][2], acc[ai][bj][m][0][3], acc[ai][bj][m][1][0], acc[ai][bj][m][1][1], acc[ai][bj][m][1][2], acc[ai][bj][m][1][3]}
struct FastEpiMain {
    static constexpr bool PERM = true, KEEPS = false; EpiMain mn; EpiKV kv; float ascale;
    __device__ __forceinline__ bool keep_acc(const pg8::Unit&) const { return false; }
    __device__ __forceinline__ void operator()(f32x4 (&acc)[2][2][4][2], const pg8::Unit& u, int wr, int wc, int fr, int fq) const {
        asm volatile("" : "+v"(fr), "+v"(fq));
        const int rowb = u.row0 + wr * 64 + fr, colb = u.col0 + wc * 32 + 8 * fq;
        if (u.aux != 0) {
#pragma unroll
            for (int ai = 0; ai < 2; ++ai)
#pragma unroll
                for (int m = 0; m < 4; ++m)
#pragma unroll
                    for (int bj = 0; bj < 2; ++bj) { float v[8] = ACC8(ai, bj, m); kv(rowb + ai * 128 + m * 16, colb + bj * 128, v); }
            return;
        }
        f32x4 bb[2][2];
#pragma unroll
        for (int bj = 0; bj < 2; ++bj) { bb[bj][0] = *(const f32x4*)(mn.biasp + colb + bj * 128); bb[bj][1] = *(const f32x4*)(mn.biasp + colb + bj * 128 + 4); }
        float fpos[2][4];
#pragma unroll
        for (int ai = 0; ai < 2; ++ai)
#pragma unroll
            for (int m = 0; m < 4; ++m) fpos[ai][m] = 0.f;
        if (u.col0 < C_V) {
#pragma unroll
            for (int ai = 0; ai < 2; ++ai)
#pragma unroll
                for (int m = 0; m < 4; ++m) fpos[ai][m] = (float)mn.pos[mn.tok0 + rowb + ai * 128 + m * 16];
        }
        if (u.col0 >= C_GATE) {
            typedef float v2f_t __attribute__((ext_vector_type(2)));
            const float s2 = -1.4426950408889634f * ascale; v2f_t bp[2][4];
#pragma unroll
            for (int bj = 0; bj < 2; ++bj) { bp[bj][0] = (v2f_t){bb[bj][0].x, bb[bj][0].y} * -1.4426950408889634f; bp[bj][1] = (v2f_t){bb[bj][0].z, bb[bj][0].w} * -1.4426950408889634f;
                bp[bj][2] = (v2f_t){bb[bj][1].x, bb[bj][1].y} * -1.4426950408889634f; bp[bj][3] = (v2f_t){bb[bj][1].z, bb[bj][1].w} * -1.4426950408889634f; }
            unsigned char* gp = (unsigned char*)mn.GATES + (size_t)rowb * 3072 + (colb - C_GATE);
#pragma unroll
            for (int ai = 0; ai < 2; ++ai)
#pragma unroll
                for (int m = 0; m < 4; ++m)
#pragma unroll
                    for (int bj = 0; bj < 2; ++bj) { const f32x4 a0 = acc[ai][bj][m][0], a1 = acc[ai][bj][m][1];
                        const v2f_t t[4] = {__builtin_elementwise_fma((v2f_t){a0.x, a0.y}, (v2f_t){s2, s2}, bp[bj][0]), __builtin_elementwise_fma((v2f_t){a0.z, a0.w}, (v2f_t){s2, s2}, bp[bj][1]),
                                            __builtin_elementwise_fma((v2f_t){a1.x, a1.y}, (v2f_t){s2, s2}, bp[bj][2]), __builtin_elementwise_fma((v2f_t){a1.z, a1.w}, (v2f_t){s2, s2}, bp[bj][3])};
                        unsigned w[2] = {0u, 0u};
#pragma unroll
                        for (int q = 0; q < 4; ++q) { v2f_t r;
#pragma unroll
                            for (int e = 0; e < 2; ++e) r[e] = __builtin_amdgcn_rcpf(__builtin_amdgcn_fmed3f(__builtin_fmaf(__builtin_amdgcn_exp2f(t[q][e]), 1.0f / 255.0f, 1.0f / 255.0f), 0.0f, 1.0f));
                            r = r + (v2f_t){0.5f, 0.5f};
                            w[q >> 1] = __builtin_amdgcn_cvt_pk_u8_f32(r[0], 2 * (q & 1), w[q >> 1]); w[q >> 1] = __builtin_amdgcn_cvt_pk_u8_f32(r[1], 2 * (q & 1) + 1, w[q >> 1]); }
                        *(u32x2*)(gp + (size_t)(ai * 128 + m * 16) * 3072 + bj * 128) = (u32x2){w[0], w[1]}; }
            return;
        }
        float invrev[4]; EpiMain::rope_freqs(colb, invrev);
#define FEM_LOOP(S_) do { _Pragma("unroll") for (int ai = 0; ai < 2; ++ai) _Pragma("unroll") for (int m = 0; m < 4; ++m) _Pragma("unroll") for (int bj = 0; bj < 2; ++bj) { float v[8] = ACC8(ai, bj, m); \
            _Pragma("unroll") for (int q = 0; q < 8; ++q) v[q] *= ascale; \
            v[0] += bb[bj][0].x; v[1] += bb[bj][0].y; v[2] += bb[bj][0].z; v[3] += bb[bj][0].w; v[4] += bb[bj][1].x; v[5] += bb[bj][1].y; v[6] += bb[bj][1].z; v[7] += bb[bj][1].w; \
            mn.template finish_s<S_>(rowb + ai * 128 + m * 16, colb + bj * 128, v, fpos[ai][m], invrev); } } while (0)
        if (u.col0 < C_GLU) {
            typedef float v2f_t __attribute__((ext_vector_type(2)));
            const int sec = u.col0 / 1536, r0 = colb - sec * 1536, gh0 = (u.col0 - sec * 1536) >> 7, pcol = r0 & 127, g = gh0 >> 2, sh = 2 * g;
            const int bl = rowb >> 11, s0 = rowb & 2047;
            bf16_t* p0 = mn.QG + (size_t)sec * (SZ_QKV1 / 2) + ((size_t)(bl * 12 + gh0) * 2048 + rowperm(g, s0)) * 128 + pcol;
            asm volatile("" : "+v"(invrev[0]), "+v"(invrev[1]), "+v"(invrev[2]), "+v"(invrev[3]));
#define FEM_QKV(ROT) do { _Pragma("unroll") for (int ai = 0; ai < 2; ++ai) _Pragma("unroll") for (int m = 0; m < 4; ++m) { \
                v2f_t C_[2], S_[2]; \
                if (ROT) { float c4[4], s4[4]; _Pragma("unroll") for (int e = 0; e < 4; ++e) { const float rev = __builtin_amdgcn_fractf(fpos[ai][m] * invrev[e]); s4[e] = __builtin_amdgcn_sinf(rev); c4[e] = __builtin_amdgcn_cosf(rev); } \
                    C_[0] = (v2f_t){c4[0], c4[1]}; C_[1] = (v2f_t){c4[2], c4[3]}; S_[0] = (v2f_t){s4[0], s4[1]}; S_[1] = (v2f_t){s4[2], s4[3]}; } \
                bf16_t* pr = p0 + (size_t)((16 * m + 128 * ai) >> sh) * 128; \
                _Pragma("unroll") for (int bj = 0; bj < 2; ++bj) { const f32x4 a0 = acc[ai][bj][m][0], a1 = acc[ai][bj][m][1]; const v2f_t as2 = {ascale, ascale}; \
                    v2f_t X[2] = {__builtin_elementwise_fma((v2f_t){a0.x, a0.y}, as2, (v2f_t){bb[bj][0].x, bb[bj][0].y}), __builtin_elementwise_fma((v2f_t){a0.z, a0.w}, as2, (v2f_t){bb[bj][0].z, bb[bj][0].w})}; \
                    v2f_t Y[2] = {__builtin_elementwise_fma((v2f_t){a1.x, a1.y}, as2, (v2f_t){bb[bj][1].x, bb[bj][1].y}), __builtin_elementwise_fma((v2f_t){a1.z, a1.w}, as2, (v2f_t){bb[bj][1].z, bb[bj][1].w})}; \
                    if (ROT) { _Pragma("unroll") for (int h = 0; h < 2; ++h) { const v2f_t x_ = X[h], y_ = Y[h]; X[h] = __builtin_elementwise_fma(-y_, S_[h], x_ * C_[h]); Y[h] = __builtin_elementwise_fma(x_, S_[h], y_ * C_[h]); } } \
                    if (QKV_FP8) { u32x2 o8; o8.x = pk4_fp8(X[0].x, X[0].y, X[1].x, X[1].y); o8.y = pk4_fp8(Y[0].x, Y[0].y, Y[1].x, Y[1].y); \
                        *(u32x2*)((unsigned char*)(pr - pcol) + pcol + (size_t)bj * (2048 * 256)) = o8; }     \
                    else { u32x4 o; o.x = pk2(X[0].x, X[0].y); o.y = pk2(X[1].x, X[1].y); o.z = pk2(Y[0].x, Y[0].y); o.w = pk2(Y[1].x, Y[1].y); \
                        *(u32x4*)(pr + (size_t)bj * (2048 * 128)) = o; } } } } while (0)
            if (u.col0 < C_V) FEM_QKV(true); else FEM_QKV(false);
#undef FEM_QKV
            return;
        }
        if (u.col0 < C_QM) FEM_LOOP(2); else FEM_LOOP(3);
#undef FEM_LOOP
    }
};
struct FastEpiGates {
    static constexpr bool PERM = true, KEEPS = false; const float* biasp; bf16_t* GATES; float ascale;
    __device__ __forceinline__ bool keep_acc(const pg8::Unit&) const { return false; }
    __device__ __forceinline__ void operator()(f32x4 (&acc)[2][2][4][2], const pg8::Unit& u, int wr, int wc, int fr, int fq) const {
        asm volatile("" : "+v"(fr), "+v"(fq));
        const int rowb = u.row0 + wr * 64 + fr, colb = u.col0 + wc * 32 + 8 * fq;
        f32x4 bb[2][2];
#pragma unroll
        for (int bj = 0; bj < 2; ++bj) { bb[bj][0] = *(const f32x4*)(biasp + colb + bj * 128); bb[bj][1] = *(const f32x4*)(biasp + colb + bj * 128 + 4); }
#pragma unroll
        for (int ai = 0; ai < 2; ++ai)
#pragma unroll
            for (int m = 0; m < 4; ++m)
#pragma unroll
                for (int bj = 0; bj < 2; ++bj) { const f32x4 a = acc[ai][bj][m][0] * ascale + bb[bj][0], b = acc[ai][bj][m][1] * ascale + bb[bj][1];
                    u32x4 o; o.x = pk2(sigmoidf_(a.x), sigmoidf_(a.y)); o.y = pk2(sigmoidf_(a.z), sigmoidf_(a.w)); o.z = pk2(sigmoidf_(b.x), sigmoidf_(b.y)); o.w = pk2(sigmoidf_(b.z), sigmoidf_(b.w));
                    *(u32x4*)(GATES + (size_t)(rowb + ai * 128 + m * 16) * 3072 + (colb + bj * 128 - C_GATE)) = o; }
    }
};
constexpr float P4_ASCALE = P4_FP8 ? 1.0f / (O8_SCALE * W8_SCALE) : 1.0f;
struct FastEpiMerge {
    static constexpr bool PERM = true, KEEPS = true; const bf16_t* GATES; bf16_t* MERGED;
    __device__ __forceinline__ bool keep_acc(const pg8::Unit& u) const { return u.aux < 2; }
    __device__ __forceinline__ void operator()(f32x4 (&acc)[2][2][4][2], const pg8::Unit& u, int wr, int wc, int fr, int fq) const {
        asm volatile("" : "+v"(fr), "+v"(fq));
        const int rowb = u.row0 + wr * 64 + fr, colb = u.col0 + wc * 32 + 8 * fq, br = u.aux;
        const unsigned char* gp = (const unsigned char*)GATES + (size_t)rowb * 3072 + br * 1024 + colb;
        bf16_t* mp = MERGED + (size_t)rowb * 1024 + colb;
#pragma unroll
        for (int ai = 0; ai < 2; ++ai) {
            u32x2 tg[4][2], tn[4][2];
#pragma unroll
            for (int m = 0; m < 4; ++m)
#pragma unroll
                for (int bj = 0; bj < 2; ++bj) { tg[m][bj] = *(const u32x2*)(gp + (size_t)(ai * 128 + m * 16) * 3072 + bj * 128);
                    if (br < 2) tn[m][bj] = *(const u32x2*)(gp + 1024 + (size_t)(ai * 128 + m * 16) * 3072 + bj * 128); }
            if (br < 2) {
#pragma unroll
                for (int m = 0; m < 4; ++m)
#pragma unroll
                    for (int bj = 0; bj < 2; ++bj) { const u32x2 g = tg[m][bj], n = tn[m][bj]; const f32x4 n0 = u8x4_raw(n.x), n1 = u8x4_raw(n.y);
                        const f32x4 r0 = {__builtin_amdgcn_rcpf(n0.x), __builtin_amdgcn_rcpf(n0.y), __builtin_amdgcn_rcpf(n0.z), __builtin_amdgcn_rcpf(n0.w)}, r1 = {__builtin_amdgcn_rcpf(n1.x), __builtin_amdgcn_rcpf(n1.y), __builtin_amdgcn_rcpf(n1.z), __builtin_amdgcn_rcpf(n1.w)};
                        acc[ai][bj][m][0] = acc[ai][bj][m][0] * (u8x4_raw(g.x) * r0); acc[ai][bj][m][1] = acc[ai][bj][m][1] * (u8x4_raw(g.y) * r1); }
            } else {
#pragma unroll
                for (int m = 0; m < 4; ++m)
#pragma unroll
                    for (int bj = 0; bj < 2; ++bj) { const u32x2 g = tg[m][bj];
#if P5_FP8
                        const f32x4 a = acc[ai][bj][m][0] * (u8x4_raw(g.x) * (P4_ASCALE * M8_SCALE / 255.0f)), b = acc[ai][bj][m][1] * (u8x4_raw(g.y) * (P4_ASCALE * M8_SCALE / 255.0f));
                        u32x2 o; o.x = pk4_fp8(a.x, a.y, a.z, a.w); o.y = pk4_fp8(b.x, b.y, b.z, b.w);
                        *(u32x2*)((unsigned char*)MERGED + (size_t)(rowb + ai * 128 + m * 16) * 1024 + colb + bj * 128) = o;
#else
                        const f32x4 a = acc[ai][bj][m][0] * (u8x4_raw(g.x) * (P4_ASCALE / 255.0f)), b = acc[ai][bj][m][1] * (u8x4_raw(g.y) * (P4_ASCALE / 255.0f));
                        u32x4 o; o.x = pk2(a.x, a.y); o.y = pk2(a.z, a.w); o.z = pk2(b.x, b.y); o.w = pk2(b.z, b.w);
                        *(u32x4*)(mp + (size_t)(ai * 128 + m * 16) * 1024 + bj * 128) = o;
#endif
                    }
            }
            asm volatile("" ::: "memory");
        }
    }
};
struct FastEpiStore8 {
    static constexpr bool PERM = true, KEEPS = false; unsigned char* O; int ld; float scale;
    __device__ __forceinline__ bool keep_acc(const pg8::Unit&) const { return false; }
    __device__ __forceinline__ void operator()(f32x4 (&acc)[2][2][4][2], const pg8::Unit& u, int wr, int wc, int fr, int fq) const {
        asm volatile("" : "+v"(fr), "+v"(fq));
        const int rowb = u.row0 + wr * 64 + fr, colb = u.col0 + wc * 32 + 8 * fq;
#pragma unroll
        for (int ai = 0; ai < 2; ++ai)
#pragma unroll
            for (int m = 0; m < 4; ++m)
#pragma unroll
                for (int bj = 0; bj < 2; ++bj) { const f32x4 a = acc[ai][bj][m][0] * scale, b = acc[ai][bj][m][1] * scale;
                    u32x2 o; o.x = pk4_fp8s(a.x, a.y, a.z, a.w); o.y = pk4_fp8s(b.x, b.y, b.z, b.w);
                    *(u32x2*)(O + (size_t)(rowb + ai * 128 + m * 16) * ld + colb + bj * 128) = o; }
    }
};
struct FastEpiStore {
    static constexpr bool PERM = true, KEEPS = false; bf16_t* O; int ld; float scale;
    __device__ __forceinline__ bool keep_acc(const pg8::Unit&) const { return false; }
    __device__ __forceinline__ void operator()(f32x4 (&acc)[2][2][4][2], const pg8::Unit& u, int wr, int wc, int fr, int fq) const {
        asm volatile("" : "+v"(fr), "+v"(fq));
        const int rowb = u.row0 + wr * 64 + fr, colb = u.col0 + wc * 32 + 8 * fq;
#pragma unroll
        for (int ai = 0; ai < 2; ++ai)
#pragma unroll
            for (int m = 0; m < 4; ++m)
#pragma unroll
                for (int bj = 0; bj < 2; ++bj) { const f32x4 a = acc[ai][bj][m][0] * scale, b = acc[ai][bj][m][1] * scale;
                    u32x4 o; o.x = pk2(a.x, a.y); o.y = pk2(a.z, a.w); o.z = pk2(b.x, b.y); o.w = pk2(b.z, b.w);
                    *(u32x4*)(O + (size_t)(rowb + ai * 128 + m * 16) * ld + colb + bj * 128) = o; }
    }
};
struct FastEpiNull {
    static constexpr bool PERM = true, KEEPS = false; bf16_t* O;
    __device__ __forceinline__ bool keep_acc(const pg8::Unit&) const { return false; }
    __device__ __forceinline__ void operator()(f32x4 (&acc)[2][2][4][2], const pg8::Unit& u, int wr, int wc, int fr, int fq) const {
        float s = 0.f;
#pragma unroll
        for (int ai = 0; ai < 2; ++ai)
#pragma unroll
            for (int m = 0; m < 4; ++m)
#pragma unroll
                for (int bj = 0; bj < 2; ++bj) { const f32x4 a = acc[ai][bj][m][0], b = acc[ai][bj][m][1]; s += a.x + a.y + a.z + a.w + b.x + b.y + b.z + b.w; }
        if (s == 1.2345e38f) O[u.row0 + fr] = (bf16_t)1;
    }
};
struct FastEpiMoe1 {
    static constexpr bool PERM = true, KEEPS = false; LAS const int* toktab; const float* wts; unsigned char* H8;
    __device__ __forceinline__ bool keep_acc(const pg8::Unit&) const { return false; }
    __device__ __forceinline__ void operator()(f32x4 (&acc)[2][2][4][2], const pg8::Unit& u, int wr, int wc, int fr, int fq) const {
        asm volatile("" : "+v"(fr), "+v"(fq));
        const int rloc = wr * 64 + fr, colb = u.col0 + wc * 32 + 8 * fq, hi = u.col0 >> 10;
        float w[2][4];
#pragma unroll
        for (int ai = 0; ai < 2; ++ai)
#pragma unroll
            for (int m = 0; m < 4; ++m) { const int tok = toktab[u.aux * 256 + rloc + ai * 128 + m * 16]; w[ai][m] = wts[(size_t)tok * 2 + hi] * (H8_SCALE / W8_SCALE); }
        constexpr float inv = 1.0f / W8_SCALE;
#pragma unroll
        for (int ai = 0; ai < 2; ++ai)
#pragma unroll
            for (int m = 0; m < 4; ++m)
#pragma unroll
                for (int bj = 0; bj < 2; ++bj) { const f32x4 gt = acc[ai][bj][m][0] * inv, up = acc[ai][bj][m][1]; const float ww = w[ai][m];
                    const int j0 = hi * 512 + (((colb + bj * 128) & 1023) >> 1);
                    float h[4] = {gt.x * sigmoidf_(gt.x) * up.x * ww, gt.y * sigmoidf_(gt.y) * up.y * ww, gt.z * sigmoidf_(gt.z) * up.z * ww, gt.w * sigmoidf_(gt.w) * up.w * ww};
#pragma unroll
                    for (int q = 0; q < 4; ++q) h[q] = fminf(fmaxf(h[q], -448.f), 448.f);
                    *(unsigned*)(H8 + (size_t)(u.row0 + rloc + ai * 128 + m * 16) * 1024 + j0) = pk4_fp8(h[0], h[1], h[2], h[3]); }
    }
};
#undef ACC8

struct SchedMain {
    pg8::TileOrder to; int nkv, tile0, cut, skip; size_t astep, bstep; const char *XB, *WIN, *MEMB, *WKV;
    __device__ __forceinline__ bool next(int i, pg8::Unit& u) const {
        int pm, pn;
        if (to.tile(i, pm, pn)) { const int ct = tile0 + (pn < cut ? pn : pn + skip); u.A = XB + (size_t)pm * astep; u.B = WIN + (size_t)ct * bstep; u.row0 = pm * 256; u.col0 = ct * 256; u.bjump = 0; u.aux = 0; return true; }
        const long L = (long)i * to.G + to.c - to.nwg; if (L >= nkv) return false;
        pm = (int)(L >> 2); pn = (int)(L & 3);
        u.A = MEMB + (size_t)pm * 256 * 2048; u.B = WKV + (size_t)pn * 256 * 2048; u.row0 = pm * 256; u.col0 = pn * 256; u.bjump = 0; u.aux = 1; return true;
    }
};
struct SchedMerge {
    pg8::TileOrder to; const char *A0, *W;
    __device__ __forceinline__ bool next(int i, pg8::Unit& u) const {
        const int ti = i / 3, br = i - ti * 3; int pm, pn; if (!to.tile(ti, pm, pn)) return false;
        u.A = A0 + (size_t)br * SZ_512 + (size_t)pm * 256 * (P4_FP8 ? 512 : 1024); u.B = W + (size_t)br * MiB + (size_t)pn * 256 * (P4_FP8 ? 512 : 1024); u.row0 = pm * 256; u.col0 = pn * 256; u.bjump = 0; u.aux = br; return true;
    }
};
struct SchedPlain {
    pg8::TileOrder to; const char *A, *B; size_t astep, bstep;
    __device__ __forceinline__ bool next(int i, pg8::Unit& u) const {
        int pm, pn; if (!to.tile(i, pm, pn)) return false;
        u.A = A + (size_t)pm * astep; u.B = B + (size_t)pn * bstep; u.row0 = pm * 256; u.col0 = pn * 256; u.bjump = 0; u.aux = 0; return true;
    }
};
struct SchedMoe {
    pg8::TileOrder to; LAS const int* pan_cls; LAS const int* toktab; const char *H, *W1, *W2; int mode;
    __device__ __forceinline__ LAS const int* toks(int i) const { return toktab + i * 256; }
    __device__ __forceinline__ bool next(int i, pg8::Unit& u) const {
        int pm, pn; if (!to.tile(i, pm, pn)) return false;
        const int cls = pan_cls[pm]; int e_lo, e_hi; class_experts(cls, e_lo, e_hi);
        u.row0 = pm * 256; u.col0 = pn * 256; u.aux = i; u.bjump = 0;
        if (mode == 1) { u.A = nullptr; u.B = W1 + ((size_t)(pn < 4 ? e_lo : e_hi) * 1024 + (size_t)(pn & 3) * 256) * 1024; }
        else { u.A = H + (size_t)pm * 256 * 1024; u.B = W2 + (size_t)pn * 256 * 8192 + (size_t)e_lo * 512; u.bjump = (e_hi - e_lo - 1) * 512; }
        return true;
    }
};

template <int WHICH> __device__ __forceinline__ float tw_src(const Params& p, int k, int n) {
    if constexpr (WHICH == TW_IN) return p.w_in[(size_t)k * INC + win_logical(n)];
    else if constexpr (WHICH == TW_KV) return p.w_mem_kv[(size_t)k * 1024 + n];
    else if constexpr (WHICH == TW_A) return p.w_attn_o[(size_t)k * 1024 + n];
    else if constexpr (WHICH == TW_C) return p.w_conv_o[(size_t)k * 1024 + n];
    else if constexpr (WHICH == TW_M) return p.w_mem_o[(size_t)k * 1024 + n];
    else if constexpr (WHICH == TW_OUT) return p.w_out[(size_t)k * 1024 + n];
    else if constexpr (WHICH == TW_W1) { const int e = n >> 10, c = n & 1023, G = c >> 3, nn = (c >> 2) & 1, ee = c & 3, jj = 4 * G + ee; return (nn ? p.w_eu : p.w_eg)[((size_t)e * 1024 + k) * 512 + jj]; }
    else { const int e = n >> 10, c = n & 1023; return p.w_ed[((size_t)e * 512 + k) * 1024 + c]; }
}
template <int WHICH> __device__ __forceinline__ void tw_item(const Params& p, int item, float* scr, int lane) {
    constexpr int N = WHICH == TW_IN ? INC : (WHICH >= TW_W1 ? 16 * 1024 : 1024);
    constexpr int ldd = (WHICH == TW_A || WHICH == TW_C || WHICH == TW_M) ? 512 : (WHICH == TW_W2 ? 8192 : 1024);
    constexpr size_t dsto = WHICH == TW_IN ? WS_WIN : WHICH == TW_KV ? WS_WKV : WHICH == TW_A ? WS_WA : WHICH == TW_C ? WS_WC : WHICH == TW_M ? WS_WM : WHICH == TW_OUT ? WS_WOUT : WHICH == TW_W1 ? WS_W1 : WS_W2;
    bf16_t* dst = WSP(bf16_t, dsto);
    constexpr int nblk = N / 32; const int kb = item / nblk, nb = item - kb * nblk, k0 = 64 * kb, n0 = 32 * nb;
#pragma unroll 8
    for (int i = 0; i < 32; ++i) { const int kk = 2 * i + (lane >> 5); scr[kk * 33 + (lane & 31)] = tw_src<WHICH>(p, k0 + kk, n0 + (lane & 31)); }
    asm volatile("s_waitcnt lgkmcnt(0)" ::: "memory");
    const int c = lane & 7;
#pragma unroll
    for (int j = 0; j < 4; ++j) { const int n = (lane >> 3) + 8 * j; const float* sp = scr + (8 * c) * 33 + n;
        const int nn = n0 + n; size_t doff;
        if constexpr (WHICH == TW_W2) doff = (size_t)(nn & 1023) * 8192 + (size_t)(nn >> 10) * 512 + k0 + 8 * c; else doff = (size_t)nn * ldd + k0 + 8 * c;
        if constexpr (WHICH >= TW_W1 || (P5_FP8 && WHICH == TW_OUT) || (P4_FP8 && (WHICH == TW_A || WHICH == TW_C || WHICH == TW_M))) {
            u32x2 o; o.x = pk4_fp8(W8_SCALE * sp[0 * 33], W8_SCALE * sp[1 * 33], W8_SCALE * sp[2 * 33], W8_SCALE * sp[3 * 33]); o.y = pk4_fp8(W8_SCALE * sp[4 * 33], W8_SCALE * sp[5 * 33], W8_SCALE * sp[6 * 33], W8_SCALE * sp[7 * 33]);
            *(u32x2*)((unsigned char*)dst + doff) = o;
        } else {
            u32x4 o; o.x = pk2(sp[0 * 33], sp[1 * 33]); o.y = pk2(sp[2 * 33], sp[3 * 33]); o.z = pk2(sp[4 * 33], sp[5 * 33]); o.w = pk2(sp[6 * 33], sp[7 * 33]);
            if constexpr (!(WHICH == TW_IN && P1_QK_FP8 == 2)) *(u32x4*)(dst + doff) = o;
            if constexpr (WHICH == TW_IN && !P1_FP6) {
                u32x2 q; q.x = pk4_fp8(WG8_SCALE * sp[0 * 33], WG8_SCALE * sp[1 * 33], WG8_SCALE * sp[2 * 33], WG8_SCALE * sp[3 * 33]); q.y = pk4_fp8(WG8_SCALE * sp[4 * 33], WG8_SCALE * sp[5 * 33], WG8_SCALE * sp[6 * 33], WG8_SCALE * sp[7 * 33]);
                *(u32x2*)(p.ws + WS_WG8 + doff) = q; } } }
    if constexpr (WHICH == TW_IN && P1_FP6) {
        const int n = lane & 31, b = lane >> 5, blk = (k0 >> 5) + b, tt = blk >> 2, fq = blk & 3; float v[32];
#pragma unroll
        for (int j = 0; j < 32; ++j) v[j] = WG8_SCALE * scr[(32 * b + j) * 33 + n];
        const v6u_t q = pack32_fp6(v);
        unsigned char* wp = p.ws + WS_WG8 + (size_t)(n0 + n) * 1024 + tt * 128 + 16 * fq;
        *(u32x4*)wp = (u32x4){q[0], q[1], q[2], q[3]}; *(u32x4*)(wp + 64) = (u32x4){q[4], q[5], 0u, 0u};
    }
    asm volatile("s_waitcnt lgkmcnt(0)" ::: "memory");
}
__device__ __forceinline__ void transpose_all(const Params& p, float* scr, int gw, int ngw, int lane) {
    constexpr int I_IN = 16 * (INC / 32), I_KV = 16 * 32, I_B = 8 * 32, I_OUT = 16 * 32, I_W1 = 16 * 512, I_W2 = 8 * 512;
    constexpr int NITEMS = I_IN + I_KV + 3 * I_B + I_OUT + I_W1 + I_W2;
    for (int it = gw; it < NITEMS; it += ngw) {
        int r = it;
        if (r < I_W1) { tw_item<TW_W1>(p, r, scr, lane); continue; } r -= I_W1;
        if (r < I_IN) { tw_item<TW_IN>(p, r, scr, lane); continue; } r -= I_IN;
        if (r < I_W2) { tw_item<TW_W2>(p, r, scr, lane); continue; } r -= I_W2;
        if (r < I_KV) { tw_item<TW_KV>(p, r, scr, lane); continue; } r -= I_KV;
        if (r < I_OUT) { tw_item<TW_OUT>(p, r, scr, lane); continue; } r -= I_OUT;
        if (r < I_B) { tw_item<TW_A>(p, r, scr, lane); continue; } r -= I_B;
        if (r < I_B) { tw_item<TW_C>(p, r, scr, lane); continue; } r -= I_B;
        tw_item<TW_M>(p, r, scr, lane);
    }
}

__device__ __forceinline__ void cvt_bf16_dev(const float* __restrict__ src, bf16_t* __restrict__ dst, size_t n8, size_t gtid, size_t gstride) {
    for (size_t i = gtid; i < n8; i += gstride) {
        const f32x4 a = *(const f32x4*)(src + i * 8), b = *(const f32x4*)(src + i * 8 + 4);
        u32x4 o; o.x = pk2(a.x, a.y); o.y = pk2(a.z, a.w); o.z = pk2(b.x, b.y); o.w = pk2(b.z, b.w);
        *(u32x4*)(dst + i * 8) = o;
    }
}

__device__ __forceinline__ void cvt_x_dev(const float* __restrict__ src, bf16_t* __restrict__ dst, unsigned char* __restrict__ dst8, size_t n32, size_t gtid, size_t gstride) {
    for (size_t i = gtid; i < n32; i += gstride) {
        float v[32];
#pragma unroll
        for (int q = 0; q < 8; ++q) { const f32x4 a = *(const f32x4*)(src + i * 32 + 4 * q); v[4 * q] = a.x; v[4 * q + 1] = a.y; v[4 * q + 2] = a.z; v[4 * q + 3] = a.w; }
#pragma unroll
        for (int q = 0; q < 4; ++q) { u32x4 o; o.x = pk2(v[8 * q], v[8 * q + 1]); o.y = pk2(v[8 * q + 2], v[8 * q + 3]); o.z = pk2(v[8 * q + 4], v[8 * q + 5]); o.w = pk2(v[8 * q + 6], v[8 * q + 7]); *(u32x4*)(dst + i * 32 + 8 * q) = o; }
        if constexpr (P1_FP6) {
            const size_t row = i >> 5; const int blk = (int)(i & 31), tt = blk >> 2, fq = blk & 3; const v6u_t q6 = pack32_fp6(v);
            unsigned char* xp = dst8 + row * 1024 + tt * 128 + 16 * fq;
            *(u32x4*)xp = (u32x4){q6[0], q6[1], q6[2], q6[3]}; *(u32x4*)(xp + 64) = (u32x4){q6[4], q6[5], 0u, 0u};
        } else {
#pragma unroll
            for (int q = 0; q < 2; ++q) { u32x4 q8; q8.x = pk4_fp8(v[16 * q], v[16 * q + 1], v[16 * q + 2], v[16 * q + 3]); q8.y = pk4_fp8(v[16 * q + 4], v[16 * q + 5], v[16 * q + 6], v[16 * q + 7]);
                q8.z = pk4_fp8(v[16 * q + 8], v[16 * q + 9], v[16 * q + 10], v[16 * q + 11]); q8.w = pk4_fp8(v[16 * q + 12], v[16 * q + 13], v[16 * q + 14], v[16 * q + 15]); *(u32x4*)(dst8 + i * 32 + 16 * q) = q8; }
        }
    }
}
__device__ __forceinline__ void wg8_dev(const Params& p, size_t gtid, size_t gstride) {
    for (size_t i = gtid; i < (size_t)INC * 64; i += gstride) { const int n = (int)(i % INC), k0 = (int)(i / INC) * 16, nl = win_logical(n); float v[16];
#pragma unroll
        for (int j = 0; j < 16; ++j) v[j] = WG8_SCALE * p.w_in[(size_t)(k0 + j) * INC + nl];
        u32x4 q; q.x = pk4_fp8(v[0], v[1], v[2], v[3]); q.y = pk4_fp8(v[4], v[5], v[6], v[7]); q.z = pk4_fp8(v[8], v[9], v[10], v[11]); q.w = pk4_fp8(v[12], v[13], v[14], v[15]);
        *(u32x4*)(p.ws + WS_WG8 + (size_t)n * 1024 + k0) = q; }
}

#ifndef STAG_US
#define STAG_US 0
#endif
__device__ __forceinline__ void delay_us(int us) { const unsigned long long t0 = __builtin_amdgcn_s_memrealtime(); while (__builtin_amdgcn_s_memrealtime() - t0 < (unsigned long long)us * 100ull) __builtin_amdgcn_s_sleep(16); }

struct Args { Params p; int ph_lo, ph_hi; };
typedef const __attribute__((address_space(4))) unsigned long long* KArgPtr;
__device__ __forceinline__ Params load_params(KArgPtr q) {
    asm volatile("" : "+s"(q));
    Params p;
    p.x = (const float*)(const GAS float*)q[0]; p.mem = (const float*)(const GAS float*)q[1]; p.pos = (const int*)(const GAS int*)q[2]; p.w_in = (const float*)(const GAS float*)q[3]; p.b_in = (const float*)(const GAS float*)q[4]; p.conv_w = (const float*)(const GAS float*)q[5]; p.conv_b = (const float*)(const GAS float*)q[6];
    p.conv_g = (const float*)(const GAS float*)q[7]; p.conv_bb = (const float*)(const GAS float*)q[8]; p.w_mem_kv = (const float*)(const GAS float*)q[9]; p.w_attn_o = (const float*)(const GAS float*)q[10]; p.w_conv_o = (const float*)(const GAS float*)q[11]; p.w_mem_o = (const float*)(const GAS float*)q[12];
    p.w_out = (const float*)(const GAS float*)q[13]; p.ln1_g = (const float*)(const GAS float*)q[14]; p.ln1_b = (const float*)(const GAS float*)q[15]; p.w_gr = (const float*)(const GAS float*)q[16]; p.b_gr = (const float*)(const GAS float*)q[17]; p.w_er = (const float*)(const GAS float*)q[18]; p.b_er = (const float*)(const GAS float*)q[19];
    p.w_eg = (const float*)(const GAS float*)q[20]; p.w_eu = (const float*)(const GAS float*)q[21]; p.w_ed = (const float*)(const GAS float*)q[22]; p.ln2_g = (const float*)(const GAS float*)q[23]; p.ln2_b = (const float*)(const GAS float*)q[24]; p.out = (float*)(GAS float*)q[25]; p.ws = (unsigned char*)(GAS unsigned char*)q[26];
    return p;
}
static_assert(sizeof(Params) == 27 * 8, "Params is 27 pointers");
constexpr int PH_P0 = 0, PH_CH0 = 1, PH_PER_CH = 5, PH_LN1 = PH_CH0 + PH_PER_CH * NCH, PH_MOE1 = PH_LN1 + 1, PH_MOE2 = PH_LN1 + 2, PH_LN2 = PH_LN1 + 3, PH_END = PH_LN1 + 4;

__global__ void __launch_bounds__(NTHR, 2) mk_fwd(Args args) {
    extern __shared__ __attribute__((aligned(16))) unsigned char lds_raw[];
    LAS unsigned char* lds = (LAS unsigned char*)lds_raw;
    const KArgPtr kargs = (KArgPtr)__builtin_amdgcn_kernarg_segment_ptr();
    const int wave = __builtin_amdgcn_readfirstlane((int)threadIdx.x >> 6);
    const int G = gridDim.x; const int bx = blockIdx.x; const int vcu = (G % 8 == 0) ? (bx % 8) * (G / 8) + bx / 8 : bx;
    volatile LAS unsigned* MISC = (volatile LAS unsigned*)(lds + LCTL_OFF);
    ClassTab* tab = (ClassTab*)(lds_raw + LCTL_OFF + 256);
    int* pan_cls = (int*)(lds_raw + LCTL_OFF + 512);
    int* toktab = (int*)(lds_raw + LTOK_OFF);
    for (int u = threadIdx.x; u < (LDS_BYTES - LCTL_OFF) / 4; u += NTHR) ((LAS unsigned*)(lds + LCTL_OFF))[u] = 0u;
    __syncthreads();
    const int lo = args.ph_lo, hi = args.ph_hi;
    unsigned* ctl; { const Params p = load_params(kargs); ctl = WSP(unsigned, WS_CTL); }
    XcdBarrier bar; bar.bar = ctl + CW_BAR; bar.x = 0; bar.st = nullptr;
    if (hi - lo > 1) bar = xcd_barrier_post(ctl + CW_BAR, MISC);
#ifndef PHMASK
#define PHMASK 0x3ff
#endif
#ifndef P1_QK_FP8
#define P1_QK_FP8 2
#endif
#if P1_QK_FP8 == 3
constexpr int P1_BF16_TILES = 4, P1_BF16_T0 = 18, P1_BF16_CUT = 4, P1_BF16_SKIP = 0, P1_FP8_TILES = 32, P1_FP8_T0 = 0, P1_FP8_CUT = 18, P1_FP8_SKIP = 4;
#elif P1_QK_FP8 == 2
constexpr int P1_BF16_TILES = 0, P1_BF16_T0 = 0, P1_BF16_CUT = 0, P1_BF16_SKIP = 0, P1_FP8_TILES = 36, P1_FP8_T0 = 0, P1_FP8_CUT = 36, P1_FP8_SKIP = 0;
#elif P1_QK_FP8
constexpr int P1_BF16_TILES = 6, P1_BF16_T0 = 18, P1_BF16_CUT = 6, P1_BF16_SKIP = 0, P1_FP8_TILES = 30, P1_FP8_T0 = 0, P1_FP8_CUT = 18, P1_FP8_SKIP = 6;
#else
constexpr int P1_BF16_TILES = 18, P1_BF16_T0 = 0, P1_BF16_CUT = 12, P1_BF16_SKIP = 6, P1_FP8_TILES = 18, P1_FP8_T0 = 12, P1_FP8_CUT = 6, P1_FP8_SKIP = 6;
#endif
#ifndef ATTN_V2
#define ATTN_V2 1
#endif
#ifndef PROBE_DUP
#define PROBE_DUP (-1)
#endif
#define NREP(b) ((PROBE_DUP == (b)) ? 2 : 1)
#define IN(k) (lo <= (k) && (k) < hi)
#define HAS(b) ((PHMASK >> (b)) & 1)
#define SEAM(k) do { if (IN(k) && IN((k) + 1)) xcd_barrier(bar); } while (0)

    if (HAS(0) && IN(PH_P0)) {
        const Params p = load_params(kargs);
        const size_t gtid = (size_t)bx * NTHR + opaque_tid(wave), gstride = (size_t)G * NTHR;
        for (int rep = 0; rep < NREP(0); ++rep) {
        { const int ptid = opaque_tid(wave); transpose_all(p, (float*)(lds_raw + RING_OFF) + (ptid >> 6) * (64 * 33), bx * NWAVES + (ptid >> 6), G * NWAVES, ptid & 63); }
        small_prep_dev(p, gtid, gstride);
        cvt_bf16_dev(p.mem, WSP(bf16_t, WS_MEMB), (size_t)NB * MEML * 1024 / 8, gtid, gstride);
        cvt_x_dev(p.x, WSP(bf16_t, WS_XB), p.ws + WS_XB8, (size_t)T * 1024 / 32, gtid, gstride);
        }
    }
    SEAM(PH_P0);
    if (PROBE_DUP == 10 && hi - lo > 1) for (int r = 0; r < 16; ++r) xcd_barrier(bar);

    for (int ch = 0; ch < NCH; ++ch) {
        const int ph0 = PH_CH0 + PH_PER_CH * ch;
        if (HAS(1) && IN(ph0)) {
            const Params p = load_params(kargs);
            const EpiMain em{WSP(float, WS_BIASP), p.pos, WSP(bf16_t, WS_QG), WSP(bf16_t, WS_CGLU), WSP(bf16_t, WS_QM), WSP(bf16_t, WS_GATES), ch * TC};
            for (int rep = 0; rep < NREP(1); ++rep) {
            {
                SchedMain S; S.to.init(TC / 256, P1_BF16_TILES, G, bx); S.nkv = ch == 0 ? (NB * MEML / 256) * 4 : 0; S.tile0 = P1_BF16_T0; S.cut = P1_BF16_CUT; S.skip = P1_BF16_SKIP; S.astep = 256 * 2048; S.bstep = 256 * 2048;
                S.XB = (const char*)(WSP(bf16_t, WS_XB) + (size_t)ch * TC * 1024); S.WIN = (const char*)WSP(bf16_t, WS_WIN); S.MEMB = (const char*)WSP(bf16_t, WS_MEMB); S.WKV = (const char*)WSP(bf16_t, WS_WKV);
                FastEpiMain E{em, EpiKV{WSP(bf16_t, WS_KM)}, 1.0f};
#ifndef NO_P1A
                pg8::gemm_phase<FastEpiMain, SchedMain, true, false, false>(lds + RING_OFF, nullptr, 1024, 1024, 1024, S, E, wave);
#endif
                if (PROBE_DUP == 16) { FastEpiStore E2{WSP(bf16_t, WS_MERGED), 1024, 1.0f}; pg8::gemm_phase<FastEpiStore, SchedMain, true, false, false>(lds + RING_OFF, nullptr, 1024, 1024, 1024, S, E2, wave); }
            }
            {
                SchedMain S; S.to.init(TC / 256, P1_FP8_TILES, G, bx); S.nkv = 0; S.tile0 = P1_FP8_T0; S.cut = P1_FP8_CUT; S.skip = P1_FP8_SKIP; S.astep = 256 * 1024; S.bstep = 256 * 1024;
                S.XB = (const char*)(p.ws + WS_XB8 + (size_t)ch * TC * 1024); S.WIN = (const char*)(p.ws + WS_WG8); S.MEMB = nullptr; S.WKV = nullptr;
                FastEpiMain E{em, EpiKV{WSP(bf16_t, WS_KM)}, 1.0f / WG8_SCALE};
#ifndef NO_P1B
                if (STAG_US > 0 && ((bx >> 3) & 1)) delay_us(STAG_US);
                pg8::gemm_phase<FastEpiMain, SchedMain, true, false, false, P1_FP6 ? 2 : 1>(lds + RING_OFF, nullptr, 512, 512, 512, S, E, wave);
#endif
                if (PROBE_DUP == 17) { FastEpiStore E2{WSP(bf16_t, WS_MERGED), 1024, 1.0f}; pg8::gemm_phase<FastEpiStore, SchedMain, true, false, false, true>(lds + RING_OFF, nullptr, 512, 512, 512, S, E2, wave); }
                if (PROBE_DUP == 19 || PROBE_DUP == 20) { SchedMain S2 = S; S2.bstep = 0; if (PROBE_DUP == 20) S2.astep = 0; FastEpiNull E2{WSP(bf16_t, WS_MERGED)}; pg8::gemm_phase<FastEpiNull, SchedMain, true, false, false, true>(lds + RING_OFF, nullptr, 512, 512, 512, S2, E2, wave); }
                if (PROBE_DUP == 21) { SchedMain S2 = S; S2.bstep = 0; S2.astep = 0; FastEpiNull E2{WSP(bf16_t, WS_MERGED)}; pg8::gemm_phase<FastEpiNull, SchedMain, true, false, false, true>(lds + RING_OFF, nullptr, 512, 512, 256, S2, E2, wave); }
                if (PROBE_DUP == 22) { SchedMain S2 = S; S2.bstep = 0; S2.astep = 0; FastEpiNull E2{WSP(bf16_t, WS_MERGED)}; pg8::gemm_phase<FastEpiNull, SchedMain, true, false, false, 3>(lds + RING_OFF, nullptr, 512, 512, 512, S2, E2, wave); }
                if (PROBE_DUP == 18) { FastEpiNull E2{WSP(bf16_t, WS_MERGED)}; pg8::gemm_phase<FastEpiNull, SchedMain, true, false, false, true>(lds + RING_OFF, nullptr, 512, 512, 512, S, E2, wave); }
            }
            }
        }
        SEAM(ph0);
        if (HAS(2) && IN(ph0 + 1)) {
            const Params p = load_params(kargs);
            constexpr int NDIL = BC * 12 * 8, NMEMB = BC * 4 * 8, NBLK = NDIL + NMEMB;
#if ATTN_V2
            for (int rep = 0; rep < NREP(2); ++rep) {
            const bool dummy = (PROBE_DUP == 2) && rep == 0;
            LAS char* rlds = (LAS char*)(lds + RING_OFF); LAS float* scr = (LAS float*)(lds + LTOK_OFF);
            if (wave >= 4) __builtin_amdgcn_s_setprio(1);
            for (int hd = vcu; hd < BC * 16; hd += G) {
                if (hd < BC * 12) { const int g = (hd % 12) >> 2; const size_t base = (size_t)hd * 2048 * 128;
                    swa::head_dilated(WSP(bf16_t, WS_QG) + base, dummy ? WSP(bf16_t, WS_MERGED) + (size_t)(hd & 127) * 2048 * 128 : WSP(bf16_t, WS_QG) + base, WSP(bf16_t, WS_KG) + base, WSP(bf16_t, WS_VG) + base, WSP(float, WS_LSE) + (size_t)hd * 2048, (2048 >> (2 * g)) - 1, rlds, scr, wave);
                } else { const int bh = hd - BC * 12, bl = bh >> 2, h = bh & 3; const size_t kvb = (size_t)(ch * BC * 4 + bh) * 256 * 128;
                    swa::head_mem(WSP(bf16_t, WS_QM) + (size_t)bh * 2048 * 128, WSP(bf16_t, WS_KM) + kvb, WSP(bf16_t, WS_VM) + kvb, (bf16_t*)(p.ws + WS_OMT + (P4_FP8 ? 1 : 2) * ((size_t)bl * 2048 * 512 + h * 128)), 512, rlds, scr, wave); }
            }
            __builtin_amdgcn_s_setprio(0);
            __syncthreads();
            }
            {
                const Params pc = load_params(kargs); const int ptid = opaque_tid(wave); volatile LAS unsigned* qslot = MISC + 4;
                for (;;) {
                    if (ptid == 0) *qslot = atomicAdd(ctl + CW_CONVQ + ch, 1u);
                    __syncthreads();
                    const int u = (int)*qslot;
                    if (u >= BC * 64) break;
                    conv_unit(pc, u, lds_raw + RING_OFF, ptid);
                }
            }
        }
#else
            for (int rep = 0; rep < NREP(2); ++rep) {
            const bool dummy = (PROBE_DUP == 2) && rep == 0;
            auto make_ref = [&](int L) -> swa::BlockRef {
                swa::BlockRef r;
                if (L < NDIL) { const int bgh = L >> 3, qb = L & 7, g = (bgh % 12) >> 2; const size_t base = (size_t)bgh * 2048 * 128;
                    r.Q = WSP(bf16_t, WS_QG) + base + (size_t)qb * 256 * 128; r.K = WSP(bf16_t, WS_KG) + base; r.V = WSP(bf16_t, WS_VG) + base; r.O = dummy ? WSP(bf16_t, WS_MERGED) + (base % (SZ_XB / 2 - 65536)) : (bf16_t*)r.Q;
                    r.LSE = WSP(float, WS_LSE) + (size_t)bgh * 2048 + qb * 256; r.P0 = qb * 256; r.W = 129; r.segmask = (2048 >> (2 * g)) - 1; r.skv = 2048; r.ostride = 128; }
                else { const int idx = L - NDIL, bh = idx >> 3, qb = idx & 7, bl = bh >> 2, h = bh & 3; const size_t kvb = (size_t)(ch * BC * 4 + bh) * 256 * 128;
                    r.Q = WSP(bf16_t, WS_QM) + ((size_t)bh * 2048 + qb * 256) * 128; r.K = WSP(bf16_t, WS_KM) + kvb; r.V = WSP(bf16_t, WS_VM) + kvb;
                    r.O = WSP(bf16_t, WS_OMT) + ((size_t)bl * 2048 + qb * 256) * 512 + h * 128; r.LSE = nullptr; r.P0 = 256; r.W = 1 << 20; r.segmask = (1 << 20) - 1; r.skv = 256; r.ostride = 512; }
                return r; };
            int L = vcu;
            if (L < NBLK) {
                swa::BlockRef cur = make_ref(L); swa::Seam Sm;
                swa::prime(cur, (char*)lds_raw + RING_OFF, Sm, wave);
                for (;;) {
                    const bool more = L + G < NBLK; const int Ln = more ? L + G : L;
                    const swa::BlockRef nxt = more ? make_ref(Ln) : cur;
                    swa::block(cur, nxt, (char*)lds_raw + RING_OFF, Sm, wave);
                    if (!more) break;
                    cur = nxt; L = Ln;
                }
            }
            __syncthreads();
            { const Params pc = load_params(kargs); const int ptid = opaque_tid(wave); for (int u = bx; u < BC * 64; u += G) conv_unit(pc, u, lds_raw + RING_OFF, ptid); }
            if (PROBE_DUP == 13) { const int ptid = opaque_tid(wave); for (int u = bx; u < BC * 64; u += G) conv_unit(p, u, lds_raw + RING_OFF, ptid); }
            if (PROBE_DUP == 14) {
                int L = NDIL + vcu;
                if (L < NBLK) { swa::BlockRef cur = make_ref(L); swa::Seam Sm; swa::prime(cur, (char*)lds_raw + RING_OFF, Sm, wave);
                    for (;;) { const bool more = L + G < NBLK; const int Ln = more ? L + G : L; const swa::BlockRef nxt = more ? make_ref(Ln) : cur; swa::block(cur, nxt, (char*)lds_raw + RING_OFF, Sm, wave); if (!more) break; cur = nxt; L = Ln; } }
                __syncthreads();
            }
            }
        }
#endif
        SEAM(ph0 + 1);
        if (HAS(3) && IN(ph0 + 2)) { const Params p = load_params(kargs); const int ptid = opaque_tid(wave); for (int rep = 0; rep < NREP(3); ++rep) for (int w = bx * NWAVES + (ptid >> 6); w < TC; w += 2 * G * NWAVES) { if (w + G * NWAVES < TC) combine_token2(p, w, w + G * NWAVES, ptid & 63); else if (O_FP8 && P4_FP8) combine_token2(p, w, w, ptid & 63); else combine_token(p, w, ptid & 63); } }
        SEAM(ph0 + 2);
        if (HAS(4) && IN(ph0 + 3)) {
            const Params p = load_params(kargs);
            SchedMerge S; S.to.init(TC / 256, 4, G, bx); S.A0 = (const char*)WSP(bf16_t, WS_OATT); S.W = (const char*)WSP(bf16_t, WS_WA);
            FastEpiMerge E{WSP(bf16_t, WS_GATES), WSP(bf16_t, WS_MERGED)};
            if (PROBE_DUP == 15) { FastEpiStore E2{WSP(bf16_t, WS_MERGED), 1024, 1.0f}; pg8::gemm_phase<FastEpiStore, SchedMerge, true, false, false>(lds + RING_OFF, nullptr, 512, 512, 512, S, E2, wave); }
#if P4_FP8
            for (int rep = 0; rep < NREP(4); ++rep) pg8::gemm_phase<FastEpiMerge, SchedMerge, true, false, false, 1>(lds + RING_OFF, nullptr, 256, 256, 256, S, E, wave);
#else
            for (int rep = 0; rep < NREP(4); ++rep) pg8::gemm_phase<FastEpiMerge, SchedMerge, true, false, false>(lds + RING_OFF, nullptr, 512, 512, 512, S, E, wave);
#endif
        }
        SEAM(ph0 + 3);
        if (HAS(5) && IN(ph0 + 4)) {
            const Params p = load_params(kargs);
#if P5_FP8
            SchedPlain S; S.to.init(TC / 256, 4, G, bx); S.A = (const char*)WSP(bf16_t, WS_MERGED); S.B = (const char*)WSP(bf16_t, WS_WOUT); S.astep = 256 * 1024; S.bstep = 256 * 1024;
            FastEpiStore E{(bf16_t*)p.out + (size_t)ch * TC * 1024, 1024, 1.0f / (M8_SCALE * W8_SCALE)};
            for (int rep = 0; rep < NREP(5); ++rep) pg8::gemm_phase<FastEpiStore, SchedPlain, true, false, false, 1>(lds + RING_OFF, nullptr, 512, 512, 512, S, E, wave);
#else
            SchedPlain S; S.to.init(TC / 256, 4, G, bx); S.A = (const char*)WSP(bf16_t, WS_MERGED); S.B = (const char*)WSP(bf16_t, WS_WOUT); S.astep = 256 * 2048; S.bstep = 256 * 2048;
            FastEpiStore E{(bf16_t*)p.out + (size_t)ch * TC * 1024, 1024, 1.0f};
            for (int rep = 0; rep < NREP(5); ++rep) pg8::gemm_phase<FastEpiStore, SchedPlain, true, false, false>(lds + RING_OFF, nullptr, 1024, 1024, 1024, S, E, wave);
#endif
        }
        SEAM(ph0 + 4);
    }

    if (HAS(6) && IN(PH_LN1)) {
        const Params p = load_params(kargs);
        float* wr = (float*)(lds_raw + RING_OFF); int* cls_l = (int*)(wr + 20 * 1024); int* misc = cls_l + 64;
        for (int i = opaque_tid(wave); i < 20 * 1024; i += NTHR) wr[i] = WSP(float, WS_WRT)[i];
        __syncthreads();
        { for (int rep = 0; rep < NREP(6); ++rep) for (int u = bx; u < T / 64; u += G) { const int ptid = opaque_tid(wave); ln1_unit16(p, u, wr, cls_l, misc, ptid, (PROBE_DUP == 6) && rep == 0); } }
    }
    SEAM(PH_LN1);
    if (IN(PH_MOE1) || IN(PH_MOE2) || IN(PH_LN2)) {
        const int tid = opaque_tid(wave);
        if (tid == 0) class_tab_fill(ctl + CW_CNT, tab);
        __syncthreads();
        const int NP = tab->rowbase[NCLS] >> 8;
        for (int pm = tid; pm < NP; pm += NTHR) pan_cls[pm] = find_class(tab, pm * 256);
        __syncthreads();
    }
    if (HAS(7) && IN(PH_MOE1)) {
        const Params p = load_params(kargs);
        const int NP = tab->rowbase[NCLS] >> 8;
        SchedMoe S; S.to.init(NP, 8, G, bx); S.pan_cls = (LAS const int*)(lds + LCTL_OFF + 512); S.toktab = (LAS const int*)(lds + LTOK_OFF); S.H = nullptr; S.W1 = (const char*)WSP(bf16_t, WS_W1); S.W2 = nullptr; S.mode = 1;
        const int tid = opaque_tid(wave);
        for (int i = 0; i < MAXU; ++i) { int pm, pn; if (!S.to.tile(i, pm, pn)) break;
            if (tid < 256) { const int cls = pan_cls[pm]; int r = pm * 256 + tid - tab->rowbase[cls]; if (r >= tab->cnt[cls]) r = tab->cnt[cls] - 1; toktab[i * 256 + tid] = WSP(int, WS_LIST)[(size_t)cls * T + r]; } }
        __syncthreads();
        FastEpiMoe1 E{(LAS const int*)(lds + LTOK_OFF), WSP(float, WS_WTS), p.ws + WS_H};
        for (int rep = 0; rep < NREP(7); ++rep) pg8::gemm_phase<FastEpiMoe1, SchedMoe, true, true, false, true>(lds + RING_OFF, (const char*)(p.ws + WS_X1B8), 512, 512, 512, S, E, wave);
    }
    SEAM(PH_MOE1);
    if (HAS(8) && IN(PH_MOE2)) {
        const Params p = load_params(kargs);
        const int NP = tab->rowbase[NCLS] >> 8;
        SchedMoe S; S.to.init(NP, 4, G, bx); S.pan_cls = (LAS const int*)(lds + LCTL_OFF + 512); S.toktab = (LAS const int*)(lds + LTOK_OFF); S.H = (const char*)WSP(bf16_t, WS_H); S.W1 = nullptr; S.W2 = (const char*)WSP(bf16_t, WS_W2); S.mode = 2;
#if Y2_FP8
        FastEpiStore8 E{p.ws + WS_Y2, 1024, Y8_SCALE / (H8_SCALE * W8_SCALE)};
        for (int rep = 0; rep < NREP(8); ++rep) pg8::gemm_phase<FastEpiStore8, SchedMoe, true, false, true, true>(lds + RING_OFF, nullptr, 512, 4096, 512, S, E, wave);
#else
        FastEpiStore E{WSP(bf16_t, WS_Y2), 1024, 1.0f / (H8_SCALE * W8_SCALE)};
        for (int rep = 0; rep < NREP(8); ++rep) pg8::gemm_phase<FastEpiStore, SchedMoe, true, false, true, true>(lds + RING_OFF, nullptr, 512, 4096, 512, S, E, wave);
#endif
    }
    SEAM(PH_MOE2);
    if (HAS(9) && IN(PH_LN2)) {
        const Params p = load_params(kargs);
        const int tot = tab->rowbase[NCLS]; const int lane = opaque_tid(wave) & 63;
        for (int rep = 0; rep < NREP(9); ++rep)
        for (int prow = bx * NWAVES + wave; prow < tot; prow += 2 * G * NWAVES) {
            int tk[2], pr[2];
#pragma unroll
            for (int r = 0; r < 2; ++r) { pr[r] = prow + r * G * NWAVES; tk[r] = -1;
                if (pr[r] < tot) { const int cls = pan_cls[pr[r] >> 8]; const int i = pr[r] - tab->rowbase[cls]; if (i < tab->cnt[cls]) tk[r] = WSP(int, WS_LIST)[(size_t)cls * T + i]; } }
            ln2_rows<2>(p, tk, pr, lane, ((PROBE_DUP == 9) && rep == 0) ? (float*)(p.ws + 512 * MiB) : nullptr);
        }
    }
#undef IN
#undef HAS
#undef SEAM
}

#ifndef MK_MODE
#define MK_MODE 3
#endif
extern "C" void kernel_launch(void* const* d_in, const int* in_sizes, int n_in, void* d_out, int out_size, void* d_ws, size_t ws_size, hipStream_t stream) {
    if (n_in != 25 || ws_size < WS_END) { fprintf(stderr, "kernel_launch: unexpected n_in %d / ws_size %zu (need %zu)\n", n_in, ws_size, (size_t)WS_END); return; }
    static int grid = 0;
    if (grid == 0) {
        (void)hipFuncSetAttribute((const void*)k_ln1, hipFuncAttributeMaxDynamicSharedMemorySize, 20 * 1024 * 4 + 1024);
        if (hipFuncSetAttribute((const void*)mk_fwd, hipFuncAttributeMaxDynamicSharedMemorySize, LDS_BYTES) != hipSuccess) fprintf(stderr, "kernel_launch: hipFuncSetAttribute(mk_fwd, %d) failed\n", LDS_BYTES);
        int dev = 0, cus = 0; (void)hipGetDevice(&dev);
        if (hipDeviceGetAttribute(&cus, hipDeviceAttributeMultiprocessorCount, dev) != hipSuccess || cus <= 0) cus = 256;
        int per_cu = 0; (void)hipOccupancyMaxActiveBlocksPerMultiprocessor(&per_cu, (const void*)mk_fwd, NTHR, LDS_BYTES);
        if (per_cu < 1) fprintf(stderr, "kernel_launch: occupancy query reports %d blocks per CU for mk_fwd\n", per_cu);
        (void)hipGetLastError();
        grid = cus;
    }
    Params p{};
    p.x = (const float*)d_in[0]; p.mem = (const float*)d_in[1]; p.pos = (const int*)d_in[2];
    p.w_in = (const float*)d_in[3]; p.b_in = (const float*)d_in[4]; p.conv_w = (const float*)d_in[5]; p.conv_b = (const float*)d_in[6];
    p.conv_g = (const float*)d_in[7]; p.conv_bb = (const float*)d_in[8]; p.w_mem_kv = (const float*)d_in[9]; p.w_attn_o = (const float*)d_in[10];
    p.w_conv_o = (const float*)d_in[11]; p.w_mem_o = (const float*)d_in[12]; p.w_out = (const float*)d_in[13]; p.ln1_g = (const float*)d_in[14]; p.ln1_b = (const float*)d_in[15];
    p.w_gr = (const float*)d_in[16]; p.b_gr = (const float*)d_in[17]; p.w_er = (const float*)d_in[18]; p.b_er = (const float*)d_in[19];
    p.w_eg = (const float*)d_in[20]; p.w_eu = (const float*)d_in[21]; p.w_ed = (const float*)d_in[22]; p.ln2_g = (const float*)d_in[23]; p.ln2_b = (const float*)d_in[24];
    p.out = (float*)d_out; p.ws = (unsigned char*)d_ws;
    (void)hipMemsetAsync((char*)d_ws + WS_CTL, 0, CTL_BYTES, stream);
#if PROBE_DUP == 12
    (void)hipMemsetAsync((char*)d_ws + 944 * MiB, 0, 64 * MiB, stream);
#endif
    auto mk = [&](int lo, int hi) { Args a{}; a.p = p; a.ph_lo = lo; a.ph_hi = hi; hipLaunchKernelGGL(mk_fwd, dim3(grid), dim3(NTHR), LDS_BYTES, stream, a); };
#if MK_MODE == 3
    mk(0, PH_END);
#elif MK_MODE == 2
    for (int ph = 0; ph < PH_END; ++ph) mk(ph, ph + 1);
#elif MK_MODE == 1
    mk(PH_P0, PH_P0 + 1);
    for (int ch = 0; ch < NCH; ++ch) {
        const int ph0 = PH_CH0 + PH_PER_CH * ch;
        mk(ph0, ph0 + 1);
        k_nattn_dil<<<BC * 12 * 2048 / 4, 256, 0, stream>>>(p);
        k_nattn_mem<<<BC * 4 * 2048 / 4, 256, 0, stream>>>(p, ch);
        k_conv<<<BC * 64, 512, 0, stream>>>(p);
        mk(ph0 + 2, ph0 + 3); mk(ph0 + 3, ph0 + 4); mk(ph0 + 4, ph0 + 5);
    }
    mk(PH_LN1, PH_LN1 + 1); mk(PH_MOE1, PH_MOE1 + 1); mk(PH_MOE2, PH_MOE2 + 1); mk(PH_LN2, PH_LN2 + 1);
#else
    for (int w = 0; w < 8; ++w) k_transpose_w<<<2048, 256, 0, stream>>>(p, w);
    k_small_prep<<<(20 * 1024 + 255) / 256, 256, 0, stream>>>(p);
    k_cvt_bf16<<<2048, 256, 0, stream>>>(p.mem, (bf16_t*)((char*)d_ws + WS_MEMB), (size_t)NB * MEML * 1024 / 8);
    k_cvt_bf16<<<4096, 256, 0, stream>>>(p.x, (bf16_t*)((char*)d_ws + WS_XB), (size_t)T * 1024 / 8);
    k_ngemm_kv<<<dim3(1024 / 64, NB * MEML / 64), 256, 0, stream>>>(p, 0);
    for (int ch = 0; ch < NCH; ++ch) {
        k_ngemm_main<<<dim3(INC / 64, TC / 64), 256, 0, stream>>>(p, ch);
        k_nattn_dil<<<BC * 12 * 2048 / 4, 256, 0, stream>>>(p);
        k_nattn_mem<<<BC * 4 * 2048 / 4, 256, 0, stream>>>(p, ch);
        k_conv<<<BC * 64, 512, 0, stream>>>(p);
        k_combine<<<TC / 4, 256, 0, stream>>>(p);
        for (int br = 0; br < 3; ++br) k_ngemm_merge<<<dim3(1024 / 64, TC / 64), 256, 0, stream>>>(p, br);
        k_ngemm_mix<<<dim3(1024 / 64, TC / 64), 256, 0, stream>>>(p, ch);
    }
    k_ln1<<<256, 512, 20 * 1024 * 4 + 1024, stream>>>(p);
    k_ngemm_moe1<<<dim3(2048 / 64, MPAD / 64), 256, 0, stream>>>(p);
    k_ngemm_moe2<<<dim3(1024 / 64, MPAD / 64), 256, 0, stream>>>(p);
    k_ln2<<<MPAD / 4, 256, 0, stream>>>(p);
#endif
}
```
